# Optimizing an MI355X kernel written in HIP

```python
import math
import jax, jax.numpy as jnp
from jax import lax
import numpy as np

D_MODEL = 2048
BATCH = 8
SEQ = 2048
DEPTH = 2

HEAD_DIM = 64
N_Q_HEADS = D_MODEL // (2 * HEAD_DIM)
N_KV_HEADS = N_Q_HEADS // 4
WINDOW = 128
ROPE_THETA = 10000.0
SSM_HEADS = D_MODEL // (2 * HEAD_DIM)
SSM_HEAD_DIM = 64
D_INNER = SSM_HEADS * SSM_HEAD_DIM
D_STATE = 128
N_GROUPS = 2
CONV_WIDTH = 4
CHUNK = 128
RWKV_HEADS = D_MODEL // HEAD_DIM
DECAY_LORA = 96
AAA_LORA = 96
GATE_LORA = 256
N_SHIFT_MIX = 6
D_FF = 4 * D_MODEL
NORM_EPS = 1e-6
GN_EPS = 64e-5

Q_W = N_Q_HEADS * HEAD_DIM
KV_W = N_KV_HEADS * HEAD_DIM
BC_W = N_GROUPS * D_STATE
CONV_DIM = D_INNER + 2 * BC_W
IN_W = Q_W + 2 * KV_W + D_INNER + CONV_DIM + SSM_HEADS
MIX_W = Q_W + D_INNER
N_EVEN = (DEPTH + 1) // 2
N_ODD = DEPTH // 2

kernel_name = "hybrid_swa_ssd_rwkv7_trunk"


def rms_norm(x, g, eps=NORM_EPS):
    xf = x.astype(jnp.float32)
    y = xf * lax.rsqrt(jnp.mean(xf * xf, axis=-1, keepdims=True) + eps)
    return (y * g.astype(jnp.float32)).astype(x.dtype)


def apply_rope(x, cos, sin):
    x1, x2 = jnp.split(x, 2, axis=-1)
    c = cos[None, :, None, :].astype(x.dtype)
    s = sin[None, :, None, :].astype(x.dtype)
    return jnp.concatenate([x1 * c - x2 * s, x2 * c + x1 * s], axis=-1)


def sliding_window_attention(q, k, v, sinks):
    b_, L = q.shape[0], q.shape[1]
    nb = L // WINDOW
    rep = N_Q_HEADS // N_KV_HEADS
    qb = q.reshape(b_, nb, WINDOW, N_KV_HEADS, rep, HEAD_DIM)
    kb = k.reshape(b_, nb, WINDOW, N_KV_HEADS, HEAD_DIM)
    vb = v.reshape(b_, nb, WINDOW, N_KV_HEADS, HEAD_DIM)

    def with_prev(t):
        prev = jnp.concatenate([jnp.zeros_like(t[:, :1]), t[:, :-1]], axis=1)
        return jnp.concatenate([prev, t], axis=2)

    kw, vw = with_prev(kb), with_prev(vb)
    s = jnp.einsum('bnqhrd,bnkhd->bnhrqk', qb, kw).astype(jnp.float32) * (HEAD_DIM ** -0.5)
    qi = jnp.arange(WINDOW)[:, None] + WINDOW
    kj = jnp.arange(2 * WINDOW)[None, :]
    band = (kj <= qi) & (qi - kj < WINDOW)
    first = band & (kj >= WINDOW)
    mask = jnp.where((jnp.arange(nb) == 0)[:, None, None], first[None], band[None])
    s = jnp.where(mask[None, :, None, None], s, -jnp.inf)
    sink = sinks.astype(jnp.float32).reshape(N_KV_HEADS, rep)[None, None, :, :, None, None]
    m = jnp.maximum(jnp.max(s, axis=-1, keepdims=True), sink)
    p = jnp.exp(s - m)
    p = p / (jnp.sum(p, axis=-1, keepdims=True) + jnp.exp(sink - m))
    o = jnp.einsum('bnhrqk,bnkhd->bnqhrd', p.astype(v.dtype), vw)
    return o.reshape(b_, L, Q_W)


def causal_depthwise_conv(x, w, b):
    y = lax.conv_general_dilated(
        x, w[:, None, :].astype(x.dtype), window_strides=(1,),
        padding=[(CONV_WIDTH - 1, 0)], dimension_numbers=('NWC', 'WIO', 'NWC'),
        feature_group_count=x.shape[-1])
    return y + b.astype(x.dtype)


def ssd_chunked(xs, dt, A, Bm, Cm):
    b_, L = xs.shape[0], xs.shape[1]
    nc = L // CHUNK
    hg = SSM_HEADS // N_GROUPS
    x = (xs.astype(jnp.float32) * dt[..., None]).reshape(b_, nc, CHUNK, N_GROUPS, hg, SSM_HEAD_DIM)
    Bc = Bm.astype(jnp.float32).reshape(b_, nc, CHUNK, N_GROUPS, D_STATE)
    Cc = Cm.astype(jnp.float32).reshape(b_, nc, CHUNK, N_GROUPS, D_STATE)
    cs = jnp.cumsum((dt * A).reshape(b_, nc, CHUNK, N_GROUPS, hg), axis=2)
    causal = jnp.tril(jnp.ones((CHUNK, CHUNK), dtype=bool))[None, None, :, :, None, None]
    seg = cs[:, :, :, None] - cs[:, :, None]
    Lm = jnp.exp(jnp.where(causal, seg, -jnp.inf))
    CB = jnp.einsum('bcqgn,bckgn->bcqkg', Cc, Bc)
    y_diag = jnp.einsum('bcqkg,bcqkgh,bckghp->bcqghp', CB, Lm, x)
    decay_out = jnp.exp(cs[:, :, -1:] - cs)
    states = jnp.einsum('bckgn,bckgh,bckghp->bcghpn', Bc, decay_out, x)
    chunk_decay = jnp.exp(cs[:, :, -1])

    def step(h, inp):
        s_c, d_c = inp
        return h * d_c[..., None, None] + s_c, h

    h0 = jnp.zeros((b_, N_GROUPS, hg, SSM_HEAD_DIM, D_STATE), jnp.float32)
    _, prev = lax.scan(step, h0, (jnp.moveaxis(states, 1, 0), jnp.moveaxis(chunk_decay, 1, 0)))
    prev = jnp.moveaxis(prev, 0, 1)
    y_off = jnp.einsum('bcqgn,bcghpn,bcqgh->bcqghp', Cc, prev, jnp.exp(cs))
    return (y_diag + y_off).reshape(b_, L, SSM_HEADS, SSM_HEAD_DIM)


def attn_ssd_mixer(h, cos, sin, w_in, conv_w, conv_b, dt_bias, a_log, d_skip, ssd_norm,
                   q_norm, k_norm, sinks, w_out):
    b_, L, _ = h.shape
    proj = h @ w_in.astype(h.dtype)
    splits = [Q_W, Q_W + KV_W, Q_W + 2 * KV_W, Q_W + 2 * KV_W + D_INNER,
              Q_W + 2 * KV_W + D_INNER + CONV_DIM]
    q, k, v, z, xbc, dt_raw = jnp.split(proj, splits, axis=-1)
    q = apply_rope(rms_norm(q.reshape(b_, L, N_Q_HEADS, HEAD_DIM), q_norm), cos, sin)
    k = apply_rope(rms_norm(k.reshape(b_, L, N_KV_HEADS, HEAD_DIM), k_norm), cos, sin)
    v = v.reshape(b_, L, N_KV_HEADS, HEAD_DIM)
    y_attn = sliding_window_attention(q, k, v, sinks)
    xbc = jax.nn.silu(causal_depthwise_conv(xbc, conv_w, conv_b))
    xs, Bm, Cm = jnp.split(xbc, [D_INNER, D_INNER + BC_W], axis=-1)
    xs = xs.reshape(b_, L, SSM_HEADS, SSM_HEAD_DIM)
    Bm = Bm.reshape(b_, L, N_GROUPS, D_STATE)
    Cm = Cm.reshape(b_, L, N_GROUPS, D_STATE)
    dt = jax.nn.softplus(dt_raw.astype(jnp.float32) + dt_bias.astype(jnp.float32))
    A = -jnp.exp(a_log.astype(jnp.float32))
    y = ssd_chunked(xs, dt, A, Bm, Cm) + d_skip.astype(jnp.float32)[:, None] * xs.astype(jnp.float32)
    y = y.reshape(b_, L, D_INNER) * jax.nn.silu(z.astype(jnp.float32))
    yg = y.reshape(b_, L, N_GROUPS, D_INNER // N_GROUPS)
    yg = yg * lax.rsqrt(jnp.mean(yg * yg, axis=-1, keepdims=True) + NORM_EPS)
    y_ssd = (yg.reshape(b_, L, D_INNER) * ssd_norm.astype(jnp.float32)).astype(h.dtype)
    return jnp.concatenate([y_attn.astype(h.dtype), y_ssd], axis=-1) @ w_out.astype(h.dtype)


def rwkv7_scan(r, w, k, v, a, b):
    def step(S, inp):
        r_t, w_t, k_t, v_t, a_t, b_t = inp
        sa = jnp.einsum('bhvk,bhk->bhv', S, a_t)
        S = S * w_t[:, :, None, :] + sa[..., None] * b_t[:, :, None, :] + v_t[..., None] * k_t[:, :, None, :]
        return S, jnp.einsum('bhvk,bhk->bhv', S, r_t)

    seq = tuple(jnp.moveaxis(t.astype(jnp.float32), 1, 0) for t in (r, w, k, v, a, b))
    b_ = r.shape[0]
    S0 = jnp.zeros((b_, RWKV_HEADS, HEAD_DIM, HEAD_DIM), jnp.float32)
    _, y = lax.scan(step, S0, seq)
    return jnp.moveaxis(y, 0, 1)


def rwkv7_time_mix(h, mix, w0, w1, w2, a0, a1, a2, g1, g2, k_k, k_a, r_k,
                   w_r, w_k, w_v, w_o, ln_w, ln_b):
    b_, L, D = h.shape
    dt_ = h.dtype
    xx = jnp.pad(h, ((0, 0), (1, 0), (0, 0)))[:, :-1] - h
    mix = mix.astype(dt_)
    xr, xw, xk, xv, xa, xg = (h + xx * mix[i] for i in range(N_SHIFT_MIX))
    r = xr @ w_r.astype(dt_)
    k = xk @ w_k.astype(dt_)
    v = xv @ w_v.astype(dt_)
    logw = -jax.nn.softplus(-(w0.astype(jnp.float32)
                              + (jnp.tanh(xw @ w1.astype(dt_)) @ w2.astype(dt_)).astype(jnp.float32))) - 0.5
    decay = jnp.exp(-jnp.exp(logw))
    a = jax.nn.sigmoid((a0.astype(dt_) + (xa @ a1.astype(dt_)) @ a2.astype(dt_)).astype(jnp.float32))
    g = jax.nn.sigmoid(xg @ g1.astype(dt_)) @ g2.astype(dt_)
    kf = k.astype(jnp.float32)
    kk = (kf * k_k.astype(jnp.float32)).reshape(b_, L, RWKV_HEADS, HEAD_DIM)
    kk = kk * lax.rsqrt(jnp.maximum(jnp.sum(kk * kk, axis=-1, keepdims=True), 1e-24))
    kf = kf * (1.0 + (a - 1.0) * k_a.astype(jnp.float32))
    hs = lambda t: t.reshape(b_, L, RWKV_HEADS, HEAD_DIM)
    rh, kh, vh, ah = hs(r.astype(jnp.float32)), hs(kf), hs(v.astype(jnp.float32)), hs(a)
    y = rwkv7_scan(rh, hs(decay), kh, vh, -kk, kk * ah)
    mu = jnp.mean(y, axis=-1, keepdims=True)
    var = jnp.mean(jnp.square(y - mu), axis=-1, keepdims=True)
    y = ((y - mu) * lax.rsqrt(var + GN_EPS)).reshape(b_, L, D)
    y = hs(y * ln_w.astype(jnp.float32) + ln_b.astype(jnp.float32))
    bonus = jnp.sum(rh * kh * r_k.astype(jnp.float32), axis=-1, keepdims=True) * vh
    y = (y + bonus).reshape(b_, L, D).astype(dt_)
    return (y * g) @ w_o.astype(dt_)


def squared_relu_mlp(h, w_up, w_down):
    u = h @ w_up.astype(h.dtype)
    return jnp.square(jax.nn.relu(u)) @ w_down.astype(h.dtype)


def setup_inputs(seed: int = 0) -> dict:
    key = jax.random.key(seed)
    ks = iter(jax.random.split(key, 48))

    def nrm(shape, scale):
        return scale * jax.random.normal(next(ks), shape, jnp.float32)

    def uni(shape, lo, hi):
        return jax.random.uniform(next(ks), shape, jnp.float32, lo, hi)

    D = D_MODEL
    x = nrm((BATCH, SEQ, D), 1.0)
    norm_mix = 1.0 + nrm((DEPTH, D), 0.02)
    norm_ffn = 1.0 + nrm((DEPTH, D), 0.02)
    w_up = nrm((DEPTH, D, D_FF), D ** -0.5)
    w_down = nrm((DEPTH, D_FF, D), D_FF ** -0.5)
    ev_w_in = nrm((N_EVEN, D, IN_W), D ** -0.5)
    ev_conv_w = nrm((N_EVEN, CONV_WIDTH, CONV_DIM), CONV_WIDTH ** -0.5)
    ev_conv_b = nrm((N_EVEN, CONV_DIM), 0.02)
    dt0 = jnp.exp(uni((N_EVEN, SSM_HEADS), math.log(1e-3), math.log(1e-1)))
    ev_dt_bias = dt0 + jnp.log(-jnp.expm1(-dt0))
    ev_a_log = jnp.log(uni((N_EVEN, SSM_HEADS), 1.0, 16.0))
    ev_d_skip = 1.0 + nrm((N_EVEN, SSM_HEADS), 0.1)
    ev_ssd_norm = 1.0 + nrm((N_EVEN, D_INNER), 0.02)
    ev_q_norm = 1.0 + nrm((N_EVEN, HEAD_DIM), 0.02)
    ev_k_norm = 1.0 + nrm((N_EVEN, HEAD_DIM), 0.02)
    ev_sinks = nrm((N_EVEN, N_Q_HEADS), 0.5)
    ev_w_out = nrm((N_EVEN, MIX_W, D), MIX_W ** -0.5)
    od_mix = uni((N_ODD, N_SHIFT_MIX, D), 0.0, 1.0)
    od_w0 = uni((N_ODD, D), -6.0, -1.0)
    od_w1 = nrm((N_ODD, D, DECAY_LORA), D ** -0.5)
    od_w2 = nrm((N_ODD, DECAY_LORA, D), 0.1 * DECAY_LORA ** -0.5)
    od_a0 = nrm((N_ODD, D), 0.5)
    od_a1 = nrm((N_ODD, D, AAA_LORA), D ** -0.5)
    od_a2 = nrm((N_ODD, AAA_LORA, D), AAA_LORA ** -0.5)
    od_g1 = nrm((N_ODD, D, GATE_LORA), D ** -0.5)
    od_g2 = nrm((N_ODD, GATE_LORA, D), GATE_LORA ** -0.5)
    od_k_k = 0.85 + nrm((N_ODD, D), 0.05)
    od_k_a = 1.0 + nrm((N_ODD, D), 0.05)
    od_r_k = nrm((N_ODD, RWKV_HEADS, HEAD_DIM), 0.1)
    od_w_r = nrm((N_ODD, D, D), D ** -0.5)
    od_w_k = nrm((N_ODD, D, D), D ** -0.5)
    od_w_v = nrm((N_ODD, D, D), D ** -0.5)
    od_w_o = nrm((N_ODD, D, D), D ** -0.5)
    od_ln_w = 1.0 + nrm((N_ODD, D), 0.02)
    od_ln_b = nrm((N_ODD, D), 0.02)
    return {
        "x": x, "norm_mix": norm_mix, "norm_ffn": norm_ffn, "w_up": w_up, "w_down": w_down,
        "ev_w_in": ev_w_in, "ev_conv_w": ev_conv_w, "ev_conv_b": ev_conv_b,
        "ev_dt_bias": ev_dt_bias, "ev_a_log": ev_a_log, "ev_d_skip": ev_d_skip,
        "ev_ssd_norm": ev_ssd_norm, "ev_q_norm": ev_q_norm, "ev_k_norm": ev_k_norm,
        "ev_sinks": ev_sinks, "ev_w_out": ev_w_out,
        "od_mix": od_mix, "od_w0": od_w0, "od_w1": od_w1, "od_w2": od_w2,
        "od_a0": od_a0, "od_a1": od_a1, "od_a2": od_a2, "od_g1": od_g1, "od_g2": od_g2,
        "od_k_k": od_k_k, "od_k_a": od_k_a, "od_r_k": od_r_k,
        "od_w_r": od_w_r, "od_w_k": od_w_k, "od_w_v": od_w_v, "od_w_o": od_w_o,
        "od_ln_w": od_ln_w, "od_ln_b": od_ln_b,
    }


def reference(x, norm_mix, norm_ffn, w_up, w_down,
              ev_w_in, ev_conv_w, ev_conv_b, ev_dt_bias, ev_a_log, ev_d_skip,
              ev_ssd_norm, ev_q_norm, ev_k_norm, ev_sinks, ev_w_out,
              od_mix, od_w0, od_w1, od_w2, od_a0, od_a1, od_a2, od_g1, od_g2,
              od_k_k, od_k_a, od_r_k, od_w_r, od_w_k, od_w_v, od_w_o, od_ln_w, od_ln_b):
    L = x.shape[1]
    inv_freq = ROPE_THETA ** (-jnp.arange(0, HEAD_DIM, 2, dtype=jnp.float32) / HEAD_DIM)
    ang = jnp.arange(L, dtype=jnp.float32)[:, None] * inv_freq[None, :]
    cos, sin = jnp.cos(ang), jnp.sin(ang)
    for i in range(DEPTH):
        j = i // 2
        h = rms_norm(x, norm_mix[i])
        if i % 2 == 0:
            mix = attn_ssd_mixer(h, cos, sin, ev_w_in[j], ev_conv_w[j], ev_conv_b[j],
                                 ev_dt_bias[j], ev_a_log[j], ev_d_skip[j], ev_ssd_norm[j],
                                 ev_q_norm[j], ev_k_norm[j], ev_sinks[j], ev_w_out[j])
        else:
            mix = rwkv7_time_mix(h, od_mix[j], od_w0[j], od_w1[j], od_w2[j], od_a0[j],
                                 od_a1[j], od_a2[j], od_g1[j], od_g2[j], od_k_k[j], od_k_a[j],
                                 od_r_k[j], od_w_r[j], od_w_k[j], od_w_v[j], od_w_o[j],
                                 od_ln_w[j], od_ln_b[j])
        x = x + mix.astype(x.dtype)
        h = rms_norm(x, norm_ffn[i])
        x = x + squared_relu_mlp(h, w_up[i], w_down[i]).astype(x.dtype)
    return x
```

```cpp
#include <hip/hip_runtime.h>
#include <hip/hip_cooperative_groups.h>
#include <cstdio>
#include <cstring>
namespace cg = cooperative_groups;
__device__ __forceinline__ int opq(int v) { asm volatile("" : "+v"(v)); return v; }
namespace pg8 {
#define PG8_LAS __attribute__((address_space(3)))
typedef unsigned short bf16_t;
typedef short bf16x8 __attribute__((ext_vector_type(8)));
typedef float f32x4 __attribute__((ext_vector_type(4)));
typedef unsigned u32x4 __attribute__((ext_vector_type(4)));
constexpr int BM = 256, BK = 64, HALF = 128, HTB = HALF * BK * 2  , STAGE_BYTES = 8 * HTB, NXCD = 8, WGM = 8;

__host__ __device__ __forceinline__ int lds_byte(int r, int c) { const int st = (r >> 4) * 2 + (c >> 5), rr = r & 15, cc = c & 31, ob = rr * 64 + cc * 2; return st * 1024 + (ob ^ (((ob >> 9) & 1) << 5)); }
__host__ __device__ __forceinline__ void stage_rc(int b, int& R, int& C) { const int st = b / 1024, sb = b % 1024, swz = sb ^ (((sb >> 9) & 1) << 5); R = (st >> 1) * 16 + swz / 64; C = (st & 1) * 32 + (swz % 64) / 2; }
__host__ __device__ __forceinline__ int perm32(int rho) { const int n = rho >> 4, i = rho & 15; return 8 * (i >> 2) + 4 * n + (i & 3); }

struct Unit { int pm, pn; };
struct Gemm { const bf16_t* A; const bf16_t* Bt; int M, N, K; };

struct StaticOrder {
    int nM, nN, nwg, G, c;
    __host__ __device__ void init(int M, int N, int G_, int c_) { nM = M / BM; nN = N / BM; nwg = nM * nN; G = G_; c = c_; }
    __host__ __device__ bool next(int i, Unit& u) const {
        const long L = (long)i * G + c; if (L >= nwg) return false;
        int wgid = (int)L; { const int q = nwg / NXCD, r = nwg % NXCD, xcd = wgid % NXCD, off = wgid / NXCD; wgid = (xcd < r ? xcd * (q + 1) : r * (q + 1) + (xcd - r) * q) + off; }
        const int nig = WGM * nN, gid = wgid / nig, fm = gid * WGM, gsz = (nM - fm) < WGM ? (nM - fm) : WGM;
        u.pm = fm + ((wgid % nig) % gsz); u.pn = (wgid % nig) / gsz; return true;
    }
    __device__ __forceinline__ void a_ready(const Unit&) const {}
    __device__ __forceinline__ void done(const Unit&) const {}
};
__device__ __forceinline__ unsigned cvt_pk_bf16(float lo, float hi) { unsigned r; asm volatile("v_cvt_pk_bf16_f32 %0, %1, %2" : "=v"(r) : "v"(lo), "v"(hi)); return r; }

template <class Epi, class Sched, bool STAMP = false>
__device__ __forceinline__ void gemm_phase(PG8_LAS unsigned char* lds, const Gemm g, const Sched& S, const Epi& E, unsigned long long* stamps) {
    const int tid = opq(threadIdx.x), wid = __builtin_amdgcn_readfirstlane(tid >> 6), lane = tid & 63, wr = wid >> 2, wc = wid & 3, fr = lane & 15, fq = lane >> 4;
    const int K = g.K, nt = K / BK;
    int ts_lo = 0, ts_hi = 0, nts = 0; const unsigned long long rt_entry = STAMP ? (unsigned long long)wall_clock64() : 0ull;
#define PG8_STAMP() do { if (STAMP && wid == 0 && nts < 64) { const unsigned long long _c = (unsigned long long)clock64(); \
        ts_lo = (lane == nts) ? (int)(unsigned)_c : ts_lo; ts_hi = (lane == nts) ? (int)(unsigned)(_c >> 32) : ts_hi; ++nts; } } while (0)
    PG8_STAMP();
    unsigned voffA[2], voffB[2];
#pragma unroll
    for (int i = 0; i < 2; ++i) { int R, C; stage_rc(tid * 16 + i * 8192, R, C); const int Rb = Epi::PERM ? ((R & ~31) + perm32(R & 31)) : R;
        voffA[i] = (unsigned)(R * K + C) * 2u; voffB[i] = (unsigned)(Rb * K + C) * 2u; }
    const size_t kstep = (size_t)(BK * 2);
    const size_t hstep = (size_t)HALF * K * 2;
    const size_t tstep = 2 * hstep;
    const unsigned ldsw = (unsigned)wid * 1024u;
    const int aoff = lds_byte(wr * 64 + fr, fq * 8), boff = lds_byte(wc * 32 + fr, fq * 8);
#define PG8_SA(b, h) (((b) * 2 + (h)) * HTB)
#define PG8_SB(b, h) ((4 + (b) * 2 + (h)) * HTB)
#define PG8_STAGE(bufoff, gbase, voff) do { _Pragma("unroll") for (int _i = 0; _i < 2; ++_i) \
        __builtin_amdgcn_global_load_lds((const unsigned*)((const char*)(gbase) + (voff)[_i]), (PG8_LAS unsigned*)(lds + (bufoff) + ldsw + _i * 8192), 16, 0, 0); } while (0)
#define PG8_LDA(dst, b, h) do { _Pragma("unroll") for (int m = 0; m < 4; ++m) _Pragma("unroll") for (int k = 0; k < 2; ++k) dst[m][k] = *(const PG8_LAS bf16x8*)(lds + PG8_SA(b, h) + aoff + m * 2048 + k * 1024); } while (0)
#define PG8_LDB(dst, b, h) do { _Pragma("unroll") for (int n = 0; n < 2; ++n) _Pragma("unroll") for (int k = 0; k < 2; ++k) dst[n][k] = *(const PG8_LAS bf16x8*)(lds + PG8_SB(b, h) + boff + n * 2048 + k * 1024); } while (0)
#define PG8_MMA(ai, bj, At, Bt) do { __builtin_amdgcn_s_setprio(1); _Pragma("unroll") for (int m = 0; m < 4; ++m) _Pragma("unroll") for (int n = 0; n < 2; ++n) _Pragma("unroll") for (int k = 0; k < 2; ++k) \
        acc[ai][bj][m][n] = __builtin_amdgcn_mfma_f32_16x16x32_bf16(Bt[n][k], At[m][k], acc[ai][bj][m][n], 0, 0, 0); __builtin_amdgcn_s_setprio(0); } while (0)
#define PG8_WAIT_V(n) asm volatile("s_waitcnt vmcnt(" #n ")" ::: "memory")
#define PG8_WAIT_L(n) asm volatile("s_waitcnt lgkmcnt(" #n ")" ::: "memory")
#define PG8_BAR __builtin_amdgcn_s_barrier()
#define PG8_SCHED __builtin_amdgcn_sched_barrier(0)
    Unit cur, nxt; int ui = 0;
    if (!S.next(0, cur)) return;
    f32x4 acc[2][2][4][2];
#pragma unroll
    for (int a = 0; a < 2; ++a)
#pragma unroll
        for (int b = 0; b < 2; ++b)
#pragma unroll
            for (int m = 0; m < 4; ++m)
#pragma unroll
                for (int n = 0; n < 2; ++n) acc[a][b][m][n] = (f32x4){0.f, 0.f, 0.f, 0.f};
    bf16x8 At[4][2], B0[2][2], B1[2][2];
    const char* cA = (const char*)g.A + (size_t)cur.pm * tstep; const char* cB = (const char*)g.Bt + (size_t)cur.pn * tstep;
    S.a_ready(cur);
    PG8_STAGE(PG8_SB(0, 0), cB, voffB); PG8_STAGE(PG8_SA(0, 0), cA, voffA); PG8_STAGE(PG8_SB(0, 1), cB + hstep, voffB); PG8_STAGE(PG8_SA(0, 1), cA + hstep, voffA);
    if (wr == 1) PG8_BAR;
    PG8_WAIT_V(4); PG8_BAR;
    PG8_STAGE(PG8_SB(1, 0), cB + kstep, voffB); PG8_STAGE(PG8_SA(1, 0), cA + kstep, voffA); PG8_STAGE(PG8_SB(1, 1), cB + hstep + kstep, voffB);
    PG8_WAIT_V(6); PG8_BAR;
    PG8_STAMP();
    for (;;) {
        const bool has_next = S.next(ui + 1, nxt);
        const char* nA = has_next ? (const char*)g.A + (size_t)nxt.pm * tstep : cA; const char* nB = has_next ? (const char*)g.Bt + (size_t)nxt.pn * tstep : cB;
        for (int t = 0; t < nt; t += 2) {
            const bool last = (t == nt - 2);
            const char* a1 = cA + (size_t)(t + 1) * kstep;
            const char* a2 = last ? nA : cA + (size_t)(t + 2) * kstep; const char* b2 = last ? nB : cB + (size_t)(t + 2) * kstep;
            const char* a3 = a2 + kstep; const char* b3 = b2 + kstep;
            if (last && has_next) S.a_ready(nxt);
            PG8_LDB(B0, 0, 0); PG8_SCHED; PG8_LDA(At, 0, 0); PG8_STAGE(PG8_SA(1, 1), a1 + hstep, voffA);
            PG8_WAIT_L(8); PG8_BAR; PG8_WAIT_L(0); PG8_MMA(0, 0, At, B0); PG8_BAR; PG8_SCHED;
            PG8_LDB(B1, 0, 1); PG8_STAGE(PG8_SB(0, 0), b2, voffB);
            PG8_BAR; PG8_WAIT_L(0); PG8_MMA(0, 1, At, B1); PG8_BAR;
            PG8_LDA(At, 0, 1); PG8_STAGE(PG8_SA(0, 0), a2, voffA);
            PG8_BAR; PG8_WAIT_L(0); PG8_MMA(1, 0, At, B0); PG8_BAR; PG8_SCHED;
            PG8_STAGE(PG8_SB(0, 1), b2 + hstep, voffB);
            PG8_WAIT_V(6); PG8_BAR; PG8_MMA(1, 1, At, B1); PG8_BAR;
            PG8_LDB(B0, 1, 0); PG8_SCHED; PG8_LDA(At, 1, 0); PG8_STAGE(PG8_SA(0, 1), a2 + hstep, voffA);
            PG8_WAIT_L(8); PG8_BAR; PG8_WAIT_L(0); PG8_MMA(0, 0, At, B0); PG8_BAR; PG8_SCHED;
            PG8_LDB(B1, 1, 1); PG8_STAGE(PG8_SB(1, 0), b3, voffB);
            PG8_BAR; PG8_WAIT_L(0); PG8_MMA(0, 1, At, B1); PG8_BAR;
            PG8_LDA(At, 1, 1); PG8_STAGE(PG8_SA(1, 0), a3, voffA);
            PG8_BAR; PG8_WAIT_L(0); PG8_MMA(1, 0, At, B0); PG8_BAR; PG8_SCHED;
            PG8_STAGE(PG8_SB(1, 1), b3 + hstep, voffB);
            PG8_WAIT_V(6); PG8_BAR; PG8_MMA(1, 1, At, B1); PG8_BAR;
        }
        PG8_STAMP();
        if constexpr (!Epi::AFTER_DRAIN) { E(acc, cur, wr, wc, fr, fq); S.done(cur); }
        PG8_STAMP();
        if (!has_next) break;
#pragma unroll
        for (int a = 0; a < 2; ++a)
#pragma unroll
            for (int b = 0; b < 2; ++b)
#pragma unroll
                for (int m = 0; m < 4; ++m)
#pragma unroll
                    for (int n = 0; n < 2; ++n) acc[a][b][m][n] = (f32x4){0.f, 0.f, 0.f, 0.f};
        cur = nxt; cA = nA; cB = nB; ++ui;
    }
    PG8_WAIT_V(0);
    if (wr == 0) PG8_BAR;
    PG8_BAR;
    if constexpr (Epi::AFTER_DRAIN) { E.fused(acc, cur, wr, wc, fr, fq, lds, wid, lane); S.done(cur); }
    PG8_STAMP();
    if (STAMP && wid == 0) { stamps[lane] = lane < nts ? (((unsigned long long)(unsigned)ts_hi << 32) | (unsigned)ts_lo) : 0ull;
        if (lane == 62) stamps[62] = rt_entry; if (lane == 63) stamps[63] = (unsigned long long)wall_clock64(); }
#undef PG8_STAMP
#undef PG8_SA
#undef PG8_SB
#undef PG8_STAGE
#undef PG8_LDA
#undef PG8_LDB
#undef PG8_MMA
#undef PG8_WAIT_V
#undef PG8_WAIT_L
#undef PG8_BAR
#undef PG8_SCHED
}
}

#include <cstdio>
#include <ctime>
#include <cstdlib>
#include <cstring>
#include <cmath>
#include <vector>
#include <algorithm>
#define CK(x) do { hipError_t e_ = (x); if (e_ != hipSuccess) { fprintf(stderr, "HIP %s:%d %s\n", __FILE__, __LINE__, hipGetErrorString(e_)); exit(2); } } while (0)
using pg8::bf16_t; using pg8::bf16x8; using pg8::f32x4; using pg8::u32x4; using pg8::cvt_pk_bf16;
#define LAS PG8_LAS

constexpr int D = 2048, SEQ = 2048, MTOK = 16384, DFF = 8192, INWP = 4352;
constexpr int COL_K = 1024, COL_V = 1280, COL_Z = 1536, COL_XBC = 2560, COL_DT = 4096;
constexpr size_t MiB = (size_t)1 << 20;
constexpr size_t WS_WBA = 0, WS_WMLP = 40 * MiB, WS_H = 104 * MiB, WS_PROJ = 168 * MiB, WS_YMIX = 304 * MiB, WS_YRAW = 368 * MiB, WS_XBC = 432 * MiB,
                 WS_DT = 480 * MiB, WS_DA = 481 * MiB, WS_ROPE = 482 * MiB, WS_U = 168 * MiB;
constexpr size_t WS_R = 40 * MiB, WS_K = 104 * MiB, WS_V = 168 * MiB, WS_L1W = 232 * MiB, WS_L1A = 240 * MiB, WS_L1G = 248 * MiB, WS_MIX = 256 * MiB,
                 WS_WDEC = 256 * MiB, WS_AA = 320 * MiB, WS_GG = 384 * MiB;
constexpr int LDS_BYTES = 140 * 1024;

enum { K_PRE0 = 0, K_GEMMB, K_GEMMF, K_CONVSSD, K_MIX0, K_POST0, K_NORM, K_PRE1, K_MIXES, K_RWKV, K_NORMCONV };
constexpr int NSTEPS = 19, NOPS = 22, NCJ = 16;

struct GemmOp { const bf16_t* A; const bf16_t* Bt; void* out; const float* bias; const float* res; int M, N, K, ldc, act, rot, pad0, pad1; };
struct ConvJob { const float* src; bf16_t* dst; int K, N, Kpad, Npad, tile0, ntiles; };
struct Params {
    const float* in[34];
    float* out; unsigned char* ws;
    GemmOp g[NOPS];
    ConvJob cj[NCJ];
    int kind[NSTEPS + 1]; int lo[NSTEPS + 1]; int hi[NSTEPS + 1];
    int step_lo, step_hi;
};

__device__ __forceinline__ float bf2f(unsigned short b) { return __uint_as_float(((unsigned)b) << 16); }
__device__ __forceinline__ float bflo(unsigned w) { return __uint_as_float(w << 16); }
__device__ __forceinline__ float bfhi(unsigned w) { return __uint_as_float(w & 0xffff0000u); }
__device__ __forceinline__ bf16_t f2bf(float f) { return (bf16_t)(cvt_pk_bf16(f, 0.f) & 0xffffu); }
__device__ __forceinline__ float wave_sum(float v) {
#pragma unroll
    for (int o = 32; o > 0; o >>= 1) v += __shfl_xor(v, o);
    return v; }
template <int CTRL> __device__ __forceinline__ float dpp_add(float x) {
    const int y = __builtin_amdgcn_update_dpp(0, __builtin_bit_cast(int, x), CTRL, 0xf, 0xf, true);
    return x + __builtin_bit_cast(float, y); }
__device__ __forceinline__ float red8(float x) { x = dpp_add<0xB1>(x); x = dpp_add<0x4E>(x); x = dpp_add<0x141>(x); return x; }
__device__ __forceinline__ float red16(float x) { x = red8(x); x = dpp_add<0x140>(x); return x; }
__device__ __forceinline__ float sigmoidf_(float v) { return 1.0f / (1.0f + __expf(-v)); }
__device__ __forceinline__ void unpack8(const uint4 r, float (&f)[8]) {
    f[0] = bflo(r.x); f[1] = bfhi(r.x); f[2] = bflo(r.y); f[3] = bfhi(r.y); f[4] = bflo(r.z); f[5] = bfhi(r.z); f[6] = bflo(r.w); f[7] = bfhi(r.w); }

__device__ __forceinline__ float act_apply(float v, int act) {
    switch (act) {
        case 1: { const float r = fmaxf(v, 0.f); return r * r; }
        case 2: return 1.0f - 2.0f / (1.0f + __expf(2.0f * v));
        case 3: return sigmoidf_(v);
        case 4: return 0.60653066f * sigmoidf_(v);
        default: return v; }
}
struct EpiB {
    static constexpr bool PERM = true, AFTER_DRAIN = false;
    bf16_t* O; int ldc; const float* bias; int act;
    __device__ __forceinline__ void operator()(const f32x4 (&acc)[2][2][4][2], const pg8::Unit& u, int wr, int wc, int fr, int fq) const {
        const int row0 = u.pm * 256 + wr * 64 + fr, col0 = u.pn * 256 + wc * 32 + 8 * fq;
        f32x4 bv[2][2];
#pragma unroll
        for (int bj = 0; bj < 2; ++bj)
#pragma unroll
            for (int n = 0; n < 2; ++n) bv[bj][n] = bias ? *(const f32x4*)(bias + col0 + bj * 128 + 4 * n) : (f32x4){0.f, 0.f, 0.f, 0.f};
#pragma unroll
        for (int ai = 0; ai < 2; ++ai)
#pragma unroll
            for (int m = 0; m < 4; ++m) { bf16_t* rowp = O + (size_t)(row0 + ai * 128 + m * 16) * ldc + col0;
#pragma unroll
                for (int bj = 0; bj < 2; ++bj) { f32x4 v0 = acc[ai][bj][m][0] + bv[bj][0], v1 = acc[ai][bj][m][1] + bv[bj][1];
                    if (act) {
#pragma unroll
                        for (int j = 0; j < 4; ++j) { v0[j] = act_apply(v0[j], act); v1[j] = act_apply(v1[j], act); } }
                    u32x4 w; w.x = cvt_pk_bf16(v0[0], v0[1]); w.y = cvt_pk_bf16(v0[2], v0[3]); w.z = cvt_pk_bf16(v1[0], v1[1]); w.w = cvt_pk_bf16(v1[2], v1[3]);
                    *(u32x4*)(rowp + bj * 128) = w; } }
    }
};
struct EpiF {
    static constexpr bool PERM = false, AFTER_DRAIN = false;
    float* C; int ldc; const float* res;
    __device__ __forceinline__ void operator()(const f32x4 (&acc)[2][2][4][2], const pg8::Unit& u, int wr, int wc, int fr, int fq) const {
        const int row0 = u.pm * 256 + wr * 64 + fr, col0 = u.pn * 256 + wc * 32 + 4 * fq;
#pragma unroll
        for (int ai = 0; ai < 2; ++ai)
#pragma unroll
            for (int m = 0; m < 4; ++m) { const size_t ro = (size_t)(row0 + ai * 128 + m * 16) * ldc + col0;
#pragma unroll
                for (int bj = 0; bj < 2; ++bj)
#pragma unroll
                    for (int n = 0; n < 2; ++n) { const f32x4 r = *(const f32x4*)(res + ro + bj * 128 + n * 16); *(f32x4*)(C + ro + bj * 128 + n * 16) = acc[ai][bj][m][n] + r; } }
    }
};

__device__ __forceinline__ void convert_tiles(const Params& p, int jlo, int jhi, LAS unsigned char* lds) {
    const int tid = opq(threadIdx.x); LAS float* T = (LAS float*)lds;
    const int total = p.cj[jhi - 1].tile0 + p.cj[jhi - 1].ntiles;
    for (int tile = blockIdx.x; tile < total; tile += gridDim.x) {
        int j = jlo; while (j + 1 < jhi && tile >= p.cj[j + 1].tile0) ++j;
        const float* src = p.cj[j].src; bf16_t* dst = p.cj[j].dst; const int K = p.cj[j].K, N = p.cj[j].N, Kpad = p.cj[j].Kpad;
        const int local = tile - p.cj[j].tile0, nkt = Kpad >> 6, kt = local % nkt, nt = local / nkt;
#pragma unroll
        for (int i = 0; i < 2; ++i) { const int idx = tid + i * 512, kr = idx >> 4, c4 = idx & 15, k = kt * 64 + kr, n = nt * 64 + c4 * 4;
            f32x4 v = (f32x4){0.f, 0.f, 0.f, 0.f};
            if (k < K && n < N) v = *(const f32x4*)(src + (size_t)k * N + n);
            T[kr * 65 + c4 * 4 + 0] = v[0]; T[kr * 65 + c4 * 4 + 1] = v[1]; T[kr * 65 + c4 * 4 + 2] = v[2]; T[kr * 65 + c4 * 4 + 3] = v[3]; }
        __syncthreads();
        { const int nl = tid >> 3, kc = tid & 7; float f[8];
#pragma unroll
          for (int e = 0; e < 8; ++e) f[e] = T[(kc * 8 + e) * 65 + nl];
          u32x4 w; w.x = cvt_pk_bf16(f[0], f[1]); w.y = cvt_pk_bf16(f[2], f[3]); w.z = cvt_pk_bf16(f[4], f[5]); w.w = cvt_pk_bf16(f[6], f[7]);
          *(u32x4*)(dst + (size_t)(nt * 64 + nl) * Kpad + kt * 64 + kc * 8) = w; }
        __syncthreads();
    }
}

__device__ __forceinline__ void rope_table(const Params& p) {
    float2* tab = (float2*)(p.ws + WS_ROPE);
    for (int idx = blockIdx.x * 512 + opq(threadIdx.x); idx < SEQ * 32; idx += gridDim.x * 512) {
        const int t = idx >> 5, i = idx & 31;
        const float inv = exp2f(-(float)i * 0.41524101186092029f);
        const float angf = (float)t * inv;
        const double ang = (double)angf;
        const double q = rint(ang * 0.6366197723675814);
        const double f = fma(-q, 1.5707963267948966, ang), f2 = f * f;
        const double s = f * (1.0 + f2 * (-1.0 / 6 + f2 * (1.0 / 120 + f2 * (-1.0 / 5040 + f2 * (1.0 / 362880 + f2 * (-1.0 / 39916800))))));
        const double c = 1.0 + f2 * (-0.5 + f2 * (1.0 / 24 + f2 * (-1.0 / 720 + f2 * (1.0 / 40320 + f2 * (-1.0 / 3628800 + f2 * (1.0 / 479001600))))));
        const int qi = ((int)q) & 3;
        const double sn = (qi == 0) ? s : (qi == 1) ? c : (qi == 2) ? -s : -c;
        const double cs = (qi == 0) ? c : (qi == 1) ? -s : (qi == 2) ? -c : s;
        tab[idx] = make_float2((float)cs, (float)sn);
    }
}

__device__ __forceinline__ void norm_rows(const float* x, const float* g, bf16_t* h) {
    const int tid_ = opq(threadIdx.x); const int lane = tid_ & 63, wv = tid_ >> 6;
    for (int row = blockIdx.x * 8 + wv; row < MTOK; row += gridDim.x * 8) {
        const float* xr = x + (size_t)row * D; f32x4 v[8]; float ss = 0.f;
#pragma unroll
        for (int i = 0; i < 8; ++i) { v[i] = *(const f32x4*)(xr + i * 256 + lane * 4); ss += v[i][0] * v[i][0] + v[i][1] * v[i][1] + v[i][2] * v[i][2] + v[i][3] * v[i][3]; }
        ss = wave_sum(ss); const float r = rsqrtf(ss * (1.0f / D) + 1e-6f);
#pragma unroll
        for (int i = 0; i < 8; ++i) { const f32x4 gg = *(const f32x4*)(g + i * 256 + lane * 4);
            uint2 w; w.x = cvt_pk_bf16(v[i][0] * r * gg[0], v[i][1] * r * gg[1]); w.y = cvt_pk_bf16(v[i][2] * r * gg[2], v[i][3] * r * gg[3]);
            *(uint2*)(h + (size_t)row * D + i * 256 + lane * 4) = w; }
    }
}

__device__ __forceinline__ void mix_rows(const float* x, const float* g, const float* mixw, bf16_t* mixbase, int tok0) {
    const int tid_ = opq(threadIdx.x); const int lane = tid_ & 63, wv = tid_ >> 6;
    for (int rl = blockIdx.x * 8 + wv; rl < 8192; rl += gridDim.x * 8) {
        const int tok = tok0 + rl; const bool hasprev = (tok & (SEQ - 1)) != 0;
        const float* xr = x + (size_t)tok * D; f32x4 v[8], pv[8]; float ss = 0.f, sp = 0.f;
#pragma unroll
        for (int i = 0; i < 8; ++i) { v[i] = *(const f32x4*)(xr + i * 256 + lane * 4); ss += v[i][0] * v[i][0] + v[i][1] * v[i][1] + v[i][2] * v[i][2] + v[i][3] * v[i][3];
            pv[i] = hasprev ? *(const f32x4*)(xr - D + i * 256 + lane * 4) : (f32x4){0.f, 0.f, 0.f, 0.f}; sp += pv[i][0] * pv[i][0] + pv[i][1] * pv[i][1] + pv[i][2] * pv[i][2] + pv[i][3] * pv[i][3]; }
        ss = wave_sum(ss); sp = wave_sum(sp);
        const float r = rsqrtf(ss * (1.0f / D) + 1e-6f), rp = hasprev ? rsqrtf(sp * (1.0f / D) + 1e-6f) : 0.f;
#pragma unroll
        for (int i = 0; i < 8; ++i) { const int col = i * 256 + lane * 4; const f32x4 gg = *(const f32x4*)(g + col);
            f32x4 hn, xx;
#pragma unroll
            for (int e = 0; e < 4; ++e) { hn[e] = v[i][e] * r * gg[e]; xx[e] = pv[i][e] * rp * gg[e] - hn[e]; }
#pragma unroll
            for (int m = 0; m < 6; ++m) { const f32x4 mw = *(const f32x4*)(mixw + m * D + col);
                uint2 w; w.x = cvt_pk_bf16(hn[0] + xx[0] * mw[0], hn[1] + xx[1] * mw[1]); w.y = cvt_pk_bf16(hn[2] + xx[2] * mw[2], hn[3] + xx[3] * mw[3]);
                *(uint2*)(mixbase + (size_t)m * 8192 * D + (size_t)rl * D + col) = w; } }
    }
}

__device__ __forceinline__ void conv_ssd(const Params& p) {
    const bf16_t* proj = (const bf16_t*)(p.ws + WS_PROJ); bf16_t* xbc = (bf16_t*)(p.ws + WS_XBC);
    const float* cw = p.in[6]; const float* cb = p.in[7];
    for (int idx = blockIdx.x * 512 + opq(threadIdx.x); idx < MTOK * 192; idx += gridDim.x * 512) {
        const int tok = idx / 192, c8 = idx - tok * 192, tpos = tok & (SEQ - 1), c = c8 * 8;
        float acc[8];
        { const f32x4 b0 = *(const f32x4*)(cb + c), b1 = *(const f32x4*)(cb + c + 4);
#pragma unroll
          for (int e = 0; e < 4; ++e) { acc[e] = b0[e]; acc[4 + e] = b1[e]; } }
#pragma unroll
        for (int j = 0; j < 4; ++j) { if (tpos - 3 + j >= 0) {
            const uint4 r = *(const uint4*)(proj + (size_t)(tok - 3 + j) * INWP + COL_XBC + c); float f[8]; unpack8(r, f);
            const f32x4 w0 = *(const f32x4*)(cw + j * 1536 + c), w1 = *(const f32x4*)(cw + j * 1536 + c + 4);
#pragma unroll
            for (int e = 0; e < 4; ++e) { acc[e] += w0[e] * f[e]; acc[4 + e] += w1[e] * f[4 + e]; } } }
#pragma unroll
        for (int e = 0; e < 8; ++e) acc[e] = acc[e] * sigmoidf_(acc[e]);
        u32x4 w; w.x = cvt_pk_bf16(acc[0], acc[1]); w.y = cvt_pk_bf16(acc[2], acc[3]); w.z = cvt_pk_bf16(acc[4], acc[5]); w.w = cvt_pk_bf16(acc[6], acc[7]);
        *(u32x4*)(xbc + (size_t)tok * 1536 + c) = w;
    }
    float* dt = (float*)(p.ws + WS_DT); float* da = (float*)(p.ws + WS_DA);
    for (int idx = blockIdx.x * 512 + opq(threadIdx.x); idx < MTOK * 16; idx += gridDim.x * 512) {
        const int tok = idx >> 4, hh = idx & 15;
        const float v = bf2f(proj[(size_t)tok * INWP + COL_DT + hh]) + p.in[8][hh];
        const float d = v > 20.f ? v : log1pf(expf(v));
        dt[idx] = d; da[idx] = expf(-d * expf(p.in[9][hh]));
    }
}

__device__ __forceinline__ void ssd_scan_job(const Params& p, int job, LAS unsigned char* lds) {
    const int tid = opq(threadIdx.x);
    const int b = job >> 5, hs = (job >> 1) & 15, half = job & 1, grp = hs >> 3, p0 = half * 32;
    const bf16_t* xbc = (const bf16_t*)(p.ws + WS_XBC) + (size_t)b * SEQ * 1536;
    const float* dtp = (const float*)(p.ws + WS_DT) + (size_t)b * SEQ * 16 + hs;
    const float* dap = (const float*)(p.ws + WS_DA) + (size_t)b * SEQ * 16 + hs;
    float* yraw = (float*)(p.ws + WS_YRAW) + (size_t)b * SEQ * 1024 + hs * 64 + p0;
    const float dskip = p.in[10][hs];
    constexpr int BUF_F = 9280;
    LAS float* L = (LAS float*)lds;
    int grow[3], gcol[3], loff[3];
#pragma unroll
    for (int k = 0; k < 3; ++k) { const int q = tid + k * 512, row = q / 36, pc = q - row * 36; grow[k] = row;
        if (pc < 4) { gcol[k] = hs * 64 + p0 + pc * 8; loff[k] = row * 32 + pc * 8; }
        else if (pc < 20) { gcol[k] = 1024 + grp * 128 + (pc - 4) * 8; loff[k] = 1024 + row * 128 + (pc - 4) * 8; }
        else { gcol[k] = 1280 + grp * 128 + (pc - 20) * 8; loff[k] = 5120 + row * 128 + (pc - 20) * 8; } }
    uint4 rg[3]; float sc = 0.f;
#define SSD_ISSUE(t0) do { _Pragma("unroll") for (int k = 0; k < 3; ++k) if (tid + k * 512 < 1152) rg[k] = *(const uint4*)(xbc + (size_t)((t0) + grow[k]) * 1536 + gcol[k]); \
        if (tid < 32) sc = dtp[((t0) + tid) * 16]; else if (tid < 64) sc = dap[((t0) + tid - 32) * 16]; } while (0)
#define SSD_COMMIT(buf) do { LAS float* Lc = L + (buf) * BUF_F; _Pragma("unroll") for (int k = 0; k < 3; ++k) if (tid + k * 512 < 1152) { float f[8]; unpack8(rg[k], f); \
            *(LAS f32x4*)(Lc + loff[k]) = (f32x4){f[0], f[1], f[2], f[3]}; *(LAS f32x4*)(Lc + loff[k] + 4) = (f32x4){f[4], f[5], f[6], f[7]}; } \
        if (tid < 32) Lc[9216 + tid] = sc; else if (tid < 64) Lc[9248 + tid - 32] = sc; } while (0)
    float h[8];
#pragma unroll
    for (int i = 0; i < 8; ++i) h[i] = 0.f;
    const int prow = tid >> 4, nseg = tid & 15;
    __syncthreads();
    SSD_ISSUE(0); SSD_COMMIT(0); __syncthreads();
    for (int ch = 0; ch < 64; ++ch) {
        const int cur = ch & 1;
        if (ch + 1 < 64) SSD_ISSUE((ch + 1) * 32);
        LAS float* Lb = L + cur * BUF_F; LAS float* yb = L + 2 * BUF_F + cur * 1024;
#pragma unroll 4
        for (int t = 0; t < 32; ++t) {
            const float dA = Lb[9248 + t], xv = Lb[t * 32 + prow], xdt = xv * Lb[9216 + t];
            const f32x4 b0 = *(LAS f32x4*)(Lb + 1024 + t * 128 + nseg * 8), b1 = *(LAS f32x4*)(Lb + 1024 + t * 128 + nseg * 8 + 4);
            const f32x4 c0 = *(LAS f32x4*)(Lb + 5120 + t * 128 + nseg * 8), c1 = *(LAS f32x4*)(Lb + 5120 + t * 128 + nseg * 8 + 4);
            float yp = 0.f;
#pragma unroll
            for (int i = 0; i < 4; ++i) { h[i] = h[i] * dA + xdt * b0[i]; h[4 + i] = h[4 + i] * dA + xdt * b1[i]; yp += h[i] * c0[i]; yp += h[4 + i] * c1[i]; }
            yp = red16(yp);
            if (nseg == 0) yb[t * 32 + prow] = yp + dskip * xv;
        }
        if (ch + 1 < 64) SSD_COMMIT(cur ^ 1);
        __syncthreads();
        if (tid < 256) { const f32x4 v = *(LAS f32x4*)(yb + (tid >> 3) * 32 + (tid & 7) * 4); *(f32x4*)(yraw + (size_t)(ch * 32 + (tid >> 3)) * 1024 + (tid & 7) * 4) = v; }
    }
#undef SSD_ISSUE
#undef SSD_COMMIT
}
__device__ __forceinline__ void attn_job(const Params& p, int job, LAS unsigned char* lds) {
    const int tid = opq(threadIdx.x), lane = tid & 63, w = tid >> 6, fr = lane & 15, fq = lane >> 4;
    const int b = job >> 8, hq = (job >> 4) & 15, nb = job & 15, kvh = hq >> 2;
    const bf16_t* proj = (const bf16_t*)(p.ws + WS_PROJ) + (size_t)b * SEQ * INWP;
    const float2* rope = (const float2*)(p.ws + WS_ROPE);
    LAS bf16_t* Ks = (LAS bf16_t*)lds;
    LAS bf16_t* Vt = (LAS bf16_t*)(lds + 36864);
    LAS bf16_t* Ps = (LAS bf16_t*)(lds + 70656) + w * 16 * 264;
    __syncthreads();
    if (tid < 256) {
        const int kr = tid, tk = (nb - 1) * 128 + kr;
        if (tk >= 0) {
            const bf16_t* src = proj + (size_t)tk * INWP + COL_K + kvh * 64; float x[64]; float ss = 0.f;
#pragma unroll
            for (int c = 0; c < 8; ++c) { const uint4 r = *(const uint4*)(src + c * 8); float f[8]; unpack8(r, f);
#pragma unroll
                for (int e = 0; e < 8; ++e) { x[c * 8 + e] = f[e]; ss += f[e] * f[e]; } }
            const float rinv = rsqrtf(ss * (1.0f / 64) + 1e-6f); const float* kn = p.in[13];
#pragma unroll
            for (int i = 0; i < 64; ++i) x[i] = x[i] * rinv * kn[i];
#pragma unroll
            for (int c = 0; c < 4; ++c) { float o1[8], o2[8];
#pragma unroll
                for (int e = 0; e < 8; ++e) { const int i = c * 8 + e; const float2 cs = rope[tk * 32 + i]; o1[e] = x[i] * cs.x - x[i + 32] * cs.y; o2[e] = x[i + 32] * cs.x + x[i] * cs.y; }
                u32x4 w1, w2; w1.x = cvt_pk_bf16(o1[0], o1[1]); w1.y = cvt_pk_bf16(o1[2], o1[3]); w1.z = cvt_pk_bf16(o1[4], o1[5]); w1.w = cvt_pk_bf16(o1[6], o1[7]);
                w2.x = cvt_pk_bf16(o2[0], o2[1]); w2.y = cvt_pk_bf16(o2[2], o2[3]); w2.z = cvt_pk_bf16(o2[4], o2[5]); w2.w = cvt_pk_bf16(o2[6], o2[7]);
                *(LAS u32x4*)(Ks + kr * 72 + c * 8) = w1; *(LAS u32x4*)(Ks + kr * 72 + 32 + c * 8) = w2; }
        } else {
#pragma unroll
            for (int c = 0; c < 8; ++c) *(LAS u32x4*)(Ks + kr * 72 + c * 8) = (u32x4){0u, 0u, 0u, 0u};
        }
    } else {
        const int kr = tid - 256, tk = (nb - 1) * 128 + kr;
        const bf16_t* src = proj + (size_t)(tk < 0 ? 0 : tk) * INWP + COL_V + kvh * 64;
#pragma unroll
        for (int c = 0; c < 8; ++c) { uint4 r = *(const uint4*)(src + c * 8); if (tk < 0) r = make_uint4(0u, 0u, 0u, 0u);
            Vt[(c * 8 + 0) * 264 + kr] = (bf16_t)(r.x & 0xffffu); Vt[(c * 8 + 1) * 264 + kr] = (bf16_t)(r.x >> 16);
            Vt[(c * 8 + 2) * 264 + kr] = (bf16_t)(r.y & 0xffffu); Vt[(c * 8 + 3) * 264 + kr] = (bf16_t)(r.y >> 16);
            Vt[(c * 8 + 4) * 264 + kr] = (bf16_t)(r.z & 0xffffu); Vt[(c * 8 + 5) * 264 + kr] = (bf16_t)(r.z >> 16);
            Vt[(c * 8 + 6) * 264 + kr] = (bf16_t)(r.w & 0xffffu); Vt[(c * 8 + 7) * 264 + kr] = (bf16_t)(r.w >> 16); }
    }
    bf16x8 qa[2];
    { const int tq = nb * 128 + w * 16 + fr; const bf16_t* src = proj + (size_t)tq * INWP + hq * 64;
      const uint4 r0 = *(const uint4*)(src + fq * 8), r1 = *(const uint4*)(src + 32 + fq * 8); float x1[8], x2[8]; unpack8(r0, x1); unpack8(r1, x2);
      float ss = 0.f;
#pragma unroll
      for (int e = 0; e < 8; ++e) ss += x1[e] * x1[e] + x2[e] * x2[e];
      ss += __shfl_xor(ss, 16); ss += __shfl_xor(ss, 32);
      const float rinv = rsqrtf(ss * (1.0f / 64) + 1e-6f) * 0.125f; const float* qn = p.in[12]; float o1[8], o2[8];
#pragma unroll
      for (int e = 0; e < 8; ++e) { const int i = fq * 8 + e; const float a = x1[e] * rinv * qn[i], c = x2[e] * rinv * qn[i + 32]; const float2 cs = rope[tq * 32 + i];
          o1[e] = a * cs.x - c * cs.y; o2[e] = c * cs.x + a * cs.y; }
      u32x4 w1, w2; w1.x = cvt_pk_bf16(o1[0], o1[1]); w1.y = cvt_pk_bf16(o1[2], o1[3]); w1.z = cvt_pk_bf16(o1[4], o1[5]); w1.w = cvt_pk_bf16(o1[6], o1[7]);
      w2.x = cvt_pk_bf16(o2[0], o2[1]); w2.y = cvt_pk_bf16(o2[2], o2[3]); w2.z = cvt_pk_bf16(o2[4], o2[5]); w2.w = cvt_pk_bf16(o2[6], o2[7]);
      qa[0] = __builtin_bit_cast(bf16x8, w1); qa[1] = __builtin_bit_cast(bf16x8, w2); }
    __syncthreads();
    f32x4 s[16];
#pragma unroll
    for (int j = 0; j < 16; ++j) { f32x4 acc = (f32x4){0.f, 0.f, 0.f, 0.f};
#pragma unroll
        for (int ks = 0; ks < 2; ++ks) { const bf16x8 kb = *(LAS bf16x8*)(Ks + (j * 16 + fr) * 72 + ks * 32 + fq * 8); acc = __builtin_amdgcn_mfma_f32_16x16x32_bf16(qa[ks], kb, acc, 0, 0, 0); }
        s[j] = acc; }
    const float sink = p.in[14][hq];
    float mx[4], inv[4];
#pragma unroll
    for (int i = 0; i < 4; ++i) { const int qi = w * 16 + fq * 4 + i + 128; float m = -3.0e38f;
#pragma unroll
        for (int j = 0; j < 16; ++j) { const int kj = j * 16 + fr; const bool ok = (kj <= qi) && (qi - kj < 128) && (nb > 0 || kj >= 128); s[j][i] = ok ? s[j][i] : -3.0e38f; m = fmaxf(m, s[j][i]); }
        m = fmaxf(m, __shfl_xor(m, 1)); m = fmaxf(m, __shfl_xor(m, 2)); m = fmaxf(m, __shfl_xor(m, 4)); m = fmaxf(m, __shfl_xor(m, 8));
        m = fmaxf(m, sink); mx[i] = m; float l = 0.f;
#pragma unroll
        for (int j = 0; j < 16; ++j) { const float e = (s[j][i] > -1.0e38f) ? __expf(s[j][i] - m) : 0.f; s[j][i] = e; l += e; }
        l += __shfl_xor(l, 1); l += __shfl_xor(l, 2); l += __shfl_xor(l, 4); l += __shfl_xor(l, 8);
        inv[i] = 1.0f / (l + __expf(sink - m)); }
#pragma unroll
    for (int j = 0; j < 16; ++j)
#pragma unroll
        for (int i = 0; i < 4; ++i) Ps[(fq * 4 + i) * 264 + j * 16 + fr] = f2bf(s[j][i] * inv[i]);
    f32x4 o[4];
#pragma unroll
    for (int nd = 0; nd < 4; ++nd) o[nd] = (f32x4){0.f, 0.f, 0.f, 0.f};
#pragma unroll
    for (int kk = 0; kk < 8; ++kk) { const bf16x8 pa = *(LAS bf16x8*)(Ps + fr * 264 + kk * 32 + fq * 8);
#pragma unroll
        for (int nd = 0; nd < 4; ++nd) { const bf16x8 vb = *(LAS bf16x8*)(Vt + (nd * 16 + fr) * 264 + kk * 32 + fq * 8); o[nd] = __builtin_amdgcn_mfma_f32_16x16x32_bf16(pa, vb, o[nd], 0, 0, 0); } }
    bf16_t* ymix = (bf16_t*)(p.ws + WS_YMIX) + (size_t)b * SEQ * D + hq * 64;
#pragma unroll
    for (int nd = 0; nd < 4; ++nd)
#pragma unroll
        for (int i = 0; i < 4; ++i) ymix[(size_t)(nb * 128 + w * 16 + fq * 4 + i) * D + nd * 16 + fr] = f2bf(o[nd][i]);
}

__device__ __forceinline__ void post_ssd(const Params& p) {
    const int tid_ = opq(threadIdx.x); const int lane = tid_ & 63, wv = tid_ >> 6;
    const float* yraw = (const float*)(p.ws + WS_YRAW); const bf16_t* proj = (const bf16_t*)(p.ws + WS_PROJ); bf16_t* ymix = (bf16_t*)(p.ws + WS_YMIX);
    for (int it = blockIdx.x * 8 + wv; it < MTOK * 2; it += gridDim.x * 8) {
        const int tok = it >> 1, grp = it & 1, c = grp * 512 + lane * 8;
        const f32x4 y0 = *(const f32x4*)(yraw + (size_t)tok * 1024 + c), y1 = *(const f32x4*)(yraw + (size_t)tok * 1024 + c + 4);
        const uint4 zr = *(const uint4*)(proj + (size_t)tok * INWP + COL_Z + c); float z[8], y[8]; unpack8(zr, z); float ss = 0.f;
#pragma unroll
        for (int e = 0; e < 8; ++e) { const float yy = (e < 4 ? y0[e] : y1[e - 4]); y[e] = yy * z[e] * sigmoidf_(z[e]); ss += y[e] * y[e]; }
        ss = wave_sum(ss); const float r = rsqrtf(ss * (1.0f / 512) + 1e-6f);
        const f32x4 n0 = *(const f32x4*)(p.in[11] + c), n1 = *(const f32x4*)(p.in[11] + c + 4);
        u32x4 w; w.x = cvt_pk_bf16(y[0] * r * n0[0], y[1] * r * n0[1]); w.y = cvt_pk_bf16(y[2] * r * n0[2], y[3] * r * n0[3]);
        w.z = cvt_pk_bf16(y[4] * r * n1[0], y[5] * r * n1[1]); w.w = cvt_pk_bf16(y[6] * r * n1[2], y[7] * r * n1[3]);
        *(u32x4*)(ymix + (size_t)tok * D + 1024 + c) = w;
    }
}

__device__ __forceinline__ void rwkv_scan_job(const Params& p, int job, LAS unsigned char* lds) {
    const int tid = opq(threadIdx.x), lane = tid & 63, wv = tid >> 6;
    const int b = job >> 5, hh = job & 31;
    const size_t base = (size_t)b * SEQ * D + hh * 64 + lane;
    bf16_t* Rb = (bf16_t*)(p.ws + WS_R) + base; const bf16_t* Kb = (const bf16_t*)(p.ws + WS_K) + base; const bf16_t* Vb = (const bf16_t*)(p.ws + WS_V) + base;
    const bf16_t* Eb = (const bf16_t*)(p.ws + WS_WDEC) + base; const bf16_t* Ab = (const bf16_t*)(p.ws + WS_AA) + base; const bf16_t* Gb = (const bf16_t*)(p.ws + WS_GG) + base;
    const int ci = hh * 64 + lane;
    const float kkw = p.in[25][ci], kaw = p.in[26][ci], rkw = p.in[27][ci], lnw = p.in[32][ci], lnb = p.in[33][ci];
    LAS float* L = (LAS float*)lds;
    unsigned short rr[2], kr[2], vr[2], er[2], ar[2], gr[2];
#define RW_ISSUE(t0) do { _Pragma("unroll") for (int s2 = 0; s2 < 2; ++s2) { const size_t off = (size_t)((t0) + wv + s2 * 8) * D; \
        rr[s2] = Rb[off]; kr[s2] = Kb[off]; vr[s2] = Vb[off]; er[s2] = Eb[off]; ar[s2] = Ab[off]; gr[s2] = Gb[off]; } } while (0)
#define RW_COMMIT(buf) do { LAS float* Lc = L + (buf) * 8192; _Pragma("unroll") for (int s2 = 0; s2 < 2; ++s2) { const int o = (wv + s2 * 8) * 64 + lane; \
        const float r_ = bf2f(rr[s2]), k_ = bf2f(kr[s2]), v_ = bf2f(vr[s2]), e_ = bf2f(er[s2]), a_ = bf2f(ar[s2]), g_ = bf2f(gr[s2]); \
        const float kkv = k_ * kkw; const float ssq = wave_sum(kkv * kkv); const float kkn = kkv * rsqrtf(fmaxf(ssq, 1e-24f)); \
        const float kmod = k_ * (1.0f + (a_ - 1.0f) * kaw); const float bonus = wave_sum(r_ * kmod * rkw); \
        Lc[o] = -kkn; Lc[1024 + o] = __expf(-e_); Lc[2048 + o] = kkn * a_; Lc[3072 + o] = kmod; Lc[4096 + o] = r_; Lc[5120 + o] = v_; Lc[6144 + o] = g_; Lc[7168 + o] = bonus * v_; } } while (0)
    float S[8];
#pragma unroll
    for (int i = 0; i < 8; ++i) S[i] = 0.f;
    const int vrow = tid >> 3, ks = tid & 7;
    __syncthreads();
    RW_ISSUE(0); RW_COMMIT(0); __syncthreads();
    for (int ch = 0; ch < 128; ++ch) {
        const int cur = ch & 1;
        if (ch + 1 < 128) RW_ISSUE((ch + 1) * 16);
        LAS float* Lb = L + cur * 8192; LAS float* yb = L + 16384 + cur * 1024;
#pragma unroll 4
        for (int t = 0; t < 16; ++t) {
            LAS float* q = Lb + t * 64 + ks * 8;
            const f32x4 a0 = *(LAS f32x4*)(q), a1 = *(LAS f32x4*)(q + 4);
            float sa = 0.f;
#pragma unroll
            for (int i = 0; i < 4; ++i) { sa += S[i] * a0[i]; sa += S[4 + i] * a1[i]; }
            sa = red8(sa);
            const f32x4 w0 = *(LAS f32x4*)(q + 1024), w1 = *(LAS f32x4*)(q + 1028), b0 = *(LAS f32x4*)(q + 2048), b1 = *(LAS f32x4*)(q + 2052), k0 = *(LAS f32x4*)(q + 3072), k1 = *(LAS f32x4*)(q + 3076);
            const f32x4 r0 = *(LAS f32x4*)(q + 4096), r1 = *(LAS f32x4*)(q + 4100);
            const float vv = Lb[5120 + t * 64 + vrow];
            float y = 0.f;
#pragma unroll
            for (int i = 0; i < 4; ++i) { S[i] = S[i] * w0[i] + sa * b0[i] + vv * k0[i]; S[4 + i] = S[4 + i] * w1[i] + sa * b1[i] + vv * k1[i]; y += S[i] * r0[i]; y += S[4 + i] * r1[i]; }
            y = red8(y);
            if (ks == 0) yb[t * 64 + vrow] = y;
        }
        if (ch + 1 < 128) RW_COMMIT(cur ^ 1);
        __syncthreads();
#pragma unroll
        for (int s2 = 0; s2 < 2; ++s2) { const int t = wv + s2 * 8, o = t * 64 + lane; const float y = yb[o];
            const float mu = wave_sum(y) * (1.0f / 64), d = y - mu, var = wave_sum(d * d) * (1.0f / 64);
            const float yn = d * rsqrtf(var + 64e-5f) * lnw + lnb;
            Rb[(size_t)(ch * 16 + t) * D] = f2bf((yn + Lb[7168 + o]) * Lb[6144 + o]); }
    }
#undef RW_ISSUE
#undef RW_COMMIT
}

__global__ __launch_bounds__(512, 2) void mega(const Params p_arg) {
    extern __shared__ __attribute__((aligned(16))) unsigned char shm[];
    const Params& p = *(const Params*)(const void*)__builtin_amdgcn_kernarg_segment_ptr();
    LAS unsigned char* lds = (LAS unsigned char*)shm;
    const int G = (int)gridDim.x, bid = (int)blockIdx.x;
    for (int s = p.step_lo; s < p.step_hi; ++s) {
        const int kind = p.kind[s], lo = p.lo[s], hi = p.hi[s];
        switch (kind) {
            case K_PRE0:
#ifndef NO_PRE
 convert_tiles(p, lo, hi, lds); rope_table(p); norm_rows(p.in[0], p.in[1], (bf16_t*)(p.ws + WS_H));
#endif
 break;
            case K_GEMMB:
#ifndef NO_GB

                for (int i = lo; i < hi; ++i) { const GemmOp& o = p.g[i]; pg8::Gemm g; g.A = o.A; g.Bt = o.Bt; g.M = o.M; g.N = o.N; g.K = o.K;
                    pg8::StaticOrder S; S.init(o.M, o.N, G, (bid + G - (o.rot % G)) % G);
                    EpiB E; E.O = (bf16_t*)o.out; E.ldc = o.ldc; E.bias = o.bias; E.act = o.act;
                    pg8::gemm_phase<EpiB, pg8::StaticOrder, false>(lds, g, S, E, nullptr); }
#endif
                break;
            case K_GEMMF:
#ifndef NO_GF

                for (int i = lo; i < hi; ++i) { const GemmOp& o = p.g[i]; pg8::Gemm g; g.A = o.A; g.Bt = o.Bt; g.M = o.M; g.N = o.N; g.K = o.K;
                    pg8::StaticOrder S; S.init(o.M, o.N, G, (bid + G - (o.rot % G)) % G);
                    EpiF E; E.C = (float*)o.out; E.ldc = o.ldc; E.res = o.res;
                    pg8::gemm_phase<EpiF, pg8::StaticOrder, false>(lds, g, S, E, nullptr); }
#endif
                break;
            case K_CONVSSD:
#ifndef NO_CONV
 conv_ssd(p);
#endif
 break;
            case K_MIX0:

#ifndef NO_SSD
for (int j = bid; j < 256; j += G) ssd_scan_job(p, j, lds);
#endif


#ifndef NO_ATT
for (int j = bid; j < 2048; j += G) attn_job(p, j, lds);
#endif

                break;
            case K_POST0: post_ssd(p); break;
            case K_NORM: norm_rows(p.out, p.in[2] + lo * D, (bf16_t*)(p.ws + WS_H)); break;
            case K_PRE1: convert_tiles(p, lo, hi, lds); mix_rows(p.out, p.in[1] + D, p.in[16], (bf16_t*)(p.ws + WS_MIX), 0); break;
            case K_MIXES: mix_rows(p.out, p.in[1] + D, p.in[16], (bf16_t*)(p.ws + WS_MIX), 8192); break;
            case K_RWKV:
#ifndef NO_RWKV
 for (int j = bid; j < 256; j += G) rwkv_scan_job(p, j, lds);
#endif
 break;
            case K_NORMCONV: convert_tiles(p, lo, hi, lds); norm_rows(p.out, p.in[2] + D, (bf16_t*)(p.ws + WS_H)); break;
            default: break;
        }
        if (s + 1 < p.step_hi) cg::this_grid().sync();
    }
}

#ifndef MK_MULTI
#define MK_MULTI 0
#endif
extern "C" void kernel_launch(void* const* d_in, const int* in_sizes, int n_in, void* d_out, int out_size, void* d_ws, size_t ws_size, hipStream_t stream) {
    static int grid = 0;
    if (grid == 0) {
        int dev = 0, cus = 0, per_cu = 0;
        hipGetDevice(&dev); hipDeviceGetAttribute(&cus, hipDeviceAttributeMultiprocessorCount, dev);
        if (hipFuncSetAttribute((const void*)mega, hipFuncAttributeMaxDynamicSharedMemorySize, LDS_BYTES) != hipSuccess) { fprintf(stderr, "hipFuncSetAttribute failed\n"); grid = -1; return; }
        if (hipOccupancyMaxActiveBlocksPerMultiprocessor(&per_cu, (const void*)mega, 512, LDS_BYTES) != hipSuccess || per_cu < 1) { fprintf(stderr, "occupancy query: %d\n", per_cu); per_cu = 1; }
        (void)hipGetLastError();
        grid = cus * per_cu; if (grid > 256) grid = 256;
        if (n_in != 34 || ws_size < 484 * MiB) { fprintf(stderr, "unexpected n_in %d / ws %zu\n", n_in, ws_size); grid = -1; return; }
    }
    if (grid < 0) return;
    static Params p;
    memset(&p, 0, sizeof(p));
    for (int i = 0; i < 34; ++i) p.in[i] = (const float*)d_in[i];
    p.out = (float*)d_out; p.ws = (unsigned char*)d_ws;
    unsigned char* ws = (unsigned char*)d_ws;
    auto B16 = [&](size_t off) { return (bf16_t*)(ws + off); };
    int ncj = 0, tile_acc = 0;
    auto CJ = [&](const float* src, size_t dst_off, int K, int N, int Kpad, int Npad) { ConvJob& c = p.cj[ncj++]; c.src = src; c.dst = B16(dst_off); c.K = K; c.N = N; c.Kpad = Kpad; c.Npad = Npad; c.tile0 = tile_acc; c.ntiles = (Kpad / 64) * (Npad / 64); tile_acc += c.ntiles; };
    const float* w_up = p.in[3]; const float* w_down = p.in[4];
    tile_acc = 0;
    CJ(p.in[5], WS_WBA, 2048, 4112, 2048, 4352); CJ(p.in[15], WS_WBA + 17 * MiB, 2048, 2048, 2048, 2048);
    CJ(w_up, WS_WMLP, 2048, 8192, 2048, 8192); CJ(w_down, WS_WMLP + 32 * MiB, 8192, 2048, 8192, 2048);
    tile_acc = 0;
    CJ(p.in[28], WS_WBA, 2048, 2048, 2048, 2048); CJ(p.in[29], WS_WBA + 8 * MiB, 2048, 2048, 2048, 2048); CJ(p.in[30], WS_WBA + 16 * MiB, 2048, 2048, 2048, 2048); CJ(p.in[31], WS_WBA + 24 * MiB, 2048, 2048, 2048, 2048);
    CJ(p.in[18], WS_WBA + 32 * MiB, 2048, 96, 2048, 256); CJ(p.in[21], WS_WBA + 33 * MiB, 2048, 96, 2048, 256); CJ(p.in[23], WS_WBA + 34 * MiB, 2048, 256, 2048, 256);
    CJ(p.in[19], WS_WBA + 35 * MiB, 96, 2048, 256, 2048); CJ(p.in[22], WS_WBA + 36 * MiB, 96, 2048, 256, 2048); CJ(p.in[24], WS_WBA + 37 * MiB, 256, 2048, 256, 2048);
    tile_acc = 0;
    CJ(w_up + (size_t)2048 * 8192, WS_WMLP, 2048, 8192, 2048, 8192); CJ(w_down + (size_t)2048 * 8192, WS_WMLP + 32 * MiB, 8192, 2048, 8192, 2048);
    int nop = 0;
    auto GO = [&](const bf16_t* A, const bf16_t* Bt, void* out, const float* bias, const float* res, int M, int N, int K, int ldc, int act, int rot) {
        GemmOp& o = p.g[nop++]; o.A = A; o.Bt = Bt; o.out = out; o.bias = bias; o.res = res; o.M = M; o.N = N; o.K = K; o.ldc = ldc; o.act = act; o.rot = rot; };
    GO(B16(WS_H), B16(WS_WBA), B16(WS_PROJ), nullptr, nullptr, MTOK, INWP, 2048, INWP, 0, 0);
    GO(B16(WS_YMIX), B16(WS_WBA + 17 * MiB), d_out, nullptr, p.in[0], MTOK, 2048, 2048, 2048, 0, 0);
    GO(B16(WS_H), B16(WS_WMLP), B16(WS_U), nullptr, nullptr, MTOK, DFF, 2048, DFF, 1, 0);
    GO(B16(WS_U), B16(WS_WMLP + 32 * MiB), d_out, nullptr, (const float*)d_out, MTOK, 2048, DFF, 2048, 0, 0);
    for (int half = 0; half < 2; ++half) {
        const size_t ro = (size_t)half * 8192 * 2048 * 2, lo_ = (size_t)half * 8192 * 256 * 2; const size_t mb = (size_t)8192 * 2048 * 2;
        GO(B16(WS_MIX + 0 * mb), B16(WS_WBA), B16(WS_R + ro), nullptr, nullptr, 8192, 2048, 2048, 2048, 0, 0);
        GO(B16(WS_MIX + 2 * mb), B16(WS_WBA + 8 * MiB), B16(WS_K + ro), nullptr, nullptr, 8192, 2048, 2048, 2048, 0, 0);
        GO(B16(WS_MIX + 3 * mb), B16(WS_WBA + 16 * MiB), B16(WS_V + ro), nullptr, nullptr, 8192, 2048, 2048, 2048, 0, 0);
        GO(B16(WS_MIX + 1 * mb), B16(WS_WBA + 32 * MiB), B16(WS_L1W + lo_), nullptr, nullptr, 8192, 256, 2048, 256, 2, 0);
        GO(B16(WS_MIX + 4 * mb), B16(WS_WBA + 33 * MiB), B16(WS_L1A + lo_), nullptr, nullptr, 8192, 256, 2048, 256, 0, 32);
        GO(B16(WS_MIX + 5 * mb), B16(WS_WBA + 34 * MiB), B16(WS_L1G + lo_), nullptr, nullptr, 8192, 256, 2048, 256, 3, 64);
    }
    GO(B16(WS_L1W), B16(WS_WBA + 35 * MiB), B16(WS_WDEC), p.in[17], nullptr, MTOK, 2048, 256, 2048, 4, 0);
    GO(B16(WS_L1A), B16(WS_WBA + 36 * MiB), B16(WS_AA), p.in[20], nullptr, MTOK, 2048, 256, 2048, 3, 0);
    GO(B16(WS_L1G), B16(WS_WBA + 37 * MiB), B16(WS_GG), nullptr, nullptr, MTOK, 2048, 256, 2048, 0, 0);
    GO(B16(WS_R), B16(WS_WBA + 24 * MiB), d_out, nullptr, (const float*)d_out, MTOK, 2048, 2048, 2048, 0, 0);
    GO(B16(WS_H), B16(WS_WMLP), B16(WS_U), nullptr, nullptr, MTOK, DFF, 2048, DFF, 1, 0);
    GO(B16(WS_U), B16(WS_WMLP + 32 * MiB), d_out, nullptr, (const float*)d_out, MTOK, 2048, DFF, 2048, 0, 0);
    int ns = 0;
    auto ST = [&](int kind, int lo, int hi) { p.kind[ns] = kind; p.lo[ns] = lo; p.hi[ns] = hi; ++ns; };
    ST(K_PRE0, 0, 4); ST(K_GEMMB, 0, 1); ST(K_CONVSSD, 0, 0); ST(K_MIX0, 0, 0); ST(K_POST0, 0, 0); ST(K_GEMMF, 1, 2); ST(K_NORM, 0, 0); ST(K_GEMMB, 2, 3); ST(K_GEMMF, 3, 4);
    ST(K_PRE1, 4, 14); ST(K_GEMMB, 4, 10); ST(K_MIXES, 0, 0); ST(K_GEMMB, 10, 16); ST(K_GEMMB, 16, 19); ST(K_RWKV, 0, 0); ST(K_GEMMF, 19, 20); ST(K_NORMCONV, 14, 16); ST(K_GEMMB, 20, 21); ST(K_GEMMF, 21, 22);
#if MK_MULTI
    for (int s = 0; s < NSTEPS; ++s) { p.step_lo = s; p.step_hi = s + 1; hipLaunchKernelGGL(mega, dim3(grid), dim3(512), LDS_BYTES, stream, p); }
#else
    p.step_lo = 0; p.step_hi = NSTEPS;
    void* args[] = {(void*)&p};
    const hipError_t e = hipLaunchCooperativeKernel((const void*)mega, dim3(grid), dim3(512), args, LDS_BYTES, stream);
    if (e != hipSuccess) fprintf(stderr, "cooperative launch failed: %s (grid %d)\n", hipGetErrorString(e), grid);
#endif
}
```

```cpp
#include <hip/hip_runtime.h>
#include <hip/hip_cooperative_groups.h>
#include <cstdio>
#include <cstring>
namespace cg = cooperative_groups;
__device__ __forceinline__ int opq(int v) { asm volatile("" : "+v"(v)); return v; }
namespace pg8 {
#define PG8_LAS __attribute__((address_space(3)))
typedef unsigned short bf16_t;
typedef short bf16x8 __attribute__((ext_vector_type(8)));
typedef float f32x4 __attribute__((ext_vector_type(4)));
typedef unsigned u32x4 __attribute__((ext_vector_type(4)));
constexpr int BM = 256, BK = 64, HALF = 128, HTB = HALF * BK * 2  , STAGE_BYTES = 8 * HTB, NXCD = 8, WGM = 8;

__host__ __device__ __forceinline__ int lds_byte(int r, int c) { const int st = (r >> 4) * 2 + (c >> 5), rr = r & 15, cc = c & 31, ob = rr * 64 + cc * 2; return st * 1024 + (ob ^ (((ob >> 9) & 1) << 5)); }
__host__ __device__ __forceinline__ void stage_rc(int b, int& R, int& C) { const int st = b / 1024, sb = b % 1024, swz = sb ^ (((sb >> 9) & 1) << 5); R = (st >> 1) * 16 + swz / 64; C = (st & 1) * 32 + (swz % 64) / 2; }
__host__ __device__ __forceinline__ int perm32(int rho) { const int n = rho >> 4, i = rho & 15; return 8 * (i >> 2) + 4 * n + (i & 3); }

struct Unit { int pm, pn; };
struct Gemm { const bf16_t* A; const bf16_t* Bt; int M, N, K; };

struct StaticOrder {
    int nM, nN, nwg, G, c;
    __host__ __device__ void init(int M, int N, int G_, int c_) { nM = M / BM; nN = N / BM; nwg = nM * nN; G = G_; c = c_; }
    __host__ __device__ bool next(int i, Unit& u) const {
        const long L = (long)i * G + c; if (L >= nwg) return false;
        int wgid = (int)L; { const int q = nwg / NXCD, r = nwg % NXCD, xcd = wgid % NXCD, off = wgid / NXCD; wgid = (xcd < r ? xcd * (q + 1) : r * (q + 1) + (xcd - r) * q) + off; }
        const int nig = WGM * nN, gid = wgid / nig, fm = gid * WGM, gsz = (nM - fm) < WGM ? (nM - fm) : WGM;
        u.pm = fm + ((wgid % nig) % gsz); u.pn = (wgid % nig) / gsz; return true;
    }
    __device__ __forceinline__ void a_ready(const Unit&) const {}
    __device__ __forceinline__ void done(const Unit&) const {}
};
__device__ __forceinline__ unsigned cvt_pk_bf16(float lo, float hi) { unsigned r; asm volatile("v_cvt_pk_bf16_f32 %0, %1, %2" : "=v"(r) : "v"(lo), "v"(hi)); return r; }

template <class Epi, class Sched, bool STAMP = false>
__device__ __forceinline__ void gemm_phase(PG8_LAS unsigned char* lds, const Gemm g, const Sched& S, const Epi& E, unsigned long long* stamps) {
    const int tid = opq(threadIdx.x), wid = __builtin_amdgcn_readfirstlane(tid >> 6), lane = tid & 63, wr = wid >> 2, wc = wid & 3, fr = lane & 15, fq = lane >> 4;
    const int K = g.K, nt = K / BK;
    int ts_lo = 0, ts_hi = 0, nts = 0; const unsigned long long rt_entry = STAMP ? (unsigned long long)wall_clock64() : 0ull;
#define PG8_STAMP() do { if (STAMP && wid == 0 && nts < 64) { const unsigned long long _c = (unsigned long long)clock64(); \
        ts_lo = (lane == nts) ? (int)(unsigned)_c : ts_lo; ts_hi = (lane == nts) ? (int)(unsigned)(_c >> 32) : ts_hi; ++nts; } } while (0)
    PG8_STAMP();
    unsigned voffA[2], voffB[2];
#pragma unroll
    for (int i = 0; i < 2; ++i) { int R, C; stage_rc(tid * 16 + i * 8192, R, C); const int Rb = Epi::PERM ? ((R & ~31) + perm32(R & 31)) : R;
        voffA[i] = (unsigned)(R * K + C) * 2u; voffB[i] = (unsigned)(Rb * K + C) * 2u; }
    const size_t kstep = (size_t)(BK * 2);
    const size_t hstep = (size_t)HALF * K * 2;
    const size_t tstep = 2 * hstep;
    const unsigned ldsw = (unsigned)wid * 1024u;
    const int aoff = lds_byte(wr * 64 + fr, fq * 8), boff = lds_byte(wc * 32 + fr, fq * 8);
#define PG8_SA(b, h) (((b) * 2 + (h)) * HTB)
#define PG8_SB(b, h) ((4 + (b) * 2 + (h)) * HTB)
#define PG8_STAGE(bufoff, gbase, voff) do { _Pragma("unroll") for (int _i = 0; _i < 2; ++_i) \
        __builtin_amdgcn_global_load_lds((const unsigned*)((const char*)(gbase) + (voff)[_i]), (PG8_LAS unsigned*)(lds + (bufoff) + ldsw + _i * 8192), 16, 0, 0); } while (0)
#define PG8_LDA(dst, b, h) do { _Pragma("unroll") for (int m = 0; m < 4; ++m) _Pragma("unroll") for (int k = 0; k < 2; ++k) dst[m][k] = *(const PG8_LAS bf16x8*)(lds + PG8_SA(b, h) + aoff + m * 2048 + k * 1024); } while (0)
#define PG8_LDB(dst, b, h) do { _Pragma("unroll") for (int n = 0; n < 2; ++n) _Pragma("unroll") for (int k = 0; k < 2; ++k) dst[n][k] = *(const PG8_LAS bf16x8*)(lds + PG8_SB(b, h) + boff + n * 2048 + k * 1024); } while (0)
#define PG8_MMA(ai, bj, At, Bt) do { __builtin_amdgcn_s_setprio(1); _Pragma("unroll") for (int m = 0; m < 4; ++m) _Pragma("unroll") for (int n = 0; n < 2; ++n) _Pragma("unroll") for (int k = 0; k < 2; ++k) \
        acc[ai][bj][m][n] = __builtin_amdgcn_mfma_f32_16x16x32_bf16(Bt[n][k], At[m][k], acc[ai][bj][m][n], 0, 0, 0); __builtin_amdgcn_s_setprio(0); } while (0)
#define PG8_WAIT_V(n) asm volatile("s_waitcnt vmcnt(" #n ")" ::: "memory")
#define PG8_WAIT_L(n) asm volatile("s_waitcnt lgkmcnt(" #n ")" ::: "memory")
#define PG8_BAR __builtin_amdgcn_s_barrier()
#define PG8_SCHED __builtin_amdgcn_sched_barrier(0)
    Unit cur, nxt; int ui = 0;
    if (!S.next(0, cur)) return;
    f32x4 acc[2][2][4][2];
#pragma unroll
    for (int a = 0; a < 2; ++a)
#pragma unroll
        for (int b = 0; b < 2; ++b)
#pragma unroll
            for (int m = 0; m < 4; ++m)
#pragma unroll
                for (int n = 0; n < 2; ++n) acc[a][b][m][n] = (f32x4){0.f, 0.f, 0.f, 0.f};
    bf16x8 At[4][2], B0[2][2], B1[2][2];
    const char* cA = (const char*)g.A + (size_t)cur.pm * tstep; const char* cB = (const char*)g.Bt + (size_t)cur.pn * tstep;
    S.a_ready(cur);
    PG8_STAGE(PG8_SB(0, 0), cB, voffB); PG8_STAGE(PG8_SA(0, 0), cA, voffA); PG8_STAGE(PG8_SB(0, 1), cB + hstep, voffB); PG8_STAGE(PG8_SA(0, 1), cA + hstep, voffA);
    if (wr == 1) PG8_BAR;
    PG8_WAIT_V(4); PG8_BAR;
    PG8_STAGE(PG8_SB(1, 0), cB + kstep, voffB); PG8_STAGE(PG8_SA(1, 0), cA + kstep, voffA); PG8_STAGE(PG8_SB(1, 1), cB + hstep + kstep, voffB);
    PG8_WAIT_V(6); PG8_BAR;
    PG8_STAMP();
    for (;;) {
        const bool has_next = S.next(ui + 1, nxt);
        const char* nA = has_next ? (const char*)g.A + (size_t)nxt.pm * tstep : cA; const char* nB = has_next ? (const char*)g.Bt + (size_t)nxt.pn * tstep : cB;
        for (int t = 0; t < nt; t += 2) {
            const bool last = (t == nt - 2);
            const char* a1 = cA + (size_t)(t + 1) * kstep;
            const char* a2 = last ? nA : cA + (size_t)(t + 2) * kstep; const char* b2 = last ? nB : cB + (size_t)(t + 2) * kstep;
            const char* a3 = a2 + kstep; const char* b3 = b2 + kstep;
            if (last && has_next) S.a_ready(nxt);
            PG8_LDB(B0, 0, 0); PG8_SCHED; PG8_LDA(At, 0, 0); PG8_STAGE(PG8_SA(1, 1), a1 + hstep, voffA);
            PG8_WAIT_L(8); PG8_BAR; PG8_WAIT_L(0); PG8_MMA(0, 0, At, B0); PG8_BAR; PG8_SCHED;
            PG8_LDB(B1, 0, 1); PG8_STAGE(PG8_SB(0, 0), b2, voffB);
            PG8_BAR; PG8_WAIT_L(0); PG8_MMA(0, 1, At, B1); PG8_BAR;
            PG8_LDA(At, 0, 1); PG8_STAGE(PG8_SA(0, 0), a2, voffA);
            PG8_BAR; PG8_WAIT_L(0); PG8_MMA(1, 0, At, B0); PG8_BAR; PG8_SCHED;
            PG8_STAGE(PG8_SB(0, 1), b2 + hstep, voffB);
            PG8_WAIT_V(6); PG8_BAR; PG8_MMA(1, 1, At, B1); PG8_BAR;
            PG8_LDB(B0, 1, 0); PG8_SCHED; PG8_LDA(At, 1, 0); PG8_STAGE(PG8_SA(0, 1), a2 + hstep, voffA);
            PG8_WAIT_L(8); PG8_BAR; PG8_WAIT_L(0); PG8_MMA(0, 0, At, B0); PG8_BAR; PG8_SCHED;
            PG8_LDB(B1, 1, 1); PG8_STAGE(PG8_SB(1, 0), b3, voffB);
            PG8_BAR; PG8_WAIT_L(0); PG8_MMA(0, 1, At, B1); PG8_BAR;
            PG8_LDA(At, 1, 1); PG8_STAGE(PG8_SA(1, 0), a3, voffA);
            PG8_BAR; PG8_WAIT_L(0); PG8_MMA(1, 0, At, B0); PG8_BAR; PG8_SCHED;
            PG8_STAGE(PG8_SB(1, 1), b3 + hstep, voffB);
            PG8_WAIT_V(6); PG8_BAR; PG8_MMA(1, 1, At, B1); PG8_BAR;
        }
        PG8_STAMP();
        if constexpr (!Epi::AFTER_DRAIN) { E(acc, cur, wr, wc, fr, fq); S.done(cur); }
        PG8_STAMP();
        if (!has_next) break;
#pragma unroll
        for (int a = 0; a < 2; ++a)
#pragma unroll
            for (int b = 0; b < 2; ++b)
#pragma unroll
                for (int m = 0; m < 4; ++m)
#pragma unroll
                    for (int n = 0; n < 2; ++n) acc[a][b][m][n] = (f32x4){0.f, 0.f, 0.f, 0.f};
        cur = nxt; cA = nA; cB = nB; ++ui;
    }
    PG8_WAIT_V(0);
    if (wr == 0) PG8_BAR;
    PG8_BAR;
    if constexpr (Epi::AFTER_DRAIN) { E.fused(acc, cur, wr, wc, fr, fq, lds, wid, lane); S.done(cur); }
    PG8_STAMP();
    if (STAMP && wid == 0) { stamps[lane] = lane < nts ? (((unsigned long long)(unsigned)ts_hi << 32) | (unsigned)ts_lo) : 0ull;
        if (lane == 62) stamps[62] = rt_entry; if (lane == 63) stamps[63] = (unsigned long long)wall_clock64(); }
#undef PG8_STAMP
#undef PG8_SA
#undef PG8_SB
#undef PG8_STAGE
#undef PG8_LDA
#undef PG8_LDB
#undef PG8_MMA
#undef PG8_WAIT_V
#undef PG8_WAIT_L
#undef PG8_BAR
#undef PG8_SCHED
}
}

#include <cstdio>
#include <ctime>
#include <cstdlib>
#include <cstring>
#include <cmath>
#include <vector>
#include <algorithm>
#define CK(x) do { hipError_t e_ = (x); if (e_ != hipSuccess) { fprintf(stderr, "HIP %s:%d %s\n", __FILE__, __LINE__, hipGetErrorString(e_)); exit(2); } } while (0)
using pg8::bf16_t; using pg8::bf16x8; using pg8::f32x4; using pg8::u32x4; using pg8::cvt_pk_bf16;
#define LAS PG8_LAS

constexpr int D = 2048, SEQ = 2048, MTOK = 16384, DFF = 8192, INWP = 4352;
constexpr int COL_K = 1024, COL_V = 1280, COL_Z = 1536, COL_XBC = 2560, COL_DT = 4096;
constexpr size_t MiB = (size_t)1 << 20;
constexpr size_t WS_WBA = 0, WS_WMLP = 40 * MiB, WS_H = 104 * MiB, WS_PROJ = 168 * MiB, WS_YMIX = 304 * MiB, WS_YRAW = 368 * MiB, WS_XBC = 432 * MiB,
                 WS_DT = 480 * MiB, WS_DA = 481 * MiB, WS_ROPE = 482 * MiB, WS_U = 168 * MiB;
constexpr size_t WS_R = 40 * MiB, WS_K = 104 * MiB, WS_V = 168 * MiB, WS_L1W = 232 * MiB, WS_L1A = 240 * MiB, WS_L1G = 248 * MiB, WS_MIX = 256 * MiB,
                 WS_WDEC = 256 * MiB, WS_AA = 320 * MiB, WS_GG = 384 * MiB, WS_YG = 448 * MiB;
constexpr int LDS_BYTES = 140 * 1024;

enum { K_PRE0 = 0, K_GEMMB, K_GEMMF, K_CONVSSD, K_MIX0, K_POST0, K_NORM, K_PRE1, K_MIXES, K_RWKV, K_NORMCONV };
constexpr int NSTEPS = 48, NOPS = 22, NCJ = 16;
#define REP_GEMMB 1
#define REP_MIX0 1
#define REP_RWKV 1
#define REP_ELEM 1

struct GemmOp { const bf16_t* A; const bf16_t* Bt; void* out; const float* bias; const float* res; int M, N, K, ldc, act, rot, pad0, pad1; };
struct ConvJob { const float* src; bf16_t* dst; int K, N, Kpad, Npad, tile0, ntiles; };
struct Params {
    const float* in[34];
    float* out; unsigned char* ws;
    GemmOp g[NOPS];
    ConvJob cj[NCJ];
    int kind[NSTEPS + 1]; int lo[NSTEPS + 1]; int hi[NSTEPS + 1];
    int step_lo, step_hi;
};

__device__ __forceinline__ float bf2f(unsigned short b) { return __uint_as_float(((unsigned)b) << 16); }
__device__ __forceinline__ float bflo(unsigned w) { return __uint_as_float(w << 16); }
__device__ __forceinline__ float bfhi(unsigned w) { return __uint_as_float(w & 0xffff0000u); }
__device__ __forceinline__ bf16_t f2bf(float f) { return (bf16_t)(cvt_pk_bf16(f, 0.f) & 0xffffu); }
template <int CTRL> __device__ __forceinline__ float dpp_add(float x) {
    const int y = __builtin_amdgcn_update_dpp(0, __builtin_bit_cast(int, x), CTRL, 0xf, 0xf, true);
    return x + __builtin_bit_cast(float, y); }
__device__ __forceinline__ float red8(float x) { x = dpp_add<0xB1>(x); x = dpp_add<0x4E>(x); x = dpp_add<0x141>(x); return x; }
__device__ __forceinline__ float red16(float x) { x = red8(x); x = dpp_add<0x140>(x); return x; }
__device__ __forceinline__ float wave_sum(float v) {
    v = red16(v);
    const float r0 = __builtin_bit_cast(float, __builtin_amdgcn_readlane(__builtin_bit_cast(int, v), 0)), r1 = __builtin_bit_cast(float, __builtin_amdgcn_readlane(__builtin_bit_cast(int, v), 16));
    const float r2 = __builtin_bit_cast(float, __builtin_amdgcn_readlane(__builtin_bit_cast(int, v), 32)), r3 = __builtin_bit_cast(float, __builtin_amdgcn_readlane(__builtin_bit_cast(int, v), 48));
    return (r0 + r1) + (r2 + r3); }
typedef float f32x2 __attribute__((ext_vector_type(2)));
__device__ __forceinline__ float sigmoidf_(float v) { return 1.0f / (1.0f + __expf(-v)); }
__device__ __forceinline__ void unpack8(const uint4 r, float (&f)[8]) {
    f[0] = bflo(r.x); f[1] = bfhi(r.x); f[2] = bflo(r.y); f[3] = bfhi(r.y); f[4] = bflo(r.z); f[5] = bfhi(r.z); f[6] = bflo(r.w); f[7] = bfhi(r.w); }

__device__ __forceinline__ float act_apply(float v, int act) {
    switch (act) {
        case 1: { const float r = fmaxf(v, 0.f); return r * r; }
        case 2: return 1.0f - 2.0f / (1.0f + __expf(2.0f * v));
        case 3: return sigmoidf_(v);
        case 4: return 0.60653066f * sigmoidf_(v);
        default: return v; }
}
struct EpiB {
    static constexpr bool PERM = true, AFTER_DRAIN = false;
    bf16_t* O; int ldc; const float* bias; int act;
    __device__ __forceinline__ void operator()(const f32x4 (&acc)[2][2][4][2], const pg8::Unit& u, int wr, int wc, int fr, int fq) const {
        const int row0 = u.pm * 256 + wr * 64 + fr, col0 = u.pn * 256 + wc * 32 + 8 * fq;
        f32x4 bv[2][2];
#pragma unroll
        for (int bj = 0; bj < 2; ++bj)
#pragma unroll
            for (int n = 0; n < 2; ++n) bv[bj][n] = bias ? *(const f32x4*)(bias + col0 + bj * 128 + 4 * n) : (f32x4){0.f, 0.f, 0.f, 0.f};
#pragma unroll
        for (int ai = 0; ai < 2; ++ai)
#pragma unroll
            for (int m = 0; m < 4; ++m) { bf16_t* rowp = O + (size_t)(row0 + ai * 128 + m * 16) * ldc + col0;
#pragma unroll
                for (int bj = 0; bj < 2; ++bj) { f32x4 v0 = acc[ai][bj][m][0] + bv[bj][0], v1 = acc[ai][bj][m][1] + bv[bj][1];
                    if (act) {
#pragma unroll
                        for (int j = 0; j < 4; ++j) { v0[j] = act_apply(v0[j], act); v1[j] = act_apply(v1[j], act); } }
                    u32x4 w; w.x = cvt_pk_bf16(v0[0], v0[1]); w.y = cvt_pk_bf16(v0[2], v0[3]); w.z = cvt_pk_bf16(v1[0], v1[1]); w.w = cvt_pk_bf16(v1[2], v1[3]);
                    *(u32x4*)(rowp + bj * 128) = w; } }
    }
};
struct EpiF {
    static constexpr bool PERM = false, AFTER_DRAIN = false;
    float* C; int ldc; const float* res;
    __device__ __forceinline__ void operator()(const f32x4 (&acc)[2][2][4][2], const pg8::Unit& u, int wr, int wc, int fr, int fq) const {
        const int row0 = u.pm * 256 + wr * 64 + fr, col0 = u.pn * 256 + wc * 32 + 4 * fq;
#pragma unroll
        for (int ai = 0; ai < 2; ++ai)
#pragma unroll
            for (int m = 0; m < 4; ++m) { const size_t ro = (size_t)(row0 + ai * 128 + m * 16) * ldc + col0;
#pragma unroll
                for (int bj = 0; bj < 2; ++bj)
#pragma unroll
                    for (int n = 0; n < 2; ++n) { const f32x4 r = *(const f32x4*)(res + ro + bj * 128 + n * 16); *(f32x4*)(C + ro + bj * 128 + n * 16) = acc[ai][bj][m][n] + r; } }
    }
};

__device__ __forceinline__ void convert_tiles(const Params& p, int jlo, int jhi, LAS unsigned char* lds) {
    const int tid = opq(threadIdx.x); LAS float* T = (LAS float*)lds;
    const int total = p.cj[jhi - 1].tile0 + p.cj[jhi - 1].ntiles;
    for (int tile = blockIdx.x; tile < total; tile += gridDim.x) {
        int j = jlo; while (j + 1 < jhi && tile >= p.cj[j + 1].tile0) ++j;
        const float* src = p.cj[j].src; bf16_t* dst = p.cj[j].dst; const int K = p.cj[j].K, N = p.cj[j].N, Kpad = p.cj[j].Kpad;
        const int local = tile - p.cj[j].tile0, nkt = Kpad >> 6, kt = local % nkt, nt = local / nkt;
        f32x4 v[8];
#pragma unroll
        for (int i = 0; i < 8; ++i) { const int idx = tid + i * 512, kr = idx >> 6, c4 = idx & 63, k = kt * 64 + kr, n = nt * 256 + c4 * 4;
            v[i] = (f32x4){0.f, 0.f, 0.f, 0.f};
            if (k < K && n < N) v[i] = *(const f32x4*)(src + (size_t)k * N + n); }
#pragma unroll
        for (int i = 0; i < 8; ++i) { const int idx = tid + i * 512, kr = idx >> 6, c4 = idx & 63;
            T[kr * 257 + c4 * 4 + 0] = v[i][0]; T[kr * 257 + c4 * 4 + 1] = v[i][1]; T[kr * 257 + c4 * 4 + 2] = v[i][2]; T[kr * 257 + c4 * 4 + 3] = v[i][3]; }
        __syncthreads();
#pragma unroll
        for (int i = 0; i < 4; ++i) { const int idx = tid + i * 512, nl = idx >> 3, kc = idx & 7; float f[8];
#pragma unroll
            for (int e = 0; e < 8; ++e) f[e] = T[(kc * 8 + e) * 257 + nl];
            u32x4 w; w.x = cvt_pk_bf16(f[0], f[1]); w.y = cvt_pk_bf16(f[2], f[3]); w.z = cvt_pk_bf16(f[4], f[5]); w.w = cvt_pk_bf16(f[6], f[7]);
            *(u32x4*)(dst + (size_t)(nt * 256 + nl) * Kpad + kt * 64 + kc * 8) = w; }
        __syncthreads();
    }
}

__device__ __forceinline__ void rope_table(const Params& p) {
    float2* tab = (float2*)(p.ws + WS_ROPE);
    for (int idx = blockIdx.x * 512 + opq(threadIdx.x); idx < SEQ * 32; idx += gridDim.x * 512) {
        const int t = idx >> 5, i = idx & 31;
        const float inv = exp2f(-(float)i * 0.41524101186092029f);
        const float angf = (float)t * inv;
        const double ang = (double)angf;
        const double q = rint(ang * 0.6366197723675814);
        const double f = fma(-q, 1.5707963267948966, ang), f2 = f * f;
        const double s = f * (1.0 + f2 * (-1.0 / 6 + f2 * (1.0 / 120 + f2 * (-1.0 / 5040 + f2 * (1.0 / 362880 + f2 * (-1.0 / 39916800))))));
        const double c = 1.0 + f2 * (-0.5 + f2 * (1.0 / 24 + f2 * (-1.0 / 720 + f2 * (1.0 / 40320 + f2 * (-1.0 / 3628800 + f2 * (1.0 / 479001600))))));
        const int qi = ((int)q) & 3;
        const double sn = (qi == 0) ? s : (qi == 1) ? c : (qi == 2) ? -s : -c;
        const double cs = (qi == 0) ? c : (qi == 1) ? -s : (qi == 2) ? -c : s;
        tab[idx] = make_float2((float)cs, (float)sn);
    }
}

__device__ __forceinline__ void norm_rows(const float* x, const float* g, bf16_t* h) {
    const int tid_ = opq(threadIdx.x); const int lane = tid_ & 63, wv = tid_ >> 6;
    for (int row = blockIdx.x * 8 + wv; row < MTOK; row += gridDim.x * 8) {
        const float* xr = x + (size_t)row * D; f32x4 v[8]; float ss = 0.f;
#pragma unroll
        for (int i = 0; i < 8; ++i) { v[i] = *(const f32x4*)(xr + i * 256 + lane * 4); ss += v[i][0] * v[i][0] + v[i][1] * v[i][1] + v[i][2] * v[i][2] + v[i][3] * v[i][3]; }
        ss = wave_sum(ss); const float r = rsqrtf(ss * (1.0f / D) + 1e-6f);
#pragma unroll
        for (int i = 0; i < 8; ++i) { const f32x4 gg = *(const f32x4*)(g + i * 256 + lane * 4);
            uint2 w; w.x = cvt_pk_bf16(v[i][0] * r * gg[0], v[i][1] * r * gg[1]); w.y = cvt_pk_bf16(v[i][2] * r * gg[2], v[i][3] * r * gg[3]);
            *(uint2*)(h + (size_t)row * D + i * 256 + lane * 4) = w; }
    }
}

__device__ __forceinline__ void mix_rows(const float* x, const float* g, const float* mixw, bf16_t* mixbase, int tok0) {
    const int tid_ = opq(threadIdx.x); const int lane = tid_ & 63, wv = tid_ >> 6;
    for (int rl = blockIdx.x * 8 + wv; rl < 8192; rl += gridDim.x * 8) {
        const int tok = tok0 + rl; const bool hasprev = (tok & (SEQ - 1)) != 0;
        const float* xr = x + (size_t)tok * D; f32x4 v[8], pv[8]; float ss = 0.f, sp = 0.f;
#pragma unroll
        for (int i = 0; i < 8; ++i) { v[i] = *(const f32x4*)(xr + i * 256 + lane * 4); ss += v[i][0] * v[i][0] + v[i][1] * v[i][1] + v[i][2] * v[i][2] + v[i][3] * v[i][3];
            pv[i] = hasprev ? *(const f32x4*)(xr - D + i * 256 + lane * 4) : (f32x4){0.f, 0.f, 0.f, 0.f}; sp += pv[i][0] * pv[i][0] + pv[i][1] * pv[i][1] + pv[i][2] * pv[i][2] + pv[i][3] * pv[i][3]; }
        ss = wave_sum(ss); sp = wave_sum(sp);
        const float r = rsqrtf(ss * (1.0f / D) + 1e-6f), rp = hasprev ? rsqrtf(sp * (1.0f / D) + 1e-6f) : 0.f;
#pragma unroll
        for (int i = 0; i < 8; ++i) { const int col = i * 256 + lane * 4; const f32x4 gg = *(const f32x4*)(g + col);
            f32x4 hn, xx;
#pragma unroll
            for (int e = 0; e < 4; ++e) { hn[e] = v[i][e] * r * gg[e]; xx[e] = pv[i][e] * rp * gg[e] - hn[e]; }
#pragma unroll
            for (int m = 0; m < 6; ++m) { const f32x4 mw = *(const f32x4*)(mixw + m * D + col);
                uint2 w; w.x = cvt_pk_bf16(hn[0] + xx[0] * mw[0], hn[1] + xx[1] * mw[1]); w.y = cvt_pk_bf16(hn[2] + xx[2] * mw[2], hn[3] + xx[3] * mw[3]);
                *(uint2*)(mixbase + (size_t)m * 8192 * D + (size_t)rl * D + col) = w; } }
    }
}

__device__ __forceinline__ void conv_ssd(const Params& p) {
    const bf16_t* proj = (const bf16_t*)(p.ws + WS_PROJ); bf16_t* xbc = (bf16_t*)(p.ws + WS_XBC);
    const float* cw = p.in[6]; const float* cb = p.in[7];
    for (int idx = blockIdx.x * 512 + opq(threadIdx.x); idx < MTOK * 192; idx += gridDim.x * 512) {
        const int tok = idx / 192, c8 = idx - tok * 192, tpos = tok & (SEQ - 1), c = c8 * 8;
        float acc[8];
        { const f32x4 b0 = *(const f32x4*)(cb + c), b1 = *(const f32x4*)(cb + c + 4);
#pragma unroll
          for (int e = 0; e < 4; ++e) { acc[e] = b0[e]; acc[4 + e] = b1[e]; } }
#pragma unroll
        for (int j = 0; j < 4; ++j) { if (tpos - 3 + j >= 0) {
            const uint4 r = *(const uint4*)(proj + (size_t)(tok - 3 + j) * INWP + COL_XBC + c); float f[8]; unpack8(r, f);
            const f32x4 w0 = *(const f32x4*)(cw + j * 1536 + c), w1 = *(const f32x4*)(cw + j * 1536 + c + 4);
#pragma unroll
            for (int e = 0; e < 4; ++e) { acc[e] += w0[e] * f[e]; acc[4 + e] += w1[e] * f[4 + e]; } } }
#pragma unroll
        for (int e = 0; e < 8; ++e) acc[e] = acc[e] * sigmoidf_(acc[e]);
        u32x4 w; w.x = cvt_pk_bf16(acc[0], acc[1]); w.y = cvt_pk_bf16(acc[2], acc[3]); w.z = cvt_pk_bf16(acc[4], acc[5]); w.w = cvt_pk_bf16(acc[6], acc[7]);
        *(u32x4*)(xbc + (size_t)tok * 1536 + c) = w;
    }
    float* dt = (float*)(p.ws + WS_DT); float* da = (float*)(p.ws + WS_DA);
    for (int idx = blockIdx.x * 512 + opq(threadIdx.x); idx < MTOK * 16; idx += gridDim.x * 512) {
        const int tok = idx >> 4, hh = idx & 15;
        const float v = bf2f(proj[(size_t)tok * INWP + COL_DT + hh]) + p.in[8][hh];
        const float d = v > 20.f ? v : log1pf(expf(v));
        dt[idx] = d; da[idx] = expf(-d * expf(p.in[9][hh]));
    }
}

__device__ __forceinline__ void ssd_scan_job(const Params& p, int job, LAS unsigned char* lds) {
    const int tid = opq(threadIdx.x);
    const int b = job >> 5, hs = (job >> 1) & 15, half = job & 1, grp = hs >> 3, p0 = half * 32;
    const bf16_t* xbc = (const bf16_t*)(p.ws + WS_XBC) + (size_t)b * SEQ * 1536;
    const float* dtp = (const float*)(p.ws + WS_DT) + (size_t)b * SEQ * 16 + hs;
    const float* dap = (const float*)(p.ws + WS_DA) + (size_t)b * SEQ * 16 + hs;
    float* yraw = (float*)(p.ws + WS_YRAW) + (size_t)b * SEQ * 1024 + hs * 64 + p0;
    const float dskip = p.in[10][hs];
    constexpr int BUF_F = 9280;
    LAS float* L = (LAS float*)lds;
    int grow[3], gcol[3], loff[3];
#pragma unroll
    for (int k = 0; k < 3; ++k) { const int q = tid + k * 512, row = q / 36, pc = q - row * 36; grow[k] = row;
        if (pc < 4) { gcol[k] = hs * 64 + p0 + pc * 8; loff[k] = row * 32 + pc * 8; }
        else if (pc < 20) { gcol[k] = 1024 + grp * 128 + (pc - 4) * 8; loff[k] = 1024 + row * 128 + (pc - 4) * 8; }
        else { gcol[k] = 1280 + grp * 128 + (pc - 20) * 8; loff[k] = 5120 + row * 128 + (pc - 20) * 8; } }
    uint4 rg[3]; float sc = 0.f;
#define SSD_ISSUE(t0) do { _Pragma("unroll") for (int k = 0; k < 3; ++k) if (tid + k * 512 < 1152) rg[k] = *(const uint4*)(xbc + (size_t)((t0) + grow[k]) * 1536 + gcol[k]); \
        if (tid < 32) sc = dtp[((t0) + tid) * 16]; else if (tid < 64) sc = dap[((t0) + tid - 32) * 16]; } while (0)
#define SSD_COMMIT(buf) do { LAS float* Lc = L + (buf) * BUF_F; _Pragma("unroll") for (int k = 0; k < 3; ++k) if (tid + k * 512 < 1152) { float f[8]; unpack8(rg[k], f); \
            *(LAS f32x4*)(Lc + loff[k]) = (f32x4){f[0], f[1], f[2], f[3]}; *(LAS f32x4*)(Lc + loff[k] + 4) = (f32x4){f[4], f[5], f[6], f[7]}; } \
        if (tid < 32) Lc[9216 + tid] = sc; else if (tid < 64) Lc[9248 + tid - 32] = sc; } while (0)
    f32x2 h[4];
#pragma unroll
    for (int i = 0; i < 4; ++i) h[i] = (f32x2){0.f, 0.f};
    const int prow = tid >> 4, nseg = tid & 15;
    __syncthreads();
    SSD_ISSUE(0); SSD_COMMIT(0); __syncthreads();
    for (int ch = 0; ch < 64; ++ch) {
        const int cur = ch & 1;
        if (ch + 1 < 64) SSD_ISSUE((ch + 1) * 32);
        LAS float* Lb = L + cur * BUF_F; LAS float* yb = L + 2 * BUF_F + cur * 1024;
        for (int tg = 0; tg < 32; tg += 16) {
            float yv[16];
            LAS float* qb = Lb + 1024 + tg * 128 + nseg * 8;
            f32x4 b0 = *(LAS f32x4*)(qb), b1 = *(LAS f32x4*)(qb + 4), c0 = *(LAS f32x4*)(qb + 4096), c1 = *(LAS f32x4*)(qb + 4100);
            float dA = Lb[9248 + tg], xv = Lb[tg * 32 + prow], dtv = Lb[9216 + tg];
#pragma unroll
            for (int tt = 0; tt < 16; ++tt) {
                f32x4 nb0, nb1, nc0, nc1; float ndA, nxv, ndtv;
                if (tt + 1 < 16) { LAS float* q = qb + (tt + 1) * 128; nb0 = *(LAS f32x4*)(q); nb1 = *(LAS f32x4*)(q + 4); nc0 = *(LAS f32x4*)(q + 4096); nc1 = *(LAS f32x4*)(q + 4100);
                    ndA = Lb[9248 + tg + tt + 1]; nxv = Lb[(tg + tt + 1) * 32 + prow]; ndtv = Lb[9216 + tg + tt + 1]; }
                __builtin_amdgcn_sched_barrier(0);
                const float xdt = xv * dtv;
                const f32x2 dA2 = (f32x2){dA, dA}, x2 = (f32x2){xdt, xdt};
                h[0] = h[0] * dA2 + x2 * b0.xy; h[1] = h[1] * dA2 + x2 * b0.zw; h[2] = h[2] * dA2 + x2 * b1.xy; h[3] = h[3] * dA2 + x2 * b1.zw;
                f32x2 yc = h[0] * c0.xy; yc = h[1] * c0.zw + yc; yc = h[2] * c1.xy + yc; yc = h[3] * c1.zw + yc;
                yv[tt] = red16(yc.x + yc.y) + dskip * xv;
                __builtin_amdgcn_sched_barrier(0);
                if (tt + 1 < 16) { b0 = nb0; b1 = nb1; c0 = nc0; c1 = nc1; dA = ndA; xv = nxv; dtv = ndtv; }
            }
            if (nseg == 0) {
#pragma unroll
                for (int tt = 0; tt < 16; ++tt) yb[(tg + tt) * 32 + prow] = yv[tt]; }
        }
        if (ch + 1 < 64) SSD_COMMIT(cur ^ 1);
        __syncthreads();
        if (tid < 256) { const f32x4 v = *(LAS f32x4*)(yb + (tid >> 3) * 32 + (tid & 7) * 4); *(f32x4*)(yraw + (size_t)(ch * 32 + (tid >> 3)) * 1024 + (tid & 7) * 4) = v; }
    }
#undef SSD_ISSUE
#undef SSD_COMMIT
}
__device__ __forceinline__ void attn_job(const Params& p, int job, LAS unsigned char* lds) {
    const int tid = opq(threadIdx.x), lane = tid & 63, w = tid >> 6, fr = lane & 15, fq = lane >> 4;
    const int b = job >> 8, hq = (job >> 4) & 15, nb = job & 15, kvh = hq >> 2;
    const bf16_t* proj = (const bf16_t*)(p.ws + WS_PROJ) + (size_t)b * SEQ * INWP;
    const float2* rope = (const float2*)(p.ws + WS_ROPE);
    LAS bf16_t* Ks = (LAS bf16_t*)lds;
    LAS bf16_t* Vt = (LAS bf16_t*)(lds + 36864);
    LAS bf16_t* Ps = (LAS bf16_t*)(lds + 70656) + w * 16 * 264;
    __syncthreads();
    if (tid < 256) {
        const int kr = tid, tk = (nb - 1) * 128 + kr;
        if (tk >= 0) {
            const bf16_t* src = proj + (size_t)tk * INWP + COL_K + kvh * 64; float x[64]; float ss = 0.f;
#pragma unroll
            for (int c = 0; c < 8; ++c) { const uint4 r = *(const uint4*)(src + c * 8); float f[8]; unpack8(r, f);
#pragma unroll
                for (int e = 0; e < 8; ++e) { x[c * 8 + e] = f[e]; ss += f[e] * f[e]; } }
            const float rinv = rsqrtf(ss * (1.0f / 64) + 1e-6f); const float* kn = p.in[13];
#pragma unroll
            for (int i = 0; i < 64; ++i) x[i] = x[i] * rinv * kn[i];
#pragma unroll
            for (int c = 0; c < 4; ++c) { float o1[8], o2[8];
#pragma unroll
                for (int e = 0; e < 8; ++e) { const int i = c * 8 + e; const float2 cs = rope[tk * 32 + i]; o1[e] = x[i] * cs.x - x[i + 32] * cs.y; o2[e] = x[i + 32] * cs.x + x[i] * cs.y; }
                u32x4 w1, w2; w1.x = cvt_pk_bf16(o1[0], o1[1]); w1.y = cvt_pk_bf16(o1[2], o1[3]); w1.z = cvt_pk_bf16(o1[4], o1[5]); w1.w = cvt_pk_bf16(o1[6], o1[7]);
                w2.x = cvt_pk_bf16(o2[0], o2[1]); w2.y = cvt_pk_bf16(o2[2], o2[3]); w2.z = cvt_pk_bf16(o2[4], o2[5]); w2.w = cvt_pk_bf16(o2[6], o2[7]);
                *(LAS u32x4*)(Ks + kr * 72 + c * 8) = w1; *(LAS u32x4*)(Ks + kr * 72 + 32 + c * 8) = w2; }
        } else {
#pragma unroll
            for (int c = 0; c < 8; ++c) *(LAS u32x4*)(Ks + kr * 72 + c * 8) = (u32x4){0u, 0u, 0u, 0u};
        }
    } else {
        const int kr = tid - 256, tk = (nb - 1) * 128 + kr;
        const bf16_t* src = proj + (size_t)(tk < 0 ? 0 : tk) * INWP + COL_V + kvh * 64;
#pragma unroll
        for (int c = 0; c < 8; ++c) { uint4 r = *(const uint4*)(src + c * 8); if (tk < 0) r = make_uint4(0u, 0u, 0u, 0u);
            Vt[(c * 8 + 0) * 264 + kr] = (bf16_t)(r.x & 0xffffu); Vt[(c * 8 + 1) * 264 + kr] = (bf16_t)(r.x >> 16);
            Vt[(c * 8 + 2) * 264 + kr] = (bf16_t)(r.y & 0xffffu); Vt[(c * 8 + 3) * 264 + kr] = (bf16_t)(r.y >> 16);
            Vt[(c * 8 + 4) * 264 + kr] = (bf16_t)(r.z & 0xffffu); Vt[(c * 8 + 5) * 264 + kr] = (bf16_t)(r.z >> 16);
            Vt[(c * 8 + 6) * 264 + kr] = (bf16_t)(r.w & 0xffffu); Vt[(c * 8 + 7) * 264 + kr] = (bf16_t)(r.w >> 16); }
    }
    bf16x8 qa[2];
    { const int tq = nb * 128 + w * 16 + fr; const bf16_t* src = proj + (size_t)tq * INWP + hq * 64;
      const uint4 r0 = *(const uint4*)(src + fq * 8), r1 = *(const uint4*)(src + 32 + fq * 8); float x1[8], x2[8]; unpack8(r0, x1); unpack8(r1, x2);
      float ss = 0.f;
#pragma unroll
      for (int e = 0; e < 8; ++e) ss += x1[e] * x1[e] + x2[e] * x2[e];
      ss += __shfl_xor(ss, 16); ss += __shfl_xor(ss, 32);
      const float rinv = rsqrtf(ss * (1.0f / 64) + 1e-6f) * 0.125f; const float* qn = p.in[12]; float o1[8], o2[8];
#pragma unroll
      for (int e = 0; e < 8; ++e) { const int i = fq * 8 + e; const float a = x1[e] * rinv * qn[i], c = x2[e] * rinv * qn[i + 32]; const float2 cs = rope[tq * 32 + i];
          o1[e] = a * cs.x - c * cs.y; o2[e] = c * cs.x + a * cs.y; }
      u32x4 w1, w2; w1.x = cvt_pk_bf16(o1[0], o1[1]); w1.y = cvt_pk_bf16(o1[2], o1[3]); w1.z = cvt_pk_bf16(o1[4], o1[5]); w1.w = cvt_pk_bf16(o1[6], o1[7]);
      w2.x = cvt_pk_bf16(o2[0], o2[1]); w2.y = cvt_pk_bf16(o2[2], o2[3]); w2.z = cvt_pk_bf16(o2[4], o2[5]); w2.w = cvt_pk_bf16(o2[6], o2[7]);
      qa[0] = __builtin_bit_cast(bf16x8, w1); qa[1] = __builtin_bit_cast(bf16x8, w2); }
    __syncthreads();
    f32x4 s[16];
#pragma unroll
    for (int j = 0; j < 16; ++j) { f32x4 acc = (f32x4){0.f, 0.f, 0.f, 0.f};
#pragma unroll
        for (int ks = 0; ks < 2; ++ks) { const bf16x8 kb = *(LAS bf16x8*)(Ks + (j * 16 + fr) * 72 + ks * 32 + fq * 8); acc = __builtin_amdgcn_mfma_f32_16x16x32_bf16(qa[ks], kb, acc, 0, 0, 0); }
        s[j] = acc; }
    const float sink = p.in[14][hq];
    float mx[4], inv[4];
#pragma unroll
    for (int i = 0; i < 4; ++i) { const int qi = w * 16 + fq * 4 + i + 128; float m = -3.0e38f;
#pragma unroll
        for (int j = 0; j < 16; ++j) { const int kj = j * 16 + fr; const bool ok = (kj <= qi) && (qi - kj < 128) && (nb > 0 || kj >= 128); s[j][i] = ok ? s[j][i] : -3.0e38f; m = fmaxf(m, s[j][i]); }
        m = fmaxf(m, __shfl_xor(m, 1)); m = fmaxf(m, __shfl_xor(m, 2)); m = fmaxf(m, __shfl_xor(m, 4)); m = fmaxf(m, __shfl_xor(m, 8));
        m = fmaxf(m, sink); mx[i] = m; float l = 0.f;
#pragma unroll
        for (int j = 0; j < 16; ++j) { const float e = (s[j][i] > -1.0e38f) ? __expf(s[j][i] - m) : 0.f; s[j][i] = e; l += e; }
        l += __shfl_xor(l, 1); l += __shfl_xor(l, 2); l += __shfl_xor(l, 4); l += __shfl_xor(l, 8);
        inv[i] = 1.0f / (l + __expf(sink - m)); }
#pragma unroll
    for (int j = 0; j < 16; ++j)
#pragma unroll
        for (int i = 0; i < 4; ++i) Ps[(fq * 4 + i) * 264 + j * 16 + fr] = f2bf(s[j][i] * inv[i]);
    f32x4 o[4];
#pragma unroll
    for (int nd = 0; nd < 4; ++nd) o[nd] = (f32x4){0.f, 0.f, 0.f, 0.f};
#pragma unroll
    for (int kk = 0; kk < 8; ++kk) { const bf16x8 pa = *(LAS bf16x8*)(Ps + fr * 264 + kk * 32 + fq * 8);
#pragma unroll
        for (int nd = 0; nd < 4; ++nd) { const bf16x8 vb = *(LAS bf16x8*)(Vt + (nd * 16 + fr) * 264 + kk * 32 + fq * 8); o[nd] = __builtin_amdgcn_mfma_f32_16x16x32_bf16(pa, vb, o[nd], 0, 0, 0); } }
    bf16_t* ymix = (bf16_t*)(p.ws + WS_YMIX) + (size_t)b * SEQ * D + hq * 64;
#pragma unroll
    for (int nd = 0; nd < 4; ++nd)
#pragma unroll
        for (int i = 0; i < 4; ++i) ymix[(size_t)(nb * 128 + w * 16 + fq * 4 + i) * D + nd * 16 + fr] = f2bf(o[nd][i]);
}

__device__ __forceinline__ void post_ssd(const Params& p) {
    const int tid_ = opq(threadIdx.x); const int lane = tid_ & 63, wv = tid_ >> 6;
    const float* yraw = (const float*)(p.ws + WS_YRAW); const bf16_t* proj = (const bf16_t*)(p.ws + WS_PROJ); bf16_t* ymix = (bf16_t*)(p.ws + WS_YMIX);
    for (int it = blockIdx.x * 8 + wv; it < MTOK * 2; it += gridDim.x * 8) {
        const int tok = it >> 1, grp = it & 1, c = grp * 512 + lane * 8;
        const f32x4 y0 = *(const f32x4*)(yraw + (size_t)tok * 1024 + c), y1 = *(const f32x4*)(yraw + (size_t)tok * 1024 + c + 4);
        const uint4 zr = *(const uint4*)(proj + (size_t)tok * INWP + COL_Z + c); float z[8], y[8]; unpack8(zr, z); float ss = 0.f;
#pragma unroll
        for (int e = 0; e < 8; ++e) { const float yy = (e < 4 ? y0[e] : y1[e - 4]); y[e] = yy * z[e] * sigmoidf_(z[e]); ss += y[e] * y[e]; }
        ss = wave_sum(ss); const float r = rsqrtf(ss * (1.0f / 512) + 1e-6f);
        const f32x4 n0 = *(const f32x4*)(p.in[11] + c), n1 = *(const f32x4*)(p.in[11] + c + 4);
        u32x4 w; w.x = cvt_pk_bf16(y[0] * r * n0[0], y[1] * r * n0[1]); w.y = cvt_pk_bf16(y[2] * r * n0[2], y[3] * r * n0[3]);
        w.z = cvt_pk_bf16(y[4] * r * n1[0], y[5] * r * n1[1]); w.w = cvt_pk_bf16(y[6] * r * n1[2], y[7] * r * n1[3]);
        *(u32x4*)(ymix + (size_t)tok * D + 1024 + c) = w;
    }
}

__device__ __forceinline__ void rwkv_scan_job(const Params& p, int job, LAS unsigned char* lds) {
    const int tid = opq(threadIdx.x), lane = tid & 63, wv = tid >> 6;
    const int b = job >> 5, hh = job & 31;
    const size_t base = (size_t)b * SEQ * D + hh * 64 + lane;
    const bf16_t* Rb = (const bf16_t*)(p.ws + WS_R) + base; bf16_t* Yg = (bf16_t*)(p.ws + WS_YG) + base; const bf16_t* Kb = (const bf16_t*)(p.ws + WS_K) + base; const bf16_t* Vb = (const bf16_t*)(p.ws + WS_V) + base;
    const bf16_t* Eb = (const bf16_t*)(p.ws + WS_WDEC) + base; const bf16_t* Ab = (const bf16_t*)(p.ws + WS_AA) + base; const bf16_t* Gb = (const bf16_t*)(p.ws + WS_GG) + base;
    const int ci = hh * 64 + lane;
    const float kkw = p.in[25][ci], kaw = p.in[26][ci], rkw = p.in[27][ci], lnw = p.in[32][ci], lnb = p.in[33][ci];
    LAS float* L = (LAS float*)lds;
    unsigned short rr[2], kr[2], vr[2], er[2], ar[2], gr[2];
#define RW_ISSUE(t0) do { _Pragma("unroll") for (int s2 = 0; s2 < 2; ++s2) { const size_t off = (size_t)((t0) + wv + s2 * 8) * D; \
        rr[s2] = Rb[off]; kr[s2] = Kb[off]; vr[s2] = Vb[off]; er[s2] = Eb[off]; ar[s2] = Ab[off]; gr[s2] = Gb[off]; } } while (0)
#define RW_COMMIT(buf) do { LAS float* Lc = L + (buf) * 8192; _Pragma("unroll") for (int s2 = 0; s2 < 2; ++s2) { const int o = (wv + s2 * 8) * 64 + lane; \
        const float r_ = bf2f(rr[s2]), k_ = bf2f(kr[s2]), v_ = bf2f(vr[s2]), e_ = bf2f(er[s2]), a_ = bf2f(ar[s2]), g_ = bf2f(gr[s2]); \
        const float kkv = k_ * kkw; const float ssq = wave_sum(kkv * kkv); const float kkn = kkv * rsqrtf(fmaxf(ssq, 1e-24f)); \
        const float kmod = k_ * (1.0f + (a_ - 1.0f) * kaw); const float bonus = wave_sum(r_ * kmod * rkw); \
        Lc[o] = -kkn; Lc[1024 + o] = __expf(-e_); Lc[2048 + o] = kkn * a_; Lc[3072 + o] = kmod; Lc[4096 + o] = r_; Lc[5120 + o] = v_; Lc[6144 + o] = g_; Lc[7168 + o] = bonus * v_; } } while (0)
    f32x2 S[4];
#pragma unroll
    for (int i = 0; i < 4; ++i) S[i] = (f32x2){0.f, 0.f};
    const int vrow = tid >> 3, ks = tid & 7;
    __syncthreads();
    RW_ISSUE(0); RW_COMMIT(0); __syncthreads();
    for (int ch = 0; ch < 128; ++ch) {
        const int cur = ch & 1;
        if (ch + 1 < 128) RW_ISSUE((ch + 1) * 16);
        LAS float* Lb = L + cur * 8192; LAS float* yb = L + 16384 + cur * 1024;
        {
            float yv[16];
            LAS float* q0 = Lb + ks * 8;
            f32x4 a0 = *(LAS f32x4*)(q0), a1 = *(LAS f32x4*)(q0 + 4), w0 = *(LAS f32x4*)(q0 + 1024), w1 = *(LAS f32x4*)(q0 + 1028), b0 = *(LAS f32x4*)(q0 + 2048), b1 = *(LAS f32x4*)(q0 + 2052);
            f32x4 k0 = *(LAS f32x4*)(q0 + 3072), k1 = *(LAS f32x4*)(q0 + 3076), r0 = *(LAS f32x4*)(q0 + 4096), r1 = *(LAS f32x4*)(q0 + 4100);
            float vv = Lb[5120 + vrow];
#pragma unroll
            for (int t = 0; t < 16; ++t) {
                f32x4 na0, na1, nw0, nw1, nb0, nb1, nk0, nk1, nr0, nr1; float nvv;
                if (t + 1 < 16) { LAS float* q = q0 + (t + 1) * 64;
                    na0 = *(LAS f32x4*)(q); na1 = *(LAS f32x4*)(q + 4); nw0 = *(LAS f32x4*)(q + 1024); nw1 = *(LAS f32x4*)(q + 1028); nb0 = *(LAS f32x4*)(q + 2048); nb1 = *(LAS f32x4*)(q + 2052);
                    nk0 = *(LAS f32x4*)(q + 3072); nk1 = *(LAS f32x4*)(q + 3076); nr0 = *(LAS f32x4*)(q + 4096); nr1 = *(LAS f32x4*)(q + 4100); nvv = Lb[5120 + (t + 1) * 64 + vrow]; }
                __builtin_amdgcn_sched_barrier(0);
                f32x2 ac = S[0] * a0.xy; ac = S[1] * a0.zw + ac; ac = S[2] * a1.xy + ac; ac = S[3] * a1.zw + ac;
                const float sa = red8(ac.x + ac.y);
                const f32x2 sa2 = (f32x2){sa, sa}, vv2 = (f32x2){vv, vv};
                S[0] = S[0] * w0.xy + (sa2 * b0.xy + vv2 * k0.xy); S[1] = S[1] * w0.zw + (sa2 * b0.zw + vv2 * k0.zw);
                S[2] = S[2] * w1.xy + (sa2 * b1.xy + vv2 * k1.xy); S[3] = S[3] * w1.zw + (sa2 * b1.zw + vv2 * k1.zw);
                f32x2 yc = S[0] * r0.xy; yc = S[1] * r0.zw + yc; yc = S[2] * r1.xy + yc; yc = S[3] * r1.zw + yc;
                yv[t] = red8(yc.x + yc.y);
                __builtin_amdgcn_sched_barrier(0);
                if (t + 1 < 16) { a0 = na0; a1 = na1; w0 = nw0; w1 = nw1; b0 = nb0; b1 = nb1; k0 = nk0; k1 = nk1; r0 = nr0; r1 = nr1; vv = nvv; }
            }
            if (ks == 0) {
#pragma unroll
                for (int t = 0; t < 16; ++t) yb[t * 64 + vrow] = yv[t]; }
        }
        if (ch + 1 < 128) RW_COMMIT(cur ^ 1);
        __syncthreads();
#pragma unroll
        for (int s2 = 0; s2 < 2; ++s2) { const int t = wv + s2 * 8, o = t * 64 + lane; const float y = yb[o];
            const float mu = wave_sum(y) * (1.0f / 64), d = y - mu, var = wave_sum(d * d) * (1.0f / 64);
            const float yn = d * rsqrtf(var + 64e-5f) * lnw + lnb;
            Yg[(size_t)(ch * 16 + t) * D] = f2bf((yn + Lb[7168 + o]) * Lb[6144 + o]); }
    }
#undef RW_ISSUE
#undef RW_COMMIT
}

__global__ __launch_bounds__(512, 2) void mega(const Params p_arg) {
    extern __shared__ __attribute__((aligned(16))) unsigned char shm[];
    const Params& p = *(const Params*)(const void*)__builtin_amdgcn_kernarg_segment_ptr();
    LAS unsigned char* lds = (LAS unsigned char*)shm;
    const int G = (int)gridDim.x, bid = (int)blockIdx.x;
    for (int s = p.step_lo; s < p.step_hi; ++s) {
        const int kind = p.kind[s], lo = p.lo[s], hi = p.hi[s];
        switch (kind) {
            case K_PRE0:
#ifndef NO_PRE
 convert_tiles(p, lo, hi, lds); rope_table(p); norm_rows(p.in[0], p.in[1], (bf16_t*)(p.ws + WS_H));
#endif
 break;
            case K_GEMMB:
#ifndef NO_GB

                for (int i = lo; i < hi; ++i) { const GemmOp& o = p.g[i]; pg8::Gemm g; g.A = o.A; g.Bt = o.Bt; g.M = o.M; g.N = o.N; g.K = o.K;
                    pg8::StaticOrder S; S.init(o.M, o.N, G, (bid + G - (o.rot % G)) % G);
                    EpiB E; E.O = (bf16_t*)o.out; E.ldc = o.ldc; E.bias = o.bias; E.act = o.act;
                    pg8::gemm_phase<EpiB, pg8::StaticOrder, false>(lds, g, S, E, nullptr); }
#endif
                break;
            case K_GEMMF:
#ifndef NO_GF

                for (int i = lo; i < hi; ++i) { const GemmOp& o = p.g[i]; pg8::Gemm g; g.A = o.A; g.Bt = o.Bt; g.M = o.M; g.N = o.N; g.K = o.K;
                    pg8::StaticOrder S; S.init(o.M, o.N, G, (bid + G - (o.rot % G)) % G);
                    EpiF E; E.C = (float*)o.out; E.ldc = o.ldc; E.res = o.res;
                    pg8::gemm_phase<EpiF, pg8::StaticOrder, false>(lds, g, S, E, nullptr); }
#endif
                break;
            case K_CONVSSD:
#ifndef NO_CONV
 conv_ssd(p);
#endif
 break;
            case K_MIX0:

#ifndef NO_SSD
for (int j = bid; j < 256; j += G) ssd_scan_job(p, j, lds);
#endif


#ifndef NO_ATT
for (int j = bid; j < 2048; j += G) attn_job(p, j, lds);
#endif

                break;
            case K_POST0: post_ssd(p); break;
            case K_NORM: norm_rows(p.out, p.in[2] + lo * D, (bf16_t*)(p.ws + WS_H)); break;
            case K_PRE1: convert_tiles(p, lo, hi, lds); mix_rows(p.out, p.in[1] + D, p.in[16], (bf16_t*)(p.ws + WS_MIX), 0); break;
            case K_MIXES: mix_rows(p.out, p.in[1] + D, p.in[16], (bf16_t*)(p.ws + WS_MIX), 8192); break;
            case K_RWKV:
#ifndef NO_RWKV
 for (int j = bid; j < 256; j += G) rwkv_scan_job(p, j, lds);
#endif
 break;
            case K_NORMCONV: convert_tiles(p, lo, hi, lds); norm_rows(p.out, p.in[2] + D, (bf16_t*)(p.ws + WS_H)); break;
            default: break;
        }
        if (s + 1 < p.step_hi) cg::this_grid().sync();
    }
}

#ifndef MK_MULTI
#define MK_MULTI 0
#endif
extern "C" void kernel_launch(void* const* d_in, const int* in_sizes, int n_in, void* d_out, int out_size, void* d_ws, size_t ws_size, hipStream_t stream) {
    static int grid = 0;
    if (grid == 0) {
        int dev = 0, cus = 0, per_cu = 0;
        hipGetDevice(&dev); hipDeviceGetAttribute(&cus, hipDeviceAttributeMultiprocessorCount, dev);
        if (hipFuncSetAttribute((const void*)mega, hipFuncAttributeMaxDynamicSharedMemorySize, LDS_BYTES) != hipSuccess) { fprintf(stderr, "hipFuncSetAttribute failed\n"); grid = -1; return; }
        if (hipOccupancyMaxActiveBlocksPerMultiprocessor(&per_cu, (const void*)mega, 512, LDS_BYTES) != hipSuccess || per_cu < 1) { fprintf(stderr, "occupancy query: %d\n", per_cu); per_cu = 1; }
        (void)hipGetLastError();
        grid = cus * per_cu; if (grid > 256) grid = 256;
        if (n_in != 34 || ws_size < 512 * MiB) { fprintf(stderr, "unexpected n_in %d / ws %zu\n", n_in, ws_size); grid = -1; return; }
    }
    if (grid < 0) return;
    static Params p;
    memset(&p, 0, sizeof(p));
    for (int i = 0; i < 34; ++i) p.in[i] = (const float*)d_in[i];
    p.out = (float*)d_out; p.ws = (unsigned char*)d_ws;
    unsigned char* ws = (unsigned char*)d_ws;
    auto B16 = [&](size_t off) { return (bf16_t*)(ws + off); };
    int ncj = 0, tile_acc = 0;
    auto CJ = [&](const float* src, size_t dst_off, int K, int N, int Kpad, int Npad) { ConvJob& c = p.cj[ncj++]; c.src = src; c.dst = B16(dst_off); c.K = K; c.N = N; c.Kpad = Kpad; c.Npad = Npad; c.tile0 = tile_acc; c.ntiles = (Kpad / 64) * (Npad / 256); tile_acc += c.ntiles; };
    const float* w_up = p.in[3]; const float* w_down = p.in[4];
    tile_acc = 0;
    CJ(p.in[5], WS_WBA, 2048, 4112, 2048, 4352); CJ(p.in[15], WS_WBA + 17 * MiB, 2048, 2048, 2048, 2048);
    CJ(w_up, WS_WMLP, 2048, 8192, 2048, 8192); CJ(w_down, WS_WMLP + 32 * MiB, 8192, 2048, 8192, 2048);
    tile_acc = 0;
    CJ(p.in[28], WS_WBA, 2048, 2048, 2048, 2048); CJ(p.in[29], WS_WBA + 8 * MiB, 2048, 2048, 2048, 2048); CJ(p.in[30], WS_WBA + 16 * MiB, 2048, 2048, 2048, 2048); CJ(p.in[31], WS_WBA + 24 * MiB, 2048, 2048, 2048, 2048);
    CJ(p.in[18], WS_WBA + 32 * MiB, 2048, 96, 2048, 256); CJ(p.in[21], WS_WBA + 33 * MiB, 2048, 96, 2048, 256); CJ(p.in[23], WS_WBA + 34 * MiB, 2048, 256, 2048, 256);
    CJ(p.in[19], WS_WBA + 35 * MiB, 96, 2048, 256, 2048); CJ(p.in[22], WS_WBA + 36 * MiB, 96, 2048, 256, 2048); CJ(p.in[24], WS_WBA + 37 * MiB, 256, 2048, 256, 2048);
    tile_acc = 0;
    CJ(w_up + (size_t)2048 * 8192, WS_WMLP, 2048, 8192, 2048, 8192); CJ(w_down + (size_t)2048 * 8192, WS_WMLP + 32 * MiB, 8192, 2048, 8192, 2048);
    int nop = 0;
    auto GO = [&](const bf16_t* A, const bf16_t* Bt, void* out, const float* bias, const float* res, int M, int N, int K, int ldc, int act, int rot) {
        GemmOp& o = p.g[nop++]; o.A = A; o.Bt = Bt; o.out = out; o.bias = bias; o.res = res; o.M = M; o.N = N; o.K = K; o.ldc = ldc; o.act = act; o.rot = rot; };
    GO(B16(WS_H), B16(WS_WBA), B16(WS_PROJ), nullptr, nullptr, MTOK, INWP, 2048, INWP, 0, 0);
    GO(B16(WS_YMIX), B16(WS_WBA + 17 * MiB), d_out, nullptr, p.in[0], MTOK, 2048, 2048, 2048, 0, 0);
    GO(B16(WS_H), B16(WS_WMLP), B16(WS_U), nullptr, nullptr, MTOK, DFF, 2048, DFF, 1, 0);
    GO(B16(WS_U), B16(WS_WMLP + 32 * MiB), d_out, nullptr, (const float*)d_out, MTOK, 2048, DFF, 2048, 0, 0);
    for (int half = 0; half < 2; ++half) {
        const size_t ro = (size_t)half * 8192 * 2048 * 2, lo_ = (size_t)half * 8192 * 256 * 2; const size_t mb = (size_t)8192 * 2048 * 2;
        GO(B16(WS_MIX + 0 * mb), B16(WS_WBA), B16(WS_R + ro), nullptr, nullptr, 8192, 2048, 2048, 2048, 0, 0);
        GO(B16(WS_MIX + 2 * mb), B16(WS_WBA + 8 * MiB), B16(WS_K + ro), nullptr, nullptr, 8192, 2048, 2048, 2048, 0, 0);
        GO(B16(WS_MIX + 3 * mb), B16(WS_WBA + 16 * MiB), B16(WS_V + ro), nullptr, nullptr, 8192, 2048, 2048, 2048, 0, 0);
        GO(B16(WS_MIX + 1 * mb), B16(WS_WBA + 32 * MiB), B16(WS_L1W + lo_), nullptr, nullptr, 8192, 256, 2048, 256, 2, 0);
        GO(B16(WS_MIX + 4 * mb), B16(WS_WBA + 33 * MiB), B16(WS_L1A + lo_), nullptr, nullptr, 8192, 256, 2048, 256, 0, 32);
        GO(B16(WS_MIX + 5 * mb), B16(WS_WBA + 34 * MiB), B16(WS_L1G + lo_), nullptr, nullptr, 8192, 256, 2048, 256, 3, 64);
    }
    GO(B16(WS_L1W), B16(WS_WBA + 35 * MiB), B16(WS_WDEC), p.in[17], nullptr, MTOK, 2048, 256, 2048, 4, 0);
    GO(B16(WS_L1A), B16(WS_WBA + 36 * MiB), B16(WS_AA), p.in[20], nullptr, MTOK, 2048, 256, 2048, 3, 0);
    GO(B16(WS_L1G), B16(WS_WBA + 37 * MiB), B16(WS_GG), nullptr, nullptr, MTOK, 2048, 256, 2048, 0, 0);
    GO(B16(WS_YG), B16(WS_WBA + 24 * MiB), d_out, nullptr, (const float*)d_out, MTOK, 2048, 2048, 2048, 0, 0);
    GO(B16(WS_H), B16(WS_WMLP), B16(WS_U), nullptr, nullptr, MTOK, DFF, 2048, DFF, 1, 0);
    GO(B16(WS_U), B16(WS_WMLP + 32 * MiB), d_out, nullptr, (const float*)d_out, MTOK, 2048, DFF, 2048, 0, 0);
    int ns = 0;
    auto ST = [&](int kind, int lo, int hi) { int rep = 1; if (kind == K_GEMMB) rep = REP_GEMMB; else if (kind == K_MIX0) rep = REP_MIX0; else if (kind == K_RWKV) rep = REP_RWKV; else if (kind != K_GEMMF) rep = REP_ELEM;
        for (int r = 0; r < rep; ++r) { p.kind[ns] = kind; p.lo[ns] = lo; p.hi[ns] = hi; ++ns; } };
    ST(K_PRE0, 0, 4); ST(K_GEMMB, 0, 1); ST(K_CONVSSD, 0, 0); ST(K_MIX0, 0, 0); ST(K_POST0, 0, 0); ST(K_GEMMF, 1, 2); ST(K_NORM, 0, 0); ST(K_GEMMB, 2, 3); ST(K_GEMMF, 3, 4);
    ST(K_PRE1, 4, 14); ST(K_GEMMB, 4, 10); ST(K_MIXES, 0, 0); ST(K_GEMMB, 10, 16); ST(K_GEMMB, 16, 19); ST(K_RWKV, 0, 0); ST(K_GEMMF, 19, 20); ST(K_NORMCONV, 14, 16); ST(K_GEMMB, 20, 21); ST(K_GEMMF, 21, 22);
#if MK_MULTI
    for (int s = 0; s < ns; ++s) { p.step_lo = s; p.step_hi = s + 1; hipLaunchKernelGGL(mega, dim3(grid), dim3(512), LDS_BYTES, stream, p); }
#else
    p.step_lo = 0; p.step_hi = ns;
    void* args[] = {(void*)&p};
    const hipError_t e = hipLaunchCooperativeKernel((const void*)mega, dim3(grid), dim3(512), args, LDS_BYTES, stream);
    if (e != hipSuccess) fprintf(stderr, "cooperative launch failed: %s (grid %d)\n", hipGetErrorString(e), grid);
#endif
}
```

```cpp
#include <hip/hip_runtime.h>
#include <hip/hip_cooperative_groups.h>
#include <cstdio>
#include <cstring>
namespace cg = cooperative_groups;
__device__ __forceinline__ int opq(int v) { asm volatile("" : "+v"(v)); return v; }
namespace pg8 {
#define PG8_LAS __attribute__((address_space(3)))
typedef unsigned short bf16_t;
typedef short bf16x8 __attribute__((ext_vector_type(8)));
typedef float f32x4 __attribute__((ext_vector_type(4)));
typedef unsigned u32x4 __attribute__((ext_vector_type(4)));
constexpr int BM = 256, BK = 64, HALF = 128, HTB = HALF * BK * 2  , STAGE_BYTES = 8 * HTB, NXCD = 8, WGM = 8;

__host__ __device__ __forceinline__ int lds_byte(int r, int c) { const int st = (r >> 4) * 2 + (c >> 5), rr = r & 15, cc = c & 31, ob = rr * 64 + cc * 2; return st * 1024 + (ob ^ (((ob >> 9) & 1) << 5)); }
__host__ __device__ __forceinline__ void stage_rc(int b, int& R, int& C) { const int st = b / 1024, sb = b % 1024, swz = sb ^ (((sb >> 9) & 1) << 5); R = (st >> 1) * 16 + swz / 64; C = (st & 1) * 32 + (swz % 64) / 2; }
__host__ __device__ __forceinline__ int perm32(int rho) { const int n = rho >> 4, i = rho & 15; return 8 * (i >> 2) + 4 * n + (i & 3); }

struct Unit { int pm, pn; };
struct Gemm { const bf16_t* A; const bf16_t* Bt; int M, N, K; };

struct StaticOrder {
    int nM, nN, nwg, G, c;
    __host__ __device__ void init(int M, int N, int G_, int c_) { nM = M / BM; nN = N / BM; nwg = nM * nN; G = G_; c = c_; }
    __host__ __device__ bool next(int i, Unit& u) const {
        const long L = (long)i * G + c; if (L >= nwg) return false;
        int wgid = (int)L; { const int q = nwg / NXCD, r = nwg % NXCD, xcd = wgid % NXCD, off = wgid / NXCD; wgid = (xcd < r ? xcd * (q + 1) : r * (q + 1) + (xcd - r) * q) + off; }
        const int nig = WGM * nN, gid = wgid / nig, fm = gid * WGM, gsz = (nM - fm) < WGM ? (nM - fm) : WGM;
        u.pm = fm + ((wgid % nig) % gsz); u.pn = (wgid % nig) / gsz; return true;
    }
    __device__ __forceinline__ void a_ready(const Unit&) const {}
    __device__ __forceinline__ void done(const Unit&) const {}
};
typedef __bf16 bf16x2_t __attribute__((ext_vector_type(2)));
typedef float f32x2_t __attribute__((ext_vector_type(2)));
__device__ __forceinline__ unsigned cvt_pk_bf16(float lo, float hi) { const f32x2_t f = {lo, hi}; const bf16x2_t v = __builtin_convertvector(f, bf16x2_t); return __builtin_bit_cast(unsigned, v); }
__device__ __forceinline__ unsigned cvt_pk_nv(float lo, float hi) { return cvt_pk_bf16(lo, hi); }

template <class Epi, class Sched, bool STAMP = false>
__device__ __forceinline__ void gemm_phase(PG8_LAS unsigned char* lds, const Gemm g, const Sched& S, const Epi& E, unsigned long long* stamps) {
    const int tid = opq(threadIdx.x), wid = __builtin_amdgcn_readfirstlane(tid >> 6), lane = tid & 63, wr = wid >> 2, wc = wid & 3, fr = lane & 15, fq = lane >> 4;
    const int K = g.K, nt = K / BK;
    int ts_lo = 0, ts_hi = 0, nts = 0; const unsigned long long rt_entry = STAMP ? (unsigned long long)wall_clock64() : 0ull;
#define PG8_STAMP() do { if (STAMP && wid == 0 && nts < 64) { const unsigned long long _c = (unsigned long long)clock64(); \
        ts_lo = (lane == nts) ? (int)(unsigned)_c : ts_lo; ts_hi = (lane == nts) ? (int)(unsigned)(_c >> 32) : ts_hi; ++nts; } } while (0)
    PG8_STAMP();
    unsigned voffA[2], voffB[2];
#pragma unroll
    for (int i = 0; i < 2; ++i) { int R, C; stage_rc(tid * 16 + i * 8192, R, C); const int Rb = Epi::PERM ? ((R & ~31) + perm32(R & 31)) : R;
        voffA[i] = (unsigned)(R * K + C) * 2u; voffB[i] = (unsigned)(Rb * K + C) * 2u; }
    const size_t kstep = (size_t)(BK * 2);
    const size_t hstep = (size_t)HALF * K * 2;
    const size_t tstep = 2 * hstep;
    const unsigned ldsw = (unsigned)wid * 1024u;
    const int aoff = lds_byte(wr * 64 + fr, fq * 8), boff = lds_byte(wc * 32 + fr, fq * 8);
#define PG8_SA(b, h) (((b) * 2 + (h)) * HTB)
#define PG8_SB(b, h) ((4 + (b) * 2 + (h)) * HTB)
#define PG8_STAGE(bufoff, gbase, voff) do { _Pragma("unroll") for (int _i = 0; _i < 2; ++_i) \
        __builtin_amdgcn_global_load_lds((const unsigned*)((const char*)(gbase) + (voff)[_i]), (PG8_LAS unsigned*)(lds + (bufoff) + ldsw + _i * 8192), 16, 0, 0); } while (0)
#define PG8_LDA(dst, b, h) do { _Pragma("unroll") for (int m = 0; m < 4; ++m) _Pragma("unroll") for (int k = 0; k < 2; ++k) dst[m][k] = *(const PG8_LAS bf16x8*)(lds + PG8_SA(b, h) + aoff + m * 2048 + k * 1024); } while (0)
#define PG8_LDB(dst, b, h) do { _Pragma("unroll") for (int n = 0; n < 2; ++n) _Pragma("unroll") for (int k = 0; k < 2; ++k) dst[n][k] = *(const PG8_LAS bf16x8*)(lds + PG8_SB(b, h) + boff + n * 2048 + k * 1024); } while (0)
#define PG8_MMA(ai, bj, At, Bt) do { __builtin_amdgcn_s_setprio(1); _Pragma("unroll") for (int m = 0; m < 4; ++m) _Pragma("unroll") for (int n = 0; n < 2; ++n) _Pragma("unroll") for (int k = 0; k < 2; ++k) \
        acc[ai][bj][m][n] = __builtin_amdgcn_mfma_f32_16x16x32_bf16(Bt[n][k], At[m][k], acc[ai][bj][m][n], 0, 0, 0); __builtin_amdgcn_s_setprio(0); } while (0)
#define PG8_WAIT_V(n) asm volatile("s_waitcnt vmcnt(" #n ")" ::: "memory")
#define PG8_WAIT_L(n) asm volatile("s_waitcnt lgkmcnt(" #n ")" ::: "memory")
#define PG8_BAR __builtin_amdgcn_s_barrier()
#define PG8_SCHED __builtin_amdgcn_sched_barrier(0)
    Unit cur, nxt; int ui = 0;
    if (!S.next(0, cur)) return;
    f32x4 acc[2][2][4][2];
#pragma unroll
    for (int a = 0; a < 2; ++a)
#pragma unroll
        for (int b = 0; b < 2; ++b)
#pragma unroll
            for (int m = 0; m < 4; ++m)
#pragma unroll
                for (int n = 0; n < 2; ++n) acc[a][b][m][n] = (f32x4){0.f, 0.f, 0.f, 0.f};
    bf16x8 At[4][2], B0[2][2], B1[2][2];
    const char* cA = (const char*)g.A + (size_t)cur.pm * tstep; const char* cB = (const char*)g.Bt + (size_t)cur.pn * tstep;
    S.a_ready(cur);
    PG8_STAGE(PG8_SB(0, 0), cB, voffB); PG8_STAGE(PG8_SA(0, 0), cA, voffA); PG8_STAGE(PG8_SB(0, 1), cB + hstep, voffB); PG8_STAGE(PG8_SA(0, 1), cA + hstep, voffA);
    if (wr == 1) PG8_BAR;
    PG8_WAIT_V(4); PG8_BAR;
    PG8_STAGE(PG8_SB(1, 0), cB + kstep, voffB); PG8_STAGE(PG8_SA(1, 0), cA + kstep, voffA); PG8_STAGE(PG8_SB(1, 1), cB + hstep + kstep, voffB);
    PG8_WAIT_V(6); PG8_BAR;
    PG8_STAMP();
    for (;;) {
        const bool has_next = S.next(ui + 1, nxt);
        const char* nA = has_next ? (const char*)g.A + (size_t)nxt.pm * tstep : cA; const char* nB = has_next ? (const char*)g.Bt + (size_t)nxt.pn * tstep : cB;
        for (int t = 0; t < nt; t += 2) {
            const bool last = (t == nt - 2);
            const char* a1 = cA + (size_t)(t + 1) * kstep;
            const char* a2 = last ? nA : cA + (size_t)(t + 2) * kstep; const char* b2 = last ? nB : cB + (size_t)(t + 2) * kstep;
            const char* a3 = a2 + kstep; const char* b3 = b2 + kstep;
            if (last && has_next) S.a_ready(nxt);
            PG8_LDB(B0, 0, 0); PG8_SCHED; PG8_LDA(At, 0, 0); PG8_STAGE(PG8_SA(1, 1), a1 + hstep, voffA);
            PG8_WAIT_L(8); PG8_BAR; PG8_WAIT_L(0); PG8_MMA(0, 0, At, B0); PG8_BAR; PG8_SCHED;
            PG8_LDB(B1, 0, 1); PG8_STAGE(PG8_SB(0, 0), b2, voffB);
            PG8_BAR; PG8_WAIT_L(0); PG8_MMA(0, 1, At, B1); PG8_BAR;
            PG8_LDA(At, 0, 1); PG8_STAGE(PG8_SA(0, 0), a2, voffA);
            PG8_BAR; PG8_WAIT_L(0); PG8_MMA(1, 0, At, B0); PG8_BAR; PG8_SCHED;
            PG8_STAGE(PG8_SB(0, 1), b2 + hstep, voffB);
            PG8_WAIT_V(6); PG8_BAR; PG8_MMA(1, 1, At, B1); PG8_BAR;
            PG8_LDB(B0, 1, 0); PG8_SCHED; PG8_LDA(At, 1, 0); PG8_STAGE(PG8_SA(0, 1), a2 + hstep, voffA);
            PG8_WAIT_L(8); PG8_BAR; PG8_WAIT_L(0); PG8_MMA(0, 0, At, B0); PG8_BAR; PG8_SCHED;
            PG8_LDB(B1, 1, 1); PG8_STAGE(PG8_SB(1, 0), b3, voffB);
            PG8_BAR; PG8_WAIT_L(0); PG8_MMA(0, 1, At, B1); PG8_BAR;
            PG8_LDA(At, 1, 1); PG8_STAGE(PG8_SA(1, 0), a3, voffA);
            PG8_BAR; PG8_WAIT_L(0); PG8_MMA(1, 0, At, B0); PG8_BAR; PG8_SCHED;
            PG8_STAGE(PG8_SB(1, 1), b3 + hstep, voffB);
            PG8_WAIT_V(6); PG8_BAR; PG8_MMA(1, 1, At, B1); PG8_BAR;
        }
        PG8_STAMP();
        if constexpr (!Epi::AFTER_DRAIN) { E(acc, cur, wr, wc, fr, fq); S.done(cur); }
        PG8_STAMP();
        if (!has_next) break;
#pragma unroll
        for (int a = 0; a < 2; ++a)
#pragma unroll
            for (int b = 0; b < 2; ++b)
#pragma unroll
                for (int m = 0; m < 4; ++m)
#pragma unroll
                    for (int n = 0; n < 2; ++n) acc[a][b][m][n] = (f32x4){0.f, 0.f, 0.f, 0.f};
        cur = nxt; cA = nA; cB = nB; ++ui;
    }
    PG8_WAIT_V(0);
    if (wr == 0) PG8_BAR;
    PG8_BAR;
    if constexpr (Epi::AFTER_DRAIN) { E.fused(acc, cur, wr, wc, fr, fq, lds, wid, lane); S.done(cur); }
    PG8_STAMP();
    if (STAMP && wid == 0) { stamps[lane] = lane < nts ? (((unsigned long long)(unsigned)ts_hi << 32) | (unsigned)ts_lo) : 0ull;
        if (lane == 62) stamps[62] = rt_entry; if (lane == 63) stamps[63] = (unsigned long long)wall_clock64(); }
#undef PG8_STAMP
#undef PG8_SA
#undef PG8_SB
#undef PG8_STAGE
#undef PG8_LDA
#undef PG8_LDB
#undef PG8_MMA
#undef PG8_WAIT_V
#undef PG8_WAIT_L
#undef PG8_BAR
#undef PG8_SCHED
}
}

#include <cstdio>
#include <ctime>
#include <cstdlib>
#include <cstring>
#include <cmath>
#include <vector>
#include <algorithm>
#define CK(x) do { hipError_t e_ = (x); if (e_ != hipSuccess) { fprintf(stderr, "HIP %s:%d %s\n", __FILE__, __LINE__, hipGetErrorString(e_)); exit(2); } } while (0)
using pg8::bf16_t; using pg8::bf16x8; using pg8::f32x4; using pg8::u32x4; using pg8::cvt_pk_bf16; using pg8::cvt_pk_nv;
#define LAS PG8_LAS

constexpr int D = 2048, SEQ = 2048, MTOK = 16384, DFF = 8192, INWP = 4352;
constexpr int COL_K = 1024, COL_V = 1280, COL_Z = 1536, COL_XBC = 2560, COL_DT = 4096;
constexpr size_t MiB = (size_t)1 << 20;
constexpr size_t WS_WBA = 0, WS_WMLP = 40 * MiB, WS_H = 104 * MiB, WS_PROJ = 168 * MiB, WS_YMIX = 304 * MiB, WS_YRAW = 368 * MiB, WS_XBC = 432 * MiB,
                 WS_DT = 480 * MiB, WS_DA = 481 * MiB, WS_ROPE = 482 * MiB, WS_U = 168 * MiB;
constexpr size_t WS_R = 40 * MiB, WS_K = 104 * MiB, WS_V = 168 * MiB, WS_L1W = 232 * MiB, WS_L1A = 240 * MiB, WS_L1G = 248 * MiB, WS_MIX = 256 * MiB,
                 WS_WDEC = 256 * MiB, WS_AA = 320 * MiB, WS_GG = 384 * MiB, WS_YG = 448 * MiB;
constexpr int LDS_BYTES = 140 * 1024;

enum { K_PRE0 = 0, K_GEMMB, K_GEMMF, K_CONVSSD, K_MIX0, K_POST0, K_NORM, K_PRE1, K_MIXES, K_RWKV, K_NORMCONV };
constexpr int NSTEPS = 48, NOPS = 22, NCJ = 16;
#define REP_GEMMB 1
#define REP_MIX0 1
#define REP_RWKV 1
#define REP_ELEM 1

struct GemmOp { const bf16_t* A; const bf16_t* Bt; void* out; const float* bias; const float* res; int M, N, K, ldc, act, rot, pad0, pad1; };
struct ConvJob { const float* src; bf16_t* dst; int K, N, Kpad, Npad, tile0, ntiles; };
struct Params {
    const float* in[34];
    float* out; unsigned char* ws;
    GemmOp g[NOPS];
    ConvJob cj[NCJ];
    int kind[NSTEPS + 1]; int lo[NSTEPS + 1]; int hi[NSTEPS + 1];
    int step_lo, step_hi;
};

__device__ __forceinline__ float bf2f(unsigned short b) { return __uint_as_float(((unsigned)b) << 16); }
__device__ __forceinline__ float bflo(unsigned w) { return __uint_as_float(w << 16); }
__device__ __forceinline__ float bfhi(unsigned w) { return __uint_as_float(w & 0xffff0000u); }
__device__ __forceinline__ bf16_t f2bf(float f) { return (bf16_t)(cvt_pk_bf16(f, 0.f) & 0xffffu); }
template <int CTRL> __device__ __forceinline__ float dpp_add(float x) {
    const int y = __builtin_amdgcn_update_dpp(0, __builtin_bit_cast(int, x), CTRL, 0xf, 0xf, true);
    return x + __builtin_bit_cast(float, y); }
__device__ __forceinline__ float red8(float x) { x = dpp_add<0xB1>(x); x = dpp_add<0x4E>(x); x = dpp_add<0x141>(x); return x; }
__device__ __forceinline__ float red16(float x) { x = red8(x); x = dpp_add<0x140>(x); return x; }
__device__ __forceinline__ float wave_sum(float v) {
    v = red16(v);
    const float r0 = __builtin_bit_cast(float, __builtin_amdgcn_readlane(__builtin_bit_cast(int, v), 0)), r1 = __builtin_bit_cast(float, __builtin_amdgcn_readlane(__builtin_bit_cast(int, v), 16));
    const float r2 = __builtin_bit_cast(float, __builtin_amdgcn_readlane(__builtin_bit_cast(int, v), 32)), r3 = __builtin_bit_cast(float, __builtin_amdgcn_readlane(__builtin_bit_cast(int, v), 48));
    return (r0 + r1) + (r2 + r3); }
typedef float f32x2 __attribute__((ext_vector_type(2)));
__device__ __forceinline__ float sigmoidf_(float v) { return 1.0f / (1.0f + __expf(-v)); }
__device__ __forceinline__ void unpack8(const uint4 r, float (&f)[8]) {
    f[0] = bflo(r.x); f[1] = bfhi(r.x); f[2] = bflo(r.y); f[3] = bfhi(r.y); f[4] = bflo(r.z); f[5] = bfhi(r.z); f[6] = bflo(r.w); f[7] = bfhi(r.w); }

__device__ __forceinline__ float act_apply(float v, int act) {
    switch (act) {
        case 1: { const float r = fmaxf(v, 0.f); return r * r; }
        case 2: return 1.0f - 2.0f / (1.0f + __expf(2.0f * v));
        case 3: return sigmoidf_(v);
        case 4: return 0.60653066f * sigmoidf_(v);
        default: return v; }
}
struct EpiB {
    static constexpr bool PERM = true, AFTER_DRAIN = false;
    bf16_t* O; int ldc; const float* bias; int act;
    __device__ __forceinline__ void operator()(const f32x4 (&acc)[2][2][4][2], const pg8::Unit& u, int wr, int wc, int fr, int fq) const {
        const int row0 = u.pm * 256 + wr * 64 + fr, col0 = u.pn * 256 + wc * 32 + 8 * fq;
        f32x4 bv[2][2];
#pragma unroll
        for (int bj = 0; bj < 2; ++bj)
#pragma unroll
            for (int n = 0; n < 2; ++n) bv[bj][n] = bias ? *(const f32x4*)(bias + col0 + bj * 128 + 4 * n) : (f32x4){0.f, 0.f, 0.f, 0.f};
#pragma unroll
        for (int ai = 0; ai < 2; ++ai)
#pragma unroll
            for (int m = 0; m < 4; ++m) { bf16_t* rowp = O + (size_t)(row0 + ai * 128 + m * 16) * ldc + col0;
#pragma unroll
                for (int bj = 0; bj < 2; ++bj) { f32x4 v0 = acc[ai][bj][m][0] + bv[bj][0], v1 = acc[ai][bj][m][1] + bv[bj][1];
                    if (act) {
#pragma unroll
                        for (int j = 0; j < 4; ++j) { v0[j] = act_apply(v0[j], act); v1[j] = act_apply(v1[j], act); } }
                    u32x4 w; w.x = cvt_pk_bf16(v0[0], v0[1]); w.y = cvt_pk_bf16(v0[2], v0[3]); w.z = cvt_pk_bf16(v1[0], v1[1]); w.w = cvt_pk_bf16(v1[2], v1[3]);
                    *(u32x4*)(rowp + bj * 128) = w; } }
    }
};
struct EpiF {
    static constexpr bool PERM = false, AFTER_DRAIN = false;
    float* C; int ldc; const float* res;
    __device__ __forceinline__ void operator()(const f32x4 (&acc)[2][2][4][2], const pg8::Unit& u, int wr, int wc, int fr, int fq) const {
        const int row0 = u.pm * 256 + wr * 64 + fr, col0 = u.pn * 256 + wc * 32 + 4 * fq;
#pragma unroll
        for (int ai = 0; ai < 2; ++ai)
#pragma unroll
            for (int m = 0; m < 4; ++m) { const size_t ro = (size_t)(row0 + ai * 128 + m * 16) * ldc + col0;
#pragma unroll
                for (int bj = 0; bj < 2; ++bj)
#pragma unroll
                    for (int n = 0; n < 2; ++n) { const f32x4 r = *(const f32x4*)(res + ro + bj * 128 + n * 16); *(f32x4*)(C + ro + bj * 128 + n * 16) = acc[ai][bj][m][n] + r; } }
    }
};

__device__ __forceinline__ void convert_tiles(const Params& p, int jlo, int jhi, LAS unsigned char* lds) {
    const int tid = opq(threadIdx.x); LAS float* T = (LAS float*)lds;
    const int total = p.cj[jhi - 1].tile0 + p.cj[jhi - 1].ntiles;
    for (int tile = blockIdx.x; tile < total; tile += gridDim.x) {
        int j = jlo; while (j + 1 < jhi && tile >= p.cj[j + 1].tile0) ++j;
        const float* src = p.cj[j].src; bf16_t* dst = p.cj[j].dst; const int K = p.cj[j].K, N = p.cj[j].N, Kpad = p.cj[j].Kpad;
        const int local = tile - p.cj[j].tile0, nkt = Kpad >> 6, kt = local % nkt, nt = local / nkt;
        f32x4 v[8];
#pragma unroll
        for (int i = 0; i < 8; ++i) { const int idx = tid + i * 512, kr = idx >> 6, c4 = idx & 63, k = kt * 64 + kr, n = nt * 256 + c4 * 4;
            v[i] = (f32x4){0.f, 0.f, 0.f, 0.f};
            if (k < K && n < N) v[i] = *(const f32x4*)(src + (size_t)k * N + n); }
#pragma unroll
        for (int i = 0; i < 8; ++i) { const int idx = tid + i * 512, kr = idx >> 6, c4 = idx & 63;
            T[kr * 257 + c4 * 4 + 0] = v[i][0]; T[kr * 257 + c4 * 4 + 1] = v[i][1]; T[kr * 257 + c4 * 4 + 2] = v[i][2]; T[kr * 257 + c4 * 4 + 3] = v[i][3]; }
        __syncthreads();
#pragma unroll
        for (int i = 0; i < 4; ++i) { const int idx = tid + i * 512, nl = idx >> 3, kc = idx & 7; float f[8];
#pragma unroll
            for (int e = 0; e < 8; ++e) f[e] = T[(kc * 8 + e) * 257 + nl];
            u32x4 w; w.x = cvt_pk_nv(f[0], f[1]); w.y = cvt_pk_nv(f[2], f[3]); w.z = cvt_pk_nv(f[4], f[5]); w.w = cvt_pk_nv(f[6], f[7]);
            *(u32x4*)(dst + (size_t)(nt * 256 + nl) * Kpad + kt * 64 + kc * 8) = w; }
        __syncthreads();
    }
}

__device__ __forceinline__ void rope_table(const Params& p) {
    float2* tab = (float2*)(p.ws + WS_ROPE);
    for (int idx = blockIdx.x * 512 + opq(threadIdx.x); idx < SEQ * 32; idx += gridDim.x * 512) {
        const int t = idx >> 5, i = idx & 31;
        const float inv = exp2f(-(float)i * 0.41524101186092029f);
        const float angf = (float)t * inv;
        const double ang = (double)angf;
        const double q = rint(ang * 0.6366197723675814);
        const double f = fma(-q, 1.5707963267948966, ang), f2 = f * f;
        const double s = f * (1.0 + f2 * (-1.0 / 6 + f2 * (1.0 / 120 + f2 * (-1.0 / 5040 + f2 * (1.0 / 362880 + f2 * (-1.0 / 39916800))))));
        const double c = 1.0 + f2 * (-0.5 + f2 * (1.0 / 24 + f2 * (-1.0 / 720 + f2 * (1.0 / 40320 + f2 * (-1.0 / 3628800 + f2 * (1.0 / 479001600))))));
        const int qi = ((int)q) & 3;
        const double sn = (qi == 0) ? s : (qi == 1) ? c : (qi == 2) ? -s : -c;
        const double cs = (qi == 0) ? c : (qi == 1) ? -s : (qi == 2) ? -c : s;
        tab[idx] = make_float2((float)cs, (float)sn);
    }
}

__device__ __forceinline__ void norm_rows(const float* x, const float* g, bf16_t* h) {
    const int tid_ = opq(threadIdx.x); const int lane = tid_ & 63, wv = tid_ >> 6;
    f32x4 gg[8];
#pragma unroll
    for (int i = 0; i < 8; ++i) gg[i] = *(const f32x4*)(g + i * 256 + lane * 4);
    for (int row = blockIdx.x * 8 + wv; row < MTOK; row += gridDim.x * 8) {
        const float* xr = x + (size_t)row * D; f32x4 v[8]; float ss = 0.f;
#pragma unroll
        for (int i = 0; i < 8; ++i) v[i] = *(const f32x4*)(xr + i * 256 + lane * 4);
#pragma unroll
        for (int i = 0; i < 8; ++i) ss += v[i][0] * v[i][0] + v[i][1] * v[i][1] + v[i][2] * v[i][2] + v[i][3] * v[i][3];
        ss = wave_sum(ss); const float r = rsqrtf(ss * (1.0f / D) + 1e-6f);
#pragma unroll
        for (int i = 0; i < 8; ++i) {
            uint2 w; w.x = cvt_pk_nv(v[i][0] * r * gg[i][0], v[i][1] * r * gg[i][1]); w.y = cvt_pk_nv(v[i][2] * r * gg[i][2], v[i][3] * r * gg[i][3]);
            *(uint2*)(h + (size_t)row * D + i * 256 + lane * 4) = w; }
    }
}

__device__ __forceinline__ void mix_rows(const float* x, const float* g, const float* mixw, bf16_t* mixbase, int tok0, LAS unsigned char* lds) {
    const int tid = opq(threadIdx.x), lane = tid & 63, wv = tid >> 6, c = tid * 4;
    LAS float* rs = (LAS float*)lds;
    const f32x4 gg = *(const f32x4*)(g + c); f32x4 mw[6];
#pragma unroll
    for (int m = 0; m < 6; ++m) mw[m] = *(const f32x4*)(mixw + m * D + c);
    for (int chunk = blockIdx.x; chunk < 256; chunk += gridDim.x) {
        const int rl0 = chunk * 32, tokc = tok0 + rl0; const bool hasprev = (tokc & (SEQ - 1)) != 0;
        __syncthreads();
        for (int r = wv; r < 33; r += 8) {
            float ss = 0.f;
            if (r > 0 || hasprev) { const float* xr = x + (size_t)(tokc - 1 + r) * D; f32x4 v[8];
#pragma unroll
                for (int i = 0; i < 8; ++i) v[i] = *(const f32x4*)(xr + i * 256 + lane * 4);
#pragma unroll
                for (int i = 0; i < 8; ++i) ss += v[i][0] * v[i][0] + v[i][1] * v[i][1] + v[i][2] * v[i][2] + v[i][3] * v[i][3]; }
            ss = wave_sum(ss);
            if (lane == 0) rs[r] = (r > 0 || hasprev) ? rsqrtf(ss * (1.0f / D) + 1e-6f) : 0.f;
        }
        __syncthreads();
        f32x4 prev = (f32x4){0.f, 0.f, 0.f, 0.f};
        if (hasprev) { const f32x4 pv = *(const f32x4*)(x + (size_t)(tokc - 1) * D + c); const float rp = rs[0]; prev = pv * rp * gg; }
        for (int r0 = 0; r0 < 32; r0 += 4) {
            f32x4 xv[4];
#pragma unroll
            for (int u = 0; u < 4; ++u) xv[u] = *(const f32x4*)(x + (size_t)(tokc + r0 + u) * D + c);
#pragma unroll
            for (int u = 0; u < 4; ++u) { const float rr = rs[r0 + u + 1]; const f32x4 hn = xv[u] * rr * gg, xx = prev - hn;
#pragma unroll
                for (int m = 0; m < 6; ++m) { const f32x4 o = hn + xx * mw[m];
                    uint2 w; w.x = cvt_pk_nv(o[0], o[1]); w.y = cvt_pk_nv(o[2], o[3]);
                    *(uint2*)(mixbase + (size_t)m * 8192 * D + (size_t)(rl0 + r0 + u) * D + c) = w; }
                prev = hn; }
        }
    }
}

__device__ __forceinline__ void conv_ssd(const Params& p) {
    const bf16_t* proj = (const bf16_t*)(p.ws + WS_PROJ); bf16_t* xbc = (bf16_t*)(p.ws + WS_XBC);
    const float* cw = p.in[6]; const float* cb = p.in[7];
    for (int idx = blockIdx.x * 512 + opq(threadIdx.x); idx < MTOK * 192; idx += gridDim.x * 512) {
        const int tok = idx / 192, c8 = idx - tok * 192, tpos = tok & (SEQ - 1), c = c8 * 8;
        float acc[8];
        { const f32x4 b0 = *(const f32x4*)(cb + c), b1 = *(const f32x4*)(cb + c + 4);
#pragma unroll
          for (int e = 0; e < 4; ++e) { acc[e] = b0[e]; acc[4 + e] = b1[e]; } }
#pragma unroll
        for (int j = 0; j < 4; ++j) { if (tpos - 3 + j >= 0) {
            const uint4 r = *(const uint4*)(proj + (size_t)(tok - 3 + j) * INWP + COL_XBC + c); float f[8]; unpack8(r, f);
            const f32x4 w0 = *(const f32x4*)(cw + j * 1536 + c), w1 = *(const f32x4*)(cw + j * 1536 + c + 4);
#pragma unroll
            for (int e = 0; e < 4; ++e) { acc[e] += w0[e] * f[e]; acc[4 + e] += w1[e] * f[4 + e]; } } }
#pragma unroll
        for (int e = 0; e < 8; ++e) acc[e] = acc[e] * sigmoidf_(acc[e]);
        u32x4 w; w.x = cvt_pk_nv(acc[0], acc[1]); w.y = cvt_pk_nv(acc[2], acc[3]); w.z = cvt_pk_nv(acc[4], acc[5]); w.w = cvt_pk_nv(acc[6], acc[7]);
        *(u32x4*)(xbc + (size_t)tok * 1536 + c) = w;
    }
    float* dt = (float*)(p.ws + WS_DT); float* da = (float*)(p.ws + WS_DA);
    for (int idx = blockIdx.x * 512 + opq(threadIdx.x); idx < MTOK * 16; idx += gridDim.x * 512) {
        const int tok = idx >> 4, hh = idx & 15;
        const float v = bf2f(proj[(size_t)tok * INWP + COL_DT + hh]) + p.in[8][hh];
        const float d = v > 20.f ? v : log1pf(expf(v));
        dt[idx] = d; da[idx] = expf(-d * expf(p.in[9][hh]));
    }
}

__device__ __forceinline__ void ssd_scan_job(const Params& p, int job, LAS unsigned char* lds) {
    const int tid = opq(threadIdx.x);
    const int b = job >> 5, hs = (job >> 1) & 15, half = job & 1, grp = hs >> 3, p0 = half * 32;
    const bf16_t* xbc = (const bf16_t*)(p.ws + WS_XBC) + (size_t)b * SEQ * 1536;
    const float* dtp = (const float*)(p.ws + WS_DT) + (size_t)b * SEQ * 16 + hs;
    const float* dap = (const float*)(p.ws + WS_DA) + (size_t)b * SEQ * 16 + hs;
    float* yraw = (float*)(p.ws + WS_YRAW) + (size_t)b * SEQ * 1024 + hs * 64 + p0;
    const float dskip = p.in[10][hs];
    constexpr int BUF_F = 9280;
    LAS float* L = (LAS float*)lds;
    int grow[3], gcol[3], loff[3];
#pragma unroll
    for (int k = 0; k < 3; ++k) { const int q = tid + k * 512, row = q / 36, pc = q - row * 36; grow[k] = row;
        if (pc < 4) { gcol[k] = hs * 64 + p0 + pc * 8; loff[k] = row * 32 + pc * 8; }
        else if (pc < 20) { gcol[k] = 1024 + grp * 128 + (pc - 4) * 8; loff[k] = 1024 + row * 128 + (pc - 4) * 8; }
        else { gcol[k] = 1280 + grp * 128 + (pc - 20) * 8; loff[k] = 5120 + row * 128 + (pc - 20) * 8; } }
    uint4 rg[3]; float sc = 0.f;
#define SSD_ISSUE(t0) do { _Pragma("unroll") for (int k = 0; k < 3; ++k) if (tid + k * 512 < 1152) rg[k] = *(const uint4*)(xbc + (size_t)((t0) + grow[k]) * 1536 + gcol[k]); \
        if (tid < 32) sc = dtp[((t0) + tid) * 16]; else if (tid < 64) sc = dap[((t0) + tid - 32) * 16]; } while (0)
#define SSD_COMMIT(buf) do { LAS float* Lc = L + (buf) * BUF_F; _Pragma("unroll") for (int k = 0; k < 3; ++k) if (tid + k * 512 < 1152) { float f[8]; unpack8(rg[k], f); \
            *(LAS f32x4*)(Lc + loff[k]) = (f32x4){f[0], f[1], f[2], f[3]}; *(LAS f32x4*)(Lc + loff[k] + 4) = (f32x4){f[4], f[5], f[6], f[7]}; } \
        if (tid < 32) Lc[9216 + tid] = sc; else if (tid < 64) Lc[9248 + tid - 32] = sc; } while (0)
    f32x2 hA[4], hB[4];
#pragma unroll
    for (int i = 0; i < 4; ++i) { hA[i] = (f32x2){0.f, 0.f}; hB[i] = (f32x2){0.f, 0.f}; }
    const int prow = (tid >> 4) & 15, nseg = tid & 15;
    __syncthreads();
    SSD_ISSUE(0); SSD_COMMIT(0); __syncthreads();
    for (int ch = 0; ch < 64; ++ch) {
        const int cur = ch & 1;
        if (ch + 1 < 64) SSD_ISSUE((ch + 1) * 32);
        LAS float* Lb = L + cur * BUF_F; LAS float* yb = L + 2 * BUF_F + cur * 1024;
        if (tid < 256) {
        for (int tg = 0; tg < 32; tg += 16) {
            float yA[16], yB[16];
            LAS float* qb = Lb + 1024 + tg * 128 + nseg * 8;
            f32x4 b0 = *(LAS f32x4*)(qb), b1 = *(LAS f32x4*)(qb + 4), c0 = *(LAS f32x4*)(qb + 4096), c1 = *(LAS f32x4*)(qb + 4100);
            float dA = Lb[9248 + tg], xa = Lb[tg * 32 + prow], xb = Lb[tg * 32 + prow + 16], dtv = Lb[9216 + tg];
#pragma unroll
            for (int tt = 0; tt < 16; ++tt) {
                f32x4 nb0, nb1, nc0, nc1; float ndA, nxa, nxb, ndtv;
                if (tt + 1 < 16) { LAS float* q = qb + (tt + 1) * 128; nb0 = *(LAS f32x4*)(q); nb1 = *(LAS f32x4*)(q + 4); nc0 = *(LAS f32x4*)(q + 4096); nc1 = *(LAS f32x4*)(q + 4100);
                    ndA = Lb[9248 + tg + tt + 1]; nxa = Lb[(tg + tt + 1) * 32 + prow]; nxb = Lb[(tg + tt + 1) * 32 + prow + 16]; ndtv = Lb[9216 + tg + tt + 1]; }
                __builtin_amdgcn_sched_barrier(0);
                const float xdta = xa * dtv, xdtb = xb * dtv;
                const f32x2 dA2 = (f32x2){dA, dA}, xa2 = (f32x2){xdta, xdta}, xb2 = (f32x2){xdtb, xdtb};
                hA[0] = hA[0] * dA2 + xa2 * b0.xy; hB[0] = hB[0] * dA2 + xb2 * b0.xy; hA[1] = hA[1] * dA2 + xa2 * b0.zw; hB[1] = hB[1] * dA2 + xb2 * b0.zw;
                hA[2] = hA[2] * dA2 + xa2 * b1.xy; hB[2] = hB[2] * dA2 + xb2 * b1.xy; hA[3] = hA[3] * dA2 + xa2 * b1.zw; hB[3] = hB[3] * dA2 + xb2 * b1.zw;
                f32x2 ya = hA[0] * c0.xy, yb2 = hB[0] * c0.xy; ya = hA[1] * c0.zw + ya; yb2 = hB[1] * c0.zw + yb2; ya = hA[2] * c1.xy + ya; yb2 = hB[2] * c1.xy + yb2; ya = hA[3] * c1.zw + ya; yb2 = hB[3] * c1.zw + yb2;
                float ra = ya.x + ya.y, rb = yb2.x + yb2.y;
                ra = dpp_add<0xB1>(ra); rb = dpp_add<0xB1>(rb); ra = dpp_add<0x4E>(ra); rb = dpp_add<0x4E>(rb); ra = dpp_add<0x141>(ra); rb = dpp_add<0x141>(rb); ra = dpp_add<0x140>(ra); rb = dpp_add<0x140>(rb);
                yA[tt] = ra + dskip * xa; yB[tt] = rb + dskip * xb;
                __builtin_amdgcn_sched_barrier(0);
                if (tt + 1 < 16) { b0 = nb0; b1 = nb1; c0 = nc0; c1 = nc1; dA = ndA; xa = nxa; xb = nxb; dtv = ndtv; }
            }
            if (nseg == 0) {
#pragma unroll
                for (int tt = 0; tt < 16; ++tt) { yb[(tg + tt) * 32 + prow] = yA[tt]; yb[(tg + tt) * 32 + prow + 16] = yB[tt]; } }
        }
        }
        if (ch + 1 < 64) SSD_COMMIT(cur ^ 1);
        __syncthreads();
        if (tid < 256) { const f32x4 v = *(LAS f32x4*)(yb + (tid >> 3) * 32 + (tid & 7) * 4); *(f32x4*)(yraw + (size_t)(ch * 32 + (tid >> 3)) * 1024 + (tid & 7) * 4) = v; }
    }
#undef SSD_ISSUE
#undef SSD_COMMIT
}
__device__ __forceinline__ void attn_job(const Params& p, int job, LAS unsigned char* lds) {
    const int tid = opq(threadIdx.x), lane = tid & 63, w = tid >> 6, fr = lane & 15, fq = lane >> 4;
    const int b = job >> 6, kvh = (job >> 4) & 3, nb = job & 15;
    const bf16_t* proj = (const bf16_t*)(p.ws + WS_PROJ) + (size_t)b * SEQ * INWP;
    const float2* rope = (const float2*)(p.ws + WS_ROPE);
    LAS bf16_t* Ks = (LAS bf16_t*)lds;
    LAS bf16_t* Vt = (LAS bf16_t*)(lds + 36864);
    LAS bf16_t* Ps = (LAS bf16_t*)(lds + 70656) + w * 16 * 264;
    __syncthreads();
    if (tid < 256) {
        const int kr = tid, tk = (nb - 1) * 128 + kr;
        if (tk >= 0) {
            const bf16_t* src = proj + (size_t)tk * INWP + COL_K + kvh * 64; float x[64]; float ss = 0.f;
#pragma unroll
            for (int c = 0; c < 8; ++c) { const uint4 r = *(const uint4*)(src + c * 8); float f[8]; unpack8(r, f);
#pragma unroll
                for (int e = 0; e < 8; ++e) { x[c * 8 + e] = f[e]; ss += f[e] * f[e]; } }
            const float rinv = rsqrtf(ss * (1.0f / 64) + 1e-6f); const float* kn = p.in[13];
#pragma unroll
            for (int i = 0; i < 64; ++i) x[i] = x[i] * rinv * kn[i];
#pragma unroll
            for (int c = 0; c < 4; ++c) { float o1[8], o2[8];
#pragma unroll
                for (int e = 0; e < 8; ++e) { const int i = c * 8 + e; const float2 cs = rope[tk * 32 + i]; o1[e] = x[i] * cs.x - x[i + 32] * cs.y; o2[e] = x[i + 32] * cs.x + x[i] * cs.y; }
                u32x4 w1, w2; w1.x = cvt_pk_bf16(o1[0], o1[1]); w1.y = cvt_pk_bf16(o1[2], o1[3]); w1.z = cvt_pk_bf16(o1[4], o1[5]); w1.w = cvt_pk_bf16(o1[6], o1[7]);
                w2.x = cvt_pk_bf16(o2[0], o2[1]); w2.y = cvt_pk_bf16(o2[2], o2[3]); w2.z = cvt_pk_bf16(o2[4], o2[5]); w2.w = cvt_pk_bf16(o2[6], o2[7]);
                *(LAS u32x4*)(Ks + kr * 72 + c * 8) = w1; *(LAS u32x4*)(Ks + kr * 72 + 32 + c * 8) = w2;
                __builtin_amdgcn_sched_barrier(0); }
        } else {
#pragma unroll
            for (int c = 0; c < 8; ++c) *(LAS u32x4*)(Ks + kr * 72 + c * 8) = (u32x4){0u, 0u, 0u, 0u};
        }
    } else {
        const int kr = tid - 256, tk = (nb - 1) * 128 + kr;
        const bf16_t* src = proj + (size_t)(tk < 0 ? 0 : tk) * INWP + COL_V + kvh * 64;
#pragma unroll
        for (int c = 0; c < 8; ++c) { uint4 r = *(const uint4*)(src + c * 8); if (tk < 0) r = make_uint4(0u, 0u, 0u, 0u);
            Vt[(c * 8 + 0) * 264 + kr] = (bf16_t)(r.x & 0xffffu); Vt[(c * 8 + 1) * 264 + kr] = (bf16_t)(r.x >> 16);
            Vt[(c * 8 + 2) * 264 + kr] = (bf16_t)(r.y & 0xffffu); Vt[(c * 8 + 3) * 264 + kr] = (bf16_t)(r.y >> 16);
            Vt[(c * 8 + 4) * 264 + kr] = (bf16_t)(r.z & 0xffffu); Vt[(c * 8 + 5) * 264 + kr] = (bf16_t)(r.z >> 16);
            Vt[(c * 8 + 6) * 264 + kr] = (bf16_t)(r.w & 0xffffu); Vt[(c * 8 + 7) * 264 + kr] = (bf16_t)(r.w >> 16); }
    }
    __syncthreads();
    for (int h4 = 0; h4 < 4; ++h4) {
    const int hq = kvh * 4 + h4;
    bf16x8 qa[2];
    { const int tq = nb * 128 + w * 16 + fr; const bf16_t* src = proj + (size_t)tq * INWP + hq * 64;
      const uint4 r0 = *(const uint4*)(src + fq * 8), r1 = *(const uint4*)(src + 32 + fq * 8); float x1[8], x2[8]; unpack8(r0, x1); unpack8(r1, x2);
      float ss = 0.f;
#pragma unroll
      for (int e = 0; e < 8; ++e) ss += x1[e] * x1[e] + x2[e] * x2[e];
      ss += __shfl_xor(ss, 16); ss += __shfl_xor(ss, 32);
      const float rinv = rsqrtf(ss * (1.0f / 64) + 1e-6f) * 0.125f; const float* qn = p.in[12]; float o1[8], o2[8];
#pragma unroll
      for (int e = 0; e < 8; ++e) { const int i = fq * 8 + e; const float a = x1[e] * rinv * qn[i], c = x2[e] * rinv * qn[i + 32]; const float2 cs = rope[tq * 32 + i];
          o1[e] = a * cs.x - c * cs.y; o2[e] = c * cs.x + a * cs.y; }
      u32x4 w1, w2; w1.x = cvt_pk_bf16(o1[0], o1[1]); w1.y = cvt_pk_bf16(o1[2], o1[3]); w1.z = cvt_pk_bf16(o1[4], o1[5]); w1.w = cvt_pk_bf16(o1[6], o1[7]);
      w2.x = cvt_pk_bf16(o2[0], o2[1]); w2.y = cvt_pk_bf16(o2[2], o2[3]); w2.z = cvt_pk_bf16(o2[4], o2[5]); w2.w = cvt_pk_bf16(o2[6], o2[7]);
      qa[0] = __builtin_bit_cast(bf16x8, w1); qa[1] = __builtin_bit_cast(bf16x8, w2); }
    f32x4 s[16];
#pragma unroll
    for (int j = 0; j < 16; ++j) { f32x4 acc = (f32x4){0.f, 0.f, 0.f, 0.f};
#pragma unroll
        for (int ks = 0; ks < 2; ++ks) { const bf16x8 kb = *(LAS bf16x8*)(Ks + (j * 16 + fr) * 72 + ks * 32 + fq * 8); acc = __builtin_amdgcn_mfma_f32_16x16x32_bf16(qa[ks], kb, acc, 0, 0, 0); }
        s[j] = acc; }
    const float sink = p.in[14][hq];
    float mx[4], inv[4];
#pragma unroll
    for (int i = 0; i < 4; ++i) { const int qi = w * 16 + fq * 4 + i + 128; float m = -3.0e38f;
#pragma unroll
        for (int j = 0; j < 16; ++j) { const int kj = j * 16 + fr; const bool ok = (kj <= qi) && (qi - kj < 128) && (nb > 0 || kj >= 128); s[j][i] = ok ? s[j][i] : -3.0e38f; m = fmaxf(m, s[j][i]); }
        m = fmaxf(m, __shfl_xor(m, 1)); m = fmaxf(m, __shfl_xor(m, 2)); m = fmaxf(m, __shfl_xor(m, 4)); m = fmaxf(m, __shfl_xor(m, 8));
        m = fmaxf(m, sink); mx[i] = m; float l = 0.f;
#pragma unroll
        for (int j = 0; j < 16; ++j) { const float e = (s[j][i] > -1.0e38f) ? __expf(s[j][i] - m) : 0.f; s[j][i] = e; l += e; }
        l += __shfl_xor(l, 1); l += __shfl_xor(l, 2); l += __shfl_xor(l, 4); l += __shfl_xor(l, 8);
        inv[i] = 1.0f / (l + __expf(sink - m)); }
#pragma unroll
    for (int j = 0; j < 16; ++j)
#pragma unroll
        for (int i = 0; i < 4; ++i) Ps[(fq * 4 + i) * 264 + j * 16 + fr] = f2bf(s[j][i] * inv[i]);
    f32x4 o[4];
#pragma unroll
    for (int nd = 0; nd < 4; ++nd) o[nd] = (f32x4){0.f, 0.f, 0.f, 0.f};
#pragma unroll
    for (int kk = 0; kk < 8; ++kk) { const bf16x8 pa = *(LAS bf16x8*)(Ps + fr * 264 + kk * 32 + fq * 8);
#pragma unroll
        for (int nd = 0; nd < 4; ++nd) { const bf16x8 vb = *(LAS bf16x8*)(Vt + (nd * 16 + fr) * 264 + kk * 32 + fq * 8); o[nd] = __builtin_amdgcn_mfma_f32_16x16x32_bf16(pa, vb, o[nd], 0, 0, 0); } }
    bf16_t* ymix = (bf16_t*)(p.ws + WS_YMIX) + (size_t)b * SEQ * D + hq * 64;
#pragma unroll
    for (int nd = 0; nd < 4; ++nd)
#pragma unroll
        for (int i = 0; i < 4; ++i) ymix[(size_t)(nb * 128 + w * 16 + fq * 4 + i) * D + nd * 16 + fr] = f2bf(o[nd][i]);
    }
}

__device__ __forceinline__ void post_ssd(const Params& p) {
    const int tid_ = opq(threadIdx.x); const int lane = tid_ & 63, wv = tid_ >> 6;
    const float* yraw = (const float*)(p.ws + WS_YRAW); const bf16_t* proj = (const bf16_t*)(p.ws + WS_PROJ); bf16_t* ymix = (bf16_t*)(p.ws + WS_YMIX);
    for (int it = blockIdx.x * 8 + wv; it < MTOK * 2; it += gridDim.x * 8) {
        const int tok = it >> 1, grp = it & 1, c = grp * 512 + lane * 8;
        const f32x4 y0 = *(const f32x4*)(yraw + (size_t)tok * 1024 + c), y1 = *(const f32x4*)(yraw + (size_t)tok * 1024 + c + 4);
        const uint4 zr = *(const uint4*)(proj + (size_t)tok * INWP + COL_Z + c); float z[8], y[8]; unpack8(zr, z); float ss = 0.f;
#pragma unroll
        for (int e = 0; e < 8; ++e) { const float yy = (e < 4 ? y0[e] : y1[e - 4]); y[e] = yy * z[e] * sigmoidf_(z[e]); ss += y[e] * y[e]; }
        ss = wave_sum(ss); const float r = rsqrtf(ss * (1.0f / 512) + 1e-6f);
        const f32x4 n0 = *(const f32x4*)(p.in[11] + c), n1 = *(const f32x4*)(p.in[11] + c + 4);
        u32x4 w; w.x = cvt_pk_nv(y[0] * r * n0[0], y[1] * r * n0[1]); w.y = cvt_pk_nv(y[2] * r * n0[2], y[3] * r * n0[3]);
        w.z = cvt_pk_nv(y[4] * r * n1[0], y[5] * r * n1[1]); w.w = cvt_pk_nv(y[6] * r * n1[2], y[7] * r * n1[3]);
        *(u32x4*)(ymix + (size_t)tok * D + 1024 + c) = w;
    }
}

__device__ __forceinline__ float half_sum(float v, bool lo) {
    v = red16(v);
    const float r0 = __builtin_bit_cast(float, __builtin_amdgcn_readlane(__builtin_bit_cast(int, v), 0)), r1 = __builtin_bit_cast(float, __builtin_amdgcn_readlane(__builtin_bit_cast(int, v), 16));
    const float r2 = __builtin_bit_cast(float, __builtin_amdgcn_readlane(__builtin_bit_cast(int, v), 32)), r3 = __builtin_bit_cast(float, __builtin_amdgcn_readlane(__builtin_bit_cast(int, v), 48));
    return lo ? (r0 + r1) : (r2 + r3); }
__device__ __forceinline__ void rwkv_scan_job(const Params& p, int job, LAS unsigned char* lds) {
    const int tid = opq(threadIdx.x), lane = tid & 63, wv = tid >> 6, l32 = lane & 31; const bool lo = lane < 32;
    const int b = job >> 5, hh = job & 31;
    const int tl = 2 * wv + (lane >> 5);
    const size_t wbase = ((size_t)b * SEQ * D + hh * 64) / 2 + l32 + (size_t)tl * (D / 2);
    const unsigned* R32 = (const unsigned*)(p.ws + WS_R) + wbase; const unsigned* K32 = (const unsigned*)(p.ws + WS_K) + wbase; const unsigned* V32 = (const unsigned*)(p.ws + WS_V) + wbase;
    const unsigned* E32 = (const unsigned*)(p.ws + WS_WDEC) + wbase; const unsigned* A32 = (const unsigned*)(p.ws + WS_AA) + wbase; const unsigned* G32 = (const unsigned*)(p.ws + WS_GG) + wbase;
    unsigned* Y32 = (unsigned*)(p.ws + WS_YG) + wbase;
    const int ci = hh * 64 + 2 * l32;
    const float2 kkw = *(const float2*)(p.in[25] + ci), kaw = *(const float2*)(p.in[26] + ci), rkw = *(const float2*)(p.in[27] + ci), lnw = *(const float2*)(p.in[32] + ci), lnb = *(const float2*)(p.in[33] + ci);
    LAS float* L = (LAS float*)lds;
    unsigned rw, kw, vw, ew, aw, gw;
    const int oo = tl * 64 + 2 * l32;
#define RW_ISSUE(t0) do { const size_t off = (size_t)(t0) * (D / 2); rw = R32[off]; kw = K32[off]; vw = V32[off]; ew = E32[off]; aw = A32[off]; gw = G32[off]; } while (0)
#define RW_COMMIT(buf) do { LAS float* Lc = L + (buf) * 8192 + oo; \
        const float r0_ = bflo(rw), r1_ = bfhi(rw), k0_ = bflo(kw), k1_ = bfhi(kw), v0_ = bflo(vw), v1_ = bfhi(vw), e0_ = bflo(ew), e1_ = bfhi(ew), a0_ = bflo(aw), a1_ = bfhi(aw), g0_ = bflo(gw), g1_ = bfhi(gw); \
        const float kkv0 = k0_ * kkw.x, kkv1 = k1_ * kkw.y; const float ssq = half_sum(kkv0 * kkv0 + kkv1 * kkv1, lo); const float rn = rsqrtf(fmaxf(ssq, 1e-24f)); const float kn0 = kkv0 * rn, kn1 = kkv1 * rn; \
        const float km0 = k0_ * (1.0f + (a0_ - 1.0f) * kaw.x), km1 = k1_ * (1.0f + (a1_ - 1.0f) * kaw.y); const float bonus = half_sum(r0_ * km0 * rkw.x + r1_ * km1 * rkw.y, lo); \
        *(LAS f32x2*)(Lc) = (f32x2){-kn0, -kn1}; *(LAS f32x2*)(Lc + 1024) = (f32x2){__expf(-e0_), __expf(-e1_)}; *(LAS f32x2*)(Lc + 2048) = (f32x2){kn0 * a0_, kn1 * a1_}; *(LAS f32x2*)(Lc + 3072) = (f32x2){km0, km1}; \
        *(LAS f32x2*)(Lc + 4096) = (f32x2){r0_, r1_}; *(LAS f32x2*)(Lc + 5120) = (f32x2){v0_, v1_}; *(LAS f32x2*)(Lc + 6144) = (f32x2){g0_, g1_}; *(LAS f32x2*)(Lc + 7168) = (f32x2){bonus * v0_, bonus * v1_}; } while (0)
    f32x2 S[4];
#pragma unroll
    for (int i = 0; i < 4; ++i) S[i] = (f32x2){0.f, 0.f};
    const int vrow = tid >> 3, ks = tid & 7;
    __syncthreads();
    RW_ISSUE(0); RW_COMMIT(0); __syncthreads();
    for (int ch = 0; ch < 128; ++ch) {
        const int cur = ch & 1;
        if (ch + 1 < 128) RW_ISSUE((ch + 1) * 16);
        LAS float* Lb = L + cur * 8192; LAS float* yb = L + 16384 + cur * 1024;
        {
            float yv[16];
            LAS float* q0 = Lb + ks * 8;
            f32x4 a0 = *(LAS f32x4*)(q0), a1 = *(LAS f32x4*)(q0 + 4), w0 = *(LAS f32x4*)(q0 + 1024), w1 = *(LAS f32x4*)(q0 + 1028), b0 = *(LAS f32x4*)(q0 + 2048), b1 = *(LAS f32x4*)(q0 + 2052);
            f32x4 k0 = *(LAS f32x4*)(q0 + 3072), k1 = *(LAS f32x4*)(q0 + 3076), r0 = *(LAS f32x4*)(q0 + 4096), r1 = *(LAS f32x4*)(q0 + 4100);
            float vv = Lb[5120 + vrow];
#pragma unroll
            for (int t = 0; t < 16; ++t) {
                f32x4 na0, na1, nw0, nw1, nb0, nb1, nk0, nk1, nr0, nr1; float nvv;
                if (t + 1 < 16) { LAS float* q = q0 + (t + 1) * 64;
                    na0 = *(LAS f32x4*)(q); na1 = *(LAS f32x4*)(q + 4); nw0 = *(LAS f32x4*)(q + 1024); nw1 = *(LAS f32x4*)(q + 1028); nb0 = *(LAS f32x4*)(q + 2048); nb1 = *(LAS f32x4*)(q + 2052);
                    nk0 = *(LAS f32x4*)(q + 3072); nk1 = *(LAS f32x4*)(q + 3076); nr0 = *(LAS f32x4*)(q + 4096); nr1 = *(LAS f32x4*)(q + 4100); nvv = Lb[5120 + (t + 1) * 64 + vrow]; }
                __builtin_amdgcn_sched_barrier(0);
                f32x2 ac = S[0] * a0.xy; ac = S[1] * a0.zw + ac; ac = S[2] * a1.xy + ac; ac = S[3] * a1.zw + ac;
                const float sa = red8(ac.x + ac.y);
                const f32x2 sa2 = (f32x2){sa, sa}, vv2 = (f32x2){vv, vv};
                S[0] = S[0] * w0.xy + (sa2 * b0.xy + vv2 * k0.xy); S[1] = S[1] * w0.zw + (sa2 * b0.zw + vv2 * k0.zw);
                S[2] = S[2] * w1.xy + (sa2 * b1.xy + vv2 * k1.xy); S[3] = S[3] * w1.zw + (sa2 * b1.zw + vv2 * k1.zw);
                f32x2 yc = S[0] * r0.xy; yc = S[1] * r0.zw + yc; yc = S[2] * r1.xy + yc; yc = S[3] * r1.zw + yc;
                yv[t] = red8(yc.x + yc.y);
                __builtin_amdgcn_sched_barrier(0);
                if (t + 1 < 16) { a0 = na0; a1 = na1; w0 = nw0; w1 = nw1; b0 = nb0; b1 = nb1; k0 = nk0; k1 = nk1; r0 = nr0; r1 = nr1; vv = nvv; }
            }
            if (ks == 0) {
#pragma unroll
                for (int t = 0; t < 16; ++t) yb[t * 64 + vrow] = yv[t]; }
        }
        if (ch + 1 < 128) RW_COMMIT(cur ^ 1);
        __syncthreads();
        { const f32x2 y = *(LAS f32x2*)(yb + oo);
          const float mu = half_sum(y.x + y.y, lo) * (1.0f / 64), d0 = y.x - mu, d1 = y.y - mu, var = half_sum(d0 * d0 + d1 * d1, lo) * (1.0f / 64), rs = rsqrtf(var + 64e-5f);
          const f32x2 bv = *(LAS f32x2*)(Lb + 7168 + oo), gg = *(LAS f32x2*)(Lb + 6144 + oo);
          Y32[(size_t)(ch * 16) * (D / 2)] = cvt_pk_nv((d0 * rs * lnw.x + lnb.x + bv.x) * gg.x, (d1 * rs * lnw.y + lnb.y + bv.y) * gg.y); }
    }
#undef RW_ISSUE
#undef RW_COMMIT
}

__global__ __launch_bounds__(512, 2) void mega(const Params p_arg) {
    extern __shared__ __attribute__((aligned(16))) unsigned char shm[];
    const Params& p = *(const Params*)(const void*)__builtin_amdgcn_kernarg_segment_ptr();
    LAS unsigned char* lds = (LAS unsigned char*)shm;
    const int G = (int)gridDim.x, bid = (int)blockIdx.x;
    for (int s = p.step_lo; s < p.step_hi; ++s) {
        const int kind = p.kind[s], lo = p.lo[s], hi = p.hi[s];
        switch (kind) {
            case K_PRE0:
#ifndef NO_PRE
 convert_tiles(p, lo, hi, lds); rope_table(p); norm_rows(p.in[0], p.in[1], (bf16_t*)(p.ws + WS_H));
#endif
 break;
            case K_GEMMB:
#ifndef NO_GB

                for (int i = lo; i < hi; ++i) { const GemmOp& o = p.g[i]; pg8::Gemm g; g.A = o.A; g.Bt = o.Bt; g.M = o.M; g.N = o.N; g.K = o.K;
                    pg8::StaticOrder S; S.init(o.M, o.N, G, (bid + G - (o.rot % G)) % G);
                    EpiB E; E.O = (bf16_t*)o.out; E.ldc = o.ldc; E.bias = o.bias; E.act = o.act;
                    pg8::gemm_phase<EpiB, pg8::StaticOrder, false>(lds, g, S, E, nullptr); }
#endif
                break;
            case K_GEMMF:
#ifndef NO_GF

                for (int i = lo; i < hi; ++i) { const GemmOp& o = p.g[i]; pg8::Gemm g; g.A = o.A; g.Bt = o.Bt; g.M = o.M; g.N = o.N; g.K = o.K;
                    pg8::StaticOrder S; S.init(o.M, o.N, G, (bid + G - (o.rot % G)) % G);
                    EpiF E; E.C = (float*)o.out; E.ldc = o.ldc; E.res = o.res;
                    pg8::gemm_phase<EpiF, pg8::StaticOrder, false>(lds, g, S, E, nullptr); }
#endif
                break;
            case K_CONVSSD:
#ifndef NO_CONV
 conv_ssd(p);
#endif
 break;
            case K_MIX0:

#ifndef NO_SSD
for (int j = bid; j < 256; j += G) ssd_scan_job(p, j, lds);
#endif


#ifndef NO_ATT
for (int j = bid; j < 512; j += G) attn_job(p, j, lds);
#endif

                break;
            case K_POST0: post_ssd(p); break;
            case K_NORM: norm_rows(p.out, p.in[2] + lo * D, (bf16_t*)(p.ws + WS_H)); break;
            case K_PRE1: convert_tiles(p, lo, hi, lds); mix_rows(p.out, p.in[1] + D, p.in[16], (bf16_t*)(p.ws + WS_MIX), 0, lds); break;
            case K_MIXES: mix_rows(p.out, p.in[1] + D, p.in[16], (bf16_t*)(p.ws + WS_MIX), 8192, lds); break;
            case K_RWKV:
#ifndef NO_RWKV
 for (int j = bid; j < 256; j += G) rwkv_scan_job(p, j, lds);
#endif
 break;
            case K_NORMCONV: convert_tiles(p, lo, hi, lds); norm_rows(p.out, p.in[2] + D, (bf16_t*)(p.ws + WS_H)); break;
            default: break;
        }
        if (s + 1 < p.step_hi) cg::this_grid().sync();
    }
}

#ifndef MK_MULTI
#define MK_MULTI 0
#endif
extern "C" void kernel_launch(void* const* d_in, const int* in_sizes, int n_in, void* d_out, int out_size, void* d_ws, size_t ws_size, hipStream_t stream) {
    static int grid = 0;
    if (grid == 0) {
        int dev = 0, cus = 0, per_cu = 0;
        hipGetDevice(&dev); hipDeviceGetAttribute(&cus, hipDeviceAttributeMultiprocessorCount, dev);
        if (hipFuncSetAttribute((const void*)mega, hipFuncAttributeMaxDynamicSharedMemorySize, LDS_BYTES) != hipSuccess) { fprintf(stderr, "hipFuncSetAttribute failed\n"); grid = -1; return; }
        if (hipOccupancyMaxActiveBlocksPerMultiprocessor(&per_cu, (const void*)mega, 512, LDS_BYTES) != hipSuccess || per_cu < 1) { fprintf(stderr, "occupancy query: %d\n", per_cu); per_cu = 1; }
        (void)hipGetLastError();
        grid = cus * per_cu; if (grid > 256) grid = 256;
        if (n_in != 34 || ws_size < 512 * MiB) { fprintf(stderr, "unexpected n_in %d / ws %zu\n", n_in, ws_size); grid = -1; return; }
    }
    if (grid < 0) return;
    static Params p;
    memset(&p, 0, sizeof(p));
    for (int i = 0; i < 34; ++i) p.in[i] = (const float*)d_in[i];
    p.out = (float*)d_out; p.ws = (unsigned char*)d_ws;
    unsigned char* ws = (unsigned char*)d_ws;
    auto B16 = [&](size_t off) { return (bf16_t*)(ws + off); };
    int ncj = 0, tile_acc = 0;
    auto CJ = [&](const float* src, size_t dst_off, int K, int N, int Kpad, int Npad) { ConvJob& c = p.cj[ncj++]; c.src = src; c.dst = B16(dst_off); c.K = K; c.N = N; c.Kpad = Kpad; c.Npad = Npad; c.tile0 = tile_acc; c.ntiles = (Kpad / 64) * (Npad / 256); tile_acc += c.ntiles; };
    const float* w_up = p.in[3]; const float* w_down = p.in[4];
    tile_acc = 0;
    CJ(p.in[5], WS_WBA, 2048, 4112, 2048, 4352); CJ(p.in[15], WS_WBA + 17 * MiB, 2048, 2048, 2048, 2048);
    CJ(w_up, WS_WMLP, 2048, 8192, 2048, 8192); CJ(w_down, WS_WMLP + 32 * MiB, 8192, 2048, 8192, 2048);
    tile_acc = 0;
    CJ(p.in[28], WS_WBA, 2048, 2048, 2048, 2048); CJ(p.in[29], WS_WBA + 8 * MiB, 2048, 2048, 2048, 2048); CJ(p.in[30], WS_WBA + 16 * MiB, 2048, 2048, 2048, 2048); CJ(p.in[31], WS_WBA + 24 * MiB, 2048, 2048, 2048, 2048);
    CJ(p.in[18], WS_WBA + 32 * MiB, 2048, 96, 2048, 256); CJ(p.in[21], WS_WBA + 33 * MiB, 2048, 96, 2048, 256); CJ(p.in[23], WS_WBA + 34 * MiB, 2048, 256, 2048, 256);
    CJ(p.in[19], WS_WBA + 35 * MiB, 96, 2048, 256, 2048); CJ(p.in[22], WS_WBA + 36 * MiB, 96, 2048, 256, 2048); CJ(p.in[24], WS_WBA + 37 * MiB, 256, 2048, 256, 2048);
    tile_acc = 0;
    CJ(w_up + (size_t)2048 * 8192, WS_WMLP, 2048, 8192, 2048, 8192); CJ(w_down + (size_t)2048 * 8192, WS_WMLP + 32 * MiB, 8192, 2048, 8192, 2048);
    int nop = 0;
    auto GO = [&](const bf16_t* A, const bf16_t* Bt, void* out, const float* bias, const float* res, int M, int N, int K, int ldc, int act, int rot) {
        GemmOp& o = p.g[nop++]; o.A = A; o.Bt = Bt; o.out = out; o.bias = bias; o.res = res; o.M = M; o.N = N; o.K = K; o.ldc = ldc; o.act = act; o.rot = rot; };
    GO(B16(WS_H), B16(WS_WBA), B16(WS_PROJ), nullptr, nullptr, MTOK, INWP, 2048, INWP, 0, 0);
    GO(B16(WS_YMIX), B16(WS_WBA + 17 * MiB), d_out, nullptr, p.in[0], MTOK, 2048, 2048, 2048, 0, 0);
    GO(B16(WS_H), B16(WS_WMLP), B16(WS_U), nullptr, nullptr, MTOK, DFF, 2048, DFF, 1, 0);
    GO(B16(WS_U), B16(WS_WMLP + 32 * MiB), d_out, nullptr, (const float*)d_out, MTOK, 2048, DFF, 2048, 0, 0);
    for (int half = 0; half < 2; ++half) {
        const size_t ro = (size_t)half * 8192 * 2048 * 2, lo_ = (size_t)half * 8192 * 256 * 2; const size_t mb = (size_t)8192 * 2048 * 2;
        GO(B16(WS_MIX + 0 * mb), B16(WS_WBA), B16(WS_R + ro), nullptr, nullptr, 8192, 2048, 2048, 2048, 0, 0);
        GO(B16(WS_MIX + 2 * mb), B16(WS_WBA + 8 * MiB), B16(WS_K + ro), nullptr, nullptr, 8192, 2048, 2048, 2048, 0, 0);
        GO(B16(WS_MIX + 3 * mb), B16(WS_WBA + 16 * MiB), B16(WS_V + ro), nullptr, nullptr, 8192, 2048, 2048, 2048, 0, 0);
        GO(B16(WS_MIX + 1 * mb), B16(WS_WBA + 32 * MiB), B16(WS_L1W + lo_), nullptr, nullptr, 8192, 256, 2048, 256, 2, 0);
        GO(B16(WS_MIX + 4 * mb), B16(WS_WBA + 33 * MiB), B16(WS_L1A + lo_), nullptr, nullptr, 8192, 256, 2048, 256, 0, 32);
        GO(B16(WS_MIX + 5 * mb), B16(WS_WBA + 34 * MiB), B16(WS_L1G + lo_), nullptr, nullptr, 8192, 256, 2048, 256, 3, 64);
    }
    GO(B16(WS_L1W), B16(WS_WBA + 35 * MiB), B16(WS_WDEC), p.in[17], nullptr, MTOK, 2048, 256, 2048, 4, 0);
    GO(B16(WS_L1A), B16(WS_WBA + 36 * MiB), B16(WS_AA), p.in[20], nullptr, MTOK, 2048, 256, 2048, 3, 0);
    GO(B16(WS_L1G), B16(WS_WBA + 37 * MiB), B16(WS_GG), nullptr, nullptr, MTOK, 2048, 256, 2048, 0, 0);
    GO(B16(WS_YG), B16(WS_WBA + 24 * MiB), d_out, nullptr, (const float*)d_out, MTOK, 2048, 2048, 2048, 0, 0);
    GO(B16(WS_H), B16(WS_WMLP), B16(WS_U), nullptr, nullptr, MTOK, DFF, 2048, DFF, 1, 0);
    GO(B16(WS_U), B16(WS_WMLP + 32 * MiB), d_out, nullptr, (const float*)d_out, MTOK, 2048, DFF, 2048, 0, 0);
    int ns = 0;
    auto ST = [&](int kind, int lo, int hi) { int rep = 1; if (kind == K_GEMMB) rep = REP_GEMMB; else if (kind == K_MIX0) rep = REP_MIX0; else if (kind == K_RWKV) rep = REP_RWKV; else if (kind != K_GEMMF) rep = REP_ELEM;
        for (int r = 0; r < rep; ++r) { p.kind[ns] = kind; p.lo[ns] = lo; p.hi[ns] = hi; ++ns; } };
    ST(K_PRE0, 0, 4); ST(K_GEMMB, 0, 1); ST(K_CONVSSD, 0, 0); ST(K_MIX0, 0, 0); ST(K_POST0, 0, 0); ST(K_GEMMF, 1, 2); ST(K_NORM, 0, 0); ST(K_GEMMB, 2, 3); ST(K_GEMMF, 3, 4);
    ST(K_PRE1, 4, 14); ST(K_GEMMB, 4, 10); ST(K_MIXES, 0, 0); ST(K_GEMMB, 10, 16); ST(K_GEMMB, 16, 19); ST(K_RWKV, 0, 0); ST(K_GEMMF, 19, 20); ST(K_NORMCONV, 14, 16); ST(K_GEMMB, 20, 21); ST(K_GEMMF, 21, 22);
#if MK_MULTI
    for (int s = 0; s < ns; ++s) { p.step_lo = s; p.step_hi = s + 1; hipLaunchKernelGGL(mega, dim3(grid), dim3(512), LDS_BYTES, stream, p); }
#else
    p.step_lo = 0; p.step_hi = ns;
    void* args[] = {(void*)&p};
    const hipError_t e = hipLaunchCooperativeKernel((const void*)mega, dim3(grid), dim3(512), args, LDS_BYTES, stream);
    if (e != hipSuccess) fprintf(stderr, "cooperative launch failed: %s (grid %d)\n", hipGetErrorString(e), grid);
#endif
}
```

```cpp
#include <hip/hip_runtime.h>
#include <hip/hip_cooperative_groups.h>
#include <cstdio>
#include <cstring>
namespace cg = cooperative_groups;
__device__ __forceinline__ int opq(int v) { asm volatile("" : "+v"(v)); return v; }
namespace pg8 {
#define PG8_LAS __attribute__((address_space(3)))
typedef unsigned short bf16_t;
typedef short bf16x8 __attribute__((ext_vector_type(8)));
typedef float f32x4 __attribute__((ext_vector_type(4)));
typedef unsigned u32x4 __attribute__((ext_vector_type(4)));
constexpr int BM = 256, BK = 64, HALF = 128, HTB = HALF * BK * 2  , STAGE_BYTES = 8 * HTB, NXCD = 8, WGM = 8;

__host__ __device__ __forceinline__ int lds_byte(int r, int c) { const int st = (r >> 4) * 2 + (c >> 5), rr = r & 15, cc = c & 31, ob = rr * 64 + cc * 2; return st * 1024 + (ob ^ (((ob >> 9) & 1) << 5)); }
__host__ __device__ __forceinline__ void stage_rc(int b, int& R, int& C) { const int st = b / 1024, sb = b % 1024, swz = sb ^ (((sb >> 9) & 1) << 5); R = (st >> 1) * 16 + swz / 64; C = (st & 1) * 32 + (swz % 64) / 2; }
__host__ __device__ __forceinline__ int perm32(int rho) { const int n = rho >> 4, i = rho & 15; return 8 * (i >> 2) + 4 * n + (i & 3); }

struct Unit { int pm, pn; };
struct Gemm { const bf16_t* A; const bf16_t* Bt; int M, N, K; };

struct StaticOrder {
    int nM, nN, nwg, G, c;
    __host__ __device__ void init(int M, int N, int G_, int c_) { nM = M / BM; nN = N / BM; nwg = nM * nN; G = G_; c = c_; }
    __host__ __device__ bool next(int i, Unit& u) const {
        const long L = (long)i * G + c; if (L >= nwg) return false;
        int wgid = (int)L; { const int q = nwg / NXCD, r = nwg % NXCD, xcd = wgid % NXCD, off = wgid / NXCD; wgid = (xcd < r ? xcd * (q + 1) : r * (q + 1) + (xcd - r) * q) + off; }
        const int nig = WGM * nN, gid = wgid / nig, fm = gid * WGM, gsz = (nM - fm) < WGM ? (nM - fm) : WGM;
        u.pm = fm + ((wgid % nig) % gsz); u.pn = (wgid % nig) / gsz; return true;
    }
    __device__ __forceinline__ void a_ready(const Unit&) const {}
    __device__ __forceinline__ void done(const Unit&) const {}
};
typedef __bf16 bf16x2_t __attribute__((ext_vector_type(2)));
typedef float f32x2_t __attribute__((ext_vector_type(2)));
__device__ __forceinline__ unsigned cvt_pk_bf16(float lo, float hi) { const f32x2_t f = {lo, hi}; const bf16x2_t v = __builtin_convertvector(f, bf16x2_t); return __builtin_bit_cast(unsigned, v); }
__device__ __forceinline__ unsigned cvt_pk_nv(float lo, float hi) { return cvt_pk_bf16(lo, hi); }

template <class Epi, class Sched, bool STAMP = false>
__device__ __forceinline__ void gemm_phase(PG8_LAS unsigned char* lds, const Gemm g, const Sched& S, const Epi& E, unsigned long long* stamps) {
    const int tid = opq(threadIdx.x), wid = __builtin_amdgcn_readfirstlane(tid >> 6), lane = tid & 63, wr = wid >> 2, wc = wid & 3, fr = lane & 15, fq = lane >> 4;
    const int K = g.K, nt = K / BK;
    int ts_lo = 0, ts_hi = 0, nts = 0; const unsigned long long rt_entry = STAMP ? (unsigned long long)wall_clock64() : 0ull;
#define PG8_STAMP() do { if (STAMP && wid == 0 && nts < 64) { const unsigned long long _c = (unsigned long long)clock64(); \
        ts_lo = (lane == nts) ? (int)(unsigned)_c : ts_lo; ts_hi = (lane == nts) ? (int)(unsigned)(_c >> 32) : ts_hi; ++nts; } } while (0)
    PG8_STAMP();
    unsigned voffA[2], voffB[2];
#pragma unroll
    for (int i = 0; i < 2; ++i) { int R, C; stage_rc(tid * 16 + i * 8192, R, C); const int Rb = Epi::PERM ? ((R & ~31) + perm32(R & 31)) : R;
        voffA[i] = (unsigned)(R * K + C) * 2u; voffB[i] = (unsigned)(Rb * K + C) * 2u; }
    const size_t kstep = (size_t)(BK * 2);
    const size_t hstep = (size_t)HALF * K * 2;
    const size_t tstep = 2 * hstep;
    const unsigned ldsw = (unsigned)wid * 1024u;
    const int aoff = lds_byte(wr * 64 + fr, fq * 8), boff = lds_byte(wc * 32 + fr, fq * 8);
#define PG8_SA(b, h) (((b) * 2 + (h)) * HTB)
#define PG8_SB(b, h) ((4 + (b) * 2 + (h)) * HTB)
#define PG8_STAGE(bufoff, gbase, voff) do { _Pragma("unroll") for (int _i = 0; _i < 2; ++_i) \
        __builtin_amdgcn_global_load_lds((const unsigned*)((const char*)(gbase) + (voff)[_i]), (PG8_LAS unsigned*)(lds + (bufoff) + ldsw + _i * 8192), 16, 0, 0); } while (0)
#define PG8_LDA(dst, b, h) do { _Pragma("unroll") for (int m = 0; m < 4; ++m) _Pragma("unroll") for (int k = 0; k < 2; ++k) dst[m][k] = *(const PG8_LAS bf16x8*)(lds + PG8_SA(b, h) + aoff + m * 2048 + k * 1024); } while (0)
#define PG8_LDB(dst, b, h) do { _Pragma("unroll") for (int n = 0; n < 2; ++n) _Pragma("unroll") for (int k = 0; k < 2; ++k) dst[n][k] = *(const PG8_LAS bf16x8*)(lds + PG8_SB(b, h) + boff + n * 2048 + k * 1024); } while (0)
#define PG8_MMA(ai, bj, At, Bt) do { __builtin_amdgcn_s_setprio(1); _Pragma("unroll") for (int m = 0; m < 4; ++m) _Pragma("unroll") for (int n = 0; n < 2; ++n) _Pragma("unroll") for (int k = 0; k < 2; ++k) \
        acc[ai][bj][m][n] = __builtin_amdgcn_mfma_f32_16x16x32_bf16(Bt[n][k], At[m][k], acc[ai][bj][m][n], 0, 0, 0); __builtin_amdgcn_s_setprio(0); } while (0)
#define PG8_WAIT_V(n) asm volatile("s_waitcnt vmcnt(" #n ")" ::: "memory")
#define PG8_WAIT_L(n) asm volatile("s_waitcnt lgkmcnt(" #n ")" ::: "memory")
#define PG8_BAR __builtin_amdgcn_s_barrier()
#define PG8_SCHED __builtin_amdgcn_sched_barrier(0)
    Unit cur, nxt; int ui = 0;
    if (!S.next(0, cur)) return;
    f32x4 acc[2][2][4][2];
#pragma unroll
    for (int a = 0; a < 2; ++a)
#pragma unroll
        for (int b = 0; b < 2; ++b)
#pragma unroll
            for (int m = 0; m < 4; ++m)
#pragma unroll
                for (int n = 0; n < 2; ++n) acc[a][b][m][n] = (f32x4){0.f, 0.f, 0.f, 0.f};
    bf16x8 At[4][2], B0[2][2], B1[2][2];
    const char* cA = (const char*)g.A + (size_t)cur.pm * tstep; const char* cB = (const char*)g.Bt + (size_t)cur.pn * tstep;
    S.a_ready(cur);
    PG8_STAGE(PG8_SB(0, 0), cB, voffB); PG8_STAGE(PG8_SA(0, 0), cA, voffA); PG8_STAGE(PG8_SB(0, 1), cB + hstep, voffB); PG8_STAGE(PG8_SA(0, 1), cA + hstep, voffA);
    if (wr == 1) PG8_BAR;
    PG8_WAIT_V(4); PG8_BAR;
    PG8_STAGE(PG8_SB(1, 0), cB + kstep, voffB); PG8_STAGE(PG8_SA(1, 0), cA + kstep, voffA); PG8_STAGE(PG8_SB(1, 1), cB + hstep + kstep, voffB);
    PG8_WAIT_V(6); PG8_BAR;
    PG8_STAMP();
    for (;;) {
        const bool has_next = S.next(ui + 1, nxt);
        const char* nA = has_next ? (const char*)g.A + (size_t)nxt.pm * tstep : cA; const char* nB = has_next ? (const char*)g.Bt + (size_t)nxt.pn * tstep : cB;
        for (int t = 0; t < nt; t += 2) {
            const bool last = (t == nt - 2);
            const char* a1 = cA + (size_t)(t + 1) * kstep;
            const char* a2 = last ? nA : cA + (size_t)(t + 2) * kstep; const char* b2 = last ? nB : cB + (size_t)(t + 2) * kstep;
            const char* a3 = a2 + kstep; const char* b3 = b2 + kstep;
            if (last && has_next) S.a_ready(nxt);
            PG8_LDB(B0, 0, 0); PG8_SCHED; PG8_LDA(At, 0, 0); PG8_STAGE(PG8_SA(1, 1), a1 + hstep, voffA);
            PG8_WAIT_L(8); PG8_BAR; PG8_WAIT_L(0); PG8_MMA(0, 0, At, B0); PG8_BAR; PG8_SCHED;
            PG8_LDB(B1, 0, 1); PG8_STAGE(PG8_SB(0, 0), b2, voffB);
            PG8_BAR; PG8_WAIT_L(0); PG8_MMA(0, 1, At, B1); PG8_BAR;
            PG8_LDA(At, 0, 1); PG8_STAGE(PG8_SA(0, 0), a2, voffA);
            PG8_BAR; PG8_WAIT_L(0); PG8_MMA(1, 0, At, B0); PG8_BAR; PG8_SCHED;
            PG8_STAGE(PG8_SB(0, 1), b2 + hstep, voffB);
            PG8_WAIT_V(6); PG8_BAR; PG8_MMA(1, 1, At, B1); PG8_BAR;
            PG8_LDB(B0, 1, 0); PG8_SCHED; PG8_LDA(At, 1, 0); PG8_STAGE(PG8_SA(0, 1), a2 + hstep, voffA);
            PG8_WAIT_L(8); PG8_BAR; PG8_WAIT_L(0); PG8_MMA(0, 0, At, B0); PG8_BAR; PG8_SCHED;
            PG8_LDB(B1, 1, 1); PG8_STAGE(PG8_SB(1, 0), b3, voffB);
            PG8_BAR; PG8_WAIT_L(0); PG8_MMA(0, 1, At, B1); PG8_BAR;
            PG8_LDA(At, 1, 1); PG8_STAGE(PG8_SA(1, 0), a3, voffA);
            PG8_BAR; PG8_WAIT_L(0); PG8_MMA(1, 0, At, B0); PG8_BAR; PG8_SCHED;
            PG8_STAGE(PG8_SB(1, 1), b3 + hstep, voffB);
            PG8_WAIT_V(6); PG8_BAR; PG8_MMA(1, 1, At, B1); PG8_BAR;
        }
        PG8_STAMP();
        if constexpr (!Epi::AFTER_DRAIN) { E(acc, cur, wr, wc, fr, fq); S.done(cur); }
        PG8_STAMP();
        if (!has_next) break;
#pragma unroll
        for (int a = 0; a < 2; ++a)
#pragma unroll
            for (int b = 0; b < 2; ++b)
#pragma unroll
                for (int m = 0; m < 4; ++m)
#pragma unroll
                    for (int n = 0; n < 2; ++n) acc[a][b][m][n] = (f32x4){0.f, 0.f, 0.f, 0.f};
        cur = nxt; cA = nA; cB = nB; ++ui;
    }
    PG8_WAIT_V(0);
    if (wr == 0) PG8_BAR;
    PG8_BAR;
    if constexpr (Epi::AFTER_DRAIN) { E.fused(acc, cur, wr, wc, fr, fq, lds, wid, lane); S.done(cur); }
    PG8_STAMP();
    if (STAMP && wid == 0) { stamps[lane] = lane < nts ? (((unsigned long long)(unsigned)ts_hi << 32) | (unsigned)ts_lo) : 0ull;
        if (lane == 62) stamps[62] = rt_entry; if (lane == 63) stamps[63] = (unsigned long long)wall_clock64(); }
#undef PG8_STAMP
#undef PG8_SA
#undef PG8_SB
#undef PG8_STAGE
#undef PG8_LDA
#undef PG8_LDB
#undef PG8_MMA
#undef PG8_WAIT_V
#undef PG8_WAIT_L
#undef PG8_BAR
#undef PG8_SCHED
}
}

#include <cstdio>
#include <ctime>
#include <cstdlib>
#include <cstring>
#include <cmath>
#include <vector>
#include <algorithm>
#define CK(x) do { hipError_t e_ = (x); if (e_ != hipSuccess) { fprintf(stderr, "HIP %s:%d %s\n", __FILE__, __LINE__, hipGetErrorString(e_)); exit(2); } } while (0)
using pg8::bf16_t; using pg8::bf16x8; using pg8::f32x4; using pg8::u32x4; using pg8::cvt_pk_bf16; using pg8::cvt_pk_nv;
#define LAS PG8_LAS

constexpr int D = 2048, SEQ = 2048, MTOK = 16384, DFF = 8192, INWP = 4352;
constexpr int COL_K = 1024, COL_V = 1280, COL_Z = 1536, COL_XBC = 2560, COL_DT = 4096;
constexpr size_t MiB = (size_t)1 << 20;
constexpr size_t WS_WBA = 0, WS_WMLP = 40 * MiB, WS_H = 104 * MiB, WS_PROJ = 168 * MiB, WS_YMIX = 304 * MiB, WS_YRAW = 368 * MiB, WS_XBC = 432 * MiB,
                 WS_DT = 480 * MiB, WS_DA = 481 * MiB, WS_ROPE = 482 * MiB, WS_U = 168 * MiB;
constexpr size_t WS_R = 40 * MiB, WS_K = 104 * MiB, WS_V = 168 * MiB, WS_L1W = 232 * MiB, WS_L1A = 240 * MiB, WS_L1G = 248 * MiB, WS_MIX = 256 * MiB,
                 WS_WDEC = 256 * MiB, WS_AA = 320 * MiB, WS_GG = 384 * MiB, WS_YG = 448 * MiB;
constexpr int LDS_BYTES = 140 * 1024;

enum { K_PRE0 = 0, K_GEMMB, K_GEMMF, K_CONVSSD, K_MIX0, K_POST0, K_NORM, K_PRE1, K_MIXES, K_RWKV, K_NORMCONV };
constexpr int NSTEPS = 48, NOPS = 22, NCJ = 16;
#define REP_GEMMB 1
#define REP_MIX0 1
#define REP_RWKV 1
#define REP_ELEM 1

struct GemmOp { const bf16_t* A; const bf16_t* Bt; void* out; const float* bias; const float* res; int M, N, K, ldc, act, rot, pad0, pad1; };
struct ConvJob { const float* src; bf16_t* dst; int K, N, Kpad, Npad, tile0, ntiles; };
struct Params {
    const float* in[34];
    float* out; unsigned char* ws;
    GemmOp g[NOPS];
    ConvJob cj[NCJ];
    int kind[NSTEPS + 1]; int lo[NSTEPS + 1]; int hi[NSTEPS + 1];
    int step_lo, step_hi;
};

__device__ __forceinline__ float bf2f(unsigned short b) { return __uint_as_float(((unsigned)b) << 16); }
__device__ __forceinline__ float bflo(unsigned w) { return __uint_as_float(w << 16); }
__device__ __forceinline__ float bfhi(unsigned w) { return __uint_as_float(w & 0xffff0000u); }
__device__ __forceinline__ bf16_t f2bf(float f) { return (bf16_t)(cvt_pk_bf16(f, 0.f) & 0xffffu); }
template <int CTRL> __device__ __forceinline__ float dpp_add(float x) {
    const int y = __builtin_amdgcn_update_dpp(0, __builtin_bit_cast(int, x), CTRL, 0xf, 0xf, true);
    return x + __builtin_bit_cast(float, y); }
__device__ __forceinline__ float red8(float x) { x = dpp_add<0xB1>(x); x = dpp_add<0x4E>(x); x = dpp_add<0x141>(x); return x; }
__device__ __forceinline__ float red16(float x) { x = red8(x); x = dpp_add<0x140>(x); return x; }
__device__ __forceinline__ float wave_sum(float v) {
    v = red16(v);
    const float r0 = __builtin_bit_cast(float, __builtin_amdgcn_readlane(__builtin_bit_cast(int, v), 0)), r1 = __builtin_bit_cast(float, __builtin_amdgcn_readlane(__builtin_bit_cast(int, v), 16));
    const float r2 = __builtin_bit_cast(float, __builtin_amdgcn_readlane(__builtin_bit_cast(int, v), 32)), r3 = __builtin_bit_cast(float, __builtin_amdgcn_readlane(__builtin_bit_cast(int, v), 48));
    return (r0 + r1) + (r2 + r3); }
typedef float f32x2 __attribute__((ext_vector_type(2)));
__device__ __forceinline__ float sigmoidf_(float v) { return 1.0f / (1.0f + __expf(-v)); }
__device__ __forceinline__ void unpack8(const uint4 r, float (&f)[8]) {
    f[0] = bflo(r.x); f[1] = bfhi(r.x); f[2] = bflo(r.y); f[3] = bfhi(r.y); f[4] = bflo(r.z); f[5] = bfhi(r.z); f[6] = bflo(r.w); f[7] = bfhi(r.w); }

__device__ __forceinline__ float act_apply(float v, int act) {
    switch (act) {
        case 1: { const float r = fmaxf(v, 0.f); return r * r; }
        case 2: return 1.0f - 2.0f / (1.0f + __expf(2.0f * v));
        case 3: return sigmoidf_(v);
        case 4: return 0.60653066f * sigmoidf_(v);
        default: return v; }
}
struct EpiB {
    static constexpr bool PERM = true, AFTER_DRAIN = false;
    bf16_t* O; int ldc; const float* bias; int act;
    __device__ __forceinline__ void operator()(const f32x4 (&acc)[2][2][4][2], const pg8::Unit& u, int wr, int wc, int fr, int fq) const {
        const int row0 = u.pm * 256 + wr * 64 + fr, col0 = u.pn * 256 + wc * 32 + 8 * fq;
        f32x4 bv[2][2];
#pragma unroll
        for (int bj = 0; bj < 2; ++bj)
#pragma unroll
            for (int n = 0; n < 2; ++n) bv[bj][n] = bias ? *(const f32x4*)(bias + col0 + bj * 128 + 4 * n) : (f32x4){0.f, 0.f, 0.f, 0.f};
#pragma unroll
        for (int ai = 0; ai < 2; ++ai)
#pragma unroll
            for (int m = 0; m < 4; ++m) { bf16_t* rowp = O + (size_t)(row0 + ai * 128 + m * 16) * ldc + col0;
#pragma unroll
                for (int bj = 0; bj < 2; ++bj) { f32x4 v0 = acc[ai][bj][m][0] + bv[bj][0], v1 = acc[ai][bj][m][1] + bv[bj][1];
                    if (act) {
#pragma unroll
                        for (int j = 0; j < 4; ++j) { v0[j] = act_apply(v0[j], act); v1[j] = act_apply(v1[j], act); } }
                    u32x4 w; w.x = cvt_pk_bf16(v0[0], v0[1]); w.y = cvt_pk_bf16(v0[2], v0[3]); w.z = cvt_pk_bf16(v1[0], v1[1]); w.w = cvt_pk_bf16(v1[2], v1[3]);
                    *(u32x4*)(rowp + bj * 128) = w; } }
    }
};
struct EpiF {
    static constexpr bool PERM = false, AFTER_DRAIN = false;
    float* C; int ldc; const float* res;
    __device__ __forceinline__ void operator()(const f32x4 (&acc)[2][2][4][2], const pg8::Unit& u, int wr, int wc, int fr, int fq) const {
        const int row0 = u.pm * 256 + wr * 64 + fr, col0 = u.pn * 256 + wc * 32 + 4 * fq;
#pragma unroll
        for (int ai = 0; ai < 2; ++ai)
#pragma unroll
            for (int m = 0; m < 4; ++m) { const size_t ro = (size_t)(row0 + ai * 128 + m * 16) * ldc + col0;
#pragma unroll
                for (int bj = 0; bj < 2; ++bj)
#pragma unroll
                    for (int n = 0; n < 2; ++n) { const f32x4 r = *(const f32x4*)(res + ro + bj * 128 + n * 16); *(f32x4*)(C + ro + bj * 128 + n * 16) = acc[ai][bj][m][n] + r; } }
    }
};

__device__ __forceinline__ void convert_tiles(const Params& p, int jlo, int jhi, LAS unsigned char* lds) {
    const int tid = opq(threadIdx.x); LAS float* T = (LAS float*)lds;
    const int total = p.cj[jhi - 1].tile0 + p.cj[jhi - 1].ntiles;
    for (int tile = blockIdx.x; tile < total; tile += gridDim.x) {
        int j = jlo; while (j + 1 < jhi && tile >= p.cj[j + 1].tile0) ++j;
        const float* src = p.cj[j].src; bf16_t* dst = p.cj[j].dst; const int K = p.cj[j].K, N = p.cj[j].N, Kpad = p.cj[j].Kpad;
        const int local = tile - p.cj[j].tile0, nkt = Kpad >> 6, kt = local % nkt, nt = local / nkt;
        f32x4 v[8];
#pragma unroll
        for (int i = 0; i < 8; ++i) { const int idx = tid + i * 512, kr = idx >> 6, c4 = idx & 63, k = kt * 64 + kr, n = nt * 256 + c4 * 4;
            v[i] = (f32x4){0.f, 0.f, 0.f, 0.f};
            if (k < K && n < N) v[i] = *(const f32x4*)(src + (size_t)k * N + n); }
#pragma unroll
        for (int i = 0; i < 8; ++i) { const int idx = tid + i * 512, kr = idx >> 6, c4 = idx & 63;
            T[kr * 257 + c4 * 4 + 0] = v[i][0]; T[kr * 257 + c4 * 4 + 1] = v[i][1]; T[kr * 257 + c4 * 4 + 2] = v[i][2]; T[kr * 257 + c4 * 4 + 3] = v[i][3]; }
        __syncthreads();
#pragma unroll
        for (int i = 0; i < 4; ++i) { const int idx = tid + i * 512, nl = idx >> 3, kc = idx & 7; float f[8];
#pragma unroll
            for (int e = 0; e < 8; ++e) f[e] = T[(kc * 8 + e) * 257 + nl];
            u32x4 w; w.x = cvt_pk_nv(f[0], f[1]); w.y = cvt_pk_nv(f[2], f[3]); w.z = cvt_pk_nv(f[4], f[5]); w.w = cvt_pk_nv(f[6], f[7]);
            *(u32x4*)(dst + (size_t)(nt * 256 + nl) * Kpad + kt * 64 + kc * 8) = w; }
        __syncthreads();
    }
}

__device__ __forceinline__ void rope_table(const Params& p) {
    float2* tab = (float2*)(p.ws + WS_ROPE);
    for (int idx = blockIdx.x * 512 + opq(threadIdx.x); idx < SEQ * 32; idx += gridDim.x * 512) {
        const int t = idx >> 5, i = idx & 31;
        const float inv = exp2f(-(float)i * 0.41524101186092029f);
        const float angf = (float)t * inv;
        const double ang = (double)angf;
        const double q = rint(ang * 0.6366197723675814);
        const double f = fma(-q, 1.5707963267948966, ang), f2 = f * f;
        const double s = f * (1.0 + f2 * (-1.0 / 6 + f2 * (1.0 / 120 + f2 * (-1.0 / 5040 + f2 * (1.0 / 362880 + f2 * (-1.0 / 39916800))))));
        const double c = 1.0 + f2 * (-0.5 + f2 * (1.0 / 24 + f2 * (-1.0 / 720 + f2 * (1.0 / 40320 + f2 * (-1.0 / 3628800 + f2 * (1.0 / 479001600))))));
        const int qi = ((int)q) & 3;
        const double sn = (qi == 0) ? s : (qi == 1) ? c : (qi == 2) ? -s : -c;
        const double cs = (qi == 0) ? c : (qi == 1) ? -s : (qi == 2) ? -c : s;
        tab[idx] = make_float2((float)cs, (float)sn);
    }
}

__device__ __forceinline__ void norm_rows(const float* x, const float* g, bf16_t* h) {
    const int tid_ = opq(threadIdx.x); const int lane = tid_ & 63, wv = tid_ >> 6;
    f32x4 gg[8];
#pragma unroll
    for (int i = 0; i < 8; ++i) gg[i] = *(const f32x4*)(g + i * 256 + lane * 4);
    for (int row = blockIdx.x * 8 + wv; row < MTOK; row += gridDim.x * 8) {
        const float* xr = x + (size_t)row * D; f32x4 v[8]; float ss = 0.f;
#pragma unroll
        for (int i = 0; i < 8; ++i) v[i] = *(const f32x4*)(xr + i * 256 + lane * 4);
#pragma unroll
        for (int i = 0; i < 8; ++i) ss += v[i][0] * v[i][0] + v[i][1] * v[i][1] + v[i][2] * v[i][2] + v[i][3] * v[i][3];
        ss = wave_sum(ss); const float r = rsqrtf(ss * (1.0f / D) + 1e-6f);
#pragma unroll
        for (int i = 0; i < 8; ++i) {
            uint2 w; w.x = cvt_pk_nv(v[i][0] * r * gg[i][0], v[i][1] * r * gg[i][1]); w.y = cvt_pk_nv(v[i][2] * r * gg[i][2], v[i][3] * r * gg[i][3]);
            *(uint2*)(h + (size_t)row * D + i * 256 + lane * 4) = w; }
    }
}

__device__ __forceinline__ void mix_rows(const float* x, const float* g, const float* mixw, bf16_t* mixbase, int tok0, LAS unsigned char* lds) {
    const int tid = opq(threadIdx.x), lane = tid & 63, wv = tid >> 6, c = tid * 4;
    LAS float* rs = (LAS float*)lds;
    const f32x4 gg = *(const f32x4*)(g + c); f32x4 mw[6];
#pragma unroll
    for (int m = 0; m < 6; ++m) mw[m] = *(const f32x4*)(mixw + m * D + c);
    for (int chunk = blockIdx.x; chunk < 256; chunk += gridDim.x) {
        const int rl0 = chunk * 32, tokc = tok0 + rl0; const bool hasprev = (tokc & (SEQ - 1)) != 0;
        __syncthreads();
        for (int r = wv; r < 33; r += 8) {
            float ss = 0.f;
            if (r > 0 || hasprev) { const float* xr = x + (size_t)(tokc - 1 + r) * D; f32x4 v[8];
#pragma unroll
                for (int i = 0; i < 8; ++i) v[i] = *(const f32x4*)(xr + i * 256 + lane * 4);
#pragma unroll
                for (int i = 0; i < 8; ++i) ss += v[i][0] * v[i][0] + v[i][1] * v[i][1] + v[i][2] * v[i][2] + v[i][3] * v[i][3]; }
            ss = wave_sum(ss);
            if (lane == 0) rs[r] = (r > 0 || hasprev) ? rsqrtf(ss * (1.0f / D) + 1e-6f) : 0.f;
        }
        __syncthreads();
        f32x4 prev = (f32x4){0.f, 0.f, 0.f, 0.f};
        if (hasprev) { const f32x4 pv = *(const f32x4*)(x + (size_t)(tokc - 1) * D + c); const float rp = rs[0]; prev = pv * rp * gg; }
        for (int r0 = 0; r0 < 32; r0 += 4) {
            f32x4 xv[4];
#pragma unroll
            for (int u = 0; u < 4; ++u) xv[u] = *(const f32x4*)(x + (size_t)(tokc + r0 + u) * D + c);
#pragma unroll
            for (int u = 0; u < 4; ++u) { const float rr = rs[r0 + u + 1]; const f32x4 hn = xv[u] * rr * gg, xx = prev - hn;
#pragma unroll
                for (int m = 0; m < 6; ++m) { const f32x4 o = hn + xx * mw[m];
                    uint2 w; w.x = cvt_pk_nv(o[0], o[1]); w.y = cvt_pk_nv(o[2], o[3]);
                    *(uint2*)(mixbase + (size_t)m * 8192 * D + (size_t)(rl0 + r0 + u) * D + c) = w; }
                prev = hn; }
        }
    }
}

__device__ __forceinline__ void conv_ssd(const Params& p) {
    const bf16_t* proj = (const bf16_t*)(p.ws + WS_PROJ); bf16_t* xbc = (bf16_t*)(p.ws + WS_XBC);
    const float* cw = p.in[6]; const float* cb = p.in[7];
    for (int idx = blockIdx.x * 512 + opq(threadIdx.x); idx < MTOK * 192; idx += gridDim.x * 512) {
        const int tok = idx / 192, c8 = idx - tok * 192, tpos = tok & (SEQ - 1), c = c8 * 8;
        float acc[8];
        { const f32x4 b0 = *(const f32x4*)(cb + c), b1 = *(const f32x4*)(cb + c + 4);
#pragma unroll
          for (int e = 0; e < 4; ++e) { acc[e] = b0[e]; acc[4 + e] = b1[e]; } }
#pragma unroll
        for (int j = 0; j < 4; ++j) { if (tpos - 3 + j >= 0) {
            const uint4 r = *(const uint4*)(proj + (size_t)(tok - 3 + j) * INWP + COL_XBC + c); float f[8]; unpack8(r, f);
            const f32x4 w0 = *(const f32x4*)(cw + j * 1536 + c), w1 = *(const f32x4*)(cw + j * 1536 + c + 4);
#pragma unroll
            for (int e = 0; e < 4; ++e) { acc[e] += w0[e] * f[e]; acc[4 + e] += w1[e] * f[4 + e]; } } }
#pragma unroll
        for (int e = 0; e < 8; ++e) acc[e] = acc[e] * sigmoidf_(acc[e]);
        u32x4 w; w.x = cvt_pk_nv(acc[0], acc[1]); w.y = cvt_pk_nv(acc[2], acc[3]); w.z = cvt_pk_nv(acc[4], acc[5]); w.w = cvt_pk_nv(acc[6], acc[7]);
        *(u32x4*)(xbc + (size_t)tok * 1536 + c) = w;
    }
    float* dt = (float*)(p.ws + WS_DT); float* da = (float*)(p.ws + WS_DA);
    for (int idx = blockIdx.x * 512 + opq(threadIdx.x); idx < MTOK * 16; idx += gridDim.x * 512) {
        const int tok = idx >> 4, hh = idx & 15;
        const float v = bf2f(proj[(size_t)tok * INWP + COL_DT + hh]) + p.in[8][hh];
        const float d = v > 20.f ? v : log1pf(expf(v));
        dt[idx] = d; da[idx] = expf(-d * expf(p.in[9][hh]));
    }
}

__device__ __forceinline__ void ssd_scan_job(const Params& p, int job, LAS unsigned char* lds) {
    const int tid = opq(threadIdx.x);
    const int b = job >> 5, hs = (job >> 1) & 15, half = job & 1, grp = hs >> 3, p0 = half * 32;
    const bf16_t* xbc = (const bf16_t*)(p.ws + WS_XBC) + (size_t)b * SEQ * 1536;
    const float* dtp = (const float*)(p.ws + WS_DT) + (size_t)b * SEQ * 16 + hs;
    const float* dap = (const float*)(p.ws + WS_DA) + (size_t)b * SEQ * 16 + hs;
    float* yraw = (float*)(p.ws + WS_YRAW) + (size_t)b * SEQ * 1024 + hs * 64 + p0;
    const float dskip = p.in[10][hs];
    constexpr int BUF_F = 9280;
    LAS float* L = (LAS float*)lds;
    int grow[3], gcol[3], loff[3];
#pragma unroll
    for (int k = 0; k < 3; ++k) { const int q = tid + k * 512, row = q / 36, pc = q - row * 36; grow[k] = row;
        if (pc < 4) { gcol[k] = hs * 64 + p0 + pc * 8; loff[k] = row * 32 + pc * 8; }
        else if (pc < 20) { gcol[k] = 1024 + grp * 128 + (pc - 4) * 8; loff[k] = 1024 + row * 128 + (pc - 4) * 8; }
        else { gcol[k] = 1280 + grp * 128 + (pc - 20) * 8; loff[k] = 5120 + row * 128 + (pc - 20) * 8; } }
    uint4 rg[3]; float sc = 0.f;
#define SSD_ISSUE(t0) do { _Pragma("unroll") for (int k = 0; k < 3; ++k) if (tid + k * 512 < 1152) rg[k] = *(const uint4*)(xbc + (size_t)((t0) + grow[k]) * 1536 + gcol[k]); \
        if (tid < 32) sc = dtp[((t0) + tid) * 16]; else if (tid < 64) sc = dap[((t0) + tid - 32) * 16]; } while (0)
#define SSD_COMMIT(buf) do { LAS float* Lc = L + (buf) * BUF_F; _Pragma("unroll") for (int k = 0; k < 3; ++k) if (tid + k * 512 < 1152) { float f[8]; unpack8(rg[k], f); \
            *(LAS f32x4*)(Lc + loff[k]) = (f32x4){f[0], f[1], f[2], f[3]}; *(LAS f32x4*)(Lc + loff[k] + 4) = (f32x4){f[4], f[5], f[6], f[7]}; } \
        if (tid < 32) Lc[9216 + tid] = sc; else if (tid < 64) Lc[9248 + tid - 32] = sc; } while (0)
    f32x2 hA[4], hB[4];
#pragma unroll
    for (int i = 0; i < 4; ++i) { hA[i] = (f32x2){0.f, 0.f}; hB[i] = (f32x2){0.f, 0.f}; }
    const int prow = (tid >> 4) & 15, nseg = tid & 15;
    __syncthreads();
    SSD_ISSUE(0); SSD_COMMIT(0); __syncthreads();
    for (int ch = 0; ch < 64; ++ch) {
        const int cur = ch & 1;
        if (ch + 1 < 64) SSD_ISSUE((ch + 1) * 32);
        LAS float* Lb = L + cur * BUF_F; LAS float* yb = L + 2 * BUF_F + cur * 1024;
        if (tid < 256) {
        for (int tg = 0; tg < 32; tg += 16) {
            float yA[16], yB[16];
            LAS float* qb = Lb + 1024 + tg * 128 + nseg * 8;
            f32x4 b0 = *(LAS f32x4*)(qb), b1 = *(LAS f32x4*)(qb + 4), c0 = *(LAS f32x4*)(qb + 4096), c1 = *(LAS f32x4*)(qb + 4100);
            float dA = Lb[9248 + tg], xa = Lb[tg * 32 + prow], xb = Lb[tg * 32 + prow + 16], dtv = Lb[9216 + tg];
#pragma unroll
            for (int tt = 0; tt < 16; ++tt) {
                f32x4 nb0, nb1, nc0, nc1; float ndA, nxa, nxb, ndtv;
                if (tt + 1 < 16) { LAS float* q = qb + (tt + 1) * 128; nb0 = *(LAS f32x4*)(q); nb1 = *(LAS f32x4*)(q + 4); nc0 = *(LAS f32x4*)(q + 4096); nc1 = *(LAS f32x4*)(q + 4100);
                    ndA = Lb[9248 + tg + tt + 1]; nxa = Lb[(tg + tt + 1) * 32 + prow]; nxb = Lb[(tg + tt + 1) * 32 + prow + 16]; ndtv = Lb[9216 + tg + tt + 1]; }
                __builtin_amdgcn_sched_barrier(0);
                const float xdta = xa * dtv, xdtb = xb * dtv;
                const f32x2 dA2 = (f32x2){dA, dA}, xa2 = (f32x2){xdta, xdta}, xb2 = (f32x2){xdtb, xdtb};
                hA[0] = hA[0] * dA2 + xa2 * b0.xy; hB[0] = hB[0] * dA2 + xb2 * b0.xy; hA[1] = hA[1] * dA2 + xa2 * b0.zw; hB[1] = hB[1] * dA2 + xb2 * b0.zw;
                hA[2] = hA[2] * dA2 + xa2 * b1.xy; hB[2] = hB[2] * dA2 + xb2 * b1.xy; hA[3] = hA[3] * dA2 + xa2 * b1.zw; hB[3] = hB[3] * dA2 + xb2 * b1.zw;
                f32x2 ya = hA[0] * c0.xy, yb2 = hB[0] * c0.xy; ya = hA[1] * c0.zw + ya; yb2 = hB[1] * c0.zw + yb2; ya = hA[2] * c1.xy + ya; yb2 = hB[2] * c1.xy + yb2; ya = hA[3] * c1.zw + ya; yb2 = hB[3] * c1.zw + yb2;
                float ra = ya.x + ya.y, rb = yb2.x + yb2.y;
                ra = dpp_add<0xB1>(ra); rb = dpp_add<0xB1>(rb); ra = dpp_add<0x4E>(ra); rb = dpp_add<0x4E>(rb); ra = dpp_add<0x141>(ra); rb = dpp_add<0x141>(rb); ra = dpp_add<0x140>(ra); rb = dpp_add<0x140>(rb);
                yA[tt] = ra + dskip * xa; yB[tt] = rb + dskip * xb;
                __builtin_amdgcn_sched_barrier(0);
                if (tt + 1 < 16) { b0 = nb0; b1 = nb1; c0 = nc0; c1 = nc1; dA = ndA; xa = nxa; xb = nxb; dtv = ndtv; }
            }
            if (nseg == 0) {
#pragma unroll
                for (int tt = 0; tt < 16; ++tt) { yb[(tg + tt) * 32 + prow] = yA[tt]; yb[(tg + tt) * 32 + prow + 16] = yB[tt]; } }
        }
        }
        if (ch + 1 < 64) SSD_COMMIT(cur ^ 1);
        __syncthreads();
        if (tid < 256) { const f32x4 v = *(LAS f32x4*)(yb + (tid >> 3) * 32 + (tid & 7) * 4); *(f32x4*)(yraw + (size_t)(ch * 32 + (tid >> 3)) * 1024 + (tid & 7) * 4) = v; }
    }
#undef SSD_ISSUE
#undef SSD_COMMIT
}
__device__ __forceinline__ void attn_job(const Params& p, int job, LAS unsigned char* lds) {
    const int tid = opq(threadIdx.x), lane = tid & 63, w = tid >> 6, fr = lane & 15, fq = lane >> 4;
    const int b = job >> 6, kvh = (job >> 4) & 3, nb = job & 15;
    const bf16_t* proj = (const bf16_t*)(p.ws + WS_PROJ) + (size_t)b * SEQ * INWP;
    const float2* rope = (const float2*)(p.ws + WS_ROPE);
    LAS bf16_t* Ks = (LAS bf16_t*)lds;
    LAS bf16_t* Vt = (LAS bf16_t*)(lds + 36864);
    LAS bf16_t* Ps = (LAS bf16_t*)(lds + 70656) + w * 16 * 264;
    __syncthreads();
    if (tid < 256) {
        const int kr = tid, tk = (nb - 1) * 128 + kr;
        if (tk >= 0) {
            const bf16_t* src = proj + (size_t)tk * INWP + COL_K + kvh * 64; float x[64]; float ss = 0.f;
#pragma unroll
            for (int c = 0; c < 8; ++c) { const uint4 r = *(const uint4*)(src + c * 8); float f[8]; unpack8(r, f);
#pragma unroll
                for (int e = 0; e < 8; ++e) { x[c * 8 + e] = f[e]; ss += f[e] * f[e]; } }
            const float rinv = rsqrtf(ss * (1.0f / 64) + 1e-6f); const float* kn = p.in[13];
#pragma unroll
            for (int i = 0; i < 64; ++i) x[i] = x[i] * rinv * kn[i];
#pragma unroll
            for (int c = 0; c < 4; ++c) { float o1[8], o2[8];
#pragma unroll
                for (int e = 0; e < 8; ++e) { const int i = c * 8 + e; const float2 cs = rope[tk * 32 + i]; o1[e] = x[i] * cs.x - x[i + 32] * cs.y; o2[e] = x[i + 32] * cs.x + x[i] * cs.y; }
                u32x4 w1, w2; w1.x = cvt_pk_bf16(o1[0], o1[1]); w1.y = cvt_pk_bf16(o1[2], o1[3]); w1.z = cvt_pk_bf16(o1[4], o1[5]); w1.w = cvt_pk_bf16(o1[6], o1[7]);
                w2.x = cvt_pk_bf16(o2[0], o2[1]); w2.y = cvt_pk_bf16(o2[2], o2[3]); w2.z = cvt_pk_bf16(o2[4], o2[5]); w2.w = cvt_pk_bf16(o2[6], o2[7]);
                *(LAS u32x4*)(Ks + kr * 72 + c * 8) = w1; *(LAS u32x4*)(Ks + kr * 72 + 32 + c * 8) = w2;
                __builtin_amdgcn_sched_barrier(0); }
        } else {
#pragma unroll
            for (int c = 0; c < 8; ++c) *(LAS u32x4*)(Ks + kr * 72 + c * 8) = (u32x4){0u, 0u, 0u, 0u};
        }
    } else {
        const int kr = tid - 256, tk = (nb - 1) * 128 + kr;
        const bf16_t* src = proj + (size_t)(tk < 0 ? 0 : tk) * INWP + COL_V + kvh * 64;
#pragma unroll
        for (int c = 0; c < 8; ++c) { uint4 r = *(const uint4*)(src + c * 8); if (tk < 0) r = make_uint4(0u, 0u, 0u, 0u);
            Vt[(c * 8 + 0) * 264 + kr] = (bf16_t)(r.x & 0xffffu); Vt[(c * 8 + 1) * 264 + kr] = (bf16_t)(r.x >> 16);
            Vt[(c * 8 + 2) * 264 + kr] = (bf16_t)(r.y & 0xffffu); Vt[(c * 8 + 3) * 264 + kr] = (bf16_t)(r.y >> 16);
            Vt[(c * 8 + 4) * 264 + kr] = (bf16_t)(r.z & 0xffffu); Vt[(c * 8 + 5) * 264 + kr] = (bf16_t)(r.z >> 16);
            Vt[(c * 8 + 6) * 264 + kr] = (bf16_t)(r.w & 0xffffu); Vt[(c * 8 + 7) * 264 + kr] = (bf16_t)(r.w >> 16); }
    }
    __syncthreads();
    for (int h4 = 0; h4 < 4; ++h4) {
    const int hq = kvh * 4 + h4;
    bf16x8 qa[2];
    { const int tq = nb * 128 + w * 16 + fr; const bf16_t* src = proj + (size_t)tq * INWP + hq * 64;
      const uint4 r0 = *(const uint4*)(src + fq * 8), r1 = *(const uint4*)(src + 32 + fq * 8); float x1[8], x2[8]; unpack8(r0, x1); unpack8(r1, x2);
      float ss = 0.f;
#pragma unroll
      for (int e = 0; e < 8; ++e) ss += x1[e] * x1[e] + x2[e] * x2[e];
      ss += __shfl_xor(ss, 16); ss += __shfl_xor(ss, 32);
      const float rinv = rsqrtf(ss * (1.0f / 64) + 1e-6f) * 0.125f; const float* qn = p.in[12]; float o1[8], o2[8];
#pragma unroll
      for (int e = 0; e < 8; ++e) { const int i = fq * 8 + e; const float a = x1[e] * rinv * qn[i], c = x2[e] * rinv * qn[i + 32]; const float2 cs = rope[tq * 32 + i];
          o1[e] = a * cs.x - c * cs.y; o2[e] = c * cs.x + a * cs.y; }
      u32x4 w1, w2; w1.x = cvt_pk_bf16(o1[0], o1[1]); w1.y = cvt_pk_bf16(o1[2], o1[3]); w1.z = cvt_pk_bf16(o1[4], o1[5]); w1.w = cvt_pk_bf16(o1[6], o1[7]);
      w2.x = cvt_pk_bf16(o2[0], o2[1]); w2.y = cvt_pk_bf16(o2[2], o2[3]); w2.z = cvt_pk_bf16(o2[4], o2[5]); w2.w = cvt_pk_bf16(o2[6], o2[7]);
      qa[0] = __builtin_bit_cast(bf16x8, w1); qa[1] = __builtin_bit_cast(bf16x8, w2); }
    f32x4 s[16];
#pragma unroll
    for (int j = 0; j < 16; ++j) { f32x4 acc = (f32x4){0.f, 0.f, 0.f, 0.f};
#pragma unroll
        for (int ks = 0; ks < 2; ++ks) { const bf16x8 kb = *(LAS bf16x8*)(Ks + (j * 16 + fr) * 72 + ks * 32 + fq * 8); acc = __builtin_amdgcn_mfma_f32_16x16x32_bf16(qa[ks], kb, acc, 0, 0, 0); }
        s[j] = acc; }
    const float sink = p.in[14][hq];
    float mx[4], inv[4];
#pragma unroll
    for (int i = 0; i < 4; ++i) { const int qi = w * 16 + fq * 4 + i + 128; float m = -3.0e38f;
#pragma unroll
        for (int j = 0; j < 16; ++j) { const int kj = j * 16 + fr; const bool ok = (kj <= qi) && (qi - kj < 128) && (nb > 0 || kj >= 128); s[j][i] = ok ? s[j][i] : -3.0e38f; m = fmaxf(m, s[j][i]); }
        m = fmaxf(m, __shfl_xor(m, 1)); m = fmaxf(m, __shfl_xor(m, 2)); m = fmaxf(m, __shfl_xor(m, 4)); m = fmaxf(m, __shfl_xor(m, 8));
        m = fmaxf(m, sink); mx[i] = m; float l = 0.f;
#pragma unroll
        for (int j = 0; j < 16; ++j) { const float e = (s[j][i] > -1.0e38f) ? __expf(s[j][i] - m) : 0.f; s[j][i] = e; l += e; }
        l += __shfl_xor(l, 1); l += __shfl_xor(l, 2); l += __shfl_xor(l, 4); l += __shfl_xor(l, 8);
        inv[i] = 1.0f / (l + __expf(sink - m)); }
#pragma unroll
    for (int j = 0; j < 16; ++j)
#pragma unroll
        for (int i = 0; i < 4; ++i) Ps[(fq * 4 + i) * 264 + j * 16 + fr] = f2bf(s[j][i] * inv[i]);
    f32x4 o[4];
#pragma unroll
    for (int nd = 0; nd < 4; ++nd) o[nd] = (f32x4){0.f, 0.f, 0.f, 0.f};
#pragma unroll
    for (int kk = 0; kk < 8; ++kk) { const bf16x8 pa = *(LAS bf16x8*)(Ps + fr * 264 + kk * 32 + fq * 8);
#pragma unroll
        for (int nd = 0; nd < 4; ++nd) { const bf16x8 vb = *(LAS bf16x8*)(Vt + (nd * 16 + fr) * 264 + kk * 32 + fq * 8); o[nd] = __builtin_amdgcn_mfma_f32_16x16x32_bf16(pa, vb, o[nd], 0, 0, 0); } }
    bf16_t* ymix = (bf16_t*)(p.ws + WS_YMIX) + (size_t)b * SEQ * D + hq * 64;
#pragma unroll
    for (int nd = 0; nd < 4; ++nd)
#pragma unroll
        for (int i = 0; i < 4; ++i) ymix[(size_t)(nb * 128 + w * 16 + fq * 4 + i) * D + nd * 16 + fr] = f2bf(o[nd][i]);
    }
}

__device__ __forceinline__ void post_ssd(const Params& p) {
    const int tid_ = opq(threadIdx.x); const int lane = tid_ & 63, wv = tid_ >> 6;
    const float* yraw = (const float*)(p.ws + WS_YRAW); const bf16_t* proj = (const bf16_t*)(p.ws + WS_PROJ); bf16_t* ymix = (bf16_t*)(p.ws + WS_YMIX);
    for (int it = blockIdx.x * 8 + wv; it < MTOK * 2; it += gridDim.x * 8) {
        const int tok = it >> 1, grp = it & 1, c = grp * 512 + lane * 8;
        const f32x4 y0 = *(const f32x4*)(yraw + (size_t)tok * 1024 + c), y1 = *(const f32x4*)(yraw + (size_t)tok * 1024 + c + 4);
        const uint4 zr = *(const uint4*)(proj + (size_t)tok * INWP + COL_Z + c); float z[8], y[8]; unpack8(zr, z); float ss = 0.f;
#pragma unroll
        for (int e = 0; e < 8; ++e) { const float yy = (e < 4 ? y0[e] : y1[e - 4]); y[e] = yy * z[e] * sigmoidf_(z[e]); ss += y[e] * y[e]; }
        ss = wave_sum(ss); const float r = rsqrtf(ss * (1.0f / 512) + 1e-6f);
        const f32x4 n0 = *(const f32x4*)(p.in[11] + c), n1 = *(const f32x4*)(p.in[11] + c + 4);
        u32x4 w; w.x = cvt_pk_nv(y[0] * r * n0[0], y[1] * r * n0[1]); w.y = cvt_pk_nv(y[2] * r * n0[2], y[3] * r * n0[3]);
        w.z = cvt_pk_nv(y[4] * r * n1[0], y[5] * r * n1[1]); w.w = cvt_pk_nv(y[6] * r * n1[2], y[7] * r * n1[3]);
        *(u32x4*)(ymix + (size_t)tok * D + 1024 + c) = w;
    }
}

__device__ __forceinline__ float half_sum(float v, bool lo) {
    v = red16(v);
    const float r0 = __builtin_bit_cast(float, __builtin_amdgcn_readlane(__builtin_bit_cast(int, v), 0)), r1 = __builtin_bit_cast(float, __builtin_amdgcn_readlane(__builtin_bit_cast(int, v), 16));
    const float r2 = __builtin_bit_cast(float, __builtin_amdgcn_readlane(__builtin_bit_cast(int, v), 32)), r3 = __builtin_bit_cast(float, __builtin_amdgcn_readlane(__builtin_bit_cast(int, v), 48));
    return lo ? (r0 + r1) : (r2 + r3); }
__device__ __forceinline__ void rwkv_scan_job(const Params& p, int job, LAS unsigned char* lds) {
    const int tid = opq(threadIdx.x), lane = tid & 63, l32 = lane & 31; const bool lo = lane < 32;
    const int b = job >> 5, hh = job & 31;
    LAS float* L = (LAS float*)lds;
    const bool producer = tid >= 256;
    const int pw = (tid >> 6) & 3;
    const int tl0 = 2 * pw + (lane >> 5);
    const size_t wbase = ((size_t)b * SEQ * D + hh * 64) / 2 + l32 + (size_t)tl0 * (D / 2);
    const unsigned* R32 = (const unsigned*)(p.ws + WS_R) + wbase; const unsigned* K32 = (const unsigned*)(p.ws + WS_K) + wbase; const unsigned* V32 = (const unsigned*)(p.ws + WS_V) + wbase;
    const unsigned* E32 = (const unsigned*)(p.ws + WS_WDEC) + wbase; const unsigned* A32 = (const unsigned*)(p.ws + WS_AA) + wbase; const unsigned* G32 = (const unsigned*)(p.ws + WS_GG) + wbase;
    unsigned* Y32 = (unsigned*)(p.ws + WS_YG) + wbase;
    const int ci = hh * 64 + 2 * l32;
    const float2 kkw = *(const float2*)(p.in[25] + ci), kaw = *(const float2*)(p.in[26] + ci), rkw = *(const float2*)(p.in[27] + ci), lnw = *(const float2*)(p.in[32] + ci), lnb = *(const float2*)(p.in[33] + ci);
    unsigned rw[2], kw[2], vw[2], ew[2], aw[2], gw[2];
    const int oo = tl0 * 64 + 2 * l32;
#define RW_ISSUE(t0) do { _Pragma("unroll") for (int i2 = 0; i2 < 2; ++i2) { const size_t off = (size_t)((t0) + 8 * i2) * (D / 2); rw[i2] = R32[off]; kw[i2] = K32[off]; vw[i2] = V32[off]; ew[i2] = E32[off]; aw[i2] = A32[off]; gw[i2] = G32[off]; } } while (0)
#define RW_COMMIT(buf) do { _Pragma("unroll") for (int i2 = 0; i2 < 2; ++i2) { LAS float* Lc = L + (buf) * 8192 + oo + i2 * 512; \
        const float r0_ = bflo(rw[i2]), r1_ = bfhi(rw[i2]), k0_ = bflo(kw[i2]), k1_ = bfhi(kw[i2]), v0_ = bflo(vw[i2]), v1_ = bfhi(vw[i2]), e0_ = bflo(ew[i2]), e1_ = bfhi(ew[i2]), a0_ = bflo(aw[i2]), a1_ = bfhi(aw[i2]), g0_ = bflo(gw[i2]), g1_ = bfhi(gw[i2]); \
        const float kkv0 = k0_ * kkw.x, kkv1 = k1_ * kkw.y; const float ssq = half_sum(kkv0 * kkv0 + kkv1 * kkv1, lo); const float rn = rsqrtf(fmaxf(ssq, 1e-24f)); const float kn0 = kkv0 * rn, kn1 = kkv1 * rn; \
        const float km0 = k0_ * (1.0f + (a0_ - 1.0f) * kaw.x), km1 = k1_ * (1.0f + (a1_ - 1.0f) * kaw.y); const float bonus = half_sum(r0_ * km0 * rkw.x + r1_ * km1 * rkw.y, lo); \
        *(LAS f32x2*)(Lc) = (f32x2){-kn0, -kn1}; *(LAS f32x2*)(Lc + 1024) = (f32x2){__expf(-e0_), __expf(-e1_)}; *(LAS f32x2*)(Lc + 2048) = (f32x2){kn0 * a0_, kn1 * a1_}; *(LAS f32x2*)(Lc + 3072) = (f32x2){km0, km1}; \
        *(LAS f32x2*)(Lc + 4096) = (f32x2){r0_, r1_}; *(LAS f32x2*)(Lc + 5120) = (f32x2){v0_, v1_}; *(LAS f32x2*)(Lc + 6144) = (f32x2){g0_, g1_}; *(LAS f32x2*)(Lc + 7168) = (f32x2){bonus * v0_, bonus * v1_}; } } while (0)
#define RW_OUTPUT(chp) do { LAS float* Lo = L + ((chp) & 1) * 8192; LAS float* yo = L + 16384 + ((chp) & 1) * 1024; _Pragma("unroll") for (int i2 = 0; i2 < 2; ++i2) { const int o2 = oo + i2 * 512; \
        const f32x2 y = *(LAS f32x2*)(yo + o2); \
        const float mu = half_sum(y.x + y.y, lo) * (1.0f / 64), d0 = y.x - mu, d1 = y.y - mu, var = half_sum(d0 * d0 + d1 * d1, lo) * (1.0f / 64), rs = rsqrtf(var + 64e-5f); \
        const f32x2 bv = *(LAS f32x2*)(Lo + 7168 + o2), gg = *(LAS f32x2*)(Lo + 6144 + o2); \
        Y32[(size_t)((chp) * 16 + 8 * i2) * (D / 2)] = cvt_pk_nv((d0 * rs * lnw.x + lnb.x + bv.x) * gg.x, (d1 * rs * lnw.y + lnb.y + bv.y) * gg.y); } } while (0)
    f32x2 SA[4], SB[4];
#pragma unroll
    for (int i = 0; i < 4; ++i) { SA[i] = (f32x2){0.f, 0.f}; SB[i] = (f32x2){0.f, 0.f}; }
    const int rp = (tid >> 3) & 31, ks = tid & 7;
    __syncthreads();
    if (producer) { RW_ISSUE(0); RW_COMMIT(0); RW_ISSUE(16); }
    __syncthreads();
    for (int ch = 0; ch < 128; ++ch) {
        const int cur = ch & 1;
        if (producer) {
            if (ch >= 1) RW_OUTPUT(ch - 1);
            if (ch + 1 < 128) RW_COMMIT(cur ^ 1);
            if (ch + 2 < 128) RW_ISSUE((ch + 2) * 16);
        } else {
            LAS float* Lb = L + cur * 8192; LAS float* yb = L + 16384 + cur * 1024;
            float yA[16], yB[16];
            LAS float* q0 = Lb + ks * 8;
            f32x4 a0 = *(LAS f32x4*)(q0), a1 = *(LAS f32x4*)(q0 + 4), w0 = *(LAS f32x4*)(q0 + 1024), w1 = *(LAS f32x4*)(q0 + 1028), b0 = *(LAS f32x4*)(q0 + 2048), b1 = *(LAS f32x4*)(q0 + 2052);
            f32x4 k0 = *(LAS f32x4*)(q0 + 3072), k1 = *(LAS f32x4*)(q0 + 3076), r0 = *(LAS f32x4*)(q0 + 4096), r1 = *(LAS f32x4*)(q0 + 4100);
            float va = Lb[5120 + rp], vb = Lb[5120 + rp + 32];
#pragma unroll
            for (int t = 0; t < 16; ++t) {
                f32x4 na0, na1, nw0, nw1, nb0, nb1, nk0, nk1, nr0, nr1; float nva, nvb;
                if (t + 1 < 16) { LAS float* q = q0 + (t + 1) * 64;
                    na0 = *(LAS f32x4*)(q); na1 = *(LAS f32x4*)(q + 4); nw0 = *(LAS f32x4*)(q + 1024); nw1 = *(LAS f32x4*)(q + 1028); nb0 = *(LAS f32x4*)(q + 2048); nb1 = *(LAS f32x4*)(q + 2052);
                    nk0 = *(LAS f32x4*)(q + 3072); nk1 = *(LAS f32x4*)(q + 3076); nr0 = *(LAS f32x4*)(q + 4096); nr1 = *(LAS f32x4*)(q + 4100); nva = Lb[5120 + (t + 1) * 64 + rp]; nvb = Lb[5120 + (t + 1) * 64 + rp + 32]; }
                __builtin_amdgcn_sched_barrier(0);
                f32x2 ca = SA[0] * a0.xy, cb = SB[0] * a0.xy; ca = SA[1] * a0.zw + ca; cb = SB[1] * a0.zw + cb; ca = SA[2] * a1.xy + ca; cb = SB[2] * a1.xy + cb; ca = SA[3] * a1.zw + ca; cb = SB[3] * a1.zw + cb;
                float sa = ca.x + ca.y, sb = cb.x + cb.y;
                sa = dpp_add<0xB1>(sa); sb = dpp_add<0xB1>(sb); sa = dpp_add<0x4E>(sa); sb = dpp_add<0x4E>(sb); sa = dpp_add<0x141>(sa); sb = dpp_add<0x141>(sb);
                const f32x2 sa2 = (f32x2){sa, sa}, sb2 = (f32x2){sb, sb}, va2 = (f32x2){va, va}, vb2 = (f32x2){vb, vb};
                SA[0] = SA[0] * w0.xy + (sa2 * b0.xy + va2 * k0.xy); SB[0] = SB[0] * w0.xy + (sb2 * b0.xy + vb2 * k0.xy);
                SA[1] = SA[1] * w0.zw + (sa2 * b0.zw + va2 * k0.zw); SB[1] = SB[1] * w0.zw + (sb2 * b0.zw + vb2 * k0.zw);
                SA[2] = SA[2] * w1.xy + (sa2 * b1.xy + va2 * k1.xy); SB[2] = SB[2] * w1.xy + (sb2 * b1.xy + vb2 * k1.xy);
                SA[3] = SA[3] * w1.zw + (sa2 * b1.zw + va2 * k1.zw); SB[3] = SB[3] * w1.zw + (sb2 * b1.zw + vb2 * k1.zw);
                f32x2 ya = SA[0] * r0.xy, yb2 = SB[0] * r0.xy; ya = SA[1] * r0.zw + ya; yb2 = SB[1] * r0.zw + yb2; ya = SA[2] * r1.xy + ya; yb2 = SB[2] * r1.xy + yb2; ya = SA[3] * r1.zw + ya; yb2 = SB[3] * r1.zw + yb2;
                float ra = ya.x + ya.y, rb = yb2.x + yb2.y;
                ra = dpp_add<0xB1>(ra); rb = dpp_add<0xB1>(rb); ra = dpp_add<0x4E>(ra); rb = dpp_add<0x4E>(rb); ra = dpp_add<0x141>(ra); rb = dpp_add<0x141>(rb);
                yA[t] = ra; yB[t] = rb;
                __builtin_amdgcn_sched_barrier(0);
                if (t + 1 < 16) { a0 = na0; a1 = na1; w0 = nw0; w1 = nw1; b0 = nb0; b1 = nb1; k0 = nk0; k1 = nk1; r0 = nr0; r1 = nr1; va = nva; vb = nvb; }
            }
            if (ks == 0) {
#pragma unroll
                for (int t = 0; t < 16; ++t) { yb[t * 64 + rp] = yA[t]; yb[t * 64 + rp + 32] = yB[t]; } }
        }
        __syncthreads();
    }
    if (producer) RW_OUTPUT(127);
#undef RW_ISSUE
#undef RW_COMMIT
#undef RW_OUTPUT
}

__global__ __launch_bounds__(512, 2) void mega(const Params p_arg) {
    extern __shared__ __attribute__((aligned(16))) unsigned char shm[];
    const Params& p = *(const Params*)(const void*)__builtin_amdgcn_kernarg_segment_ptr();
    LAS unsigned char* lds = (LAS unsigned char*)shm;
    const int G = (int)gridDim.x, bid = (int)blockIdx.x;
    for (int s = p.step_lo; s < p.step_hi; ++s) {
        const int kind = p.kind[s], lo = p.lo[s], hi = p.hi[s];
        switch (kind) {
            case K_PRE0:
#ifndef NO_PRE
 convert_tiles(p, lo, hi, lds); rope_table(p); norm_rows(p.in[0], p.in[1], (bf16_t*)(p.ws + WS_H));
#endif
 break;
            case K_GEMMB:
#ifndef NO_GB

                for (int i = lo; i < hi; ++i) { const GemmOp& o = p.g[i]; pg8::Gemm g; g.A = o.A; g.Bt = o.Bt; g.M = o.M; g.N = o.N; g.K = o.K;
                    pg8::StaticOrder S; S.init(o.M, o.N, G, (bid + G - (o.rot % G)) % G);
                    EpiB E; E.O = (bf16_t*)o.out; E.ldc = o.ldc; E.bias = o.bias; E.act = o.act;
                    pg8::gemm_phase<EpiB, pg8::StaticOrder, false>(lds, g, S, E, nullptr); }
#endif
                break;
            case K_GEMMF:
#ifndef NO_GF

                for (int i = lo; i < hi; ++i) { const GemmOp& o = p.g[i]; pg8::Gemm g; g.A = o.A; g.Bt = o.Bt; g.M = o.M; g.N = o.N; g.K = o.K;
                    pg8::StaticOrder S; S.init(o.M, o.N, G, (bid + G - (o.rot % G)) % G);
                    EpiF E; E.C = (float*)o.out; E.ldc = o.ldc; E.res = o.res;
                    pg8::gemm_phase<EpiF, pg8::StaticOrder, false>(lds, g, S, E, nullptr); }
#endif
                break;
            case K_CONVSSD:
#ifndef NO_CONV
 conv_ssd(p);
#endif
 break;
            case K_MIX0:

#ifndef NO_SSD
for (int j = bid; j < 256; j += G) ssd_scan_job(p, j, lds);
#endif


#ifndef NO_ATT
for (int j = bid; j < 512; j += G) attn_job(p, j, lds);
#endif

                break;
            case K_POST0: post_ssd(p); break;
            case K_NORM: norm_rows(p.out, p.in[2] + lo * D, (bf16_t*)(p.ws + WS_H)); break;
            case K_PRE1: convert_tiles(p, lo, hi, lds); mix_rows(p.out, p.in[1] + D, p.in[16], (bf16_t*)(p.ws + WS_MIX), 0, lds); break;
            case K_MIXES: mix_rows(p.out, p.in[1] + D, p.in[16], (bf16_t*)(p.ws + WS_MIX), 8192, lds); break;
            case K_RWKV:
#ifndef NO_RWKV
 for (int j = bid; j < 256; j += G) rwkv_scan_job(p, j, lds);
#endif
 break;
            case K_NORMCONV: convert_tiles(p, lo, hi, lds); norm_rows(p.out, p.in[2] + D, (bf16_t*)(p.ws + WS_H)); break;
            default: break;
        }
        if (s + 1 < p.step_hi) cg::this_grid().sync();
    }
}

#ifndef MK_MULTI
#define MK_MULTI 0
#endif
extern "C" void kernel_launch(void* const* d_in, const int* in_sizes, int n_in, void* d_out, int out_size, void* d_ws, size_t ws_size, hipStream_t stream) {
    static int grid = 0;
    if (grid == 0) {
        int dev = 0, cus = 0, per_cu = 0;
        hipGetDevice(&dev); hipDeviceGetAttribute(&cus, hipDeviceAttributeMultiprocessorCount, dev);
        if (hipFuncSetAttribute((const void*)mega, hipFuncAttributeMaxDynamicSharedMemorySize, LDS_BYTES) != hipSuccess) { fprintf(stderr, "hipFuncSetAttribute failed\n"); grid = -1; return; }
        if (hipOccupancyMaxActiveBlocksPerMultiprocessor(&per_cu, (const void*)mega, 512, LDS_BYTES) != hipSuccess || per_cu < 1) { fprintf(stderr, "occupancy query: %d\n", per_cu); per_cu = 1; }
        (void)hipGetLastError();
        grid = cus * per_cu; if (grid > 256) grid = 256;
        if (n_in != 34 || ws_size < 512 * MiB) { fprintf(stderr, "unexpected n_in %d / ws %zu\n", n_in, ws_size); grid = -1; return; }
    }
    if (grid < 0) return;
    static Params p;
    memset(&p, 0, sizeof(p));
    for (int i = 0; i < 34; ++i) p.in[i] = (const float*)d_in[i];
    p.out = (float*)d_out; p.ws = (unsigned char*)d_ws;
    unsigned char* ws = (unsigned char*)d_ws;
    auto B16 = [&](size_t off) { return (bf16_t*)(ws + off); };
    int ncj = 0, tile_acc = 0;
    auto CJ = [&](const float* src, size_t dst_off, int K, int N, int Kpad, int Npad) { ConvJob& c = p.cj[ncj++]; c.src = src; c.dst = B16(dst_off); c.K = K; c.N = N; c.Kpad = Kpad; c.Npad = Npad; c.tile0 = tile_acc; c.ntiles = (Kpad / 64) * (Npad / 256); tile_acc += c.ntiles; };
    const float* w_up = p.in[3]; const float* w_down = p.in[4];
    tile_acc = 0;
    CJ(p.in[5], WS_WBA, 2048, 4112, 2048, 4352); CJ(p.in[15], WS_WBA + 17 * MiB, 2048, 2048, 2048, 2048);
    CJ(w_up, WS_WMLP, 2048, 8192, 2048, 8192); CJ(w_down, WS_WMLP + 32 * MiB, 8192, 2048, 8192, 2048);
    tile_acc = 0;
    CJ(p.in[28], WS_WBA, 2048, 2048, 2048, 2048); CJ(p.in[29], WS_WBA + 8 * MiB, 2048, 2048, 2048, 2048); CJ(p.in[30], WS_WBA + 16 * MiB, 2048, 2048, 2048, 2048); CJ(p.in[31], WS_WBA + 24 * MiB, 2048, 2048, 2048, 2048);
    CJ(p.in[18], WS_WBA + 32 * MiB, 2048, 96, 2048, 256); CJ(p.in[21], WS_WBA + 33 * MiB, 2048, 96, 2048, 256); CJ(p.in[23], WS_WBA + 34 * MiB, 2048, 256, 2048, 256);
    CJ(p.in[19], WS_WBA + 35 * MiB, 96, 2048, 256, 2048); CJ(p.in[22], WS_WBA + 36 * MiB, 96, 2048, 256, 2048); CJ(p.in[24], WS_WBA + 37 * MiB, 256, 2048, 256, 2048);
    tile_acc = 0;
    CJ(w_up + (size_t)2048 * 8192, WS_WMLP, 2048, 8192, 2048, 8192); CJ(w_down + (size_t)2048 * 8192, WS_WMLP + 32 * MiB, 8192, 2048, 8192, 2048);
    int nop = 0;
    auto GO = [&](const bf16_t* A, const bf16_t* Bt, void* out, const float* bias, const float* res, int M, int N, int K, int ldc, int act, int rot) {
        GemmOp& o = p.g[nop++]; o.A = A; o.Bt = Bt; o.out = out; o.bias = bias; o.res = res; o.M = M; o.N = N; o.K = K; o.ldc = ldc; o.act = act; o.rot = rot; };
    GO(B16(WS_H), B16(WS_WBA), B16(WS_PROJ), nullptr, nullptr, MTOK, INWP, 2048, INWP, 0, 0);
    GO(B16(WS_YMIX), B16(WS_WBA + 17 * MiB), d_out, nullptr, p.in[0], MTOK, 2048, 2048, 2048, 0, 0);
    GO(B16(WS_H), B16(WS_WMLP), B16(WS_U), nullptr, nullptr, MTOK, DFF, 2048, DFF, 1, 0);
    GO(B16(WS_U), B16(WS_WMLP + 32 * MiB), d_out, nullptr, (const float*)d_out, MTOK, 2048, DFF, 2048, 0, 0);
    for (int half = 0; half < 2; ++half) {
        const size_t ro = (size_t)half * 8192 * 2048 * 2, lo_ = (size_t)half * 8192 * 256 * 2; const size_t mb = (size_t)8192 * 2048 * 2;
        GO(B16(WS_MIX + 0 * mb), B16(WS_WBA), B16(WS_R + ro), nullptr, nullptr, 8192, 2048, 2048, 2048, 0, 0);
        GO(B16(WS_MIX + 2 * mb), B16(WS_WBA + 8 * MiB), B16(WS_K + ro), nullptr, nullptr, 8192, 2048, 2048, 2048, 0, 0);
        GO(B16(WS_MIX + 3 * mb), B16(WS_WBA + 16 * MiB), B16(WS_V + ro), nullptr, nullptr, 8192, 2048, 2048, 2048, 0, 0);
        GO(B16(WS_MIX + 1 * mb), B16(WS_WBA + 32 * MiB), B16(WS_L1W + lo_), nullptr, nullptr, 8192, 256, 2048, 256, 2, 0);
        GO(B16(WS_MIX + 4 * mb), B16(WS_WBA + 33 * MiB), B16(WS_L1A + lo_), nullptr, nullptr, 8192, 256, 2048, 256, 0, 32);
        GO(B16(WS_MIX + 5 * mb), B16(WS_WBA + 34 * MiB), B16(WS_L1G + lo_), nullptr, nullptr, 8192, 256, 2048, 256, 3, 64);
    }
    GO(B16(WS_L1W), B16(WS_WBA + 35 * MiB), B16(WS_WDEC), p.in[17], nullptr, MTOK, 2048, 256, 2048, 4, 0);
    GO(B16(WS_L1A), B16(WS_WBA + 36 * MiB), B16(WS_AA), p.in[20], nullptr, MTOK, 2048, 256, 2048, 3, 0);
    GO(B16(WS_L1G), B16(WS_WBA + 37 * MiB), B16(WS_GG), nullptr, nullptr, MTOK, 2048, 256, 2048, 0, 0);
    GO(B16(WS_YG), B16(WS_WBA + 24 * MiB), d_out, nullptr, (const float*)d_out, MTOK, 2048, 2048, 2048, 0, 0);
    GO(B16(WS_H), B16(WS_WMLP), B16(WS_U), nullptr, nullptr, MTOK, DFF, 2048, DFF, 1, 0);
    GO(B16(WS_U), B16(WS_WMLP + 32 * MiB), d_out, nullptr, (const float*)d_out, MTOK, 2048, DFF, 2048, 0, 0);
    int ns = 0;
    auto ST = [&](int kind, int lo, int hi) { int rep = 1; if (kind == K_GEMMB) rep = REP_GEMMB; else if (kind == K_MIX0) rep = REP_MIX0; else if (kind == K_RWKV) rep = REP_RWKV; else if (kind != K_GEMMF) rep = REP_ELEM;
        for (int r = 0; r < rep; ++r) { p.kind[ns] = kind; p.lo[ns] = lo; p.hi[ns] = hi; ++ns; } };
    ST(K_PRE0, 0, 4); ST(K_GEMMB, 0, 1); ST(K_CONVSSD, 0, 0); ST(K_MIX0, 0, 0); ST(K_POST0, 0, 0); ST(K_GEMMF, 1, 2); ST(K_NORM, 0, 0); ST(K_GEMMB, 2, 3); ST(K_GEMMF, 3, 4);
    ST(K_PRE1, 4, 14); ST(K_GEMMB, 4, 10); ST(K_MIXES, 0, 0); ST(K_GEMMB, 10, 16); ST(K_GEMMB, 16, 19); ST(K_RWKV, 0, 0); ST(K_GEMMF, 19, 20); ST(K_NORMCONV, 14, 16); ST(K_GEMMB, 20, 21); ST(K_GEMMF, 21, 22);
#if MK_MULTI
    for (int s = 0; s < ns; ++s) { p.step_lo = s; p.step_hi = s + 1; hipLaunchKernelGGL(mega, dim3(grid), dim3(512), LDS_BYTES, stream, p); }
#else
    p.step_lo = 0; p.step_hi = ns;
    void* args[] = {(void*)&p};
    const hipError_t e = hipLaunchCooperativeKernel((const void*)mega, dim3(grid), dim3(512), args, LDS_BYTES, stream);
    if (e != hipSuccess) fprintf(stderr, "cooperative launch failed: %s (grid %d)\n", hipGetErrorString(e), grid);
#endif
}
```

```cpp
#include <hip/hip_runtime.h>
#include <hip/hip_cooperative_groups.h>
#include <cstdio>
#include <cstring>
namespace cg = cooperative_groups;
__device__ __forceinline__ int opq(int v) { asm volatile("" : "+v"(v)); return v; }
namespace pg8 {
#define PG8_LAS __attribute__((address_space(3)))
typedef unsigned short bf16_t;
typedef short bf16x8 __attribute__((ext_vector_type(8)));
typedef float f32x4 __attribute__((ext_vector_type(4)));
typedef unsigned u32x4 __attribute__((ext_vector_type(4)));
constexpr int BM = 256, BK = 64, HALF = 128, HTB = HALF * BK * 2  , STAGE_BYTES = 8 * HTB, NXCD = 8, WGM = 8;

__host__ __device__ __forceinline__ int lds_byte(int r, int c) { const int st = (r >> 4) * 2 + (c >> 5), rr = r & 15, cc = c & 31, ob = rr * 64 + cc * 2; return st * 1024 + (ob ^ (((ob >> 9) & 1) << 5)); }
__host__ __device__ __forceinline__ void stage_rc(int b, int& R, int& C) { const int st = b / 1024, sb = b % 1024, swz = sb ^ (((sb >> 9) & 1) << 5); R = (st >> 1) * 16 + swz / 64; C = (st & 1) * 32 + (swz % 64) / 2; }
__host__ __device__ __forceinline__ int perm32(int rho) { const int n = rho >> 4, i = rho & 15; return 8 * (i >> 2) + 4 * n + (i & 3); }

struct Unit { int pm, pn; };
struct Gemm { const bf16_t* A; const bf16_t* Bt; int M, N, K; };

struct StaticOrder {
    int nM, nN, nwg, G, c;
    __host__ __device__ void init(int M, int N, int G_, int c_) { nM = M / BM; nN = N / BM; nwg = nM * nN; G = G_; c = c_; }
    __host__ __device__ bool next(int i, Unit& u) const {
        const long L = (long)i * G + c; if (L >= nwg) return false;
        int wgid = (int)L; { const int q = nwg / NXCD, r = nwg % NXCD, xcd = wgid % NXCD, off = wgid / NXCD; wgid = (xcd < r ? xcd * (q + 1) : r * (q + 1) + (xcd - r) * q) + off; }
        const int nig = WGM * nN, gid = wgid / nig, fm = gid * WGM, gsz = (nM - fm) < WGM ? (nM - fm) : WGM;
        u.pm = fm + ((wgid % nig) % gsz); u.pn = (wgid % nig) / gsz; return true;
    }
    __device__ __forceinline__ void a_ready(const Unit&) const {}
    __device__ __forceinline__ void done(const Unit&) const {}
};
typedef __bf16 bf16x2_t __attribute__((ext_vector_type(2)));
typedef float f32x2_t __attribute__((ext_vector_type(2)));
__device__ __forceinline__ unsigned cvt_pk_bf16(float lo, float hi) { const f32x2_t f = {lo, hi}; const bf16x2_t v = __builtin_convertvector(f, bf16x2_t); return __builtin_bit_cast(unsigned, v); }
__device__ __forceinline__ unsigned cvt_pk_nv(float lo, float hi) { return cvt_pk_bf16(lo, hi); }

template <class Epi, class Sched, bool STAMP = false>
__device__ __forceinline__ void gemm_phase(PG8_LAS unsigned char* lds, const Gemm g, const Sched& S, const Epi& E, unsigned long long* stamps) {
    const int tid = opq(threadIdx.x), wid = __builtin_amdgcn_readfirstlane(tid >> 6), lane = tid & 63, wr = wid >> 2, wc = wid & 3, fr = lane & 15, fq = lane >> 4;
    const int K = g.K, nt = K / BK;
    int ts_lo = 0, ts_hi = 0, nts = 0; const unsigned long long rt_entry = STAMP ? (unsigned long long)wall_clock64() : 0ull;
#define PG8_STAMP() do { if (STAMP && wid == 0 && nts < 64) { const unsigned long long _c = (unsigned long long)clock64(); \
        ts_lo = (lane == nts) ? (int)(unsigned)_c : ts_lo; ts_hi = (lane == nts) ? (int)(unsigned)(_c >> 32) : ts_hi; ++nts; } } while (0)
    PG8_STAMP();
    unsigned voffA[2], voffB[2];
#pragma unroll
    for (int i = 0; i < 2; ++i) { int R, C; stage_rc(tid * 16 + i * 8192, R, C); const int Rb = Epi::PERM ? ((R & ~31) + perm32(R & 31)) : R;
        voffA[i] = (unsigned)(R * K + C) * 2u; voffB[i] = (unsigned)(Rb * K + C) * 2u; }
    const size_t kstep = (size_t)(BK * 2);
    const size_t hstep = (size_t)HALF * K * 2;
    const size_t tstep = 2 * hstep;
    const unsigned ldsw = (unsigned)wid * 1024u;
    const int aoff = lds_byte(wr * 64 + fr, fq * 8), boff = lds_byte(wc * 32 + fr, fq * 8);
#define PG8_SA(b, h) (((b) * 2 + (h)) * HTB)
#define PG8_SB(b, h) ((4 + (b) * 2 + (h)) * HTB)
#define PG8_STAGE(bufoff, gbase, voff) do { _Pragma("unroll") for (int _i = 0; _i < 2; ++_i) \
        __builtin_amdgcn_global_load_lds((const unsigned*)((const char*)(gbase) + (voff)[_i]), (PG8_LAS unsigned*)(lds + (bufoff) + ldsw + _i * 8192), 16, 0, 0); } while (0)
#define PG8_LDA(dst, b, h) do { _Pragma("unroll") for (int m = 0; m < 4; ++m) _Pragma("unroll") for (int k = 0; k < 2; ++k) dst[m][k] = *(const PG8_LAS bf16x8*)(lds + PG8_SA(b, h) + aoff + m * 2048 + k * 1024); } while (0)
#define PG8_LDB(dst, b, h) do { _Pragma("unroll") for (int n = 0; n < 2; ++n) _Pragma("unroll") for (int k = 0; k < 2; ++k) dst[n][k] = *(const PG8_LAS bf16x8*)(lds + PG8_SB(b, h) + boff + n * 2048 + k * 1024); } while (0)
#define PG8_MMA(ai, bj, At, Bt) do { __builtin_amdgcn_s_setprio(1); _Pragma("unroll") for (int m = 0; m < 4; ++m) _Pragma("unroll") for (int n = 0; n < 2; ++n) _Pragma("unroll") for (int k = 0; k < 2; ++k) \
        acc[ai][bj][m][n] = __builtin_amdgcn_mfma_f32_16x16x32_bf16(Bt[n][k], At[m][k], acc[ai][bj][m][n], 0, 0, 0); __builtin_amdgcn_s_setprio(0); } while (0)
#define PG8_WAIT_V(n) asm volatile("s_waitcnt vmcnt(" #n ")" ::: "memory")
#define PG8_WAIT_L(n) asm volatile("s_waitcnt lgkmcnt(" #n ")" ::: "memory")
#define PG8_BAR __builtin_amdgcn_s_barrier()
#define PG8_SCHED __builtin_amdgcn_sched_barrier(0)
    Unit cur, nxt; int ui = 0;
    if (!S.next(0, cur)) return;
    f32x4 acc[2][2][4][2];
#pragma unroll
    for (int a = 0; a < 2; ++a)
#pragma unroll
        for (int b = 0; b < 2; ++b)
#pragma unroll
            for (int m = 0; m < 4; ++m)
#pragma unroll
                for (int n = 0; n < 2; ++n) acc[a][b][m][n] = (f32x4){0.f, 0.f, 0.f, 0.f};
    bf16x8 At[4][2], B0[2][2], B1[2][2];
    const char* cA = (const char*)g.A + (size_t)cur.pm * tstep; const char* cB = (const char*)g.Bt + (size_t)cur.pn * tstep;
    S.a_ready(cur);
    PG8_STAGE(PG8_SB(0, 0), cB, voffB); PG8_STAGE(PG8_SA(0, 0), cA, voffA); PG8_STAGE(PG8_SB(0, 1), cB + hstep, voffB); PG8_STAGE(PG8_SA(0, 1), cA + hstep, voffA);
    if (wr == 1) PG8_BAR;
    PG8_WAIT_V(4); PG8_BAR;
    PG8_STAGE(PG8_SB(1, 0), cB + kstep, voffB); PG8_STAGE(PG8_SA(1, 0), cA + kstep, voffA); PG8_STAGE(PG8_SB(1, 1), cB + hstep + kstep, voffB);
    PG8_WAIT_V(6); PG8_BAR;
    PG8_STAMP();
    for (;;) {
        const bool has_next = S.next(ui + 1, nxt);
        const char* nA = has_next ? (const char*)g.A + (size_t)nxt.pm * tstep : cA; const char* nB = has_next ? (const char*)g.Bt + (size_t)nxt.pn * tstep : cB;
        for (int t = 0; t < nt; t += 2) {
            const bool last = (t == nt - 2);
            const char* a1 = cA + (size_t)(t + 1) * kstep;
            const char* a2 = last ? nA : cA + (size_t)(t + 2) * kstep; const char* b2 = last ? nB : cB + (size_t)(t + 2) * kstep;
            const char* a3 = a2 + kstep; const char* b3 = b2 + kstep;
            if (last && has_next) S.a_ready(nxt);
            PG8_LDB(B0, 0, 0); PG8_SCHED; PG8_LDA(At, 0, 0); PG8_STAGE(PG8_SA(1, 1), a1 + hstep, voffA);
            PG8_WAIT_L(8); PG8_BAR; PG8_WAIT_L(0); PG8_MMA(0, 0, At, B0); PG8_BAR; PG8_SCHED;
            PG8_LDB(B1, 0, 1); PG8_STAGE(PG8_SB(0, 0), b2, voffB);
            PG8_BAR; PG8_WAIT_L(0); PG8_MMA(0, 1, At, B1); PG8_BAR;
            PG8_LDA(At, 0, 1); PG8_STAGE(PG8_SA(0, 0), a2, voffA);
            PG8_BAR; PG8_WAIT_L(0); PG8_MMA(1, 0, At, B0); PG8_BAR; PG8_SCHED;
            PG8_STAGE(PG8_SB(0, 1), b2 + hstep, voffB);
            PG8_WAIT_V(6); PG8_BAR; PG8_MMA(1, 1, At, B1); PG8_BAR;
            PG8_LDB(B0, 1, 0); PG8_SCHED; PG8_LDA(At, 1, 0); PG8_STAGE(PG8_SA(0, 1), a2 + hstep, voffA);
            PG8_WAIT_L(8); PG8_BAR; PG8_WAIT_L(0); PG8_MMA(0, 0, At, B0); PG8_BAR; PG8_SCHED;
            PG8_LDB(B1, 1, 1); PG8_STAGE(PG8_SB(1, 0), b3, voffB);
            PG8_BAR; PG8_WAIT_L(0); PG8_MMA(0, 1, At, B1); PG8_BAR;
            PG8_LDA(At, 1, 1); PG8_STAGE(PG8_SA(1, 0), a3, voffA);
            PG8_BAR; PG8_WAIT_L(0); PG8_MMA(1, 0, At, B0); PG8_BAR; PG8_SCHED;
            PG8_STAGE(PG8_SB(1, 1), b3 + hstep, voffB);
            PG8_WAIT_V(6); PG8_BAR; PG8_MMA(1, 1, At, B1); PG8_BAR;
        }
        PG8_STAMP();
        if constexpr (!Epi::AFTER_DRAIN) { E(acc, cur, wr, wc, fr, fq); S.done(cur); }
        PG8_STAMP();
        if (!has_next) break;
#pragma unroll
        for (int a = 0; a < 2; ++a)
#pragma unroll
            for (int b = 0; b < 2; ++b)
#pragma unroll
                for (int m = 0; m < 4; ++m)
#pragma unroll
                    for (int n = 0; n < 2; ++n) acc[a][b][m][n] = (f32x4){0.f, 0.f, 0.f, 0.f};
        cur = nxt; cA = nA; cB = nB; ++ui;
    }
    PG8_WAIT_V(0);
    if (wr == 0) PG8_BAR;
    PG8_BAR;
    if constexpr (Epi::AFTER_DRAIN) { E.fused(acc, cur, wr, wc, fr, fq, lds, wid, lane); S.done(cur); }
    PG8_STAMP();
    if (STAMP && wid == 0) { stamps[lane] = lane < nts ? (((unsigned long long)(unsigned)ts_hi << 32) | (unsigned)ts_lo) : 0ull;
        if (lane == 62) stamps[62] = rt_entry; if (lane == 63) stamps[63] = (unsigned long long)wall_clock64(); }
#undef PG8_STAMP
#undef PG8_SA
#undef PG8_SB
#undef PG8_STAGE
#undef PG8_LDA
#undef PG8_LDB
#undef PG8_MMA
#undef PG8_WAIT_V
#undef PG8_WAIT_L
#undef PG8_BAR
#undef PG8_SCHED
}
}

#include <cstdio>
#include <ctime>
#include <cstdlib>
#include <cstring>
#include <cmath>
#include <vector>
#include <algorithm>
#define CK(x) do { hipError_t e_ = (x); if (e_ != hipSuccess) { fprintf(stderr, "HIP %s:%d %s\n", __FILE__, __LINE__, hipGetErrorString(e_)); exit(2); } } while (0)
using pg8::bf16_t; using pg8::bf16x8; using pg8::f32x4; using pg8::u32x4; using pg8::cvt_pk_bf16; using pg8::cvt_pk_nv;
#define LAS PG8_LAS

constexpr int D = 2048, SEQ = 2048, MTOK = 16384, DFF = 8192, INWP = 4352;
constexpr int COL_K = 1024, COL_V = 1280, COL_Z = 1536, COL_XBC = 2560, COL_DT = 4096;
constexpr size_t MiB = (size_t)1 << 20;
constexpr size_t WS_WBA = 0, WS_WMLP = 40 * MiB, WS_H = 104 * MiB, WS_PROJ = 168 * MiB, WS_YMIX = 304 * MiB, WS_YRAW = 368 * MiB, WS_XBC = 432 * MiB,
                 WS_DT = 480 * MiB, WS_DA = 481 * MiB, WS_ROPE = 482 * MiB, WS_U = 168 * MiB;
constexpr size_t WS_R = 40 * MiB, WS_K = 104 * MiB, WS_V = 168 * MiB, WS_L1W = 232 * MiB, WS_L1A = 240 * MiB, WS_L1G = 248 * MiB, WS_MIX = 256 * MiB,
                 WS_WDEC = 256 * MiB, WS_AA = 320 * MiB, WS_GG = 384 * MiB, WS_YG = 448 * MiB;
constexpr size_t WS_BAR = 39 * MiB;
constexpr int LDS_BYTES = 140 * 1024;

enum { K_PRE0 = 0, K_GEMMB, K_GEMMF, K_CONVSSD, K_MIX0, K_POST0, K_NORM, K_PRE1, K_MIXES, K_RWKV, K_NORMCONV };
constexpr int NSTEPS = 48, NOPS = 22, NCJ = 16;
#define REP_GEMMB 1
#define REP_MIX0 1
#define REP_RWKV 1
#define REP_ELEM 1

struct GemmOp { const bf16_t* A; const bf16_t* Bt; void* out; const float* bias; const float* res; int M, N, K, ldc, act, rot, pad0, pad1; };
struct ConvJob { const float* src; bf16_t* dst; int K, N, Kpad, Npad, tile0, ntiles; };
struct Params {
    const float* in[34];
    float* out; unsigned char* ws;
    GemmOp g[NOPS];
    ConvJob cj[NCJ];
    int kind[NSTEPS + 1]; int lo[NSTEPS + 1]; int hi[NSTEPS + 1];
    int step_lo, step_hi;
};

__device__ __forceinline__ float bf2f(unsigned short b) { return __uint_as_float(((unsigned)b) << 16); }
__device__ __forceinline__ float bflo(unsigned w) { return __uint_as_float(w << 16); }
__device__ __forceinline__ float bfhi(unsigned w) { return __uint_as_float(w & 0xffff0000u); }
__device__ __forceinline__ bf16_t f2bf(float f) { return (bf16_t)(cvt_pk_bf16(f, 0.f) & 0xffffu); }
template <int CTRL> __device__ __forceinline__ float dpp_add(float x) {
    const int y = __builtin_amdgcn_update_dpp(0, __builtin_bit_cast(int, x), CTRL, 0xf, 0xf, true);
    return x + __builtin_bit_cast(float, y); }
__device__ __forceinline__ float red8(float x) { x = dpp_add<0xB1>(x); x = dpp_add<0x4E>(x); x = dpp_add<0x141>(x); return x; }
__device__ __forceinline__ float red16(float x) { x = red8(x); x = dpp_add<0x140>(x); return x; }
__device__ __forceinline__ float wave_sum(float v) {
    v = red16(v);
    const float r0 = __builtin_bit_cast(float, __builtin_amdgcn_readlane(__builtin_bit_cast(int, v), 0)), r1 = __builtin_bit_cast(float, __builtin_amdgcn_readlane(__builtin_bit_cast(int, v), 16));
    const float r2 = __builtin_bit_cast(float, __builtin_amdgcn_readlane(__builtin_bit_cast(int, v), 32)), r3 = __builtin_bit_cast(float, __builtin_amdgcn_readlane(__builtin_bit_cast(int, v), 48));
    return (r0 + r1) + (r2 + r3); }
typedef float f32x2 __attribute__((ext_vector_type(2)));
__device__ __forceinline__ float sigmoidf_(float v) { return 1.0f / (1.0f + __expf(-v)); }
__device__ __forceinline__ void unpack8(const uint4 r, float (&f)[8]) {
    f[0] = bflo(r.x); f[1] = bfhi(r.x); f[2] = bflo(r.y); f[3] = bfhi(r.y); f[4] = bflo(r.z); f[5] = bfhi(r.z); f[6] = bflo(r.w); f[7] = bfhi(r.w); }

__device__ __forceinline__ float act_apply(float v, int act) {
    switch (act) {
        case 1: { const float r = fmaxf(v, 0.f); return r * r; }
        case 2: return 1.0f - 2.0f / (1.0f + __expf(2.0f * v));
        case 3: return sigmoidf_(v);
        case 4: return 0.60653066f * sigmoidf_(v);
        default: return v; }
}
struct EpiB {
    static constexpr bool PERM = true, AFTER_DRAIN = false;
    bf16_t* O; int ldc; const float* bias; int act;
    __device__ __forceinline__ void operator()(const f32x4 (&acc)[2][2][4][2], const pg8::Unit& u, int wr, int wc, int fr, int fq) const {
        const int row0 = u.pm * 256 + wr * 64 + fr, col0 = u.pn * 256 + wc * 32 + 8 * fq;
#pragma unroll
        for (int ai = 0; ai < 2; ++ai)
#pragma unroll
            for (int m = 0; m < 4; ++m) { bf16_t* rowp = O + (size_t)(row0 + ai * 128 + m * 16) * ldc + col0;
#pragma unroll
                for (int bj = 0; bj < 2; ++bj) { f32x4 v0 = acc[ai][bj][m][0], v1 = acc[ai][bj][m][1];
                    if (bias) { v0 += *(const f32x4*)(bias + col0 + bj * 128); v1 += *(const f32x4*)(bias + col0 + bj * 128 + 4); }
                    if (act) {
#pragma unroll
                        for (int j = 0; j < 4; ++j) { v0[j] = act_apply(v0[j], act); v1[j] = act_apply(v1[j], act); } }
                    u32x4 w; w.x = cvt_pk_bf16(v0[0], v0[1]); w.y = cvt_pk_bf16(v0[2], v0[3]); w.z = cvt_pk_bf16(v1[0], v1[1]); w.w = cvt_pk_bf16(v1[2], v1[3]);
                    *(u32x4*)(rowp + bj * 128) = w; } }
    }
};
struct EpiF {
    static constexpr bool PERM = false, AFTER_DRAIN = false;
    float* C; int ldc; const float* res;
    __device__ __forceinline__ void operator()(const f32x4 (&acc)[2][2][4][2], const pg8::Unit& u, int wr, int wc, int fr, int fq) const {
        const int row0 = u.pm * 256 + wr * 64 + fr, col0 = u.pn * 256 + wc * 32 + 4 * fq;
#pragma unroll
        for (int ai = 0; ai < 2; ++ai)
#pragma unroll
            for (int m = 0; m < 4; ++m) { const size_t ro = (size_t)(row0 + ai * 128 + m * 16) * ldc + col0;
#pragma unroll
                for (int bj = 0; bj < 2; ++bj)
#pragma unroll
                    for (int n = 0; n < 2; ++n) { const f32x4 r = *(const f32x4*)(res + ro + bj * 128 + n * 16); *(f32x4*)(C + ro + bj * 128 + n * 16) = acc[ai][bj][m][n] + r; } }
    }
};

__device__ __forceinline__ void convert_tiles(const Params& p, int jlo, int jhi, LAS unsigned char* lds) {
    const int tid = opq(threadIdx.x); LAS float* T = (LAS float*)lds;
    const int total = p.cj[jhi - 1].tile0 + p.cj[jhi - 1].ntiles;
    for (int tile = blockIdx.x; tile < total; tile += gridDim.x) {
        int j = jlo; while (j + 1 < jhi && tile >= p.cj[j + 1].tile0) ++j;
        const float* src = p.cj[j].src; bf16_t* dst = p.cj[j].dst; const int K = p.cj[j].K, N = p.cj[j].N, Kpad = p.cj[j].Kpad;
        const int local = tile - p.cj[j].tile0, nkt = Kpad >> 6, kt = local % nkt, nt = local / nkt;
        f32x4 v[8];
#pragma unroll
        for (int i = 0; i < 8; ++i) { const int idx = tid + i * 512, kr = idx >> 6, c4 = idx & 63, k = kt * 64 + kr, n = nt * 256 + c4 * 4;
            v[i] = (f32x4){0.f, 0.f, 0.f, 0.f};
            if (k < K && n < N) v[i] = *(const f32x4*)(src + (size_t)k * N + n); }
#pragma unroll
        for (int i = 0; i < 8; ++i) { const int idx = tid + i * 512, kr = idx >> 6, c4 = idx & 63;
            T[kr * 257 + c4 * 4 + 0] = v[i][0]; T[kr * 257 + c4 * 4 + 1] = v[i][1]; T[kr * 257 + c4 * 4 + 2] = v[i][2]; T[kr * 257 + c4 * 4 + 3] = v[i][3]; }
        __syncthreads();
#pragma unroll
        for (int i = 0; i < 4; ++i) { const int idx = tid + i * 512, nl = idx >> 3, kc = idx & 7; float f[8];
#pragma unroll
            for (int e = 0; e < 8; ++e) f[e] = T[(kc * 8 + e) * 257 + nl];
            u32x4 w; w.x = cvt_pk_nv(f[0], f[1]); w.y = cvt_pk_nv(f[2], f[3]); w.z = cvt_pk_nv(f[4], f[5]); w.w = cvt_pk_nv(f[6], f[7]);
            *(u32x4*)(dst + (size_t)(nt * 256 + nl) * Kpad + kt * 64 + kc * 8) = w; }
        __syncthreads();
    }
}

__device__ __forceinline__ void rope_table(const Params& p) {
    float2* tab = (float2*)(p.ws + WS_ROPE);
    for (int idx = blockIdx.x * 512 + opq(threadIdx.x); idx < SEQ * 32; idx += gridDim.x * 512) {
        const int t = idx >> 5, i = idx & 31;
        const float inv = exp2f(-(float)i * 0.41524101186092029f);
        const float angf = (float)t * inv;
        const double ang = (double)angf;
        const double q = rint(ang * 0.6366197723675814);
        const double f = fma(-q, 1.5707963267948966, ang), f2 = f * f;
        const double s = f * (1.0 + f2 * (-1.0 / 6 + f2 * (1.0 / 120 + f2 * (-1.0 / 5040 + f2 * (1.0 / 362880 + f2 * (-1.0 / 39916800))))));
        const double c = 1.0 + f2 * (-0.5 + f2 * (1.0 / 24 + f2 * (-1.0 / 720 + f2 * (1.0 / 40320 + f2 * (-1.0 / 3628800 + f2 * (1.0 / 479001600))))));
        const int qi = ((int)q) & 3;
        const double sn = (qi == 0) ? s : (qi == 1) ? c : (qi == 2) ? -s : -c;
        const double cs = (qi == 0) ? c : (qi == 1) ? -s : (qi == 2) ? -c : s;
        tab[idx] = make_float2((float)cs, (float)sn);
    }
}

__device__ __forceinline__ void norm_rows(const float* x, const float* g, bf16_t* h) {
    const int tid_ = opq(threadIdx.x); const int lane = tid_ & 63, wv = tid_ >> 6;
    f32x4 gg[8];
#pragma unroll
    for (int i = 0; i < 8; ++i) gg[i] = *(const f32x4*)(g + i * 256 + lane * 4);
    for (int row = blockIdx.x * 8 + wv; row < MTOK; row += gridDim.x * 8) {
        const float* xr = x + (size_t)row * D; f32x4 v[8]; float ss = 0.f;
#pragma unroll
        for (int i = 0; i < 8; ++i) v[i] = *(const f32x4*)(xr + i * 256 + lane * 4);
#pragma unroll
        for (int i = 0; i < 8; ++i) ss += v[i][0] * v[i][0] + v[i][1] * v[i][1] + v[i][2] * v[i][2] + v[i][3] * v[i][3];
        ss = wave_sum(ss); const float r = rsqrtf(ss * (1.0f / D) + 1e-6f);
#pragma unroll
        for (int i = 0; i < 8; ++i) {
            uint2 w; w.x = cvt_pk_nv(v[i][0] * r * gg[i][0], v[i][1] * r * gg[i][1]); w.y = cvt_pk_nv(v[i][2] * r * gg[i][2], v[i][3] * r * gg[i][3]);
            *(uint2*)(h + (size_t)row * D + i * 256 + lane * 4) = w; }
    }
}

__device__ __forceinline__ void mix_rows(const float* x, const float* g, const float* mixw, bf16_t* mixbase, int tok0, LAS unsigned char* lds) {
    const int tid = opq(threadIdx.x), lane = tid & 63, wv = tid >> 6, c = tid * 4;
    LAS float* rs = (LAS float*)lds;
    const f32x4 gg = *(const f32x4*)(g + c); f32x4 mw[6];
#pragma unroll
    for (int m = 0; m < 6; ++m) mw[m] = *(const f32x4*)(mixw + m * D + c);
    for (int chunk = blockIdx.x; chunk < 256; chunk += gridDim.x) {
        const int rl0 = chunk * 32, tokc = tok0 + rl0; const bool hasprev = (tokc & (SEQ - 1)) != 0;
        __syncthreads();
        for (int r = wv; r < 33; r += 8) {
            float ss = 0.f;
            if (r > 0 || hasprev) { const float* xr = x + (size_t)(tokc - 1 + r) * D; f32x4 v[8];
#pragma unroll
                for (int i = 0; i < 8; ++i) v[i] = *(const f32x4*)(xr + i * 256 + lane * 4);
#pragma unroll
                for (int i = 0; i < 8; ++i) ss += v[i][0] * v[i][0] + v[i][1] * v[i][1] + v[i][2] * v[i][2] + v[i][3] * v[i][3]; }
            ss = wave_sum(ss);
            if (lane == 0) rs[r] = (r > 0 || hasprev) ? rsqrtf(ss * (1.0f / D) + 1e-6f) : 0.f;
        }
        __syncthreads();
        f32x4 prev = (f32x4){0.f, 0.f, 0.f, 0.f};
        if (hasprev) { const f32x4 pv = *(const f32x4*)(x + (size_t)(tokc - 1) * D + c); const float rp = rs[0]; prev = pv * rp * gg; }
        for (int r0 = 0; r0 < 32; r0 += 4) {
            f32x4 xv[4];
#pragma unroll
            for (int u = 0; u < 4; ++u) xv[u] = *(const f32x4*)(x + (size_t)(tokc + r0 + u) * D + c);
#pragma unroll
            for (int u = 0; u < 4; ++u) { const float rr = rs[r0 + u + 1]; const f32x4 hn = xv[u] * rr * gg, xx = prev - hn;
#pragma unroll
                for (int m = 0; m < 6; ++m) { const f32x4 o = hn + xx * mw[m];
                    uint2 w; w.x = cvt_pk_nv(o[0], o[1]); w.y = cvt_pk_nv(o[2], o[3]);
                    *(uint2*)(mixbase + (size_t)m * 8192 * D + (size_t)(rl0 + r0 + u) * D + c) = w; }
                prev = hn; }
        }
    }
}

__device__ __forceinline__ void conv_ssd(const Params& p) {
    const bf16_t* proj = (const bf16_t*)(p.ws + WS_PROJ); bf16_t* xbc = (bf16_t*)(p.ws + WS_XBC);
    const float* cw = p.in[6]; const float* cb = p.in[7];
    for (int idx = blockIdx.x * 512 + opq(threadIdx.x); idx < MTOK * 192; idx += gridDim.x * 512) {
        const int tok = idx / 192, c8 = idx - tok * 192, tpos = tok & (SEQ - 1), c = c8 * 8;
        float acc[8];
        { const f32x4 b0 = *(const f32x4*)(cb + c), b1 = *(const f32x4*)(cb + c + 4);
#pragma unroll
          for (int e = 0; e < 4; ++e) { acc[e] = b0[e]; acc[4 + e] = b1[e]; } }
#pragma unroll
        for (int j = 0; j < 4; ++j) { if (tpos - 3 + j >= 0) {
            const uint4 r = *(const uint4*)(proj + (size_t)(tok - 3 + j) * INWP + COL_XBC + c); float f[8]; unpack8(r, f);
            const f32x4 w0 = *(const f32x4*)(cw + j * 1536 + c), w1 = *(const f32x4*)(cw + j * 1536 + c + 4);
#pragma unroll
            for (int e = 0; e < 4; ++e) { acc[e] += w0[e] * f[e]; acc[4 + e] += w1[e] * f[4 + e]; } } }
#pragma unroll
        for (int e = 0; e < 8; ++e) acc[e] = acc[e] * sigmoidf_(acc[e]);
        u32x4 w; w.x = cvt_pk_nv(acc[0], acc[1]); w.y = cvt_pk_nv(acc[2], acc[3]); w.z = cvt_pk_nv(acc[4], acc[5]); w.w = cvt_pk_nv(acc[6], acc[7]);
        *(u32x4*)(xbc + (size_t)tok * 1536 + c) = w;
    }
    float* dt = (float*)(p.ws + WS_DT); float* da = (float*)(p.ws + WS_DA);
    for (int idx = blockIdx.x * 512 + opq(threadIdx.x); idx < MTOK * 16; idx += gridDim.x * 512) {
        const int tok = idx >> 4, hh = idx & 15;
        const float v = bf2f(proj[(size_t)tok * INWP + COL_DT + hh]) + p.in[8][hh];
        const float d = fmaxf(v, 0.f) + __logf(1.0f + __expf(-fabsf(v)));
        dt[idx] = d; da[idx] = __expf(-d * __expf(p.in[9][hh]));
    }
}

__device__ __forceinline__ void ssd_scan_job(const Params& p, int job, LAS unsigned char* lds) {
    const int tid = opq(threadIdx.x);
    const int b = job >> 5, hs = (job >> 1) & 15, half = job & 1, grp = hs >> 3, p0 = half * 32;
    const bf16_t* xbc = (const bf16_t*)(p.ws + WS_XBC) + (size_t)b * SEQ * 1536;
    const float* dtp = (const float*)(p.ws + WS_DT) + (size_t)b * SEQ * 16 + hs;
    const float* dap = (const float*)(p.ws + WS_DA) + (size_t)b * SEQ * 16 + hs;
    float* yraw = (float*)(p.ws + WS_YRAW) + (size_t)b * SEQ * 1024 + hs * 64 + p0;
    const float dskip = p.in[10][hs];
    constexpr int BUF_F = 9280;
    LAS float* L = (LAS float*)lds;
    int grow[3], gcol[3], loff[3];
#pragma unroll
    for (int k = 0; k < 3; ++k) { const int q = tid + k * 512, row = q / 36, pc = q - row * 36; grow[k] = row;
        if (pc < 4) { gcol[k] = hs * 64 + p0 + pc * 8; loff[k] = row * 32 + pc * 8; }
        else if (pc < 20) { gcol[k] = 1024 + grp * 128 + (pc - 4) * 8; loff[k] = 1024 + row * 128 + (pc - 4) * 8; }
        else { gcol[k] = 1280 + grp * 128 + (pc - 20) * 8; loff[k] = 5120 + row * 128 + (pc - 20) * 8; } }
    uint4 rg[3]; float sc = 0.f;
#define SSD_ISSUE(t0) do { _Pragma("unroll") for (int k = 0; k < 3; ++k) if (tid + k * 512 < 1152) rg[k] = *(const uint4*)(xbc + (size_t)((t0) + grow[k]) * 1536 + gcol[k]); \
        if (tid < 32) sc = dtp[((t0) + tid) * 16]; else if (tid < 64) sc = dap[((t0) + tid - 32) * 16]; } while (0)
#define SSD_COMMIT(buf) do { LAS float* Lc = L + (buf) * BUF_F; _Pragma("unroll") for (int k = 0; k < 3; ++k) if (tid + k * 512 < 1152) { float f[8]; unpack8(rg[k], f); \
            *(LAS f32x4*)(Lc + loff[k]) = (f32x4){f[0], f[1], f[2], f[3]}; *(LAS f32x4*)(Lc + loff[k] + 4) = (f32x4){f[4], f[5], f[6], f[7]}; } \
        if (tid < 32) Lc[9216 + tid] = sc; else if (tid < 64) Lc[9248 + tid - 32] = sc; } while (0)
    f32x2 hA[4], hB[4];
#pragma unroll
    for (int i = 0; i < 4; ++i) { hA[i] = (f32x2){0.f, 0.f}; hB[i] = (f32x2){0.f, 0.f}; }
    const int prow = (tid >> 4) & 15, nseg = tid & 15;
    __syncthreads();
    SSD_ISSUE(0); SSD_COMMIT(0); __syncthreads();
    for (int ch = 0; ch < 64; ++ch) {
        const int cur = ch & 1;
        if (ch + 1 < 64) SSD_ISSUE((ch + 1) * 32);
        LAS float* Lb = L + cur * BUF_F; LAS float* yb = L + 2 * BUF_F + cur * 1024;
        if (tid < 256) {
        for (int tg = 0; tg < 32; tg += 16) {
            float yA[16], yB[16];
            LAS float* qb = Lb + 1024 + tg * 128 + nseg * 8;
            f32x4 b0 = *(LAS f32x4*)(qb), b1 = *(LAS f32x4*)(qb + 4), c0 = *(LAS f32x4*)(qb + 4096), c1 = *(LAS f32x4*)(qb + 4100);
            float dA = Lb[9248 + tg], xa = Lb[tg * 32 + prow], xb = Lb[tg * 32 + prow + 16], dtv = Lb[9216 + tg];
#pragma unroll
            for (int tt = 0; tt < 16; ++tt) {
                f32x4 nb0, nb1, nc0, nc1; float ndA, nxa, nxb, ndtv;
                if (tt + 1 < 16) { LAS float* q = qb + (tt + 1) * 128; nb0 = *(LAS f32x4*)(q); nb1 = *(LAS f32x4*)(q + 4); nc0 = *(LAS f32x4*)(q + 4096); nc1 = *(LAS f32x4*)(q + 4100);
                    ndA = Lb[9248 + tg + tt + 1]; nxa = Lb[(tg + tt + 1) * 32 + prow]; nxb = Lb[(tg + tt + 1) * 32 + prow + 16]; ndtv = Lb[9216 + tg + tt + 1]; }
                __builtin_amdgcn_sched_barrier(0);
                const float xdta = xa * dtv, xdtb = xb * dtv;
                const f32x2 dA2 = (f32x2){dA, dA}, xa2 = (f32x2){xdta, xdta}, xb2 = (f32x2){xdtb, xdtb};
                hA[0] = hA[0] * dA2 + xa2 * b0.xy; hB[0] = hB[0] * dA2 + xb2 * b0.xy; hA[1] = hA[1] * dA2 + xa2 * b0.zw; hB[1] = hB[1] * dA2 + xb2 * b0.zw;
                hA[2] = hA[2] * dA2 + xa2 * b1.xy; hB[2] = hB[2] * dA2 + xb2 * b1.xy; hA[3] = hA[3] * dA2 + xa2 * b1.zw; hB[3] = hB[3] * dA2 + xb2 * b1.zw;
                f32x2 ya = hA[0] * c0.xy, yb2 = hB[0] * c0.xy; ya = hA[1] * c0.zw + ya; yb2 = hB[1] * c0.zw + yb2; ya = hA[2] * c1.xy + ya; yb2 = hB[2] * c1.xy + yb2; ya = hA[3] * c1.zw + ya; yb2 = hB[3] * c1.zw + yb2;
                float ra = ya.x + ya.y, rb = yb2.x + yb2.y;
                ra = dpp_add<0xB1>(ra); rb = dpp_add<0xB1>(rb); ra = dpp_add<0x4E>(ra); rb = dpp_add<0x4E>(rb); ra = dpp_add<0x141>(ra); rb = dpp_add<0x141>(rb); ra = dpp_add<0x140>(ra); rb = dpp_add<0x140>(rb);
                yA[tt] = ra + dskip * xa; yB[tt] = rb + dskip * xb;
                __builtin_amdgcn_sched_barrier(0);
                if (tt + 1 < 16) { b0 = nb0; b1 = nb1; c0 = nc0; c1 = nc1; dA = ndA; xa = nxa; xb = nxb; dtv = ndtv; }
            }
            if (nseg == 0) {
#pragma unroll
                for (int tt = 0; tt < 16; ++tt) { yb[(tg + tt) * 32 + prow] = yA[tt]; yb[(tg + tt) * 32 + prow + 16] = yB[tt]; } }
        }
        }
        if (ch + 1 < 64) SSD_COMMIT(cur ^ 1);
        __syncthreads();
        if (tid < 256) { const f32x4 v = *(LAS f32x4*)(yb + (tid >> 3) * 32 + (tid & 7) * 4); *(f32x4*)(yraw + (size_t)(ch * 32 + (tid >> 3)) * 1024 + (tid & 7) * 4) = v; }
    }
#undef SSD_ISSUE
#undef SSD_COMMIT
}
__device__ __forceinline__ void attn_job(const Params& p, int job, LAS unsigned char* lds) {
    const int tid = opq(threadIdx.x), lane = tid & 63, w = tid >> 6, fr = lane & 15, fq = lane >> 4;
    const int b = job >> 6, kvh = (job >> 4) & 3, nb = job & 15;
    const bf16_t* proj = (const bf16_t*)(p.ws + WS_PROJ) + (size_t)b * SEQ * INWP;
    const float2* rope = (const float2*)(p.ws + WS_ROPE);
    LAS bf16_t* Ks = (LAS bf16_t*)lds;
    LAS bf16_t* Vt = (LAS bf16_t*)(lds + 36864);
    LAS bf16_t* Ps = (LAS bf16_t*)(lds + 70656) + w * 16 * 264;
    __syncthreads();
    if (tid < 256) {
        const int kr = tid, tk = (nb - 1) * 128 + kr;
        if (tk >= 0) {
            const bf16_t* src = proj + (size_t)tk * INWP + COL_K + kvh * 64; float x[64]; float ss = 0.f;
#pragma unroll
            for (int c = 0; c < 8; ++c) { const uint4 r = *(const uint4*)(src + c * 8); float f[8]; unpack8(r, f);
#pragma unroll
                for (int e = 0; e < 8; ++e) { x[c * 8 + e] = f[e]; ss += f[e] * f[e]; } }
            const float rinv = rsqrtf(ss * (1.0f / 64) + 1e-6f); const float* kn = p.in[13];
#pragma unroll
            for (int i = 0; i < 64; ++i) x[i] = x[i] * rinv * kn[i];
#pragma unroll
            for (int c = 0; c < 4; ++c) { float o1[8], o2[8];
#pragma unroll
                for (int e = 0; e < 8; ++e) { const int i = c * 8 + e; const float2 cs = rope[tk * 32 + i]; o1[e] = x[i] * cs.x - x[i + 32] * cs.y; o2[e] = x[i + 32] * cs.x + x[i] * cs.y; }
                u32x4 w1, w2; w1.x = cvt_pk_bf16(o1[0], o1[1]); w1.y = cvt_pk_bf16(o1[2], o1[3]); w1.z = cvt_pk_bf16(o1[4], o1[5]); w1.w = cvt_pk_bf16(o1[6], o1[7]);
                w2.x = cvt_pk_bf16(o2[0], o2[1]); w2.y = cvt_pk_bf16(o2[2], o2[3]); w2.z = cvt_pk_bf16(o2[4], o2[5]); w2.w = cvt_pk_bf16(o2[6], o2[7]);
                *(LAS u32x4*)(Ks + kr * 72 + c * 8) = w1; *(LAS u32x4*)(Ks + kr * 72 + 32 + c * 8) = w2;
                __builtin_amdgcn_sched_barrier(0); }
        } else {
#pragma unroll
            for (int c = 0; c < 8; ++c) *(LAS u32x4*)(Ks + kr * 72 + c * 8) = (u32x4){0u, 0u, 0u, 0u};
        }
    } else {
        const int kr = tid - 256, tk = (nb - 1) * 128 + kr;
        const bf16_t* src = proj + (size_t)(tk < 0 ? 0 : tk) * INWP + COL_V + kvh * 64;
#pragma unroll
        for (int c = 0; c < 8; ++c) { uint4 r = *(const uint4*)(src + c * 8); if (tk < 0) r = make_uint4(0u, 0u, 0u, 0u);
            Vt[(c * 8 + 0) * 264 + kr] = (bf16_t)(r.x & 0xffffu); Vt[(c * 8 + 1) * 264 + kr] = (bf16_t)(r.x >> 16);
            Vt[(c * 8 + 2) * 264 + kr] = (bf16_t)(r.y & 0xffffu); Vt[(c * 8 + 3) * 264 + kr] = (bf16_t)(r.y >> 16);
            Vt[(c * 8 + 4) * 264 + kr] = (bf16_t)(r.z & 0xffffu); Vt[(c * 8 + 5) * 264 + kr] = (bf16_t)(r.z >> 16);
            Vt[(c * 8 + 6) * 264 + kr] = (bf16_t)(r.w & 0xffffu); Vt[(c * 8 + 7) * 264 + kr] = (bf16_t)(r.w >> 16); }
    }
    __syncthreads();
    for (int h4 = 0; h4 < 4; ++h4) {
    const int hq = kvh * 4 + h4;
    bf16x8 qa[2];
    { const int tq = nb * 128 + w * 16 + fr; const bf16_t* src = proj + (size_t)tq * INWP + hq * 64;
      const uint4 r0 = *(const uint4*)(src + fq * 8), r1 = *(const uint4*)(src + 32 + fq * 8); float x1[8], x2[8]; unpack8(r0, x1); unpack8(r1, x2);
      float ss = 0.f;
#pragma unroll
      for (int e = 0; e < 8; ++e) ss += x1[e] * x1[e] + x2[e] * x2[e];
      ss += __shfl_xor(ss, 16); ss += __shfl_xor(ss, 32);
      const float rinv = rsqrtf(ss * (1.0f / 64) + 1e-6f) * 0.125f; const float* qn = p.in[12]; float o1[8], o2[8];
#pragma unroll
      for (int e = 0; e < 8; ++e) { const int i = fq * 8 + e; const float a = x1[e] * rinv * qn[i], c = x2[e] * rinv * qn[i + 32]; const float2 cs = rope[tq * 32 + i];
          o1[e] = a * cs.x - c * cs.y; o2[e] = c * cs.x + a * cs.y; }
      u32x4 w1, w2; w1.x = cvt_pk_bf16(o1[0], o1[1]); w1.y = cvt_pk_bf16(o1[2], o1[3]); w1.z = cvt_pk_bf16(o1[4], o1[5]); w1.w = cvt_pk_bf16(o1[6], o1[7]);
      w2.x = cvt_pk_bf16(o2[0], o2[1]); w2.y = cvt_pk_bf16(o2[2], o2[3]); w2.z = cvt_pk_bf16(o2[4], o2[5]); w2.w = cvt_pk_bf16(o2[6], o2[7]);
      qa[0] = __builtin_bit_cast(bf16x8, w1); qa[1] = __builtin_bit_cast(bf16x8, w2); }
    f32x4 s[16];
#pragma unroll
    for (int j = 0; j < 16; ++j) { f32x4 acc = (f32x4){0.f, 0.f, 0.f, 0.f};
#pragma unroll
        for (int ks = 0; ks < 2; ++ks) { const bf16x8 kb = *(LAS bf16x8*)(Ks + (j * 16 + fr) * 72 + ks * 32 + fq * 8); acc = __builtin_amdgcn_mfma_f32_16x16x32_bf16(qa[ks], kb, acc, 0, 0, 0); }
        s[j] = acc; }
    const float sink = p.in[14][hq];
    float mx[4], inv[4];
#pragma unroll
    for (int i = 0; i < 4; ++i) { const int qi = w * 16 + fq * 4 + i + 128; float m = -3.0e38f;
#pragma unroll
        for (int j = 0; j < 16; ++j) { const int kj = j * 16 + fr; const bool ok = (kj <= qi) && (qi - kj < 128) && (nb > 0 || kj >= 128); s[j][i] = ok ? s[j][i] : -3.0e38f; m = fmaxf(m, s[j][i]); }
        m = fmaxf(m, __shfl_xor(m, 1)); m = fmaxf(m, __shfl_xor(m, 2)); m = fmaxf(m, __shfl_xor(m, 4)); m = fmaxf(m, __shfl_xor(m, 8));
        m = fmaxf(m, sink); mx[i] = m; float l = 0.f;
#pragma unroll
        for (int j = 0; j < 16; ++j) { const float e = (s[j][i] > -1.0e38f) ? __expf(s[j][i] - m) : 0.f; s[j][i] = e; l += e; }
        l += __shfl_xor(l, 1); l += __shfl_xor(l, 2); l += __shfl_xor(l, 4); l += __shfl_xor(l, 8);
        inv[i] = 1.0f / (l + __expf(sink - m)); }
#pragma unroll
    for (int j = 0; j < 16; ++j)
#pragma unroll
        for (int i = 0; i < 4; ++i) Ps[(fq * 4 + i) * 264 + j * 16 + fr] = f2bf(s[j][i] * inv[i]);
    f32x4 o[4];
#pragma unroll
    for (int nd = 0; nd < 4; ++nd) o[nd] = (f32x4){0.f, 0.f, 0.f, 0.f};
#pragma unroll
    for (int kk = 0; kk < 8; ++kk) { const bf16x8 pa = *(LAS bf16x8*)(Ps + fr * 264 + kk * 32 + fq * 8);
#pragma unroll
        for (int nd = 0; nd < 4; ++nd) { const bf16x8 vb = *(LAS bf16x8*)(Vt + (nd * 16 + fr) * 264 + kk * 32 + fq * 8); o[nd] = __builtin_amdgcn_mfma_f32_16x16x32_bf16(pa, vb, o[nd], 0, 0, 0); } }
    bf16_t* ymix = (bf16_t*)(p.ws + WS_YMIX) + (size_t)b * SEQ * D + hq * 64;
#pragma unroll
    for (int nd = 0; nd < 4; ++nd)
#pragma unroll
        for (int i = 0; i < 4; ++i) ymix[(size_t)(nb * 128 + w * 16 + fq * 4 + i) * D + nd * 16 + fr] = f2bf(o[nd][i]);
    }
}

__device__ __forceinline__ void post_ssd(const Params& p) {
    const int tid_ = opq(threadIdx.x); const int lane = tid_ & 63, wv = tid_ >> 6;
    const float* yraw = (const float*)(p.ws + WS_YRAW); const bf16_t* proj = (const bf16_t*)(p.ws + WS_PROJ); bf16_t* ymix = (bf16_t*)(p.ws + WS_YMIX);
    for (int it = blockIdx.x * 8 + wv; it < MTOK * 2; it += gridDim.x * 8) {
        const int tok = it >> 1, grp = it & 1, c = grp * 512 + lane * 8;
        const f32x4 y0 = *(const f32x4*)(yraw + (size_t)tok * 1024 + c), y1 = *(const f32x4*)(yraw + (size_t)tok * 1024 + c + 4);
        const uint4 zr = *(const uint4*)(proj + (size_t)tok * INWP + COL_Z + c); float z[8], y[8]; unpack8(zr, z); float ss = 0.f;
#pragma unroll
        for (int e = 0; e < 8; ++e) { const float yy = (e < 4 ? y0[e] : y1[e - 4]); y[e] = yy * z[e] * sigmoidf_(z[e]); ss += y[e] * y[e]; }
        ss = wave_sum(ss); const float r = rsqrtf(ss * (1.0f / 512) + 1e-6f);
        const f32x4 n0 = *(const f32x4*)(p.in[11] + c), n1 = *(const f32x4*)(p.in[11] + c + 4);
        u32x4 w; w.x = cvt_pk_nv(y[0] * r * n0[0], y[1] * r * n0[1]); w.y = cvt_pk_nv(y[2] * r * n0[2], y[3] * r * n0[3]);
        w.z = cvt_pk_nv(y[4] * r * n1[0], y[5] * r * n1[1]); w.w = cvt_pk_nv(y[6] * r * n1[2], y[7] * r * n1[3]);
        *(u32x4*)(ymix + (size_t)tok * D + 1024 + c) = w;
    }
}

__device__ __forceinline__ float half_sum(float v, bool lo) {
    v = red16(v);
    const float r0 = __builtin_bit_cast(float, __builtin_amdgcn_readlane(__builtin_bit_cast(int, v), 0)), r1 = __builtin_bit_cast(float, __builtin_amdgcn_readlane(__builtin_bit_cast(int, v), 16));
    const float r2 = __builtin_bit_cast(float, __builtin_amdgcn_readlane(__builtin_bit_cast(int, v), 32)), r3 = __builtin_bit_cast(float, __builtin_amdgcn_readlane(__builtin_bit_cast(int, v), 48));
    return lo ? (r0 + r1) : (r2 + r3); }
__device__ __forceinline__ void rwkv_scan_job(const Params& p, int job, LAS unsigned char* lds) {
    const int tid = opq(threadIdx.x), lane = tid & 63, l32 = lane & 31; const bool lo = lane < 32;
    const int b = job >> 5, hh = job & 31;
    LAS float* L = (LAS float*)lds;
    const bool producer = tid >= 256;
    const int pw = (tid >> 6) & 3;
    const int tl0 = 2 * pw + (lane >> 5);
    const size_t wbase = ((size_t)b * SEQ * D + hh * 64) / 2 + l32 + (size_t)tl0 * (D / 2);
    const unsigned* R32 = (const unsigned*)(p.ws + WS_R) + wbase; const unsigned* K32 = (const unsigned*)(p.ws + WS_K) + wbase; const unsigned* V32 = (const unsigned*)(p.ws + WS_V) + wbase;
    const unsigned* E32 = (const unsigned*)(p.ws + WS_WDEC) + wbase; const unsigned* A32 = (const unsigned*)(p.ws + WS_AA) + wbase; const unsigned* G32 = (const unsigned*)(p.ws + WS_GG) + wbase;
    unsigned* Y32 = (unsigned*)(p.ws + WS_YG) + wbase;
    const int ci = hh * 64 + 2 * l32;
    const float2 kkw = *(const float2*)(p.in[25] + ci), kaw = *(const float2*)(p.in[26] + ci), rkw = *(const float2*)(p.in[27] + ci), lnw = *(const float2*)(p.in[32] + ci), lnb = *(const float2*)(p.in[33] + ci);
    unsigned rw[2], kw[2], vw[2], ew[2], aw[2], gw[2];
    const int oo = tl0 * 64 + 2 * l32;
#define RW_ISSUE(t0) do { _Pragma("unroll") for (int i2 = 0; i2 < 2; ++i2) { const size_t off = (size_t)((t0) + 8 * i2) * (D / 2); rw[i2] = R32[off]; kw[i2] = K32[off]; vw[i2] = V32[off]; ew[i2] = E32[off]; aw[i2] = A32[off]; gw[i2] = G32[off]; } } while (0)
#define RW_COMMIT(buf) do { _Pragma("unroll") for (int i2 = 0; i2 < 2; ++i2) { LAS float* Lc = L + (buf) * 8192 + oo + i2 * 512; \
        const float r0_ = bflo(rw[i2]), r1_ = bfhi(rw[i2]), k0_ = bflo(kw[i2]), k1_ = bfhi(kw[i2]), v0_ = bflo(vw[i2]), v1_ = bfhi(vw[i2]), e0_ = bflo(ew[i2]), e1_ = bfhi(ew[i2]), a0_ = bflo(aw[i2]), a1_ = bfhi(aw[i2]), g0_ = bflo(gw[i2]), g1_ = bfhi(gw[i2]); \
        const float kkv0 = k0_ * kkw.x, kkv1 = k1_ * kkw.y; const float ssq = half_sum(kkv0 * kkv0 + kkv1 * kkv1, lo); const float rn = rsqrtf(fmaxf(ssq, 1e-24f)); const float kn0 = kkv0 * rn, kn1 = kkv1 * rn; \
        const float km0 = k0_ * (1.0f + (a0_ - 1.0f) * kaw.x), km1 = k1_ * (1.0f + (a1_ - 1.0f) * kaw.y); const float bonus = half_sum(r0_ * km0 * rkw.x + r1_ * km1 * rkw.y, lo); \
        *(LAS f32x2*)(Lc) = (f32x2){-kn0, -kn1}; *(LAS f32x2*)(Lc + 1024) = (f32x2){__expf(-e0_), __expf(-e1_)}; *(LAS f32x2*)(Lc + 2048) = (f32x2){kn0 * a0_, kn1 * a1_}; *(LAS f32x2*)(Lc + 3072) = (f32x2){km0, km1}; \
        *(LAS f32x2*)(Lc + 4096) = (f32x2){r0_, r1_}; *(LAS f32x2*)(Lc + 5120) = (f32x2){v0_, v1_}; *(LAS f32x2*)(Lc + 6144) = (f32x2){g0_, g1_}; *(LAS f32x2*)(Lc + 7168) = (f32x2){bonus * v0_, bonus * v1_}; } } while (0)
#define RW_OUTPUT(chp) do { LAS float* Lo = L + ((chp) & 1) * 8192; LAS float* yo = L + 16384 + ((chp) & 1) * 1024; _Pragma("unroll") for (int i2 = 0; i2 < 2; ++i2) { const int o2 = oo + i2 * 512; \
        const f32x2 y = *(LAS f32x2*)(yo + o2); \
        const float mu = half_sum(y.x + y.y, lo) * (1.0f / 64), d0 = y.x - mu, d1 = y.y - mu, var = half_sum(d0 * d0 + d1 * d1, lo) * (1.0f / 64), rs = rsqrtf(var + 64e-5f); \
        const f32x2 bv = *(LAS f32x2*)(Lo + 7168 + o2), gg = *(LAS f32x2*)(Lo + 6144 + o2); \
        Y32[(size_t)((chp) * 16 + 8 * i2) * (D / 2)] = cvt_pk_nv((d0 * rs * lnw.x + lnb.x + bv.x) * gg.x, (d1 * rs * lnw.y + lnb.y + bv.y) * gg.y); } } while (0)
    f32x2 SA[4], SB[4];
#pragma unroll
    for (int i = 0; i < 4; ++i) { SA[i] = (f32x2){0.f, 0.f}; SB[i] = (f32x2){0.f, 0.f}; }
    const int rp = (tid >> 3) & 31, ks = tid & 7;
    __syncthreads();
    if (producer) { RW_ISSUE(0); RW_COMMIT(0); RW_ISSUE(16); }
    __syncthreads();
    for (int ch = 0; ch < 128; ++ch) {
        const int cur = ch & 1;
        if (producer) {
            if (ch >= 1) RW_OUTPUT(ch - 1);
            if (ch + 1 < 128) RW_COMMIT(cur ^ 1);
            if (ch + 2 < 128) RW_ISSUE((ch + 2) * 16);
        } else {
            LAS float* Lb = L + cur * 8192; LAS float* yb = L + 16384 + cur * 1024;
            float yA[16], yB[16];
            LAS float* q0 = Lb + ks * 8;
            f32x4 a0 = *(LAS f32x4*)(q0), a1 = *(LAS f32x4*)(q0 + 4), w0 = *(LAS f32x4*)(q0 + 1024), w1 = *(LAS f32x4*)(q0 + 1028), b0 = *(LAS f32x4*)(q0 + 2048), b1 = *(LAS f32x4*)(q0 + 2052);
            f32x4 k0 = *(LAS f32x4*)(q0 + 3072), k1 = *(LAS f32x4*)(q0 + 3076), r0 = *(LAS f32x4*)(q0 + 4096), r1 = *(LAS f32x4*)(q0 + 4100);
            float va = Lb[5120 + rp], vb = Lb[5120 + rp + 32];
#pragma unroll
            for (int t = 0; t < 16; ++t) {
                f32x4 na0, na1, nw0, nw1, nb0, nb1, nk0, nk1, nr0, nr1; float nva, nvb;
                if (t + 1 < 16) { LAS float* q = q0 + (t + 1) * 64;
                    na0 = *(LAS f32x4*)(q); na1 = *(LAS f32x4*)(q + 4); nw0 = *(LAS f32x4*)(q + 1024); nw1 = *(LAS f32x4*)(q + 1028); nb0 = *(LAS f32x4*)(q + 2048); nb1 = *(LAS f32x4*)(q + 2052);
                    nk0 = *(LAS f32x4*)(q + 3072); nk1 = *(LAS f32x4*)(q + 3076); nr0 = *(LAS f32x4*)(q + 4096); nr1 = *(LAS f32x4*)(q + 4100); nva = Lb[5120 + (t + 1) * 64 + rp]; nvb = Lb[5120 + (t + 1) * 64 + rp + 32]; }
                __builtin_amdgcn_sched_barrier(0);
                f32x2 ca = SA[0] * a0.xy, cb = SB[0] * a0.xy; ca = SA[1] * a0.zw + ca; cb = SB[1] * a0.zw + cb; ca = SA[2] * a1.xy + ca; cb = SB[2] * a1.xy + cb; ca = SA[3] * a1.zw + ca; cb = SB[3] * a1.zw + cb;
                float sa = ca.x + ca.y, sb = cb.x + cb.y;
                sa = dpp_add<0xB1>(sa); sb = dpp_add<0xB1>(sb); sa = dpp_add<0x4E>(sa); sb = dpp_add<0x4E>(sb); sa = dpp_add<0x141>(sa); sb = dpp_add<0x141>(sb);
                const f32x2 sa2 = (f32x2){sa, sa}, sb2 = (f32x2){sb, sb}, va2 = (f32x2){va, va}, vb2 = (f32x2){vb, vb};
                SA[0] = SA[0] * w0.xy + (sa2 * b0.xy + va2 * k0.xy); SB[0] = SB[0] * w0.xy + (sb2 * b0.xy + vb2 * k0.xy);
                SA[1] = SA[1] * w0.zw + (sa2 * b0.zw + va2 * k0.zw); SB[1] = SB[1] * w0.zw + (sb2 * b0.zw + vb2 * k0.zw);
                SA[2] = SA[2] * w1.xy + (sa2 * b1.xy + va2 * k1.xy); SB[2] = SB[2] * w1.xy + (sb2 * b1.xy + vb2 * k1.xy);
                SA[3] = SA[3] * w1.zw + (sa2 * b1.zw + va2 * k1.zw); SB[3] = SB[3] * w1.zw + (sb2 * b1.zw + vb2 * k1.zw);
                f32x2 ya = SA[0] * r0.xy, yb2 = SB[0] * r0.xy; ya = SA[1] * r0.zw + ya; yb2 = SB[1] * r0.zw + yb2; ya = SA[2] * r1.xy + ya; yb2 = SB[2] * r1.xy + yb2; ya = SA[3] * r1.zw + ya; yb2 = SB[3] * r1.zw + yb2;
                float ra = ya.x + ya.y, rb = yb2.x + yb2.y;
                ra = dpp_add<0xB1>(ra); rb = dpp_add<0xB1>(rb); ra = dpp_add<0x4E>(ra); rb = dpp_add<0x4E>(rb); ra = dpp_add<0x141>(ra); rb = dpp_add<0x141>(rb);
                yA[t] = ra; yB[t] = rb;
                __builtin_amdgcn_sched_barrier(0);
                if (t + 1 < 16) { a0 = na0; a1 = na1; w0 = nw0; w1 = nw1; b0 = nb0; b1 = nb1; k0 = nk0; k1 = nk1; r0 = nr0; r1 = nr1; va = nva; vb = nvb; }
            }
            if (ks == 0) {
#pragma unroll
                for (int t = 0; t < 16; ++t) { yb[t * 64 + rp] = yA[t]; yb[t * 64 + rp + 32] = yB[t]; } }
        }
        __syncthreads();
    }
    if (producer) RW_OUTPUT(127);
#undef RW_ISSUE
#undef RW_COMMIT
#undef RW_OUTPUT
}

#define XB_TMO      128
#define XB_XCNT(j)  (256  + 64 * (j))
#define XB_XSUB(j)  (1280 + 64 * (j))
#define XB_XGEN(j)  (2304 + 64 * (j))
#define XB_TOP      3328
#define XB_TOPGEN   3392
#define XCD_BAR_WORDS 3456
#define XB_SPIN_CAP (1u << 18)

__device__ __forceinline__ unsigned xb_ld(unsigned* p)              { return __hip_atomic_load(p, __ATOMIC_RELAXED, __HIP_MEMORY_SCOPE_AGENT); }
__device__ __forceinline__ unsigned xb_add(unsigned* p, unsigned v) { return __hip_atomic_fetch_add(p, v, __ATOMIC_RELAXED, __HIP_MEMORY_SCOPE_AGENT); }
__device__ __forceinline__ unsigned xb_xcc_id() { return (unsigned)__builtin_amdgcn_s_getreg((3 << 11) | 20) & 0xFu; }
#define XB_SPIN(cond, bar) do { unsigned _sp = 0; while (cond) { __builtin_amdgcn_s_sleep(1); \
    if ((++_sp & 255u) == 0u) { if (xb_ld(&(bar)[XB_TMO])) break; if (_sp > XB_SPIN_CAP) { atomicAdd(&(bar)[XB_TMO], 1u); break; } } } } while (0)

struct XcdBarrier {
    unsigned* bar; unsigned x;
    volatile LAS unsigned* st;
};

__device__ __forceinline__ XcdBarrier xcd_barrier_post(unsigned* bar, volatile LAS unsigned* st) {
    XcdBarrier b; b.bar = bar; b.x = xb_xcc_id(); b.st = st;
    if (threadIdx.x == 0) (void)xb_add(&bar[XB_XCNT(b.x)], 1u);
    return b;
}
__device__ __forceinline__ void xcd_barrier_complete(unsigned* bar, unsigned x, unsigned& nloc, unsigned& nx) {
    const unsigned G = gridDim.x * gridDim.y * gridDim.z;
    unsigned sum, cnt, mine, sp = 0u;
    for (;;) {
        sum = 0u; cnt = 0u; mine = 0u;
#pragma unroll
        for (unsigned j = 0; j < 16; ++j) { const unsigned c = xb_ld(&bar[XB_XCNT(j)]); sum += c; cnt += (c > 0u) ? 1u : 0u; mine = (j == x) ? c : mine; }
        if (sum == G) break;
        __builtin_amdgcn_s_sleep(1);
        if ((++sp & 255u) == 0u) { if (xb_ld(&bar[XB_TMO])) break; if (sp > XB_SPIN_CAP) { atomicAdd(&bar[XB_TMO], 1u); break; } }
    }
    nloc = mine > 0u ? mine : 1u; nx = cnt > 0u ? cnt : 1u;
}

__device__ __forceinline__ void xcd_barrier(const XcdBarrier& b) {
    asm volatile("s_waitcnt vmcnt(0)" ::: "memory");
    __syncthreads();
    if (threadIdx.x == 0) {
        unsigned* bar = b.bar;
        __builtin_amdgcn_s_waitcnt(0);
        unsigned nloc = b.st[0], nx = b.st[1];
        if (nloc == 0u) { xcd_barrier_complete(bar, b.x, nloc, nx); b.st[0] = nloc; b.st[1] = nx; }
        const unsigned old = xb_add(&bar[XB_XSUB(b.x)], 1u);
        const unsigned gen = old / nloc;
        if (old + 1u == (gen + 1u) * nloc) {
            __builtin_amdgcn_fence(__ATOMIC_RELEASE, "agent");
            asm volatile("s_waitcnt vmcnt(0)" ::: "memory");
            const unsigned og = xb_add(&bar[XB_TOP], 1u);
            const unsigned tg = og / nx;
            if (og + 1u == (tg + 1u) * nx) xb_add(&bar[XB_TOPGEN], 1u);
            else XB_SPIN(xb_ld(&bar[XB_TOPGEN]) == tg, bar);
            __builtin_amdgcn_fence(__ATOMIC_ACQUIRE, "agent");
            xb_add(&bar[XB_XGEN(b.x)], 1u);
            asm volatile("s_waitcnt vmcnt(0)" ::: "memory");
        } else {
            XB_SPIN(xb_ld(&bar[XB_XGEN(b.x)]) == gen, bar);
            __builtin_amdgcn_fence(__ATOMIC_ACQUIRE, "agent");
            asm volatile("s_waitcnt vmcnt(0)" ::: "memory");
        }
    }
    __syncthreads();
}


__global__ __launch_bounds__(512, 2) void mega(const Params p_arg) {
    extern __shared__ __attribute__((aligned(16))) unsigned char shm[];
    const Params& p = *(const Params*)(const void*)__builtin_amdgcn_kernarg_segment_ptr();
    LAS unsigned char* lds = (LAS unsigned char*)shm;
    const int G = (int)gridDim.x, bid = (int)blockIdx.x;
    __shared__ uint4 xb_words;
    if (threadIdx.x == 0) xb_words = make_uint4(0u, 0u, 0u, 0u);
    __syncthreads();
    (void)xcd_barrier_post((unsigned*)(p.ws + WS_BAR), (volatile LAS unsigned*)&xb_words);
    const int step_lo = p.step_lo, step_hi = p.step_hi;
    for (int s = step_lo; s < step_hi; ++s) {
        const int kind = p.kind[s], lo = p.lo[s], hi = p.hi[s];
        switch (kind) {
            case K_PRE0:
#ifndef NO_PRE
 convert_tiles(p, lo, hi, lds); rope_table(p); norm_rows(p.in[0], p.in[1], (bf16_t*)(p.ws + WS_H));
#endif
 break;
            case K_GEMMB:
#ifndef NO_GB

                for (int i = lo; i < hi; ++i) { const GemmOp& o = p.g[i]; pg8::Gemm g; g.A = o.A; g.Bt = o.Bt; g.M = o.M; g.N = o.N; g.K = o.K;
                    pg8::StaticOrder S; S.init(o.M, o.N, G, (bid + G - (o.rot % G)) % G);
                    EpiB E; E.O = (bf16_t*)o.out; E.ldc = o.ldc; E.bias = o.bias; E.act = o.act;
                    pg8::gemm_phase<EpiB, pg8::StaticOrder, false>(lds, g, S, E, nullptr); }
#endif
                break;
            case K_GEMMF:
#ifndef NO_GF

                for (int i = lo; i < hi; ++i) { const GemmOp& o = p.g[i]; pg8::Gemm g; g.A = o.A; g.Bt = o.Bt; g.M = o.M; g.N = o.N; g.K = o.K;
                    pg8::StaticOrder S; S.init(o.M, o.N, G, (bid + G - (o.rot % G)) % G);
                    EpiF E; E.C = (float*)o.out; E.ldc = o.ldc; E.res = o.res;
                    pg8::gemm_phase<EpiF, pg8::StaticOrder, false>(lds, g, S, E, nullptr); }
#endif
                break;
            case K_CONVSSD:
#ifndef NO_CONV
 conv_ssd(p);
#endif
 break;
            case K_MIX0:

#ifndef NO_SSD
for (int j = bid; j < 256; j += G) ssd_scan_job(p, j, lds);
#endif


#ifndef NO_ATT
for (int j = bid; j < 512; j += G) attn_job(p, j, lds);
#endif

                break;
            case K_POST0: post_ssd(p); break;
            case K_NORM: norm_rows(p.out, p.in[2] + lo * D, (bf16_t*)(p.ws + WS_H)); break;
            case K_PRE1: convert_tiles(p, lo, hi, lds); mix_rows(p.out, p.in[1] + D, p.in[16], (bf16_t*)(p.ws + WS_MIX), 0, lds); break;
            case K_MIXES: mix_rows(p.out, p.in[1] + D, p.in[16], (bf16_t*)(p.ws + WS_MIX), 8192, lds); break;
            case K_RWKV:
#ifndef NO_RWKV
 for (int j = bid; j < 256; j += G) rwkv_scan_job(p, j, lds);
#endif
 break;
            case K_NORMCONV: convert_tiles(p, lo, hi, lds); norm_rows(p.out, p.in[2] + D, (bf16_t*)(p.ws + WS_H)); break;
            default: break;
        }
        if (s + 1 < step_hi) { if (s == step_lo) cg::this_grid().sync(); else { XcdBarrier xb; xb.bar = (unsigned*)(p.ws + WS_BAR); xb.x = xb_xcc_id(); xb.st = (volatile LAS unsigned*)&xb_words; xcd_barrier(xb); } }
    }
}

#ifndef MK_MULTI
#define MK_MULTI 0
#endif
extern "C" void kernel_launch(void* const* d_in, const int* in_sizes, int n_in, void* d_out, int out_size, void* d_ws, size_t ws_size, hipStream_t stream) {
    static int grid = 0;
    if (grid == 0) {
        int dev = 0, cus = 0, per_cu = 0;
        hipGetDevice(&dev); hipDeviceGetAttribute(&cus, hipDeviceAttributeMultiprocessorCount, dev);
        if (hipFuncSetAttribute((const void*)mega, hipFuncAttributeMaxDynamicSharedMemorySize, LDS_BYTES) != hipSuccess) { fprintf(stderr, "hipFuncSetAttribute failed\n"); grid = -1; return; }
        if (hipOccupancyMaxActiveBlocksPerMultiprocessor(&per_cu, (const void*)mega, 512, LDS_BYTES) != hipSuccess || per_cu < 1) { fprintf(stderr, "occupancy query: %d\n", per_cu); per_cu = 1; }
        (void)hipGetLastError();
        grid = cus * per_cu; if (grid > 256) grid = 256;
        if (n_in != 34 || ws_size < 512 * MiB) { fprintf(stderr, "unexpected n_in %d / ws %zu\n", n_in, ws_size); grid = -1; return; }
    }
    if (grid < 0) return;
    static Params p;
    memset(&p, 0, sizeof(p));
    for (int i = 0; i < 34; ++i) p.in[i] = (const float*)d_in[i];
    p.out = (float*)d_out; p.ws = (unsigned char*)d_ws;
    unsigned char* ws = (unsigned char*)d_ws;
    auto B16 = [&](size_t off) { return (bf16_t*)(ws + off); };
    int ncj = 0, tile_acc = 0;
    auto CJ = [&](const float* src, size_t dst_off, int K, int N, int Kpad, int Npad) { ConvJob& c = p.cj[ncj++]; c.src = src; c.dst = B16(dst_off); c.K = K; c.N = N; c.Kpad = Kpad; c.Npad = Npad; c.tile0 = tile_acc; c.ntiles = (Kpad / 64) * (Npad / 256); tile_acc += c.ntiles; };
    const float* w_up = p.in[3]; const float* w_down = p.in[4];
    tile_acc = 0;
    CJ(p.in[5], WS_WBA, 2048, 4112, 2048, 4352); CJ(p.in[15], WS_WBA + 17 * MiB, 2048, 2048, 2048, 2048);
    CJ(w_up, WS_WMLP, 2048, 8192, 2048, 8192); CJ(w_down, WS_WMLP + 32 * MiB, 8192, 2048, 8192, 2048);
    tile_acc = 0;
    CJ(p.in[28], WS_WBA, 2048, 2048, 2048, 2048); CJ(p.in[29], WS_WBA + 8 * MiB, 2048, 2048, 2048, 2048); CJ(p.in[30], WS_WBA + 16 * MiB, 2048, 2048, 2048, 2048); CJ(p.in[31], WS_WBA + 24 * MiB, 2048, 2048, 2048, 2048);
    CJ(p.in[18], WS_WBA + 32 * MiB, 2048, 96, 2048, 256); CJ(p.in[21], WS_WBA + 33 * MiB, 2048, 96, 2048, 256); CJ(p.in[23], WS_WBA + 34 * MiB, 2048, 256, 2048, 256);
    CJ(p.in[19], WS_WBA + 35 * MiB, 96, 2048, 256, 2048); CJ(p.in[22], WS_WBA + 36 * MiB, 96, 2048, 256, 2048); CJ(p.in[24], WS_WBA + 37 * MiB, 256, 2048, 256, 2048);
    tile_acc = 0;
    CJ(w_up + (size_t)2048 * 8192, WS_WMLP, 2048, 8192, 2048, 8192); CJ(w_down + (size_t)2048 * 8192, WS_WMLP + 32 * MiB, 8192, 2048, 8192, 2048);
    int nop = 0;
    auto GO = [&](const bf16_t* A, const bf16_t* Bt, void* out, const float* bias, const float* res, int M, int N, int K, int ldc, int act, int rot) {
        GemmOp& o = p.g[nop++]; o.A = A; o.Bt = Bt; o.out = out; o.bias = bias; o.res = res; o.M = M; o.N = N; o.K = K; o.ldc = ldc; o.act = act; o.rot = rot; };
    GO(B16(WS_H), B16(WS_WBA), B16(WS_PROJ), nullptr, nullptr, MTOK, INWP, 2048, INWP, 0, 0);
    GO(B16(WS_YMIX), B16(WS_WBA + 17 * MiB), d_out, nullptr, p.in[0], MTOK, 2048, 2048, 2048, 0, 0);
    GO(B16(WS_H), B16(WS_WMLP), B16(WS_U), nullptr, nullptr, MTOK, DFF, 2048, DFF, 1, 0);
    GO(B16(WS_U), B16(WS_WMLP + 32 * MiB), d_out, nullptr, (const float*)d_out, MTOK, 2048, DFF, 2048, 0, 0);
    for (int half = 0; half < 2; ++half) {
        const size_t ro = (size_t)half * 8192 * 2048 * 2, lo_ = (size_t)half * 8192 * 256 * 2; const size_t mb = (size_t)8192 * 2048 * 2;
        GO(B16(WS_MIX + 0 * mb), B16(WS_WBA), B16(WS_R + ro), nullptr, nullptr, 8192, 2048, 2048, 2048, 0, 0);
        GO(B16(WS_MIX + 2 * mb), B16(WS_WBA + 8 * MiB), B16(WS_K + ro), nullptr, nullptr, 8192, 2048, 2048, 2048, 0, 0);
        GO(B16(WS_MIX + 3 * mb), B16(WS_WBA + 16 * MiB), B16(WS_V + ro), nullptr, nullptr, 8192, 2048, 2048, 2048, 0, 0);
        GO(B16(WS_MIX + 1 * mb), B16(WS_WBA + 32 * MiB), B16(WS_L1W + lo_), nullptr, nullptr, 8192, 256, 2048, 256, 2, 0);
        GO(B16(WS_MIX + 4 * mb), B16(WS_WBA + 33 * MiB), B16(WS_L1A + lo_), nullptr, nullptr, 8192, 256, 2048, 256, 0, 32);
        GO(B16(WS_MIX + 5 * mb), B16(WS_WBA + 34 * MiB), B16(WS_L1G + lo_), nullptr, nullptr, 8192, 256, 2048, 256, 3, 64);
    }
    GO(B16(WS_L1W), B16(WS_WBA + 35 * MiB), B16(WS_WDEC), p.in[17], nullptr, MTOK, 2048, 256, 2048, 4, 0);
    GO(B16(WS_L1A), B16(WS_WBA + 36 * MiB), B16(WS_AA), p.in[20], nullptr, MTOK, 2048, 256, 2048, 3, 0);
    GO(B16(WS_L1G), B16(WS_WBA + 37 * MiB), B16(WS_GG), nullptr, nullptr, MTOK, 2048, 256, 2048, 0, 0);
    GO(B16(WS_YG), B16(WS_WBA + 24 * MiB), d_out, nullptr, (const float*)d_out, MTOK, 2048, 2048, 2048, 0, 0);
    GO(B16(WS_H), B16(WS_WMLP), B16(WS_U), nullptr, nullptr, MTOK, DFF, 2048, DFF, 1, 0);
    GO(B16(WS_U), B16(WS_WMLP + 32 * MiB), d_out, nullptr, (const float*)d_out, MTOK, 2048, DFF, 2048, 0, 0);
    int ns = 0;
    auto ST = [&](int kind, int lo, int hi) { int rep = 1; if (kind == K_GEMMB) rep = REP_GEMMB; else if (kind == K_MIX0) rep = REP_MIX0; else if (kind == K_RWKV) rep = REP_RWKV; else if (kind != K_GEMMF) rep = REP_ELEM;
        for (int r = 0; r < rep; ++r) { p.kind[ns] = kind; p.lo[ns] = lo; p.hi[ns] = hi; ++ns; } };
    ST(K_PRE0, 0, 4); ST(K_GEMMB, 0, 1); ST(K_CONVSSD, 0, 0); ST(K_MIX0, 0, 0); ST(K_POST0, 0, 0); ST(K_GEMMF, 1, 2); ST(K_NORM, 0, 0); ST(K_GEMMB, 2, 3); ST(K_GEMMF, 3, 4);
    ST(K_PRE1, 4, 14); ST(K_GEMMB, 4, 10); ST(K_MIXES, 0, 0); ST(K_GEMMB, 10, 16); ST(K_GEMMB, 16, 19); ST(K_RWKV, 0, 0); ST(K_GEMMF, 19, 20); ST(K_NORMCONV, 14, 16); ST(K_GEMMB, 20, 21); ST(K_GEMMF, 21, 22);
    (void)hipMemsetAsync(ws + WS_BAR, 0, XCD_BAR_WORDS * sizeof(unsigned), stream);
#if MK_MULTI
    for (int s = 0; s < ns; ++s) { p.step_lo = s; p.step_hi = s + 1; hipLaunchKernelGGL(mega, dim3(grid), dim3(512), LDS_BYTES, stream, p); }
#else
    p.step_lo = 0; p.step_hi = ns;
    void* args[] = {(void*)&p};
    const hipError_t e = hipLaunchCooperativeKernel((const void*)mega, dim3(grid), dim3(512), args, LDS_BYTES, stream);
    if (e != hipSuccess) fprintf(stderr, "cooperative launch failed: %s (grid %d)\n", hipGetErrorString(e), grid);
#endif
}
```

```cpp
#include <hip/hip_runtime.h>
#include <hip/hip_cooperative_groups.h>
#include <cstdio>
#include <cstring>
namespace cg = cooperative_groups;
__device__ __forceinline__ int opq(int v) { asm volatile("" : "+v"(v)); return v; }
namespace pg8 {
#define PG8_LAS __attribute__((address_space(3)))
typedef unsigned short bf16_t;
typedef short bf16x8 __attribute__((ext_vector_type(8)));
typedef float f32x4 __attribute__((ext_vector_type(4)));
typedef unsigned u32x4 __attribute__((ext_vector_type(4)));
constexpr int BM = 256, BK = 64, HALF = 128, HTB = HALF * BK * 2  , STAGE_BYTES = 8 * HTB, NXCD = 8, WGM = 8;

__host__ __device__ __forceinline__ int lds_byte(int r, int c) { const int st = (r >> 4) * 2 + (c >> 5), rr = r & 15, cc = c & 31, ob = rr * 64 + cc * 2; return st * 1024 + (ob ^ (((ob >> 9) & 1) << 5)); }
__host__ __device__ __forceinline__ void stage_rc(int b, int& R, int& C) { const int st = b / 1024, sb = b % 1024, swz = sb ^ (((sb >> 9) & 1) << 5); R = (st >> 1) * 16 + swz / 64; C = (st & 1) * 32 + (swz % 64) / 2; }
__host__ __device__ __forceinline__ int perm32(int rho) { const int n = rho >> 4, i = rho & 15; return 8 * (i >> 2) + 4 * n + (i & 3); }

struct Unit { int pm, pn; };
struct Gemm { const bf16_t* A; const bf16_t* Bt; int M, N, K; };

struct StaticOrder {
    int nM, nN, nwg, G, c;
    __host__ __device__ void init(int M, int N, int G_, int c_) { nM = M / BM; nN = N / BM; nwg = nM * nN; G = G_; c = c_; }
    __host__ __device__ bool next(int i, Unit& u) const {
        const long L = (long)i * G + c; if (L >= nwg) return false;
        int wgid = (int)L; { const int q = nwg / NXCD, r = nwg % NXCD, xcd = wgid % NXCD, off = wgid / NXCD; wgid = (xcd < r ? xcd * (q + 1) : r * (q + 1) + (xcd - r) * q) + off; }
        const int nig = WGM * nN, gid = wgid / nig, fm = gid * WGM, gsz = (nM - fm) < WGM ? (nM - fm) : WGM;
        u.pm = fm + ((wgid % nig) % gsz); u.pn = (wgid % nig) / gsz; return true;
    }
    __device__ __forceinline__ void a_ready(const Unit&) const {}
    __device__ __forceinline__ void done(const Unit&) const {}
};
typedef __bf16 bf16x2_t __attribute__((ext_vector_type(2)));
typedef float f32x2_t __attribute__((ext_vector_type(2)));
__device__ __forceinline__ unsigned cvt_pk_bf16(float lo, float hi) { const f32x2_t f = {lo, hi}; const bf16x2_t v = __builtin_convertvector(f, bf16x2_t); return __builtin_bit_cast(unsigned, v); }
__device__ __forceinline__ unsigned cvt_pk_nv(float lo, float hi) { return cvt_pk_bf16(lo, hi); }

template <class Epi, class Sched, bool STAMP = false>
__device__ __forceinline__ void gemm_phase(PG8_LAS unsigned char* lds, const Gemm g, const Sched& S, const Epi& E, unsigned long long* stamps) {
    const int tid = opq(threadIdx.x), wid = __builtin_amdgcn_readfirstlane(tid >> 6), lane = tid & 63, wr = wid >> 2, wc = wid & 3, fr = lane & 15, fq = lane >> 4;
    const int K = g.K, nt = K / BK;
    int ts_lo = 0, ts_hi = 0, nts = 0; const unsigned long long rt_entry = STAMP ? (unsigned long long)wall_clock64() : 0ull;
#define PG8_STAMP() do { if (STAMP && wid == 0 && nts < 64) { const unsigned long long _c = (unsigned long long)clock64(); \
        ts_lo = (lane == nts) ? (int)(unsigned)_c : ts_lo; ts_hi = (lane == nts) ? (int)(unsigned)(_c >> 32) : ts_hi; ++nts; } } while (0)
    PG8_STAMP();
    unsigned voffA[2], voffB[2];
#pragma unroll
    for (int i = 0; i < 2; ++i) { int R, C; stage_rc(tid * 16 + i * 8192, R, C); const int Rb = Epi::PERM ? ((R & ~31) + perm32(R & 31)) : R;
        voffA[i] = (unsigned)(R * K + C) * 2u; voffB[i] = (unsigned)(Rb * K + C) * 2u; }
    const size_t kstep = (size_t)(BK * 2);
    const size_t hstep = (size_t)HALF * K * 2;
    const size_t tstep = 2 * hstep;
    const unsigned ldsw = (unsigned)wid * 1024u;
    const int aoff = lds_byte(wr * 64 + fr, fq * 8), boff = lds_byte(wc * 32 + fr, fq * 8);
#define PG8_SA(b, h) (((b) * 2 + (h)) * HTB)
#define PG8_SB(b, h) ((4 + (b) * 2 + (h)) * HTB)
#define PG8_STAGE(bufoff, gbase, voff) do { _Pragma("unroll") for (int _i = 0; _i < 2; ++_i) \
        __builtin_amdgcn_global_load_lds((const unsigned*)((const char*)(gbase) + (voff)[_i]), (PG8_LAS unsigned*)(lds + (bufoff) + ldsw + _i * 8192), 16, 0, 0); } while (0)
#define PG8_LDA(dst, b, h) do { _Pragma("unroll") for (int m = 0; m < 4; ++m) _Pragma("unroll") for (int k = 0; k < 2; ++k) dst[m][k] = *(const PG8_LAS bf16x8*)(lds + PG8_SA(b, h) + aoff + m * 2048 + k * 1024); } while (0)
#define PG8_LDB(dst, b, h) do { _Pragma("unroll") for (int n = 0; n < 2; ++n) _Pragma("unroll") for (int k = 0; k < 2; ++k) dst[n][k] = *(const PG8_LAS bf16x8*)(lds + PG8_SB(b, h) + boff + n * 2048 + k * 1024); } while (0)
#define PG8_MMA(ai, bj, At, Bt) do { __builtin_amdgcn_s_setprio(1); _Pragma("unroll") for (int m = 0; m < 4; ++m) _Pragma("unroll") for (int n = 0; n < 2; ++n) _Pragma("unroll") for (int k = 0; k < 2; ++k) \
        acc[ai][bj][m][n] = __builtin_amdgcn_mfma_f32_16x16x32_bf16(Bt[n][k], At[m][k], acc[ai][bj][m][n], 0, 0, 0); __builtin_amdgcn_s_setprio(0); } while (0)
#define PG8_WAIT_V(n) asm volatile("s_waitcnt vmcnt(" #n ")" ::: "memory")
#define PG8_WAIT_L(n) asm volatile("s_waitcnt lgkmcnt(" #n ")" ::: "memory")
#define PG8_BAR __builtin_amdgcn_s_barrier()
#define PG8_SCHED __builtin_amdgcn_sched_barrier(0)
    Unit cur, nxt; int ui = 0;
    if (!S.next(0, cur)) return;
    f32x4 acc[2][2][4][2];
#pragma unroll
    for (int a = 0; a < 2; ++a)
#pragma unroll
        for (int b = 0; b < 2; ++b)
#pragma unroll
            for (int m = 0; m < 4; ++m)
#pragma unroll
                for (int n = 0; n < 2; ++n) acc[a][b][m][n] = (f32x4){0.f, 0.f, 0.f, 0.f};
    bf16x8 At[4][2], B0[2][2], B1[2][2];
    const char* cA = (const char*)g.A + (size_t)cur.pm * tstep; const char* cB = (const char*)g.Bt + (size_t)cur.pn * tstep;
    S.a_ready(cur);
    PG8_STAGE(PG8_SB(0, 0), cB, voffB); PG8_STAGE(PG8_SA(0, 0), cA, voffA); PG8_STAGE(PG8_SB(0, 1), cB + hstep, voffB); PG8_STAGE(PG8_SA(0, 1), cA + hstep, voffA);
    if (wr == 1) PG8_BAR;
    PG8_WAIT_V(4); PG8_BAR;
    PG8_STAGE(PG8_SB(1, 0), cB + kstep, voffB); PG8_STAGE(PG8_SA(1, 0), cA + kstep, voffA); PG8_STAGE(PG8_SB(1, 1), cB + hstep + kstep, voffB);
    PG8_WAIT_V(6); PG8_BAR;
    PG8_STAMP();
    for (;;) {
        const bool has_next = S.next(ui + 1, nxt);
        const char* nA = has_next ? (const char*)g.A + (size_t)nxt.pm * tstep : cA; const char* nB = has_next ? (const char*)g.Bt + (size_t)nxt.pn * tstep : cB;
        for (int t = 0; t < nt; t += 2) {
            const bool last = (t == nt - 2);
            const char* a1 = cA + (size_t)(t + 1) * kstep;
            const char* a2 = last ? nA : cA + (size_t)(t + 2) * kstep; const char* b2 = last ? nB : cB + (size_t)(t + 2) * kstep;
            const char* a3 = a2 + kstep; const char* b3 = b2 + kstep;
            if (last && has_next) S.a_ready(nxt);
            PG8_LDB(B0, 0, 0); PG8_SCHED; PG8_LDA(At, 0, 0); PG8_STAGE(PG8_SA(1, 1), a1 + hstep, voffA);
            PG8_WAIT_L(8); PG8_BAR; PG8_WAIT_L(0); PG8_MMA(0, 0, At, B0); PG8_BAR; PG8_SCHED;
            PG8_LDB(B1, 0, 1); PG8_STAGE(PG8_SB(0, 0), b2, voffB);
            PG8_BAR; PG8_WAIT_L(0); PG8_MMA(0, 1, At, B1); PG8_BAR;
            PG8_LDA(At, 0, 1); PG8_STAGE(PG8_SA(0, 0), a2, voffA);
            PG8_BAR; PG8_WAIT_L(0); PG8_MMA(1, 0, At, B0); PG8_BAR; PG8_SCHED;
            PG8_STAGE(PG8_SB(0, 1), b2 + hstep, voffB);
            PG8_WAIT_V(6); PG8_BAR; PG8_MMA(1, 1, At, B1); PG8_BAR;
            PG8_LDB(B0, 1, 0); PG8_SCHED; PG8_LDA(At, 1, 0); PG8_STAGE(PG8_SA(0, 1), a2 + hstep, voffA);
            PG8_WAIT_L(8); PG8_BAR; PG8_WAIT_L(0); PG8_MMA(0, 0, At, B0); PG8_BAR; PG8_SCHED;
            PG8_LDB(B1, 1, 1); PG8_STAGE(PG8_SB(1, 0), b3, voffB);
            PG8_BAR; PG8_WAIT_L(0); PG8_MMA(0, 1, At, B1); PG8_BAR;
            PG8_LDA(At, 1, 1); PG8_STAGE(PG8_SA(1, 0), a3, voffA);
            PG8_BAR; PG8_WAIT_L(0); PG8_MMA(1, 0, At, B0); PG8_BAR; PG8_SCHED;
            PG8_STAGE(PG8_SB(1, 1), b3 + hstep, voffB);
            PG8_WAIT_V(6); PG8_BAR; PG8_MMA(1, 1, At, B1); PG8_BAR;
        }
        PG8_STAMP();
        if constexpr (!Epi::AFTER_DRAIN) { E(acc, cur, wr, wc, fr, fq); S.done(cur); }
        PG8_STAMP();
        if (!has_next) break;
#pragma unroll
        for (int a = 0; a < 2; ++a)
#pragma unroll
            for (int b = 0; b < 2; ++b)
#pragma unroll
                for (int m = 0; m < 4; ++m)
#pragma unroll
                    for (int n = 0; n < 2; ++n) acc[a][b][m][n] = (f32x4){0.f, 0.f, 0.f, 0.f};
        cur = nxt; cA = nA; cB = nB; ++ui;
    }
    PG8_WAIT_V(0);
    if (wr == 0) PG8_BAR;
    PG8_BAR;
    if constexpr (Epi::AFTER_DRAIN) { E.fused(acc, cur, wr, wc, fr, fq, lds, wid, lane); S.done(cur); }
    PG8_STAMP();
    if (STAMP && wid == 0) { stamps[lane] = lane < nts ? (((unsigned long long)(unsigned)ts_hi << 32) | (unsigned)ts_lo) : 0ull;
        if (lane == 62) stamps[62] = rt_entry; if (lane == 63) stamps[63] = (unsigned long long)wall_clock64(); }
#undef PG8_STAMP
#undef PG8_SA
#undef PG8_SB
#undef PG8_STAGE
#undef PG8_LDA
#undef PG8_LDB
#undef PG8_MMA
#undef PG8_WAIT_V
#undef PG8_WAIT_L
#undef PG8_BAR
#undef PG8_SCHED
}
}

#include <cstdio>
#include <ctime>
#include <cstdlib>
#include <cstring>
#include <cmath>
#include <vector>
#include <algorithm>
#define CK(x) do { hipError_t e_ = (x); if (e_ != hipSuccess) { fprintf(stderr, "HIP %s:%d %s\n", __FILE__, __LINE__, hipGetErrorString(e_)); exit(2); } } while (0)
using pg8::bf16_t; using pg8::bf16x8; using pg8::f32x4; using pg8::u32x4; using pg8::cvt_pk_bf16; using pg8::cvt_pk_nv;
#define LAS PG8_LAS

constexpr int D = 2048, SEQ = 2048, MTOK = 16384, DFF = 8192, INWP = 4352;
constexpr int COL_K = 1024, COL_V = 1280, COL_Z = 1536, COL_XBC = 2560, COL_DT = 4096;
constexpr size_t MiB = (size_t)1 << 20;
constexpr size_t WS_WBA = 0, WS_WMLP = 40 * MiB, WS_H = 104 * MiB, WS_PROJ = 168 * MiB, WS_YMIX = 304 * MiB, WS_YRAW = 368 * MiB, WS_XBC = 432 * MiB,
                 WS_DT = 480 * MiB, WS_DA = 481 * MiB, WS_ROPE = 482 * MiB, WS_U = 168 * MiB;
constexpr size_t WS_R = 40 * MiB, WS_K = 104 * MiB, WS_V = 168 * MiB, WS_L1W = 232 * MiB, WS_L1A = 240 * MiB, WS_L1G = 248 * MiB, WS_MIX = 256 * MiB,
                 WS_WDEC = 256 * MiB, WS_AA = 320 * MiB, WS_GG = 384 * MiB, WS_YG = 40 * MiB  , WS_WMLP1 = 448 * MiB;
constexpr size_t WS_BAR = 39 * MiB;
constexpr int LDS_BYTES = 140 * 1024;

enum { K_PRE0 = 0, K_GEMMB, K_GEMMF, K_CONVSSD, K_MIX0, K_POST0, K_NORM, K_PRE1, K_MIXES, K_RWKV, K_NORMCONV };
constexpr int NSTEPS = 48, NOPS = 22, NCJ = 16;
#define REP_GEMMB 1
#define REP_MIX0 1
#define REP_RWKV 1
#define REP_ELEM 1

struct GemmOp { const bf16_t* A; const bf16_t* Bt; void* out; const float* bias; const float* res; int M, N, K, ldc, act, rot, pad0, pad1; };
struct ConvJob { const float* src; bf16_t* dst; int K, N, Kpad, Npad, tile0, ntiles; };
struct Params {
    const float* in[34];
    float* out; unsigned char* ws;
    GemmOp g[NOPS];
    ConvJob cj[NCJ];
    int kind[NSTEPS + 1]; int lo[NSTEPS + 1]; int hi[NSTEPS + 1]; int clo[NSTEPS + 1]; int chi[NSTEPS + 1]; int cq[NSTEPS + 1];
    int step_lo, step_hi;
};

__device__ __forceinline__ float bf2f(unsigned short b) { return __uint_as_float(((unsigned)b) << 16); }
__device__ __forceinline__ float bflo(unsigned w) { return __uint_as_float(w << 16); }
__device__ __forceinline__ float bfhi(unsigned w) { return __uint_as_float(w & 0xffff0000u); }
__device__ __forceinline__ bf16_t f2bf(float f) { return (bf16_t)(cvt_pk_bf16(f, 0.f) & 0xffffu); }
template <int CTRL> __device__ __forceinline__ float dpp_add(float x) {
    const int y = __builtin_amdgcn_update_dpp(0, __builtin_bit_cast(int, x), CTRL, 0xf, 0xf, true);
    return x + __builtin_bit_cast(float, y); }
__device__ __forceinline__ float red8(float x) { x = dpp_add<0xB1>(x); x = dpp_add<0x4E>(x); x = dpp_add<0x141>(x); return x; }
__device__ __forceinline__ float red16(float x) { x = red8(x); x = dpp_add<0x140>(x); return x; }
__device__ __forceinline__ float wave_sum(float v) {
    v = red16(v);
    const float r0 = __builtin_bit_cast(float, __builtin_amdgcn_readlane(__builtin_bit_cast(int, v), 0)), r1 = __builtin_bit_cast(float, __builtin_amdgcn_readlane(__builtin_bit_cast(int, v), 16));
    const float r2 = __builtin_bit_cast(float, __builtin_amdgcn_readlane(__builtin_bit_cast(int, v), 32)), r3 = __builtin_bit_cast(float, __builtin_amdgcn_readlane(__builtin_bit_cast(int, v), 48));
    return (r0 + r1) + (r2 + r3); }
typedef float f32x2 __attribute__((ext_vector_type(2)));
__device__ __forceinline__ float sigmoidf_(float v) { return 1.0f / (1.0f + __expf(-v)); }
__device__ __forceinline__ void unpack8(const uint4 r, float (&f)[8]) {
    f[0] = bflo(r.x); f[1] = bfhi(r.x); f[2] = bflo(r.y); f[3] = bfhi(r.y); f[4] = bflo(r.z); f[5] = bfhi(r.z); f[6] = bflo(r.w); f[7] = bfhi(r.w); }

__device__ __forceinline__ float act_apply(float v, int act) {
    switch (act) {
        case 1: { const float r = fmaxf(v, 0.f); return r * r; }
        case 2: return 1.0f - 2.0f / (1.0f + __expf(2.0f * v));
        case 3: return sigmoidf_(v);
        case 4: return 0.60653066f * sigmoidf_(v);
        default: return v; }
}
struct EpiB {
    static constexpr bool PERM = true, AFTER_DRAIN = false;
    bf16_t* O; int ldc; const float* bias; int act;
    __device__ __forceinline__ void operator()(const f32x4 (&acc)[2][2][4][2], const pg8::Unit& u, int wr, int wc, int fr, int fq) const {
        const int row0 = u.pm * 256 + wr * 64 + fr, col0 = u.pn * 256 + wc * 32 + 8 * fq;
#pragma unroll
        for (int ai = 0; ai < 2; ++ai)
#pragma unroll
            for (int m = 0; m < 4; ++m) { bf16_t* rowp = O + (size_t)(row0 + ai * 128 + m * 16) * ldc + col0;
#pragma unroll
                for (int bj = 0; bj < 2; ++bj) { f32x4 v0 = acc[ai][bj][m][0], v1 = acc[ai][bj][m][1];
                    if (bias) { v0 += *(const f32x4*)(bias + col0 + bj * 128); v1 += *(const f32x4*)(bias + col0 + bj * 128 + 4); }
                    if (act) {
#pragma unroll
                        for (int j = 0; j < 4; ++j) { v0[j] = act_apply(v0[j], act); v1[j] = act_apply(v1[j], act); } }
                    u32x4 w; w.x = cvt_pk_bf16(v0[0], v0[1]); w.y = cvt_pk_bf16(v0[2], v0[3]); w.z = cvt_pk_bf16(v1[0], v1[1]); w.w = cvt_pk_bf16(v1[2], v1[3]);
                    *(u32x4*)(rowp + bj * 128) = w; } }
    }
};
struct EpiF {
    static constexpr bool PERM = false, AFTER_DRAIN = false;
    float* C; int ldc; const float* res;
    __device__ __forceinline__ void operator()(const f32x4 (&acc)[2][2][4][2], const pg8::Unit& u, int wr, int wc, int fr, int fq) const {
        const int row0 = u.pm * 256 + wr * 64 + fr, col0 = u.pn * 256 + wc * 32 + 4 * fq;
#pragma unroll
        for (int ai = 0; ai < 2; ++ai)
#pragma unroll
            for (int m = 0; m < 4; ++m) { const size_t ro = (size_t)(row0 + ai * 128 + m * 16) * ldc + col0;
#pragma unroll
                for (int bj = 0; bj < 2; ++bj)
#pragma unroll
                    for (int n = 0; n < 2; ++n) { const f32x4 r = *(const f32x4*)(res + ro + bj * 128 + n * 16); *(f32x4*)(C + ro + bj * 128 + n * 16) = acc[ai][bj][m][n] + r; } }
    }
};

__device__ __forceinline__ void convert_one_tile(const Params& p, int jlo, int jhi, int tile, int tid, LAS float* T) {
    int j = jlo; while (j + 1 < jhi && tile >= p.cj[j + 1].tile0) ++j;
    const float* src = p.cj[j].src; bf16_t* dst = p.cj[j].dst; const int K = p.cj[j].K, N = p.cj[j].N, Kpad = p.cj[j].Kpad;
    const int local = tile - p.cj[j].tile0, nkt = Kpad >> 6, kt = local % nkt, nt = local / nkt;
    f32x4 v[8];
#pragma unroll
    for (int i = 0; i < 8; ++i) { const int idx = tid + i * 512, kr = idx >> 6, c4 = idx & 63, k = kt * 64 + kr, n = nt * 256 + c4 * 4;
        v[i] = (f32x4){0.f, 0.f, 0.f, 0.f};
        if (k < K && n < N) v[i] = *(const f32x4*)(src + (size_t)k * N + n); }
#pragma unroll
    for (int i = 0; i < 8; ++i) { const int idx = tid + i * 512, kr = idx >> 6, c4 = idx & 63;
        T[kr * 257 + c4 * 4 + 0] = v[i][0]; T[kr * 257 + c4 * 4 + 1] = v[i][1]; T[kr * 257 + c4 * 4 + 2] = v[i][2]; T[kr * 257 + c4 * 4 + 3] = v[i][3]; }
    __syncthreads();
#pragma unroll
    for (int i = 0; i < 4; ++i) { const int idx = tid + i * 512, nl = idx >> 3, kc = idx & 7; float f[8];
#pragma unroll
        for (int e = 0; e < 8; ++e) f[e] = T[(kc * 8 + e) * 257 + nl];
        u32x4 w; w.x = cvt_pk_nv(f[0], f[1]); w.y = cvt_pk_nv(f[2], f[3]); w.z = cvt_pk_nv(f[4], f[5]); w.w = cvt_pk_nv(f[6], f[7]);
        *(u32x4*)(dst + (size_t)(nt * 256 + nl) * Kpad + kt * 64 + kc * 8) = w; }
    __syncthreads();
}
__device__ __forceinline__ void convert_tiles(const Params& p, int jlo, int jhi, LAS unsigned char* lds) {
    const int tid = opq(threadIdx.x); LAS float* T = (LAS float*)lds;
    const int total = p.cj[jhi - 1].tile0 + p.cj[jhi - 1].ntiles;
    for (int tile = blockIdx.x; tile < total; tile += gridDim.x) convert_one_tile(p, jlo, jhi, tile, tid, T);
}
__device__ __forceinline__ void convert_queue(const Params& p, int jlo, int jhi, unsigned* counter, LAS unsigned char* lds) {
    const int tid = opq(threadIdx.x); LAS float* T = (LAS float*)lds; LAS int* slot = (LAS int*)(lds + 72 * 1024);
    const int total = p.cj[jhi - 1].tile0 + p.cj[jhi - 1].ntiles;
    for (;;) {
        __syncthreads();
        if (tid == 0) *slot = (int)__hip_atomic_fetch_add(counter, 1u, __ATOMIC_RELAXED, __HIP_MEMORY_SCOPE_AGENT);
        __syncthreads();
        const int tile = *slot;
        if (tile >= total) break;
        convert_one_tile(p, jlo, jhi, tile, tid, T);
    }
}

__device__ __forceinline__ void rope_table(const Params& p) {
    float2* tab = (float2*)(p.ws + WS_ROPE);
    for (int idx = blockIdx.x * 512 + opq(threadIdx.x); idx < SEQ * 32; idx += gridDim.x * 512) {
        const int t = idx >> 5, i = idx & 31;
        const float inv = exp2f(-(float)i * 0.41524101186092029f);
        const float angf = (float)t * inv;
        const double ang = (double)angf;
        const double q = rint(ang * 0.6366197723675814);
        const double f = fma(-q, 1.5707963267948966, ang), f2 = f * f;
        const double s = f * (1.0 + f2 * (-1.0 / 6 + f2 * (1.0 / 120 + f2 * (-1.0 / 5040 + f2 * (1.0 / 362880 + f2 * (-1.0 / 39916800))))));
        const double c = 1.0 + f2 * (-0.5 + f2 * (1.0 / 24 + f2 * (-1.0 / 720 + f2 * (1.0 / 40320 + f2 * (-1.0 / 3628800 + f2 * (1.0 / 479001600))))));
        const int qi = ((int)q) & 3;
        const double sn = (qi == 0) ? s : (qi == 1) ? c : (qi == 2) ? -s : -c;
        const double cs = (qi == 0) ? c : (qi == 1) ? -s : (qi == 2) ? -c : s;
        tab[idx] = make_float2((float)cs, (float)sn);
    }
}

__device__ __forceinline__ void norm_rows(const float* x, const float* g, bf16_t* h) {
    const int tid_ = opq(threadIdx.x); const int lane = tid_ & 63, wv = tid_ >> 6;
    f32x4 gg[8];
#pragma unroll
    for (int i = 0; i < 8; ++i) gg[i] = *(const f32x4*)(g + i * 256 + lane * 4);
    for (int row = (blockIdx.x * 8 + wv) * 2; row < MTOK; row += gridDim.x * 16) {
        const float* xr = x + (size_t)row * D; f32x4 v[8], u[8]; float ss = 0.f, st = 0.f;
#pragma unroll
        for (int i = 0; i < 8; ++i) { v[i] = *(const f32x4*)(xr + i * 256 + lane * 4); u[i] = *(const f32x4*)(xr + D + i * 256 + lane * 4); }
#pragma unroll
        for (int i = 0; i < 8; ++i) { ss += v[i][0] * v[i][0] + v[i][1] * v[i][1] + v[i][2] * v[i][2] + v[i][3] * v[i][3]; st += u[i][0] * u[i][0] + u[i][1] * u[i][1] + u[i][2] * u[i][2] + u[i][3] * u[i][3]; }
        ss = wave_sum(ss); st = wave_sum(st); const float r = rsqrtf(ss * (1.0f / D) + 1e-6f), r2 = rsqrtf(st * (1.0f / D) + 1e-6f);
#pragma unroll
        for (int i = 0; i < 8; ++i) {
            uint2 w; w.x = cvt_pk_nv(v[i][0] * r * gg[i][0], v[i][1] * r * gg[i][1]); w.y = cvt_pk_nv(v[i][2] * r * gg[i][2], v[i][3] * r * gg[i][3]);
            *(uint2*)(h + (size_t)row * D + i * 256 + lane * 4) = w;
            uint2 w2; w2.x = cvt_pk_nv(u[i][0] * r2 * gg[i][0], u[i][1] * r2 * gg[i][1]); w2.y = cvt_pk_nv(u[i][2] * r2 * gg[i][2], u[i][3] * r2 * gg[i][3]);
            *(uint2*)(h + (size_t)(row + 1) * D + i * 256 + lane * 4) = w2; }
    }
}

__device__ __forceinline__ void mix_rows(const float* x, const float* g, const float* mixw, bf16_t* mixbase, int tok0, LAS unsigned char* lds) {
    const int tid = opq(threadIdx.x), lane = tid & 63, wv = tid >> 6, c = tid * 4;
    LAS float* rs = (LAS float*)lds;
    const f32x4 gg = *(const f32x4*)(g + c); f32x4 mw[6];
#pragma unroll
    for (int m = 0; m < 6; ++m) mw[m] = *(const f32x4*)(mixw + m * D + c);
    for (int chunk = blockIdx.x; chunk < 256; chunk += gridDim.x) {
        const int rl0 = chunk * 32, tokc = tok0 + rl0; const bool hasprev = (tokc & (SEQ - 1)) != 0;
        __syncthreads();
        for (int r = wv; r < 33; r += 8) {
            float ss = 0.f;
            if (r > 0 || hasprev) { const float* xr = x + (size_t)(tokc - 1 + r) * D; f32x4 v[8];
#pragma unroll
                for (int i = 0; i < 8; ++i) v[i] = *(const f32x4*)(xr + i * 256 + lane * 4);
#pragma unroll
                for (int i = 0; i < 8; ++i) ss += v[i][0] * v[i][0] + v[i][1] * v[i][1] + v[i][2] * v[i][2] + v[i][3] * v[i][3]; }
            ss = wave_sum(ss);
            if (lane == 0) rs[r] = (r > 0 || hasprev) ? rsqrtf(ss * (1.0f / D) + 1e-6f) : 0.f;
        }
        __syncthreads();
        f32x4 prev = (f32x4){0.f, 0.f, 0.f, 0.f};
        if (hasprev) { const f32x4 pv = *(const f32x4*)(x + (size_t)(tokc - 1) * D + c); const float rp = rs[0]; prev = pv * rp * gg; }
        for (int r0 = 0; r0 < 32; r0 += 4) {
            f32x4 xv[4];
#pragma unroll
            for (int u = 0; u < 4; ++u) xv[u] = *(const f32x4*)(x + (size_t)(tokc + r0 + u) * D + c);
#pragma unroll
            for (int u = 0; u < 4; ++u) { const float rr = rs[r0 + u + 1]; const f32x4 hn = xv[u] * rr * gg, xx = prev - hn;
#pragma unroll
                for (int m = 0; m < 6; ++m) { const f32x4 o = hn + xx * mw[m];
                    uint2 w; w.x = cvt_pk_nv(o[0], o[1]); w.y = cvt_pk_nv(o[2], o[3]);
                    *(uint2*)(mixbase + (size_t)m * 8192 * D + (size_t)(rl0 + r0 + u) * D + c) = w; }
                prev = hn; }
        }
    }
}

__device__ __forceinline__ void conv_ssd(const Params& p) {
    const bf16_t* proj = (const bf16_t*)(p.ws + WS_PROJ); bf16_t* xbc = (bf16_t*)(p.ws + WS_XBC);
    const float* cw = p.in[6]; const float* cb = p.in[7];
    const int tid = opq(threadIdx.x);
    if (tid < 384) {
        const int c8 = tid % 192, par = tid / 192, c = c8 * 8;
        float w[4][8], bb[8];
#pragma unroll
        for (int j = 0; j < 4; ++j) { const f32x4 w0 = *(const f32x4*)(cw + j * 1536 + c), w1 = *(const f32x4*)(cw + j * 1536 + c + 4);
#pragma unroll
            for (int e = 0; e < 4; ++e) { w[j][e] = w0[e]; w[j][4 + e] = w1[e]; } }
        { const f32x4 b0 = *(const f32x4*)(cb + c), b1 = *(const f32x4*)(cb + c + 4);
#pragma unroll
          for (int e = 0; e < 4; ++e) { bb[e] = b0[e]; bb[4 + e] = b1[e]; } }
        for (int chunk = blockIdx.x; chunk < 256; chunk += gridDim.x) {
            const int t0 = chunk * 64 + par * 32; const bool hasprev = (t0 & (SEQ - 1)) != 0;
            float r0[8], r1[8], r2[8];
            if (hasprev) { const uint4 a = *(const uint4*)(proj + (size_t)(t0 - 3) * INWP + COL_XBC + c), b = *(const uint4*)(proj + (size_t)(t0 - 2) * INWP + COL_XBC + c), d = *(const uint4*)(proj + (size_t)(t0 - 1) * INWP + COL_XBC + c);
                unpack8(a, r0); unpack8(b, r1); unpack8(d, r2); }
            else {
#pragma unroll
                for (int e = 0; e < 8; ++e) { r0[e] = 0.f; r1[e] = 0.f; r2[e] = 0.f; } }
            for (int tg = 0; tg < 32; tg += 4) {
                uint4 rw[4];
#pragma unroll
                for (int u = 0; u < 4; ++u) rw[u] = *(const uint4*)(proj + (size_t)(t0 + tg + u) * INWP + COL_XBC + c);
#pragma unroll
                for (int u = 0; u < 4; ++u) { float cur[8], acc[8]; unpack8(rw[u], cur);
#pragma unroll
                    for (int e = 0; e < 8; ++e) { acc[e] = bb[e] + w[0][e] * r0[e] + w[1][e] * r1[e] + w[2][e] * r2[e] + w[3][e] * cur[e]; acc[e] = acc[e] * sigmoidf_(acc[e]); r0[e] = r1[e]; r1[e] = r2[e]; r2[e] = cur[e]; }
                    u32x4 o; o.x = cvt_pk_nv(acc[0], acc[1]); o.y = cvt_pk_nv(acc[2], acc[3]); o.z = cvt_pk_nv(acc[4], acc[5]); o.w = cvt_pk_nv(acc[6], acc[7]);
                    *(u32x4*)(xbc + (size_t)(t0 + tg + u) * 1536 + c) = o; }
            }
        }
    }
    float* dt = (float*)(p.ws + WS_DT); float* da = (float*)(p.ws + WS_DA);
    for (int idx = blockIdx.x * 512 + opq(threadIdx.x); idx < MTOK * 16; idx += gridDim.x * 512) {
        const int tok = idx >> 4, hh = idx & 15;
        const float v = bf2f(proj[(size_t)tok * INWP + COL_DT + hh]) + p.in[8][hh];
        const float d = fmaxf(v, 0.f) + __logf(1.0f + __expf(-fabsf(v)));
        dt[idx] = d; da[idx] = __expf(-d * __expf(p.in[9][hh]));
    }
}

__device__ __forceinline__ void ssd_scan_job(const Params& p, int job, LAS unsigned char* lds) {
    const int tid = opq(threadIdx.x);
    const int b = job >> 5, hs = (job >> 1) & 15, half = job & 1, grp = hs >> 3, p0 = half * 32;
    const bf16_t* xbc = (const bf16_t*)(p.ws + WS_XBC) + (size_t)b * SEQ * 1536;
    const float* dtp = (const float*)(p.ws + WS_DT) + (size_t)b * SEQ * 16 + hs;
    const float* dap = (const float*)(p.ws + WS_DA) + (size_t)b * SEQ * 16 + hs;
    float* yraw = (float*)(p.ws + WS_YRAW) + (size_t)b * SEQ * 1024 + hs * 64 + p0;
    const float dskip = p.in[10][hs];
    constexpr int BUF_F = 9280;
    LAS float* L = (LAS float*)lds;
    const bool producer = tid >= 256; const int ptid = tid & 255;
    int grow[5], gcol[5], loff[5];
#pragma unroll
    for (int k = 0; k < 5; ++k) { const int q = ptid + k * 256, row = q / 36, pc = q - row * 36; grow[k] = row;
        if (pc < 4) { gcol[k] = hs * 64 + p0 + pc * 8; loff[k] = row * 32 + pc * 8; }
        else if (pc < 20) { gcol[k] = 1024 + grp * 128 + (pc - 4) * 8; loff[k] = 1024 + row * 128 + (pc - 4) * 8; }
        else { gcol[k] = 1280 + grp * 128 + (pc - 20) * 8; loff[k] = 5120 + row * 128 + (pc - 20) * 8; } }
    uint4 rg[5]; float sc = 0.f;
#define SSD_ISSUE(t0) do { _Pragma("unroll") for (int k = 0; k < 5; ++k) if (ptid + k * 256 < 1152) rg[k] = *(const uint4*)(xbc + (size_t)((t0) + grow[k]) * 1536 + gcol[k]); \
        if (ptid < 32) sc = dtp[((t0) + ptid) * 16]; else if (ptid < 64) sc = dap[((t0) + ptid - 32) * 16]; } while (0)
#define SSD_COMMIT(buf) do { LAS float* Lc = L + (buf) * BUF_F; _Pragma("unroll") for (int k = 0; k < 5; ++k) if (ptid + k * 256 < 1152) { float f[8]; unpack8(rg[k], f); \
            *(LAS f32x4*)(Lc + loff[k]) = (f32x4){f[0], f[1], f[2], f[3]}; *(LAS f32x4*)(Lc + loff[k] + 4) = (f32x4){f[4], f[5], f[6], f[7]}; } \
        if (ptid < 32) Lc[9216 + ptid] = sc; else if (ptid < 64) Lc[9248 + ptid - 32] = sc; } while (0)
#define SSD_FLUSH(chp) do { LAS float* yo = L + 2 * BUF_F + ((chp) & 1) * 1024; const f32x4 v = *(LAS f32x4*)(yo + (ptid >> 3) * 32 + (ptid & 7) * 4); \
        *(f32x4*)(yraw + (size_t)((chp) * 32 + (ptid >> 3)) * 1024 + (ptid & 7) * 4) = v; } while (0)
    f32x2 hA[4], hB[4];
#pragma unroll
    for (int i = 0; i < 4; ++i) { hA[i] = (f32x2){0.f, 0.f}; hB[i] = (f32x2){0.f, 0.f}; }
    const int prow = (tid >> 4) & 15, nseg = tid & 15;
    __syncthreads();
    if (producer) { SSD_ISSUE(0); SSD_COMMIT(0); SSD_ISSUE(32); }
    __syncthreads();
    for (int ch = 0; ch < 64; ++ch) {
        const int cur = ch & 1;
        if (producer) {
            if (ch >= 1) SSD_FLUSH(ch - 1);
            if (ch + 1 < 64) SSD_COMMIT(cur ^ 1);
            if (ch + 2 < 64) SSD_ISSUE((ch + 2) * 32);
        } else {
        LAS float* Lb = L + cur * BUF_F; LAS float* yb = L + 2 * BUF_F + cur * 1024;
        for (int tg = 0; tg < 32; tg += 16) {
            float yA[16], yB[16];
            LAS float* qb = Lb + 1024 + tg * 128 + nseg * 8;
            f32x4 b0 = *(LAS f32x4*)(qb), b1 = *(LAS f32x4*)(qb + 4), c0 = *(LAS f32x4*)(qb + 4096), c1 = *(LAS f32x4*)(qb + 4100);
            float dA = Lb[9248 + tg], xa = Lb[tg * 32 + prow], xb = Lb[tg * 32 + prow + 16], dtv = Lb[9216 + tg];
#pragma unroll
            for (int tt = 0; tt < 16; ++tt) {
                f32x4 nb0, nb1, nc0, nc1; float ndA, nxa, nxb, ndtv;
                if (tt + 1 < 16) { LAS float* q = qb + (tt + 1) * 128; nb0 = *(LAS f32x4*)(q); nb1 = *(LAS f32x4*)(q + 4); nc0 = *(LAS f32x4*)(q + 4096); nc1 = *(LAS f32x4*)(q + 4100);
                    ndA = Lb[9248 + tg + tt + 1]; nxa = Lb[(tg + tt + 1) * 32 + prow]; nxb = Lb[(tg + tt + 1) * 32 + prow + 16]; ndtv = Lb[9216 + tg + tt + 1]; }
                __builtin_amdgcn_sched_barrier(0);
                const float xdta = xa * dtv, xdtb = xb * dtv;
                const f32x2 dA2 = (f32x2){dA, dA}, xa2 = (f32x2){xdta, xdta}, xb2 = (f32x2){xdtb, xdtb};
                hA[0] = hA[0] * dA2 + xa2 * b0.xy; hB[0] = hB[0] * dA2 + xb2 * b0.xy; hA[1] = hA[1] * dA2 + xa2 * b0.zw; hB[1] = hB[1] * dA2 + xb2 * b0.zw;
                hA[2] = hA[2] * dA2 + xa2 * b1.xy; hB[2] = hB[2] * dA2 + xb2 * b1.xy; hA[3] = hA[3] * dA2 + xa2 * b1.zw; hB[3] = hB[3] * dA2 + xb2 * b1.zw;
                f32x2 ya = hA[0] * c0.xy, yb2 = hB[0] * c0.xy; ya = hA[1] * c0.zw + ya; yb2 = hB[1] * c0.zw + yb2; ya = hA[2] * c1.xy + ya; yb2 = hB[2] * c1.xy + yb2; ya = hA[3] * c1.zw + ya; yb2 = hB[3] * c1.zw + yb2;
                float ra = ya.x + ya.y, rb = yb2.x + yb2.y;
                ra = dpp_add<0xB1>(ra); rb = dpp_add<0xB1>(rb); ra = dpp_add<0x4E>(ra); rb = dpp_add<0x4E>(rb); ra = dpp_add<0x141>(ra); rb = dpp_add<0x141>(rb); ra = dpp_add<0x140>(ra); rb = dpp_add<0x140>(rb);
                yA[tt] = ra + dskip * xa; yB[tt] = rb + dskip * xb;
                __builtin_amdgcn_sched_barrier(0);
                if (tt + 1 < 16) { b0 = nb0; b1 = nb1; c0 = nc0; c1 = nc1; dA = ndA; xa = nxa; xb = nxb; dtv = ndtv; }
            }
            if (nseg == 0) {
#pragma unroll
                for (int tt = 0; tt < 16; ++tt) { yb[(tg + tt) * 32 + prow] = yA[tt]; yb[(tg + tt) * 32 + prow + 16] = yB[tt]; } }
        }
        }
        __syncthreads();
    }
    if (producer) SSD_FLUSH(63);
#undef SSD_ISSUE
#undef SSD_COMMIT
#undef SSD_FLUSH
}

__device__ __forceinline__ void attn_job(const Params& p, int job, LAS unsigned char* lds) {
    const int tid = opq(threadIdx.x), lane = tid & 63, w = tid >> 6, fr = lane & 15, fq = lane >> 4;
    const int b = job >> 6, kvh = (job >> 4) & 3, nb = job & 15;
    const bf16_t* proj = (const bf16_t*)(p.ws + WS_PROJ) + (size_t)b * SEQ * INWP;
    const float2* rope = (const float2*)(p.ws + WS_ROPE);
    LAS bf16_t* Ks = (LAS bf16_t*)lds;
    LAS bf16_t* Vt = (LAS bf16_t*)(lds + 36864);
    LAS bf16_t* Ps = (LAS bf16_t*)(lds + 70656) + w * 16 * 264;
    __syncthreads();
    if (tid < 256) {
        const int kr = tid, tk = (nb - 1) * 128 + kr;
        if (tk >= 0) {
            const bf16_t* src = proj + (size_t)tk * INWP + COL_K + kvh * 64; float x[64]; float ss = 0.f;
#pragma unroll
            for (int c = 0; c < 8; ++c) { const uint4 r = *(const uint4*)(src + c * 8); float f[8]; unpack8(r, f);
#pragma unroll
                for (int e = 0; e < 8; ++e) { x[c * 8 + e] = f[e]; ss += f[e] * f[e]; } }
            const float rinv = rsqrtf(ss * (1.0f / 64) + 1e-6f); const float* kn = p.in[13];
#pragma unroll
            for (int i = 0; i < 64; ++i) x[i] = x[i] * rinv * kn[i];
#pragma unroll
            for (int c = 0; c < 4; ++c) { float o1[8], o2[8];
#pragma unroll
                for (int e = 0; e < 8; ++e) { const int i = c * 8 + e; const float2 cs = rope[tk * 32 + i]; o1[e] = x[i] * cs.x - x[i + 32] * cs.y; o2[e] = x[i + 32] * cs.x + x[i] * cs.y; }
                u32x4 w1, w2; w1.x = cvt_pk_bf16(o1[0], o1[1]); w1.y = cvt_pk_bf16(o1[2], o1[3]); w1.z = cvt_pk_bf16(o1[4], o1[5]); w1.w = cvt_pk_bf16(o1[6], o1[7]);
                w2.x = cvt_pk_bf16(o2[0], o2[1]); w2.y = cvt_pk_bf16(o2[2], o2[3]); w2.z = cvt_pk_bf16(o2[4], o2[5]); w2.w = cvt_pk_bf16(o2[6], o2[7]);
                *(LAS u32x4*)(Ks + kr * 72 + c * 8) = w1; *(LAS u32x4*)(Ks + kr * 72 + 32 + c * 8) = w2;
                __builtin_amdgcn_sched_barrier(0); }
        } else {
#pragma unroll
            for (int c = 0; c < 8; ++c) *(LAS u32x4*)(Ks + kr * 72 + c * 8) = (u32x4){0u, 0u, 0u, 0u};
        }
    } else {
        const int kr = tid - 256, tk = (nb - 1) * 128 + kr;
        const bf16_t* src = proj + (size_t)(tk < 0 ? 0 : tk) * INWP + COL_V + kvh * 64;
#pragma unroll
        for (int c = 0; c < 8; ++c) { uint4 r = *(const uint4*)(src + c * 8); if (tk < 0) r = make_uint4(0u, 0u, 0u, 0u);
            Vt[(c * 8 + 0) * 264 + kr] = (bf16_t)(r.x & 0xffffu); Vt[(c * 8 + 1) * 264 + kr] = (bf16_t)(r.x >> 16);
            Vt[(c * 8 + 2) * 264 + kr] = (bf16_t)(r.y & 0xffffu); Vt[(c * 8 + 3) * 264 + kr] = (bf16_t)(r.y >> 16);
            Vt[(c * 8 + 4) * 264 + kr] = (bf16_t)(r.z & 0xffffu); Vt[(c * 8 + 5) * 264 + kr] = (bf16_t)(r.z >> 16);
            Vt[(c * 8 + 6) * 264 + kr] = (bf16_t)(r.w & 0xffffu); Vt[(c * 8 + 7) * 264 + kr] = (bf16_t)(r.w >> 16); }
    }
    __syncthreads();
    for (int h4 = 0; h4 < 4; ++h4) {
    const int hq = kvh * 4 + h4;
    bf16x8 qa[2];
    { const int tq = nb * 128 + w * 16 + fr; const bf16_t* src = proj + (size_t)tq * INWP + hq * 64;
      const uint4 r0 = *(const uint4*)(src + fq * 8), r1 = *(const uint4*)(src + 32 + fq * 8); float x1[8], x2[8]; unpack8(r0, x1); unpack8(r1, x2);
      float ss = 0.f;
#pragma unroll
      for (int e = 0; e < 8; ++e) ss += x1[e] * x1[e] + x2[e] * x2[e];
      ss += __shfl_xor(ss, 16); ss += __shfl_xor(ss, 32);
      const float rinv = rsqrtf(ss * (1.0f / 64) + 1e-6f) * 0.125f; const float* qn = p.in[12]; float o1[8], o2[8];
#pragma unroll
      for (int e = 0; e < 8; ++e) { const int i = fq * 8 + e; const float a = x1[e] * rinv * qn[i], c = x2[e] * rinv * qn[i + 32]; const float2 cs = rope[tq * 32 + i];
          o1[e] = a * cs.x - c * cs.y; o2[e] = c * cs.x + a * cs.y; }
      u32x4 w1, w2; w1.x = cvt_pk_bf16(o1[0], o1[1]); w1.y = cvt_pk_bf16(o1[2], o1[3]); w1.z = cvt_pk_bf16(o1[4], o1[5]); w1.w = cvt_pk_bf16(o1[6], o1[7]);
      w2.x = cvt_pk_bf16(o2[0], o2[1]); w2.y = cvt_pk_bf16(o2[2], o2[3]); w2.z = cvt_pk_bf16(o2[4], o2[5]); w2.w = cvt_pk_bf16(o2[6], o2[7]);
      qa[0] = __builtin_bit_cast(bf16x8, w1); qa[1] = __builtin_bit_cast(bf16x8, w2); }
    f32x4 s[16];
#pragma unroll
    for (int j = 0; j < 16; ++j) { f32x4 acc = (f32x4){0.f, 0.f, 0.f, 0.f};
#pragma unroll
        for (int ks = 0; ks < 2; ++ks) { const bf16x8 kb = *(LAS bf16x8*)(Ks + (j * 16 + fr) * 72 + ks * 32 + fq * 8); acc = __builtin_amdgcn_mfma_f32_16x16x32_bf16(qa[ks], kb, acc, 0, 0, 0); }
        s[j] = acc; }
    const float sink = p.in[14][hq];
    float mx[4], inv[4];
#pragma unroll
    for (int i = 0; i < 4; ++i) { const int qi = w * 16 + fq * 4 + i + 128; float m = -3.0e38f;
#pragma unroll
        for (int j = 0; j < 16; ++j) { const int kj = j * 16 + fr; const bool ok = (kj <= qi) && (qi - kj < 128) && (nb > 0 || kj >= 128); s[j][i] = ok ? s[j][i] : -3.0e38f; m = fmaxf(m, s[j][i]); }
        m = fmaxf(m, __shfl_xor(m, 1)); m = fmaxf(m, __shfl_xor(m, 2)); m = fmaxf(m, __shfl_xor(m, 4)); m = fmaxf(m, __shfl_xor(m, 8));
        m = fmaxf(m, sink); mx[i] = m; float l = 0.f;
#pragma unroll
        for (int j = 0; j < 16; ++j) { const float e = (s[j][i] > -1.0e38f) ? __expf(s[j][i] - m) : 0.f; s[j][i] = e; l += e; }
        l += __shfl_xor(l, 1); l += __shfl_xor(l, 2); l += __shfl_xor(l, 4); l += __shfl_xor(l, 8);
        inv[i] = 1.0f / (l + __expf(sink - m)); }
#pragma unroll
    for (int j = 0; j < 16; ++j)
#pragma unroll
        for (int i = 0; i < 4; ++i) Ps[(fq * 4 + i) * 264 + j * 16 + fr] = f2bf(s[j][i] * inv[i]);
    f32x4 o[4];
#pragma unroll
    for (int nd = 0; nd < 4; ++nd) o[nd] = (f32x4){0.f, 0.f, 0.f, 0.f};
#pragma unroll
    for (int kk = 0; kk < 8; ++kk) { const bf16x8 pa = *(LAS bf16x8*)(Ps + fr * 264 + kk * 32 + fq * 8);
#pragma unroll
        for (int nd = 0; nd < 4; ++nd) { const bf16x8 vb = *(LAS bf16x8*)(Vt + (nd * 16 + fr) * 264 + kk * 32 + fq * 8); o[nd] = __builtin_amdgcn_mfma_f32_16x16x32_bf16(pa, vb, o[nd], 0, 0, 0); } }
    bf16_t* ymix = (bf16_t*)(p.ws + WS_YMIX) + (size_t)b * SEQ * D + hq * 64;
#pragma unroll
    for (int nd = 0; nd < 4; ++nd)
#pragma unroll
        for (int i = 0; i < 4; ++i) ymix[(size_t)(nb * 128 + w * 16 + fq * 4 + i) * D + nd * 16 + fr] = f2bf(o[nd][i]);
    }
}

__device__ __forceinline__ void post_ssd(const Params& p) {
    const int tid_ = opq(threadIdx.x); const int lane = tid_ & 63, wv = tid_ >> 6;
    const float* yraw = (const float*)(p.ws + WS_YRAW); const bf16_t* proj = (const bf16_t*)(p.ws + WS_PROJ); bf16_t* ymix = (bf16_t*)(p.ws + WS_YMIX);
    for (int it = blockIdx.x * 8 + wv; it < MTOK * 2; it += gridDim.x * 8) {
        const int tok = it >> 1, grp = it & 1, c = grp * 512 + lane * 8;
        const f32x4 y0 = *(const f32x4*)(yraw + (size_t)tok * 1024 + c), y1 = *(const f32x4*)(yraw + (size_t)tok * 1024 + c + 4);
        const uint4 zr = *(const uint4*)(proj + (size_t)tok * INWP + COL_Z + c); float z[8], y[8]; unpack8(zr, z); float ss = 0.f;
#pragma unroll
        for (int e = 0; e < 8; ++e) { const float yy = (e < 4 ? y0[e] : y1[e - 4]); y[e] = yy * z[e] * sigmoidf_(z[e]); ss += y[e] * y[e]; }
        ss = wave_sum(ss); const float r = rsqrtf(ss * (1.0f / 512) + 1e-6f);
        const f32x4 n0 = *(const f32x4*)(p.in[11] + c), n1 = *(const f32x4*)(p.in[11] + c + 4);
        u32x4 w; w.x = cvt_pk_nv(y[0] * r * n0[0], y[1] * r * n0[1]); w.y = cvt_pk_nv(y[2] * r * n0[2], y[3] * r * n0[3]);
        w.z = cvt_pk_nv(y[4] * r * n1[0], y[5] * r * n1[1]); w.w = cvt_pk_nv(y[6] * r * n1[2], y[7] * r * n1[3]);
        *(u32x4*)(ymix + (size_t)tok * D + 1024 + c) = w;
    }
}

__device__ __forceinline__ float half_sum(float v, bool lo) {
    v = red16(v);
    const float r0 = __builtin_bit_cast(float, __builtin_amdgcn_readlane(__builtin_bit_cast(int, v), 0)), r1 = __builtin_bit_cast(float, __builtin_amdgcn_readlane(__builtin_bit_cast(int, v), 16));
    const float r2 = __builtin_bit_cast(float, __builtin_amdgcn_readlane(__builtin_bit_cast(int, v), 32)), r3 = __builtin_bit_cast(float, __builtin_amdgcn_readlane(__builtin_bit_cast(int, v), 48));
    return lo ? (r0 + r1) : (r2 + r3); }
__device__ __forceinline__ void rwkv_scan_job(const Params& p, int job, LAS unsigned char* lds) {
    const int tid = opq(threadIdx.x), lane = tid & 63, l32 = lane & 31; const bool lo = lane < 32;
    const int b = job >> 5, hh = job & 31;
    LAS float* L = (LAS float*)lds;
    const bool producer = tid >= 256;
    const int pw = (tid >> 6) & 3;
    const int tl0 = 2 * pw + (lane >> 5);
    const size_t wbase = ((size_t)b * SEQ * D + hh * 64) / 2 + l32 + (size_t)tl0 * (D / 2);
    const unsigned* R32 = (const unsigned*)(p.ws + WS_R) + wbase; const unsigned* K32 = (const unsigned*)(p.ws + WS_K) + wbase; const unsigned* V32 = (const unsigned*)(p.ws + WS_V) + wbase;
    const unsigned* E32 = (const unsigned*)(p.ws + WS_WDEC) + wbase; const unsigned* A32 = (const unsigned*)(p.ws + WS_AA) + wbase; const unsigned* G32 = (const unsigned*)(p.ws + WS_GG) + wbase;
    unsigned* Y32 = (unsigned*)(p.ws + WS_YG) + wbase;
    const int ci = hh * 64 + 2 * l32;
    const float2 kkw = *(const float2*)(p.in[25] + ci), kaw = *(const float2*)(p.in[26] + ci), rkw = *(const float2*)(p.in[27] + ci), lnw = *(const float2*)(p.in[32] + ci), lnb = *(const float2*)(p.in[33] + ci);
    unsigned rw[2], kw[2], vw[2], ew[2], aw[2], gw[2];
    const int oo = tl0 * 64 + 2 * l32;
#define RW_ISSUE(t0) do { _Pragma("unroll") for (int i2 = 0; i2 < 2; ++i2) { const size_t off = (size_t)((t0) + 8 * i2) * (D / 2); rw[i2] = R32[off]; kw[i2] = K32[off]; vw[i2] = V32[off]; ew[i2] = E32[off]; aw[i2] = A32[off]; gw[i2] = G32[off]; } } while (0)
#define RW_COMMIT(buf) do { _Pragma("unroll") for (int i2 = 0; i2 < 2; ++i2) { LAS float* Lc = L + (buf) * 8192 + oo + i2 * 512; \
        const float r0_ = bflo(rw[i2]), r1_ = bfhi(rw[i2]), k0_ = bflo(kw[i2]), k1_ = bfhi(kw[i2]), v0_ = bflo(vw[i2]), v1_ = bfhi(vw[i2]), e0_ = bflo(ew[i2]), e1_ = bfhi(ew[i2]), a0_ = bflo(aw[i2]), a1_ = bfhi(aw[i2]), g0_ = bflo(gw[i2]), g1_ = bfhi(gw[i2]); \
        const float kkv0 = k0_ * kkw.x, kkv1 = k1_ * kkw.y; const float ssq = half_sum(kkv0 * kkv0 + kkv1 * kkv1, lo); const float rn = rsqrtf(fmaxf(ssq, 1e-24f)); const float kn0 = kkv0 * rn, kn1 = kkv1 * rn; \
        const float km0 = k0_ * (1.0f + (a0_ - 1.0f) * kaw.x), km1 = k1_ * (1.0f + (a1_ - 1.0f) * kaw.y); const float bonus = half_sum(r0_ * km0 * rkw.x + r1_ * km1 * rkw.y, lo); \
        *(LAS f32x2*)(Lc) = (f32x2){-kn0, -kn1}; *(LAS f32x2*)(Lc + 1024) = (f32x2){__expf(-e0_), __expf(-e1_)}; *(LAS f32x2*)(Lc + 2048) = (f32x2){kn0 * a0_, kn1 * a1_}; *(LAS f32x2*)(Lc + 3072) = (f32x2){km0, km1}; \
        *(LAS f32x2*)(Lc + 4096) = (f32x2){r0_, r1_}; *(LAS f32x2*)(Lc + 5120) = (f32x2){v0_, v1_}; *(LAS f32x2*)(Lc + 6144) = (f32x2){g0_, g1_}; *(LAS f32x2*)(Lc + 7168) = (f32x2){bonus * v0_, bonus * v1_}; } } while (0)
#define RW_OUTPUT(chp) do { LAS float* Lo = L + ((chp) & 1) * 8192; LAS float* yo = L + 16384 + ((chp) & 1) * 1024; _Pragma("unroll") for (int i2 = 0; i2 < 2; ++i2) { const int o2 = oo + i2 * 512; \
        const f32x2 y = *(LAS f32x2*)(yo + o2); \
        const float mu = half_sum(y.x + y.y, lo) * (1.0f / 64), d0 = y.x - mu, d1 = y.y - mu, var = half_sum(d0 * d0 + d1 * d1, lo) * (1.0f / 64), rs = rsqrtf(var + 64e-5f); \
        const f32x2 bv = *(LAS f32x2*)(Lo + 7168 + o2), gg = *(LAS f32x2*)(Lo + 6144 + o2); \
        Y32[(size_t)((chp) * 16 + 8 * i2) * (D / 2)] = cvt_pk_nv((d0 * rs * lnw.x + lnb.x + bv.x) * gg.x, (d1 * rs * lnw.y + lnb.y + bv.y) * gg.y); } } while (0)
    f32x2 SA[4], SB[4];
#pragma unroll
    for (int i = 0; i < 4; ++i) { SA[i] = (f32x2){0.f, 0.f}; SB[i] = (f32x2){0.f, 0.f}; }
    const int rp = (tid >> 3) & 31, ks = tid & 7;
    __syncthreads();
    if (producer) { RW_ISSUE(0); RW_COMMIT(0); RW_ISSUE(16); }
    __syncthreads();
    for (int ch = 0; ch < 128; ++ch) {
        const int cur = ch & 1;
        if (producer) {
            if (ch >= 1) RW_OUTPUT(ch - 1);
            if (ch + 1 < 128) RW_COMMIT(cur ^ 1);
            if (ch + 2 < 128) RW_ISSUE((ch + 2) * 16);
        } else {
            LAS float* Lb = L + cur * 8192; LAS float* yb = L + 16384 + cur * 1024;
            float yA[16], yB[16];
            LAS float* q0 = Lb + ks * 8;
            f32x4 a0 = *(LAS f32x4*)(q0), a1 = *(LAS f32x4*)(q0 + 4), w0 = *(LAS f32x4*)(q0 + 1024), w1 = *(LAS f32x4*)(q0 + 1028), b0 = *(LAS f32x4*)(q0 + 2048), b1 = *(LAS f32x4*)(q0 + 2052);
            f32x4 k0 = *(LAS f32x4*)(q0 + 3072), k1 = *(LAS f32x4*)(q0 + 3076), r0 = *(LAS f32x4*)(q0 + 4096), r1 = *(LAS f32x4*)(q0 + 4100);
            float va = Lb[5120 + rp], vb = Lb[5120 + rp + 32];
#pragma unroll
            for (int t = 0; t < 16; ++t) {
                f32x4 na0, na1, nw0, nw1, nb0, nb1, nk0, nk1, nr0, nr1; float nva, nvb;
                if (t + 1 < 16) { LAS float* q = q0 + (t + 1) * 64;
                    na0 = *(LAS f32x4*)(q); na1 = *(LAS f32x4*)(q + 4); nw0 = *(LAS f32x4*)(q + 1024); nw1 = *(LAS f32x4*)(q + 1028); nb0 = *(LAS f32x4*)(q + 2048); nb1 = *(LAS f32x4*)(q + 2052);
                    nk0 = *(LAS f32x4*)(q + 3072); nk1 = *(LAS f32x4*)(q + 3076); nr0 = *(LAS f32x4*)(q + 4096); nr1 = *(LAS f32x4*)(q + 4100); nva = Lb[5120 + (t + 1) * 64 + rp]; nvb = Lb[5120 + (t + 1) * 64 + rp + 32]; }
                __builtin_amdgcn_sched_barrier(0);
                f32x2 ca = SA[0] * a0.xy, cb = SB[0] * a0.xy; ca = SA[1] * a0.zw + ca; cb = SB[1] * a0.zw + cb; ca = SA[2] * a1.xy + ca; cb = SB[2] * a1.xy + cb; ca = SA[3] * a1.zw + ca; cb = SB[3] * a1.zw + cb;
                float sa = ca.x + ca.y, sb = cb.x + cb.y;
                sa = dpp_add<0xB1>(sa); sb = dpp_add<0xB1>(sb); sa = dpp_add<0x4E>(sa); sb = dpp_add<0x4E>(sb); sa = dpp_add<0x141>(sa); sb = dpp_add<0x141>(sb);
                const f32x2 sa2 = (f32x2){sa, sa}, sb2 = (f32x2){sb, sb}, va2 = (f32x2){va, va}, vb2 = (f32x2){vb, vb};
                SA[0] = SA[0] * w0.xy + (sa2 * b0.xy + va2 * k0.xy); SB[0] = SB[0] * w0.xy + (sb2 * b0.xy + vb2 * k0.xy);
                SA[1] = SA[1] * w0.zw + (sa2 * b0.zw + va2 * k0.zw); SB[1] = SB[1] * w0.zw + (sb2 * b0.zw + vb2 * k0.zw);
                SA[2] = SA[2] * w1.xy + (sa2 * b1.xy + va2 * k1.xy); SB[2] = SB[2] * w1.xy + (sb2 * b1.xy + vb2 * k1.xy);
                SA[3] = SA[3] * w1.zw + (sa2 * b1.zw + va2 * k1.zw); SB[3] = SB[3] * w1.zw + (sb2 * b1.zw + vb2 * k1.zw);
                f32x2 ya = SA[0] * r0.xy, yb2 = SB[0] * r0.xy; ya = SA[1] * r0.zw + ya; yb2 = SB[1] * r0.zw + yb2; ya = SA[2] * r1.xy + ya; yb2 = SB[2] * r1.xy + yb2; ya = SA[3] * r1.zw + ya; yb2 = SB[3] * r1.zw + yb2;
                float ra = ya.x + ya.y, rb = yb2.x + yb2.y;
                ra = dpp_add<0xB1>(ra); rb = dpp_add<0xB1>(rb); ra = dpp_add<0x4E>(ra); rb = dpp_add<0x4E>(rb); ra = dpp_add<0x141>(ra); rb = dpp_add<0x141>(rb);
                yA[t] = ra; yB[t] = rb;
                __builtin_amdgcn_sched_barrier(0);
                if (t + 1 < 16) { a0 = na0; a1 = na1; w0 = nw0; w1 = nw1; b0 = nb0; b1 = nb1; k0 = nk0; k1 = nk1; r0 = nr0; r1 = nr1; va = nva; vb = nvb; }
            }
            if (ks == 0) {
#pragma unroll
                for (int t = 0; t < 16; ++t) { yb[t * 64 + rp] = yA[t]; yb[t * 64 + rp + 32] = yB[t]; } }
        }
        __syncthreads();
    }
    if (producer) RW_OUTPUT(127);
#undef RW_ISSUE
#undef RW_COMMIT
#undef RW_OUTPUT
}

#define XB_TMO      128
#define XB_XCNT(j)  (256  + 64 * (j))
#define XB_XSUB(j)  (1280 + 64 * (j))
#define XB_XGEN(j)  (2304 + 64 * (j))
#define XB_TOP      3328
#define XB_TOPGEN   3392
#define XCD_BAR_WORDS 3456
#define XB_SPIN_CAP (1u << 18)

__device__ __forceinline__ unsigned xb_ld(unsigned* p)              { return __hip_atomic_load(p, __ATOMIC_RELAXED, __HIP_MEMORY_SCOPE_AGENT); }
__device__ __forceinline__ unsigned xb_add(unsigned* p, unsigned v) { return __hip_atomic_fetch_add(p, v, __ATOMIC_RELAXED, __HIP_MEMORY_SCOPE_AGENT); }
__device__ __forceinline__ unsigned xb_xcc_id() { return (unsigned)__builtin_amdgcn_s_getreg((3 << 11) | 20) & 0xFu; }
#define XB_SPIN(cond, bar) do { unsigned _sp = 0; while (cond) { __builtin_amdgcn_s_sleep(1); \
    if ((++_sp & 255u) == 0u) { if (xb_ld(&(bar)[XB_TMO])) break; if (_sp > XB_SPIN_CAP) { atomicAdd(&(bar)[XB_TMO], 1u); break; } } } } while (0)

struct XcdBarrier {
    unsigned* bar; unsigned x;
    volatile LAS unsigned* st;
};

__device__ __forceinline__ XcdBarrier xcd_barrier_post(unsigned* bar, volatile LAS unsigned* st) {
    XcdBarrier b; b.bar = bar; b.x = xb_xcc_id(); b.st = st;
    if (threadIdx.x == 0) (void)xb_add(&bar[XB_XCNT(b.x)], 1u);
    return b;
}
__device__ __forceinline__ void xcd_barrier_complete(unsigned* bar, unsigned x, unsigned& nloc, unsigned& nx) {
    const unsigned G = gridDim.x * gridDim.y * gridDim.z;
    unsigned sum, cnt, mine, sp = 0u;
    for (;;) {
        sum = 0u; cnt = 0u; mine = 0u;
#pragma unroll
        for (unsigned j = 0; j < 16; ++j) { const unsigned c = xb_ld(&bar[XB_XCNT(j)]); sum += c; cnt += (c > 0u) ? 1u : 0u; mine = (j == x) ? c : mine; }
        if (sum == G) break;
        __builtin_amdgcn_s_sleep(1);
        if ((++sp & 255u) == 0u) { if (xb_ld(&bar[XB_TMO])) break; if (sp > XB_SPIN_CAP) { atomicAdd(&bar[XB_TMO], 1u); break; } }
    }
    nloc = mine > 0u ? mine : 1u; nx = cnt > 0u ? cnt : 1u;
}

__device__ __forceinline__ void xcd_barrier(const XcdBarrier& b) {
    asm volatile("s_waitcnt vmcnt(0)" ::: "memory");
    __syncthreads();
    if (threadIdx.x == 0) {
        unsigned* bar = b.bar;
        __builtin_amdgcn_s_waitcnt(0);
        unsigned nloc = b.st[0], nx = b.st[1];
        if (nloc == 0u) { xcd_barrier_complete(bar, b.x, nloc, nx); b.st[0] = nloc; b.st[1] = nx; }
        const unsigned old = xb_add(&bar[XB_XSUB(b.x)], 1u);
        const unsigned gen = old / nloc;
        if (old + 1u == (gen + 1u) * nloc) {
            __builtin_amdgcn_fence(__ATOMIC_RELEASE, "agent");
            asm volatile("s_waitcnt vmcnt(0)" ::: "memory");
            const unsigned og = xb_add(&bar[XB_TOP], 1u);
            const unsigned tg = og / nx;
            if (og + 1u == (tg + 1u) * nx) xb_add(&bar[XB_TOPGEN], 1u);
            else XB_SPIN(xb_ld(&bar[XB_TOPGEN]) == tg, bar);
            __builtin_amdgcn_fence(__ATOMIC_ACQUIRE, "agent");
            xb_add(&bar[XB_XGEN(b.x)], 1u);
            asm volatile("s_waitcnt vmcnt(0)" ::: "memory");
        } else {
            XB_SPIN(xb_ld(&bar[XB_XGEN(b.x)]) == gen, bar);
            __builtin_amdgcn_fence(__ATOMIC_ACQUIRE, "agent");
            asm volatile("s_waitcnt vmcnt(0)" ::: "memory");
        }
    }
    __syncthreads();
}


__global__ __launch_bounds__(512, 2) void mega(const Params p_arg) {
    extern __shared__ __attribute__((aligned(16))) unsigned char shm[];
    const Params& p = *(const Params*)(const void*)__builtin_amdgcn_kernarg_segment_ptr();
    LAS unsigned char* lds = (LAS unsigned char*)shm;
    const int G = (int)gridDim.x, bid = (int)blockIdx.x;
    __shared__ uint4 xb_words;
    if (threadIdx.x == 0) xb_words = make_uint4(0u, 0u, 0u, 0u);
    __syncthreads();
    (void)xcd_barrier_post((unsigned*)(p.ws + WS_BAR), (volatile LAS unsigned*)&xb_words);
    const int step_lo = p.step_lo, step_hi = p.step_hi;
    for (int s = step_lo; s < step_hi; ++s) {
        const int kind = p.kind[s], lo = p.lo[s], hi = p.hi[s];
        switch (kind) {
            case K_PRE0:
#ifndef NO_PRE
 convert_tiles(p, lo, hi, lds); rope_table(p); norm_rows(p.in[0], p.in[1], (bf16_t*)(p.ws + WS_H));
#endif
 break;
            case K_GEMMB:
#ifndef NO_GB

                for (int i = lo; i < hi; ++i) { const GemmOp& o = p.g[i]; pg8::Gemm g; g.A = o.A; g.Bt = o.Bt; g.M = o.M; g.N = o.N; g.K = o.K;
                    pg8::StaticOrder S; S.init(o.M, o.N, G, (bid + G - (o.rot % G)) % G);
                    EpiB E; E.O = (bf16_t*)o.out; E.ldc = o.ldc; E.bias = o.bias; E.act = o.act;
                    pg8::gemm_phase<EpiB, pg8::StaticOrder, false>(lds, g, S, E, nullptr); }
                if (p.chi[s] > p.clo[s]) convert_queue(p, p.clo[s], p.chi[s], (unsigned*)(p.ws + WS_BAR + 16384) + 64 * p.cq[s], lds);
#endif
                break;
            case K_GEMMF:
#ifndef NO_GF

                for (int i = lo; i < hi; ++i) { const GemmOp& o = p.g[i]; pg8::Gemm g; g.A = o.A; g.Bt = o.Bt; g.M = o.M; g.N = o.N; g.K = o.K;
                    pg8::StaticOrder S; S.init(o.M, o.N, G, (bid + G - (o.rot % G)) % G);
                    EpiF E; E.C = (float*)o.out; E.ldc = o.ldc; E.res = o.res;
                    pg8::gemm_phase<EpiF, pg8::StaticOrder, false>(lds, g, S, E, nullptr); }
#endif
                break;
            case K_CONVSSD:
#ifndef NO_CONV
 conv_ssd(p);
#endif
 break;
            case K_MIX0:

#ifndef NO_SSD
for (int j = bid; j < 256; j += G) ssd_scan_job(p, j, lds);
#endif


#ifndef NO_ATT
for (int j = bid; j < 512; j += G) attn_job(p, j, lds);
#endif

                break;
            case K_POST0: post_ssd(p); break;
            case K_NORM: norm_rows(p.out, p.in[2] + lo * D, (bf16_t*)(p.ws + WS_H)); break;
            case K_PRE1: convert_tiles(p, lo, hi, lds); mix_rows(p.out, p.in[1] + D, p.in[16], (bf16_t*)(p.ws + WS_MIX), 0, lds); break;
            case K_MIXES: mix_rows(p.out, p.in[1] + D, p.in[16], (bf16_t*)(p.ws + WS_MIX), 8192, lds); break;
            case K_RWKV:
#ifndef NO_RWKV
 for (int j = bid; j < 256; j += G) rwkv_scan_job(p, j, lds);
#endif
 break;
            case K_NORMCONV: convert_tiles(p, lo, hi, lds); norm_rows(p.out, p.in[2] + D, (bf16_t*)(p.ws + WS_H)); break;
            default: break;
        }
        if (s + 1 < step_hi) { if (step_hi < 0) cg::this_grid().sync();   XcdBarrier xb; xb.bar = (unsigned*)(p.ws + WS_BAR); xb.x = xb_xcc_id(); xb.st = (volatile LAS unsigned*)&xb_words; xcd_barrier(xb); }
    }
}

#ifndef MK_MULTI
#define MK_MULTI 0
#endif
extern "C" void kernel_launch(void* const* d_in, const int* in_sizes, int n_in, void* d_out, int out_size, void* d_ws, size_t ws_size, hipStream_t stream) {
    static int grid = 0;
    if (grid == 0) {
        int dev = 0, cus = 0, per_cu = 0;
        hipGetDevice(&dev); hipDeviceGetAttribute(&cus, hipDeviceAttributeMultiprocessorCount, dev);
        if (hipFuncSetAttribute((const void*)mega, hipFuncAttributeMaxDynamicSharedMemorySize, LDS_BYTES) != hipSuccess) { fprintf(stderr, "hipFuncSetAttribute failed\n"); grid = -1; return; }
        if (hipOccupancyMaxActiveBlocksPerMultiprocessor(&per_cu, (const void*)mega, 512, LDS_BYTES) != hipSuccess || per_cu < 1) { fprintf(stderr, "occupancy query: %d\n", per_cu); per_cu = 1; }
        (void)hipGetLastError();
        grid = cus * per_cu; if (grid > 256) grid = 256;
        if (n_in != 34 || ws_size < 512 * MiB) { fprintf(stderr, "unexpected n_in %d / ws %zu\n", n_in, ws_size); grid = -1; return; }
    }
    if (grid < 0) return;
    static Params p;
    memset(&p, 0, sizeof(p));
    for (int i = 0; i < 34; ++i) p.in[i] = (const float*)d_in[i];
    p.out = (float*)d_out; p.ws = (unsigned char*)d_ws;
    unsigned char* ws = (unsigned char*)d_ws;
    auto B16 = [&](size_t off) { return (bf16_t*)(ws + off); };
    int ncj = 0, tile_acc = 0;
    auto CJ = [&](const float* src, size_t dst_off, int K, int N, int Kpad, int Npad) { ConvJob& c = p.cj[ncj++]; c.src = src; c.dst = B16(dst_off); c.K = K; c.N = N; c.Kpad = Kpad; c.Npad = Npad; c.tile0 = tile_acc; c.ntiles = (Kpad / 64) * (Npad / 256); tile_acc += c.ntiles; };
    const float* w_up = p.in[3]; const float* w_down = p.in[4];
    tile_acc = 0;
    CJ(p.in[5], WS_WBA, 2048, 4112, 2048, 4352); CJ(p.in[15], WS_WBA + 17 * MiB, 2048, 2048, 2048, 2048);
    tile_acc = 0;
    CJ(w_up, WS_WMLP, 2048, 8192, 2048, 8192); CJ(w_down, WS_WMLP + 32 * MiB, 8192, 2048, 8192, 2048);
    tile_acc = 0;
    CJ(p.in[28], WS_WBA, 2048, 2048, 2048, 2048); CJ(p.in[29], WS_WBA + 8 * MiB, 2048, 2048, 2048, 2048); CJ(p.in[30], WS_WBA + 16 * MiB, 2048, 2048, 2048, 2048); CJ(p.in[31], WS_WBA + 24 * MiB, 2048, 2048, 2048, 2048);
    CJ(p.in[18], WS_WBA + 32 * MiB, 2048, 96, 2048, 256); CJ(p.in[21], WS_WBA + 33 * MiB, 2048, 96, 2048, 256); CJ(p.in[23], WS_WBA + 34 * MiB, 2048, 256, 2048, 256);
    CJ(p.in[19], WS_WBA + 35 * MiB, 96, 2048, 256, 2048); CJ(p.in[22], WS_WBA + 36 * MiB, 96, 2048, 256, 2048); CJ(p.in[24], WS_WBA + 37 * MiB, 256, 2048, 256, 2048);
    tile_acc = 0;
    CJ(w_up + (size_t)2048 * 8192, WS_WMLP1, 2048, 8192, 2048, 8192); CJ(w_down + (size_t)2048 * 8192, WS_WMLP1 + 32 * MiB, 8192, 2048, 8192, 2048);
    int nop = 0;
    auto GO = [&](const bf16_t* A, const bf16_t* Bt, void* out, const float* bias, const float* res, int M, int N, int K, int ldc, int act, int rot) {
        GemmOp& o = p.g[nop++]; o.A = A; o.Bt = Bt; o.out = out; o.bias = bias; o.res = res; o.M = M; o.N = N; o.K = K; o.ldc = ldc; o.act = act; o.rot = rot; };
    GO(B16(WS_H), B16(WS_WBA), B16(WS_PROJ), nullptr, nullptr, MTOK, INWP, 2048, INWP, 0, 0);
    GO(B16(WS_YMIX), B16(WS_WBA + 17 * MiB), d_out, nullptr, p.in[0], MTOK, 2048, 2048, 2048, 0, 0);
    GO(B16(WS_H), B16(WS_WMLP), B16(WS_U), nullptr, nullptr, MTOK, DFF, 2048, DFF, 1, 0);
    GO(B16(WS_U), B16(WS_WMLP + 32 * MiB), d_out, nullptr, (const float*)d_out, MTOK, 2048, DFF, 2048, 0, 0);
    for (int half = 0; half < 2; ++half) {
        const size_t ro = (size_t)half * 8192 * 2048 * 2, lo_ = (size_t)half * 8192 * 256 * 2; const size_t mb = (size_t)8192 * 2048 * 2;
        GO(B16(WS_MIX + 0 * mb), B16(WS_WBA), B16(WS_R + ro), nullptr, nullptr, 8192, 2048, 2048, 2048, 0, 0);
        GO(B16(WS_MIX + 2 * mb), B16(WS_WBA + 8 * MiB), B16(WS_K + ro), nullptr, nullptr, 8192, 2048, 2048, 2048, 0, 0);
        GO(B16(WS_MIX + 3 * mb), B16(WS_WBA + 16 * MiB), B16(WS_V + ro), nullptr, nullptr, 8192, 2048, 2048, 2048, 0, 0);
        GO(B16(WS_MIX + 1 * mb), B16(WS_WBA + 32 * MiB), B16(WS_L1W + lo_), nullptr, nullptr, 8192, 256, 2048, 256, 2, 0);
        GO(B16(WS_MIX + 4 * mb), B16(WS_WBA + 33 * MiB), B16(WS_L1A + lo_), nullptr, nullptr, 8192, 256, 2048, 256, 0, 32);
        GO(B16(WS_MIX + 5 * mb), B16(WS_WBA + 34 * MiB), B16(WS_L1G + lo_), nullptr, nullptr, 8192, 256, 2048, 256, 3, 64);
    }
    GO(B16(WS_L1W), B16(WS_WBA + 35 * MiB), B16(WS_WDEC), p.in[17], nullptr, MTOK, 2048, 256, 2048, 4, 0);
    GO(B16(WS_L1A), B16(WS_WBA + 36 * MiB), B16(WS_AA), p.in[20], nullptr, MTOK, 2048, 256, 2048, 3, 0);
    GO(B16(WS_L1G), B16(WS_WBA + 37 * MiB), B16(WS_GG), nullptr, nullptr, MTOK, 2048, 256, 2048, 0, 0);
    GO(B16(WS_YG), B16(WS_WBA + 24 * MiB), d_out, nullptr, (const float*)d_out, MTOK, 2048, 2048, 2048, 0, 0);
    GO(B16(WS_H), B16(WS_WMLP1), B16(WS_U), nullptr, nullptr, MTOK, DFF, 2048, DFF, 1, 0);
    GO(B16(WS_U), B16(WS_WMLP1 + 32 * MiB), d_out, nullptr, (const float*)d_out, MTOK, 2048, DFF, 2048, 0, 0);
    int ns = 0;
    auto ST = [&](int kind, int lo, int hi, int clo = 0, int chi = 0, int cq = 0) { p.kind[ns] = kind; p.lo[ns] = lo; p.hi[ns] = hi; p.clo[ns] = clo; p.chi[ns] = chi; p.cq[ns] = cq; ++ns; };
    ST(K_PRE0, 0, 2); ST(K_GEMMB, 0, 1, 2, 4, 0); ST(K_CONVSSD, 0, 0); ST(K_MIX0, 0, 0); ST(K_POST0, 0, 0); ST(K_GEMMF, 1, 2); ST(K_NORM, 0, 0); ST(K_GEMMB, 2, 3); ST(K_GEMMF, 3, 4);
    ST(K_PRE1, 4, 14); ST(K_GEMMB, 4, 10, 14, 16, 1); ST(K_MIXES, 0, 0); ST(K_GEMMB, 10, 16, 14, 16, 1); ST(K_GEMMB, 16, 19); ST(K_RWKV, 0, 0); ST(K_GEMMF, 19, 20); ST(K_NORM, 1, 0); ST(K_GEMMB, 20, 21); ST(K_GEMMF, 21, 22);
    (void)hipMemsetAsync(ws + WS_BAR, 0, 16384 + 1024, stream);
#if MK_MULTI
    for (int s = 0; s < ns; ++s) { p.step_lo = s; p.step_hi = s + 1; hipLaunchKernelGGL(mega, dim3(grid), dim3(512), LDS_BYTES, stream, p); }
#else
    p.step_lo = 0; p.step_hi = ns;
    void* args[] = {(void*)&p};
    const hipError_t e = hipLaunchCooperativeKernel((const void*)mega, dim3(grid), dim3(512), args, LDS_BYTES, stream);
    if (e != hipSuccess) fprintf(stderr, "cooperative launch failed: %s (grid %d)\n", hipGetErrorString(e), grid);
#endif
}
```

```cpp
#include <hip/hip_runtime.h>
#include <hip/hip_cooperative_groups.h>
#include <cstdio>
#include <cstring>
namespace cg = cooperative_groups;
__device__ __forceinline__ int opq(int v) { asm volatile("" : "+v"(v)); return v; }
namespace pg8 {
#define PG8_LAS __attribute__((address_space(3)))
typedef unsigned short bf16_t;
typedef short bf16x8 __attribute__((ext_vector_type(8)));
typedef float f32x4 __attribute__((ext_vector_type(4)));
typedef unsigned u32x4 __attribute__((ext_vector_type(4)));
constexpr int BM = 256, BK = 64, HALF = 128, HTB = HALF * BK * 2  , STAGE_BYTES = 8 * HTB, NXCD = 8, WGM = 8;

__host__ __device__ __forceinline__ int lds_byte(int r, int c) { const int st = (r >> 4) * 2 + (c >> 5), rr = r & 15, cc = c & 31, ob = rr * 64 + cc * 2; return st * 1024 + (ob ^ (((ob >> 9) & 1) << 5)); }
__host__ __device__ __forceinline__ void stage_rc(int b, int& R, int& C) { const int st = b / 1024, sb = b % 1024, swz = sb ^ (((sb >> 9) & 1) << 5); R = (st >> 1) * 16 + swz / 64; C = (st & 1) * 32 + (swz % 64) / 2; }
__host__ __device__ __forceinline__ int perm32(int rho) { const int n = rho >> 4, i = rho & 15; return 8 * (i >> 2) + 4 * n + (i & 3); }

struct Unit { int pm, pn; };
struct Gemm { const bf16_t* A; const bf16_t* Bt; int M, N, K; };

struct StaticOrder {
    int nM, nN, nwg, G, c;
    __host__ __device__ void init(int M, int N, int G_, int c_) { nM = M / BM; nN = N / BM; nwg = nM * nN; G = G_; c = c_; }
    __host__ __device__ bool next(int i, Unit& u) const {
        const long L = (long)i * G + c; if (L >= nwg) return false;
        int wgid = (int)L; { const int q = nwg / NXCD, r = nwg % NXCD, xcd = wgid % NXCD, off = wgid / NXCD; wgid = (xcd < r ? xcd * (q + 1) : r * (q + 1) + (xcd - r) * q) + off; }
        const int nig = WGM * nN, gid = wgid / nig, fm = gid * WGM, gsz = (nM - fm) < WGM ? (nM - fm) : WGM;
        u.pm = fm + ((wgid % nig) % gsz); u.pn = (wgid % nig) / gsz; return true;
    }
    __device__ __forceinline__ void a_ready(const Unit&) const {}
    __device__ __forceinline__ void done(const Unit&) const {}
};
typedef __bf16 bf16x2_t __attribute__((ext_vector_type(2)));
typedef float f32x2_t __attribute__((ext_vector_type(2)));
__device__ __forceinline__ unsigned cvt_pk_bf16(float lo, float hi) { const f32x2_t f = {lo, hi}; const bf16x2_t v = __builtin_convertvector(f, bf16x2_t); return __builtin_bit_cast(unsigned, v); }
__device__ __forceinline__ unsigned cvt_pk_nv(float lo, float hi) { return cvt_pk_bf16(lo, hi); }

template <class Epi, class Sched, bool STAMP = false>
__device__ __forceinline__ void gemm_phase(PG8_LAS unsigned char* lds, const Gemm g, const Sched& S, const Epi& E, unsigned long long* stamps) {
    const int tid = opq(threadIdx.x), wid = __builtin_amdgcn_readfirstlane(tid >> 6), lane = tid & 63, wr = wid >> 2, wc = wid & 3, fr = lane & 15, fq = lane >> 4;
    const int K = g.K, nt = K / BK;
    int ts_lo = 0, ts_hi = 0, nts = 0; const unsigned long long rt_entry = STAMP ? (unsigned long long)wall_clock64() : 0ull;
#define PG8_STAMP() do { if (STAMP && wid == 0 && nts < 64) { const unsigned long long _c = (unsigned long long)clock64(); \
        ts_lo = (lane == nts) ? (int)(unsigned)_c : ts_lo; ts_hi = (lane == nts) ? (int)(unsigned)(_c >> 32) : ts_hi; ++nts; } } while (0)
    PG8_STAMP();
    unsigned voffA[2], voffB[2];
#pragma unroll
    for (int i = 0; i < 2; ++i) { int R, C; stage_rc(tid * 16 + i * 8192, R, C); const int Rb = Epi::PERM ? ((R & ~31) + perm32(R & 31)) : R;
        voffA[i] = (unsigned)(R * K + C) * 2u; voffB[i] = (unsigned)(Rb * K + C) * 2u; }
    const size_t kstep = (size_t)(BK * 2);
    const size_t hstep = (size_t)HALF * K * 2;
    const size_t tstep = 2 * hstep;
    const unsigned ldsw = (unsigned)wid * 1024u;
    const int aoff = lds_byte(wr * 64 + fr, fq * 8), boff = lds_byte(wc * 32 + fr, fq * 8);
#define PG8_SA(b, h) (((b) * 2 + (h)) * HTB)
#define PG8_SB(b, h) ((4 + (b) * 2 + (h)) * HTB)
#define PG8_STAGE(bufoff, gbase, voff) do { _Pragma("unroll") for (int _i = 0; _i < 2; ++_i) \
        __builtin_amdgcn_global_load_lds((const unsigned*)((const char*)(gbase) + (voff)[_i]), (PG8_LAS unsigned*)(lds + (bufoff) + ldsw + _i * 8192), 16, 0, 0); } while (0)
#define PG8_LDA(dst, b, h) do { _Pragma("unroll") for (int m = 0; m < 4; ++m) _Pragma("unroll") for (int k = 0; k < 2; ++k) dst[m][k] = *(const PG8_LAS bf16x8*)(lds + PG8_SA(b, h) + aoff + m * 2048 + k * 1024); } while (0)
#define PG8_LDB(dst, b, h) do { _Pragma("unroll") for (int n = 0; n < 2; ++n) _Pragma("unroll") for (int k = 0; k < 2; ++k) dst[n][k] = *(const PG8_LAS bf16x8*)(lds + PG8_SB(b, h) + boff + n * 2048 + k * 1024); } while (0)
#define PG8_MMA(ai, bj, At, Bt) do { __builtin_amdgcn_s_setprio(1); _Pragma("unroll") for (int m = 0; m < 4; ++m) _Pragma("unroll") for (int n = 0; n < 2; ++n) _Pragma("unroll") for (int k = 0; k < 2; ++k) \
        acc[ai][bj][m][n] = __builtin_amdgcn_mfma_f32_16x16x32_bf16(Bt[n][k], At[m][k], acc[ai][bj][m][n], 0, 0, 0); __builtin_amdgcn_s_setprio(0); } while (0)
#define PG8_WAIT_V(n) asm volatile("s_waitcnt vmcnt(" #n ")" ::: "memory")
#define PG8_WAIT_L(n) asm volatile("s_waitcnt lgkmcnt(" #n ")" ::: "memory")
#define PG8_BAR __builtin_amdgcn_s_barrier()
#define PG8_SCHED __builtin_amdgcn_sched_barrier(0)
    Unit cur, nxt; int ui = 0;
    if (!S.next(0, cur)) return;
    f32x4 acc[2][2][4][2];
#pragma unroll
    for (int a = 0; a < 2; ++a)
#pragma unroll
        for (int b = 0; b < 2; ++b)
#pragma unroll
            for (int m = 0; m < 4; ++m)
#pragma unroll
                for (int n = 0; n < 2; ++n) acc[a][b][m][n] = (f32x4){0.f, 0.f, 0.f, 0.f};
    bf16x8 At[4][2], B0[2][2], B1[2][2];
    const char* cA = (const char*)g.A + (size_t)cur.pm * tstep; const char* cB = (const char*)g.Bt + (size_t)cur.pn * tstep;
    S.a_ready(cur);
    PG8_STAGE(PG8_SB(0, 0), cB, voffB); PG8_STAGE(PG8_SA(0, 0), cA, voffA); PG8_STAGE(PG8_SB(0, 1), cB + hstep, voffB); PG8_STAGE(PG8_SA(0, 1), cA + hstep, voffA);
    if (wr == 1) PG8_BAR;
    PG8_WAIT_V(4); PG8_BAR;
    PG8_STAGE(PG8_SB(1, 0), cB + kstep, voffB); PG8_STAGE(PG8_SA(1, 0), cA + kstep, voffA); PG8_STAGE(PG8_SB(1, 1), cB + hstep + kstep, voffB);
    PG8_WAIT_V(6); PG8_BAR;
    PG8_STAMP();
    for (;;) {
        const bool has_next = S.next(ui + 1, nxt);
        const char* nA = has_next ? (const char*)g.A + (size_t)nxt.pm * tstep : cA; const char* nB = has_next ? (const char*)g.Bt + (size_t)nxt.pn * tstep : cB;
        for (int t = 0; t < nt; t += 2) {
            const bool last = (t == nt - 2);
            const char* a1 = cA + (size_t)(t + 1) * kstep;
            const char* a2 = last ? nA : cA + (size_t)(t + 2) * kstep; const char* b2 = last ? nB : cB + (size_t)(t + 2) * kstep;
            const char* a3 = a2 + kstep; const char* b3 = b2 + kstep;
            if (last && has_next) S.a_ready(nxt);
            PG8_LDB(B0, 0, 0); PG8_SCHED; PG8_LDA(At, 0, 0); PG8_STAGE(PG8_SA(1, 1), a1 + hstep, voffA);
            PG8_WAIT_L(8); PG8_BAR; PG8_WAIT_L(0); PG8_MMA(0, 0, At, B0); PG8_BAR; PG8_SCHED;
            PG8_LDB(B1, 0, 1); PG8_STAGE(PG8_SB(0, 0), b2, voffB);
            PG8_BAR; PG8_WAIT_L(0); PG8_MMA(0, 1, At, B1); PG8_BAR;
            PG8_LDA(At, 0, 1); PG8_STAGE(PG8_SA(0, 0), a2, voffA);
            PG8_BAR; PG8_WAIT_L(0); PG8_MMA(1, 0, At, B0); PG8_BAR; PG8_SCHED;
            PG8_STAGE(PG8_SB(0, 1), b2 + hstep, voffB);
            PG8_WAIT_V(6); PG8_BAR; PG8_MMA(1, 1, At, B1); PG8_BAR;
            PG8_LDB(B0, 1, 0); PG8_SCHED; PG8_LDA(At, 1, 0); PG8_STAGE(PG8_SA(0, 1), a2 + hstep, voffA);
            PG8_WAIT_L(8); PG8_BAR; PG8_WAIT_L(0); PG8_MMA(0, 0, At, B0); PG8_BAR; PG8_SCHED;
            PG8_LDB(B1, 1, 1); PG8_STAGE(PG8_SB(1, 0), b3, voffB);
            PG8_BAR; PG8_WAIT_L(0); PG8_MMA(0, 1, At, B1); PG8_BAR;
            PG8_LDA(At, 1, 1); PG8_STAGE(PG8_SA(1, 0), a3, voffA);
            PG8_BAR; PG8_WAIT_L(0); PG8_MMA(1, 0, At, B0); PG8_BAR; PG8_SCHED;
            PG8_STAGE(PG8_SB(1, 1), b3 + hstep, voffB);
            PG8_WAIT_V(6); PG8_BAR; PG8_MMA(1, 1, At, B1); PG8_BAR;
        }
        PG8_STAMP();
        if constexpr (!Epi::AFTER_DRAIN) { E(acc, cur, wr, wc, fr, fq); S.done(cur); }
        PG8_STAMP();
        if (!has_next) break;
#pragma unroll
        for (int a = 0; a < 2; ++a)
#pragma unroll
            for (int b = 0; b < 2; ++b)
#pragma unroll
                for (int m = 0; m < 4; ++m)
#pragma unroll
                    for (int n = 0; n < 2; ++n) acc[a][b][m][n] = (f32x4){0.f, 0.f, 0.f, 0.f};
        cur = nxt; cA = nA; cB = nB; ++ui;
    }
    PG8_WAIT_V(0);
    if (wr == 0) PG8_BAR;
    PG8_BAR;
    if constexpr (Epi::AFTER_DRAIN) { E.fused(acc, cur, wr, wc, fr, fq, lds, wid, lane); S.done(cur); }
    PG8_STAMP();
    if (STAMP && wid == 0) { stamps[lane] = lane < nts ? (((unsigned long long)(unsigned)ts_hi << 32) | (unsigned)ts_lo) : 0ull;
        if (lane == 62) stamps[62] = rt_entry; if (lane == 63) stamps[63] = (unsigned long long)wall_clock64(); }
#undef PG8_STAMP
#undef PG8_SA
#undef PG8_SB
#undef PG8_STAGE
#undef PG8_LDA
#undef PG8_LDB
#undef PG8_MMA
#undef PG8_WAIT_V
#undef PG8_WAIT_L
#undef PG8_BAR
#undef PG8_SCHED
}
}

#include <cstdio>
#include <ctime>
#include <cstdlib>
#include <cstring>
#include <cmath>
#include <vector>
#include <algorithm>
#define CK(x) do { hipError_t e_ = (x); if (e_ != hipSuccess) { fprintf(stderr, "HIP %s:%d %s\n", __FILE__, __LINE__, hipGetErrorString(e_)); exit(2); } } while (0)
using pg8::bf16_t; using pg8::bf16x8; using pg8::f32x4; using pg8::u32x4; using pg8::cvt_pk_bf16; using pg8::cvt_pk_nv;
#define LAS PG8_LAS

constexpr int D = 2048, SEQ = 2048, MTOK = 16384, DFF = 8192, INWP = 4352;
constexpr int COL_K = 1024, COL_V = 1280, COL_Z = 1536, COL_XBC = 2560, COL_DT = 4096;
constexpr size_t MiB = (size_t)1 << 20;
constexpr size_t WS_WBA = 0, WS_WMLP = 40 * MiB, WS_H = 104 * MiB, WS_PROJ = 168 * MiB, WS_YMIX = 304 * MiB, WS_YRAW = 368 * MiB, WS_XBC = 432 * MiB,
                 WS_DT = 480 * MiB, WS_DA = 481 * MiB, WS_ROPE = 482 * MiB, WS_U = 168 * MiB;
constexpr size_t WS_R = 40 * MiB, WS_K = 104 * MiB, WS_V = 168 * MiB, WS_L1W = 232 * MiB, WS_L1A = 240 * MiB, WS_L1G = 248 * MiB, WS_MIX = 256 * MiB,
                 WS_WDEC = 256 * MiB, WS_AA = 320 * MiB, WS_GG = 384 * MiB, WS_YG = 40 * MiB  , WS_WMLP1 = 448 * MiB;
constexpr size_t WS_BAR = 39 * MiB;
constexpr int LDS_BYTES = 140 * 1024;

enum { K_PRE0 = 0, K_GEMMB, K_GEMMF, K_CONVSSD, K_MIX0, K_POST0, K_NORM, K_PRE1, K_MIXES, K_RWKV, K_NORMCONV };
constexpr int NSTEPS = 48, NOPS = 22, NCJ = 16;
#define REP_GEMMB 1
#define REP_MIX0 1
#define REP_RWKV 1
#define REP_ELEM 1

struct GemmOp { const bf16_t* A; const bf16_t* Bt; void* out; const float* bias; const float* res; int M, N, K, ldc, act, rot, pad0, pad1; };
struct ConvJob { const float* src; bf16_t* dst; int K, N, Kpad, Npad, tile0, ntiles; };
struct Params {
    const float* in[34];
    float* out; unsigned char* ws;
    GemmOp g[NOPS];
    ConvJob cj[NCJ];
    int kind[NSTEPS + 1]; int lo[NSTEPS + 1]; int hi[NSTEPS + 1]; int clo[NSTEPS + 1]; int chi[NSTEPS + 1]; int cq[NSTEPS + 1];
    int step_lo, step_hi;
};

__device__ __forceinline__ float bf2f(unsigned short b) { return __uint_as_float(((unsigned)b) << 16); }
__device__ __forceinline__ float bflo(unsigned w) { return __uint_as_float(w << 16); }
__device__ __forceinline__ float bfhi(unsigned w) { return __uint_as_float(w & 0xffff0000u); }
__device__ __forceinline__ bf16_t f2bf(float f) { return (bf16_t)(cvt_pk_bf16(f, 0.f) & 0xffffu); }
template <int CTRL> __device__ __forceinline__ float dpp_add(float x) {
    const int y = __builtin_amdgcn_update_dpp(0, __builtin_bit_cast(int, x), CTRL, 0xf, 0xf, true);
    return x + __builtin_bit_cast(float, y); }
__device__ __forceinline__ float red8(float x) { x = dpp_add<0xB1>(x); x = dpp_add<0x4E>(x); x = dpp_add<0x141>(x); return x; }
__device__ __forceinline__ float red16(float x) { x = red8(x); x = dpp_add<0x140>(x); return x; }
__device__ __forceinline__ float wave_sum(float v) {
    v = red16(v);
    const float r0 = __builtin_bit_cast(float, __builtin_amdgcn_readlane(__builtin_bit_cast(int, v), 0)), r1 = __builtin_bit_cast(float, __builtin_amdgcn_readlane(__builtin_bit_cast(int, v), 16));
    const float r2 = __builtin_bit_cast(float, __builtin_amdgcn_readlane(__builtin_bit_cast(int, v), 32)), r3 = __builtin_bit_cast(float, __builtin_amdgcn_readlane(__builtin_bit_cast(int, v), 48));
    return (r0 + r1) + (r2 + r3); }
typedef float f32x2 __attribute__((ext_vector_type(2)));
__device__ __forceinline__ float sigmoidf_(float v) { return 1.0f / (1.0f + __expf(-v)); }
__device__ __forceinline__ void unpack8(const uint4 r, float (&f)[8]) {
    f[0] = bflo(r.x); f[1] = bfhi(r.x); f[2] = bflo(r.y); f[3] = bfhi(r.y); f[4] = bflo(r.z); f[5] = bfhi(r.z); f[6] = bflo(r.w); f[7] = bfhi(r.w); }

__device__ __forceinline__ float act_apply(float v, int act) {
    switch (act) {
        case 1: { const float r = fmaxf(v, 0.f); return r * r; }
        case 2: return 1.0f - 2.0f / (1.0f + __expf(2.0f * v));
        case 3: return sigmoidf_(v);
        case 4: return 0.60653066f * sigmoidf_(v);
        default: return v; }
}
struct EpiB {
    static constexpr bool PERM = true, AFTER_DRAIN = false;
    bf16_t* O; int ldc; const float* bias; int act;
    __device__ __forceinline__ void operator()(const f32x4 (&acc)[2][2][4][2], const pg8::Unit& u, int wr, int wc, int fr, int fq) const {
        const int row0 = u.pm * 256 + wr * 64 + fr, col0 = u.pn * 256 + wc * 32 + 8 * fq;
#pragma unroll
        for (int ai = 0; ai < 2; ++ai)
#pragma unroll
            for (int m = 0; m < 4; ++m) { bf16_t* rowp = O + (size_t)(row0 + ai * 128 + m * 16) * ldc + col0;
#pragma unroll
                for (int bj = 0; bj < 2; ++bj) { f32x4 v0 = acc[ai][bj][m][0], v1 = acc[ai][bj][m][1];
                    if (bias) { v0 += *(const f32x4*)(bias + col0 + bj * 128); v1 += *(const f32x4*)(bias + col0 + bj * 128 + 4); }
                    if (act) {
#pragma unroll
                        for (int j = 0; j < 4; ++j) { v0[j] = act_apply(v0[j], act); v1[j] = act_apply(v1[j], act); } }
                    u32x4 w; w.x = cvt_pk_bf16(v0[0], v0[1]); w.y = cvt_pk_bf16(v0[2], v0[3]); w.z = cvt_pk_bf16(v1[0], v1[1]); w.w = cvt_pk_bf16(v1[2], v1[3]);
                    *(u32x4*)(rowp + bj * 128) = w; } }
    }
};
struct EpiF {
    static constexpr bool PERM = false, AFTER_DRAIN = false;
    float* C; int ldc; const float* res;
    __device__ __forceinline__ void operator()(const f32x4 (&acc)[2][2][4][2], const pg8::Unit& u, int wr, int wc, int fr, int fq) const {
        const int row0 = u.pm * 256 + wr * 64 + fr, col0 = u.pn * 256 + wc * 32 + 4 * fq;
#pragma unroll
        for (int ai = 0; ai < 2; ++ai)
#pragma unroll
            for (int m = 0; m < 4; ++m) { const size_t ro = (size_t)(row0 + ai * 128 + m * 16) * ldc + col0;
#pragma unroll
                for (int bj = 0; bj < 2; ++bj)
#pragma unroll
                    for (int n = 0; n < 2; ++n) { const f32x4 r = *(const f32x4*)(res + ro + bj * 128 + n * 16); *(f32x4*)(C + ro + bj * 128 + n * 16) = acc[ai][bj][m][n] + r; } }
    }
};

__device__ __forceinline__ void convert_one_tile(const Params& p, int jlo, int jhi, int tile, int tid, LAS float* T) {
    int j = jlo; while (j + 1 < jhi && tile >= p.cj[j + 1].tile0) ++j;
    const float* src = p.cj[j].src; bf16_t* dst = p.cj[j].dst; const int K = p.cj[j].K, N = p.cj[j].N, Kpad = p.cj[j].Kpad;
    const int local = tile - p.cj[j].tile0, nkt = Kpad >> 6, kt = local % nkt, nt = local / nkt;
    f32x4 v[8];
#pragma unroll
    for (int i = 0; i < 8; ++i) { const int idx = tid + i * 512, kr = idx >> 6, c4 = idx & 63, k = kt * 64 + kr, n = nt * 256 + c4 * 4;
        v[i] = (f32x4){0.f, 0.f, 0.f, 0.f};
        if (k < K && n < N) v[i] = *(const f32x4*)(src + (size_t)k * N + n); }
#pragma unroll
    for (int i = 0; i < 8; ++i) { const int idx = tid + i * 512, kr = idx >> 6, c4 = idx & 63;
        T[kr * 257 + c4 * 4 + 0] = v[i][0]; T[kr * 257 + c4 * 4 + 1] = v[i][1]; T[kr * 257 + c4 * 4 + 2] = v[i][2]; T[kr * 257 + c4 * 4 + 3] = v[i][3]; }
    __syncthreads();
#pragma unroll
    for (int i = 0; i < 4; ++i) { const int idx = tid + i * 512, nl = idx >> 3, kc = idx & 7; float f[8];
#pragma unroll
        for (int e = 0; e < 8; ++e) f[e] = T[(kc * 8 + e) * 257 + nl];
        u32x4 w; w.x = cvt_pk_nv(f[0], f[1]); w.y = cvt_pk_nv(f[2], f[3]); w.z = cvt_pk_nv(f[4], f[5]); w.w = cvt_pk_nv(f[6], f[7]);
        *(u32x4*)(dst + (size_t)(nt * 256 + nl) * Kpad + kt * 64 + kc * 8) = w; }
    __syncthreads();
}
__device__ __forceinline__ void convert_tiles(const Params& p, int jlo, int jhi, LAS unsigned char* lds) {
    const int tid = opq(threadIdx.x); LAS float* T = (LAS float*)lds;
    const int total = p.cj[jhi - 1].tile0 + p.cj[jhi - 1].ntiles;
    for (int tile = blockIdx.x; tile < total; tile += gridDim.x) convert_one_tile(p, jlo, jhi, tile, tid, T);
}
__device__ __forceinline__ void convert_queue(const Params& p, int jlo, int jhi, unsigned* counter, LAS unsigned char* lds) {
    const int tid = opq(threadIdx.x); LAS float* T = (LAS float*)lds; LAS int* slot = (LAS int*)(lds + 72 * 1024);
    const int total = p.cj[jhi - 1].tile0 + p.cj[jhi - 1].ntiles;
    for (;;) {
        __syncthreads();
        if (tid == 0) *slot = (int)__hip_atomic_fetch_add(counter, 1u, __ATOMIC_RELAXED, __HIP_MEMORY_SCOPE_AGENT);
        __syncthreads();
        const int tile = *slot;
        if (tile >= total) break;
        convert_one_tile(p, jlo, jhi, tile, tid, T);
    }
}

__device__ __forceinline__ void rope_table(const Params& p) {
    float2* tab = (float2*)(p.ws + WS_ROPE);
    for (int idx = blockIdx.x * 512 + opq(threadIdx.x); idx < SEQ * 32; idx += gridDim.x * 512) {
        const int t = idx >> 5, i = idx & 31;
        const float inv = exp2f(-(float)i * 0.41524101186092029f);
        const float angf = (float)t * inv;
        const double ang = (double)angf;
        const double q = rint(ang * 0.6366197723675814);
        const float f = (float)fma(-q, 1.5707963267948966, ang), f2 = f * f;
        const float s = f * (1.0f + f2 * (-1.6666667e-1f + f2 * (8.3333333e-3f + f2 * (-1.9841270e-4f + f2 * 2.7557319e-6f))));
        const float c = 1.0f + f2 * (-0.5f + f2 * (4.1666667e-2f + f2 * (-1.3888889e-3f + f2 * (2.4801587e-5f + f2 * (-2.7557319e-7f)))));
        const int qi = ((int)q) & 3;
        const float sn = (qi == 0) ? s : (qi == 1) ? c : (qi == 2) ? -s : -c;
        const float cs = (qi == 0) ? c : (qi == 1) ? -s : (qi == 2) ? -c : s;
        tab[idx] = make_float2(cs, sn);
    }
}

__device__ __forceinline__ void norm_rows(const float* x, const float* g, bf16_t* h) {
    const int tid_ = opq(threadIdx.x); const int lane = tid_ & 63, wv = tid_ >> 6;
    f32x4 gg[8];
#pragma unroll
    for (int i = 0; i < 8; ++i) gg[i] = *(const f32x4*)(g + i * 256 + lane * 4);
    for (int row = (blockIdx.x * 8 + wv) * 2; row < MTOK; row += gridDim.x * 16) {
        const float* xr = x + (size_t)row * D; f32x4 v[8], u[8]; float ss = 0.f, st = 0.f;
#pragma unroll
        for (int i = 0; i < 8; ++i) { v[i] = *(const f32x4*)(xr + i * 256 + lane * 4); u[i] = *(const f32x4*)(xr + D + i * 256 + lane * 4); }
#pragma unroll
        for (int i = 0; i < 8; ++i) { ss += v[i][0] * v[i][0] + v[i][1] * v[i][1] + v[i][2] * v[i][2] + v[i][3] * v[i][3]; st += u[i][0] * u[i][0] + u[i][1] * u[i][1] + u[i][2] * u[i][2] + u[i][3] * u[i][3]; }
        ss = wave_sum(ss); st = wave_sum(st); const float r = rsqrtf(ss * (1.0f / D) + 1e-6f), r2 = rsqrtf(st * (1.0f / D) + 1e-6f);
#pragma unroll
        for (int i = 0; i < 8; ++i) {
            uint2 w; w.x = cvt_pk_nv(v[i][0] * r * gg[i][0], v[i][1] * r * gg[i][1]); w.y = cvt_pk_nv(v[i][2] * r * gg[i][2], v[i][3] * r * gg[i][3]);
            *(uint2*)(h + (size_t)row * D + i * 256 + lane * 4) = w;
            uint2 w2; w2.x = cvt_pk_nv(u[i][0] * r2 * gg[i][0], u[i][1] * r2 * gg[i][1]); w2.y = cvt_pk_nv(u[i][2] * r2 * gg[i][2], u[i][3] * r2 * gg[i][3]);
            *(uint2*)(h + (size_t)(row + 1) * D + i * 256 + lane * 4) = w2; }
    }
}

__device__ __forceinline__ void mix_rows(const float* x, const float* g, const float* mixw, bf16_t* mixbase, int tok0, LAS unsigned char* lds) {
    const int tid = opq(threadIdx.x), lane = tid & 63, wv = tid >> 6, c = tid * 4;
    LAS float* rs = (LAS float*)lds;
    const f32x4 gg = *(const f32x4*)(g + c); f32x4 mw[6];
#pragma unroll
    for (int m = 0; m < 6; ++m) mw[m] = *(const f32x4*)(mixw + m * D + c);
    for (int chunk = blockIdx.x; chunk < 256; chunk += gridDim.x) {
        const int rl0 = chunk * 32, tokc = tok0 + rl0; const bool hasprev = (tokc & (SEQ - 1)) != 0;
        __syncthreads();
        for (int r = wv; r < 33; r += 8) {
            float ss = 0.f;
            if (r > 0 || hasprev) { const float* xr = x + (size_t)(tokc - 1 + r) * D; f32x4 v[8];
#pragma unroll
                for (int i = 0; i < 8; ++i) v[i] = *(const f32x4*)(xr + i * 256 + lane * 4);
#pragma unroll
                for (int i = 0; i < 8; ++i) ss += v[i][0] * v[i][0] + v[i][1] * v[i][1] + v[i][2] * v[i][2] + v[i][3] * v[i][3]; }
            ss = wave_sum(ss);
            if (lane == 0) rs[r] = (r > 0 || hasprev) ? rsqrtf(ss * (1.0f / D) + 1e-6f) : 0.f;
        }
        __syncthreads();
        f32x4 prev = (f32x4){0.f, 0.f, 0.f, 0.f};
        if (hasprev) { const f32x4 pv = *(const f32x4*)(x + (size_t)(tokc - 1) * D + c); const float rp = rs[0]; prev = pv * rp * gg; }
        for (int r0 = 0; r0 < 32; r0 += 4) {
            f32x4 xv[4];
#pragma unroll
            for (int u = 0; u < 4; ++u) xv[u] = *(const f32x4*)(x + (size_t)(tokc + r0 + u) * D + c);
#pragma unroll
            for (int u = 0; u < 4; ++u) { const float rr = rs[r0 + u + 1]; const f32x4 hn = xv[u] * rr * gg, xx = prev - hn;
#pragma unroll
                for (int m = 0; m < 6; ++m) { const f32x4 o = hn + xx * mw[m];
                    uint2 w; w.x = cvt_pk_nv(o[0], o[1]); w.y = cvt_pk_nv(o[2], o[3]);
                    *(uint2*)(mixbase + (size_t)m * 8192 * D + (size_t)(rl0 + r0 + u) * D + c) = w; }
                prev = hn; }
        }
    }
}

__device__ __forceinline__ void conv_ssd(const Params& p) {
    const bf16_t* proj = (const bf16_t*)(p.ws + WS_PROJ); bf16_t* xbc = (bf16_t*)(p.ws + WS_XBC);
    const float* cw = p.in[6]; const float* cb = p.in[7];
    const int tid = opq(threadIdx.x);
    if (tid < 384) {
        const int c8 = tid % 192, par = tid / 192, c = c8 * 8;
        float w[4][8], bb[8];
#pragma unroll
        for (int j = 0; j < 4; ++j) { const f32x4 w0 = *(const f32x4*)(cw + j * 1536 + c), w1 = *(const f32x4*)(cw + j * 1536 + c + 4);
#pragma unroll
            for (int e = 0; e < 4; ++e) { w[j][e] = w0[e]; w[j][4 + e] = w1[e]; } }
        { const f32x4 b0 = *(const f32x4*)(cb + c), b1 = *(const f32x4*)(cb + c + 4);
#pragma unroll
          for (int e = 0; e < 4; ++e) { bb[e] = b0[e]; bb[4 + e] = b1[e]; } }
        for (int chunk = blockIdx.x; chunk < 256; chunk += gridDim.x) {
            const int t0 = chunk * 64 + par * 32; const bool hasprev = (t0 & (SEQ - 1)) != 0;
            float r0[8], r1[8], r2[8];
            if (hasprev) { const uint4 a = *(const uint4*)(proj + (size_t)(t0 - 3) * INWP + COL_XBC + c), b = *(const uint4*)(proj + (size_t)(t0 - 2) * INWP + COL_XBC + c), d = *(const uint4*)(proj + (size_t)(t0 - 1) * INWP + COL_XBC + c);
                unpack8(a, r0); unpack8(b, r1); unpack8(d, r2); }
            else {
#pragma unroll
                for (int e = 0; e < 8; ++e) { r0[e] = 0.f; r1[e] = 0.f; r2[e] = 0.f; } }
            for (int tg = 0; tg < 32; tg += 4) {
                uint4 rw[4];
#pragma unroll
                for (int u = 0; u < 4; ++u) rw[u] = *(const uint4*)(proj + (size_t)(t0 + tg + u) * INWP + COL_XBC + c);
#pragma unroll
                for (int u = 0; u < 4; ++u) { float cur[8], acc[8]; unpack8(rw[u], cur);
#pragma unroll
                    for (int e = 0; e < 8; ++e) { acc[e] = bb[e] + w[0][e] * r0[e] + w[1][e] * r1[e] + w[2][e] * r2[e] + w[3][e] * cur[e]; acc[e] = acc[e] * sigmoidf_(acc[e]); r0[e] = r1[e]; r1[e] = r2[e]; r2[e] = cur[e]; }
                    u32x4 o; o.x = cvt_pk_nv(acc[0], acc[1]); o.y = cvt_pk_nv(acc[2], acc[3]); o.z = cvt_pk_nv(acc[4], acc[5]); o.w = cvt_pk_nv(acc[6], acc[7]);
                    *(u32x4*)(xbc + (size_t)(t0 + tg + u) * 1536 + c) = o; }
            }
        }
    }
    float* dt = (float*)(p.ws + WS_DT); float* da = (float*)(p.ws + WS_DA);
    for (int idx = blockIdx.x * 512 + opq(threadIdx.x); idx < MTOK * 16; idx += gridDim.x * 512) {
        const int tok = idx >> 4, hh = idx & 15;
        const float v = bf2f(proj[(size_t)tok * INWP + COL_DT + hh]) + p.in[8][hh];
        const float d = fmaxf(v, 0.f) + __logf(1.0f + __expf(-fabsf(v)));
        dt[idx] = d; da[idx] = __expf(-d * __expf(p.in[9][hh]));
    }
}

__device__ __forceinline__ void ssd_scan_job(const Params& p, int job, LAS unsigned char* lds) {
    const int tid = opq(threadIdx.x);
    const int b = job >> 5, hs = (job >> 1) & 15, half = job & 1, grp = hs >> 3, p0 = half * 32;
    const bf16_t* xbc = (const bf16_t*)(p.ws + WS_XBC) + (size_t)b * SEQ * 1536;
    const float* dtp = (const float*)(p.ws + WS_DT) + (size_t)b * SEQ * 16 + hs;
    const float* dap = (const float*)(p.ws + WS_DA) + (size_t)b * SEQ * 16 + hs;
    float* yraw = (float*)(p.ws + WS_YRAW) + (size_t)b * SEQ * 1024 + hs * 64 + p0;
    const float dskip = p.in[10][hs];
    constexpr int BUF_F = 9280;
    LAS float* L = (LAS float*)lds;
    const bool producer = tid >= 256; const int ptid = tid & 255;
    int grow[5], gcol[5], loff[5];
#pragma unroll
    for (int k = 0; k < 5; ++k) { const int q = ptid + k * 256, row = q / 36, pc = q - row * 36; grow[k] = row;
        if (pc < 4) { gcol[k] = hs * 64 + p0 + pc * 8; loff[k] = row * 32 + pc * 8; }
        else if (pc < 20) { gcol[k] = 1024 + grp * 128 + (pc - 4) * 8; loff[k] = 1024 + row * 128 + (pc - 4) * 8; }
        else { gcol[k] = 1280 + grp * 128 + (pc - 20) * 8; loff[k] = 5120 + row * 128 + (pc - 20) * 8; } }
    uint4 rg[5]; float sc = 0.f;
#define SSD_ISSUE(t0) do { _Pragma("unroll") for (int k = 0; k < 5; ++k) if (ptid + k * 256 < 1152) rg[k] = *(const uint4*)(xbc + (size_t)((t0) + grow[k]) * 1536 + gcol[k]); \
        if (ptid < 32) sc = dtp[((t0) + ptid) * 16]; else if (ptid < 64) sc = dap[((t0) + ptid - 32) * 16]; } while (0)
#define SSD_COMMIT(buf) do { LAS float* Lc = L + (buf) * BUF_F; _Pragma("unroll") for (int k = 0; k < 5; ++k) if (ptid + k * 256 < 1152) { float f[8]; unpack8(rg[k], f); \
            *(LAS f32x4*)(Lc + loff[k]) = (f32x4){f[0], f[1], f[2], f[3]}; *(LAS f32x4*)(Lc + loff[k] + 4) = (f32x4){f[4], f[5], f[6], f[7]}; } \
        if (ptid < 32) Lc[9216 + ptid] = sc; else if (ptid < 64) Lc[9248 + ptid - 32] = sc; } while (0)
#define SSD_FLUSH(chp) do { LAS float* yo = L + 2 * BUF_F + ((chp) & 1) * 1024; const f32x4 v = *(LAS f32x4*)(yo + (ptid >> 3) * 32 + (ptid & 7) * 4); \
        *(f32x4*)(yraw + (size_t)((chp) * 32 + (ptid >> 3)) * 1024 + (ptid & 7) * 4) = v; } while (0)
    f32x2 hA[4], hB[4];
#pragma unroll
    for (int i = 0; i < 4; ++i) { hA[i] = (f32x2){0.f, 0.f}; hB[i] = (f32x2){0.f, 0.f}; }
    const int prow = (tid >> 4) & 15, nseg = tid & 15;
    __syncthreads();
    if (producer) { SSD_ISSUE(0); SSD_COMMIT(0); SSD_ISSUE(32); }
    __syncthreads();
    for (int ch = 0; ch < 64; ++ch) {
        const int cur = ch & 1;
        if (producer) {
            if (ch >= 1) SSD_FLUSH(ch - 1);
            if (ch + 1 < 64) SSD_COMMIT(cur ^ 1);
            if (ch + 2 < 64) SSD_ISSUE((ch + 2) * 32);
        } else {
        LAS float* Lb = L + cur * BUF_F; LAS float* yb = L + 2 * BUF_F + cur * 1024;
        for (int tg = 0; tg < 32; tg += 16) {
            float yA[16], yB[16];
            LAS float* qb = Lb + 1024 + tg * 128 + nseg * 8;
            f32x4 b0 = *(LAS f32x4*)(qb), b1 = *(LAS f32x4*)(qb + 4), c0 = *(LAS f32x4*)(qb + 4096), c1 = *(LAS f32x4*)(qb + 4100);
            float dA = Lb[9248 + tg], xa = Lb[tg * 32 + prow], xb = Lb[tg * 32 + prow + 16], dtv = Lb[9216 + tg];
#pragma unroll
            for (int tt = 0; tt < 16; ++tt) {
                f32x4 nb0, nb1, nc0, nc1; float ndA, nxa, nxb, ndtv;
                if (tt + 1 < 16) { LAS float* q = qb + (tt + 1) * 128; nb0 = *(LAS f32x4*)(q); nb1 = *(LAS f32x4*)(q + 4); nc0 = *(LAS f32x4*)(q + 4096); nc1 = *(LAS f32x4*)(q + 4100);
                    ndA = Lb[9248 + tg + tt + 1]; nxa = Lb[(tg + tt + 1) * 32 + prow]; nxb = Lb[(tg + tt + 1) * 32 + prow + 16]; ndtv = Lb[9216 + tg + tt + 1]; }
                __builtin_amdgcn_sched_barrier(0);
                const float xdta = xa * dtv, xdtb = xb * dtv;
                const f32x2 dA2 = (f32x2){dA, dA}, xa2 = (f32x2){xdta, xdta}, xb2 = (f32x2){xdtb, xdtb};
                hA[0] = hA[0] * dA2 + xa2 * b0.xy; hB[0] = hB[0] * dA2 + xb2 * b0.xy; hA[1] = hA[1] * dA2 + xa2 * b0.zw; hB[1] = hB[1] * dA2 + xb2 * b0.zw;
                hA[2] = hA[2] * dA2 + xa2 * b1.xy; hB[2] = hB[2] * dA2 + xb2 * b1.xy; hA[3] = hA[3] * dA2 + xa2 * b1.zw; hB[3] = hB[3] * dA2 + xb2 * b1.zw;
                f32x2 ya = hA[0] * c0.xy, yb2 = hB[0] * c0.xy; ya = hA[1] * c0.zw + ya; yb2 = hB[1] * c0.zw + yb2; ya = hA[2] * c1.xy + ya; yb2 = hB[2] * c1.xy + yb2; ya = hA[3] * c1.zw + ya; yb2 = hB[3] * c1.zw + yb2;
                float ra = ya.x + ya.y, rb = yb2.x + yb2.y;
                ra = dpp_add<0xB1>(ra); rb = dpp_add<0xB1>(rb); ra = dpp_add<0x4E>(ra); rb = dpp_add<0x4E>(rb); ra = dpp_add<0x141>(ra); rb = dpp_add<0x141>(rb); ra = dpp_add<0x140>(ra); rb = dpp_add<0x140>(rb);
                yA[tt] = ra + dskip * xa; yB[tt] = rb + dskip * xb;
                __builtin_amdgcn_sched_barrier(0);
                if (tt + 1 < 16) { b0 = nb0; b1 = nb1; c0 = nc0; c1 = nc1; dA = ndA; xa = nxa; xb = nxb; dtv = ndtv; }
            }
            if (nseg == 0) {
#pragma unroll
                for (int tt = 0; tt < 16; ++tt) { yb[(tg + tt) * 32 + prow] = yA[tt]; yb[(tg + tt) * 32 + prow + 16] = yB[tt]; } }
        }
        }
        __syncthreads();
    }
    if (producer) SSD_FLUSH(63);
#undef SSD_ISSUE
#undef SSD_COMMIT
#undef SSD_FLUSH
}

__device__ __forceinline__ void ssd_chunk_job(const Params& p, int job, LAS unsigned char* lds) {
    const int tid = opq(threadIdx.x), lane = tid & 63, w = tid >> 6, fr = lane & 15, fq = lane >> 4;
    const int b = job >> 5, hs = (job >> 1) & 15, half = job & 1, grp = hs >> 3, p0 = half * 32;
    const bf16_t* xbc = (const bf16_t*)(p.ws + WS_XBC) + (size_t)b * SEQ * 1536;
    const float* dtp = (const float*)(p.ws + WS_DT) + (size_t)b * SEQ * 16 + hs;
    float* yraw = (float*)(p.ws + WS_YRAW) + (size_t)b * SEQ * 1024 + hs * 64 + p0;
    const float dskip = p.in[10][hs], Ah = -__expf(p.in[9][hs]);
    constexpr int RS = 136;
    LAS bf16_t* Cs = (LAS bf16_t*)lds;
    LAS bf16_t* Bs = (LAS bf16_t*)(lds + 34816);
    LAS bf16_t* BTs = (LAS bf16_t*)(lds + 69632);
    LAS bf16_t* XTa = (LAS bf16_t*)(lds + 104448);
    LAS bf16_t* XTb = (LAS bf16_t*)(lds + 113152);
    LAS bf16_t* Ps = (LAS bf16_t*)(lds + 121856);
    LAS float* af = (LAS float*)(lds + 130560);
    LAS float* dtf = (LAS float*)(lds + 131584);
    const int crow0 = tid >> 4, cpc = tid & 15;
    const int xk = tid >> 2, xpc = tid & 3;
    u32x4 rc[4], rb[4], rx; float rdt = 0.f;
#define SC_ISSUE(t0) do { _Pragma("unroll") for (int i = 0; i < 4; ++i) { const bf16_t* rp_ = xbc + (size_t)((t0) + (crow0 + 32 * i)) * 1536 + grp * 128 + cpc * 8; rb[i] = *(const u32x4*)(rp_ + 1024); rc[i] = *(const u32x4*)(rp_ + 1280); } \
        rx = *(const u32x4*)(xbc + (size_t)((t0) + xk) * 1536 + hs * 64 + p0 + xpc * 8); if (tid < 128) rdt = dtp[((t0) + tid) * 16]; } while (0)
    f32x4 st[2];
    st[0] = (f32x4){0.f, 0.f, 0.f, 0.f}; st[1] = st[0];
    __syncthreads();
    for (int i = tid; i < 32 * RS / 2; i += 512) ((LAS unsigned*)Ps)[i] = 0u;
    SC_ISSUE(0);
    for (int ch = 0; ch < 16; ++ch) {
        const int t0 = ch * 128;
        __syncthreads();
#pragma unroll
        for (int i = 0; i < 4; ++i) { *(LAS u32x4*)(Cs + (crow0 + 32 * i) * RS + cpc * 8) = rc[i]; *(LAS u32x4*)(Bs + (crow0 + 32 * i) * RS + cpc * 8) = rb[i];

#pragma unroll
            for (int e = 0; e < 4; ++e) { BTs[(cpc * 8 + 2 * e) * RS + (crow0 + 32 * i)] = (bf16_t)(rb[i][e] & 0xffffu); BTs[(cpc * 8 + 2 * e + 1) * RS + (crow0 + 32 * i)] = (bf16_t)(rb[i][e] >> 16); } }
        float csv = 0.f;
        if (tid < 128) {
            csv = rdt * Ah; dtf[tid] = rdt;
#pragma unroll
            for (int off = 1; off < 64; off <<= 1) { const float t_ = __shfl_up(csv, off); if (lane >= off) csv += t_; }
            if (tid == 63) af[128] = csv;
        }
        float xr[8]; xr[0] = bflo(rx[0]); xr[1] = bfhi(rx[0]); xr[2] = bflo(rx[1]); xr[3] = bfhi(rx[1]); xr[4] = bflo(rx[2]); xr[5] = bfhi(rx[2]); xr[6] = bflo(rx[3]); xr[7] = bfhi(rx[3]);
        __syncthreads();
        if (tid < 128) af[tid] = (tid >= 64) ? csv + af[128] : csv;
        __syncthreads();
        const float cs_last = af[127];
        { const float d = dtf[xk], dout = __expf(cs_last - af[xk]);
#pragma unroll
          for (int e = 0; e < 8; ++e) { const float xa = xr[e] * d; XTa[(xpc * 8 + e) * RS + xk] = f2bf(xa); XTb[(xpc * 8 + e) * RS + xk] = f2bf(xa * dout); } }
        __syncthreads();
        bf16x8 cf[4];
#pragma unroll
        for (int ks = 0; ks < 4; ++ks) cf[ks] = *(LAS bf16x8*)(Cs + (w * 16 + fr) * RS + ks * 32 + fq * 8);
        f32x4 yo[2];
#pragma unroll
        for (int pt = 0; pt < 2; ++pt) { f32x4 acc = (f32x4){0.f, 0.f, 0.f, 0.f};
#pragma unroll
            for (int ks = 0; ks < 4; ++ks) { const bf16x8 pb = *(LAS bf16x8*)(Ps + (pt * 16 + fr) * RS + ks * 32 + fq * 8); acc = __builtin_amdgcn_mfma_f32_16x16x32_bf16(cf[ks], pb, acc, 0, 0, 0); }
            yo[pt] = acc; }
        float csq[4];
#pragma unroll
        for (int i = 0; i < 4; ++i) csq[i] = af[w * 16 + fq * 4 + i];
#pragma unroll
        for (int kt = 0; kt < 8; ++kt) { f32x4 acc = (f32x4){0.f, 0.f, 0.f, 0.f};
#pragma unroll
            for (int ks = 0; ks < 4; ++ks) { const bf16x8 bb = *(LAS bf16x8*)(Bs + (kt * 16 + fr) * RS + ks * 32 + fq * 8); acc = __builtin_amdgcn_mfma_f32_16x16x32_bf16(cf[ks], bb, acc, 0, 0, 0); }
            const int kk = kt * 16 + fr; const float csk = af[kk];
#pragma unroll
            for (int i = 0; i < 4; ++i) { const int qq = w * 16 + fq * 4 + i; const float m = (kk <= qq) ? acc[i] * __expf(csq[i] - csk) : 0.f; Cs[qq * RS + kk] = f2bf(m); } }
        f32x4 yd[2];
        { bf16x8 mf[4];
#pragma unroll
          for (int ks = 0; ks < 4; ++ks) mf[ks] = *(LAS bf16x8*)(Cs + (w * 16 + fr) * RS + ks * 32 + fq * 8);
#pragma unroll
          for (int pt = 0; pt < 2; ++pt) { f32x4 acc = (f32x4){0.f, 0.f, 0.f, 0.f};
#pragma unroll
              for (int ks = 0; ks < 4; ++ks) { const bf16x8 xb = *(LAS bf16x8*)(XTa + (pt * 16 + fr) * RS + ks * 32 + fq * 8); acc = __builtin_amdgcn_mfma_f32_16x16x32_bf16(mf[ks], xb, acc, 0, 0, 0); }
              yd[pt] = acc; } }
#pragma unroll
        for (int pt = 0; pt < 2; ++pt)
#pragma unroll
            for (int i = 0; i < 4; ++i) { const int qq = w * 16 + fq * 4 + i, pp = pt * 16 + fr;
                const float xv = bf2f(xbc[(size_t)(t0 + qq) * 1536 + hs * 64 + p0 + pp]);
                yraw[(size_t)(t0 + qq) * 1024 + pp] = yd[pt][i] + __expf(csq[i]) * yo[pt][i] + dskip * xv; }
        if (ch + 1 < 16) SC_ISSUE(t0 + 128);
        __syncthreads();
        { const float cd = __expf(cs_last);
#pragma unroll
          for (int pt = 0; pt < 2; ++pt) { f32x4 acc = st[pt] * cd;
#pragma unroll
              for (int ks = 0; ks < 4; ++ks) { const bf16x8 xa = *(LAS bf16x8*)(XTb + (pt * 16 + fr) * RS + ks * 32 + fq * 8); const bf16x8 bt = *(LAS bf16x8*)(BTs + (w * 16 + fr) * RS + ks * 32 + fq * 8);
                  acc = __builtin_amdgcn_mfma_f32_16x16x32_bf16(xa, bt, acc, 0, 0, 0); }
              st[pt] = acc;
#pragma unroll
              for (int i = 0; i < 4; ++i) Ps[(pt * 16 + fq * 4 + i) * RS + w * 16 + fr] = f2bf(acc[i]); } }
    }
#undef SC_ISSUE
}

__device__ __forceinline__ void attn_job(const Params& p, int job, LAS unsigned char* lds) {
    const int tid = opq(threadIdx.x), lane = tid & 63, w = tid >> 6, fr = lane & 15, fq = lane >> 4;
    const int b = job >> 6, kvh = (job >> 4) & 3, nb = job & 15;
    const bf16_t* proj = (const bf16_t*)(p.ws + WS_PROJ) + (size_t)b * SEQ * INWP;
    const float2* rope = (const float2*)(p.ws + WS_ROPE);
    LAS bf16_t* Ks = (LAS bf16_t*)lds;
    LAS bf16_t* Vt = (LAS bf16_t*)(lds + 36864);
    LAS bf16_t* Ps = (LAS bf16_t*)(lds + 70656) + w * 16 * 264;
    __syncthreads();
    if (tid < 256) {
        const int kr = tid, tk = (nb - 1) * 128 + kr;
        if (tk >= 0) {
            const bf16_t* src = proj + (size_t)tk * INWP + COL_K + kvh * 64; float x[64]; float ss = 0.f;
#pragma unroll
            for (int c = 0; c < 8; ++c) { const uint4 r = *(const uint4*)(src + c * 8); float f[8]; unpack8(r, f);
#pragma unroll
                for (int e = 0; e < 8; ++e) { x[c * 8 + e] = f[e]; ss += f[e] * f[e]; } }
            const float rinv = rsqrtf(ss * (1.0f / 64) + 1e-6f); const float* kn = p.in[13];
#pragma unroll
            for (int i = 0; i < 64; ++i) x[i] = x[i] * rinv * kn[i];
#pragma unroll
            for (int c = 0; c < 4; ++c) { float o1[8], o2[8];
#pragma unroll
                for (int e = 0; e < 8; ++e) { const int i = c * 8 + e; const float2 cs = rope[tk * 32 + i]; o1[e] = x[i] * cs.x - x[i + 32] * cs.y; o2[e] = x[i + 32] * cs.x + x[i] * cs.y; }
                u32x4 w1, w2; w1.x = cvt_pk_bf16(o1[0], o1[1]); w1.y = cvt_pk_bf16(o1[2], o1[3]); w1.z = cvt_pk_bf16(o1[4], o1[5]); w1.w = cvt_pk_bf16(o1[6], o1[7]);
                w2.x = cvt_pk_bf16(o2[0], o2[1]); w2.y = cvt_pk_bf16(o2[2], o2[3]); w2.z = cvt_pk_bf16(o2[4], o2[5]); w2.w = cvt_pk_bf16(o2[6], o2[7]);
                *(LAS u32x4*)(Ks + kr * 72 + c * 8) = w1; *(LAS u32x4*)(Ks + kr * 72 + 32 + c * 8) = w2;
                __builtin_amdgcn_sched_barrier(0); }
        } else {
#pragma unroll
            for (int c = 0; c < 8; ++c) *(LAS u32x4*)(Ks + kr * 72 + c * 8) = (u32x4){0u, 0u, 0u, 0u};
        }
    } else {
        const int kr = tid - 256, tk = (nb - 1) * 128 + kr;
        const bf16_t* src = proj + (size_t)(tk < 0 ? 0 : tk) * INWP + COL_V + kvh * 64;
#pragma unroll
        for (int c = 0; c < 8; ++c) { uint4 r = *(const uint4*)(src + c * 8); if (tk < 0) r = make_uint4(0u, 0u, 0u, 0u);
            Vt[(c * 8 + 0) * 264 + kr] = (bf16_t)(r.x & 0xffffu); Vt[(c * 8 + 1) * 264 + kr] = (bf16_t)(r.x >> 16);
            Vt[(c * 8 + 2) * 264 + kr] = (bf16_t)(r.y & 0xffffu); Vt[(c * 8 + 3) * 264 + kr] = (bf16_t)(r.y >> 16);
            Vt[(c * 8 + 4) * 264 + kr] = (bf16_t)(r.z & 0xffffu); Vt[(c * 8 + 5) * 264 + kr] = (bf16_t)(r.z >> 16);
            Vt[(c * 8 + 6) * 264 + kr] = (bf16_t)(r.w & 0xffffu); Vt[(c * 8 + 7) * 264 + kr] = (bf16_t)(r.w >> 16); }
    }
    __syncthreads();
    for (int h4 = 0; h4 < 4; ++h4) {
    const int hq = kvh * 4 + h4;
    bf16x8 qa[2];
    { const int tq = nb * 128 + w * 16 + fr; const bf16_t* src = proj + (size_t)tq * INWP + hq * 64;
      const uint4 r0 = *(const uint4*)(src + fq * 8), r1 = *(const uint4*)(src + 32 + fq * 8); float x1[8], x2[8]; unpack8(r0, x1); unpack8(r1, x2);
      float ss = 0.f;
#pragma unroll
      for (int e = 0; e < 8; ++e) ss += x1[e] * x1[e] + x2[e] * x2[e];
      ss += __shfl_xor(ss, 16); ss += __shfl_xor(ss, 32);
      const float rinv = rsqrtf(ss * (1.0f / 64) + 1e-6f) * 0.125f; const float* qn = p.in[12]; float o1[8], o2[8];
#pragma unroll
      for (int e = 0; e < 8; ++e) { const int i = fq * 8 + e; const float a = x1[e] * rinv * qn[i], c = x2[e] * rinv * qn[i + 32]; const float2 cs = rope[tq * 32 + i];
          o1[e] = a * cs.x - c * cs.y; o2[e] = c * cs.x + a * cs.y; }
      u32x4 w1, w2; w1.x = cvt_pk_bf16(o1[0], o1[1]); w1.y = cvt_pk_bf16(o1[2], o1[3]); w1.z = cvt_pk_bf16(o1[4], o1[5]); w1.w = cvt_pk_bf16(o1[6], o1[7]);
      w2.x = cvt_pk_bf16(o2[0], o2[1]); w2.y = cvt_pk_bf16(o2[2], o2[3]); w2.z = cvt_pk_bf16(o2[4], o2[5]); w2.w = cvt_pk_bf16(o2[6], o2[7]);
      qa[0] = __builtin_bit_cast(bf16x8, w1); qa[1] = __builtin_bit_cast(bf16x8, w2); }
    f32x4 s[16];
#pragma unroll
    for (int j = 0; j < 16; ++j) { f32x4 acc = (f32x4){0.f, 0.f, 0.f, 0.f};
#pragma unroll
        for (int ks = 0; ks < 2; ++ks) { const bf16x8 kb = *(LAS bf16x8*)(Ks + (j * 16 + fr) * 72 + ks * 32 + fq * 8); acc = __builtin_amdgcn_mfma_f32_16x16x32_bf16(qa[ks], kb, acc, 0, 0, 0); }
        s[j] = acc; }
    const float sink = p.in[14][hq];
    float mx[4], inv[4];
#pragma unroll
    for (int i = 0; i < 4; ++i) { const int qi = w * 16 + fq * 4 + i + 128; float m = -3.0e38f;
#pragma unroll
        for (int j = 0; j < 16; ++j) { const int kj = j * 16 + fr; const bool ok = (kj <= qi) && (qi - kj < 128) && (nb > 0 || kj >= 128); s[j][i] = ok ? s[j][i] : -3.0e38f; m = fmaxf(m, s[j][i]); }
        m = fmaxf(m, __shfl_xor(m, 1)); m = fmaxf(m, __shfl_xor(m, 2)); m = fmaxf(m, __shfl_xor(m, 4)); m = fmaxf(m, __shfl_xor(m, 8));
        m = fmaxf(m, sink); mx[i] = m; float l = 0.f;
#pragma unroll
        for (int j = 0; j < 16; ++j) { const float e = (s[j][i] > -1.0e38f) ? __expf(s[j][i] - m) : 0.f; s[j][i] = e; l += e; }
        l += __shfl_xor(l, 1); l += __shfl_xor(l, 2); l += __shfl_xor(l, 4); l += __shfl_xor(l, 8);
        inv[i] = 1.0f / (l + __expf(sink - m)); }
#pragma unroll
    for (int j = 0; j < 16; ++j)
#pragma unroll
        for (int i = 0; i < 4; ++i) Ps[(fq * 4 + i) * 264 + j * 16 + fr] = f2bf(s[j][i] * inv[i]);
    f32x4 o[4];
#pragma unroll
    for (int nd = 0; nd < 4; ++nd) o[nd] = (f32x4){0.f, 0.f, 0.f, 0.f};
#pragma unroll
    for (int kk = 0; kk < 8; ++kk) { const bf16x8 pa = *(LAS bf16x8*)(Ps + fr * 264 + kk * 32 + fq * 8);
#pragma unroll
        for (int nd = 0; nd < 4; ++nd) { const bf16x8 vb = *(LAS bf16x8*)(Vt + (nd * 16 + fr) * 264 + kk * 32 + fq * 8); o[nd] = __builtin_amdgcn_mfma_f32_16x16x32_bf16(pa, vb, o[nd], 0, 0, 0); } }
    bf16_t* ymix = (bf16_t*)(p.ws + WS_YMIX) + (size_t)b * SEQ * D + hq * 64;
#pragma unroll
    for (int nd = 0; nd < 4; ++nd)
#pragma unroll
        for (int i = 0; i < 4; ++i) ymix[(size_t)(nb * 128 + w * 16 + fq * 4 + i) * D + nd * 16 + fr] = f2bf(o[nd][i]);
    }
}

__device__ __forceinline__ void post_ssd(const Params& p) {
    const int tid_ = opq(threadIdx.x); const int lane = tid_ & 63, wv = tid_ >> 6;
    const float* yraw = (const float*)(p.ws + WS_YRAW); const bf16_t* proj = (const bf16_t*)(p.ws + WS_PROJ); bf16_t* ymix = (bf16_t*)(p.ws + WS_YMIX);
    for (int it = blockIdx.x * 8 + wv; it < MTOK * 2; it += gridDim.x * 8) {
        const int tok = it >> 1, grp = it & 1, c = grp * 512 + lane * 8;
        const f32x4 y0 = *(const f32x4*)(yraw + (size_t)tok * 1024 + c), y1 = *(const f32x4*)(yraw + (size_t)tok * 1024 + c + 4);
        const uint4 zr = *(const uint4*)(proj + (size_t)tok * INWP + COL_Z + c); float z[8], y[8]; unpack8(zr, z); float ss = 0.f;
#pragma unroll
        for (int e = 0; e < 8; ++e) { const float yy = (e < 4 ? y0[e] : y1[e - 4]); y[e] = yy * z[e] * sigmoidf_(z[e]); ss += y[e] * y[e]; }
        ss = wave_sum(ss); const float r = rsqrtf(ss * (1.0f / 512) + 1e-6f);
        const f32x4 n0 = *(const f32x4*)(p.in[11] + c), n1 = *(const f32x4*)(p.in[11] + c + 4);
        u32x4 w; w.x = cvt_pk_nv(y[0] * r * n0[0], y[1] * r * n0[1]); w.y = cvt_pk_nv(y[2] * r * n0[2], y[3] * r * n0[3]);
        w.z = cvt_pk_nv(y[4] * r * n1[0], y[5] * r * n1[1]); w.w = cvt_pk_nv(y[6] * r * n1[2], y[7] * r * n1[3]);
        *(u32x4*)(ymix + (size_t)tok * D + 1024 + c) = w;
    }
}

__device__ __forceinline__ float half_sum(float v, bool lo) {
    v = red16(v);
    const float r0 = __builtin_bit_cast(float, __builtin_amdgcn_readlane(__builtin_bit_cast(int, v), 0)), r1 = __builtin_bit_cast(float, __builtin_amdgcn_readlane(__builtin_bit_cast(int, v), 16));
    const float r2 = __builtin_bit_cast(float, __builtin_amdgcn_readlane(__builtin_bit_cast(int, v), 32)), r3 = __builtin_bit_cast(float, __builtin_amdgcn_readlane(__builtin_bit_cast(int, v), 48));
    return lo ? (r0 + r1) : (r2 + r3); }
__device__ __forceinline__ void rwkv_scan_job(const Params& p, int job, LAS unsigned char* lds) {
    const int tid = opq(threadIdx.x), lane = tid & 63, l32 = lane & 31; const bool lo = lane < 32;
    const int b = job >> 5, hh = job & 31;
    LAS float* L = (LAS float*)lds;
    const bool producer = tid >= 256;
    const int pw = (tid >> 6) & 3;
    const int tl0 = 2 * pw + (lane >> 5);
    const size_t wbase = ((size_t)b * SEQ * D + hh * 64) / 2 + l32 + (size_t)tl0 * (D / 2);
    const unsigned* R32 = (const unsigned*)(p.ws + WS_R) + wbase; const unsigned* K32 = (const unsigned*)(p.ws + WS_K) + wbase; const unsigned* V32 = (const unsigned*)(p.ws + WS_V) + wbase;
    const unsigned* E32 = (const unsigned*)(p.ws + WS_WDEC) + wbase; const unsigned* A32 = (const unsigned*)(p.ws + WS_AA) + wbase; const unsigned* G32 = (const unsigned*)(p.ws + WS_GG) + wbase;
    unsigned* Y32 = (unsigned*)(p.ws + WS_YG) + wbase;
    const int ci = hh * 64 + 2 * l32;
    const float2 kkw = *(const float2*)(p.in[25] + ci), kaw = *(const float2*)(p.in[26] + ci), rkw = *(const float2*)(p.in[27] + ci), lnw = *(const float2*)(p.in[32] + ci), lnb = *(const float2*)(p.in[33] + ci);
    unsigned rw[2], kw[2], vw[2], ew[2], aw[2], gw[2];
    const int oo = tl0 * 64 + 2 * l32;
#define RW_ISSUE(t0) do { _Pragma("unroll") for (int i2 = 0; i2 < 2; ++i2) { const size_t off = (size_t)((t0) + 8 * i2) * (D / 2); rw[i2] = R32[off]; kw[i2] = K32[off]; vw[i2] = V32[off]; ew[i2] = E32[off]; aw[i2] = A32[off]; gw[i2] = G32[off]; } } while (0)
#define RW_COMMIT(buf) do { _Pragma("unroll") for (int i2 = 0; i2 < 2; ++i2) { LAS float* Lc = L + (buf) * 8192 + oo + i2 * 512; \
        const float r0_ = bflo(rw[i2]), r1_ = bfhi(rw[i2]), k0_ = bflo(kw[i2]), k1_ = bfhi(kw[i2]), v0_ = bflo(vw[i2]), v1_ = bfhi(vw[i2]), e0_ = bflo(ew[i2]), e1_ = bfhi(ew[i2]), a0_ = bflo(aw[i2]), a1_ = bfhi(aw[i2]), g0_ = bflo(gw[i2]), g1_ = bfhi(gw[i2]); \
        const float kkv0 = k0_ * kkw.x, kkv1 = k1_ * kkw.y; const float ssq = half_sum(kkv0 * kkv0 + kkv1 * kkv1, lo); const float rn = rsqrtf(fmaxf(ssq, 1e-24f)); const float kn0 = kkv0 * rn, kn1 = kkv1 * rn; \
        const float km0 = k0_ * (1.0f + (a0_ - 1.0f) * kaw.x), km1 = k1_ * (1.0f + (a1_ - 1.0f) * kaw.y); const float bonus = half_sum(r0_ * km0 * rkw.x + r1_ * km1 * rkw.y, lo); \
        *(LAS f32x2*)(Lc) = (f32x2){-kn0, -kn1}; *(LAS f32x2*)(Lc + 1024) = (f32x2){__expf(-e0_), __expf(-e1_)}; *(LAS f32x2*)(Lc + 2048) = (f32x2){kn0 * a0_, kn1 * a1_}; *(LAS f32x2*)(Lc + 3072) = (f32x2){km0, km1}; \
        *(LAS f32x2*)(Lc + 4096) = (f32x2){r0_, r1_}; *(LAS f32x2*)(Lc + 5120) = (f32x2){v0_, v1_}; *(LAS f32x2*)(Lc + 6144) = (f32x2){g0_, g1_}; *(LAS f32x2*)(Lc + 7168) = (f32x2){bonus * v0_, bonus * v1_}; } } while (0)
#define RW_OUTPUT(chp) do { LAS float* Lo = L + ((chp) & 1) * 8192; LAS float* yo = L + 16384 + ((chp) & 1) * 1024; _Pragma("unroll") for (int i2 = 0; i2 < 2; ++i2) { const int o2 = oo + i2 * 512; \
        const f32x2 y = *(LAS f32x2*)(yo + o2); \
        const float mu = half_sum(y.x + y.y, lo) * (1.0f / 64), d0 = y.x - mu, d1 = y.y - mu, var = half_sum(d0 * d0 + d1 * d1, lo) * (1.0f / 64), rs = rsqrtf(var + 64e-5f); \
        const f32x2 bv = *(LAS f32x2*)(Lo + 7168 + o2), gg = *(LAS f32x2*)(Lo + 6144 + o2); \
        Y32[(size_t)((chp) * 16 + 8 * i2) * (D / 2)] = cvt_pk_nv((d0 * rs * lnw.x + lnb.x + bv.x) * gg.x, (d1 * rs * lnw.y + lnb.y + bv.y) * gg.y); } } while (0)
    f32x2 SA[4], SB[4];
#pragma unroll
    for (int i = 0; i < 4; ++i) { SA[i] = (f32x2){0.f, 0.f}; SB[i] = (f32x2){0.f, 0.f}; }
    const int rp = (tid >> 3) & 31, ks = tid & 7;
    __syncthreads();
    if (producer) { RW_ISSUE(0); RW_COMMIT(0); RW_ISSUE(16); }
    __syncthreads();
    for (int ch = 0; ch < 128; ++ch) {
        const int cur = ch & 1;
        if (producer) {
            if (ch >= 1) RW_OUTPUT(ch - 1);
            if (ch + 1 < 128) RW_COMMIT(cur ^ 1);
            if (ch + 2 < 128) RW_ISSUE((ch + 2) * 16);
        } else {
            LAS float* Lb = L + cur * 8192; LAS float* yb = L + 16384 + cur * 1024;
            float yA[16], yB[16];
            LAS float* q0 = Lb + ks * 8;
            f32x4 a0 = *(LAS f32x4*)(q0), a1 = *(LAS f32x4*)(q0 + 4), w0 = *(LAS f32x4*)(q0 + 1024), w1 = *(LAS f32x4*)(q0 + 1028), b0 = *(LAS f32x4*)(q0 + 2048), b1 = *(LAS f32x4*)(q0 + 2052);
            f32x4 k0 = *(LAS f32x4*)(q0 + 3072), k1 = *(LAS f32x4*)(q0 + 3076), r0 = *(LAS f32x4*)(q0 + 4096), r1 = *(LAS f32x4*)(q0 + 4100);
            float va = Lb[5120 + rp], vb = Lb[5120 + rp + 32];
#pragma unroll
            for (int t = 0; t < 16; ++t) {
                f32x4 na0, na1, nw0, nw1, nb0, nb1, nk0, nk1, nr0, nr1; float nva, nvb;
                if (t + 1 < 16) { LAS float* q = q0 + (t + 1) * 64;
                    na0 = *(LAS f32x4*)(q); na1 = *(LAS f32x4*)(q + 4); nw0 = *(LAS f32x4*)(q + 1024); nw1 = *(LAS f32x4*)(q + 1028); nb0 = *(LAS f32x4*)(q + 2048); nb1 = *(LAS f32x4*)(q + 2052);
                    nk0 = *(LAS f32x4*)(q + 3072); nk1 = *(LAS f32x4*)(q + 3076); nr0 = *(LAS f32x4*)(q + 4096); nr1 = *(LAS f32x4*)(q + 4100); nva = Lb[5120 + (t + 1) * 64 + rp]; nvb = Lb[5120 + (t + 1) * 64 + rp + 32]; }
                __builtin_amdgcn_sched_barrier(0);
                f32x2 ca = SA[0] * a0.xy, cb = SB[0] * a0.xy; ca = SA[1] * a0.zw + ca; cb = SB[1] * a0.zw + cb; ca = SA[2] * a1.xy + ca; cb = SB[2] * a1.xy + cb; ca = SA[3] * a1.zw + ca; cb = SB[3] * a1.zw + cb;
                float sa = ca.x + ca.y, sb = cb.x + cb.y;
                sa = dpp_add<0xB1>(sa); sb = dpp_add<0xB1>(sb); sa = dpp_add<0x4E>(sa); sb = dpp_add<0x4E>(sb); sa = dpp_add<0x141>(sa); sb = dpp_add<0x141>(sb);
                const f32x2 sa2 = (f32x2){sa, sa}, sb2 = (f32x2){sb, sb}, va2 = (f32x2){va, va}, vb2 = (f32x2){vb, vb};
                SA[0] = SA[0] * w0.xy + (sa2 * b0.xy + va2 * k0.xy); SB[0] = SB[0] * w0.xy + (sb2 * b0.xy + vb2 * k0.xy);
                SA[1] = SA[1] * w0.zw + (sa2 * b0.zw + va2 * k0.zw); SB[1] = SB[1] * w0.zw + (sb2 * b0.zw + vb2 * k0.zw);
                SA[2] = SA[2] * w1.xy + (sa2 * b1.xy + va2 * k1.xy); SB[2] = SB[2] * w1.xy + (sb2 * b1.xy + vb2 * k1.xy);
                SA[3] = SA[3] * w1.zw + (sa2 * b1.zw + va2 * k1.zw); SB[3] = SB[3] * w1.zw + (sb2 * b1.zw + vb2 * k1.zw);
                f32x2 ya = SA[0] * r0.xy, yb2 = SB[0] * r0.xy; ya = SA[1] * r0.zw + ya; yb2 = SB[1] * r0.zw + yb2; ya = SA[2] * r1.xy + ya; yb2 = SB[2] * r1.xy + yb2; ya = SA[3] * r1.zw + ya; yb2 = SB[3] * r1.zw + yb2;
                float ra = ya.x + ya.y, rb = yb2.x + yb2.y;
                ra = dpp_add<0xB1>(ra); rb = dpp_add<0xB1>(rb); ra = dpp_add<0x4E>(ra); rb = dpp_add<0x4E>(rb); ra = dpp_add<0x141>(ra); rb = dpp_add<0x141>(rb);
                yA[t] = ra; yB[t] = rb;
                __builtin_amdgcn_sched_barrier(0);
                if (t + 1 < 16) { a0 = na0; a1 = na1; w0 = nw0; w1 = nw1; b0 = nb0; b1 = nb1; k0 = nk0; k1 = nk1; r0 = nr0; r1 = nr1; va = nva; vb = nvb; }
            }
            if (ks == 0) {
#pragma unroll
                for (int t = 0; t < 16; ++t) { yb[t * 64 + rp] = yA[t]; yb[t * 64 + rp + 32] = yB[t]; } }
        }
        __syncthreads();
    }
    if (producer) RW_OUTPUT(127);
#undef RW_ISSUE
#undef RW_COMMIT
#undef RW_OUTPUT
}

#define XB_TMO      128
#define XB_XCNT(j)  (256  + 64 * (j))
#define XB_XSUB(j)  (1280 + 64 * (j))
#define XB_XGEN(j)  (2304 + 64 * (j))
#define XB_TOP      3328
#define XB_TOPGEN   3392
#define XCD_BAR_WORDS 3456
#define XB_SPIN_CAP (1u << 18)

__device__ __forceinline__ unsigned xb_ld(unsigned* p)              { return __hip_atomic_load(p, __ATOMIC_RELAXED, __HIP_MEMORY_SCOPE_AGENT); }
__device__ __forceinline__ unsigned xb_add(unsigned* p, unsigned v) { return __hip_atomic_fetch_add(p, v, __ATOMIC_RELAXED, __HIP_MEMORY_SCOPE_AGENT); }
__device__ __forceinline__ unsigned xb_xcc_id() { return (unsigned)__builtin_amdgcn_s_getreg((3 << 11) | 20) & 0xFu; }
#define XB_SPIN(cond, bar) do { unsigned _sp = 0; while (cond) { __builtin_amdgcn_s_sleep(1); \
    if ((++_sp & 255u) == 0u) { if (xb_ld(&(bar)[XB_TMO])) break; if (_sp > XB_SPIN_CAP) { atomicAdd(&(bar)[XB_TMO], 1u); break; } } } } while (0)

struct XcdBarrier {
    unsigned* bar; unsigned x;
    volatile LAS unsigned* st;
};

__device__ __forceinline__ XcdBarrier xcd_barrier_post(unsigned* bar, volatile LAS unsigned* st) {
    XcdBarrier b; b.bar = bar; b.x = xb_xcc_id(); b.st = st;
    if (threadIdx.x == 0) (void)xb_add(&bar[XB_XCNT(b.x)], 1u);
    return b;
}
__device__ __forceinline__ void xcd_barrier_complete(unsigned* bar, unsigned x, unsigned& nloc, unsigned& nx) {
    const unsigned G = gridDim.x * gridDim.y * gridDim.z;
    unsigned sum, cnt, mine, sp = 0u;
    for (;;) {
        sum = 0u; cnt = 0u; mine = 0u;
#pragma unroll
        for (unsigned j = 0; j < 16; ++j) { const unsigned c = xb_ld(&bar[XB_XCNT(j)]); sum += c; cnt += (c > 0u) ? 1u : 0u; mine = (j == x) ? c : mine; }
        if (sum == G) break;
        __builtin_amdgcn_s_sleep(1);
        if ((++sp & 255u) == 0u) { if (xb_ld(&bar[XB_TMO])) break; if (sp > XB_SPIN_CAP) { atomicAdd(&bar[XB_TMO], 1u); break; } }
    }
    nloc = mine > 0u ? mine : 1u; nx = cnt > 0u ? cnt : 1u;
}

__device__ __forceinline__ void xcd_barrier(const XcdBarrier& b) {
    asm volatile("s_waitcnt vmcnt(0)" ::: "memory");
    __syncthreads();
    if (threadIdx.x == 0) {
        unsigned* bar = b.bar;
        __builtin_amdgcn_s_waitcnt(0);
        unsigned nloc = b.st[0], nx = b.st[1];
        if (nloc == 0u) { xcd_barrier_complete(bar, b.x, nloc, nx); b.st[0] = nloc; b.st[1] = nx; }
        const unsigned old = xb_add(&bar[XB_XSUB(b.x)], 1u);
        const unsigned gen = old / nloc;
        if (old + 1u == (gen + 1u) * nloc) {
            __builtin_amdgcn_fence(__ATOMIC_RELEASE, "agent");
            asm volatile("s_waitcnt vmcnt(0)" ::: "memory");
            const unsigned og = xb_add(&bar[XB_TOP], 1u);
            const unsigned tg = og / nx;
            if (og + 1u == (tg + 1u) * nx) xb_add(&bar[XB_TOPGEN], 1u);
            else XB_SPIN(xb_ld(&bar[XB_TOPGEN]) == tg, bar);
            __builtin_amdgcn_fence(__ATOMIC_ACQUIRE, "agent");
            xb_add(&bar[XB_XGEN(b.x)], 1u);
            asm volatile("s_waitcnt vmcnt(0)" ::: "memory");
        } else {
            XB_SPIN(xb_ld(&bar[XB_XGEN(b.x)]) == gen, bar);
            __builtin_amdgcn_fence(__ATOMIC_ACQUIRE, "agent");
            asm volatile("s_waitcnt vmcnt(0)" ::: "memory");
        }
    }
    __syncthreads();
}


__global__ __launch_bounds__(512, 2) void mega(const Params p_arg) {
    extern __shared__ __attribute__((aligned(16))) unsigned char shm[];
    const Params& p = *(const Params*)(const void*)__builtin_amdgcn_kernarg_segment_ptr();
    LAS unsigned char* lds = (LAS unsigned char*)shm;
    const int G = (int)gridDim.x, bid = (int)blockIdx.x;
    __shared__ uint4 xb_words;
    if (threadIdx.x == 0) xb_words = make_uint4(0u, 0u, 0u, 0u);
    __syncthreads();
    (void)xcd_barrier_post((unsigned*)(p.ws + WS_BAR), (volatile LAS unsigned*)&xb_words);
    const int step_lo = p.step_lo, step_hi = p.step_hi;
    for (int s = step_lo; s < step_hi; ++s) {
        const int kind = p.kind[s], lo = p.lo[s], hi = p.hi[s];
        switch (kind) {
            case K_PRE0:
#ifndef NO_PRE
 convert_tiles(p, lo, hi, lds); rope_table(p); norm_rows(p.in[0], p.in[1], (bf16_t*)(p.ws + WS_H));
#endif
 break;
            case K_GEMMB:
#ifndef NO_GB

                for (int i = lo; i < hi; ++i) { const GemmOp& o = p.g[i]; pg8::Gemm g; g.A = o.A; g.Bt = o.Bt; g.M = o.M; g.N = o.N; g.K = o.K;
                    pg8::StaticOrder S; S.init(o.M, o.N, G, (bid + G - (o.rot % G)) % G);
                    EpiB E; E.O = (bf16_t*)o.out; E.ldc = o.ldc; E.bias = o.bias; E.act = o.act;
                    pg8::gemm_phase<EpiB, pg8::StaticOrder, false>(lds, g, S, E, nullptr); }
                if (p.chi[s] > p.clo[s]) convert_queue(p, p.clo[s], p.chi[s], (unsigned*)(p.ws + WS_BAR + 16384) + 64 * p.cq[s], lds);
#endif
                break;
            case K_GEMMF:
#ifndef NO_GF

                for (int i = lo; i < hi; ++i) { const GemmOp& o = p.g[i]; pg8::Gemm g; g.A = o.A; g.Bt = o.Bt; g.M = o.M; g.N = o.N; g.K = o.K;
                    pg8::StaticOrder S; S.init(o.M, o.N, G, (bid + G - (o.rot % G)) % G);
                    EpiF E; E.C = (float*)o.out; E.ldc = o.ldc; E.res = o.res;
                    pg8::gemm_phase<EpiF, pg8::StaticOrder, false>(lds, g, S, E, nullptr); }
#endif
                break;
            case K_CONVSSD:
#ifndef NO_CONV
 conv_ssd(p);
#endif
 break;
            case K_MIX0:

#ifndef NO_SSD
for (int j = bid; j < 256; j += G) ssd_chunk_job(p, j, lds);
#endif


#ifndef NO_ATT
for (int j = bid; j < 512; j += G) attn_job(p, j, lds);
#endif

                break;
            case K_POST0: post_ssd(p); break;
            case K_NORM: norm_rows(p.out, p.in[2] + lo * D, (bf16_t*)(p.ws + WS_H)); break;
            case K_PRE1: convert_tiles(p, lo, hi, lds); mix_rows(p.out, p.in[1] + D, p.in[16], (bf16_t*)(p.ws + WS_MIX), 0, lds); break;
            case K_MIXES: mix_rows(p.out, p.in[1] + D, p.in[16], (bf16_t*)(p.ws + WS_MIX), 8192, lds); break;
            case K_RWKV:
#ifndef NO_RWKV
 for (int j = bid; j < 256; j += G) rwkv_scan_job(p, j, lds);
#endif
 break;
            case K_NORMCONV: convert_tiles(p, lo, hi, lds); norm_rows(p.out, p.in[2] + D, (bf16_t*)(p.ws + WS_H)); break;
            default: break;
        }
        if (s + 1 < step_hi) { if (step_hi < 0) cg::this_grid().sync();   XcdBarrier xb; xb.bar = (unsigned*)(p.ws + WS_BAR); xb.x = xb_xcc_id(); xb.st = (volatile LAS unsigned*)&xb_words; xcd_barrier(xb); }
    }
}

#ifndef MK_MULTI
#define MK_MULTI 0
#endif
extern "C" void kernel_launch(void* const* d_in, const int* in_sizes, int n_in, void* d_out, int out_size, void* d_ws, size_t ws_size, hipStream_t stream) {
    static int grid = 0;
    if (grid == 0) {
        int dev = 0, cus = 0, per_cu = 0;
        hipGetDevice(&dev); hipDeviceGetAttribute(&cus, hipDeviceAttributeMultiprocessorCount, dev);
        if (hipFuncSetAttribute((const void*)mega, hipFuncAttributeMaxDynamicSharedMemorySize, LDS_BYTES) != hipSuccess) { fprintf(stderr, "hipFuncSetAttribute failed\n"); grid = -1; return; }
        if (hipOccupancyMaxActiveBlocksPerMultiprocessor(&per_cu, (const void*)mega, 512, LDS_BYTES) != hipSuccess || per_cu < 1) { fprintf(stderr, "occupancy query: %d\n", per_cu); per_cu = 1; }
        (void)hipGetLastError();
        grid = cus * per_cu; if (grid > 256) grid = 256;
        if (n_in != 34 || ws_size < 512 * MiB) { fprintf(stderr, "unexpected n_in %d / ws %zu\n", n_in, ws_size); grid = -1; return; }
    }
    if (grid < 0) return;
    static Params p;
    memset(&p, 0, sizeof(p));
    for (int i = 0; i < 34; ++i) p.in[i] = (const float*)d_in[i];
    p.out = (float*)d_out; p.ws = (unsigned char*)d_ws;
    unsigned char* ws = (unsigned char*)d_ws;
    auto B16 = [&](size_t off) { return (bf16_t*)(ws + off); };
    int ncj = 0, tile_acc = 0;
    auto CJ = [&](const float* src, size_t dst_off, int K, int N, int Kpad, int Npad) { ConvJob& c = p.cj[ncj++]; c.src = src; c.dst = B16(dst_off); c.K = K; c.N = N; c.Kpad = Kpad; c.Npad = Npad; c.tile0 = tile_acc; c.ntiles = (Kpad / 64) * (Npad / 256); tile_acc += c.ntiles; };
    const float* w_up = p.in[3]; const float* w_down = p.in[4];
    tile_acc = 0;
    CJ(p.in[5], WS_WBA, 2048, 4112, 2048, 4352); CJ(p.in[15], WS_WBA + 17 * MiB, 2048, 2048, 2048, 2048);
    tile_acc = 0;
    CJ(w_up, WS_WMLP, 2048, 8192, 2048, 8192); CJ(w_down, WS_WMLP + 32 * MiB, 8192, 2048, 8192, 2048);
    tile_acc = 0;
    CJ(p.in[28], WS_WBA, 2048, 2048, 2048, 2048); CJ(p.in[29], WS_WBA + 8 * MiB, 2048, 2048, 2048, 2048); CJ(p.in[30], WS_WBA + 16 * MiB, 2048, 2048, 2048, 2048); CJ(p.in[31], WS_WBA + 24 * MiB, 2048, 2048, 2048, 2048);
    CJ(p.in[18], WS_WBA + 32 * MiB, 2048, 96, 2048, 256); CJ(p.in[21], WS_WBA + 33 * MiB, 2048, 96, 2048, 256); CJ(p.in[23], WS_WBA + 34 * MiB, 2048, 256, 2048, 256);
    CJ(p.in[19], WS_WBA + 35 * MiB, 96, 2048, 256, 2048); CJ(p.in[22], WS_WBA + 36 * MiB, 96, 2048, 256, 2048); CJ(p.in[24], WS_WBA + 37 * MiB, 256, 2048, 256, 2048);
    tile_acc = 0;
    CJ(w_up + (size_t)2048 * 8192, WS_WMLP1, 2048, 8192, 2048, 8192); CJ(w_down + (size_t)2048 * 8192, WS_WMLP1 + 32 * MiB, 8192, 2048, 8192, 2048);
    int nop = 0;
    auto GO = [&](const bf16_t* A, const bf16_t* Bt, void* out, const float* bias, const float* res, int M, int N, int K, int ldc, int act, int rot) {
        GemmOp& o = p.g[nop++]; o.A = A; o.Bt = Bt; o.out = out; o.bias = bias; o.res = res; o.M = M; o.N = N; o.K = K; o.ldc = ldc; o.act = act; o.rot = rot; };
    GO(B16(WS_H), B16(WS_WBA), B16(WS_PROJ), nullptr, nullptr, MTOK, INWP, 2048, INWP, 0, 0);
    GO(B16(WS_YMIX), B16(WS_WBA + 17 * MiB), d_out, nullptr, p.in[0], MTOK, 2048, 2048, 2048, 0, 0);
    GO(B16(WS_H), B16(WS_WMLP), B16(WS_U), nullptr, nullptr, MTOK, DFF, 2048, DFF, 1, 0);
    GO(B16(WS_U), B16(WS_WMLP + 32 * MiB), d_out, nullptr, (const float*)d_out, MTOK, 2048, DFF, 2048, 0, 0);
    for (int half = 0; half < 2; ++half) {
        const size_t ro = (size_t)half * 8192 * 2048 * 2, lo_ = (size_t)half * 8192 * 256 * 2; const size_t mb = (size_t)8192 * 2048 * 2;
        GO(B16(WS_MIX + 0 * mb), B16(WS_WBA), B16(WS_R + ro), nullptr, nullptr, 8192, 2048, 2048, 2048, 0, 0);
        GO(B16(WS_MIX + 2 * mb), B16(WS_WBA + 8 * MiB), B16(WS_K + ro), nullptr, nullptr, 8192, 2048, 2048, 2048, 0, 0);
        GO(B16(WS_MIX + 3 * mb), B16(WS_WBA + 16 * MiB), B16(WS_V + ro), nullptr, nullptr, 8192, 2048, 2048, 2048, 0, 0);
        GO(B16(WS_MIX + 1 * mb), B16(WS_WBA + 32 * MiB), B16(WS_L1W + lo_), nullptr, nullptr, 8192, 256, 2048, 256, 2, 0);
        GO(B16(WS_MIX + 4 * mb), B16(WS_WBA + 33 * MiB), B16(WS_L1A + lo_), nullptr, nullptr, 8192, 256, 2048, 256, 0, 32);
        GO(B16(WS_MIX + 5 * mb), B16(WS_WBA + 34 * MiB), B16(WS_L1G + lo_), nullptr, nullptr, 8192, 256, 2048, 256, 3, 64);
    }
    GO(B16(WS_L1W), B16(WS_WBA + 35 * MiB), B16(WS_WDEC), p.in[17], nullptr, MTOK, 2048, 256, 2048, 4, 0);
    GO(B16(WS_L1A), B16(WS_WBA + 36 * MiB), B16(WS_AA), p.in[20], nullptr, MTOK, 2048, 256, 2048, 3, 0);
    GO(B16(WS_L1G), B16(WS_WBA + 37 * MiB), B16(WS_GG), nullptr, nullptr, MTOK, 2048, 256, 2048, 0, 0);
    GO(B16(WS_YG), B16(WS_WBA + 24 * MiB), d_out, nullptr, (const float*)d_out, MTOK, 2048, 2048, 2048, 0, 0);
    GO(B16(WS_H), B16(WS_WMLP1), B16(WS_U), nullptr, nullptr, MTOK, DFF, 2048, DFF, 1, 0);
    GO(B16(WS_U), B16(WS_WMLP1 + 32 * MiB), d_out, nullptr, (const float*)d_out, MTOK, 2048, DFF, 2048, 0, 0);
    int ns = 0;
    auto ST = [&](int kind, int lo, int hi, int clo = 0, int chi = 0, int cq = 0) { p.kind[ns] = kind; p.lo[ns] = lo; p.hi[ns] = hi; p.clo[ns] = clo; p.chi[ns] = chi; p.cq[ns] = cq; ++ns; };
    ST(K_PRE0, 0, 2); ST(K_GEMMB, 0, 1, 2, 4, 0); ST(K_CONVSSD, 0, 0); ST(K_MIX0, 0, 0); ST(K_POST0, 0, 0); ST(K_GEMMF, 1, 2); ST(K_NORM, 0, 0); ST(K_GEMMB, 2, 3); ST(K_GEMMF, 3, 4);
    ST(K_PRE1, 4, 14); ST(K_GEMMB, 4, 10, 14, 16, 1); ST(K_MIXES, 0, 0); ST(K_GEMMB, 10, 16, 14, 16, 1); ST(K_GEMMB, 16, 19); ST(K_RWKV, 0, 0); ST(K_GEMMF, 19, 20); ST(K_NORM, 1, 0); ST(K_GEMMB, 20, 21); ST(K_GEMMF, 21, 22);
    (void)hipMemsetAsync(ws + WS_BAR, 0, 16384 + 1024, stream);
#if MK_MULTI
    for (int s = 0; s < ns; ++s) { p.step_lo = s; p.step_hi = s + 1; hipLaunchKernelGGL(mega, dim3(grid), dim3(512), LDS_BYTES, stream, p); }
#else
    p.step_lo = 0; p.step_hi = ns;
    void* args[] = {(void*)&p};
    const hipError_t e = hipLaunchCooperativeKernel((const void*)mega, dim3(grid), dim3(512), args, LDS_BYTES, stream);
    if (e != hipSuccess) fprintf(stderr, "cooperative launch failed: %s (grid %d)\n", hipGetErrorString(e), grid);
#endif
}
```

```cpp
#include <hip/hip_runtime.h>
#include <hip/hip_cooperative_groups.h>
#include <cstdio>
#include <cstring>
namespace cg = cooperative_groups;
__device__ __forceinline__ int opq(int v) { asm volatile("" : "+v"(v)); return v; }
namespace pg8 {
#define PG8_LAS __attribute__((address_space(3)))
typedef unsigned short bf16_t;
typedef short bf16x8 __attribute__((ext_vector_type(8)));
typedef float f32x4 __attribute__((ext_vector_type(4)));
typedef unsigned u32x4 __attribute__((ext_vector_type(4)));
constexpr int BM = 256, BK = 64, HALF = 128, HTB = HALF * BK * 2  , STAGE_BYTES = 8 * HTB, NXCD = 8, WGM = 8;

__host__ __device__ __forceinline__ int lds_byte(int r, int c) { const int st = (r >> 4) * 2 + (c >> 5), rr = r & 15, cc = c & 31, ob = rr * 64 + cc * 2; return st * 1024 + (ob ^ (((ob >> 9) & 1) << 5)); }
__host__ __device__ __forceinline__ void stage_rc(int b, int& R, int& C) { const int st = b / 1024, sb = b % 1024, swz = sb ^ (((sb >> 9) & 1) << 5); R = (st >> 1) * 16 + swz / 64; C = (st & 1) * 32 + (swz % 64) / 2; }
__host__ __device__ __forceinline__ int perm32(int rho) { const int n = rho >> 4, i = rho & 15; return 8 * (i >> 2) + 4 * n + (i & 3); }

struct Unit { int pm, pn; };
struct Gemm { const bf16_t* A; const bf16_t* Bt; int M, N, K; };

struct StaticOrder {
    int nM, nN, nwg, G, c;
    __host__ __device__ void init(int M, int N, int G_, int c_) { nM = M / BM; nN = N / BM; nwg = nM * nN; G = G_; c = c_; }
    __host__ __device__ bool next(int i, Unit& u) const {
        const long L = (long)i * G + c; if (L >= nwg) return false;
        int wgid = (int)L; { const int q = nwg / NXCD, r = nwg % NXCD, xcd = wgid % NXCD, off = wgid / NXCD; wgid = (xcd < r ? xcd * (q + 1) : r * (q + 1) + (xcd - r) * q) + off; }
        const int nig = WGM * nN, gid = wgid / nig, fm = gid * WGM, gsz = (nM - fm) < WGM ? (nM - fm) : WGM;
        u.pm = fm + ((wgid % nig) % gsz); u.pn = (wgid % nig) / gsz; return true;
    }
    __device__ __forceinline__ void a_ready(const Unit&) const {}
    __device__ __forceinline__ void done(const Unit&) const {}
};
typedef __bf16 bf16x2_t __attribute__((ext_vector_type(2)));
typedef float f32x2_t __attribute__((ext_vector_type(2)));
__device__ __forceinline__ unsigned cvt_pk_bf16(float lo, float hi) { const f32x2_t f = {lo, hi}; const bf16x2_t v = __builtin_convertvector(f, bf16x2_t); return __builtin_bit_cast(unsigned, v); }
__device__ __forceinline__ unsigned cvt_pk_nv(float lo, float hi) { return cvt_pk_bf16(lo, hi); }

template <class Epi, class Sched, bool STAMP = false>
__device__ __forceinline__ void gemm_phase(PG8_LAS unsigned char* lds, const Gemm g, const Sched& S, const Epi& E, unsigned long long* stamps) {
    const int tid = opq(threadIdx.x), wid = __builtin_amdgcn_readfirstlane(tid >> 6), lane = tid & 63, wr = wid >> 2, wc = wid & 3, fr = lane & 15, fq = lane >> 4;
    const int K = g.K, nt = K / BK;
    int ts_lo = 0, ts_hi = 0, nts = 0; const unsigned long long rt_entry = STAMP ? (unsigned long long)wall_clock64() : 0ull;
#define PG8_STAMP() do { if (STAMP && wid == 0 && nts < 64) { const unsigned long long _c = (unsigned long long)clock64(); \
        ts_lo = (lane == nts) ? (int)(unsigned)_c : ts_lo; ts_hi = (lane == nts) ? (int)(unsigned)(_c >> 32) : ts_hi; ++nts; } } while (0)
    PG8_STAMP();
    unsigned voffA[2], voffB[2];
#pragma unroll
    for (int i = 0; i < 2; ++i) { int R, C; stage_rc(tid * 16 + i * 8192, R, C); const int Rb = Epi::PERM ? ((R & ~31) + perm32(R & 31)) : R;
        voffA[i] = (unsigned)(R * K + C) * 2u; voffB[i] = (unsigned)(Rb * K + C) * 2u; }
    const size_t kstep = (size_t)(BK * 2);
    const size_t hstep = (size_t)HALF * K * 2;
    const size_t tstep = 2 * hstep;
    const unsigned ldsw = (unsigned)wid * 1024u;
    const int aoff = lds_byte(wr * 64 + fr, fq * 8), boff = lds_byte(wc * 32 + fr, fq * 8);
#define PG8_SA(b, h) (((b) * 2 + (h)) * HTB)
#define PG8_SB(b, h) ((4 + (b) * 2 + (h)) * HTB)
#define PG8_STAGE(bufoff, gbase, voff) do { _Pragma("unroll") for (int _i = 0; _i < 2; ++_i) \
        __builtin_amdgcn_global_load_lds((const unsigned*)((const char*)(gbase) + (voff)[_i]), (PG8_LAS unsigned*)(lds + (bufoff) + ldsw + _i * 8192), 16, 0, 0); } while (0)
#define PG8_LDA(dst, b, h) do { _Pragma("unroll") for (int m = 0; m < 4; ++m) _Pragma("unroll") for (int k = 0; k < 2; ++k) dst[m][k] = *(const PG8_LAS bf16x8*)(lds + PG8_SA(b, h) + aoff + m * 2048 + k * 1024); } while (0)
#define PG8_LDB(dst, b, h) do { _Pragma("unroll") for (int n = 0; n < 2; ++n) _Pragma("unroll") for (int k = 0; k < 2; ++k) dst[n][k] = *(const PG8_LAS bf16x8*)(lds + PG8_SB(b, h) + boff + n * 2048 + k * 1024); } while (0)
#define PG8_MMA(ai, bj, At, Bt) do { __builtin_amdgcn_s_setprio(1); _Pragma("unroll") for (int m = 0; m < 4; ++m) _Pragma("unroll") for (int n = 0; n < 2; ++n) _Pragma("unroll") for (int k = 0; k < 2; ++k) \
        acc[ai][bj][m][n] = __builtin_amdgcn_mfma_f32_16x16x32_bf16(Bt[n][k], At[m][k], acc[ai][bj][m][n], 0, 0, 0); __builtin_amdgcn_s_setprio(0); } while (0)
#define PG8_WAIT_V(n) asm volatile("s_waitcnt vmcnt(" #n ")" ::: "memory")
#define PG8_WAIT_L(n) asm volatile("s_waitcnt lgkmcnt(" #n ")" ::: "memory")
#define PG8_BAR __builtin_amdgcn_s_barrier()
#define PG8_SCHED __builtin_amdgcn_sched_barrier(0)
    Unit cur, nxt; int ui = 0;
    if (!S.next(0, cur)) return;
    f32x4 acc[2][2][4][2];
#pragma unroll
    for (int a = 0; a < 2; ++a)
#pragma unroll
        for (int b = 0; b < 2; ++b)
#pragma unroll
            for (int m = 0; m < 4; ++m)
#pragma unroll
                for (int n = 0; n < 2; ++n) acc[a][b][m][n] = (f32x4){0.f, 0.f, 0.f, 0.f};
    bf16x8 At[4][2], B0[2][2], B1[2][2];
    const char* cA = (const char*)g.A + (size_t)cur.pm * tstep; const char* cB = (const char*)g.Bt + (size_t)cur.pn * tstep;
    S.a_ready(cur);
    PG8_STAGE(PG8_SB(0, 0), cB, voffB); PG8_STAGE(PG8_SA(0, 0), cA, voffA); PG8_STAGE(PG8_SB(0, 1), cB + hstep, voffB); PG8_STAGE(PG8_SA(0, 1), cA + hstep, voffA);
    if (wr == 1) PG8_BAR;
    PG8_WAIT_V(4); PG8_BAR;
    PG8_STAGE(PG8_SB(1, 0), cB + kstep, voffB); PG8_STAGE(PG8_SA(1, 0), cA + kstep, voffA); PG8_STAGE(PG8_SB(1, 1), cB + hstep + kstep, voffB);
    PG8_WAIT_V(6); PG8_BAR;
    PG8_STAMP();
    for (;;) {
        const bool has_next = S.next(ui + 1, nxt);
        const char* nA = has_next ? (const char*)g.A + (size_t)nxt.pm * tstep : cA; const char* nB = has_next ? (const char*)g.Bt + (size_t)nxt.pn * tstep : cB;
        for (int t = 0; t < nt; t += 2) {
            const bool last = (t == nt - 2);
            const char* a1 = cA + (size_t)(t + 1) * kstep;
            const char* a2 = last ? nA : cA + (size_t)(t + 2) * kstep; const char* b2 = last ? nB : cB + (size_t)(t + 2) * kstep;
            const char* a3 = a2 + kstep; const char* b3 = b2 + kstep;
            if (last && has_next) S.a_ready(nxt);
            PG8_LDB(B0, 0, 0); PG8_SCHED; PG8_LDA(At, 0, 0); PG8_STAGE(PG8_SA(1, 1), a1 + hstep, voffA);
            PG8_WAIT_L(8); PG8_BAR; PG8_WAIT_L(0); PG8_MMA(0, 0, At, B0); PG8_BAR; PG8_SCHED;
            PG8_LDB(B1, 0, 1); PG8_STAGE(PG8_SB(0, 0), b2, voffB);
            PG8_BAR; PG8_WAIT_L(0); PG8_MMA(0, 1, At, B1); PG8_BAR;
            PG8_LDA(At, 0, 1); PG8_STAGE(PG8_SA(0, 0), a2, voffA);
            PG8_BAR; PG8_WAIT_L(0); PG8_MMA(1, 0, At, B0); PG8_BAR; PG8_SCHED;
            PG8_STAGE(PG8_SB(0, 1), b2 + hstep, voffB);
            PG8_WAIT_V(6); PG8_BAR; PG8_MMA(1, 1, At, B1); PG8_BAR;
            PG8_LDB(B0, 1, 0); PG8_SCHED; PG8_LDA(At, 1, 0); PG8_STAGE(PG8_SA(0, 1), a2 + hstep, voffA);
            PG8_WAIT_L(8); PG8_BAR; PG8_WAIT_L(0); PG8_MMA(0, 0, At, B0); PG8_BAR; PG8_SCHED;
            PG8_LDB(B1, 1, 1); PG8_STAGE(PG8_SB(1, 0), b3, voffB);
            PG8_BAR; PG8_WAIT_L(0); PG8_MMA(0, 1, At, B1); PG8_BAR;
            PG8_LDA(At, 1, 1); PG8_STAGE(PG8_SA(1, 0), a3, voffA);
            PG8_BAR; PG8_WAIT_L(0); PG8_MMA(1, 0, At, B0); PG8_BAR; PG8_SCHED;
            PG8_STAGE(PG8_SB(1, 1), b3 + hstep, voffB);
            PG8_WAIT_V(6); PG8_BAR; PG8_MMA(1, 1, At, B1); PG8_BAR;
        }
        PG8_STAMP();
        if constexpr (!Epi::AFTER_DRAIN) { E(acc, cur, wr, wc, fr, fq); S.done(cur); }
        PG8_STAMP();
        if (!has_next) break;
#pragma unroll
        for (int a = 0; a < 2; ++a)
#pragma unroll
            for (int b = 0; b < 2; ++b)
#pragma unroll
                for (int m = 0; m < 4; ++m)
#pragma unroll
                    for (int n = 0; n < 2; ++n) acc[a][b][m][n] = (f32x4){0.f, 0.f, 0.f, 0.f};
        cur = nxt; cA = nA; cB = nB; ++ui;
    }
    PG8_WAIT_V(0);
    if (wr == 0) PG8_BAR;
    PG8_BAR;
    if constexpr (Epi::AFTER_DRAIN) { E.fused(acc, cur, wr, wc, fr, fq, lds, wid, lane); S.done(cur); }
    PG8_STAMP();
    if (STAMP && wid == 0) { stamps[lane] = lane < nts ? (((unsigned long long)(unsigned)ts_hi << 32) | (unsigned)ts_lo) : 0ull;
        if (lane == 62) stamps[62] = rt_entry; if (lane == 63) stamps[63] = (unsigned long long)wall_clock64(); }
#undef PG8_STAMP
#undef PG8_SA
#undef PG8_SB
#undef PG8_STAGE
#undef PG8_LDA
#undef PG8_LDB
#undef PG8_MMA
#undef PG8_WAIT_V
#undef PG8_WAIT_L
#undef PG8_BAR
#undef PG8_SCHED
}
}

#include <cstdio>
#include <ctime>
#include <cstdlib>
#include <cstring>
#include <cmath>
#include <vector>
#include <algorithm>
#define CK(x) do { hipError_t e_ = (x); if (e_ != hipSuccess) { fprintf(stderr, "HIP %s:%d %s\n", __FILE__, __LINE__, hipGetErrorString(e_)); exit(2); } } while (0)
using pg8::bf16_t; using pg8::bf16x8; using pg8::f32x4; using pg8::u32x4; using pg8::cvt_pk_bf16; using pg8::cvt_pk_nv;
#define LAS PG8_LAS

constexpr int D = 2048, SEQ = 2048, MTOK = 16384, DFF = 8192, INWP = 4352;
constexpr int COL_K = 1024, COL_V = 1280, COL_Z = 1536, COL_XBC = 2560, COL_DT = 4096;
constexpr size_t MiB = (size_t)1 << 20;
constexpr size_t WS_WBA = 0, WS_WMLP = 40 * MiB, WS_H = 104 * MiB, WS_PROJ = 168 * MiB, WS_YMIX = 304 * MiB, WS_YRAW = 368 * MiB, WS_XBC = 432 * MiB,
                 WS_DT = 480 * MiB, WS_DA = 481 * MiB, WS_ROPE = 482 * MiB, WS_U = 168 * MiB;
constexpr size_t WS_R = 40 * MiB, WS_K = 104 * MiB, WS_V = 168 * MiB, WS_L1W = 232 * MiB, WS_L1A = 240 * MiB, WS_L1G = 248 * MiB, WS_MIX = 256 * MiB,
                 WS_WDEC = 256 * MiB, WS_AA = 320 * MiB, WS_GG = 384 * MiB, WS_YG = 40 * MiB  , WS_WMLP1 = 448 * MiB;
constexpr size_t WS_BAR = 39 * MiB;
constexpr int LDS_BYTES = 140 * 1024;

enum { K_PRE0 = 0, K_GEMMB, K_GEMMF, K_CONVSSD, K_MIX0, K_POST0, K_NORM, K_PRE1, K_MIXES, K_RWKV, K_NORMCONV };
constexpr int NSTEPS = 48, NOPS = 22, NCJ = 16;
#define REP_GEMMB 1
#define REP_MIX0 1
#define REP_RWKV 1
#define REP_ELEM 1

struct GemmOp { const bf16_t* A; const bf16_t* Bt; void* out; const float* bias; const float* res; int M, N, K, ldc, act, rot, pad0, pad1; };
struct ConvJob { const float* src; bf16_t* dst; int K, N, Kpad, Npad, tile0, ntiles; };
struct Params {
    const float* in[34];
    float* out; unsigned char* ws;
    GemmOp g[NOPS];
    ConvJob cj[NCJ];
    int kind[NSTEPS + 1]; int lo[NSTEPS + 1]; int hi[NSTEPS + 1]; int clo[NSTEPS + 1]; int chi[NSTEPS + 1]; int cq[NSTEPS + 1];
    int step_lo, step_hi;
};

__device__ __forceinline__ float bf2f(unsigned short b) { return __uint_as_float(((unsigned)b) << 16); }
__device__ __forceinline__ float bflo(unsigned w) { return __uint_as_float(w << 16); }
__device__ __forceinline__ float bfhi(unsigned w) { return __uint_as_float(w & 0xffff0000u); }
__device__ __forceinline__ bf16_t f2bf(float f) { return (bf16_t)(cvt_pk_bf16(f, 0.f) & 0xffffu); }
template <int CTRL> __device__ __forceinline__ float dpp_add(float x) {
    const int y = __builtin_amdgcn_update_dpp(0, __builtin_bit_cast(int, x), CTRL, 0xf, 0xf, true);
    return x + __builtin_bit_cast(float, y); }
__device__ __forceinline__ float red8(float x) { x = dpp_add<0xB1>(x); x = dpp_add<0x4E>(x); x = dpp_add<0x141>(x); return x; }
__device__ __forceinline__ float red16(float x) { x = red8(x); x = dpp_add<0x140>(x); return x; }
__device__ __forceinline__ float wave_sum(float v) {
    v = red16(v);
    const float r0 = __builtin_bit_cast(float, __builtin_amdgcn_readlane(__builtin_bit_cast(int, v), 0)), r1 = __builtin_bit_cast(float, __builtin_amdgcn_readlane(__builtin_bit_cast(int, v), 16));
    const float r2 = __builtin_bit_cast(float, __builtin_amdgcn_readlane(__builtin_bit_cast(int, v), 32)), r3 = __builtin_bit_cast(float, __builtin_amdgcn_readlane(__builtin_bit_cast(int, v), 48));
    return (r0 + r1) + (r2 + r3); }
typedef float f32x2 __attribute__((ext_vector_type(2)));
typedef unsigned u32x2 __attribute__((ext_vector_type(2)));
__device__ __forceinline__ float sigmoidf_(float v) { return 1.0f / (1.0f + __expf(-v)); }
__device__ __forceinline__ void unpack8(const uint4 r, float (&f)[8]) {
    f[0] = bflo(r.x); f[1] = bfhi(r.x); f[2] = bflo(r.y); f[3] = bfhi(r.y); f[4] = bflo(r.z); f[5] = bfhi(r.z); f[6] = bflo(r.w); f[7] = bfhi(r.w); }

__device__ __forceinline__ float act_apply(float v, int act) {
    switch (act) {
        case 1: { const float r = fmaxf(v, 0.f); return r * r; }
        case 2: return 1.0f - 2.0f / (1.0f + __expf(2.0f * v));
        case 3: return sigmoidf_(v);
        case 4: return 0.60653066f * sigmoidf_(v);
        default: return v; }
}
struct EpiB {
    static constexpr bool PERM = true, AFTER_DRAIN = false;
    bf16_t* O; int ldc; const float* bias; int act;
    __device__ __forceinline__ void operator()(const f32x4 (&acc)[2][2][4][2], const pg8::Unit& u, int wr, int wc, int fr, int fq) const {
        const int row0 = u.pm * 256 + wr * 64 + fr, col0 = u.pn * 256 + wc * 32 + 8 * fq;
#pragma unroll
        for (int ai = 0; ai < 2; ++ai)
#pragma unroll
            for (int m = 0; m < 4; ++m) { bf16_t* rowp = O + (size_t)(row0 + ai * 128 + m * 16) * ldc + col0;
#pragma unroll
                for (int bj = 0; bj < 2; ++bj) { f32x4 v0 = acc[ai][bj][m][0], v1 = acc[ai][bj][m][1];
                    if (bias) { v0 += *(const f32x4*)(bias + col0 + bj * 128); v1 += *(const f32x4*)(bias + col0 + bj * 128 + 4); }
                    if (act) {
#pragma unroll
                        for (int j = 0; j < 4; ++j) { v0[j] = act_apply(v0[j], act); v1[j] = act_apply(v1[j], act); } }
                    u32x4 w; w.x = cvt_pk_bf16(v0[0], v0[1]); w.y = cvt_pk_bf16(v0[2], v0[3]); w.z = cvt_pk_bf16(v1[0], v1[1]); w.w = cvt_pk_bf16(v1[2], v1[3]);
                    *(u32x4*)(rowp + bj * 128) = w; } }
    }
};
struct EpiF {
    static constexpr bool PERM = false, AFTER_DRAIN = false;
    float* C; int ldc; const float* res;
    __device__ __forceinline__ void operator()(const f32x4 (&acc)[2][2][4][2], const pg8::Unit& u, int wr, int wc, int fr, int fq) const {
        const int row0 = u.pm * 256 + wr * 64 + fr, col0 = u.pn * 256 + wc * 32 + 4 * fq;
#pragma unroll
        for (int ai = 0; ai < 2; ++ai)
#pragma unroll
            for (int m = 0; m < 4; ++m) { const size_t ro = (size_t)(row0 + ai * 128 + m * 16) * ldc + col0;
#pragma unroll
                for (int bj = 0; bj < 2; ++bj)
#pragma unroll
                    for (int n = 0; n < 2; ++n) { const f32x4 r = *(const f32x4*)(res + ro + bj * 128 + n * 16); *(f32x4*)(C + ro + bj * 128 + n * 16) = acc[ai][bj][m][n] + r; } }
    }
};

__device__ __forceinline__ void convert_one_tile(const Params& p, int jlo, int jhi, int tile, int tid, LAS float* T) {
    int j = jlo; while (j + 1 < jhi && tile >= p.cj[j + 1].tile0) ++j;
    const float* src = p.cj[j].src; bf16_t* dst = p.cj[j].dst; const int K = p.cj[j].K, N = p.cj[j].N, Kpad = p.cj[j].Kpad;
    const int local = tile - p.cj[j].tile0, nkt = Kpad >> 6, kt = local % nkt, nt = local / nkt;
    f32x4 v[8];
#pragma unroll
    for (int i = 0; i < 8; ++i) { const int idx = tid + i * 512, kr = idx >> 6, c4 = idx & 63, k = kt * 64 + kr, n = nt * 256 + c4 * 4;
        v[i] = (f32x4){0.f, 0.f, 0.f, 0.f};
        if (k < K && n < N) v[i] = *(const f32x4*)(src + (size_t)k * N + n); }
#pragma unroll
    for (int i = 0; i < 8; ++i) { const int idx = tid + i * 512, kr = idx >> 6, c4 = idx & 63;
        T[kr * 257 + c4 * 4 + 0] = v[i][0]; T[kr * 257 + c4 * 4 + 1] = v[i][1]; T[kr * 257 + c4 * 4 + 2] = v[i][2]; T[kr * 257 + c4 * 4 + 3] = v[i][3]; }
    __syncthreads();
#pragma unroll
    for (int i = 0; i < 4; ++i) { const int idx = tid + i * 512, nl = idx >> 3, kc = idx & 7; float f[8];
#pragma unroll
        for (int e = 0; e < 8; ++e) f[e] = T[(kc * 8 + e) * 257 + nl];
        u32x4 w; w.x = cvt_pk_nv(f[0], f[1]); w.y = cvt_pk_nv(f[2], f[3]); w.z = cvt_pk_nv(f[4], f[5]); w.w = cvt_pk_nv(f[6], f[7]);
        *(u32x4*)(dst + (size_t)(nt * 256 + nl) * Kpad + kt * 64 + kc * 8) = w; }
    __syncthreads();
}
__device__ __forceinline__ void convert_tiles(const Params& p, int jlo, int jhi, LAS unsigned char* lds) {
    const int tid = opq(threadIdx.x); LAS float* T = (LAS float*)lds;
    const int total = p.cj[jhi - 1].tile0 + p.cj[jhi - 1].ntiles;
    for (int tile = blockIdx.x; tile < total; tile += gridDim.x) convert_one_tile(p, jlo, jhi, tile, tid, T);
}
__device__ __forceinline__ void convert_queue(const Params& p, int jlo, int jhi, unsigned* counter, LAS unsigned char* lds) {
    const int tid = opq(threadIdx.x); LAS float* T = (LAS float*)lds; LAS int* slot = (LAS int*)(lds + 72 * 1024);
    const int total = p.cj[jhi - 1].tile0 + p.cj[jhi - 1].ntiles;
    for (;;) {
        __syncthreads();
        if (tid == 0) *slot = (int)__hip_atomic_fetch_add(counter, 1u, __ATOMIC_RELAXED, __HIP_MEMORY_SCOPE_AGENT);
        __syncthreads();
        const int tile = *slot;
        if (tile >= total) break;
        convert_one_tile(p, jlo, jhi, tile, tid, T);
    }
}

__device__ __forceinline__ void rope_table(const Params& p) {
    float2* tab = (float2*)(p.ws + WS_ROPE);
    for (int idx = blockIdx.x * 512 + opq(threadIdx.x); idx < SEQ * 32; idx += gridDim.x * 512) {
        const int t = idx >> 5, i = idx & 31;
        const float inv = exp2f(-(float)i * 0.41524101186092029f);
        const float angf = (float)t * inv;
        const double ang = (double)angf;
        const double q = rint(ang * 0.6366197723675814);
        const float f = (float)fma(-q, 1.5707963267948966, ang), f2 = f * f;
        const float s = f * (1.0f + f2 * (-1.6666667e-1f + f2 * (8.3333333e-3f + f2 * (-1.9841270e-4f + f2 * 2.7557319e-6f))));
        const float c = 1.0f + f2 * (-0.5f + f2 * (4.1666667e-2f + f2 * (-1.3888889e-3f + f2 * (2.4801587e-5f + f2 * (-2.7557319e-7f)))));
        const int qi = ((int)q) & 3;
        const float sn = (qi == 0) ? s : (qi == 1) ? c : (qi == 2) ? -s : -c;
        const float cs = (qi == 0) ? c : (qi == 1) ? -s : (qi == 2) ? -c : s;
        tab[idx] = make_float2(cs, sn);
    }
}

__device__ __forceinline__ void norm_rows(const float* x, const float* g, bf16_t* h) {
    const int tid_ = opq(threadIdx.x); const int lane = tid_ & 63, wv = tid_ >> 6;
    f32x4 gg[8];
#pragma unroll
    for (int i = 0; i < 8; ++i) gg[i] = *(const f32x4*)(g + i * 256 + lane * 4);
    for (int row = (blockIdx.x * 8 + wv) * 2; row < MTOK; row += gridDim.x * 16) {
        const float* xr = x + (size_t)row * D; f32x4 v[8], u[8]; float ss = 0.f, st = 0.f;
#pragma unroll
        for (int i = 0; i < 8; ++i) { v[i] = *(const f32x4*)(xr + i * 256 + lane * 4); u[i] = *(const f32x4*)(xr + D + i * 256 + lane * 4); }
#pragma unroll
        for (int i = 0; i < 8; ++i) { ss += v[i][0] * v[i][0] + v[i][1] * v[i][1] + v[i][2] * v[i][2] + v[i][3] * v[i][3]; st += u[i][0] * u[i][0] + u[i][1] * u[i][1] + u[i][2] * u[i][2] + u[i][3] * u[i][3]; }
        ss = wave_sum(ss); st = wave_sum(st); const float r = rsqrtf(ss * (1.0f / D) + 1e-6f), r2 = rsqrtf(st * (1.0f / D) + 1e-6f);
#pragma unroll
        for (int i = 0; i < 8; ++i) {
            uint2 w; w.x = cvt_pk_nv(v[i][0] * r * gg[i][0], v[i][1] * r * gg[i][1]); w.y = cvt_pk_nv(v[i][2] * r * gg[i][2], v[i][3] * r * gg[i][3]);
            *(uint2*)(h + (size_t)row * D + i * 256 + lane * 4) = w;
            uint2 w2; w2.x = cvt_pk_nv(u[i][0] * r2 * gg[i][0], u[i][1] * r2 * gg[i][1]); w2.y = cvt_pk_nv(u[i][2] * r2 * gg[i][2], u[i][3] * r2 * gg[i][3]);
            *(uint2*)(h + (size_t)(row + 1) * D + i * 256 + lane * 4) = w2; }
    }
}

__device__ __forceinline__ void mix_rows(const float* x, const float* g, const float* mixw, bf16_t* mixbase, int tok0, LAS unsigned char* lds) {
    const int tid = opq(threadIdx.x), lane = tid & 63, wv = tid >> 6, c = tid * 4;
    LAS float* rs = (LAS float*)lds;
    const f32x4 gg = *(const f32x4*)(g + c); f32x4 mw[6];
#pragma unroll
    for (int m = 0; m < 6; ++m) mw[m] = *(const f32x4*)(mixw + m * D + c);
    for (int chunk = blockIdx.x; chunk < 256; chunk += gridDim.x) {
        const int rl0 = chunk * 32, tokc = tok0 + rl0; const bool hasprev = (tokc & (SEQ - 1)) != 0;
        __syncthreads();
        for (int r = wv; r < 33; r += 8) {
            float ss = 0.f;
            if (r > 0 || hasprev) { const float* xr = x + (size_t)(tokc - 1 + r) * D; f32x4 v[8];
#pragma unroll
                for (int i = 0; i < 8; ++i) v[i] = *(const f32x4*)(xr + i * 256 + lane * 4);
#pragma unroll
                for (int i = 0; i < 8; ++i) ss += v[i][0] * v[i][0] + v[i][1] * v[i][1] + v[i][2] * v[i][2] + v[i][3] * v[i][3]; }
            ss = wave_sum(ss);
            if (lane == 0) rs[r] = (r > 0 || hasprev) ? rsqrtf(ss * (1.0f / D) + 1e-6f) : 0.f;
        }
        __syncthreads();
        f32x4 prev = (f32x4){0.f, 0.f, 0.f, 0.f};
        if (hasprev) { const f32x4 pv = *(const f32x4*)(x + (size_t)(tokc - 1) * D + c); const float rp = rs[0]; prev = pv * rp * gg; }
        for (int r0 = 0; r0 < 32; r0 += 4) {
            f32x4 xv[4];
#pragma unroll
            for (int u = 0; u < 4; ++u) xv[u] = *(const f32x4*)(x + (size_t)(tokc + r0 + u) * D + c);
#pragma unroll
            for (int u = 0; u < 4; ++u) { const float rr = rs[r0 + u + 1]; const f32x4 hn = xv[u] * rr * gg, xx = prev - hn;
#pragma unroll
                for (int m = 0; m < 6; ++m) { const f32x4 o = hn + xx * mw[m];
                    uint2 w; w.x = cvt_pk_nv(o[0], o[1]); w.y = cvt_pk_nv(o[2], o[3]);
                    *(uint2*)(mixbase + (size_t)m * 8192 * D + (size_t)(rl0 + r0 + u) * D + c) = w; }
                prev = hn; }
        }
    }
}

__device__ __forceinline__ void conv_ssd(const Params& p) {
    const bf16_t* proj = (const bf16_t*)(p.ws + WS_PROJ); bf16_t* xbc = (bf16_t*)(p.ws + WS_XBC);
    const float* cw = p.in[6]; const float* cb = p.in[7];
    const int tid = opq(threadIdx.x);
    if (tid < 384) {
        const int c8 = tid % 192, par = tid / 192, c = c8 * 8;
        float w[4][8], bb[8];
#pragma unroll
        for (int j = 0; j < 4; ++j) { const f32x4 w0 = *(const f32x4*)(cw + j * 1536 + c), w1 = *(const f32x4*)(cw + j * 1536 + c + 4);
#pragma unroll
            for (int e = 0; e < 4; ++e) { w[j][e] = w0[e]; w[j][4 + e] = w1[e]; } }
        { const f32x4 b0 = *(const f32x4*)(cb + c), b1 = *(const f32x4*)(cb + c + 4);
#pragma unroll
          for (int e = 0; e < 4; ++e) { bb[e] = b0[e]; bb[4 + e] = b1[e]; } }
        for (int chunk = blockIdx.x; chunk < 256; chunk += gridDim.x) {
            const int t0 = chunk * 64 + par * 32; const bool hasprev = (t0 & (SEQ - 1)) != 0;
            float r0[8], r1[8], r2[8];
            if (hasprev) { const uint4 a = *(const uint4*)(proj + (size_t)(t0 - 3) * INWP + COL_XBC + c), b = *(const uint4*)(proj + (size_t)(t0 - 2) * INWP + COL_XBC + c), d = *(const uint4*)(proj + (size_t)(t0 - 1) * INWP + COL_XBC + c);
                unpack8(a, r0); unpack8(b, r1); unpack8(d, r2); }
            else {
#pragma unroll
                for (int e = 0; e < 8; ++e) { r0[e] = 0.f; r1[e] = 0.f; r2[e] = 0.f; } }
            for (int tg = 0; tg < 32; tg += 4) {
                uint4 rw[4];
#pragma unroll
                for (int u = 0; u < 4; ++u) rw[u] = *(const uint4*)(proj + (size_t)(t0 + tg + u) * INWP + COL_XBC + c);
#pragma unroll
                for (int u = 0; u < 4; ++u) { float cur[8], acc[8]; unpack8(rw[u], cur);
#pragma unroll
                    for (int e = 0; e < 8; ++e) { acc[e] = bb[e] + w[0][e] * r0[e] + w[1][e] * r1[e] + w[2][e] * r2[e] + w[3][e] * cur[e]; acc[e] = acc[e] * sigmoidf_(acc[e]); r0[e] = r1[e]; r1[e] = r2[e]; r2[e] = cur[e]; }
                    u32x4 o; o.x = cvt_pk_nv(acc[0], acc[1]); o.y = cvt_pk_nv(acc[2], acc[3]); o.z = cvt_pk_nv(acc[4], acc[5]); o.w = cvt_pk_nv(acc[6], acc[7]);
                    *(u32x4*)(xbc + (size_t)(t0 + tg + u) * 1536 + c) = o; }
            }
        }
    }
    float* dt = (float*)(p.ws + WS_DT); float* da = (float*)(p.ws + WS_DA);
    for (int idx = blockIdx.x * 512 + opq(threadIdx.x); idx < MTOK * 16; idx += gridDim.x * 512) {
        const int tok = idx >> 4, hh = idx & 15;
        const float v = bf2f(proj[(size_t)tok * INWP + COL_DT + hh]) + p.in[8][hh];
        const float d = fmaxf(v, 0.f) + __logf(1.0f + __expf(-fabsf(v)));
        dt[idx] = d; da[idx] = __expf(-d * __expf(p.in[9][hh]));
    }
}

__device__ __forceinline__ void ssd_scan_job(const Params& p, int job, LAS unsigned char* lds) {
    const int tid = opq(threadIdx.x);
    const int b = job >> 5, hs = (job >> 1) & 15, half = job & 1, grp = hs >> 3, p0 = half * 32;
    const bf16_t* xbc = (const bf16_t*)(p.ws + WS_XBC) + (size_t)b * SEQ * 1536;
    const float* dtp = (const float*)(p.ws + WS_DT) + (size_t)b * SEQ * 16 + hs;
    const float* dap = (const float*)(p.ws + WS_DA) + (size_t)b * SEQ * 16 + hs;
    float* yraw = (float*)(p.ws + WS_YRAW) + (size_t)b * SEQ * 1024 + hs * 64 + p0;
    const float dskip = p.in[10][hs];
    constexpr int BUF_F = 9280;
    LAS float* L = (LAS float*)lds;
    const bool producer = tid >= 256; const int ptid = tid & 255;
    int grow[5], gcol[5], loff[5];
#pragma unroll
    for (int k = 0; k < 5; ++k) { const int q = ptid + k * 256, row = q / 36, pc = q - row * 36; grow[k] = row;
        if (pc < 4) { gcol[k] = hs * 64 + p0 + pc * 8; loff[k] = row * 32 + pc * 8; }
        else if (pc < 20) { gcol[k] = 1024 + grp * 128 + (pc - 4) * 8; loff[k] = 1024 + row * 128 + (pc - 4) * 8; }
        else { gcol[k] = 1280 + grp * 128 + (pc - 20) * 8; loff[k] = 5120 + row * 128 + (pc - 20) * 8; } }
    uint4 rg[5]; float sc = 0.f;
#define SSD_ISSUE(t0) do { _Pragma("unroll") for (int k = 0; k < 5; ++k) if (ptid + k * 256 < 1152) rg[k] = *(const uint4*)(xbc + (size_t)((t0) + grow[k]) * 1536 + gcol[k]); \
        if (ptid < 32) sc = dtp[((t0) + ptid) * 16]; else if (ptid < 64) sc = dap[((t0) + ptid - 32) * 16]; } while (0)
#define SSD_COMMIT(buf) do { LAS float* Lc = L + (buf) * BUF_F; _Pragma("unroll") for (int k = 0; k < 5; ++k) if (ptid + k * 256 < 1152) { float f[8]; unpack8(rg[k], f); \
            *(LAS f32x4*)(Lc + loff[k]) = (f32x4){f[0], f[1], f[2], f[3]}; *(LAS f32x4*)(Lc + loff[k] + 4) = (f32x4){f[4], f[5], f[6], f[7]}; } \
        if (ptid < 32) Lc[9216 + ptid] = sc; else if (ptid < 64) Lc[9248 + ptid - 32] = sc; } while (0)
#define SSD_FLUSH(chp) do { LAS float* yo = L + 2 * BUF_F + ((chp) & 1) * 1024; const f32x4 v = *(LAS f32x4*)(yo + (ptid >> 3) * 32 + (ptid & 7) * 4); \
        *(f32x4*)(yraw + (size_t)((chp) * 32 + (ptid >> 3)) * 1024 + (ptid & 7) * 4) = v; } while (0)
    f32x2 hA[4], hB[4];
#pragma unroll
    for (int i = 0; i < 4; ++i) { hA[i] = (f32x2){0.f, 0.f}; hB[i] = (f32x2){0.f, 0.f}; }
    const int prow = (tid >> 4) & 15, nseg = tid & 15;
    __syncthreads();
    if (producer) { SSD_ISSUE(0); SSD_COMMIT(0); SSD_ISSUE(32); }
    __syncthreads();
    for (int ch = 0; ch < 64; ++ch) {
        const int cur = ch & 1;
        if (producer) {
            if (ch >= 1) SSD_FLUSH(ch - 1);
            if (ch + 1 < 64) SSD_COMMIT(cur ^ 1);
            if (ch + 2 < 64) SSD_ISSUE((ch + 2) * 32);
        } else {
        LAS float* Lb = L + cur * BUF_F; LAS float* yb = L + 2 * BUF_F + cur * 1024;
        for (int tg = 0; tg < 32; tg += 16) {
            float yA[16], yB[16];
            LAS float* qb = Lb + 1024 + tg * 128 + nseg * 8;
            f32x4 b0 = *(LAS f32x4*)(qb), b1 = *(LAS f32x4*)(qb + 4), c0 = *(LAS f32x4*)(qb + 4096), c1 = *(LAS f32x4*)(qb + 4100);
            float dA = Lb[9248 + tg], xa = Lb[tg * 32 + prow], xb = Lb[tg * 32 + prow + 16], dtv = Lb[9216 + tg];
#pragma unroll
            for (int tt = 0; tt < 16; ++tt) {
                f32x4 nb0, nb1, nc0, nc1; float ndA, nxa, nxb, ndtv;
                if (tt + 1 < 16) { LAS float* q = qb + (tt + 1) * 128; nb0 = *(LAS f32x4*)(q); nb1 = *(LAS f32x4*)(q + 4); nc0 = *(LAS f32x4*)(q + 4096); nc1 = *(LAS f32x4*)(q + 4100);
                    ndA = Lb[9248 + tg + tt + 1]; nxa = Lb[(tg + tt + 1) * 32 + prow]; nxb = Lb[(tg + tt + 1) * 32 + prow + 16]; ndtv = Lb[9216 + tg + tt + 1]; }
                __builtin_amdgcn_sched_barrier(0);
                const float xdta = xa * dtv, xdtb = xb * dtv;
                const f32x2 dA2 = (f32x2){dA, dA}, xa2 = (f32x2){xdta, xdta}, xb2 = (f32x2){xdtb, xdtb};
                hA[0] = hA[0] * dA2 + xa2 * b0.xy; hB[0] = hB[0] * dA2 + xb2 * b0.xy; hA[1] = hA[1] * dA2 + xa2 * b0.zw; hB[1] = hB[1] * dA2 + xb2 * b0.zw;
                hA[2] = hA[2] * dA2 + xa2 * b1.xy; hB[2] = hB[2] * dA2 + xb2 * b1.xy; hA[3] = hA[3] * dA2 + xa2 * b1.zw; hB[3] = hB[3] * dA2 + xb2 * b1.zw;
                f32x2 ya = hA[0] * c0.xy, yb2 = hB[0] * c0.xy; ya = hA[1] * c0.zw + ya; yb2 = hB[1] * c0.zw + yb2; ya = hA[2] * c1.xy + ya; yb2 = hB[2] * c1.xy + yb2; ya = hA[3] * c1.zw + ya; yb2 = hB[3] * c1.zw + yb2;
                float ra = ya.x + ya.y, rb = yb2.x + yb2.y;
                ra = dpp_add<0xB1>(ra); rb = dpp_add<0xB1>(rb); ra = dpp_add<0x4E>(ra); rb = dpp_add<0x4E>(rb); ra = dpp_add<0x141>(ra); rb = dpp_add<0x141>(rb); ra = dpp_add<0x140>(ra); rb = dpp_add<0x140>(rb);
                yA[tt] = ra + dskip * xa; yB[tt] = rb + dskip * xb;
                __builtin_amdgcn_sched_barrier(0);
                if (tt + 1 < 16) { b0 = nb0; b1 = nb1; c0 = nc0; c1 = nc1; dA = ndA; xa = nxa; xb = nxb; dtv = ndtv; }
            }
            if (nseg == 0) {
#pragma unroll
                for (int tt = 0; tt < 16; ++tt) { yb[(tg + tt) * 32 + prow] = yA[tt]; yb[(tg + tt) * 32 + prow + 16] = yB[tt]; } }
        }
        }
        __syncthreads();
    }
    if (producer) SSD_FLUSH(63);
#undef SSD_ISSUE
#undef SSD_COMMIT
#undef SSD_FLUSH
}

__device__ __forceinline__ void ssd_chunk_job(const Params& p, int job, LAS unsigned char* lds) {
    const int tid = opq(threadIdx.x), lane = tid & 63, w = tid >> 6, fr = lane & 15, fq = lane >> 4;
    const int b = job >> 5, hs = (job >> 1) & 15, half = job & 1, grp = hs >> 3, p0 = half * 32;
    const bf16_t* xbc = (const bf16_t*)(p.ws + WS_XBC) + (size_t)b * SEQ * 1536;
    const float* dtp = (const float*)(p.ws + WS_DT) + (size_t)b * SEQ * 16 + hs;
    float* yraw = (float*)(p.ws + WS_YRAW) + (size_t)b * SEQ * 1024 + hs * 64 + p0;
    const float dskip = p.in[10][hs], Ah = -__expf(p.in[9][hs]);
    constexpr int RS = 136;
    LAS bf16_t* Cs = (LAS bf16_t*)lds;
    LAS bf16_t* Bs = (LAS bf16_t*)(lds + 34816);
    LAS bf16_t* BTs = (LAS bf16_t*)(lds + 69632);
    LAS bf16_t* XTa = (LAS bf16_t*)(lds + 104448);
    LAS bf16_t* XTb = (LAS bf16_t*)(lds + 113152);
    LAS bf16_t* Ps = (LAS bf16_t*)(lds + 121856);
    LAS float* af = (LAS float*)(lds + 130560);
    LAS float* dtf = (LAS float*)(lds + 131584);
    const int crow0 = tid >> 4, cpc = tid & 15;
    const int xk = tid >> 2, xpc = tid & 3;
    u32x4 rc[4], rb[4], rx; float rdt = 0.f;
#define SC_ISSUE(t0) do { _Pragma("unroll") for (int i = 0; i < 4; ++i) { const bf16_t* rp_ = xbc + (size_t)((t0) + (crow0 + 32 * i)) * 1536 + grp * 128 + cpc * 8; rb[i] = *(const u32x4*)(rp_ + 1024); rc[i] = *(const u32x4*)(rp_ + 1280); } \
        rx = *(const u32x4*)(xbc + (size_t)((t0) + xk) * 1536 + hs * 64 + p0 + xpc * 8); if (tid < 128) rdt = dtp[((t0) + tid) * 16]; } while (0)
    f32x4 st[2];
    st[0] = (f32x4){0.f, 0.f, 0.f, 0.f}; st[1] = st[0];
    __syncthreads();
    for (int i = tid; i < 32 * RS / 2; i += 512) ((LAS unsigned*)Ps)[i] = 0u;
    SC_ISSUE(0);
    for (int ch = 0; ch < 16; ++ch) {
        const int t0 = ch * 128;
        __syncthreads();
#pragma unroll
        for (int i = 0; i < 4; ++i) { *(LAS u32x4*)(Cs + (crow0 + 32 * i) * RS + cpc * 8) = rc[i]; *(LAS u32x4*)(Bs + (crow0 + 32 * i) * RS + cpc * 8) = rb[i];

#pragma unroll
            for (int e = 0; e < 4; ++e) { BTs[(cpc * 8 + 2 * e) * RS + (crow0 + 32 * i)] = (bf16_t)(rb[i][e] & 0xffffu); BTs[(cpc * 8 + 2 * e + 1) * RS + (crow0 + 32 * i)] = (bf16_t)(rb[i][e] >> 16); } }
        float csv = 0.f;
        if (tid < 128) {
            csv = rdt * Ah; dtf[tid] = rdt;
#pragma unroll
            for (int off = 1; off < 64; off <<= 1) { const float t_ = __shfl_up(csv, off); if (lane >= off) csv += t_; }
            if (tid == 63) af[128] = csv;
        }
        float xr[8]; xr[0] = bflo(rx[0]); xr[1] = bfhi(rx[0]); xr[2] = bflo(rx[1]); xr[3] = bfhi(rx[1]); xr[4] = bflo(rx[2]); xr[5] = bfhi(rx[2]); xr[6] = bflo(rx[3]); xr[7] = bfhi(rx[3]);
        __syncthreads();
        if (tid < 128) af[tid] = (tid >= 64) ? csv + af[128] : csv;
        __syncthreads();
        const float cs_last = af[127];
        { const float d = dtf[xk], dout = __expf(cs_last - af[xk]);
#pragma unroll
          for (int e = 0; e < 8; ++e) { const float xa = xr[e] * d; XTa[(xpc * 8 + e) * RS + xk] = f2bf(xa); XTb[(xpc * 8 + e) * RS + xk] = f2bf(xa * dout); } }
        __syncthreads();
        bf16x8 cf[4];
#pragma unroll
        for (int ks = 0; ks < 4; ++ks) cf[ks] = *(LAS bf16x8*)(Cs + (w * 16 + fr) * RS + ks * 32 + fq * 8);
        f32x4 yo[2];
#pragma unroll
        for (int pt = 0; pt < 2; ++pt) { f32x4 acc = (f32x4){0.f, 0.f, 0.f, 0.f};
#pragma unroll
            for (int ks = 0; ks < 4; ++ks) { const bf16x8 pb = *(LAS bf16x8*)(Ps + (pt * 16 + fr) * RS + ks * 32 + fq * 8); acc = __builtin_amdgcn_mfma_f32_16x16x32_bf16(cf[ks], pb, acc, 0, 0, 0); }
            yo[pt] = acc; }
        float csq[4];
#pragma unroll
        for (int i = 0; i < 4; ++i) csq[i] = af[w * 16 + fq * 4 + i];
#pragma unroll
        for (int kt = 0; kt < 8; ++kt) { f32x4 acc = (f32x4){0.f, 0.f, 0.f, 0.f};
#pragma unroll
            for (int ks = 0; ks < 4; ++ks) { const bf16x8 bb = *(LAS bf16x8*)(Bs + (kt * 16 + fr) * RS + ks * 32 + fq * 8); acc = __builtin_amdgcn_mfma_f32_16x16x32_bf16(cf[ks], bb, acc, 0, 0, 0); }
            const int kk = kt * 16 + fr; const float csk = af[kk];
#pragma unroll
            for (int i = 0; i < 4; ++i) { const int qq = w * 16 + fq * 4 + i; const float m = (kk <= qq) ? acc[i] * __expf(csq[i] - csk) : 0.f; Cs[qq * RS + kk] = f2bf(m); } }
        f32x4 yd[2];
        { bf16x8 mf[4];
#pragma unroll
          for (int ks = 0; ks < 4; ++ks) mf[ks] = *(LAS bf16x8*)(Cs + (w * 16 + fr) * RS + ks * 32 + fq * 8);
#pragma unroll
          for (int pt = 0; pt < 2; ++pt) { f32x4 acc = (f32x4){0.f, 0.f, 0.f, 0.f};
#pragma unroll
              for (int ks = 0; ks < 4; ++ks) { const bf16x8 xb = *(LAS bf16x8*)(XTa + (pt * 16 + fr) * RS + ks * 32 + fq * 8); acc = __builtin_amdgcn_mfma_f32_16x16x32_bf16(mf[ks], xb, acc, 0, 0, 0); }
              yd[pt] = acc; } }
#pragma unroll
        for (int pt = 0; pt < 2; ++pt)
#pragma unroll
            for (int i = 0; i < 4; ++i) { const int qq = w * 16 + fq * 4 + i, pp = pt * 16 + fr;
                const float xv = bf2f(xbc[(size_t)(t0 + qq) * 1536 + hs * 64 + p0 + pp]);
                yraw[(size_t)(t0 + qq) * 1024 + pp] = yd[pt][i] + __expf(csq[i]) * yo[pt][i] + dskip * xv; }
        if (ch + 1 < 16) SC_ISSUE(t0 + 128);
        __syncthreads();
        { const float cd = __expf(cs_last);
#pragma unroll
          for (int pt = 0; pt < 2; ++pt) { f32x4 acc = st[pt] * cd;
#pragma unroll
              for (int ks = 0; ks < 4; ++ks) { const bf16x8 xa = *(LAS bf16x8*)(XTb + (pt * 16 + fr) * RS + ks * 32 + fq * 8); const bf16x8 bt = *(LAS bf16x8*)(BTs + (w * 16 + fr) * RS + ks * 32 + fq * 8);
                  acc = __builtin_amdgcn_mfma_f32_16x16x32_bf16(xa, bt, acc, 0, 0, 0); }
              st[pt] = acc;
#pragma unroll
              for (int i = 0; i < 4; ++i) Ps[(pt * 16 + fq * 4 + i) * RS + w * 16 + fr] = f2bf(acc[i]); } }
    }
#undef SC_ISSUE
}

__device__ __forceinline__ void attn_job(const Params& p, int job, LAS unsigned char* lds) {
    const int tid = opq(threadIdx.x), lane = tid & 63, w = tid >> 6, fr = lane & 15, fq = lane >> 4;
    const int b = job >> 6, kvh = (job >> 4) & 3, nb = job & 15;
    const bf16_t* proj = (const bf16_t*)(p.ws + WS_PROJ) + (size_t)b * SEQ * INWP;
    const float2* rope = (const float2*)(p.ws + WS_ROPE);
    LAS bf16_t* Ks = (LAS bf16_t*)lds;
    LAS bf16_t* Vt = (LAS bf16_t*)(lds + 36864);
    LAS bf16_t* Ps = (LAS bf16_t*)(lds + 70656) + w * 16 * 264;
    __syncthreads();
    if (tid < 256) {
        const int kr = tid, tk = (nb - 1) * 128 + kr;
        if (tk >= 0) {
            const bf16_t* src = proj + (size_t)tk * INWP + COL_K + kvh * 64; float x[64]; float ss = 0.f;
#pragma unroll
            for (int c = 0; c < 8; ++c) { const uint4 r = *(const uint4*)(src + c * 8); float f[8]; unpack8(r, f);
#pragma unroll
                for (int e = 0; e < 8; ++e) { x[c * 8 + e] = f[e]; ss += f[e] * f[e]; } }
            const float rinv = rsqrtf(ss * (1.0f / 64) + 1e-6f); const float* kn = p.in[13];
#pragma unroll
            for (int i = 0; i < 64; ++i) x[i] = x[i] * rinv * kn[i];
#pragma unroll
            for (int c = 0; c < 4; ++c) { float o1[8], o2[8];
#pragma unroll
                for (int e = 0; e < 8; ++e) { const int i = c * 8 + e; const float2 cs = rope[tk * 32 + i]; o1[e] = x[i] * cs.x - x[i + 32] * cs.y; o2[e] = x[i + 32] * cs.x + x[i] * cs.y; }
                u32x4 w1, w2; w1.x = cvt_pk_bf16(o1[0], o1[1]); w1.y = cvt_pk_bf16(o1[2], o1[3]); w1.z = cvt_pk_bf16(o1[4], o1[5]); w1.w = cvt_pk_bf16(o1[6], o1[7]);
                w2.x = cvt_pk_bf16(o2[0], o2[1]); w2.y = cvt_pk_bf16(o2[2], o2[3]); w2.z = cvt_pk_bf16(o2[4], o2[5]); w2.w = cvt_pk_bf16(o2[6], o2[7]);
                *(LAS u32x4*)(Ks + kr * 72 + c * 8) = w1; *(LAS u32x4*)(Ks + kr * 72 + 32 + c * 8) = w2;
                __builtin_amdgcn_sched_barrier(0); }
        } else {
#pragma unroll
            for (int c = 0; c < 8; ++c) *(LAS u32x4*)(Ks + kr * 72 + c * 8) = (u32x4){0u, 0u, 0u, 0u};
        }
    } else {
        const int kr = tid - 256, tk = (nb - 1) * 128 + kr;
        const bf16_t* src = proj + (size_t)(tk < 0 ? 0 : tk) * INWP + COL_V + kvh * 64;
#pragma unroll
        for (int c = 0; c < 8; ++c) { uint4 r = *(const uint4*)(src + c * 8); if (tk < 0) r = make_uint4(0u, 0u, 0u, 0u);
            Vt[(c * 8 + 0) * 264 + kr] = (bf16_t)(r.x & 0xffffu); Vt[(c * 8 + 1) * 264 + kr] = (bf16_t)(r.x >> 16);
            Vt[(c * 8 + 2) * 264 + kr] = (bf16_t)(r.y & 0xffffu); Vt[(c * 8 + 3) * 264 + kr] = (bf16_t)(r.y >> 16);
            Vt[(c * 8 + 4) * 264 + kr] = (bf16_t)(r.z & 0xffffu); Vt[(c * 8 + 5) * 264 + kr] = (bf16_t)(r.z >> 16);
            Vt[(c * 8 + 6) * 264 + kr] = (bf16_t)(r.w & 0xffffu); Vt[(c * 8 + 7) * 264 + kr] = (bf16_t)(r.w >> 16); }
    }
    __syncthreads();
    for (int h4 = 0; h4 < 4; ++h4) {
    const int hq = kvh * 4 + h4;
    bf16x8 qa[2];
    { const int tq = nb * 128 + w * 16 + fr; const bf16_t* src = proj + (size_t)tq * INWP + hq * 64;
      const uint4 r0 = *(const uint4*)(src + fq * 8), r1 = *(const uint4*)(src + 32 + fq * 8); float x1[8], x2[8]; unpack8(r0, x1); unpack8(r1, x2);
      float ss = 0.f;
#pragma unroll
      for (int e = 0; e < 8; ++e) ss += x1[e] * x1[e] + x2[e] * x2[e];
      ss += __shfl_xor(ss, 16); ss += __shfl_xor(ss, 32);
      const float rinv = rsqrtf(ss * (1.0f / 64) + 1e-6f) * 0.125f; const float* qn = p.in[12]; float o1[8], o2[8];
#pragma unroll
      for (int e = 0; e < 8; ++e) { const int i = fq * 8 + e; const float a = x1[e] * rinv * qn[i], c = x2[e] * rinv * qn[i + 32]; const float2 cs = rope[tq * 32 + i];
          o1[e] = a * cs.x - c * cs.y; o2[e] = c * cs.x + a * cs.y; }
      u32x4 w1, w2; w1.x = cvt_pk_bf16(o1[0], o1[1]); w1.y = cvt_pk_bf16(o1[2], o1[3]); w1.z = cvt_pk_bf16(o1[4], o1[5]); w1.w = cvt_pk_bf16(o1[6], o1[7]);
      w2.x = cvt_pk_bf16(o2[0], o2[1]); w2.y = cvt_pk_bf16(o2[2], o2[3]); w2.z = cvt_pk_bf16(o2[4], o2[5]); w2.w = cvt_pk_bf16(o2[6], o2[7]);
      qa[0] = __builtin_bit_cast(bf16x8, w1); qa[1] = __builtin_bit_cast(bf16x8, w2); }
    f32x4 s[16];
#pragma unroll
    for (int j = 0; j < 16; ++j) { f32x4 acc = (f32x4){0.f, 0.f, 0.f, 0.f};
#pragma unroll
        for (int ks = 0; ks < 2; ++ks) { const bf16x8 kb = *(LAS bf16x8*)(Ks + (j * 16 + fr) * 72 + ks * 32 + fq * 8); acc = __builtin_amdgcn_mfma_f32_16x16x32_bf16(qa[ks], kb, acc, 0, 0, 0); }
        s[j] = acc; }
    const float sink = p.in[14][hq];
    float mx[4], inv[4];
#pragma unroll
    for (int i = 0; i < 4; ++i) { const int qi = w * 16 + fq * 4 + i + 128; float m = -3.0e38f;
#pragma unroll
        for (int j = 0; j < 16; ++j) { const int kj = j * 16 + fr; const bool ok = (kj <= qi) && (qi - kj < 128) && (nb > 0 || kj >= 128); s[j][i] = ok ? s[j][i] : -3.0e38f; m = fmaxf(m, s[j][i]); }
        m = fmaxf(m, __shfl_xor(m, 1)); m = fmaxf(m, __shfl_xor(m, 2)); m = fmaxf(m, __shfl_xor(m, 4)); m = fmaxf(m, __shfl_xor(m, 8));
        m = fmaxf(m, sink); mx[i] = m; float l = 0.f;
#pragma unroll
        for (int j = 0; j < 16; ++j) { const float e = (s[j][i] > -1.0e38f) ? __expf(s[j][i] - m) : 0.f; s[j][i] = e; l += e; }
        l += __shfl_xor(l, 1); l += __shfl_xor(l, 2); l += __shfl_xor(l, 4); l += __shfl_xor(l, 8);
        inv[i] = 1.0f / (l + __expf(sink - m)); }
#pragma unroll
    for (int j = 0; j < 16; ++j)
#pragma unroll
        for (int i = 0; i < 4; ++i) Ps[(fq * 4 + i) * 264 + j * 16 + fr] = f2bf(s[j][i] * inv[i]);
    f32x4 o[4];
#pragma unroll
    for (int nd = 0; nd < 4; ++nd) o[nd] = (f32x4){0.f, 0.f, 0.f, 0.f};
#pragma unroll
    for (int kk = 0; kk < 8; ++kk) { const bf16x8 pa = *(LAS bf16x8*)(Ps + fr * 264 + kk * 32 + fq * 8);
#pragma unroll
        for (int nd = 0; nd < 4; ++nd) { const bf16x8 vb = *(LAS bf16x8*)(Vt + (nd * 16 + fr) * 264 + kk * 32 + fq * 8); o[nd] = __builtin_amdgcn_mfma_f32_16x16x32_bf16(pa, vb, o[nd], 0, 0, 0); } }
    bf16_t* ymix = (bf16_t*)(p.ws + WS_YMIX) + (size_t)b * SEQ * D + hq * 64;
#pragma unroll
    for (int nd = 0; nd < 4; ++nd)
#pragma unroll
        for (int i = 0; i < 4; ++i) ymix[(size_t)(nb * 128 + w * 16 + fq * 4 + i) * D + nd * 16 + fr] = f2bf(o[nd][i]);
    }
}

__device__ __forceinline__ void post_ssd(const Params& p) {
    const int tid_ = opq(threadIdx.x); const int lane = tid_ & 63, wv = tid_ >> 6;
    const float* yraw = (const float*)(p.ws + WS_YRAW); const bf16_t* proj = (const bf16_t*)(p.ws + WS_PROJ); bf16_t* ymix = (bf16_t*)(p.ws + WS_YMIX);
    for (int it = blockIdx.x * 8 + wv; it < MTOK * 2; it += gridDim.x * 8) {
        const int tok = it >> 1, grp = it & 1, c = grp * 512 + lane * 8;
        const f32x4 y0 = *(const f32x4*)(yraw + (size_t)tok * 1024 + c), y1 = *(const f32x4*)(yraw + (size_t)tok * 1024 + c + 4);
        const uint4 zr = *(const uint4*)(proj + (size_t)tok * INWP + COL_Z + c); float z[8], y[8]; unpack8(zr, z); float ss = 0.f;
#pragma unroll
        for (int e = 0; e < 8; ++e) { const float yy = (e < 4 ? y0[e] : y1[e - 4]); y[e] = yy * z[e] * sigmoidf_(z[e]); ss += y[e] * y[e]; }
        ss = wave_sum(ss); const float r = rsqrtf(ss * (1.0f / 512) + 1e-6f);
        const f32x4 n0 = *(const f32x4*)(p.in[11] + c), n1 = *(const f32x4*)(p.in[11] + c + 4);
        u32x4 w; w.x = cvt_pk_nv(y[0] * r * n0[0], y[1] * r * n0[1]); w.y = cvt_pk_nv(y[2] * r * n0[2], y[3] * r * n0[3]);
        w.z = cvt_pk_nv(y[4] * r * n1[0], y[5] * r * n1[1]); w.w = cvt_pk_nv(y[6] * r * n1[2], y[7] * r * n1[3]);
        *(u32x4*)(ymix + (size_t)tok * D + 1024 + c) = w;
    }
}

__device__ __forceinline__ float half_sum(float v, bool lo) {
    v = red16(v);
    const float r0 = __builtin_bit_cast(float, __builtin_amdgcn_readlane(__builtin_bit_cast(int, v), 0)), r1 = __builtin_bit_cast(float, __builtin_amdgcn_readlane(__builtin_bit_cast(int, v), 16));
    const float r2 = __builtin_bit_cast(float, __builtin_amdgcn_readlane(__builtin_bit_cast(int, v), 32)), r3 = __builtin_bit_cast(float, __builtin_amdgcn_readlane(__builtin_bit_cast(int, v), 48));
    return lo ? (r0 + r1) : (r2 + r3); }
__device__ __forceinline__ void rwkv_scan_job(const Params& p, int job, LAS unsigned char* lds) {
    const int tid = opq(threadIdx.x), lane = tid & 63, l32 = lane & 31; const bool lo = lane < 32;
    const int b = job >> 5, hh = job & 31;
    LAS float* L = (LAS float*)lds;
    const bool producer = tid >= 256;
    const int pw = (tid >> 6) & 3;
    const int tl0 = 2 * pw + (lane >> 5);
    const size_t wbase = ((size_t)b * SEQ * D + hh * 64) / 2 + l32 + (size_t)tl0 * (D / 2);
    const unsigned* R32 = (const unsigned*)(p.ws + WS_R) + wbase; const unsigned* K32 = (const unsigned*)(p.ws + WS_K) + wbase; const unsigned* V32 = (const unsigned*)(p.ws + WS_V) + wbase;
    const unsigned* E32 = (const unsigned*)(p.ws + WS_WDEC) + wbase; const unsigned* A32 = (const unsigned*)(p.ws + WS_AA) + wbase; const unsigned* G32 = (const unsigned*)(p.ws + WS_GG) + wbase;
    unsigned* Y32 = (unsigned*)(p.ws + WS_YG) + wbase;
    const int ci = hh * 64 + 2 * l32;
    const float2 kkw = *(const float2*)(p.in[25] + ci), kaw = *(const float2*)(p.in[26] + ci), rkw = *(const float2*)(p.in[27] + ci), lnw = *(const float2*)(p.in[32] + ci), lnb = *(const float2*)(p.in[33] + ci);
    unsigned rw[2], kw[2], vw[2], ew[2], aw[2], gw[2];
    const int oo = tl0 * 64 + 2 * l32;
#define RW_ISSUE(t0) do { _Pragma("unroll") for (int i2 = 0; i2 < 2; ++i2) { const size_t off = (size_t)((t0) + 8 * i2) * (D / 2); rw[i2] = R32[off]; kw[i2] = K32[off]; vw[i2] = V32[off]; ew[i2] = E32[off]; aw[i2] = A32[off]; gw[i2] = G32[off]; } } while (0)
#define RW_COMMIT(buf) do { _Pragma("unroll") for (int i2 = 0; i2 < 2; ++i2) { LAS float* Lc = L + (buf) * 8192 + oo + i2 * 512; \
        const float r0_ = bflo(rw[i2]), r1_ = bfhi(rw[i2]), k0_ = bflo(kw[i2]), k1_ = bfhi(kw[i2]), v0_ = bflo(vw[i2]), v1_ = bfhi(vw[i2]), e0_ = bflo(ew[i2]), e1_ = bfhi(ew[i2]), a0_ = bflo(aw[i2]), a1_ = bfhi(aw[i2]), g0_ = bflo(gw[i2]), g1_ = bfhi(gw[i2]); \
        const float kkv0 = k0_ * kkw.x, kkv1 = k1_ * kkw.y; const float ssq = half_sum(kkv0 * kkv0 + kkv1 * kkv1, lo); const float rn = rsqrtf(fmaxf(ssq, 1e-24f)); const float kn0 = kkv0 * rn, kn1 = kkv1 * rn; \
        const float km0 = k0_ * (1.0f + (a0_ - 1.0f) * kaw.x), km1 = k1_ * (1.0f + (a1_ - 1.0f) * kaw.y); const float bonus = half_sum(r0_ * km0 * rkw.x + r1_ * km1 * rkw.y, lo); \
        *(LAS f32x2*)(Lc) = (f32x2){-kn0, -kn1}; *(LAS f32x2*)(Lc + 1024) = (f32x2){__expf(-e0_), __expf(-e1_)}; *(LAS f32x2*)(Lc + 2048) = (f32x2){kn0 * a0_, kn1 * a1_}; *(LAS f32x2*)(Lc + 3072) = (f32x2){km0, km1}; \
        *(LAS f32x2*)(Lc + 4096) = (f32x2){r0_, r1_}; *(LAS f32x2*)(Lc + 5120) = (f32x2){v0_, v1_}; *(LAS f32x2*)(Lc + 6144) = (f32x2){g0_, g1_}; *(LAS f32x2*)(Lc + 7168) = (f32x2){bonus * v0_, bonus * v1_}; } } while (0)
#define RW_OUTPUT(chp) do { LAS float* Lo = L + ((chp) & 1) * 8192; LAS float* yo = L + 16384 + ((chp) & 1) * 1024; _Pragma("unroll") for (int i2 = 0; i2 < 2; ++i2) { const int o2 = oo + i2 * 512; \
        const f32x2 y = *(LAS f32x2*)(yo + o2); \
        const float mu = half_sum(y.x + y.y, lo) * (1.0f / 64), d0 = y.x - mu, d1 = y.y - mu, var = half_sum(d0 * d0 + d1 * d1, lo) * (1.0f / 64), rs = rsqrtf(var + 64e-5f); \
        const f32x2 bv = *(LAS f32x2*)(Lo + 7168 + o2), gg = *(LAS f32x2*)(Lo + 6144 + o2); \
        Y32[(size_t)((chp) * 16 + 8 * i2) * (D / 2)] = cvt_pk_nv((d0 * rs * lnw.x + lnb.x + bv.x) * gg.x, (d1 * rs * lnw.y + lnb.y + bv.y) * gg.y); } } while (0)
    f32x2 SA[4], SB[4];
#pragma unroll
    for (int i = 0; i < 4; ++i) { SA[i] = (f32x2){0.f, 0.f}; SB[i] = (f32x2){0.f, 0.f}; }
    const int rp = (tid >> 3) & 31, ks = tid & 7;
    __syncthreads();
    if (producer) { RW_ISSUE(0); RW_COMMIT(0); RW_ISSUE(16); }
    __syncthreads();
    for (int ch = 0; ch < 128; ++ch) {
        const int cur = ch & 1;
        if (producer) {
            if (ch >= 1) RW_OUTPUT(ch - 1);
            if (ch + 1 < 128) RW_COMMIT(cur ^ 1);
            if (ch + 2 < 128) RW_ISSUE((ch + 2) * 16);
        } else {
            LAS float* Lb = L + cur * 8192; LAS float* yb = L + 16384 + cur * 1024;
            float yA[16], yB[16];
            LAS float* q0 = Lb + ks * 8;
            f32x4 a0 = *(LAS f32x4*)(q0), a1 = *(LAS f32x4*)(q0 + 4), w0 = *(LAS f32x4*)(q0 + 1024), w1 = *(LAS f32x4*)(q0 + 1028), b0 = *(LAS f32x4*)(q0 + 2048), b1 = *(LAS f32x4*)(q0 + 2052);
            f32x4 k0 = *(LAS f32x4*)(q0 + 3072), k1 = *(LAS f32x4*)(q0 + 3076), r0 = *(LAS f32x4*)(q0 + 4096), r1 = *(LAS f32x4*)(q0 + 4100);
            float va = Lb[5120 + rp], vb = Lb[5120 + rp + 32];
#pragma unroll
            for (int t = 0; t < 16; ++t) {
                f32x4 na0, na1, nw0, nw1, nb0, nb1, nk0, nk1, nr0, nr1; float nva, nvb;
                if (t + 1 < 16) { LAS float* q = q0 + (t + 1) * 64;
                    na0 = *(LAS f32x4*)(q); na1 = *(LAS f32x4*)(q + 4); nw0 = *(LAS f32x4*)(q + 1024); nw1 = *(LAS f32x4*)(q + 1028); nb0 = *(LAS f32x4*)(q + 2048); nb1 = *(LAS f32x4*)(q + 2052);
                    nk0 = *(LAS f32x4*)(q + 3072); nk1 = *(LAS f32x4*)(q + 3076); nr0 = *(LAS f32x4*)(q + 4096); nr1 = *(LAS f32x4*)(q + 4100); nva = Lb[5120 + (t + 1) * 64 + rp]; nvb = Lb[5120 + (t + 1) * 64 + rp + 32]; }
                __builtin_amdgcn_sched_barrier(0);
                f32x2 ca = SA[0] * a0.xy, cb = SB[0] * a0.xy; ca = SA[1] * a0.zw + ca; cb = SB[1] * a0.zw + cb; ca = SA[2] * a1.xy + ca; cb = SB[2] * a1.xy + cb; ca = SA[3] * a1.zw + ca; cb = SB[3] * a1.zw + cb;
                float sa = ca.x + ca.y, sb = cb.x + cb.y;
                sa = dpp_add<0xB1>(sa); sb = dpp_add<0xB1>(sb); sa = dpp_add<0x4E>(sa); sb = dpp_add<0x4E>(sb); sa = dpp_add<0x141>(sa); sb = dpp_add<0x141>(sb);
                const f32x2 sa2 = (f32x2){sa, sa}, sb2 = (f32x2){sb, sb}, va2 = (f32x2){va, va}, vb2 = (f32x2){vb, vb};
                SA[0] = SA[0] * w0.xy + (sa2 * b0.xy + va2 * k0.xy); SB[0] = SB[0] * w0.xy + (sb2 * b0.xy + vb2 * k0.xy);
                SA[1] = SA[1] * w0.zw + (sa2 * b0.zw + va2 * k0.zw); SB[1] = SB[1] * w0.zw + (sb2 * b0.zw + vb2 * k0.zw);
                SA[2] = SA[2] * w1.xy + (sa2 * b1.xy + va2 * k1.xy); SB[2] = SB[2] * w1.xy + (sb2 * b1.xy + vb2 * k1.xy);
                SA[3] = SA[3] * w1.zw + (sa2 * b1.zw + va2 * k1.zw); SB[3] = SB[3] * w1.zw + (sb2 * b1.zw + vb2 * k1.zw);
                f32x2 ya = SA[0] * r0.xy, yb2 = SB[0] * r0.xy; ya = SA[1] * r0.zw + ya; yb2 = SB[1] * r0.zw + yb2; ya = SA[2] * r1.xy + ya; yb2 = SB[2] * r1.xy + yb2; ya = SA[3] * r1.zw + ya; yb2 = SB[3] * r1.zw + yb2;
                float ra = ya.x + ya.y, rb = yb2.x + yb2.y;
                ra = dpp_add<0xB1>(ra); rb = dpp_add<0xB1>(rb); ra = dpp_add<0x4E>(ra); rb = dpp_add<0x4E>(rb); ra = dpp_add<0x141>(ra); rb = dpp_add<0x141>(rb);
                yA[t] = ra; yB[t] = rb;
                __builtin_amdgcn_sched_barrier(0);
                if (t + 1 < 16) { a0 = na0; a1 = na1; w0 = nw0; w1 = nw1; b0 = nb0; b1 = nb1; k0 = nk0; k1 = nk1; r0 = nr0; r1 = nr1; va = nva; vb = nvb; }
            }
            if (ks == 0) {
#pragma unroll
                for (int t = 0; t < 16; ++t) { yb[t * 64 + rp] = yA[t]; yb[t * 64 + rp + 32] = yB[t]; } }
        }
        __syncthreads();
    }
    if (producer) RW_OUTPUT(127);
#undef RW_ISSUE
#undef RW_COMMIT
#undef RW_OUTPUT
}

__device__ __forceinline__ void rwkv_chunk_job(const Params& p, int job, LAS unsigned char* lds) {
    const int tid = opq(threadIdx.x), lane = tid & 63, w = tid >> 6, fr = lane & 15, fq = lane >> 4, l32 = lane & 31; const bool lo = lane < 32;
    const int b = job >> 5, hh = job & 31;
    const int tl = 2 * w + (lane >> 5);
    const size_t wbase = ((size_t)b * SEQ * D + hh * 64) / 2 + l32 + (size_t)tl * (D / 2);
    const unsigned* R32 = (const unsigned*)(p.ws + WS_R) + wbase; const unsigned* K32 = (const unsigned*)(p.ws + WS_K) + wbase; const unsigned* V32 = (const unsigned*)(p.ws + WS_V) + wbase;
    const unsigned* E32 = (const unsigned*)(p.ws + WS_WDEC) + wbase; const unsigned* A32 = (const unsigned*)(p.ws + WS_AA) + wbase; const unsigned* G32 = (const unsigned*)(p.ws + WS_GG) + wbase;
    unsigned* Y32 = (unsigned*)(p.ws + WS_YG) + wbase;
    const int ci = hh * 64 + 2 * l32;
    const float2 kkw = *(const float2*)(p.in[25] + ci), kaw = *(const float2*)(p.in[26] + ci), rkw = *(const float2*)(p.in[27] + ci), lnw = *(const float2*)(p.in[32] + ci), lnb = *(const float2*)(p.in[33] + ci);
    LAS float* Av = (LAS float*)(lds + 0);
    LAS float* Bv = (LAS float*)(lds + 4096);
    LAS float* Km = (LAS float*)(lds + 8192);
    LAS float* Rr = (LAS float*)(lds + 12288);
    LAS float* ybuf = (LAS float*)(lds + 16384);
    LAS float* RHS = (LAS float*)(lds + 20480);
    LAS float* Aab = (LAS float*)(lds + 24832);
    LAS float* Wend = (LAS float*)(lds + 25856);
    LAS bf16_t* ET = (LAS bf16_t*)(lds + 26112);
    LAS bf16_t* VT = (LAS bf16_t*)(lds + 31232);
    LAS bf16_t* BtT = (LAS bf16_t*)(lds + 36352);
    LAS bf16_t* KtT = (LAS bf16_t*)(lds + 41472);
    LAS bf16_t* Ub = (LAS bf16_t*)(lds + 46592);
    LAS bf16_t* AakT = (LAS bf16_t*)(lds + 51712);
    LAS bf16_t* AbrT = (LAS bf16_t*)(lds + 52992);
    LAS bf16_t* AkrT = (LAS bf16_t*)(lds + 54272);
    LAS bf16_t* At = (LAS bf16_t*)(lds + 55552);
    LAS bf16_t* Bt = (LAS bf16_t*)(lds + 57856);
    LAS bf16_t* Kt = (LAS bf16_t*)(lds + 60160);
    LAS bf16_t* Rt = (LAS bf16_t*)(lds + 62464);
    LAS bf16_t* S0b = (LAS bf16_t*)(lds + 64768);
    LAS bf16_t* VT1 = (LAS bf16_t*)(lds + 73984);
    constexpr int LDS_END = 73984 + 64 * 40 * 2;
    __syncthreads();
    for (int i = tid; i < LDS_END / 4; i += 512) ((LAS unsigned*)lds)[i] = 0u;
    f32x4 stt[2]; stt[0] = (f32x4){0.f, 0.f, 0.f, 0.f}; stt[1] = stt[0];
    const int vt = w >> 1, kt0 = (w & 1) * 2;
    bf16x8 Lf;
#pragma unroll
    for (int e = 0; e < 8; ++e) { const int i = fq * 8 + e; Lf[e] = (i <= fr && i < 16) ? (short)0x3F80 : (short)0; }
    unsigned rw, kw, vw, ew, aw, gw;
#define RC_ISSUE(t0) do { const size_t off = (size_t)(t0) * (D / 2); rw = R32[off]; kw = K32[off]; vw = V32[off]; ew = E32[off]; aw = A32[off]; gw = G32[off]; } while (0)
#define RC_PREP(chn) do { \
        const float r0_ = bflo(rw), r1_ = bfhi(rw), k0_ = bflo(kw), k1_ = bfhi(kw), v0_ = bflo(vw), v1_ = bfhi(vw), a0_ = bflo(aw), a1_ = bfhi(aw); gn0 = bflo(gw); gn1 = bfhi(gw); \
        const unsigned ewc = ew, vwc = vw; \
        if ((chn) + 1 < 128) RC_ISSUE(((chn) + 1) * 16); \
        const float kkv0 = k0_ * kkw.x, kkv1 = k1_ * kkw.y; const float ssq = half_sum(kkv0 * kkv0 + kkv1 * kkv1, lo); const float rn = rsqrtf(fmaxf(ssq, 1e-24f)); const float kn0 = kkv0 * rn, kn1 = kkv1 * rn; \
        const float km0 = k0_ * (1.0f + (a0_ - 1.0f) * kaw.x), km1 = k1_ * (1.0f + (a1_ - 1.0f) * kaw.y); const float bonus = half_sum(r0_ * km0 * rkw.x + r1_ * km1 * rkw.y, lo); \
        bn0 = bonus * v0_; bn1 = bonus * v1_; \
        { const int o = tl * 64 + 2 * l32; LAS bf16_t* VTw = ((chn) & 1) ? VT1 : VT; \
          *(LAS f32x2*)(Av + o) = (f32x2){-kn0, -kn1}; *(LAS f32x2*)(Bv + o) = (f32x2){kn0 * a0_, kn1 * a1_}; *(LAS f32x2*)(Km + o) = (f32x2){km0, km1}; *(LAS f32x2*)(Rr + o) = (f32x2){r0_, r1_}; \
          ET[(2 * l32) * 40 + tl] = (bf16_t)(ewc & 0xffffu); ET[(2 * l32 + 1) * 40 + tl] = (bf16_t)(ewc >> 16); \
          VTw[(2 * l32) * 40 + tl] = (bf16_t)(vwc & 0xffffu); VTw[(2 * l32 + 1) * 40 + tl] = (bf16_t)(vwc >> 16); } } while (0)
    float gc0 = 0.f, gc1 = 0.f, bc0 = 0.f, bc1 = 0.f, gn0, gn1, bn0, bn1;
    RC_ISSUE(0);
    __syncthreads();
    RC_PREP(0); gc0 = gn0; gc1 = gn1; bc0 = bn0; bc1 = bn1;
    __syncthreads();
    for (int ch = 0; ch < 128; ++ch) {
        LAS bf16_t* VTc = (ch & 1) ? VT1 : VT;
        if (w < 4) {
            const bf16x8 eb = *(LAS bf16x8*)(ET + (w * 16 + fr) * 40 + fq * 8);
            f32x4 ec = (f32x4){0.f, 0.f, 0.f, 0.f}; ec = __builtin_amdgcn_mfma_f32_16x16x32_bf16(Lf, eb, ec, 0, 0, 0);
            const int kk = w * 16 + fr; unsigned bt_pk[2], kt_pk[2]; float btv[4], ktv[4];
#pragma unroll
            for (int i = 0; i < 4; ++i) { const int t = fq * 4 + i; const float et = bf2f(ET[kk * 40 + t]);
                const float Wt = __expf(-ec[i]), Wp = __expf(et - ec[i]), iW = __expf(ec[i]);
                const int o = t * 64 + kk;
                At[t * 72 + kk] = f2bf(Av[o] * Wp); Rt[t * 72 + kk] = f2bf(Rr[o] * Wt);
                btv[i] = Bv[o] * iW; ktv[i] = Km[o] * iW;
                Bt[t * 72 + kk] = f2bf(btv[i]); Kt[t * 72 + kk] = f2bf(ktv[i]);
                if (t == 15) Wend[kk] = Wt; }
            bt_pk[0] = cvt_pk_bf16(btv[0], btv[1]); bt_pk[1] = cvt_pk_bf16(btv[2], btv[3]); kt_pk[0] = cvt_pk_bf16(ktv[0], ktv[1]); kt_pk[1] = cvt_pk_bf16(ktv[2], ktv[3]);
            *(LAS u32x2*)(BtT + kk * 40 + fq * 4) = (u32x2){bt_pk[0], bt_pk[1]}; *(LAS u32x2*)(KtT + kk * 40 + fq * 4) = (u32x2){kt_pk[0], kt_pk[1]};
        }
        __syncthreads();
        if (w < 4) {
            LAS bf16_t* Xr = (w & 1) ? Kt : Bt; LAS bf16_t* Yr = (w & 2) ? Rt : At;
            f32x4 gacc = (f32x4){0.f, 0.f, 0.f, 0.f};
#pragma unroll
            for (int ks = 0; ks < 2; ++ks) { const bf16x8 xa = *(LAS bf16x8*)(Xr + fr * 72 + ks * 32 + fq * 8); const bf16x8 yb_ = *(LAS bf16x8*)(Yr + fr * 72 + ks * 32 + fq * 8); gacc = __builtin_amdgcn_mfma_f32_16x16x32_bf16(xa, yb_, gacc, 0, 0, 0); }
            float gm[4];
#pragma unroll
            for (int i = 0; i < 4; ++i) { const int j = fq * 4 + i; const bool keep = (w & 2) ? (j <= fr) : (j < fr); gm[i] = keep ? gacc[i] : 0.f; }
            if (w == 0) {
#pragma unroll
                for (int i = 0; i < 4; ++i) Aab[(fq * 4 + i) * 16 + fr] = gm[i]; }
            else { LAS bf16_t* dst = (w == 1) ? AakT : (w == 2) ? AbrT : AkrT; *(LAS u32x2*)(dst + fr * 40 + fq * 4) = (u32x2){cvt_pk_bf16(gm[0], gm[1]), cvt_pk_bf16(gm[2], gm[3])}; }
        }
        __syncthreads();
        f32x4 y0 = (f32x4){0.f, 0.f, 0.f, 0.f};
        { const int vtile = w & 3; LAS bf16_t* Yr = (w < 4) ? At : Rt; LAS bf16_t* Gt = (w < 4) ? AakT : AkrT;
#pragma unroll
          for (int ks = 0; ks < 2; ++ks) { const bf16x8 sa = *(LAS bf16x8*)(S0b + (vtile * 16 + fr) * 72 + ks * 32 + fq * 8); const bf16x8 yb_ = *(LAS bf16x8*)(Yr + fr * 72 + ks * 32 + fq * 8); y0 = __builtin_amdgcn_mfma_f32_16x16x32_bf16(sa, yb_, y0, 0, 0, 0); }
          { const bf16x8 va = *(LAS bf16x8*)(VTc + (vtile * 16 + fr) * 40 + fq * 8); const bf16x8 gb = *(LAS bf16x8*)(Gt + fr * 40 + fq * 8); y0 = __builtin_amdgcn_mfma_f32_16x16x32_bf16(va, gb, y0, 0, 0, 0); }
          if (w < 4) {
#pragma unroll
              for (int i = 0; i < 4; ++i) RHS[(vtile * 16 + fq * 4 + i) * 17 + fr] = y0[i]; } }
        __syncthreads();
        if (w == 0) {
            float u[16];
#pragma unroll
            for (int t = 0; t < 16; ++t) u[t] = RHS[lane * 17 + t];
#pragma unroll
            for (int t = 0; t < 15; ++t) {
#pragma unroll
                for (int t2 = t + 1; t2 < 16; ++t2) u[t2] += u[t] * Aab[t * 16 + t2]; }
            u32x4 o0, o1; o0.x = cvt_pk_bf16(u[0], u[1]); o0.y = cvt_pk_bf16(u[2], u[3]); o0.z = cvt_pk_bf16(u[4], u[5]); o0.w = cvt_pk_bf16(u[6], u[7]);
            o1.x = cvt_pk_bf16(u[8], u[9]); o1.y = cvt_pk_bf16(u[10], u[11]); o1.z = cvt_pk_bf16(u[12], u[13]); o1.w = cvt_pk_bf16(u[14], u[15]);
            *(LAS u32x4*)(Ub + lane * 40) = o0; *(LAS u32x4*)(Ub + lane * 40 + 8) = o1;
        }
        if (ch + 1 < 128) RC_PREP(ch + 1);
        __syncthreads();
        if (w >= 4) { const int vtile = w & 3;
            const bf16x8 ua = *(LAS bf16x8*)(Ub + (vtile * 16 + fr) * 40 + fq * 8); const bf16x8 gb = *(LAS bf16x8*)(AbrT + fr * 40 + fq * 8); y0 = __builtin_amdgcn_mfma_f32_16x16x32_bf16(ua, gb, y0, 0, 0, 0);
#pragma unroll
            for (int i = 0; i < 4; ++i) ybuf[fr * 64 + vtile * 16 + fq * 4 + i] = y0[i]; }
        { const bf16x8 ua = *(LAS bf16x8*)(Ub + (vt * 16 + fr) * 40 + fq * 8); const bf16x8 va = *(LAS bf16x8*)(VTc + (vt * 16 + fr) * 40 + fq * 8);
#pragma unroll
          for (int q = 0; q < 2; ++q) { const int kk = (kt0 + q) * 16 + fr;
              const bf16x8 bb = *(LAS bf16x8*)(BtT + kk * 40 + fq * 8); const bf16x8 kb = *(LAS bf16x8*)(KtT + kk * 40 + fq * 8);
              f32x4 acc = stt[q]; acc = __builtin_amdgcn_mfma_f32_16x16x32_bf16(ua, bb, acc, 0, 0, 0); acc = __builtin_amdgcn_mfma_f32_16x16x32_bf16(va, kb, acc, 0, 0, 0);
              const float we = Wend[kk]; acc = acc * we; stt[q] = acc;
#pragma unroll
              for (int i = 0; i < 4; ++i) S0b[(vt * 16 + fq * 4 + i) * 72 + kk] = f2bf(acc[i]); } }
        __syncthreads();
        { const f32x2 y = *(LAS f32x2*)(ybuf + tl * 64 + 2 * l32);
          const float mu = half_sum(y.x + y.y, lo) * (1.0f / 64), d0 = y.x - mu, d1 = y.y - mu, var = half_sum(d0 * d0 + d1 * d1, lo) * (1.0f / 64), rs = rsqrtf(var + 64e-5f);
          Y32[(size_t)(ch * 16) * (D / 2)] = cvt_pk_nv((d0 * rs * lnw.x + lnb.x + bc0) * gc0, (d1 * rs * lnw.y + lnb.y + bc1) * gc1); }
        gc0 = gn0; gc1 = gn1; bc0 = bn0; bc1 = bn1;
    }
#undef RC_ISSUE
#undef RC_PREP
}

#define XB_TMO      128
#define XB_XCNT(j)  (256  + 64 * (j))
#define XB_XSUB(j)  (1280 + 64 * (j))
#define XB_XGEN(j)  (2304 + 64 * (j))
#define XB_TOP      3328
#define XB_TOPGEN   3392
#define XCD_BAR_WORDS 3456
#define XB_SPIN_CAP (1u << 18)

__device__ __forceinline__ unsigned xb_ld(unsigned* p)              { return __hip_atomic_load(p, __ATOMIC_RELAXED, __HIP_MEMORY_SCOPE_AGENT); }
__device__ __forceinline__ unsigned xb_add(unsigned* p, unsigned v) { return __hip_atomic_fetch_add(p, v, __ATOMIC_RELAXED, __HIP_MEMORY_SCOPE_AGENT); }
__device__ __forceinline__ unsigned xb_xcc_id() { return (unsigned)__builtin_amdgcn_s_getreg((3 << 11) | 20) & 0xFu; }
#define XB_SPIN(cond, bar) do { unsigned _sp = 0; while (cond) { __builtin_amdgcn_s_sleep(1); \
    if ((++_sp & 255u) == 0u) { if (xb_ld(&(bar)[XB_TMO])) break; if (_sp > XB_SPIN_CAP) { atomicAdd(&(bar)[XB_TMO], 1u); break; } } } } while (0)

struct XcdBarrier {
    unsigned* bar; unsigned x;
    volatile LAS unsigned* st;
};

__device__ __forceinline__ XcdBarrier xcd_barrier_post(unsigned* bar, volatile LAS unsigned* st) {
    XcdBarrier b; b.bar = bar; b.x = xb_xcc_id(); b.st = st;
    if (threadIdx.x == 0) (void)xb_add(&bar[XB_XCNT(b.x)], 1u);
    return b;
}
__device__ __forceinline__ void xcd_barrier_complete(unsigned* bar, unsigned x, unsigned& nloc, unsigned& nx) {
    const unsigned G = gridDim.x * gridDim.y * gridDim.z;
    unsigned sum, cnt, mine, sp = 0u;
    for (;;) {
        sum = 0u; cnt = 0u; mine = 0u;
#pragma unroll
        for (unsigned j = 0; j < 16; ++j) { const unsigned c = xb_ld(&bar[XB_XCNT(j)]); sum += c; cnt += (c > 0u) ? 1u : 0u; mine = (j == x) ? c : mine; }
        if (sum == G) break;
        __builtin_amdgcn_s_sleep(1);
        if ((++sp & 255u) == 0u) { if (xb_ld(&bar[XB_TMO])) break; if (sp > XB_SPIN_CAP) { atomicAdd(&bar[XB_TMO], 1u); break; } }
    }
    nloc = mine > 0u ? mine : 1u; nx = cnt > 0u ? cnt : 1u;
}

__device__ __forceinline__ void xcd_barrier(const XcdBarrier& b) {
    asm volatile("s_waitcnt vmcnt(0)" ::: "memory");
    __syncthreads();
    if (threadIdx.x == 0) {
        unsigned* bar = b.bar;
        __builtin_amdgcn_s_waitcnt(0);
        unsigned nloc = b.st[0], nx = b.st[1];
        if (nloc == 0u) { xcd_barrier_complete(bar, b.x, nloc, nx); b.st[0] = nloc; b.st[1] = nx; }
        const unsigned old = xb_add(&bar[XB_XSUB(b.x)], 1u);
        const unsigned gen = old / nloc;
        if (old + 1u == (gen + 1u) * nloc) {
            __builtin_amdgcn_fence(__ATOMIC_RELEASE, "agent");
            asm volatile("s_waitcnt vmcnt(0)" ::: "memory");
            const unsigned og = xb_add(&bar[XB_TOP], 1u);
            const unsigned tg = og / nx;
            if (og + 1u == (tg + 1u) * nx) xb_add(&bar[XB_TOPGEN], 1u);
            else XB_SPIN(xb_ld(&bar[XB_TOPGEN]) == tg, bar);
            __builtin_amdgcn_fence(__ATOMIC_ACQUIRE, "agent");
            xb_add(&bar[XB_XGEN(b.x)], 1u);
            asm volatile("s_waitcnt vmcnt(0)" ::: "memory");
        } else {
            XB_SPIN(xb_ld(&bar[XB_XGEN(b.x)]) == gen, bar);
            __builtin_amdgcn_fence(__ATOMIC_ACQUIRE, "agent");
            asm volatile("s_waitcnt vmcnt(0)" ::: "memory");
        }
    }
    __syncthreads();
}


__global__ __launch_bounds__(512, 2) void mega(const Params p_arg) {
    extern __shared__ __attribute__((aligned(16))) unsigned char shm[];
    const Params& p = *(const Params*)(const void*)__builtin_amdgcn_kernarg_segment_ptr();
    LAS unsigned char* lds = (LAS unsigned char*)shm;
    const int G = (int)gridDim.x, bid = (int)blockIdx.x;
    __shared__ uint4 xb_words;
    if (threadIdx.x == 0) xb_words = make_uint4(0u, 0u, 0u, 0u);
    __syncthreads();
    (void)xcd_barrier_post((unsigned*)(p.ws + WS_BAR), (volatile LAS unsigned*)&xb_words);
    const int step_lo = p.step_lo, step_hi = p.step_hi;
    for (int s = step_lo; s < step_hi; ++s) {
        const int kind = p.kind[s], lo = p.lo[s], hi = p.hi[s];
        switch (kind) {
            case K_PRE0:
#ifndef NO_PRE
 convert_tiles(p, lo, hi, lds); rope_table(p); norm_rows(p.in[0], p.in[1], (bf16_t*)(p.ws + WS_H));
#endif
 break;
            case K_GEMMB:
#ifndef NO_GB

                for (int i = lo; i < hi; ++i) { const GemmOp& o = p.g[i]; pg8::Gemm g; g.A = o.A; g.Bt = o.Bt; g.M = o.M; g.N = o.N; g.K = o.K;
                    pg8::StaticOrder S; S.init(o.M, o.N, G, (bid + G - (o.rot % G)) % G);
                    EpiB E; E.O = (bf16_t*)o.out; E.ldc = o.ldc; E.bias = o.bias; E.act = o.act;
                    pg8::gemm_phase<EpiB, pg8::StaticOrder, false>(lds, g, S, E, nullptr); }
                if (p.chi[s] > p.clo[s]) convert_queue(p, p.clo[s], p.chi[s], (unsigned*)(p.ws + WS_BAR + 16384) + 64 * p.cq[s], lds);
#endif
                break;
            case K_GEMMF:
#ifndef NO_GF

                for (int i = lo; i < hi; ++i) { const GemmOp& o = p.g[i]; pg8::Gemm g; g.A = o.A; g.Bt = o.Bt; g.M = o.M; g.N = o.N; g.K = o.K;
                    pg8::StaticOrder S; S.init(o.M, o.N, G, (bid + G - (o.rot % G)) % G);
                    EpiF E; E.C = (float*)o.out; E.ldc = o.ldc; E.res = o.res;
                    pg8::gemm_phase<EpiF, pg8::StaticOrder, false>(lds, g, S, E, nullptr); }
#endif
                break;
            case K_CONVSSD:
#ifndef NO_CONV
 conv_ssd(p);
#endif
 break;
            case K_MIX0:

#ifndef NO_SSD
for (int j = bid; j < 256; j += G) ssd_chunk_job(p, j, lds);
#endif


#ifndef NO_ATT
for (int j = bid; j < 512; j += G) attn_job(p, j, lds);
#endif

                break;
            case K_POST0: post_ssd(p); break;
            case K_NORM: norm_rows(p.out, p.in[2] + lo * D, (bf16_t*)(p.ws + WS_H)); break;
            case K_PRE1: convert_tiles(p, lo, hi, lds); mix_rows(p.out, p.in[1] + D, p.in[16], (bf16_t*)(p.ws + WS_MIX), 0, lds); break;
            case K_MIXES: mix_rows(p.out, p.in[1] + D, p.in[16], (bf16_t*)(p.ws + WS_MIX), 8192, lds); break;
            case K_RWKV:
#ifndef NO_RWKV
 for (int j = bid; j < 256; j += G) rwkv_chunk_job(p, j, lds);
#endif
 break;
            case K_NORMCONV: convert_tiles(p, lo, hi, lds); norm_rows(p.out, p.in[2] + D, (bf16_t*)(p.ws + WS_H)); break;
            default: break;
        }
        if (s + 1 < step_hi) { if (step_hi < 0) cg::this_grid().sync();   XcdBarrier xb; xb.bar = (unsigned*)(p.ws + WS_BAR); xb.x = xb_xcc_id(); xb.st = (volatile LAS unsigned*)&xb_words; xcd_barrier(xb); }
    }
}

#ifndef MK_MULTI
#define MK_MULTI 0
#endif
extern "C" void kernel_launch(void* const* d_in, const int* in_sizes, int n_in, void* d_out, int out_size, void* d_ws, size_t ws_size, hipStream_t stream) {
    static int grid = 0;
    if (grid == 0) {
        int dev = 0, cus = 0, per_cu = 0;
        hipGetDevice(&dev); hipDeviceGetAttribute(&cus, hipDeviceAttributeMultiprocessorCount, dev);
        if (hipFuncSetAttribute((const void*)mega, hipFuncAttributeMaxDynamicSharedMemorySize, LDS_BYTES) != hipSuccess) { fprintf(stderr, "hipFuncSetAttribute failed\n"); grid = -1; return; }
        if (hipOccupancyMaxActiveBlocksPerMultiprocessor(&per_cu, (const void*)mega, 512, LDS_BYTES) != hipSuccess || per_cu < 1) { fprintf(stderr, "occupancy query: %d\n", per_cu); per_cu = 1; }
        (void)hipGetLastError();
        grid = cus * per_cu; if (grid > 256) grid = 256;
        if (n_in != 34 || ws_size < 512 * MiB) { fprintf(stderr, "unexpected n_in %d / ws %zu\n", n_in, ws_size); grid = -1; return; }
    }
    if (grid < 0) return;
    static Params p;
    memset(&p, 0, sizeof(p));
    for (int i = 0; i < 34; ++i) p.in[i] = (const float*)d_in[i];
    p.out = (float*)d_out; p.ws = (unsigned char*)d_ws;
    unsigned char* ws = (unsigned char*)d_ws;
    auto B16 = [&](size_t off) { return (bf16_t*)(ws + off); };
    int ncj = 0, tile_acc = 0;
    auto CJ = [&](const float* src, size_t dst_off, int K, int N, int Kpad, int Npad) { ConvJob& c = p.cj[ncj++]; c.src = src; c.dst = B16(dst_off); c.K = K; c.N = N; c.Kpad = Kpad; c.Npad = Npad; c.tile0 = tile_acc; c.ntiles = (Kpad / 64) * (Npad / 256); tile_acc += c.ntiles; };
    const float* w_up = p.in[3]; const float* w_down = p.in[4];
    tile_acc = 0;
    CJ(p.in[5], WS_WBA, 2048, 4112, 2048, 4352); CJ(p.in[15], WS_WBA + 17 * MiB, 2048, 2048, 2048, 2048);
    tile_acc = 0;
    CJ(w_up, WS_WMLP, 2048, 8192, 2048, 8192); CJ(w_down, WS_WMLP + 32 * MiB, 8192, 2048, 8192, 2048);
    tile_acc = 0;
    CJ(p.in[28], WS_WBA, 2048, 2048, 2048, 2048); CJ(p.in[29], WS_WBA + 8 * MiB, 2048, 2048, 2048, 2048); CJ(p.in[30], WS_WBA + 16 * MiB, 2048, 2048, 2048, 2048); CJ(p.in[31], WS_WBA + 24 * MiB, 2048, 2048, 2048, 2048);
    CJ(p.in[18], WS_WBA + 32 * MiB, 2048, 96, 2048, 256); CJ(p.in[21], WS_WBA + 33 * MiB, 2048, 96, 2048, 256); CJ(p.in[23], WS_WBA + 34 * MiB, 2048, 256, 2048, 256);
    CJ(p.in[19], WS_WBA + 35 * MiB, 96, 2048, 256, 2048); CJ(p.in[22], WS_WBA + 36 * MiB, 96, 2048, 256, 2048); CJ(p.in[24], WS_WBA + 37 * MiB, 256, 2048, 256, 2048);
    tile_acc = 0;
    CJ(w_up + (size_t)2048 * 8192, WS_WMLP1, 2048, 8192, 2048, 8192); CJ(w_down + (size_t)2048 * 8192, WS_WMLP1 + 32 * MiB, 8192, 2048, 8192, 2048);
    int nop = 0;
    auto GO = [&](const bf16_t* A, const bf16_t* Bt, void* out, const float* bias, const float* res, int M, int N, int K, int ldc, int act, int rot) {
        GemmOp& o = p.g[nop++]; o.A = A; o.Bt = Bt; o.out = out; o.bias = bias; o.res = res; o.M = M; o.N = N; o.K = K; o.ldc = ldc; o.act = act; o.rot = rot; };
    GO(B16(WS_H), B16(WS_WBA), B16(WS_PROJ), nullptr, nullptr, MTOK, INWP, 2048, INWP, 0, 0);
    GO(B16(WS_YMIX), B16(WS_WBA + 17 * MiB), d_out, nullptr, p.in[0], MTOK, 2048, 2048, 2048, 0, 0);
    GO(B16(WS_H), B16(WS_WMLP), B16(WS_U), nullptr, nullptr, MTOK, DFF, 2048, DFF, 1, 0);
    GO(B16(WS_U), B16(WS_WMLP + 32 * MiB), d_out, nullptr, (const float*)d_out, MTOK, 2048, DFF, 2048, 0, 0);
    for (int half = 0; half < 2; ++half) {
        const size_t ro = (size_t)half * 8192 * 2048 * 2, lo_ = (size_t)half * 8192 * 256 * 2; const size_t mb = (size_t)8192 * 2048 * 2;
        GO(B16(WS_MIX + 0 * mb), B16(WS_WBA), B16(WS_R + ro), nullptr, nullptr, 8192, 2048, 2048, 2048, 0, 0);
        GO(B16(WS_MIX + 2 * mb), B16(WS_WBA + 8 * MiB), B16(WS_K + ro), nullptr, nullptr, 8192, 2048, 2048, 2048, 0, 0);
        GO(B16(WS_MIX + 3 * mb), B16(WS_WBA + 16 * MiB), B16(WS_V + ro), nullptr, nullptr, 8192, 2048, 2048, 2048, 0, 0);
        GO(B16(WS_MIX + 1 * mb), B16(WS_WBA + 32 * MiB), B16(WS_L1W + lo_), nullptr, nullptr, 8192, 256, 2048, 256, 2, 0);
        GO(B16(WS_MIX + 4 * mb), B16(WS_WBA + 33 * MiB), B16(WS_L1A + lo_), nullptr, nullptr, 8192, 256, 2048, 256, 0, 32);
        GO(B16(WS_MIX + 5 * mb), B16(WS_WBA + 34 * MiB), B16(WS_L1G + lo_), nullptr, nullptr, 8192, 256, 2048, 256, 3, 64);
    }
    GO(B16(WS_L1W), B16(WS_WBA + 35 * MiB), B16(WS_WDEC), p.in[17], nullptr, MTOK, 2048, 256, 2048, 4, 0);
    GO(B16(WS_L1A), B16(WS_WBA + 36 * MiB), B16(WS_AA), p.in[20], nullptr, MTOK, 2048, 256, 2048, 3, 0);
    GO(B16(WS_L1G), B16(WS_WBA + 37 * MiB), B16(WS_GG), nullptr, nullptr, MTOK, 2048, 256, 2048, 0, 0);
    GO(B16(WS_YG), B16(WS_WBA + 24 * MiB), d_out, nullptr, (const float*)d_out, MTOK, 2048, 2048, 2048, 0, 0);
    GO(B16(WS_H), B16(WS_WMLP1), B16(WS_U), nullptr, nullptr, MTOK, DFF, 2048, DFF, 1, 0);
    GO(B16(WS_U), B16(WS_WMLP1 + 32 * MiB), d_out, nullptr, (const float*)d_out, MTOK, 2048, DFF, 2048, 0, 0);
    int ns = 0;
    auto ST = [&](int kind, int lo, int hi, int clo = 0, int chi = 0, int cq = 0) { p.kind[ns] = kind; p.lo[ns] = lo; p.hi[ns] = hi; p.clo[ns] = clo; p.chi[ns] = chi; p.cq[ns] = cq; ++ns; };
    ST(K_PRE0, 0, 2); ST(K_GEMMB, 0, 1, 2, 4, 0); ST(K_CONVSSD, 0, 0); ST(K_MIX0, 0, 0); ST(K_POST0, 0, 0); ST(K_GEMMF, 1, 2); ST(K_NORM, 0, 0); ST(K_GEMMB, 2, 3); ST(K_GEMMF, 3, 4);
    ST(K_PRE1, 4, 14); ST(K_GEMMB, 4, 10, 14, 16, 1); ST(K_MIXES, 0, 0); ST(K_GEMMB, 10, 16, 14, 16, 1); ST(K_GEMMB, 16, 19); ST(K_RWKV, 0, 0); ST(K_GEMMF, 19, 20); ST(K_NORM, 1, 0); ST(K_GEMMB, 20, 21); ST(K_GEMMF, 21, 22);
    (void)hipMemsetAsync(ws + WS_BAR, 0, 16384 + 1024, stream);
#if MK_MULTI
    for (int s = 0; s < ns; ++s) { p.step_lo = s; p.step_hi = s + 1; hipLaunchKernelGGL(mega, dim3(grid), dim3(512), LDS_BYTES, stream, p); }
#else
    p.step_lo = 0; p.step_hi = ns;
    void* args[] = {(void*)&p};
    const hipError_t e = hipLaunchCooperativeKernel((const void*)mega, dim3(grid), dim3(512), args, LDS_BYTES, stream);
    if (e != hipSuccess) fprintf(stderr, "cooperative launch failed: %s (grid %d)\n", hipGetErrorString(e), grid);
#endif
}
```

```cpp
#include <hip/hip_runtime.h>
#include <hip/hip_cooperative_groups.h>
#include <cstdio>
#include <cstring>
namespace cg = cooperative_groups;
__device__ __forceinline__ int opq(int v) { asm volatile("" : "+v"(v)); return v; }
namespace pg8 {
#define PG8_LAS __attribute__((address_space(3)))
typedef unsigned short bf16_t;
typedef short bf16x8 __attribute__((ext_vector_type(8)));
typedef float f32x4 __attribute__((ext_vector_type(4)));
typedef unsigned u32x4 __attribute__((ext_vector_type(4)));
constexpr int BM = 256, BK = 64, HALF = 128, HTB = HALF * BK * 2  , STAGE_BYTES = 8 * HTB, NXCD = 8, WGM = 8;

__host__ __device__ __forceinline__ int lds_byte(int r, int c) { const int st = (r >> 4) * 2 + (c >> 5), rr = r & 15, cc = c & 31, ob = rr * 64 + cc * 2; return st * 1024 + (ob ^ (((ob >> 9) & 1) << 5)); }
__host__ __device__ __forceinline__ void stage_rc(int b, int& R, int& C) { const int st = b / 1024, sb = b % 1024, swz = sb ^ (((sb >> 9) & 1) << 5); R = (st >> 1) * 16 + swz / 64; C = (st & 1) * 32 + (swz % 64) / 2; }
__host__ __device__ __forceinline__ int perm32(int rho) { const int n = rho >> 4, i = rho & 15; return 8 * (i >> 2) + 4 * n + (i & 3); }

struct Unit { int pm, pn; };
struct Gemm { const bf16_t* A; const bf16_t* Bt; int M, N, K; };

struct StaticOrder {
    int nM, nN, nwg, G, c;
    __host__ __device__ void init(int M, int N, int G_, int c_) { nM = M / BM; nN = N / BM; nwg = nM * nN; G = G_; c = c_; }
    __host__ __device__ bool next(int i, Unit& u) const {
        const long L = (long)i * G + c; if (L >= nwg) return false;
        int wgid = (int)L; { const int q = nwg / NXCD, r = nwg % NXCD, xcd = wgid % NXCD, off = wgid / NXCD; wgid = (xcd < r ? xcd * (q + 1) : r * (q + 1) + (xcd - r) * q) + off; }
        const int nig = WGM * nN, gid = wgid / nig, fm = gid * WGM, gsz = (nM - fm) < WGM ? (nM - fm) : WGM;
        u.pm = fm + ((wgid % nig) % gsz); u.pn = (wgid % nig) / gsz; return true;
    }
    __device__ __forceinline__ void a_ready(const Unit&) const {}
    __device__ __forceinline__ void done(const Unit&) const {}
};
typedef __bf16 bf16x2_t __attribute__((ext_vector_type(2)));
typedef float f32x2_t __attribute__((ext_vector_type(2)));
__device__ __forceinline__ unsigned cvt_pk_bf16(float lo, float hi) { const f32x2_t f = {lo, hi}; const bf16x2_t v = __builtin_convertvector(f, bf16x2_t); return __builtin_bit_cast(unsigned, v); }
__device__ __forceinline__ unsigned cvt_pk_nv(float lo, float hi) { return cvt_pk_bf16(lo, hi); }

template <class Epi, class Sched, bool STAMP = false>
__device__ __forceinline__ void gemm_phase(PG8_LAS unsigned char* lds, const Gemm g, const Sched& S, const Epi& E, unsigned long long* stamps) {
    const int tid = opq(threadIdx.x), wid = __builtin_amdgcn_readfirstlane(tid >> 6), lane = tid & 63, wr = wid >> 2, wc = wid & 3, fr = lane & 15, fq = lane >> 4;
    const int K = g.K, nt = K / BK;
    int ts_lo = 0, ts_hi = 0, nts = 0; const unsigned long long rt_entry = STAMP ? (unsigned long long)wall_clock64() : 0ull;
#define PG8_STAMP() do { if (STAMP && wid == 0 && nts < 64) { const unsigned long long _c = (unsigned long long)clock64(); \
        ts_lo = (lane == nts) ? (int)(unsigned)_c : ts_lo; ts_hi = (lane == nts) ? (int)(unsigned)(_c >> 32) : ts_hi; ++nts; } } while (0)
    PG8_STAMP();
    unsigned voffA[2], voffB[2];
#pragma unroll
    for (int i = 0; i < 2; ++i) { int R, C; stage_rc(tid * 16 + i * 8192, R, C); const int Rb = Epi::PERM ? ((R & ~31) + perm32(R & 31)) : R;
        voffA[i] = (unsigned)(R * K + C) * 2u; voffB[i] = (unsigned)(Rb * K + C) * 2u; }
    const size_t kstep = (size_t)(BK * 2);
    const size_t hstep = (size_t)HALF * K * 2;
    const size_t tstep = 2 * hstep;
    const unsigned ldsw = (unsigned)wid * 1024u;
    const int aoff = lds_byte(wr * 64 + fr, fq * 8), boff = lds_byte(wc * 32 + fr, fq * 8);
#define PG8_SA(b, h) (((b) * 2 + (h)) * HTB)
#define PG8_SB(b, h) ((4 + (b) * 2 + (h)) * HTB)
#define PG8_STAGE(bufoff, gbase, voff) do { _Pragma("unroll") for (int _i = 0; _i < 2; ++_i) \
        __builtin_amdgcn_global_load_lds((const unsigned*)((const char*)(gbase) + (voff)[_i]), (PG8_LAS unsigned*)(lds + (bufoff) + ldsw + _i * 8192), 16, 0, 0); } while (0)
#define PG8_LDA(dst, b, h) do { _Pragma("unroll") for (int m = 0; m < 4; ++m) _Pragma("unroll") for (int k = 0; k < 2; ++k) dst[m][k] = *(const PG8_LAS bf16x8*)(lds + PG8_SA(b, h) + aoff + m * 2048 + k * 1024); } while (0)
#define PG8_LDB(dst, b, h) do { _Pragma("unroll") for (int n = 0; n < 2; ++n) _Pragma("unroll") for (int k = 0; k < 2; ++k) dst[n][k] = *(const PG8_LAS bf16x8*)(lds + PG8_SB(b, h) + boff + n * 2048 + k * 1024); } while (0)
#define PG8_MMA(ai, bj, At, Bt) do { __builtin_amdgcn_s_setprio(1); _Pragma("unroll") for (int m = 0; m < 4; ++m) _Pragma("unroll") for (int n = 0; n < 2; ++n) _Pragma("unroll") for (int k = 0; k < 2; ++k) \
        acc[ai][bj][m][n] = __builtin_amdgcn_mfma_f32_16x16x32_bf16(Bt[n][k], At[m][k], acc[ai][bj][m][n], 0, 0, 0); __builtin_amdgcn_s_setprio(0); } while (0)
#define PG8_WAIT_V(n) asm volatile("s_waitcnt vmcnt(" #n ")" ::: "memory")
#define PG8_WAIT_L(n) asm volatile("s_waitcnt lgkmcnt(" #n ")" ::: "memory")
#define PG8_BAR __builtin_amdgcn_s_barrier()
#define PG8_SCHED __builtin_amdgcn_sched_barrier(0)
    Unit cur, nxt; int ui = 0;
    if (!S.next(0, cur)) return;
    f32x4 acc[2][2][4][2];
#pragma unroll
    for (int a = 0; a < 2; ++a)
#pragma unroll
        for (int b = 0; b < 2; ++b)
#pragma unroll
            for (int m = 0; m < 4; ++m)
#pragma unroll
                for (int n = 0; n < 2; ++n) acc[a][b][m][n] = (f32x4){0.f, 0.f, 0.f, 0.f};
    bf16x8 At[4][2], B0[2][2], B1[2][2];
    const char* cA = (const char*)g.A + (size_t)cur.pm * tstep; const char* cB = (const char*)g.Bt + (size_t)cur.pn * tstep;
    S.a_ready(cur);
    PG8_STAGE(PG8_SB(0, 0), cB, voffB); PG8_STAGE(PG8_SA(0, 0), cA, voffA); PG8_STAGE(PG8_SB(0, 1), cB + hstep, voffB); PG8_STAGE(PG8_SA(0, 1), cA + hstep, voffA);
    if (wr == 1) PG8_BAR;
    PG8_WAIT_V(4); PG8_BAR;
    PG8_STAGE(PG8_SB(1, 0), cB + kstep, voffB); PG8_STAGE(PG8_SA(1, 0), cA + kstep, voffA); PG8_STAGE(PG8_SB(1, 1), cB + hstep + kstep, voffB);
    PG8_WAIT_V(6); PG8_BAR;
    PG8_STAMP();
    for (;;) {
        const bool has_next = S.next(ui + 1, nxt);
        const char* nA = has_next ? (const char*)g.A + (size_t)nxt.pm * tstep : cA; const char* nB = has_next ? (const char*)g.Bt + (size_t)nxt.pn * tstep : cB;
        for (int t = 0; t < nt; t += 2) {
            const bool last = (t == nt - 2);
            const char* a1 = cA + (size_t)(t + 1) * kstep;
            const char* a2 = last ? nA : cA + (size_t)(t + 2) * kstep; const char* b2 = last ? nB : cB + (size_t)(t + 2) * kstep;
            const char* a3 = a2 + kstep; const char* b3 = b2 + kstep;
            if (last && has_next) S.a_ready(nxt);
            PG8_LDB(B0, 0, 0); PG8_SCHED; PG8_LDA(At, 0, 0); PG8_STAGE(PG8_SA(1, 1), a1 + hstep, voffA);
            PG8_WAIT_L(8); PG8_BAR; PG8_WAIT_L(0); PG8_MMA(0, 0, At, B0); PG8_BAR; PG8_SCHED;
            PG8_LDB(B1, 0, 1); PG8_STAGE(PG8_SB(0, 0), b2, voffB);
            PG8_BAR; PG8_WAIT_L(0); PG8_MMA(0, 1, At, B1); PG8_BAR;
            PG8_LDA(At, 0, 1); PG8_STAGE(PG8_SA(0, 0), a2, voffA);
            PG8_BAR; PG8_WAIT_L(0); PG8_MMA(1, 0, At, B0); PG8_BAR; PG8_SCHED;
            PG8_STAGE(PG8_SB(0, 1), b2 + hstep, voffB);
            PG8_WAIT_V(6); PG8_BAR; PG8_MMA(1, 1, At, B1); PG8_BAR;
            PG8_LDB(B0, 1, 0); PG8_SCHED; PG8_LDA(At, 1, 0); PG8_STAGE(PG8_SA(0, 1), a2 + hstep, voffA);
            PG8_WAIT_L(8); PG8_BAR; PG8_WAIT_L(0); PG8_MMA(0, 0, At, B0); PG8_BAR; PG8_SCHED;
            PG8_LDB(B1, 1, 1); PG8_STAGE(PG8_SB(1, 0), b3, voffB);
            PG8_BAR; PG8_WAIT_L(0); PG8_MMA(0, 1, At, B1); PG8_BAR;
            PG8_LDA(At, 1, 1); PG8_STAGE(PG8_SA(1, 0), a3, voffA);
            PG8_BAR; PG8_WAIT_L(0); PG8_MMA(1, 0, At, B0); PG8_BAR; PG8_SCHED;
            PG8_STAGE(PG8_SB(1, 1), b3 + hstep, voffB);
            PG8_WAIT_V(6); PG8_BAR; PG8_MMA(1, 1, At, B1); PG8_BAR;
        }
        PG8_STAMP();
        if constexpr (!Epi::AFTER_DRAIN) { E(acc, cur, wr, wc, fr, fq); S.done(cur); }
        PG8_STAMP();
        if (!has_next) break;
#pragma unroll
        for (int a = 0; a < 2; ++a)
#pragma unroll
            for (int b = 0; b < 2; ++b)
#pragma unroll
                for (int m = 0; m < 4; ++m)
#pragma unroll
                    for (int n = 0; n < 2; ++n) acc[a][b][m][n] = (f32x4){0.f, 0.f, 0.f, 0.f};
        cur = nxt; cA = nA; cB = nB; ++ui;
    }
    PG8_WAIT_V(0);
    if (wr == 0) PG8_BAR;
    PG8_BAR;
    if constexpr (Epi::AFTER_DRAIN) { E.fused(acc, cur, wr, wc, fr, fq, lds, wid, lane); S.done(cur); }
    PG8_STAMP();
    if (STAMP && wid == 0) { stamps[lane] = lane < nts ? (((unsigned long long)(unsigned)ts_hi << 32) | (unsigned)ts_lo) : 0ull;
        if (lane == 62) stamps[62] = rt_entry; if (lane == 63) stamps[63] = (unsigned long long)wall_clock64(); }
#undef PG8_STAMP
#undef PG8_SA
#undef PG8_SB
#undef PG8_STAGE
#undef PG8_LDA
#undef PG8_LDB
#undef PG8_MMA
#undef PG8_WAIT_V
#undef PG8_WAIT_L
#undef PG8_BAR
#undef PG8_SCHED
}
}

#include <cstdio>
#include <ctime>
#include <cstdlib>
#include <cstring>
#include <cmath>
#include <vector>
#include <algorithm>
#define CK(x) do { hipError_t e_ = (x); if (e_ != hipSuccess) { fprintf(stderr, "HIP %s:%d %s\n", __FILE__, __LINE__, hipGetErrorString(e_)); exit(2); } } while (0)
using pg8::bf16_t; using pg8::bf16x8; using pg8::f32x4; using pg8::u32x4; using pg8::cvt_pk_bf16; using pg8::cvt_pk_nv;
#define LAS PG8_LAS

constexpr int D = 2048, SEQ = 2048, MTOK = 16384, DFF = 8192, INWP = 4352;
constexpr int COL_K = 1024, COL_V = 1280, COL_Z = 1536, COL_XBC = 2560, COL_DT = 4096;
constexpr size_t MiB = (size_t)1 << 20;
constexpr size_t WS_WBA = 0, WS_WMLP = 40 * MiB, WS_H = 104 * MiB, WS_PROJ = 168 * MiB, WS_YMIX = 304 * MiB, WS_YRAW = 368 * MiB, WS_XBC = 432 * MiB,
                 WS_DT = 480 * MiB, WS_DA = 481 * MiB, WS_ROPE = 482 * MiB, WS_U = 168 * MiB;
constexpr size_t WS_R = 40 * MiB, WS_K = 104 * MiB, WS_V = 168 * MiB, WS_L1W = 232 * MiB, WS_L1A = 240 * MiB, WS_L1G = 248 * MiB, WS_MIX = 256 * MiB,
                 WS_WDEC = 256 * MiB, WS_AA = 320 * MiB, WS_GG = 384 * MiB, WS_YG = 40 * MiB  , WS_WMLP1 = 448 * MiB;
constexpr size_t WS_BAR = 39 * MiB;
constexpr int LDS_BYTES = 140 * 1024;

enum { K_PRE0 = 0, K_GEMMB, K_GEMMF, K_CONVSSD, K_MIX0, K_POST0, K_NORM, K_PRE1, K_MIXES, K_RWKV, K_NORMCONV };
constexpr int NSTEPS = 48, NOPS = 22, NCJ = 16;
#define REP_GEMMB 1
#define REP_MIX0 1
#define REP_RWKV 1
#define REP_ELEM 1

struct GemmOp { const bf16_t* A; const bf16_t* Bt; void* out; const float* bias; const float* res; int M, N, K, ldc, act, rot, pad0, pad1; };
struct ConvJob { const float* src; bf16_t* dst; int K, N, Kpad, Npad, tile0, ntiles; };
struct Params {
    const float* in[34];
    float* out; unsigned char* ws;
    GemmOp g[NOPS];
    ConvJob cj[NCJ];
    int kind[NSTEPS + 1]; int lo[NSTEPS + 1]; int hi[NSTEPS + 1]; int clo[NSTEPS + 1]; int chi[NSTEPS + 1]; int cq[NSTEPS + 1];
    int step_lo, step_hi;
};

__device__ __forceinline__ float bf2f(unsigned short b) { return __uint_as_float(((unsigned)b) << 16); }
__device__ __forceinline__ float bflo(unsigned w) { return __uint_as_float(w << 16); }
__device__ __forceinline__ float bfhi(unsigned w) { return __uint_as_float(w & 0xffff0000u); }
__device__ __forceinline__ bf16_t f2bf(float f) { return (bf16_t)(cvt_pk_bf16(f, 0.f) & 0xffffu); }
template <int CTRL> __device__ __forceinline__ float dpp_add(float x) {
    const int y = __builtin_amdgcn_update_dpp(0, __builtin_bit_cast(int, x), CTRL, 0xf, 0xf, true);
    return x + __builtin_bit_cast(float, y); }
template <int CTRL> __device__ __forceinline__ float dpp_max(float x) {
    const int y = __builtin_amdgcn_update_dpp(0, __builtin_bit_cast(int, x), CTRL, 0xf, 0xf, true);
    return fmaxf(x, __builtin_bit_cast(float, y)); }
__device__ __forceinline__ float max16(float x) { x = dpp_max<0xB1>(x); x = dpp_max<0x4E>(x); x = dpp_max<0x141>(x); x = dpp_max<0x140>(x); return x; }
__device__ __forceinline__ float red8(float x) { x = dpp_add<0xB1>(x); x = dpp_add<0x4E>(x); x = dpp_add<0x141>(x); return x; }
__device__ __forceinline__ float red16(float x) { x = red8(x); x = dpp_add<0x140>(x); return x; }
__device__ __forceinline__ float wave_sum(float v) {
    v = red16(v);
    const float r0 = __builtin_bit_cast(float, __builtin_amdgcn_readlane(__builtin_bit_cast(int, v), 0)), r1 = __builtin_bit_cast(float, __builtin_amdgcn_readlane(__builtin_bit_cast(int, v), 16));
    const float r2 = __builtin_bit_cast(float, __builtin_amdgcn_readlane(__builtin_bit_cast(int, v), 32)), r3 = __builtin_bit_cast(float, __builtin_amdgcn_readlane(__builtin_bit_cast(int, v), 48));
    return (r0 + r1) + (r2 + r3); }
typedef float f32x2 __attribute__((ext_vector_type(2)));
typedef unsigned u32x2 __attribute__((ext_vector_type(2)));
__device__ __forceinline__ float sigmoidf_(float v) { return 1.0f / (1.0f + __expf(-v)); }
__device__ __forceinline__ void unpack8(const uint4 r, float (&f)[8]) {
    f[0] = bflo(r.x); f[1] = bfhi(r.x); f[2] = bflo(r.y); f[3] = bfhi(r.y); f[4] = bflo(r.z); f[5] = bfhi(r.z); f[6] = bflo(r.w); f[7] = bfhi(r.w); }

__device__ __forceinline__ float act_apply(float v, int act) {
    switch (act) {
        case 1: { const float r = fmaxf(v, 0.f); return r * r; }
        case 2: return 1.0f - 2.0f / (1.0f + __expf(2.0f * v));
        case 3: return sigmoidf_(v);
        case 4: return 0.60653066f * sigmoidf_(v);
        default: return v; }
}
struct EpiB {
    static constexpr bool PERM = true, AFTER_DRAIN = false;
    bf16_t* O; int ldc; const float* bias; int act;
    __device__ __forceinline__ void operator()(const f32x4 (&acc)[2][2][4][2], const pg8::Unit& u, int wr, int wc, int fr, int fq) const {
        const int row0 = u.pm * 256 + wr * 64 + fr, col0 = u.pn * 256 + wc * 32 + 8 * fq;
#pragma unroll
        for (int ai = 0; ai < 2; ++ai)
#pragma unroll
            for (int m = 0; m < 4; ++m) { bf16_t* rowp = O + (size_t)(row0 + ai * 128 + m * 16) * ldc + col0;
#pragma unroll
                for (int bj = 0; bj < 2; ++bj) { f32x4 v0 = acc[ai][bj][m][0], v1 = acc[ai][bj][m][1];
                    if (bias) { v0 += *(const f32x4*)(bias + col0 + bj * 128); v1 += *(const f32x4*)(bias + col0 + bj * 128 + 4); }
                    if (act) {
#pragma unroll
                        for (int j = 0; j < 4; ++j) { v0[j] = act_apply(v0[j], act); v1[j] = act_apply(v1[j], act); } }
                    u32x4 w; w.x = cvt_pk_bf16(v0[0], v0[1]); w.y = cvt_pk_bf16(v0[2], v0[3]); w.z = cvt_pk_bf16(v1[0], v1[1]); w.w = cvt_pk_bf16(v1[2], v1[3]);
                    *(u32x4*)(rowp + bj * 128) = w; } }
    }
};
struct EpiF {
    static constexpr bool PERM = false, AFTER_DRAIN = false;
    float* C; int ldc; const float* res;
    __device__ __forceinline__ void operator()(const f32x4 (&acc)[2][2][4][2], const pg8::Unit& u, int wr, int wc, int fr, int fq) const {
        const int row0 = u.pm * 256 + wr * 64 + fr, col0 = u.pn * 256 + wc * 32 + 4 * fq;
#pragma unroll
        for (int ai = 0; ai < 2; ++ai)
#pragma unroll
            for (int m = 0; m < 4; ++m) { const size_t ro = (size_t)(row0 + ai * 128 + m * 16) * ldc + col0;
#pragma unroll
                for (int bj = 0; bj < 2; ++bj)
#pragma unroll
                    for (int n = 0; n < 2; ++n) { const f32x4 r = *(const f32x4*)(res + ro + bj * 128 + n * 16); *(f32x4*)(C + ro + bj * 128 + n * 16) = acc[ai][bj][m][n] + r; } }
    }
};

__device__ __forceinline__ void convert_one_tile(const Params& p, int jlo, int jhi, int tile, int tid, LAS float* T) {
    int j = jlo; while (j + 1 < jhi && tile >= p.cj[j + 1].tile0) ++j;
    const float* src = p.cj[j].src; bf16_t* dst = p.cj[j].dst; const int K = p.cj[j].K, N = p.cj[j].N, Kpad = p.cj[j].Kpad;
    const int local = tile - p.cj[j].tile0, nkt = Kpad >> 6, kt = local % nkt, nt = local / nkt;
    f32x4 v[8];
#pragma unroll
    for (int i = 0; i < 8; ++i) { const int idx = tid + i * 512, kr = idx >> 6, c4 = idx & 63, k = kt * 64 + kr, n = nt * 256 + c4 * 4;
        v[i] = (f32x4){0.f, 0.f, 0.f, 0.f};
        if (k < K && n < N) v[i] = *(const f32x4*)(src + (size_t)k * N + n); }
#pragma unroll
    for (int i = 0; i < 8; ++i) { const int idx = tid + i * 512, kr = idx >> 6, c4 = idx & 63;
        T[kr * 257 + c4 * 4 + 0] = v[i][0]; T[kr * 257 + c4 * 4 + 1] = v[i][1]; T[kr * 257 + c4 * 4 + 2] = v[i][2]; T[kr * 257 + c4 * 4 + 3] = v[i][3]; }
    __syncthreads();
#pragma unroll
    for (int i = 0; i < 4; ++i) { const int idx = tid + i * 512, nl = idx >> 3, kc = idx & 7; float f[8];
#pragma unroll
        for (int e = 0; e < 8; ++e) f[e] = T[(kc * 8 + e) * 257 + nl];
        u32x4 w; w.x = cvt_pk_nv(f[0], f[1]); w.y = cvt_pk_nv(f[2], f[3]); w.z = cvt_pk_nv(f[4], f[5]); w.w = cvt_pk_nv(f[6], f[7]);
        *(u32x4*)(dst + (size_t)(nt * 256 + nl) * Kpad + kt * 64 + kc * 8) = w; }
    __syncthreads();
}
__device__ __forceinline__ void convert_tiles(const Params& p, int jlo, int jhi, LAS unsigned char* lds) {
    const int tid = opq(threadIdx.x); LAS float* T = (LAS float*)lds;
    const int total = p.cj[jhi - 1].tile0 + p.cj[jhi - 1].ntiles;
    for (int tile = blockIdx.x; tile < total; tile += gridDim.x) convert_one_tile(p, jlo, jhi, tile, tid, T);
}
__device__ __forceinline__ void convert_queue(const Params& p, int jlo, int jhi, unsigned* counter, LAS unsigned char* lds) {
    const int tid = opq(threadIdx.x); LAS float* T = (LAS float*)lds; LAS int* slot = (LAS int*)(lds + 72 * 1024);
    const int total = p.cj[jhi - 1].tile0 + p.cj[jhi - 1].ntiles;
    for (;;) {
        __syncthreads();
        if (tid == 0) *slot = (int)__hip_atomic_fetch_add(counter, 1u, __ATOMIC_RELAXED, __HIP_MEMORY_SCOPE_AGENT);
        __syncthreads();
        const int tile = *slot;
        if (tile >= total) break;
        convert_one_tile(p, jlo, jhi, tile, tid, T);
    }
}

__device__ __forceinline__ void rope_table(const Params& p) {
    float2* tab = (float2*)(p.ws + WS_ROPE);
    for (int idx = blockIdx.x * 512 + opq(threadIdx.x); idx < SEQ * 32; idx += gridDim.x * 512) {
        const int t = idx >> 5, i = idx & 31;
        const float inv = exp2f(-(float)i * 0.41524101186092029f);
        const float angf = (float)t * inv;
        const double ang = (double)angf;
        const double q = rint(ang * 0.6366197723675814);
        const float f = (float)fma(-q, 1.5707963267948966, ang), f2 = f * f;
        const float s = f * (1.0f + f2 * (-1.6666667e-1f + f2 * (8.3333333e-3f + f2 * (-1.9841270e-4f + f2 * 2.7557319e-6f))));
        const float c = 1.0f + f2 * (-0.5f + f2 * (4.1666667e-2f + f2 * (-1.3888889e-3f + f2 * (2.4801587e-5f + f2 * (-2.7557319e-7f)))));
        const int qi = ((int)q) & 3;
        const float sn = (qi == 0) ? s : (qi == 1) ? c : (qi == 2) ? -s : -c;
        const float cs = (qi == 0) ? c : (qi == 1) ? -s : (qi == 2) ? -c : s;
        tab[idx] = make_float2(cs, sn);
    }
}

__device__ __forceinline__ void norm_rows(const float* x, const float* g, bf16_t* h) {
    const int tid_ = opq(threadIdx.x); const int lane = tid_ & 63, wv = tid_ >> 6;
    f32x4 gg[8];
#pragma unroll
    for (int i = 0; i < 8; ++i) gg[i] = *(const f32x4*)(g + i * 256 + lane * 4);
    for (int row = (blockIdx.x * 8 + wv) * 2; row < MTOK; row += gridDim.x * 16) {
        const float* xr = x + (size_t)row * D; f32x4 v[8], u[8]; float ss = 0.f, st = 0.f;
#pragma unroll
        for (int i = 0; i < 8; ++i) { v[i] = *(const f32x4*)(xr + i * 256 + lane * 4); u[i] = *(const f32x4*)(xr + D + i * 256 + lane * 4); }
#pragma unroll
        for (int i = 0; i < 8; ++i) { ss += v[i][0] * v[i][0] + v[i][1] * v[i][1] + v[i][2] * v[i][2] + v[i][3] * v[i][3]; st += u[i][0] * u[i][0] + u[i][1] * u[i][1] + u[i][2] * u[i][2] + u[i][3] * u[i][3]; }
        ss = wave_sum(ss); st = wave_sum(st); const float r = rsqrtf(ss * (1.0f / D) + 1e-6f), r2 = rsqrtf(st * (1.0f / D) + 1e-6f);
#pragma unroll
        for (int i = 0; i < 8; ++i) {
            uint2 w; w.x = cvt_pk_nv(v[i][0] * r * gg[i][0], v[i][1] * r * gg[i][1]); w.y = cvt_pk_nv(v[i][2] * r * gg[i][2], v[i][3] * r * gg[i][3]);
            *(uint2*)(h + (size_t)row * D + i * 256 + lane * 4) = w;
            uint2 w2; w2.x = cvt_pk_nv(u[i][0] * r2 * gg[i][0], u[i][1] * r2 * gg[i][1]); w2.y = cvt_pk_nv(u[i][2] * r2 * gg[i][2], u[i][3] * r2 * gg[i][3]);
            *(uint2*)(h + (size_t)(row + 1) * D + i * 256 + lane * 4) = w2; }
    }
}

__device__ __forceinline__ void mix_rows(const float* x, const float* g, const float* mixw, bf16_t* mixbase, int tok0, LAS unsigned char* lds) {
    const int tid = opq(threadIdx.x), lane = tid & 63, wv = tid >> 6, c = tid * 4;
    LAS float* rs = (LAS float*)lds;
    const f32x4 gg = *(const f32x4*)(g + c); f32x4 mw[6];
#pragma unroll
    for (int m = 0; m < 6; ++m) mw[m] = *(const f32x4*)(mixw + m * D + c);
    for (int chunk = blockIdx.x; chunk < 256; chunk += gridDim.x) {
        const int rl0 = chunk * 32, tokc = tok0 + rl0; const bool hasprev = (tokc & (SEQ - 1)) != 0;
        __syncthreads();
        for (int r = wv; r < 33; r += 8) {
            float ss = 0.f;
            if (r > 0 || hasprev) { const float* xr = x + (size_t)(tokc - 1 + r) * D; f32x4 v[8];
#pragma unroll
                for (int i = 0; i < 8; ++i) v[i] = *(const f32x4*)(xr + i * 256 + lane * 4);
#pragma unroll
                for (int i = 0; i < 8; ++i) ss += v[i][0] * v[i][0] + v[i][1] * v[i][1] + v[i][2] * v[i][2] + v[i][3] * v[i][3]; }
            ss = wave_sum(ss);
            if (lane == 0) rs[r] = (r > 0 || hasprev) ? rsqrtf(ss * (1.0f / D) + 1e-6f) : 0.f;
        }
        __syncthreads();
        f32x4 prev = (f32x4){0.f, 0.f, 0.f, 0.f};
        if (hasprev) { const f32x4 pv = *(const f32x4*)(x + (size_t)(tokc - 1) * D + c); const float rp = rs[0]; prev = pv * rp * gg; }
        for (int r0 = 0; r0 < 32; r0 += 4) {
            f32x4 xv[4];
#pragma unroll
            for (int u = 0; u < 4; ++u) xv[u] = *(const f32x4*)(x + (size_t)(tokc + r0 + u) * D + c);
#pragma unroll
            for (int u = 0; u < 4; ++u) { const float rr = rs[r0 + u + 1]; const f32x4 hn = xv[u] * rr * gg, xx = prev - hn;
#pragma unroll
                for (int m = 0; m < 6; ++m) { const f32x4 o = hn + xx * mw[m];
                    uint2 w; w.x = cvt_pk_nv(o[0], o[1]); w.y = cvt_pk_nv(o[2], o[3]);
                    *(uint2*)(mixbase + (size_t)m * 8192 * D + (size_t)(rl0 + r0 + u) * D + c) = w; }
                prev = hn; }
        }
    }
}

__device__ __forceinline__ void conv_ssd(const Params& p) {
    const bf16_t* proj = (const bf16_t*)(p.ws + WS_PROJ); bf16_t* xbc = (bf16_t*)(p.ws + WS_XBC);
    const float* cw = p.in[6]; const float* cb = p.in[7];
    const int tid = opq(threadIdx.x);
    if (tid < 384) {
        const int c8 = tid % 192, par = tid / 192, c = c8 * 8;
        float w[4][8], bb[8];
#pragma unroll
        for (int j = 0; j < 4; ++j) { const f32x4 w0 = *(const f32x4*)(cw + j * 1536 + c), w1 = *(const f32x4*)(cw + j * 1536 + c + 4);
#pragma unroll
            for (int e = 0; e < 4; ++e) { w[j][e] = w0[e]; w[j][4 + e] = w1[e]; } }
        { const f32x4 b0 = *(const f32x4*)(cb + c), b1 = *(const f32x4*)(cb + c + 4);
#pragma unroll
          for (int e = 0; e < 4; ++e) { bb[e] = b0[e]; bb[4 + e] = b1[e]; } }
        for (int chunk = blockIdx.x; chunk < 256; chunk += gridDim.x) {
            const int t0 = chunk * 64 + par * 32; const bool hasprev = (t0 & (SEQ - 1)) != 0;
            float r0[8], r1[8], r2[8];
            if (hasprev) { const uint4 a = *(const uint4*)(proj + (size_t)(t0 - 3) * INWP + COL_XBC + c), b = *(const uint4*)(proj + (size_t)(t0 - 2) * INWP + COL_XBC + c), d = *(const uint4*)(proj + (size_t)(t0 - 1) * INWP + COL_XBC + c);
                unpack8(a, r0); unpack8(b, r1); unpack8(d, r2); }
            else {
#pragma unroll
                for (int e = 0; e < 8; ++e) { r0[e] = 0.f; r1[e] = 0.f; r2[e] = 0.f; } }
            for (int tg = 0; tg < 32; tg += 4) {
                uint4 rw[4];
#pragma unroll
                for (int u = 0; u < 4; ++u) rw[u] = *(const uint4*)(proj + (size_t)(t0 + tg + u) * INWP + COL_XBC + c);
#pragma unroll
                for (int u = 0; u < 4; ++u) { float cur[8], acc[8]; unpack8(rw[u], cur);
#pragma unroll
                    for (int e = 0; e < 8; ++e) { acc[e] = bb[e] + w[0][e] * r0[e] + w[1][e] * r1[e] + w[2][e] * r2[e] + w[3][e] * cur[e]; acc[e] = acc[e] * sigmoidf_(acc[e]); r0[e] = r1[e]; r1[e] = r2[e]; r2[e] = cur[e]; }
                    u32x4 o; o.x = cvt_pk_nv(acc[0], acc[1]); o.y = cvt_pk_nv(acc[2], acc[3]); o.z = cvt_pk_nv(acc[4], acc[5]); o.w = cvt_pk_nv(acc[6], acc[7]);
                    *(u32x4*)(xbc + (size_t)(t0 + tg + u) * 1536 + c) = o; }
            }
        }
    }
    float* dt = (float*)(p.ws + WS_DT); float* da = (float*)(p.ws + WS_DA);
    for (int idx = blockIdx.x * 512 + opq(threadIdx.x); idx < MTOK * 16; idx += gridDim.x * 512) {
        const int tok = idx >> 4, hh = idx & 15;
        const float v = bf2f(proj[(size_t)tok * INWP + COL_DT + hh]) + p.in[8][hh];
        const float d = fmaxf(v, 0.f) + __logf(1.0f + __expf(-fabsf(v)));
        dt[idx] = d; da[idx] = __expf(-d * __expf(p.in[9][hh]));
    }
}

__device__ __forceinline__ void ssd_scan_job(const Params& p, int job, LAS unsigned char* lds) {
    const int tid = opq(threadIdx.x);
    const int b = job >> 5, hs = (job >> 1) & 15, half = job & 1, grp = hs >> 3, p0 = half * 32;
    const bf16_t* xbc = (const bf16_t*)(p.ws + WS_XBC) + (size_t)b * SEQ * 1536;
    const float* dtp = (const float*)(p.ws + WS_DT) + (size_t)b * SEQ * 16 + hs;
    const float* dap = (const float*)(p.ws + WS_DA) + (size_t)b * SEQ * 16 + hs;
    float* yraw = (float*)(p.ws + WS_YRAW) + (size_t)b * SEQ * 1024 + hs * 64 + p0;
    const float dskip = p.in[10][hs];
    constexpr int BUF_F = 9280;
    LAS float* L = (LAS float*)lds;
    const bool producer = tid >= 256; const int ptid = tid & 255;
    int grow[5], gcol[5], loff[5];
#pragma unroll
    for (int k = 0; k < 5; ++k) { const int q = ptid + k * 256, row = q / 36, pc = q - row * 36; grow[k] = row;
        if (pc < 4) { gcol[k] = hs * 64 + p0 + pc * 8; loff[k] = row * 32 + pc * 8; }
        else if (pc < 20) { gcol[k] = 1024 + grp * 128 + (pc - 4) * 8; loff[k] = 1024 + row * 128 + (pc - 4) * 8; }
        else { gcol[k] = 1280 + grp * 128 + (pc - 20) * 8; loff[k] = 5120 + row * 128 + (pc - 20) * 8; } }
    uint4 rg[5]; float sc = 0.f;
#define SSD_ISSUE(t0) do { _Pragma("unroll") for (int k = 0; k < 5; ++k) if (ptid + k * 256 < 1152) rg[k] = *(const uint4*)(xbc + (size_t)((t0) + grow[k]) * 1536 + gcol[k]); \
        if (ptid < 32) sc = dtp[((t0) + ptid) * 16]; else if (ptid < 64) sc = dap[((t0) + ptid - 32) * 16]; } while (0)
#define SSD_COMMIT(buf) do { LAS float* Lc = L + (buf) * BUF_F; _Pragma("unroll") for (int k = 0; k < 5; ++k) if (ptid + k * 256 < 1152) { float f[8]; unpack8(rg[k], f); \
            *(LAS f32x4*)(Lc + loff[k]) = (f32x4){f[0], f[1], f[2], f[3]}; *(LAS f32x4*)(Lc + loff[k] + 4) = (f32x4){f[4], f[5], f[6], f[7]}; } \
        if (ptid < 32) Lc[9216 + ptid] = sc; else if (ptid < 64) Lc[9248 + ptid - 32] = sc; } while (0)
#define SSD_FLUSH(chp) do { LAS float* yo = L + 2 * BUF_F + ((chp) & 1) * 1024; const f32x4 v = *(LAS f32x4*)(yo + (ptid >> 3) * 32 + (ptid & 7) * 4); \
        *(f32x4*)(yraw + (size_t)((chp) * 32 + (ptid >> 3)) * 1024 + (ptid & 7) * 4) = v; } while (0)
    f32x2 hA[4], hB[4];
#pragma unroll
    for (int i = 0; i < 4; ++i) { hA[i] = (f32x2){0.f, 0.f}; hB[i] = (f32x2){0.f, 0.f}; }
    const int prow = (tid >> 4) & 15, nseg = tid & 15;
    __syncthreads();
    if (producer) { SSD_ISSUE(0); SSD_COMMIT(0); SSD_ISSUE(32); }
    __syncthreads();
    for (int ch = 0; ch < 64; ++ch) {
        const int cur = ch & 1;
        if (producer) {
            if (ch >= 1) SSD_FLUSH(ch - 1);
            if (ch + 1 < 64) SSD_COMMIT(cur ^ 1);
            if (ch + 2 < 64) SSD_ISSUE((ch + 2) * 32);
        } else {
        LAS float* Lb = L + cur * BUF_F; LAS float* yb = L + 2 * BUF_F + cur * 1024;
        for (int tg = 0; tg < 32; tg += 16) {
            float yA[16], yB[16];
            LAS float* qb = Lb + 1024 + tg * 128 + nseg * 8;
            f32x4 b0 = *(LAS f32x4*)(qb), b1 = *(LAS f32x4*)(qb + 4), c0 = *(LAS f32x4*)(qb + 4096), c1 = *(LAS f32x4*)(qb + 4100);
            float dA = Lb[9248 + tg], xa = Lb[tg * 32 + prow], xb = Lb[tg * 32 + prow + 16], dtv = Lb[9216 + tg];
#pragma unroll
            for (int tt = 0; tt < 16; ++tt) {
                f32x4 nb0, nb1, nc0, nc1; float ndA, nxa, nxb, ndtv;
                if (tt + 1 < 16) { LAS float* q = qb + (tt + 1) * 128; nb0 = *(LAS f32x4*)(q); nb1 = *(LAS f32x4*)(q + 4); nc0 = *(LAS f32x4*)(q + 4096); nc1 = *(LAS f32x4*)(q + 4100);
                    ndA = Lb[9248 + tg + tt + 1]; nxa = Lb[(tg + tt + 1) * 32 + prow]; nxb = Lb[(tg + tt + 1) * 32 + prow + 16]; ndtv = Lb[9216 + tg + tt + 1]; }
                __builtin_amdgcn_sched_barrier(0);
                const float xdta = xa * dtv, xdtb = xb * dtv;
                const f32x2 dA2 = (f32x2){dA, dA}, xa2 = (f32x2){xdta, xdta}, xb2 = (f32x2){xdtb, xdtb};
                hA[0] = hA[0] * dA2 + xa2 * b0.xy; hB[0] = hB[0] * dA2 + xb2 * b0.xy; hA[1] = hA[1] * dA2 + xa2 * b0.zw; hB[1] = hB[1] * dA2 + xb2 * b0.zw;
                hA[2] = hA[2] * dA2 + xa2 * b1.xy; hB[2] = hB[2] * dA2 + xb2 * b1.xy; hA[3] = hA[3] * dA2 + xa2 * b1.zw; hB[3] = hB[3] * dA2 + xb2 * b1.zw;
                f32x2 ya = hA[0] * c0.xy, yb2 = hB[0] * c0.xy; ya = hA[1] * c0.zw + ya; yb2 = hB[1] * c0.zw + yb2; ya = hA[2] * c1.xy + ya; yb2 = hB[2] * c1.xy + yb2; ya = hA[3] * c1.zw + ya; yb2 = hB[3] * c1.zw + yb2;
                float ra = ya.x + ya.y, rb = yb2.x + yb2.y;
                ra = dpp_add<0xB1>(ra); rb = dpp_add<0xB1>(rb); ra = dpp_add<0x4E>(ra); rb = dpp_add<0x4E>(rb); ra = dpp_add<0x141>(ra); rb = dpp_add<0x141>(rb); ra = dpp_add<0x140>(ra); rb = dpp_add<0x140>(rb);
                yA[tt] = ra + dskip * xa; yB[tt] = rb + dskip * xb;
                __builtin_amdgcn_sched_barrier(0);
                if (tt + 1 < 16) { b0 = nb0; b1 = nb1; c0 = nc0; c1 = nc1; dA = ndA; xa = nxa; xb = nxb; dtv = ndtv; }
            }
            if (nseg == 0) {
#pragma unroll
                for (int tt = 0; tt < 16; ++tt) { yb[(tg + tt) * 32 + prow] = yA[tt]; yb[(tg + tt) * 32 + prow + 16] = yB[tt]; } }
        }
        }
        __syncthreads();
    }
    if (producer) SSD_FLUSH(63);
#undef SSD_ISSUE
#undef SSD_COMMIT
#undef SSD_FLUSH
}

__device__ __forceinline__ void ssd_chunk_job(const Params& p, int job, LAS unsigned char* lds) {
    const int tid = opq(threadIdx.x), lane = tid & 63, w = tid >> 6, fr = lane & 15, fq = lane >> 4;
    const int b = job >> 5, hs = (job >> 1) & 15, half = job & 1, grp = hs >> 3, p0 = half * 32;
    const bf16_t* xbc = (const bf16_t*)(p.ws + WS_XBC) + (size_t)b * SEQ * 1536;
    const float* dtp = (const float*)(p.ws + WS_DT) + (size_t)b * SEQ * 16 + hs;
    float* yraw = (float*)(p.ws + WS_YRAW) + (size_t)b * SEQ * 1024 + hs * 64 + p0;
    const float dskip = p.in[10][hs], Ah = -__expf(p.in[9][hs]);
    constexpr int RS = 136;
    LAS bf16_t* Cs = (LAS bf16_t*)lds;
    LAS bf16_t* Bs = (LAS bf16_t*)(lds + 34816);
    LAS bf16_t* BTs = (LAS bf16_t*)(lds + 69632);
    LAS bf16_t* XTa = (LAS bf16_t*)(lds + 104448);
    LAS bf16_t* XTb = (LAS bf16_t*)(lds + 113152);
    LAS bf16_t* Ps = (LAS bf16_t*)(lds + 121856);
    LAS float* af = (LAS float*)(lds + 130560);
    LAS float* dtf = (LAS float*)(lds + 131584);
    const int crow0 = tid >> 4, cpc = tid & 15;
    const int xk = tid >> 2, xpc = tid & 3;
    u32x4 rc[4], rb[4], rx; float rdt = 0.f;
#define SC_ISSUE(t0) do { _Pragma("unroll") for (int i = 0; i < 4; ++i) { const bf16_t* rp_ = xbc + (size_t)((t0) + (crow0 + 32 * i)) * 1536 + grp * 128 + cpc * 8; rb[i] = *(const u32x4*)(rp_ + 1024); rc[i] = *(const u32x4*)(rp_ + 1280); } \
        rx = *(const u32x4*)(xbc + (size_t)((t0) + xk) * 1536 + hs * 64 + p0 + xpc * 8); if (tid < 128) rdt = dtp[((t0) + tid) * 16]; } while (0)
    f32x4 st[2];
    st[0] = (f32x4){0.f, 0.f, 0.f, 0.f}; st[1] = st[0];
    __syncthreads();
    for (int i = tid; i < 32 * RS / 2; i += 512) ((LAS unsigned*)Ps)[i] = 0u;
    SC_ISSUE(0);
    for (int ch = 0; ch < 16; ++ch) {
        const int t0 = ch * 128;
        __syncthreads();
#pragma unroll
        for (int i = 0; i < 4; ++i) { *(LAS u32x4*)(Cs + (crow0 + 32 * i) * RS + cpc * 8) = rc[i]; *(LAS u32x4*)(Bs + (crow0 + 32 * i) * RS + cpc * 8) = rb[i];

#pragma unroll
            for (int e = 0; e < 4; ++e) { BTs[(cpc * 8 + 2 * e) * RS + (crow0 + 32 * i)] = (bf16_t)(rb[i][e] & 0xffffu); BTs[(cpc * 8 + 2 * e + 1) * RS + (crow0 + 32 * i)] = (bf16_t)(rb[i][e] >> 16); } }
        float csv = 0.f;
        if (tid < 128) {
            csv = rdt * Ah; dtf[tid] = rdt;
#pragma unroll
            for (int off = 1; off < 64; off <<= 1) { const float t_ = __shfl_up(csv, off); if (lane >= off) csv += t_; }
            if (tid == 63) af[128] = csv;
        }
        float xr[8]; xr[0] = bflo(rx[0]); xr[1] = bfhi(rx[0]); xr[2] = bflo(rx[1]); xr[3] = bfhi(rx[1]); xr[4] = bflo(rx[2]); xr[5] = bfhi(rx[2]); xr[6] = bflo(rx[3]); xr[7] = bfhi(rx[3]);
        __syncthreads();
        if (tid < 128) af[tid] = (tid >= 64) ? csv + af[128] : csv;
        __syncthreads();
        const float cs_last = af[127];
        { const float d = dtf[xk], dout = __expf(cs_last - af[xk]);
#pragma unroll
          for (int e = 0; e < 8; ++e) { const float xa = xr[e] * d; XTa[(xpc * 8 + e) * RS + xk] = f2bf(xa); XTb[(xpc * 8 + e) * RS + xk] = f2bf(xa * dout); } }
        __syncthreads();
        bf16x8 cf[4];
#pragma unroll
        for (int ks = 0; ks < 4; ++ks) cf[ks] = *(LAS bf16x8*)(Cs + (w * 16 + fr) * RS + ks * 32 + fq * 8);
        f32x4 yo[2];
#pragma unroll
        for (int pt = 0; pt < 2; ++pt) { f32x4 acc = (f32x4){0.f, 0.f, 0.f, 0.f};
#pragma unroll
            for (int ks = 0; ks < 4; ++ks) { const bf16x8 pb = *(LAS bf16x8*)(Ps + (pt * 16 + fr) * RS + ks * 32 + fq * 8); acc = __builtin_amdgcn_mfma_f32_16x16x32_bf16(cf[ks], pb, acc, 0, 0, 0); }
            yo[pt] = acc; }
        float csq[4];
#pragma unroll
        for (int i = 0; i < 4; ++i) csq[i] = af[w * 16 + fq * 4 + i];
#pragma unroll
        for (int kt = 0; kt < 8; ++kt) { f32x4 acc = (f32x4){0.f, 0.f, 0.f, 0.f};
            if (kt > w) {
#pragma unroll
                for (int i = 0; i < 4; ++i) Cs[(w * 16 + fq * 4 + i) * RS + kt * 16 + fr] = (bf16_t)0;
                continue; }
#pragma unroll
            for (int ks = 0; ks < 4; ++ks) { const bf16x8 bb = *(LAS bf16x8*)(Bs + (kt * 16 + fr) * RS + ks * 32 + fq * 8); acc = __builtin_amdgcn_mfma_f32_16x16x32_bf16(cf[ks], bb, acc, 0, 0, 0); }
            const int kk = kt * 16 + fr; const float csk = af[kk];
#pragma unroll
            for (int i = 0; i < 4; ++i) { const int qq = w * 16 + fq * 4 + i; const float m = (kk <= qq) ? acc[i] * __expf(csq[i] - csk) : 0.f; Cs[qq * RS + kk] = f2bf(m); } }
        f32x4 yd[2];
        { bf16x8 mf[4];
#pragma unroll
          for (int ks = 0; ks < 4; ++ks) mf[ks] = *(LAS bf16x8*)(Cs + (w * 16 + fr) * RS + ks * 32 + fq * 8);
#pragma unroll
          for (int pt = 0; pt < 2; ++pt) { f32x4 acc = (f32x4){0.f, 0.f, 0.f, 0.f};
#pragma unroll
              for (int ks = 0; ks < 4; ++ks) { const bf16x8 xb = *(LAS bf16x8*)(XTa + (pt * 16 + fr) * RS + ks * 32 + fq * 8); acc = __builtin_amdgcn_mfma_f32_16x16x32_bf16(mf[ks], xb, acc, 0, 0, 0); }
              yd[pt] = acc; } }
#pragma unroll
        for (int pt = 0; pt < 2; ++pt)
#pragma unroll
            for (int i = 0; i < 4; ++i) { const int qq = w * 16 + fq * 4 + i, pp = pt * 16 + fr;
                const float xv = bf2f(xbc[(size_t)(t0 + qq) * 1536 + hs * 64 + p0 + pp]);
                yraw[(size_t)(t0 + qq) * 1024 + pp] = yd[pt][i] + __expf(csq[i]) * yo[pt][i] + dskip * xv; }
        if (ch + 1 < 16) SC_ISSUE(t0 + 128);
        __syncthreads();
        { const float cd = __expf(cs_last);
#pragma unroll
          for (int pt = 0; pt < 2; ++pt) { f32x4 acc = st[pt] * cd;
#pragma unroll
              for (int ks = 0; ks < 4; ++ks) { const bf16x8 xa = *(LAS bf16x8*)(XTb + (pt * 16 + fr) * RS + ks * 32 + fq * 8); const bf16x8 bt = *(LAS bf16x8*)(BTs + (w * 16 + fr) * RS + ks * 32 + fq * 8);
                  acc = __builtin_amdgcn_mfma_f32_16x16x32_bf16(xa, bt, acc, 0, 0, 0); }
              st[pt] = acc;
#pragma unroll
              for (int i = 0; i < 4; ++i) Ps[(pt * 16 + fq * 4 + i) * RS + w * 16 + fr] = f2bf(acc[i]); } }
    }
#undef SC_ISSUE
}

__device__ __forceinline__ void attn_job(const Params& p, int job, LAS unsigned char* lds) {
    const int tid = opq(threadIdx.x), lane = tid & 63, w = tid >> 6, fr = lane & 15, fq = lane >> 4;
    const int b = job >> 6, kvh = (job >> 4) & 3, nb = job & 15;
    const bf16_t* proj = (const bf16_t*)(p.ws + WS_PROJ) + (size_t)b * SEQ * INWP;
    const float2* rope = (const float2*)(p.ws + WS_ROPE);
    LAS bf16_t* Ks = (LAS bf16_t*)lds;
    LAS bf16_t* Vt = (LAS bf16_t*)(lds + 36864);
    LAS bf16_t* Ps = (LAS bf16_t*)(lds + 70656) + w * 16 * 264;
    __syncthreads();
    if (tid < 256) {
        const int kr = tid, tk = (nb - 1) * 128 + kr;
        if (tk >= 0) {
            const bf16_t* src = proj + (size_t)tk * INWP + COL_K + kvh * 64; float x[64]; float ss = 0.f;
#pragma unroll
            for (int c = 0; c < 8; ++c) { const uint4 r = *(const uint4*)(src + c * 8); float f[8]; unpack8(r, f);
#pragma unroll
                for (int e = 0; e < 8; ++e) { x[c * 8 + e] = f[e]; ss += f[e] * f[e]; } }
            const float rinv = rsqrtf(ss * (1.0f / 64) + 1e-6f); const float* kn = p.in[13];
#pragma unroll
            for (int i = 0; i < 64; ++i) x[i] = x[i] * rinv * kn[i];
#pragma unroll
            for (int c = 0; c < 4; ++c) { float o1[8], o2[8];
#pragma unroll
                for (int e = 0; e < 8; ++e) { const int i = c * 8 + e; const float2 cs = rope[tk * 32 + i]; o1[e] = x[i] * cs.x - x[i + 32] * cs.y; o2[e] = x[i + 32] * cs.x + x[i] * cs.y; }
                u32x4 w1, w2; w1.x = cvt_pk_bf16(o1[0], o1[1]); w1.y = cvt_pk_bf16(o1[2], o1[3]); w1.z = cvt_pk_bf16(o1[4], o1[5]); w1.w = cvt_pk_bf16(o1[6], o1[7]);
                w2.x = cvt_pk_bf16(o2[0], o2[1]); w2.y = cvt_pk_bf16(o2[2], o2[3]); w2.z = cvt_pk_bf16(o2[4], o2[5]); w2.w = cvt_pk_bf16(o2[6], o2[7]);
                *(LAS u32x4*)(Ks + kr * 72 + c * 8) = w1; *(LAS u32x4*)(Ks + kr * 72 + 32 + c * 8) = w2;
                __builtin_amdgcn_sched_barrier(0); }
        } else {
#pragma unroll
            for (int c = 0; c < 8; ++c) *(LAS u32x4*)(Ks + kr * 72 + c * 8) = (u32x4){0u, 0u, 0u, 0u};
        }
    } else {
        const int kr = tid - 256, tk = (nb - 1) * 128 + kr;
        const bf16_t* src = proj + (size_t)(tk < 0 ? 0 : tk) * INWP + COL_V + kvh * 64;
#pragma unroll
        for (int c = 0; c < 8; ++c) { uint4 r = *(const uint4*)(src + c * 8); if (tk < 0) r = make_uint4(0u, 0u, 0u, 0u);
            Vt[(c * 8 + 0) * 264 + kr] = (bf16_t)(r.x & 0xffffu); Vt[(c * 8 + 1) * 264 + kr] = (bf16_t)(r.x >> 16);
            Vt[(c * 8 + 2) * 264 + kr] = (bf16_t)(r.y & 0xffffu); Vt[(c * 8 + 3) * 264 + kr] = (bf16_t)(r.y >> 16);
            Vt[(c * 8 + 4) * 264 + kr] = (bf16_t)(r.z & 0xffffu); Vt[(c * 8 + 5) * 264 + kr] = (bf16_t)(r.z >> 16);
            Vt[(c * 8 + 6) * 264 + kr] = (bf16_t)(r.w & 0xffffu); Vt[(c * 8 + 7) * 264 + kr] = (bf16_t)(r.w >> 16); }
    }
    __syncthreads();
    for (int h4 = 0; h4 < 4; ++h4) {
    const int hq = kvh * 4 + h4;
    bf16x8 qa[2];
    { const int tq = nb * 128 + w * 16 + fr; const bf16_t* src = proj + (size_t)tq * INWP + hq * 64;
      const uint4 r0 = *(const uint4*)(src + fq * 8), r1 = *(const uint4*)(src + 32 + fq * 8); float x1[8], x2[8]; unpack8(r0, x1); unpack8(r1, x2);
      float ss = 0.f;
#pragma unroll
      for (int e = 0; e < 8; ++e) ss += x1[e] * x1[e] + x2[e] * x2[e];
      ss += __shfl_xor(ss, 16); ss += __shfl_xor(ss, 32);
      const float rinv = rsqrtf(ss * (1.0f / 64) + 1e-6f) * 0.125f; const float* qn = p.in[12]; float o1[8], o2[8];
#pragma unroll
      for (int e = 0; e < 8; ++e) { const int i = fq * 8 + e; const float a = x1[e] * rinv * qn[i], c = x2[e] * rinv * qn[i + 32]; const float2 cs = rope[tq * 32 + i];
          o1[e] = a * cs.x - c * cs.y; o2[e] = c * cs.x + a * cs.y; }
      u32x4 w1, w2; w1.x = cvt_pk_bf16(o1[0], o1[1]); w1.y = cvt_pk_bf16(o1[2], o1[3]); w1.z = cvt_pk_bf16(o1[4], o1[5]); w1.w = cvt_pk_bf16(o1[6], o1[7]);
      w2.x = cvt_pk_bf16(o2[0], o2[1]); w2.y = cvt_pk_bf16(o2[2], o2[3]); w2.z = cvt_pk_bf16(o2[4], o2[5]); w2.w = cvt_pk_bf16(o2[6], o2[7]);
      qa[0] = __builtin_bit_cast(bf16x8, w1); qa[1] = __builtin_bit_cast(bf16x8, w2); }
    f32x4 s[16];
#pragma unroll
    for (int j = 0; j < 16; ++j) { f32x4 acc = (f32x4){0.f, 0.f, 0.f, 0.f};
#pragma unroll
        for (int ks = 0; ks < 2; ++ks) { const bf16x8 kb = *(LAS bf16x8*)(Ks + (j * 16 + fr) * 72 + ks * 32 + fq * 8); acc = __builtin_amdgcn_mfma_f32_16x16x32_bf16(qa[ks], kb, acc, 0, 0, 0); }
        s[j] = acc; }
    const float sink = p.in[14][hq];
    float mx[4], inv[4];
#pragma unroll
    for (int i = 0; i < 4; ++i) { const int qi = w * 16 + fq * 4 + i + 128; float m = -3.0e38f;
#pragma unroll
        for (int j = 0; j < 16; ++j) { const int kj = j * 16 + fr; const bool ok = (kj <= qi) && (qi - kj < 128) && (nb > 0 || kj >= 128); s[j][i] = ok ? s[j][i] : -3.0e38f; m = fmaxf(m, s[j][i]); }
        m = max16(m);
        m = fmaxf(m, sink); mx[i] = m; float l = 0.f;
#pragma unroll
        for (int j = 0; j < 16; ++j) { const float e = (s[j][i] > -1.0e38f) ? __expf(s[j][i] - m) : 0.f; s[j][i] = e; l += e; }
        l = red16(l);
        inv[i] = 1.0f / (l + __expf(sink - m)); }
#pragma unroll
    for (int j = 0; j < 16; ++j)
#pragma unroll
        for (int i = 0; i < 4; ++i) Ps[(fq * 4 + i) * 264 + j * 16 + fr] = f2bf(s[j][i] * inv[i]);
    f32x4 o[4];
#pragma unroll
    for (int nd = 0; nd < 4; ++nd) o[nd] = (f32x4){0.f, 0.f, 0.f, 0.f};
#pragma unroll
    for (int kk = 0; kk < 8; ++kk) { const bf16x8 pa = *(LAS bf16x8*)(Ps + fr * 264 + kk * 32 + fq * 8);
#pragma unroll
        for (int nd = 0; nd < 4; ++nd) { const bf16x8 vb = *(LAS bf16x8*)(Vt + (nd * 16 + fr) * 264 + kk * 32 + fq * 8); o[nd] = __builtin_amdgcn_mfma_f32_16x16x32_bf16(pa, vb, o[nd], 0, 0, 0); } }
    bf16_t* ymix = (bf16_t*)(p.ws + WS_YMIX) + (size_t)b * SEQ * D + hq * 64;
#pragma unroll
    for (int nd = 0; nd < 4; ++nd)
#pragma unroll
        for (int i = 0; i < 4; ++i) ymix[(size_t)(nb * 128 + w * 16 + fq * 4 + i) * D + nd * 16 + fr] = f2bf(o[nd][i]);
    }
}

__device__ __forceinline__ void post_ssd(const Params& p) {
    const int tid_ = opq(threadIdx.x); const int lane = tid_ & 63, wv = tid_ >> 6;
    const float* yraw = (const float*)(p.ws + WS_YRAW); const bf16_t* proj = (const bf16_t*)(p.ws + WS_PROJ); bf16_t* ymix = (bf16_t*)(p.ws + WS_YMIX);
    for (int it = blockIdx.x * 8 + wv; it < MTOK * 2; it += gridDim.x * 8) {
        const int tok = it >> 1, grp = it & 1, c = grp * 512 + lane * 8;
        const f32x4 y0 = *(const f32x4*)(yraw + (size_t)tok * 1024 + c), y1 = *(const f32x4*)(yraw + (size_t)tok * 1024 + c + 4);
        const uint4 zr = *(const uint4*)(proj + (size_t)tok * INWP + COL_Z + c); float z[8], y[8]; unpack8(zr, z); float ss = 0.f;
#pragma unroll
        for (int e = 0; e < 8; ++e) { const float yy = (e < 4 ? y0[e] : y1[e - 4]); y[e] = yy * z[e] * sigmoidf_(z[e]); ss += y[e] * y[e]; }
        ss = wave_sum(ss); const float r = rsqrtf(ss * (1.0f / 512) + 1e-6f);
        const f32x4 n0 = *(const f32x4*)(p.in[11] + c), n1 = *(const f32x4*)(p.in[11] + c + 4);
        u32x4 w; w.x = cvt_pk_nv(y[0] * r * n0[0], y[1] * r * n0[1]); w.y = cvt_pk_nv(y[2] * r * n0[2], y[3] * r * n0[3]);
        w.z = cvt_pk_nv(y[4] * r * n1[0], y[5] * r * n1[1]); w.w = cvt_pk_nv(y[6] * r * n1[2], y[7] * r * n1[3]);
        *(u32x4*)(ymix + (size_t)tok * D + 1024 + c) = w;
    }
}

__device__ __forceinline__ float half_sum(float v, bool lo) {
    (void)lo; v = red16(v); return v + __shfl_xor(v, 16); }
__device__ __forceinline__ void rwkv_scan_job(const Params& p, int job, LAS unsigned char* lds) {
    const int tid = opq(threadIdx.x), lane = tid & 63, l32 = lane & 31; const bool lo = lane < 32;
    const int b = job >> 5, hh = job & 31;
    LAS float* L = (LAS float*)lds;
    const bool producer = tid >= 256;
    const int pw = (tid >> 6) & 3;
    const int tl0 = 2 * pw + (lane >> 5);
    const size_t wbase = ((size_t)b * SEQ * D + hh * 64) / 2 + l32 + (size_t)tl0 * (D / 2);
    const unsigned* R32 = (const unsigned*)(p.ws + WS_R) + wbase; const unsigned* K32 = (const unsigned*)(p.ws + WS_K) + wbase; const unsigned* V32 = (const unsigned*)(p.ws + WS_V) + wbase;
    const unsigned* E32 = (const unsigned*)(p.ws + WS_WDEC) + wbase; const unsigned* A32 = (const unsigned*)(p.ws + WS_AA) + wbase; const unsigned* G32 = (const unsigned*)(p.ws + WS_GG) + wbase;
    unsigned* Y32 = (unsigned*)(p.ws + WS_YG) + wbase;
    const int ci = hh * 64 + 2 * l32;
    const float2 kkw = *(const float2*)(p.in[25] + ci), kaw = *(const float2*)(p.in[26] + ci), rkw = *(const float2*)(p.in[27] + ci), lnw = *(const float2*)(p.in[32] + ci), lnb = *(const float2*)(p.in[33] + ci);
    unsigned rw[2], kw[2], vw[2], ew[2], aw[2], gw[2];
    const int oo = tl0 * 64 + 2 * l32;
#define RW_ISSUE(t0) do { _Pragma("unroll") for (int i2 = 0; i2 < 2; ++i2) { const size_t off = (size_t)((t0) + 8 * i2) * (D / 2); rw[i2] = R32[off]; kw[i2] = K32[off]; vw[i2] = V32[off]; ew[i2] = E32[off]; aw[i2] = A32[off]; gw[i2] = G32[off]; } } while (0)
#define RW_COMMIT(buf) do { _Pragma("unroll") for (int i2 = 0; i2 < 2; ++i2) { LAS float* Lc = L + (buf) * 8192 + oo + i2 * 512; \
        const float r0_ = bflo(rw[i2]), r1_ = bfhi(rw[i2]), k0_ = bflo(kw[i2]), k1_ = bfhi(kw[i2]), v0_ = bflo(vw[i2]), v1_ = bfhi(vw[i2]), e0_ = bflo(ew[i2]), e1_ = bfhi(ew[i2]), a0_ = bflo(aw[i2]), a1_ = bfhi(aw[i2]), g0_ = bflo(gw[i2]), g1_ = bfhi(gw[i2]); \
        const float kkv0 = k0_ * kkw.x, kkv1 = k1_ * kkw.y; const float ssq = half_sum(kkv0 * kkv0 + kkv1 * kkv1, lo); const float rn = rsqrtf(fmaxf(ssq, 1e-24f)); const float kn0 = kkv0 * rn, kn1 = kkv1 * rn; \
        const float km0 = k0_ * (1.0f + (a0_ - 1.0f) * kaw.x), km1 = k1_ * (1.0f + (a1_ - 1.0f) * kaw.y); const float bonus = half_sum(r0_ * km0 * rkw.x + r1_ * km1 * rkw.y, lo); \
        *(LAS f32x2*)(Lc) = (f32x2){-kn0, -kn1}; *(LAS f32x2*)(Lc + 1024) = (f32x2){__expf(-e0_), __expf(-e1_)}; *(LAS f32x2*)(Lc + 2048) = (f32x2){kn0 * a0_, kn1 * a1_}; *(LAS f32x2*)(Lc + 3072) = (f32x2){km0, km1}; \
        *(LAS f32x2*)(Lc + 4096) = (f32x2){r0_, r1_}; *(LAS f32x2*)(Lc + 5120) = (f32x2){v0_, v1_}; *(LAS f32x2*)(Lc + 6144) = (f32x2){g0_, g1_}; *(LAS f32x2*)(Lc + 7168) = (f32x2){bonus * v0_, bonus * v1_}; } } while (0)
#define RW_OUTPUT(chp) do { LAS float* Lo = L + ((chp) & 1) * 8192; LAS float* yo = L + 16384 + ((chp) & 1) * 1024; _Pragma("unroll") for (int i2 = 0; i2 < 2; ++i2) { const int o2 = oo + i2 * 512; \
        const f32x2 y = *(LAS f32x2*)(yo + o2); \
        const float mu = half_sum(y.x + y.y, lo) * (1.0f / 64), d0 = y.x - mu, d1 = y.y - mu, var = half_sum(d0 * d0 + d1 * d1, lo) * (1.0f / 64), rs = rsqrtf(var + 64e-5f); \
        const f32x2 bv = *(LAS f32x2*)(Lo + 7168 + o2), gg = *(LAS f32x2*)(Lo + 6144 + o2); \
        Y32[(size_t)((chp) * 16 + 8 * i2) * (D / 2)] = cvt_pk_nv((d0 * rs * lnw.x + lnb.x + bv.x) * gg.x, (d1 * rs * lnw.y + lnb.y + bv.y) * gg.y); } } while (0)
    f32x2 SA[4], SB[4];
#pragma unroll
    for (int i = 0; i < 4; ++i) { SA[i] = (f32x2){0.f, 0.f}; SB[i] = (f32x2){0.f, 0.f}; }
    const int rp = (tid >> 3) & 31, ks = tid & 7;
    __syncthreads();
    if (producer) { RW_ISSUE(0); RW_COMMIT(0); RW_ISSUE(16); }
    __syncthreads();
    for (int ch = 0; ch < 128; ++ch) {
        const int cur = ch & 1;
        if (producer) {
            if (ch >= 1) RW_OUTPUT(ch - 1);
            if (ch + 1 < 128) RW_COMMIT(cur ^ 1);
            if (ch + 2 < 128) RW_ISSUE((ch + 2) * 16);
        } else {
            LAS float* Lb = L + cur * 8192; LAS float* yb = L + 16384 + cur * 1024;
            float yA[16], yB[16];
            LAS float* q0 = Lb + ks * 8;
            f32x4 a0 = *(LAS f32x4*)(q0), a1 = *(LAS f32x4*)(q0 + 4), w0 = *(LAS f32x4*)(q0 + 1024), w1 = *(LAS f32x4*)(q0 + 1028), b0 = *(LAS f32x4*)(q0 + 2048), b1 = *(LAS f32x4*)(q0 + 2052);
            f32x4 k0 = *(LAS f32x4*)(q0 + 3072), k1 = *(LAS f32x4*)(q0 + 3076), r0 = *(LAS f32x4*)(q0 + 4096), r1 = *(LAS f32x4*)(q0 + 4100);
            float va = Lb[5120 + rp], vb = Lb[5120 + rp + 32];
#pragma unroll
            for (int t = 0; t < 16; ++t) {
                f32x4 na0, na1, nw0, nw1, nb0, nb1, nk0, nk1, nr0, nr1; float nva, nvb;
                if (t + 1 < 16) { LAS float* q = q0 + (t + 1) * 64;
                    na0 = *(LAS f32x4*)(q); na1 = *(LAS f32x4*)(q + 4); nw0 = *(LAS f32x4*)(q + 1024); nw1 = *(LAS f32x4*)(q + 1028); nb0 = *(LAS f32x4*)(q + 2048); nb1 = *(LAS f32x4*)(q + 2052);
                    nk0 = *(LAS f32x4*)(q + 3072); nk1 = *(LAS f32x4*)(q + 3076); nr0 = *(LAS f32x4*)(q + 4096); nr1 = *(LAS f32x4*)(q + 4100); nva = Lb[5120 + (t + 1) * 64 + rp]; nvb = Lb[5120 + (t + 1) * 64 + rp + 32]; }
                __builtin_amdgcn_sched_barrier(0);
                f32x2 ca = SA[0] * a0.xy, cb = SB[0] * a0.xy; ca = SA[1] * a0.zw + ca; cb = SB[1] * a0.zw + cb; ca = SA[2] * a1.xy + ca; cb = SB[2] * a1.xy + cb; ca = SA[3] * a1.zw + ca; cb = SB[3] * a1.zw + cb;
                float sa = ca.x + ca.y, sb = cb.x + cb.y;
                sa = dpp_add<0xB1>(sa); sb = dpp_add<0xB1>(sb); sa = dpp_add<0x4E>(sa); sb = dpp_add<0x4E>(sb); sa = dpp_add<0x141>(sa); sb = dpp_add<0x141>(sb);
                const f32x2 sa2 = (f32x2){sa, sa}, sb2 = (f32x2){sb, sb}, va2 = (f32x2){va, va}, vb2 = (f32x2){vb, vb};
                SA[0] = SA[0] * w0.xy + (sa2 * b0.xy + va2 * k0.xy); SB[0] = SB[0] * w0.xy + (sb2 * b0.xy + vb2 * k0.xy);
                SA[1] = SA[1] * w0.zw + (sa2 * b0.zw + va2 * k0.zw); SB[1] = SB[1] * w0.zw + (sb2 * b0.zw + vb2 * k0.zw);
                SA[2] = SA[2] * w1.xy + (sa2 * b1.xy + va2 * k1.xy); SB[2] = SB[2] * w1.xy + (sb2 * b1.xy + vb2 * k1.xy);
                SA[3] = SA[3] * w1.zw + (sa2 * b1.zw + va2 * k1.zw); SB[3] = SB[3] * w1.zw + (sb2 * b1.zw + vb2 * k1.zw);
                f32x2 ya = SA[0] * r0.xy, yb2 = SB[0] * r0.xy; ya = SA[1] * r0.zw + ya; yb2 = SB[1] * r0.zw + yb2; ya = SA[2] * r1.xy + ya; yb2 = SB[2] * r1.xy + yb2; ya = SA[3] * r1.zw + ya; yb2 = SB[3] * r1.zw + yb2;
                float ra = ya.x + ya.y, rb = yb2.x + yb2.y;
                ra = dpp_add<0xB1>(ra); rb = dpp_add<0xB1>(rb); ra = dpp_add<0x4E>(ra); rb = dpp_add<0x4E>(rb); ra = dpp_add<0x141>(ra); rb = dpp_add<0x141>(rb);
                yA[t] = ra; yB[t] = rb;
                __builtin_amdgcn_sched_barrier(0);
                if (t + 1 < 16) { a0 = na0; a1 = na1; w0 = nw0; w1 = nw1; b0 = nb0; b1 = nb1; k0 = nk0; k1 = nk1; r0 = nr0; r1 = nr1; va = nva; vb = nvb; }
            }
            if (ks == 0) {
#pragma unroll
                for (int t = 0; t < 16; ++t) { yb[t * 64 + rp] = yA[t]; yb[t * 64 + rp + 32] = yB[t]; } }
        }
        __syncthreads();
    }
    if (producer) RW_OUTPUT(127);
#undef RW_ISSUE
#undef RW_COMMIT
#undef RW_OUTPUT
}

__device__ __forceinline__ void rwkv_chunk_job(const Params& p, int job, LAS unsigned char* lds) {
    const int tid = opq(threadIdx.x), lane = tid & 63, w = tid >> 6, fr = lane & 15, fq = lane >> 4, l32 = lane & 31; const bool lo = lane < 32;
    const int b = job >> 5, hh = job & 31;
    const int tl = 2 * w + (lane >> 5);
    const size_t wbase = ((size_t)b * SEQ * D + hh * 64) / 2 + l32 + (size_t)tl * (D / 2);
    const unsigned* R32 = (const unsigned*)(p.ws + WS_R) + wbase; const unsigned* K32 = (const unsigned*)(p.ws + WS_K) + wbase; const unsigned* V32 = (const unsigned*)(p.ws + WS_V) + wbase;
    const unsigned* E32 = (const unsigned*)(p.ws + WS_WDEC) + wbase; const unsigned* A32 = (const unsigned*)(p.ws + WS_AA) + wbase; const unsigned* G32 = (const unsigned*)(p.ws + WS_GG) + wbase;
    unsigned* Y32 = (unsigned*)(p.ws + WS_YG) + wbase;
    const int ci = hh * 64 + 2 * l32;
    const float2 kkw = *(const float2*)(p.in[25] + ci), kaw = *(const float2*)(p.in[26] + ci), rkw = *(const float2*)(p.in[27] + ci), lnw = *(const float2*)(p.in[32] + ci), lnb = *(const float2*)(p.in[33] + ci);
    LAS float* Av = (LAS float*)(lds + 0);
    LAS float* Bv = (LAS float*)(lds + 4096);
    LAS float* Km = (LAS float*)(lds + 8192);
    LAS float* Rr = (LAS float*)(lds + 12288);
    LAS float* ybuf = (LAS float*)(lds + 16384);
    LAS float* RHS = (LAS float*)(lds + 20480);
    LAS float* Aab = (LAS float*)(lds + 24832);
    LAS float* Wend = (LAS float*)(lds + 25856);
    LAS bf16_t* ET = (LAS bf16_t*)(lds + 26112);
    LAS bf16_t* VT = (LAS bf16_t*)(lds + 31232);
    LAS bf16_t* BtT = (LAS bf16_t*)(lds + 36352);
    LAS bf16_t* KtT = (LAS bf16_t*)(lds + 41472);
    LAS bf16_t* Ub = (LAS bf16_t*)(lds + 46592);
    LAS bf16_t* AakT = (LAS bf16_t*)(lds + 51712);
    LAS bf16_t* AbrT = (LAS bf16_t*)(lds + 52992);
    LAS bf16_t* AkrT = (LAS bf16_t*)(lds + 54272);
    LAS bf16_t* At = (LAS bf16_t*)(lds + 55552);
    LAS bf16_t* Bt = (LAS bf16_t*)(lds + 57856);
    LAS bf16_t* Kt = (LAS bf16_t*)(lds + 60160);
    LAS bf16_t* Rt = (LAS bf16_t*)(lds + 62464);
    LAS bf16_t* S0b = (LAS bf16_t*)(lds + 64768);
    LAS bf16_t* VT1 = (LAS bf16_t*)(lds + 73984);
    constexpr int LDS_END = 73984 + 64 * 40 * 2;
    __syncthreads();
    for (int i = tid; i < LDS_END / 4; i += 512) ((LAS unsigned*)lds)[i] = 0u;
    f32x4 stt[2]; stt[0] = (f32x4){0.f, 0.f, 0.f, 0.f}; stt[1] = stt[0];
    const int vt = w >> 1, kt0 = (w & 1) * 2;
    bf16x8 Lf;
#pragma unroll
    for (int e = 0; e < 8; ++e) { const int i = fq * 8 + e; Lf[e] = (i <= fr && i < 16) ? (short)0x3F80 : (short)0; }
    unsigned rw, kw, vw, ew, aw, gw;
#define RC_ISSUE(t0) do { const size_t off = (size_t)(t0) * (D / 2); rw = R32[off]; kw = K32[off]; vw = V32[off]; ew = E32[off]; aw = A32[off]; gw = G32[off]; } while (0)
#define RC_PREP(chn) do { \
        const float r0_ = bflo(rw), r1_ = bfhi(rw), k0_ = bflo(kw), k1_ = bfhi(kw), v0_ = bflo(vw), v1_ = bfhi(vw), a0_ = bflo(aw), a1_ = bfhi(aw); gn0 = bflo(gw); gn1 = bfhi(gw); \
        const unsigned ewc = ew, vwc = vw; \
        if ((chn) + 1 < 128) RC_ISSUE(((chn) + 1) * 16); \
        const float kkv0 = k0_ * kkw.x, kkv1 = k1_ * kkw.y; const float ssq = half_sum(kkv0 * kkv0 + kkv1 * kkv1, lo); const float rn = rsqrtf(fmaxf(ssq, 1e-24f)); const float kn0 = kkv0 * rn, kn1 = kkv1 * rn; \
        const float km0 = k0_ * (1.0f + (a0_ - 1.0f) * kaw.x), km1 = k1_ * (1.0f + (a1_ - 1.0f) * kaw.y); const float bonus = half_sum(r0_ * km0 * rkw.x + r1_ * km1 * rkw.y, lo); \
        bn0 = bonus * v0_; bn1 = bonus * v1_; \
        { const int o = tl * 64 + 2 * l32; LAS bf16_t* VTw = ((chn) & 1) ? VT1 : VT; \
          *(LAS f32x2*)(Av + o) = (f32x2){-kn0, -kn1}; *(LAS f32x2*)(Bv + o) = (f32x2){kn0 * a0_, kn1 * a1_}; *(LAS f32x2*)(Km + o) = (f32x2){km0, km1}; *(LAS f32x2*)(Rr + o) = (f32x2){r0_, r1_}; \
          ET[(2 * l32) * 40 + tl] = (bf16_t)(ewc & 0xffffu); ET[(2 * l32 + 1) * 40 + tl] = (bf16_t)(ewc >> 16); \
          VTw[(2 * l32) * 40 + tl] = (bf16_t)(vwc & 0xffffu); VTw[(2 * l32 + 1) * 40 + tl] = (bf16_t)(vwc >> 16); } } while (0)
    float gc0 = 0.f, gc1 = 0.f, bc0 = 0.f, bc1 = 0.f, gn0, gn1, bn0, bn1;
    RC_ISSUE(0);
    __syncthreads();
    RC_PREP(0); gc0 = gn0; gc1 = gn1; bc0 = bn0; bc1 = bn1;
    __syncthreads();
    for (int ch = 0; ch < 128; ++ch) {
        LAS bf16_t* VTc = (ch & 1) ? VT1 : VT;
        if (w < 4) {
            const bf16x8 eb = *(LAS bf16x8*)(ET + (w * 16 + fr) * 40 + fq * 8);
            f32x4 ec = (f32x4){0.f, 0.f, 0.f, 0.f}; ec = __builtin_amdgcn_mfma_f32_16x16x32_bf16(Lf, eb, ec, 0, 0, 0);
            const int kk = w * 16 + fr; unsigned bt_pk[2], kt_pk[2]; float btv[4], ktv[4];
#pragma unroll
            for (int i = 0; i < 4; ++i) { const int t = fq * 4 + i; const float et = bf2f(ET[kk * 40 + t]);
                const float Wt = __expf(-ec[i]), Wp = __expf(et - ec[i]), iW = __expf(ec[i]);
                const int o = t * 64 + kk;
                At[t * 72 + kk] = f2bf(Av[o] * Wp); Rt[t * 72 + kk] = f2bf(Rr[o] * Wt);
                btv[i] = Bv[o] * iW; ktv[i] = Km[o] * iW;
                Bt[t * 72 + kk] = f2bf(btv[i]); Kt[t * 72 + kk] = f2bf(ktv[i]);
                if (t == 15) Wend[kk] = Wt; }
            bt_pk[0] = cvt_pk_bf16(btv[0], btv[1]); bt_pk[1] = cvt_pk_bf16(btv[2], btv[3]); kt_pk[0] = cvt_pk_bf16(ktv[0], ktv[1]); kt_pk[1] = cvt_pk_bf16(ktv[2], ktv[3]);
            *(LAS u32x2*)(BtT + kk * 40 + fq * 4) = (u32x2){bt_pk[0], bt_pk[1]}; *(LAS u32x2*)(KtT + kk * 40 + fq * 4) = (u32x2){kt_pk[0], kt_pk[1]};
        }
        __syncthreads();
        if (w < 4) {
            LAS bf16_t* Xr = (w & 1) ? Kt : Bt; LAS bf16_t* Yr = (w & 2) ? Rt : At;
            f32x4 gacc = (f32x4){0.f, 0.f, 0.f, 0.f};
#pragma unroll
            for (int ks = 0; ks < 2; ++ks) { const bf16x8 xa = *(LAS bf16x8*)(Xr + fr * 72 + ks * 32 + fq * 8); const bf16x8 yb_ = *(LAS bf16x8*)(Yr + fr * 72 + ks * 32 + fq * 8); gacc = __builtin_amdgcn_mfma_f32_16x16x32_bf16(xa, yb_, gacc, 0, 0, 0); }
            float gm[4];
#pragma unroll
            for (int i = 0; i < 4; ++i) { const int j = fq * 4 + i; const bool keep = (w & 2) ? (j <= fr) : (j < fr); gm[i] = keep ? gacc[i] : 0.f; }
            if (w == 0) {
#pragma unroll
                for (int i = 0; i < 4; ++i) Aab[(fq * 4 + i) * 16 + fr] = gm[i]; }
            else { LAS bf16_t* dst = (w == 1) ? AakT : (w == 2) ? AbrT : AkrT; *(LAS u32x2*)(dst + fr * 40 + fq * 4) = (u32x2){cvt_pk_bf16(gm[0], gm[1]), cvt_pk_bf16(gm[2], gm[3])}; }
        }
        __syncthreads();
        f32x4 y0 = (f32x4){0.f, 0.f, 0.f, 0.f};
        { const int vtile = w & 3; LAS bf16_t* Yr = (w < 4) ? At : Rt; LAS bf16_t* Gt = (w < 4) ? AakT : AkrT;
#pragma unroll
          for (int ks = 0; ks < 2; ++ks) { const bf16x8 sa = *(LAS bf16x8*)(S0b + (vtile * 16 + fr) * 72 + ks * 32 + fq * 8); const bf16x8 yb_ = *(LAS bf16x8*)(Yr + fr * 72 + ks * 32 + fq * 8); y0 = __builtin_amdgcn_mfma_f32_16x16x32_bf16(sa, yb_, y0, 0, 0, 0); }
          { const bf16x8 va = *(LAS bf16x8*)(VTc + (vtile * 16 + fr) * 40 + fq * 8); const bf16x8 gb = *(LAS bf16x8*)(Gt + fr * 40 + fq * 8); y0 = __builtin_amdgcn_mfma_f32_16x16x32_bf16(va, gb, y0, 0, 0, 0); }
          if (w < 4) {
#pragma unroll
              for (int i = 0; i < 4; ++i) RHS[(vtile * 16 + fq * 4 + i) * 17 + fr] = y0[i]; } }
        __syncthreads();
        if (w == 0) {
            float u[16];
#pragma unroll
            for (int t = 0; t < 16; ++t) u[t] = RHS[lane * 17 + t];
#pragma unroll
            for (int t = 0; t < 15; ++t) {
#pragma unroll
                for (int t2 = t + 1; t2 < 16; ++t2) u[t2] += u[t] * Aab[t * 16 + t2]; }
            u32x4 o0, o1; o0.x = cvt_pk_bf16(u[0], u[1]); o0.y = cvt_pk_bf16(u[2], u[3]); o0.z = cvt_pk_bf16(u[4], u[5]); o0.w = cvt_pk_bf16(u[6], u[7]);
            o1.x = cvt_pk_bf16(u[8], u[9]); o1.y = cvt_pk_bf16(u[10], u[11]); o1.z = cvt_pk_bf16(u[12], u[13]); o1.w = cvt_pk_bf16(u[14], u[15]);
            *(LAS u32x4*)(Ub + lane * 40) = o0; *(LAS u32x4*)(Ub + lane * 40 + 8) = o1;
        }
        if (ch + 1 < 128) RC_PREP(ch + 1);
        __syncthreads();
        if (w >= 4) { const int vtile = w & 3;
            const bf16x8 ua = *(LAS bf16x8*)(Ub + (vtile * 16 + fr) * 40 + fq * 8); const bf16x8 gb = *(LAS bf16x8*)(AbrT + fr * 40 + fq * 8); y0 = __builtin_amdgcn_mfma_f32_16x16x32_bf16(ua, gb, y0, 0, 0, 0);
#pragma unroll
            for (int i = 0; i < 4; ++i) ybuf[fr * 64 + vtile * 16 + fq * 4 + i] = y0[i]; }
        { const bf16x8 ua = *(LAS bf16x8*)(Ub + (vt * 16 + fr) * 40 + fq * 8); const bf16x8 va = *(LAS bf16x8*)(VTc + (vt * 16 + fr) * 40 + fq * 8);
#pragma unroll
          for (int q = 0; q < 2; ++q) { const int kk = (kt0 + q) * 16 + fr;
              const bf16x8 bb = *(LAS bf16x8*)(BtT + kk * 40 + fq * 8); const bf16x8 kb = *(LAS bf16x8*)(KtT + kk * 40 + fq * 8);
              f32x4 acc = stt[q]; acc = __builtin_amdgcn_mfma_f32_16x16x32_bf16(ua, bb, acc, 0, 0, 0); acc = __builtin_amdgcn_mfma_f32_16x16x32_bf16(va, kb, acc, 0, 0, 0);
              const float we = Wend[kk]; acc = acc * we; stt[q] = acc;
#pragma unroll
              for (int i = 0; i < 4; ++i) S0b[(vt * 16 + fq * 4 + i) * 72 + kk] = f2bf(acc[i]); } }
        __syncthreads();
        { const f32x2 y = *(LAS f32x2*)(ybuf + tl * 64 + 2 * l32);
          const float mu = half_sum(y.x + y.y, lo) * (1.0f / 64), d0 = y.x - mu, d1 = y.y - mu, var = half_sum(d0 * d0 + d1 * d1, lo) * (1.0f / 64), rs = rsqrtf(var + 64e-5f);
          Y32[(size_t)(ch * 16) * (D / 2)] = cvt_pk_nv((d0 * rs * lnw.x + lnb.x + bc0) * gc0, (d1 * rs * lnw.y + lnb.y + bc1) * gc1); }
        gc0 = gn0; gc1 = gn1; bc0 = bn0; bc1 = bn1;
    }
#undef RC_ISSUE
#undef RC_PREP
}

#define XB_TMO      128
#define XB_XCNT(j)  (256  + 64 * (j))
#define XB_XSUB(j)  (1280 + 64 * (j))
#define XB_XGEN(j)  (2304 + 64 * (j))
#define XB_TOP      3328
#define XB_TOPGEN   3392
#define XCD_BAR_WORDS 3456
#define XB_SPIN_CAP (1u << 18)

__device__ __forceinline__ unsigned xb_ld(unsigned* p)              { return __hip_atomic_load(p, __ATOMIC_RELAXED, __HIP_MEMORY_SCOPE_AGENT); }
__device__ __forceinline__ unsigned xb_add(unsigned* p, unsigned v) { return __hip_atomic_fetch_add(p, v, __ATOMIC_RELAXED, __HIP_MEMORY_SCOPE_AGENT); }
__device__ __forceinline__ unsigned xb_xcc_id() { return (unsigned)__builtin_amdgcn_s_getreg((3 << 11) | 20) & 0xFu; }
#define XB_SPIN(cond, bar) do { unsigned _sp = 0; while (cond) { __builtin_amdgcn_s_sleep(1); \
    if ((++_sp & 255u) == 0u) { if (xb_ld(&(bar)[XB_TMO])) break; if (_sp > XB_SPIN_CAP) { atomicAdd(&(bar)[XB_TMO], 1u); break; } } } } while (0)

struct XcdBarrier {
    unsigned* bar; unsigned x;
    volatile LAS unsigned* st;
};

__device__ __forceinline__ XcdBarrier xcd_barrier_post(unsigned* bar, volatile LAS unsigned* st) {
    XcdBarrier b; b.bar = bar; b.x = xb_xcc_id(); b.st = st;
    if (threadIdx.x == 0) (void)xb_add(&bar[XB_XCNT(b.x)], 1u);
    return b;
}
__device__ __forceinline__ void xcd_barrier_complete(unsigned* bar, unsigned x, unsigned& nloc, unsigned& nx) {
    const unsigned G = gridDim.x * gridDim.y * gridDim.z;
    unsigned sum, cnt, mine, sp = 0u;
    for (;;) {
        sum = 0u; cnt = 0u; mine = 0u;
#pragma unroll
        for (unsigned j = 0; j < 16; ++j) { const unsigned c = xb_ld(&bar[XB_XCNT(j)]); sum += c; cnt += (c > 0u) ? 1u : 0u; mine = (j == x) ? c : mine; }
        if (sum == G) break;
        __builtin_amdgcn_s_sleep(1);
        if ((++sp & 255u) == 0u) { if (xb_ld(&bar[XB_TMO])) break; if (sp > XB_SPIN_CAP) { atomicAdd(&bar[XB_TMO], 1u); break; } }
    }
    nloc = mine > 0u ? mine : 1u; nx = cnt > 0u ? cnt : 1u;
}

__device__ __forceinline__ void xcd_barrier(const XcdBarrier& b) {
    asm volatile("s_waitcnt vmcnt(0)" ::: "memory");
    __syncthreads();
    if (threadIdx.x == 0) {
        unsigned* bar = b.bar;
        __builtin_amdgcn_s_waitcnt(0);
        unsigned nloc = b.st[0], nx = b.st[1];
        if (nloc == 0u) { xcd_barrier_complete(bar, b.x, nloc, nx); b.st[0] = nloc; b.st[1] = nx; }
        const unsigned old = xb_add(&bar[XB_XSUB(b.x)], 1u);
        const unsigned gen = old / nloc;
        if (old + 1u == (gen + 1u) * nloc) {
            __builtin_amdgcn_fence(__ATOMIC_RELEASE, "agent");
            asm volatile("s_waitcnt vmcnt(0)" ::: "memory");
            const unsigned og = xb_add(&bar[XB_TOP], 1u);
            const unsigned tg = og / nx;
            if (og + 1u == (tg + 1u) * nx) xb_add(&bar[XB_TOPGEN], 1u);
            else XB_SPIN(xb_ld(&bar[XB_TOPGEN]) == tg, bar);
            __builtin_amdgcn_fence(__ATOMIC_ACQUIRE, "agent");
            xb_add(&bar[XB_XGEN(b.x)], 1u);
            asm volatile("s_waitcnt vmcnt(0)" ::: "memory");
        } else {
            XB_SPIN(xb_ld(&bar[XB_XGEN(b.x)]) == gen, bar);
            __builtin_amdgcn_fence(__ATOMIC_ACQUIRE, "agent");
            asm volatile("s_waitcnt vmcnt(0)" ::: "memory");
        }
    }
    __syncthreads();
}


__global__ __launch_bounds__(512, 2) void mega(const Params p_arg) {
    extern __shared__ __attribute__((aligned(16))) unsigned char shm[];
    const Params& p = *(const Params*)(const void*)__builtin_amdgcn_kernarg_segment_ptr();
    LAS unsigned char* lds = (LAS unsigned char*)shm;
    const int G = (int)gridDim.x, bid = (int)blockIdx.x;
    __shared__ uint4 xb_words;
    if (threadIdx.x == 0) xb_words = make_uint4(0u, 0u, 0u, 0u);
    __syncthreads();
    (void)xcd_barrier_post((unsigned*)(p.ws + WS_BAR), (volatile LAS unsigned*)&xb_words);
    const int step_lo = p.step_lo, step_hi = p.step_hi;
    for (int s = step_lo; s < step_hi; ++s) {
        const int kind = p.kind[s], lo = p.lo[s], hi = p.hi[s];
        switch (kind) {
            case K_PRE0:
#ifndef NO_PRE
 convert_tiles(p, lo, hi, lds); rope_table(p); norm_rows(p.in[0], p.in[1], (bf16_t*)(p.ws + WS_H));
#endif
 break;
            case K_GEMMB:
#ifndef NO_GB

                for (int i = lo; i < hi; ++i) { const GemmOp& o = p.g[i]; pg8::Gemm g; g.A = o.A; g.Bt = o.Bt; g.M = o.M; g.N = o.N; g.K = o.K;
                    pg8::StaticOrder S; S.init(o.M, o.N, G, (bid + G - (o.rot % G)) % G);
                    EpiB E; E.O = (bf16_t*)o.out; E.ldc = o.ldc; E.bias = o.bias; E.act = o.act;
                    pg8::gemm_phase<EpiB, pg8::StaticOrder, false>(lds, g, S, E, nullptr); }
                if (p.chi[s] > p.clo[s]) convert_queue(p, p.clo[s], p.chi[s], (unsigned*)(p.ws + WS_BAR + 16384) + 64 * p.cq[s], lds);
#endif
                break;
            case K_GEMMF:
#ifndef NO_GF

                for (int i = lo; i < hi; ++i) { const GemmOp& o = p.g[i]; pg8::Gemm g; g.A = o.A; g.Bt = o.Bt; g.M = o.M; g.N = o.N; g.K = o.K;
                    pg8::StaticOrder S; S.init(o.M, o.N, G, (bid + G - (o.rot % G)) % G);
                    EpiF E; E.C = (float*)o.out; E.ldc = o.ldc; E.res = o.res;
                    pg8::gemm_phase<EpiF, pg8::StaticOrder, false>(lds, g, S, E, nullptr); }
#endif
                break;
            case K_CONVSSD:
#ifndef NO_CONV
 conv_ssd(p);
#endif
 break;
            case K_MIX0:

#ifndef NO_SSD
for (int j = bid; j < 256; j += G) ssd_chunk_job(p, j, lds);
#endif


#ifndef NO_ATT
for (int j = bid; j < 512; j += G) attn_job(p, j, lds);
#endif

                break;
            case K_POST0: post_ssd(p); break;
            case K_NORM: norm_rows(p.out, p.in[2] + lo * D, (bf16_t*)(p.ws + WS_H)); break;
            case K_PRE1: convert_tiles(p, lo, hi, lds); mix_rows(p.out, p.in[1] + D, p.in[16], (bf16_t*)(p.ws + WS_MIX), 0, lds); break;
            case K_MIXES: mix_rows(p.out, p.in[1] + D, p.in[16], (bf16_t*)(p.ws + WS_MIX), 8192, lds); break;
            case K_RWKV:
#ifndef NO_RWKV
 for (int j = bid; j < 256; j += G) rwkv_chunk_job(p, j, lds);
#endif
 break;
            case K_NORMCONV: convert_tiles(p, lo, hi, lds); norm_rows(p.out, p.in[2] + D, (bf16_t*)(p.ws + WS_H)); break;
            default: break;
        }
        if (s + 1 < step_hi) { if (step_hi < 0) cg::this_grid().sync();   XcdBarrier xb; xb.bar = (unsigned*)(p.ws + WS_BAR); xb.x = xb_xcc_id(); xb.st = (volatile LAS unsigned*)&xb_words; xcd_barrier(xb); }
    }
}

#ifndef MK_MULTI
#define MK_MULTI 0
#endif
extern "C" void kernel_launch(void* const* d_in, const int* in_sizes, int n_in, void* d_out, int out_size, void* d_ws, size_t ws_size, hipStream_t stream) {
    static int grid = 0;
    if (grid == 0) {
        int dev = 0, cus = 0, per_cu = 0;
        hipGetDevice(&dev); hipDeviceGetAttribute(&cus, hipDeviceAttributeMultiprocessorCount, dev);
        if (hipFuncSetAttribute((const void*)mega, hipFuncAttributeMaxDynamicSharedMemorySize, LDS_BYTES) != hipSuccess) { fprintf(stderr, "hipFuncSetAttribute failed\n"); grid = -1; return; }
        if (hipOccupancyMaxActiveBlocksPerMultiprocessor(&per_cu, (const void*)mega, 512, LDS_BYTES) != hipSuccess || per_cu < 1) { fprintf(stderr, "occupancy query: %d\n", per_cu); per_cu = 1; }
        (void)hipGetLastError();
        grid = cus * per_cu; if (grid > 256) grid = 256;
        if (n_in != 34 || ws_size < 512 * MiB) { fprintf(stderr, "unexpected n_in %d / ws %zu\n", n_in, ws_size); grid = -1; return; }
    }
    if (grid < 0) return;
    static Params p;
    memset(&p, 0, sizeof(p));
    for (int i = 0; i < 34; ++i) p.in[i] = (const float*)d_in[i];
    p.out = (float*)d_out; p.ws = (unsigned char*)d_ws;
    unsigned char* ws = (unsigned char*)d_ws;
    auto B16 = [&](size_t off) { return (bf16_t*)(ws + off); };
    int ncj = 0, tile_acc = 0;
    auto CJ = [&](const float* src, size_t dst_off, int K, int N, int Kpad, int Npad) { ConvJob& c = p.cj[ncj++]; c.src = src; c.dst = B16(dst_off); c.K = K; c.N = N; c.Kpad = Kpad; c.Npad = Npad; c.tile0 = tile_acc; c.ntiles = (Kpad / 64) * (Npad / 256); tile_acc += c.ntiles; };
    const float* w_up = p.in[3]; const float* w_down = p.in[4];
    tile_acc = 0;
    CJ(p.in[5], WS_WBA, 2048, 4112, 2048, 4352); CJ(p.in[15], WS_WBA + 17 * MiB, 2048, 2048, 2048, 2048);
    tile_acc = 0;
    CJ(w_up, WS_WMLP, 2048, 8192, 2048, 8192); CJ(w_down, WS_WMLP + 32 * MiB, 8192, 2048, 8192, 2048);
    tile_acc = 0;
    CJ(p.in[28], WS_WBA, 2048, 2048, 2048, 2048); CJ(p.in[29], WS_WBA + 8 * MiB, 2048, 2048, 2048, 2048); CJ(p.in[30], WS_WBA + 16 * MiB, 2048, 2048, 2048, 2048); CJ(p.in[31], WS_WBA + 24 * MiB, 2048, 2048, 2048, 2048);
    CJ(p.in[18], WS_WBA + 32 * MiB, 2048, 96, 2048, 256); CJ(p.in[21], WS_WBA + 33 * MiB, 2048, 96, 2048, 256); CJ(p.in[23], WS_WBA + 34 * MiB, 2048, 256, 2048, 256);
    CJ(p.in[19], WS_WBA + 35 * MiB, 96, 2048, 256, 2048); CJ(p.in[22], WS_WBA + 36 * MiB, 96, 2048, 256, 2048); CJ(p.in[24], WS_WBA + 37 * MiB, 256, 2048, 256, 2048);
    tile_acc = 0;
    CJ(w_up + (size_t)2048 * 8192, WS_WMLP1, 2048, 8192, 2048, 8192); CJ(w_down + (size_t)2048 * 8192, WS_WMLP1 + 32 * MiB, 8192, 2048, 8192, 2048);
    int nop = 0;
    auto GO = [&](const bf16_t* A, const bf16_t* Bt, void* out, const float* bias, const float* res, int M, int N, int K, int ldc, int act, int rot) {
        GemmOp& o = p.g[nop++]; o.A = A; o.Bt = Bt; o.out = out; o.bias = bias; o.res = res; o.M = M; o.N = N; o.K = K; o.ldc = ldc; o.act = act; o.rot = rot; };
    GO(B16(WS_H), B16(WS_WBA), B16(WS_PROJ), nullptr, nullptr, MTOK, INWP, 2048, INWP, 0, 0);
    GO(B16(WS_YMIX), B16(WS_WBA + 17 * MiB), d_out, nullptr, p.in[0], MTOK, 2048, 2048, 2048, 0, 0);
    GO(B16(WS_H), B16(WS_WMLP), B16(WS_U), nullptr, nullptr, MTOK, DFF, 2048, DFF, 1, 0);
    GO(B16(WS_U), B16(WS_WMLP + 32 * MiB), d_out, nullptr, (const float*)d_out, MTOK, 2048, DFF, 2048, 0, 0);
    for (int half = 0; half < 2; ++half) {
        const size_t ro = (size_t)half * 8192 * 2048 * 2, lo_ = (size_t)half * 8192 * 256 * 2; const size_t mb = (size_t)8192 * 2048 * 2;
        GO(B16(WS_MIX + 0 * mb), B16(WS_WBA), B16(WS_R + ro), nullptr, nullptr, 8192, 2048, 2048, 2048, 0, 0);
        GO(B16(WS_MIX + 2 * mb), B16(WS_WBA + 8 * MiB), B16(WS_K + ro), nullptr, nullptr, 8192, 2048, 2048, 2048, 0, 0);
        GO(B16(WS_MIX + 3 * mb), B16(WS_WBA + 16 * MiB), B16(WS_V + ro), nullptr, nullptr, 8192, 2048, 2048, 2048, 0, 0);
        GO(B16(WS_MIX + 1 * mb), B16(WS_WBA + 32 * MiB), B16(WS_L1W + lo_), nullptr, nullptr, 8192, 256, 2048, 256, 2, 0);
        GO(B16(WS_MIX + 4 * mb), B16(WS_WBA + 33 * MiB), B16(WS_L1A + lo_), nullptr, nullptr, 8192, 256, 2048, 256, 0, 32);
        GO(B16(WS_MIX + 5 * mb), B16(WS_WBA + 34 * MiB), B16(WS_L1G + lo_), nullptr, nullptr, 8192, 256, 2048, 256, 3, 64);
    }
    GO(B16(WS_L1W), B16(WS_WBA + 35 * MiB), B16(WS_WDEC), p.in[17], nullptr, MTOK, 2048, 256, 2048, 4, 0);
    GO(B16(WS_L1A), B16(WS_WBA + 36 * MiB), B16(WS_AA), p.in[20], nullptr, MTOK, 2048, 256, 2048, 3, 0);
    GO(B16(WS_L1G), B16(WS_WBA + 37 * MiB), B16(WS_GG), nullptr, nullptr, MTOK, 2048, 256, 2048, 0, 0);
    GO(B16(WS_YG), B16(WS_WBA + 24 * MiB), d_out, nullptr, (const float*)d_out, MTOK, 2048, 2048, 2048, 0, 0);
    GO(B16(WS_H), B16(WS_WMLP1), B16(WS_U), nullptr, nullptr, MTOK, DFF, 2048, DFF, 1, 0);
    GO(B16(WS_U), B16(WS_WMLP1 + 32 * MiB), d_out, nullptr, (const float*)d_out, MTOK, 2048, DFF, 2048, 0, 0);
    int ns = 0;
    auto ST = [&](int kind, int lo, int hi, int clo = 0, int chi = 0, int cq = 0) { p.kind[ns] = kind; p.lo[ns] = lo; p.hi[ns] = hi; p.clo[ns] = clo; p.chi[ns] = chi; p.cq[ns] = cq; ++ns; };
    ST(K_PRE0, 0, 2); ST(K_GEMMB, 0, 1, 2, 4, 0); ST(K_CONVSSD, 0, 0); ST(K_MIX0, 0, 0); ST(K_POST0, 0, 0); ST(K_GEMMF, 1, 2); ST(K_NORM, 0, 0); ST(K_GEMMB, 2, 3); ST(K_GEMMF, 3, 4);
    ST(K_PRE1, 4, 14); ST(K_GEMMB, 4, 10, 14, 16, 1); ST(K_MIXES, 0, 0); ST(K_GEMMB, 10, 16, 14, 16, 1); ST(K_GEMMB, 16, 19); ST(K_RWKV, 0, 0); ST(K_GEMMF, 19, 20); ST(K_NORM, 1, 0); ST(K_GEMMB, 20, 21); ST(K_GEMMF, 21, 22);
    (void)hipMemsetAsync(ws + WS_BAR, 0, 16384 + 1024, stream);
#if MK_MULTI
    for (int s = 0; s < ns; ++s) { p.step_lo = s; p.step_hi = s + 1; hipLaunchKernelGGL(mega, dim3(grid), dim3(512), LDS_BYTES, stream, p); }
#else
    p.step_lo = 0; p.step_hi = ns;
    void* args[] = {(void*)&p};
    const hipError_t e = hipLaunchCooperativeKernel((const void*)mega, dim3(grid), dim3(512), args, LDS_BYTES, stream);
    if (e != hipSuccess) fprintf(stderr, "cooperative launch failed: %s (grid %d)\n", hipGetErrorString(e), grid);
#endif
}
```

```cpp
#include <hip/hip_runtime.h>
#include <hip/hip_cooperative_groups.h>
#include <cstdio>
#include <cstring>
namespace cg = cooperative_groups;
__device__ __forceinline__ int opq(int v) { asm volatile("" : "+v"(v)); return v; }
namespace pg8 {
#define PG8_LAS __attribute__((address_space(3)))
typedef unsigned short bf16_t;
typedef short bf16x8 __attribute__((ext_vector_type(8)));
typedef float f32x4 __attribute__((ext_vector_type(4)));
typedef unsigned u32x4 __attribute__((ext_vector_type(4)));
constexpr int BM = 256, BK = 64, HALF = 128, HTB = HALF * BK * 2  , STAGE_BYTES = 8 * HTB, NXCD = 8, WGM = 8;

__host__ __device__ __forceinline__ int lds_byte(int r, int c) { const int st = (r >> 4) * 2 + (c >> 5), rr = r & 15, cc = c & 31, ob = rr * 64 + cc * 2; return st * 1024 + (ob ^ (((ob >> 9) & 1) << 5)); }
__host__ __device__ __forceinline__ void stage_rc(int b, int& R, int& C) { const int st = b / 1024, sb = b % 1024, swz = sb ^ (((sb >> 9) & 1) << 5); R = (st >> 1) * 16 + swz / 64; C = (st & 1) * 32 + (swz % 64) / 2; }
__host__ __device__ __forceinline__ int perm32(int rho) { const int n = rho >> 4, i = rho & 15; return 8 * (i >> 2) + 4 * n + (i & 3); }

struct Unit { int pm, pn; };
struct Gemm { const bf16_t* A; const bf16_t* Bt; int M, N, K; };

struct StaticOrder {
    int nM, nN, nwg, G, c;
    __host__ __device__ void init(int M, int N, int G_, int c_) { nM = M / BM; nN = N / BM; nwg = nM * nN; G = G_; c = c_; }
    __host__ __device__ bool next(int i, Unit& u) const {
        const long L = (long)i * G + c; if (L >= nwg) return false;
        int wgid = (int)L; { const int q = nwg / NXCD, r = nwg % NXCD, xcd = wgid % NXCD, off = wgid / NXCD; wgid = (xcd < r ? xcd * (q + 1) : r * (q + 1) + (xcd - r) * q) + off; }
        const int nig = WGM * nN, gid = wgid / nig, fm = gid * WGM, gsz = (nM - fm) < WGM ? (nM - fm) : WGM;
        u.pm = fm + ((wgid % nig) % gsz); u.pn = (wgid % nig) / gsz; return true;
    }
    __device__ __forceinline__ void a_ready(const Unit&) const {}
    __device__ __forceinline__ void done(const Unit&) const {}
};
typedef __bf16 bf16x2_t __attribute__((ext_vector_type(2)));
typedef float f32x2_t __attribute__((ext_vector_type(2)));
__device__ __forceinline__ unsigned cvt_pk_bf16(float lo, float hi) { const f32x2_t f = {lo, hi}; const bf16x2_t v = __builtin_convertvector(f, bf16x2_t); return __builtin_bit_cast(unsigned, v); }
__device__ __forceinline__ unsigned cvt_pk_nv(float lo, float hi) { return cvt_pk_bf16(lo, hi); }

template <class Epi, class Sched, bool STAMP = false>
__device__ __forceinline__ void gemm_phase(PG8_LAS unsigned char* lds, const Gemm g, const Sched& S, const Epi& E, unsigned long long* stamps) {
    const int tid = opq(threadIdx.x), wid = __builtin_amdgcn_readfirstlane(tid >> 6), lane = tid & 63, wr = wid >> 2, wc = wid & 3, fr = lane & 15, fq = lane >> 4;
    const int K = g.K, nt = K / BK;
    int ts_lo = 0, ts_hi = 0, nts = 0; const unsigned long long rt_entry = STAMP ? (unsigned long long)wall_clock64() : 0ull;
#define PG8_STAMP() do { if (STAMP && wid == 0 && nts < 64) { const unsigned long long _c = (unsigned long long)clock64(); \
        ts_lo = (lane == nts) ? (int)(unsigned)_c : ts_lo; ts_hi = (lane == nts) ? (int)(unsigned)(_c >> 32) : ts_hi; ++nts; } } while (0)
    PG8_STAMP();
    unsigned voffA[2], voffB[2];
#pragma unroll
    for (int i = 0; i < 2; ++i) { int R, C; stage_rc(tid * 16 + i * 8192, R, C); const int Rb = Epi::PERM ? ((R & ~31) + perm32(R & 31)) : R;
        voffA[i] = (unsigned)(R * K + C) * 2u; voffB[i] = (unsigned)(Rb * K + C) * 2u; }
    const size_t kstep = (size_t)(BK * 2);
    const size_t hstep = (size_t)HALF * K * 2;
    const size_t tstep = 2 * hstep;
    const unsigned ldsw = (unsigned)wid * 1024u;
    const int aoff = lds_byte(wr * 64 + fr, fq * 8), boff = lds_byte(wc * 32 + fr, fq * 8);
#define PG8_SA(b, h) (((b) * 2 + (h)) * HTB)
#define PG8_SB(b, h) ((4 + (b) * 2 + (h)) * HTB)
#define PG8_STAGE(bufoff, gbase, voff) do { _Pragma("unroll") for (int _i = 0; _i < 2; ++_i) \
        __builtin_amdgcn_global_load_lds((const unsigned*)((const char*)(gbase) + (voff)[_i]), (PG8_LAS unsigned*)(lds + (bufoff) + ldsw + _i * 8192), 16, 0, 0); } while (0)
#define PG8_LDA(dst, b, h) do { _Pragma("unroll") for (int m = 0; m < 4; ++m) _Pragma("unroll") for (int k = 0; k < 2; ++k) dst[m][k] = *(const PG8_LAS bf16x8*)(lds + PG8_SA(b, h) + aoff + m * 2048 + k * 1024); } while (0)
#define PG8_LDB(dst, b, h) do { _Pragma("unroll") for (int n = 0; n < 2; ++n) _Pragma("unroll") for (int k = 0; k < 2; ++k) dst[n][k] = *(const PG8_LAS bf16x8*)(lds + PG8_SB(b, h) + boff + n * 2048 + k * 1024); } while (0)
#define PG8_MMA(ai, bj, At, Bt) do { __builtin_amdgcn_s_setprio(1); _Pragma("unroll") for (int m = 0; m < 4; ++m) _Pragma("unroll") for (int n = 0; n < 2; ++n) _Pragma("unroll") for (int k = 0; k < 2; ++k) \
        acc[ai][bj][m][n] = __builtin_amdgcn_mfma_f32_16x16x32_bf16(Bt[n][k], At[m][k], acc[ai][bj][m][n], 0, 0, 0); __builtin_amdgcn_s_setprio(0); } while (0)
#define PG8_WAIT_V(n) asm volatile("s_waitcnt vmcnt(" #n ")" ::: "memory")
#define PG8_WAIT_L(n) asm volatile("s_waitcnt lgkmcnt(" #n ")" ::: "memory")
#define PG8_BAR __builtin_amdgcn_s_barrier()
#define PG8_SCHED __builtin_amdgcn_sched_barrier(0)
    Unit cur, nxt; int ui = 0;
    if (!S.next(0, cur)) return;
    f32x4 acc[2][2][4][2];
#pragma unroll
    for (int a = 0; a < 2; ++a)
#pragma unroll
        for (int b = 0; b < 2; ++b)
#pragma unroll
            for (int m = 0; m < 4; ++m)
#pragma unroll
                for (int n = 0; n < 2; ++n) acc[a][b][m][n] = (f32x4){0.f, 0.f, 0.f, 0.f};
    bf16x8 At[4][2], B0[2][2], B1[2][2];
    const char* cA = (const char*)g.A + (size_t)cur.pm * tstep; const char* cB = (const char*)g.Bt + (size_t)cur.pn * tstep;
    S.a_ready(cur);
    PG8_STAGE(PG8_SB(0, 0), cB, voffB); PG8_STAGE(PG8_SA(0, 0), cA, voffA); PG8_STAGE(PG8_SB(0, 1), cB + hstep, voffB); PG8_STAGE(PG8_SA(0, 1), cA + hstep, voffA);
    if (wr == 1) PG8_BAR;
    PG8_WAIT_V(4); PG8_BAR;
    PG8_STAGE(PG8_SB(1, 0), cB + kstep, voffB); PG8_STAGE(PG8_SA(1, 0), cA + kstep, voffA); PG8_STAGE(PG8_SB(1, 1), cB + hstep + kstep, voffB);
    PG8_WAIT_V(6); PG8_BAR;
    PG8_STAMP();
    for (;;) {
        const bool has_next = S.next(ui + 1, nxt);
        const char* nA = has_next ? (const char*)g.A + (size_t)nxt.pm * tstep : cA; const char* nB = has_next ? (const char*)g.Bt + (size_t)nxt.pn * tstep : cB;
        for (int t = 0; t < nt; t += 2) {
            const bool last = (t == nt - 2);
            const char* a1 = cA + (size_t)(t + 1) * kstep;
            const char* a2 = last ? nA : cA + (size_t)(t + 2) * kstep; const char* b2 = last ? nB : cB + (size_t)(t + 2) * kstep;
            const char* a3 = a2 + kstep; const char* b3 = b2 + kstep;
            if (last && has_next) S.a_ready(nxt);
            PG8_LDB(B0, 0, 0); PG8_SCHED; PG8_LDA(At, 0, 0); PG8_STAGE(PG8_SA(1, 1), a1 + hstep, voffA);
            PG8_WAIT_L(8); PG8_BAR; PG8_WAIT_L(0); PG8_MMA(0, 0, At, B0); PG8_BAR; PG8_SCHED;
            PG8_LDB(B1, 0, 1); PG8_STAGE(PG8_SB(0, 0), b2, voffB);
            PG8_BAR; PG8_WAIT_L(0); PG8_MMA(0, 1, At, B1); PG8_BAR;
            PG8_LDA(At, 0, 1); PG8_STAGE(PG8_SA(0, 0), a2, voffA);
            PG8_BAR; PG8_WAIT_L(0); PG8_MMA(1, 0, At, B0); PG8_BAR; PG8_SCHED;
            PG8_STAGE(PG8_SB(0, 1), b2 + hstep, voffB);
            PG8_WAIT_V(6); PG8_BAR; PG8_MMA(1, 1, At, B1); PG8_BAR;
            PG8_LDB(B0, 1, 0); PG8_SCHED; PG8_LDA(At, 1, 0); PG8_STAGE(PG8_SA(0, 1), a2 + hstep, voffA);
            PG8_WAIT_L(8); PG8_BAR; PG8_WAIT_L(0); PG8_MMA(0, 0, At, B0); PG8_BAR; PG8_SCHED;
            PG8_LDB(B1, 1, 1); PG8_STAGE(PG8_SB(1, 0), b3, voffB);
            PG8_BAR; PG8_WAIT_L(0); PG8_MMA(0, 1, At, B1); PG8_BAR;
            PG8_LDA(At, 1, 1); PG8_STAGE(PG8_SA(1, 0), a3, voffA);
            PG8_BAR; PG8_WAIT_L(0); PG8_MMA(1, 0, At, B0); PG8_BAR; PG8_SCHED;
            PG8_STAGE(PG8_SB(1, 1), b3 + hstep, voffB);
            PG8_WAIT_V(6); PG8_BAR; PG8_MMA(1, 1, At, B1); PG8_BAR;
        }
        PG8_STAMP();
        if constexpr (!Epi::AFTER_DRAIN) { E(acc, cur, wr, wc, fr, fq); S.done(cur); }
        PG8_STAMP();
        if (!has_next) break;
#pragma unroll
        for (int a = 0; a < 2; ++a)
#pragma unroll
            for (int b = 0; b < 2; ++b)
#pragma unroll
                for (int m = 0; m < 4; ++m)
#pragma unroll
                    for (int n = 0; n < 2; ++n) acc[a][b][m][n] = (f32x4){0.f, 0.f, 0.f, 0.f};
        cur = nxt; cA = nA; cB = nB; ++ui;
    }
    PG8_WAIT_V(0);
    if (wr == 0) PG8_BAR;
    PG8_BAR;
    if constexpr (Epi::AFTER_DRAIN) { E.fused(acc, cur, wr, wc, fr, fq, lds, wid, lane); S.done(cur); }
    PG8_STAMP();
    if (STAMP && wid == 0) { stamps[lane] = lane < nts ? (((unsigned long long)(unsigned)ts_hi << 32) | (unsigned)ts_lo) : 0ull;
        if (lane == 62) stamps[62] = rt_entry; if (lane == 63) stamps[63] = (unsigned long long)wall_clock64(); }
#undef PG8_STAMP
#undef PG8_SA
#undef PG8_SB
#undef PG8_STAGE
#undef PG8_LDA
#undef PG8_LDB
#undef PG8_MMA
#undef PG8_WAIT_V
#undef PG8_WAIT_L
#undef PG8_BAR
#undef PG8_SCHED
}
}

#include <cstdio>
#include <ctime>
#include <cstdlib>
#include <cstring>
#include <cmath>
#include <vector>
#include <algorithm>
#define CK(x) do { hipError_t e_ = (x); if (e_ != hipSuccess) { fprintf(stderr, "HIP %s:%d %s\n", __FILE__, __LINE__, hipGetErrorString(e_)); exit(2); } } while (0)
using pg8::bf16_t; using pg8::bf16x8; using pg8::f32x4; using pg8::u32x4; using pg8::cvt_pk_bf16; using pg8::cvt_pk_nv;
#define LAS PG8_LAS

constexpr int D = 2048, SEQ = 2048, MTOK = 16384, DFF = 8192, INWP = 4352;
constexpr int COL_K = 1024, COL_V = 1280, COL_Z = 1536, COL_XBC = 2560, COL_DT = 4096;
constexpr size_t MiB = (size_t)1 << 20;
constexpr size_t WS_WBA = 0, WS_WMLP = 40 * MiB, WS_H = 104 * MiB, WS_PROJ = 168 * MiB, WS_YMIX = 304 * MiB, WS_YRAW = 368 * MiB, WS_XBC = 432 * MiB,
                 WS_DT = 480 * MiB, WS_DA = 481 * MiB, WS_ROPE = 482 * MiB, WS_U = 168 * MiB;
constexpr size_t WS_R = 40 * MiB, WS_K = 104 * MiB, WS_V = 168 * MiB, WS_L1W = 232 * MiB, WS_L1A = 240 * MiB, WS_L1G = 248 * MiB, WS_MIX = 256 * MiB,
                 WS_WDEC = 256 * MiB, WS_AA = 320 * MiB, WS_GG = 384 * MiB, WS_YG = 40 * MiB  , WS_WMLP1 = 448 * MiB;
constexpr size_t WS_BAR = 39 * MiB;
constexpr int LDS_BYTES = 140 * 1024;

enum { K_PRE0 = 0, K_GEMMB, K_GEMMF, K_CONVSSD, K_MIX0, K_POST0, K_NORM, K_PRE1, K_MIXES, K_RWKV, K_NORMCONV };
constexpr int NSTEPS = 48, NOPS = 22, NCJ = 16;
#define REP_GEMMB 1
#define REP_MIX0 1
#define REP_RWKV 1
#define REP_ELEM 1

struct GemmOp { const bf16_t* A; const bf16_t* Bt; void* out; const float* bias; const float* res; int M, N, K, ldc, act, rot, pad0, pad1; };
struct ConvJob { const float* src; bf16_t* dst; int K, N, Kpad, Npad, tile0, ntiles; };
struct Params {
    const float* in[34];
    float* out; unsigned char* ws;
    GemmOp g[NOPS];
    ConvJob cj[NCJ];
    int kind[NSTEPS + 1]; int lo[NSTEPS + 1]; int hi[NSTEPS + 1]; int clo[NSTEPS + 1]; int chi[NSTEPS + 1]; int cq[NSTEPS + 1];
    int step_lo, step_hi;
};

__device__ __forceinline__ float bf2f(unsigned short b) { return __uint_as_float(((unsigned)b) << 16); }
__device__ __forceinline__ float bflo(unsigned w) { return __uint_as_float(w << 16); }
__device__ __forceinline__ float bfhi(unsigned w) { return __uint_as_float(w & 0xffff0000u); }
__device__ __forceinline__ bf16_t f2bf(float f) { return (bf16_t)(cvt_pk_bf16(f, 0.f) & 0xffffu); }
template <int CTRL> __device__ __forceinline__ float dpp_add(float x) {
    const int y = __builtin_amdgcn_update_dpp(0, __builtin_bit_cast(int, x), CTRL, 0xf, 0xf, true);
    return x + __builtin_bit_cast(float, y); }
template <int CTRL> __device__ __forceinline__ float dpp_max(float x) {
    const int y = __builtin_amdgcn_update_dpp(0, __builtin_bit_cast(int, x), CTRL, 0xf, 0xf, true);
    return fmaxf(x, __builtin_bit_cast(float, y)); }
__device__ __forceinline__ float max16(float x) { x = dpp_max<0xB1>(x); x = dpp_max<0x4E>(x); x = dpp_max<0x141>(x); x = dpp_max<0x140>(x); return x; }
__device__ __forceinline__ float red8(float x) { x = dpp_add<0xB1>(x); x = dpp_add<0x4E>(x); x = dpp_add<0x141>(x); return x; }
__device__ __forceinline__ float red16(float x) { x = red8(x); x = dpp_add<0x140>(x); return x; }
__device__ __forceinline__ float wave_sum(float v) {
    v = red16(v);
    const float r0 = __builtin_bit_cast(float, __builtin_amdgcn_readlane(__builtin_bit_cast(int, v), 0)), r1 = __builtin_bit_cast(float, __builtin_amdgcn_readlane(__builtin_bit_cast(int, v), 16));
    const float r2 = __builtin_bit_cast(float, __builtin_amdgcn_readlane(__builtin_bit_cast(int, v), 32)), r3 = __builtin_bit_cast(float, __builtin_amdgcn_readlane(__builtin_bit_cast(int, v), 48));
    return (r0 + r1) + (r2 + r3); }
typedef float f32x2 __attribute__((ext_vector_type(2)));
typedef unsigned u32x2 __attribute__((ext_vector_type(2)));
__device__ __forceinline__ float sigmoidf_(float v) { return __builtin_amdgcn_rcpf(1.0f + __expf(-v)); }
__device__ __forceinline__ void unpack8(const uint4 r, float (&f)[8]) {
    f[0] = bflo(r.x); f[1] = bfhi(r.x); f[2] = bflo(r.y); f[3] = bfhi(r.y); f[4] = bflo(r.z); f[5] = bfhi(r.z); f[6] = bflo(r.w); f[7] = bfhi(r.w); }

__device__ __forceinline__ float act_apply(float v, int act) {
    switch (act) {
        case 1: { const float r = fmaxf(v, 0.f); return r * r; }
        case 2: return 1.0f - 2.0f * __builtin_amdgcn_rcpf(1.0f + __expf(2.0f * v));
        case 3: return sigmoidf_(v);
        case 4: return 0.60653066f * sigmoidf_(v);
        default: return v; }
}
struct EpiB {
    static constexpr bool PERM = true, AFTER_DRAIN = false;
    bf16_t* O; int ldc; const float* bias; int act;
    __device__ __forceinline__ void operator()(const f32x4 (&acc)[2][2][4][2], const pg8::Unit& u, int wr, int wc, int fr, int fq) const {
        const int row0 = u.pm * 256 + wr * 64 + fr, col0 = u.pn * 256 + wc * 32 + 8 * fq;
        f32x4 bv[2][2];
#pragma unroll
        for (int bj = 0; bj < 2; ++bj)
#pragma unroll
            for (int n = 0; n < 2; ++n) bv[bj][n] = bias ? *(const f32x4*)(bias + col0 + bj * 128 + 4 * n) : (f32x4){0.f, 0.f, 0.f, 0.f};
#pragma unroll
        for (int ai = 0; ai < 2; ++ai)
#pragma unroll
            for (int m = 0; m < 4; ++m) { bf16_t* rowp = O + (size_t)(row0 + ai * 128 + m * 16) * ldc + col0;
#pragma unroll
                for (int bj = 0; bj < 2; ++bj) { f32x4 v0 = acc[ai][bj][m][0], v1 = acc[ai][bj][m][1];
                    v0 += bv[bj][0]; v1 += bv[bj][1];
                    if (act) {
#pragma unroll
                        for (int j = 0; j < 4; ++j) { v0[j] = act_apply(v0[j], act); v1[j] = act_apply(v1[j], act); } }
                    u32x4 w; w.x = cvt_pk_bf16(v0[0], v0[1]); w.y = cvt_pk_bf16(v0[2], v0[3]); w.z = cvt_pk_bf16(v1[0], v1[1]); w.w = cvt_pk_bf16(v1[2], v1[3]);
                    *(u32x4*)(rowp + bj * 128) = w; } }
    }
};
struct EpiF {
    static constexpr bool PERM = false, AFTER_DRAIN = false;
    float* C; int ldc; const float* res;
    __device__ __forceinline__ void operator()(const f32x4 (&acc)[2][2][4][2], const pg8::Unit& u, int wr, int wc, int fr, int fq) const {
        const int row0 = u.pm * 256 + wr * 64 + fr, col0 = u.pn * 256 + wc * 32 + 4 * fq;
#pragma unroll
        for (int ai = 0; ai < 2; ++ai)
#pragma unroll
            for (int mh = 0; mh < 2; ++mh) { size_t ro[2]; f32x4 r[2][2][2];
#pragma unroll
                for (int mm = 0; mm < 2; ++mm) { ro[mm] = (size_t)(row0 + ai * 128 + (mh * 2 + mm) * 16) * ldc + col0;
#pragma unroll
                    for (int bj = 0; bj < 2; ++bj)
#pragma unroll
                        for (int n = 0; n < 2; ++n) r[mm][bj][n] = *(const f32x4*)(res + ro[mm] + bj * 128 + n * 16); }
#pragma unroll
                for (int mm = 0; mm < 2; ++mm)
#pragma unroll
                    for (int bj = 0; bj < 2; ++bj)
#pragma unroll
                        for (int n = 0; n < 2; ++n) *(f32x4*)(C + ro[mm] + bj * 128 + n * 16) = acc[ai][bj][mh * 2 + mm][n] + r[mm][bj][n]; }
    }
};

__device__ __forceinline__ void convert_one_tile(const Params& p, int jlo, int jhi, int tile, int tid, LAS float* T) {
    int j = jlo; while (j + 1 < jhi && tile >= p.cj[j + 1].tile0) ++j;
    const float* src = p.cj[j].src; bf16_t* dst = p.cj[j].dst; const int K = p.cj[j].K, N = p.cj[j].N, Kpad = p.cj[j].Kpad;
    const int local = tile - p.cj[j].tile0, nkt = Kpad >> 6, kt = local % nkt, nt = local / nkt;
    f32x4 v[8];
#pragma unroll
    for (int i = 0; i < 8; ++i) { const int idx = tid + i * 512, kr = idx >> 6, c4 = idx & 63, k = kt * 64 + kr, n = nt * 256 + c4 * 4;
        v[i] = (f32x4){0.f, 0.f, 0.f, 0.f};
        if (k < K && n < N) v[i] = *(const f32x4*)(src + (size_t)k * N + n); }
#pragma unroll
    for (int i = 0; i < 8; ++i) { const int idx = tid + i * 512, kr = idx >> 6, c4 = idx & 63;
        T[kr * 257 + c4 * 4 + 0] = v[i][0]; T[kr * 257 + c4 * 4 + 1] = v[i][1]; T[kr * 257 + c4 * 4 + 2] = v[i][2]; T[kr * 257 + c4 * 4 + 3] = v[i][3]; }
    __syncthreads();
#pragma unroll
    for (int i = 0; i < 4; ++i) { const int idx = tid + i * 512, nl = idx >> 3, kc = idx & 7; float f[8];
#pragma unroll
        for (int e = 0; e < 8; ++e) f[e] = T[(kc * 8 + e) * 257 + nl];
        u32x4 w; w.x = cvt_pk_nv(f[0], f[1]); w.y = cvt_pk_nv(f[2], f[3]); w.z = cvt_pk_nv(f[4], f[5]); w.w = cvt_pk_nv(f[6], f[7]);
        *(u32x4*)(dst + (size_t)(nt * 256 + nl) * Kpad + kt * 64 + kc * 8) = w; }
    __syncthreads();
}
__device__ __forceinline__ void convert_tiles(const Params& p, int jlo, int jhi, LAS unsigned char* lds) {
    const int tid = opq(threadIdx.x); LAS float* T = (LAS float*)lds;
    const int total = p.cj[jhi - 1].tile0 + p.cj[jhi - 1].ntiles;
    for (int tile = blockIdx.x; tile < total; tile += gridDim.x) convert_one_tile(p, jlo, jhi, tile, tid, T);
}
__device__ __forceinline__ void convert_queue(const Params& p, int jlo, int jhi, unsigned* counter, LAS unsigned char* lds) {
    const int tid = opq(threadIdx.x); LAS float* T = (LAS float*)lds; LAS int* slot = (LAS int*)(lds + 72 * 1024);
    const int total = p.cj[jhi - 1].tile0 + p.cj[jhi - 1].ntiles;
    for (;;) {
        __syncthreads();
        if (tid == 0) *slot = (int)__hip_atomic_fetch_add(counter, 1u, __ATOMIC_RELAXED, __HIP_MEMORY_SCOPE_AGENT);
        __syncthreads();
        const int tile = *slot;
        if (tile >= total) break;
        convert_one_tile(p, jlo, jhi, tile, tid, T);
    }
}

__device__ __forceinline__ void rope_table(const Params& p) {
    float2* tab = (float2*)(p.ws + WS_ROPE);
    for (int idx = blockIdx.x * 512 + opq(threadIdx.x); idx < SEQ * 32; idx += gridDim.x * 512) {
        const int t = idx >> 5, i = idx & 31;
        const float inv = exp2f(-(float)i * 0.41524101186092029f);
        const float angf = (float)t * inv;
        const double ang = (double)angf;
        const double q = rint(ang * 0.6366197723675814);
        const float f = (float)fma(-q, 1.5707963267948966, ang), f2 = f * f;
        const float s = f * (1.0f + f2 * (-1.6666667e-1f + f2 * (8.3333333e-3f + f2 * (-1.9841270e-4f + f2 * 2.7557319e-6f))));
        const float c = 1.0f + f2 * (-0.5f + f2 * (4.1666667e-2f + f2 * (-1.3888889e-3f + f2 * (2.4801587e-5f + f2 * (-2.7557319e-7f)))));
        const int qi = ((int)q) & 3;
        const float sn = (qi == 0) ? s : (qi == 1) ? c : (qi == 2) ? -s : -c;
        const float cs = (qi == 0) ? c : (qi == 1) ? -s : (qi == 2) ? -c : s;
        tab[idx] = make_float2(cs, sn);
    }
}

__device__ __forceinline__ void norm_rows(const float* x, const float* g, bf16_t* h) {
    const int tid_ = opq(threadIdx.x); const int lane = tid_ & 63, wv = tid_ >> 6;
    f32x4 gg[8];
#pragma unroll
    for (int i = 0; i < 8; ++i) gg[i] = *(const f32x4*)(g + i * 256 + lane * 4);
    for (int row = (blockIdx.x * 8 + wv) * 2; row < MTOK; row += gridDim.x * 16) {
        const float* xr = x + (size_t)row * D; f32x4 v[8], u[8]; float ss = 0.f, st = 0.f;
#pragma unroll
        for (int i = 0; i < 8; ++i) { v[i] = *(const f32x4*)(xr + i * 256 + lane * 4); u[i] = *(const f32x4*)(xr + D + i * 256 + lane * 4); }
#pragma unroll
        for (int i = 0; i < 8; ++i) { ss += v[i][0] * v[i][0] + v[i][1] * v[i][1] + v[i][2] * v[i][2] + v[i][3] * v[i][3]; st += u[i][0] * u[i][0] + u[i][1] * u[i][1] + u[i][2] * u[i][2] + u[i][3] * u[i][3]; }
        ss = wave_sum(ss); st = wave_sum(st); const float r = rsqrtf(ss * (1.0f / D) + 1e-6f), r2 = rsqrtf(st * (1.0f / D) + 1e-6f);
#pragma unroll
        for (int i = 0; i < 8; ++i) {
            uint2 w; w.x = cvt_pk_nv(v[i][0] * r * gg[i][0], v[i][1] * r * gg[i][1]); w.y = cvt_pk_nv(v[i][2] * r * gg[i][2], v[i][3] * r * gg[i][3]);
            *(uint2*)(h + (size_t)row * D + i * 256 + lane * 4) = w;
            uint2 w2; w2.x = cvt_pk_nv(u[i][0] * r2 * gg[i][0], u[i][1] * r2 * gg[i][1]); w2.y = cvt_pk_nv(u[i][2] * r2 * gg[i][2], u[i][3] * r2 * gg[i][3]);
            *(uint2*)(h + (size_t)(row + 1) * D + i * 256 + lane * 4) = w2; }
    }
}

__device__ __forceinline__ void mix_rows(const float* x, const float* g, const float* mixw, bf16_t* mixbase, int tok0, LAS unsigned char* lds) {
    const int tid = opq(threadIdx.x), lane = tid & 63, wv = tid >> 6, c = tid * 4;
    LAS float* rs = (LAS float*)lds;
    const f32x4 gg = *(const f32x4*)(g + c); f32x4 mw[6];
#pragma unroll
    for (int m = 0; m < 6; ++m) mw[m] = *(const f32x4*)(mixw + m * D + c);
    for (int chunk = blockIdx.x; chunk < 256; chunk += gridDim.x) {
        const int rl0 = chunk * 32, tokc = tok0 + rl0; const bool hasprev = (tokc & (SEQ - 1)) != 0;
        __syncthreads();
        for (int r = wv; r < 33; r += 8) {
            float ss = 0.f;
            if (r > 0 || hasprev) { const float* xr = x + (size_t)(tokc - 1 + r) * D; f32x4 v[8];
#pragma unroll
                for (int i = 0; i < 8; ++i) v[i] = *(const f32x4*)(xr + i * 256 + lane * 4);
#pragma unroll
                for (int i = 0; i < 8; ++i) ss += v[i][0] * v[i][0] + v[i][1] * v[i][1] + v[i][2] * v[i][2] + v[i][3] * v[i][3]; }
            ss = wave_sum(ss);
            if (lane == 0) rs[r] = (r > 0 || hasprev) ? rsqrtf(ss * (1.0f / D) + 1e-6f) : 0.f;
        }
        __syncthreads();
        f32x4 prev = (f32x4){0.f, 0.f, 0.f, 0.f};
        if (hasprev) { const f32x4 pv = *(const f32x4*)(x + (size_t)(tokc - 1) * D + c); const float rp = rs[0]; prev = pv * rp * gg; }
        for (int r0 = 0; r0 < 32; r0 += 4) {
            f32x4 xv[4];
#pragma unroll
            for (int u = 0; u < 4; ++u) xv[u] = *(const f32x4*)(x + (size_t)(tokc + r0 + u) * D + c);
#pragma unroll
            for (int u = 0; u < 4; ++u) { const float rr = rs[r0 + u + 1]; const f32x4 hn = xv[u] * rr * gg, xx = prev - hn;
#pragma unroll
                for (int m = 0; m < 6; ++m) { const f32x4 o = hn + xx * mw[m];
                    uint2 w; w.x = cvt_pk_nv(o[0], o[1]); w.y = cvt_pk_nv(o[2], o[3]);
                    *(uint2*)(mixbase + (size_t)m * 8192 * D + (size_t)(rl0 + r0 + u) * D + c) = w; }
                prev = hn; }
        }
    }
}

__device__ __forceinline__ void conv_ssd(const Params& p) {
    const bf16_t* proj = (const bf16_t*)(p.ws + WS_PROJ); bf16_t* xbc = (bf16_t*)(p.ws + WS_XBC);
    const float* cw = p.in[6]; const float* cb = p.in[7];
    const int tid = opq(threadIdx.x);
    if (tid < 384) {
        const int c8 = tid % 192, par = tid / 192, c = c8 * 8;
        float w[4][8], bb[8];
#pragma unroll
        for (int j = 0; j < 4; ++j) { const f32x4 w0 = *(const f32x4*)(cw + j * 1536 + c), w1 = *(const f32x4*)(cw + j * 1536 + c + 4);
#pragma unroll
            for (int e = 0; e < 4; ++e) { w[j][e] = w0[e]; w[j][4 + e] = w1[e]; } }
        { const f32x4 b0 = *(const f32x4*)(cb + c), b1 = *(const f32x4*)(cb + c + 4);
#pragma unroll
          for (int e = 0; e < 4; ++e) { bb[e] = b0[e]; bb[4 + e] = b1[e]; } }
        for (int chunk = blockIdx.x; chunk < 256; chunk += gridDim.x) {
            const int t0 = chunk * 64 + par * 32; const bool hasprev = (t0 & (SEQ - 1)) != 0;
            float r0[8], r1[8], r2[8];
            if (hasprev) { const uint4 a = *(const uint4*)(proj + (size_t)(t0 - 3) * INWP + COL_XBC + c), b = *(const uint4*)(proj + (size_t)(t0 - 2) * INWP + COL_XBC + c), d = *(const uint4*)(proj + (size_t)(t0 - 1) * INWP + COL_XBC + c);
                unpack8(a, r0); unpack8(b, r1); unpack8(d, r2); }
            else {
#pragma unroll
                for (int e = 0; e < 8; ++e) { r0[e] = 0.f; r1[e] = 0.f; r2[e] = 0.f; } }
            for (int tg = 0; tg < 32; tg += 4) {
                uint4 rw[4];
#pragma unroll
                for (int u = 0; u < 4; ++u) rw[u] = *(const uint4*)(proj + (size_t)(t0 + tg + u) * INWP + COL_XBC + c);
#pragma unroll
                for (int u = 0; u < 4; ++u) { float cur[8], acc[8]; unpack8(rw[u], cur);
#pragma unroll
                    for (int e = 0; e < 8; ++e) { acc[e] = bb[e] + w[0][e] * r0[e] + w[1][e] * r1[e] + w[2][e] * r2[e] + w[3][e] * cur[e]; acc[e] = acc[e] * sigmoidf_(acc[e]); r0[e] = r1[e]; r1[e] = r2[e]; r2[e] = cur[e]; }
                    u32x4 o; o.x = cvt_pk_nv(acc[0], acc[1]); o.y = cvt_pk_nv(acc[2], acc[3]); o.z = cvt_pk_nv(acc[4], acc[5]); o.w = cvt_pk_nv(acc[6], acc[7]);
                    *(u32x4*)(xbc + (size_t)(t0 + tg + u) * 1536 + c) = o; }
            }
        }
    }
    float* dt = (float*)(p.ws + WS_DT); float* da = (float*)(p.ws + WS_DA);
    for (int idx = blockIdx.x * 512 + opq(threadIdx.x); idx < MTOK * 16; idx += gridDim.x * 512) {
        const int tok = idx >> 4, hh = idx & 15;
        const float v = bf2f(proj[(size_t)tok * INWP + COL_DT + hh]) + p.in[8][hh];
        const float d = fmaxf(v, 0.f) + __logf(1.0f + __expf(-fabsf(v)));
        dt[idx] = d; da[idx] = __expf(-d * __expf(p.in[9][hh]));
    }
}

__device__ __forceinline__ void ssd_scan_job(const Params& p, int job, LAS unsigned char* lds) {
    const int tid = opq(threadIdx.x);
    const int b = job >> 5, hs = (job >> 1) & 15, half = job & 1, grp = hs >> 3, p0 = half * 32;
    const bf16_t* xbc = (const bf16_t*)(p.ws + WS_XBC) + (size_t)b * SEQ * 1536;
    const float* dtp = (const float*)(p.ws + WS_DT) + (size_t)b * SEQ * 16 + hs;
    const float* dap = (const float*)(p.ws + WS_DA) + (size_t)b * SEQ * 16 + hs;
    float* yraw = (float*)(p.ws + WS_YRAW) + (size_t)b * SEQ * 1024 + hs * 64 + p0;
    const float dskip = p.in[10][hs];
    constexpr int BUF_F = 9280;
    LAS float* L = (LAS float*)lds;
    const bool producer = tid >= 256; const int ptid = tid & 255;
    int grow[5], gcol[5], loff[5];
#pragma unroll
    for (int k = 0; k < 5; ++k) { const int q = ptid + k * 256, row = q / 36, pc = q - row * 36; grow[k] = row;
        if (pc < 4) { gcol[k] = hs * 64 + p0 + pc * 8; loff[k] = row * 32 + pc * 8; }
        else if (pc < 20) { gcol[k] = 1024 + grp * 128 + (pc - 4) * 8; loff[k] = 1024 + row * 128 + (pc - 4) * 8; }
        else { gcol[k] = 1280 + grp * 128 + (pc - 20) * 8; loff[k] = 5120 + row * 128 + (pc - 20) * 8; } }
    uint4 rg[5]; float sc = 0.f;
#define SSD_ISSUE(t0) do { _Pragma("unroll") for (int k = 0; k < 5; ++k) if (ptid + k * 256 < 1152) rg[k] = *(const uint4*)(xbc + (size_t)((t0) + grow[k]) * 1536 + gcol[k]); \
        if (ptid < 32) sc = dtp[((t0) + ptid) * 16]; else if (ptid < 64) sc = dap[((t0) + ptid - 32) * 16]; } while (0)
#define SSD_COMMIT(buf) do { LAS float* Lc = L + (buf) * BUF_F; _Pragma("unroll") for (int k = 0; k < 5; ++k) if (ptid + k * 256 < 1152) { float f[8]; unpack8(rg[k], f); \
            *(LAS f32x4*)(Lc + loff[k]) = (f32x4){f[0], f[1], f[2], f[3]}; *(LAS f32x4*)(Lc + loff[k] + 4) = (f32x4){f[4], f[5], f[6], f[7]}; } \
        if (ptid < 32) Lc[9216 + ptid] = sc; else if (ptid < 64) Lc[9248 + ptid - 32] = sc; } while (0)
#define SSD_FLUSH(chp) do { LAS float* yo = L + 2 * BUF_F + ((chp) & 1) * 1024; const f32x4 v = *(LAS f32x4*)(yo + (ptid >> 3) * 32 + (ptid & 7) * 4); \
        *(f32x4*)(yraw + (size_t)((chp) * 32 + (ptid >> 3)) * 1024 + (ptid & 7) * 4) = v; } while (0)
    f32x2 hA[4], hB[4];
#pragma unroll
    for (int i = 0; i < 4; ++i) { hA[i] = (f32x2){0.f, 0.f}; hB[i] = (f32x2){0.f, 0.f}; }
    const int prow = (tid >> 4) & 15, nseg = tid & 15;
    __syncthreads();
    if (producer) { SSD_ISSUE(0); SSD_COMMIT(0); SSD_ISSUE(32); }
    __syncthreads();
    for (int ch = 0; ch < 64; ++ch) {
        const int cur = ch & 1;
        if (producer) {
            if (ch >= 1) SSD_FLUSH(ch - 1);
            if (ch + 1 < 64) SSD_COMMIT(cur ^ 1);
            if (ch + 2 < 64) SSD_ISSUE((ch + 2) * 32);
        } else {
        LAS float* Lb = L + cur * BUF_F; LAS float* yb = L + 2 * BUF_F + cur * 1024;
        for (int tg = 0; tg < 32; tg += 16) {
            float yA[16], yB[16];
            LAS float* qb = Lb + 1024 + tg * 128 + nseg * 8;
            f32x4 b0 = *(LAS f32x4*)(qb), b1 = *(LAS f32x4*)(qb + 4), c0 = *(LAS f32x4*)(qb + 4096), c1 = *(LAS f32x4*)(qb + 4100);
            float dA = Lb[9248 + tg], xa = Lb[tg * 32 + prow], xb = Lb[tg * 32 + prow + 16], dtv = Lb[9216 + tg];
#pragma unroll
            for (int tt = 0; tt < 16; ++tt) {
                f32x4 nb0, nb1, nc0, nc1; float ndA, nxa, nxb, ndtv;
                if (tt + 1 < 16) { LAS float* q = qb + (tt + 1) * 128; nb0 = *(LAS f32x4*)(q); nb1 = *(LAS f32x4*)(q + 4); nc0 = *(LAS f32x4*)(q + 4096); nc1 = *(LAS f32x4*)(q + 4100);
                    ndA = Lb[9248 + tg + tt + 1]; nxa = Lb[(tg + tt + 1) * 32 + prow]; nxb = Lb[(tg + tt + 1) * 32 + prow + 16]; ndtv = Lb[9216 + tg + tt + 1]; }
                __builtin_amdgcn_sched_barrier(0);
                const float xdta = xa * dtv, xdtb = xb * dtv;
                const f32x2 dA2 = (f32x2){dA, dA}, xa2 = (f32x2){xdta, xdta}, xb2 = (f32x2){xdtb, xdtb};
                hA[0] = hA[0] * dA2 + xa2 * b0.xy; hB[0] = hB[0] * dA2 + xb2 * b0.xy; hA[1] = hA[1] * dA2 + xa2 * b0.zw; hB[1] = hB[1] * dA2 + xb2 * b0.zw;
                hA[2] = hA[2] * dA2 + xa2 * b1.xy; hB[2] = hB[2] * dA2 + xb2 * b1.xy; hA[3] = hA[3] * dA2 + xa2 * b1.zw; hB[3] = hB[3] * dA2 + xb2 * b1.zw;
                f32x2 ya = hA[0] * c0.xy, yb2 = hB[0] * c0.xy; ya = hA[1] * c0.zw + ya; yb2 = hB[1] * c0.zw + yb2; ya = hA[2] * c1.xy + ya; yb2 = hB[2] * c1.xy + yb2; ya = hA[3] * c1.zw + ya; yb2 = hB[3] * c1.zw + yb2;
                float ra = ya.x + ya.y, rb = yb2.x + yb2.y;
                ra = dpp_add<0xB1>(ra); rb = dpp_add<0xB1>(rb); ra = dpp_add<0x4E>(ra); rb = dpp_add<0x4E>(rb); ra = dpp_add<0x141>(ra); rb = dpp_add<0x141>(rb); ra = dpp_add<0x140>(ra); rb = dpp_add<0x140>(rb);
                yA[tt] = ra + dskip * xa; yB[tt] = rb + dskip * xb;
                __builtin_amdgcn_sched_barrier(0);
                if (tt + 1 < 16) { b0 = nb0; b1 = nb1; c0 = nc0; c1 = nc1; dA = ndA; xa = nxa; xb = nxb; dtv = ndtv; }
            }
            if (nseg == 0) {
#pragma unroll
                for (int tt = 0; tt < 16; ++tt) { yb[(tg + tt) * 32 + prow] = yA[tt]; yb[(tg + tt) * 32 + prow + 16] = yB[tt]; } }
        }
        }
        __syncthreads();
    }
    if (producer) SSD_FLUSH(63);
#undef SSD_ISSUE
#undef SSD_COMMIT
#undef SSD_FLUSH
}

__device__ __forceinline__ void ssd_chunk_job(const Params& p, int job, LAS unsigned char* lds) {
    const int tid = opq(threadIdx.x), lane = tid & 63, w = tid >> 6, fr = lane & 15, fq = lane >> 4;
    const int b = job >> 5, hs = (job >> 1) & 15, half = job & 1, grp = hs >> 3, p0 = half * 32;
    const bf16_t* xbc = (const bf16_t*)(p.ws + WS_XBC) + (size_t)b * SEQ * 1536;
    const float* dtp = (const float*)(p.ws + WS_DT) + (size_t)b * SEQ * 16 + hs;
    float* yraw = (float*)(p.ws + WS_YRAW) + (size_t)b * SEQ * 1024 + hs * 64 + p0;
    const float dskip = p.in[10][hs], Ah = -__expf(p.in[9][hs]);
    constexpr int RS = 136;
    LAS bf16_t* Cs = (LAS bf16_t*)lds;
    LAS bf16_t* Bs = (LAS bf16_t*)(lds + 34816);
    LAS bf16_t* BTs = (LAS bf16_t*)(lds + 69632);
    LAS bf16_t* XTa = (LAS bf16_t*)(lds + 104448);
    LAS bf16_t* XTb = (LAS bf16_t*)(lds + 113152);
    LAS bf16_t* Ps = (LAS bf16_t*)(lds + 121856);
    LAS float* af = (LAS float*)(lds + 130560);
    LAS float* dtf = (LAS float*)(lds + 131584);
    const int crow0 = tid >> 4, cpc = tid & 15;
    const int xk = tid >> 2, xpc = tid & 3;
    u32x4 rc[4], rb[4], rx; float rdt = 0.f;
#define SC_ISSUE(t0) do { _Pragma("unroll") for (int i = 0; i < 4; ++i) { const bf16_t* rp_ = xbc + (size_t)((t0) + (crow0 + 32 * i)) * 1536 + grp * 128 + cpc * 8; rb[i] = *(const u32x4*)(rp_ + 1024); rc[i] = *(const u32x4*)(rp_ + 1280); } \
        rx = *(const u32x4*)(xbc + (size_t)((t0) + xk) * 1536 + hs * 64 + p0 + xpc * 8); if (tid < 128) rdt = dtp[((t0) + tid) * 16]; } while (0)
    f32x4 st[2];
    st[0] = (f32x4){0.f, 0.f, 0.f, 0.f}; st[1] = st[0];
    __syncthreads();
    for (int i = tid; i < 32 * RS / 2; i += 512) ((LAS unsigned*)Ps)[i] = 0u;
    SC_ISSUE(0);
    for (int ch = 0; ch < 16; ++ch) {
        const int t0 = ch * 128;
        __syncthreads();
#pragma unroll
        for (int i = 0; i < 4; ++i) { *(LAS u32x4*)(Cs + (crow0 + 32 * i) * RS + cpc * 8) = rc[i]; *(LAS u32x4*)(Bs + (crow0 + 32 * i) * RS + cpc * 8) = rb[i];

#pragma unroll
            for (int e = 0; e < 4; ++e) { BTs[(cpc * 8 + 2 * e) * RS + (crow0 + 32 * i)] = (bf16_t)(rb[i][e] & 0xffffu); BTs[(cpc * 8 + 2 * e + 1) * RS + (crow0 + 32 * i)] = (bf16_t)(rb[i][e] >> 16); } }
        float csv = 0.f;
        if (tid < 128) {
            csv = rdt * Ah; dtf[tid] = rdt;
#pragma unroll
            for (int off = 1; off < 64; off <<= 1) { const float t_ = __shfl_up(csv, off); if (lane >= off) csv += t_; }
            if (tid == 63) af[128] = csv;
        }
        float xr[8]; xr[0] = bflo(rx[0]); xr[1] = bfhi(rx[0]); xr[2] = bflo(rx[1]); xr[3] = bfhi(rx[1]); xr[4] = bflo(rx[2]); xr[5] = bfhi(rx[2]); xr[6] = bflo(rx[3]); xr[7] = bfhi(rx[3]);
        __syncthreads();
        if (tid < 128) af[tid] = (tid >= 64) ? csv + af[128] : csv;
        __syncthreads();
        const float cs_last = af[127];
        { const float d = dtf[xk], dout = __expf(cs_last - af[xk]);
#pragma unroll
          for (int e = 0; e < 8; ++e) { const float xa = xr[e] * d; XTa[(xpc * 8 + e) * RS + xk] = f2bf(xa); XTb[(xpc * 8 + e) * RS + xk] = f2bf(xa * dout); } }
        __syncthreads();
        bf16x8 cf[4];
#pragma unroll
        for (int ks = 0; ks < 4; ++ks) cf[ks] = *(LAS bf16x8*)(Cs + (w * 16 + fr) * RS + ks * 32 + fq * 8);
        f32x4 yo[2];
#pragma unroll
        for (int pt = 0; pt < 2; ++pt) { f32x4 acc = (f32x4){0.f, 0.f, 0.f, 0.f};
#pragma unroll
            for (int ks = 0; ks < 4; ++ks) { const bf16x8 pb = *(LAS bf16x8*)(Ps + (pt * 16 + fr) * RS + ks * 32 + fq * 8); acc = __builtin_amdgcn_mfma_f32_16x16x32_bf16(cf[ks], pb, acc, 0, 0, 0); }
            yo[pt] = acc; }
        float csq[4];
#pragma unroll
        for (int i = 0; i < 4; ++i) csq[i] = af[w * 16 + fq * 4 + i];
#pragma unroll
        for (int kt = 0; kt < 8; ++kt) { f32x4 acc = (f32x4){0.f, 0.f, 0.f, 0.f};
            if (kt > w) {
#pragma unroll
                for (int i = 0; i < 4; ++i) Cs[(w * 16 + fq * 4 + i) * RS + kt * 16 + fr] = (bf16_t)0;
                continue; }
#pragma unroll
            for (int ks = 0; ks < 4; ++ks) { const bf16x8 bb = *(LAS bf16x8*)(Bs + (kt * 16 + fr) * RS + ks * 32 + fq * 8); acc = __builtin_amdgcn_mfma_f32_16x16x32_bf16(cf[ks], bb, acc, 0, 0, 0); }
            const int kk = kt * 16 + fr; const float csk = af[kk];
#pragma unroll
            for (int i = 0; i < 4; ++i) { const int qq = w * 16 + fq * 4 + i; const float m = (kk <= qq) ? acc[i] * __expf(csq[i] - csk) : 0.f; Cs[qq * RS + kk] = f2bf(m); } }
        f32x4 yd[2];
        { bf16x8 mf[4];
#pragma unroll
          for (int ks = 0; ks < 4; ++ks) mf[ks] = *(LAS bf16x8*)(Cs + (w * 16 + fr) * RS + ks * 32 + fq * 8);
#pragma unroll
          for (int pt = 0; pt < 2; ++pt) { f32x4 acc = (f32x4){0.f, 0.f, 0.f, 0.f};
#pragma unroll
              for (int ks = 0; ks < 4; ++ks) { const bf16x8 xb = *(LAS bf16x8*)(XTa + (pt * 16 + fr) * RS + ks * 32 + fq * 8); acc = __builtin_amdgcn_mfma_f32_16x16x32_bf16(mf[ks], xb, acc, 0, 0, 0); }
              yd[pt] = acc; } }
#pragma unroll
        for (int pt = 0; pt < 2; ++pt)
#pragma unroll
            for (int i = 0; i < 4; ++i) { const int qq = w * 16 + fq * 4 + i, pp = pt * 16 + fr;
                const float xv = bf2f(xbc[(size_t)(t0 + qq) * 1536 + hs * 64 + p0 + pp]);
                yraw[(size_t)(t0 + qq) * 1024 + pp] = yd[pt][i] + __expf(csq[i]) * yo[pt][i] + dskip * xv; }
        if (ch + 1 < 16) SC_ISSUE(t0 + 128);
        __syncthreads();
        { const float cd = __expf(cs_last);
#pragma unroll
          for (int pt = 0; pt < 2; ++pt) { f32x4 acc = st[pt] * cd;
#pragma unroll
              for (int ks = 0; ks < 4; ++ks) { const bf16x8 xa = *(LAS bf16x8*)(XTb + (pt * 16 + fr) * RS + ks * 32 + fq * 8); const bf16x8 bt = *(LAS bf16x8*)(BTs + (w * 16 + fr) * RS + ks * 32 + fq * 8);
                  acc = __builtin_amdgcn_mfma_f32_16x16x32_bf16(xa, bt, acc, 0, 0, 0); }
              st[pt] = acc;
#pragma unroll
              for (int i = 0; i < 4; ++i) Ps[(pt * 16 + fq * 4 + i) * RS + w * 16 + fr] = f2bf(acc[i]); } }
    }
#undef SC_ISSUE
}

__device__ __forceinline__ void attn_job(const Params& p, int job, LAS unsigned char* lds) {
    const int tid = opq(threadIdx.x), lane = tid & 63, w = tid >> 6, fr = lane & 15, fq = lane >> 4;
    const int b = job >> 6, kvh = (job >> 4) & 3, nb = job & 15;
    const bf16_t* proj = (const bf16_t*)(p.ws + WS_PROJ) + (size_t)b * SEQ * INWP;
    const float2* rope = (const float2*)(p.ws + WS_ROPE);
    LAS bf16_t* Ks = (LAS bf16_t*)lds;
    LAS bf16_t* Vt = (LAS bf16_t*)(lds + 36864);
    LAS bf16_t* Ps = (LAS bf16_t*)(lds + 70656) + w * 16 * 264;
    __syncthreads();
    if (tid < 256) {
        const int kr = tid, tk = (nb - 1) * 128 + kr;
        if (tk >= 0) {
            const bf16_t* src = proj + (size_t)tk * INWP + COL_K + kvh * 64; float x[64]; float ss = 0.f;
#pragma unroll
            for (int c = 0; c < 8; ++c) { const uint4 r = *(const uint4*)(src + c * 8); float f[8]; unpack8(r, f);
#pragma unroll
                for (int e = 0; e < 8; ++e) { x[c * 8 + e] = f[e]; ss += f[e] * f[e]; } }
            const float rinv = rsqrtf(ss * (1.0f / 64) + 1e-6f); const float* kn = p.in[13];
#pragma unroll
            for (int i = 0; i < 64; ++i) x[i] = x[i] * rinv * kn[i];
#pragma unroll
            for (int c = 0; c < 4; ++c) { float o1[8], o2[8];
#pragma unroll
                for (int e = 0; e < 8; ++e) { const int i = c * 8 + e; const float2 cs = rope[tk * 32 + i]; o1[e] = x[i] * cs.x - x[i + 32] * cs.y; o2[e] = x[i + 32] * cs.x + x[i] * cs.y; }
                u32x4 w1, w2; w1.x = cvt_pk_bf16(o1[0], o1[1]); w1.y = cvt_pk_bf16(o1[2], o1[3]); w1.z = cvt_pk_bf16(o1[4], o1[5]); w1.w = cvt_pk_bf16(o1[6], o1[7]);
                w2.x = cvt_pk_bf16(o2[0], o2[1]); w2.y = cvt_pk_bf16(o2[2], o2[3]); w2.z = cvt_pk_bf16(o2[4], o2[5]); w2.w = cvt_pk_bf16(o2[6], o2[7]);
                *(LAS u32x4*)(Ks + kr * 72 + c * 8) = w1; *(LAS u32x4*)(Ks + kr * 72 + 32 + c * 8) = w2;
                __builtin_amdgcn_sched_barrier(0); }
        } else {
#pragma unroll
            for (int c = 0; c < 8; ++c) *(LAS u32x4*)(Ks + kr * 72 + c * 8) = (u32x4){0u, 0u, 0u, 0u};
        }
    } else {
        const int kr = tid - 256, tk = (nb - 1) * 128 + kr;
        const bf16_t* src = proj + (size_t)(tk < 0 ? 0 : tk) * INWP + COL_V + kvh * 64;
#pragma unroll
        for (int c = 0; c < 8; ++c) { uint4 r = *(const uint4*)(src + c * 8); if (tk < 0) r = make_uint4(0u, 0u, 0u, 0u);
            Vt[(c * 8 + 0) * 264 + kr] = (bf16_t)(r.x & 0xffffu); Vt[(c * 8 + 1) * 264 + kr] = (bf16_t)(r.x >> 16);
            Vt[(c * 8 + 2) * 264 + kr] = (bf16_t)(r.y & 0xffffu); Vt[(c * 8 + 3) * 264 + kr] = (bf16_t)(r.y >> 16);
            Vt[(c * 8 + 4) * 264 + kr] = (bf16_t)(r.z & 0xffffu); Vt[(c * 8 + 5) * 264 + kr] = (bf16_t)(r.z >> 16);
            Vt[(c * 8 + 6) * 264 + kr] = (bf16_t)(r.w & 0xffffu); Vt[(c * 8 + 7) * 264 + kr] = (bf16_t)(r.w >> 16); }
    }
    __syncthreads();
    for (int h4 = 0; h4 < 4; ++h4) {
    const int hq = kvh * 4 + h4;
    bf16x8 qa[2];
    { const int tq = nb * 128 + w * 16 + fr; const bf16_t* src = proj + (size_t)tq * INWP + hq * 64;
      const uint4 r0 = *(const uint4*)(src + fq * 8), r1 = *(const uint4*)(src + 32 + fq * 8); float x1[8], x2[8]; unpack8(r0, x1); unpack8(r1, x2);
      float ss = 0.f;
#pragma unroll
      for (int e = 0; e < 8; ++e) ss += x1[e] * x1[e] + x2[e] * x2[e];
      ss += __shfl_xor(ss, 16); ss += __shfl_xor(ss, 32);
      const float rinv = rsqrtf(ss * (1.0f / 64) + 1e-6f) * 0.125f; const float* qn = p.in[12]; float o1[8], o2[8];
#pragma unroll
      for (int e = 0; e < 8; ++e) { const int i = fq * 8 + e; const float a = x1[e] * rinv * qn[i], c = x2[e] * rinv * qn[i + 32]; const float2 cs = rope[tq * 32 + i];
          o1[e] = a * cs.x - c * cs.y; o2[e] = c * cs.x + a * cs.y; }
      u32x4 w1, w2; w1.x = cvt_pk_bf16(o1[0], o1[1]); w1.y = cvt_pk_bf16(o1[2], o1[3]); w1.z = cvt_pk_bf16(o1[4], o1[5]); w1.w = cvt_pk_bf16(o1[6], o1[7]);
      w2.x = cvt_pk_bf16(o2[0], o2[1]); w2.y = cvt_pk_bf16(o2[2], o2[3]); w2.z = cvt_pk_bf16(o2[4], o2[5]); w2.w = cvt_pk_bf16(o2[6], o2[7]);
      qa[0] = __builtin_bit_cast(bf16x8, w1); qa[1] = __builtin_bit_cast(bf16x8, w2); }
    f32x4 s[16];
#pragma unroll
    for (int j = 0; j < 16; ++j) { f32x4 acc = (f32x4){0.f, 0.f, 0.f, 0.f};
#pragma unroll
        for (int ks = 0; ks < 2; ++ks) { const bf16x8 kb = *(LAS bf16x8*)(Ks + (j * 16 + fr) * 72 + ks * 32 + fq * 8); acc = __builtin_amdgcn_mfma_f32_16x16x32_bf16(qa[ks], kb, acc, 0, 0, 0); }
        s[j] = acc; }
    const float sink = p.in[14][hq];
    float mx[4], inv[4];
#pragma unroll
    for (int i = 0; i < 4; ++i) { const int qi = w * 16 + fq * 4 + i + 128; float m = -3.0e38f;
#pragma unroll
        for (int j = 0; j < 16; ++j) { const int kj = j * 16 + fr; const bool ok = (kj <= qi) && (qi - kj < 128) && (nb > 0 || kj >= 128); s[j][i] = ok ? s[j][i] : -3.0e38f; m = fmaxf(m, s[j][i]); }
        m = max16(m);
        m = fmaxf(m, sink); mx[i] = m; float l = 0.f;
#pragma unroll
        for (int j = 0; j < 16; ++j) { const float e = (s[j][i] > -1.0e38f) ? __expf(s[j][i] - m) : 0.f; s[j][i] = e; l += e; }
        l = red16(l);
        inv[i] = 1.0f / (l + __expf(sink - m)); }
#pragma unroll
    for (int j = 0; j < 16; ++j)
#pragma unroll
        for (int i = 0; i < 4; ++i) Ps[(fq * 4 + i) * 264 + j * 16 + fr] = f2bf(s[j][i] * inv[i]);
    f32x4 o[4];
#pragma unroll
    for (int nd = 0; nd < 4; ++nd) o[nd] = (f32x4){0.f, 0.f, 0.f, 0.f};
#pragma unroll
    for (int kk = 0; kk < 8; ++kk) { const bf16x8 pa = *(LAS bf16x8*)(Ps + fr * 264 + kk * 32 + fq * 8);
#pragma unroll
        for (int nd = 0; nd < 4; ++nd) { const bf16x8 vb = *(LAS bf16x8*)(Vt + (nd * 16 + fr) * 264 + kk * 32 + fq * 8); o[nd] = __builtin_amdgcn_mfma_f32_16x16x32_bf16(pa, vb, o[nd], 0, 0, 0); } }
    bf16_t* ymix = (bf16_t*)(p.ws + WS_YMIX) + (size_t)b * SEQ * D + hq * 64;
#pragma unroll
    for (int nd = 0; nd < 4; ++nd)
#pragma unroll
        for (int i = 0; i < 4; ++i) ymix[(size_t)(nb * 128 + w * 16 + fq * 4 + i) * D + nd * 16 + fr] = f2bf(o[nd][i]);
    }
}

__device__ __forceinline__ void post_ssd(const Params& p) {
    const int tid_ = opq(threadIdx.x); const int lane = tid_ & 63, wv = tid_ >> 6;
    const float* yraw = (const float*)(p.ws + WS_YRAW); const bf16_t* proj = (const bf16_t*)(p.ws + WS_PROJ); bf16_t* ymix = (bf16_t*)(p.ws + WS_YMIX);
    for (int it = blockIdx.x * 8 + wv; it < MTOK * 2; it += gridDim.x * 8) {
        const int tok = it >> 1, grp = it & 1, c = grp * 512 + lane * 8;
        const f32x4 y0 = *(const f32x4*)(yraw + (size_t)tok * 1024 + c), y1 = *(const f32x4*)(yraw + (size_t)tok * 1024 + c + 4);
        const uint4 zr = *(const uint4*)(proj + (size_t)tok * INWP + COL_Z + c); float z[8], y[8]; unpack8(zr, z); float ss = 0.f;
#pragma unroll
        for (int e = 0; e < 8; ++e) { const float yy = (e < 4 ? y0[e] : y1[e - 4]); y[e] = yy * z[e] * sigmoidf_(z[e]); ss += y[e] * y[e]; }
        ss = wave_sum(ss); const float r = rsqrtf(ss * (1.0f / 512) + 1e-6f);
        const f32x4 n0 = *(const f32x4*)(p.in[11] + c), n1 = *(const f32x4*)(p.in[11] + c + 4);
        u32x4 w; w.x = cvt_pk_nv(y[0] * r * n0[0], y[1] * r * n0[1]); w.y = cvt_pk_nv(y[2] * r * n0[2], y[3] * r * n0[3]);
        w.z = cvt_pk_nv(y[4] * r * n1[0], y[5] * r * n1[1]); w.w = cvt_pk_nv(y[6] * r * n1[2], y[7] * r * n1[3]);
        *(u32x4*)(ymix + (size_t)tok * D + 1024 + c) = w;
    }
}

__device__ __forceinline__ float half_sum(float v, bool lo) {
    (void)lo; v = red16(v); return v + __shfl_xor(v, 16); }
__device__ __forceinline__ void rwkv_scan_job(const Params& p, int job, LAS unsigned char* lds) {
    const int tid = opq(threadIdx.x), lane = tid & 63, l32 = lane & 31; const bool lo = lane < 32;
    const int b = job >> 5, hh = job & 31;
    LAS float* L = (LAS float*)lds;
    const bool producer = tid >= 256;
    const int pw = (tid >> 6) & 3;
    const int tl0 = 2 * pw + (lane >> 5);
    const size_t wbase = ((size_t)b * SEQ * D + hh * 64) / 2 + l32 + (size_t)tl0 * (D / 2);
    const unsigned* R32 = (const unsigned*)(p.ws + WS_R) + wbase; const unsigned* K32 = (const unsigned*)(p.ws + WS_K) + wbase; const unsigned* V32 = (const unsigned*)(p.ws + WS_V) + wbase;
    const unsigned* E32 = (const unsigned*)(p.ws + WS_WDEC) + wbase; const unsigned* A32 = (const unsigned*)(p.ws + WS_AA) + wbase; const unsigned* G32 = (const unsigned*)(p.ws + WS_GG) + wbase;
    unsigned* Y32 = (unsigned*)(p.ws + WS_YG) + wbase;
    const int ci = hh * 64 + 2 * l32;
    const float2 kkw = *(const float2*)(p.in[25] + ci), kaw = *(const float2*)(p.in[26] + ci), rkw = *(const float2*)(p.in[27] + ci), lnw = *(const float2*)(p.in[32] + ci), lnb = *(const float2*)(p.in[33] + ci);
    unsigned rw[2], kw[2], vw[2], ew[2], aw[2], gw[2];
    const int oo = tl0 * 64 + 2 * l32;
#define RW_ISSUE(t0) do { _Pragma("unroll") for (int i2 = 0; i2 < 2; ++i2) { const size_t off = (size_t)((t0) + 8 * i2) * (D / 2); rw[i2] = R32[off]; kw[i2] = K32[off]; vw[i2] = V32[off]; ew[i2] = E32[off]; aw[i2] = A32[off]; gw[i2] = G32[off]; } } while (0)
#define RW_COMMIT(buf) do { _Pragma("unroll") for (int i2 = 0; i2 < 2; ++i2) { LAS float* Lc = L + (buf) * 8192 + oo + i2 * 512; \
        const float r0_ = bflo(rw[i2]), r1_ = bfhi(rw[i2]), k0_ = bflo(kw[i2]), k1_ = bfhi(kw[i2]), v0_ = bflo(vw[i2]), v1_ = bfhi(vw[i2]), e0_ = bflo(ew[i2]), e1_ = bfhi(ew[i2]), a0_ = bflo(aw[i2]), a1_ = bfhi(aw[i2]), g0_ = bflo(gw[i2]), g1_ = bfhi(gw[i2]); \
        const float kkv0 = k0_ * kkw.x, kkv1 = k1_ * kkw.y; const float ssq = half_sum(kkv0 * kkv0 + kkv1 * kkv1, lo); const float rn = rsqrtf(fmaxf(ssq, 1e-24f)); const float kn0 = kkv0 * rn, kn1 = kkv1 * rn; \
        const float km0 = k0_ * (1.0f + (a0_ - 1.0f) * kaw.x), km1 = k1_ * (1.0f + (a1_ - 1.0f) * kaw.y); const float bonus = half_sum(r0_ * km0 * rkw.x + r1_ * km1 * rkw.y, lo); \
        *(LAS f32x2*)(Lc) = (f32x2){-kn0, -kn1}; *(LAS f32x2*)(Lc + 1024) = (f32x2){__expf(-e0_), __expf(-e1_)}; *(LAS f32x2*)(Lc + 2048) = (f32x2){kn0 * a0_, kn1 * a1_}; *(LAS f32x2*)(Lc + 3072) = (f32x2){km0, km1}; \
        *(LAS f32x2*)(Lc + 4096) = (f32x2){r0_, r1_}; *(LAS f32x2*)(Lc + 5120) = (f32x2){v0_, v1_}; *(LAS f32x2*)(Lc + 6144) = (f32x2){g0_, g1_}; *(LAS f32x2*)(Lc + 7168) = (f32x2){bonus * v0_, bonus * v1_}; } } while (0)
#define RW_OUTPUT(chp) do { LAS float* Lo = L + ((chp) & 1) * 8192; LAS float* yo = L + 16384 + ((chp) & 1) * 1024; _Pragma("unroll") for (int i2 = 0; i2 < 2; ++i2) { const int o2 = oo + i2 * 512; \
        const f32x2 y = *(LAS f32x2*)(yo + o2); \
        const float mu = half_sum(y.x + y.y, lo) * (1.0f / 64), d0 = y.x - mu, d1 = y.y - mu, var = half_sum(d0 * d0 + d1 * d1, lo) * (1.0f / 64), rs = rsqrtf(var + 64e-5f); \
        const f32x2 bv = *(LAS f32x2*)(Lo + 7168 + o2), gg = *(LAS f32x2*)(Lo + 6144 + o2); \
        Y32[(size_t)((chp) * 16 + 8 * i2) * (D / 2)] = cvt_pk_nv((d0 * rs * lnw.x + lnb.x + bv.x) * gg.x, (d1 * rs * lnw.y + lnb.y + bv.y) * gg.y); } } while (0)
    f32x2 SA[4], SB[4];
#pragma unroll
    for (int i = 0; i < 4; ++i) { SA[i] = (f32x2){0.f, 0.f}; SB[i] = (f32x2){0.f, 0.f}; }
    const int rp = (tid >> 3) & 31, ks = tid & 7;
    __syncthreads();
    if (producer) { RW_ISSUE(0); RW_COMMIT(0); RW_ISSUE(16); }
    __syncthreads();
    for (int ch = 0; ch < 128; ++ch) {
        const int cur = ch & 1;
        if (producer) {
            if (ch >= 1) RW_OUTPUT(ch - 1);
            if (ch + 1 < 128) RW_COMMIT(cur ^ 1);
            if (ch + 2 < 128) RW_ISSUE((ch + 2) * 16);
        } else {
            LAS float* Lb = L + cur * 8192; LAS float* yb = L + 16384 + cur * 1024;
            float yA[16], yB[16];
            LAS float* q0 = Lb + ks * 8;
            f32x4 a0 = *(LAS f32x4*)(q0), a1 = *(LAS f32x4*)(q0 + 4), w0 = *(LAS f32x4*)(q0 + 1024), w1 = *(LAS f32x4*)(q0 + 1028), b0 = *(LAS f32x4*)(q0 + 2048), b1 = *(LAS f32x4*)(q0 + 2052);
            f32x4 k0 = *(LAS f32x4*)(q0 + 3072), k1 = *(LAS f32x4*)(q0 + 3076), r0 = *(LAS f32x4*)(q0 + 4096), r1 = *(LAS f32x4*)(q0 + 4100);
            float va = Lb[5120 + rp], vb = Lb[5120 + rp + 32];
#pragma unroll
            for (int t = 0; t < 16; ++t) {
                f32x4 na0, na1, nw0, nw1, nb0, nb1, nk0, nk1, nr0, nr1; float nva, nvb;
                if (t + 1 < 16) { LAS float* q = q0 + (t + 1) * 64;
                    na0 = *(LAS f32x4*)(q); na1 = *(LAS f32x4*)(q + 4); nw0 = *(LAS f32x4*)(q + 1024); nw1 = *(LAS f32x4*)(q + 1028); nb0 = *(LAS f32x4*)(q + 2048); nb1 = *(LAS f32x4*)(q + 2052);
                    nk0 = *(LAS f32x4*)(q + 3072); nk1 = *(LAS f32x4*)(q + 3076); nr0 = *(LAS f32x4*)(q + 4096); nr1 = *(LAS f32x4*)(q + 4100); nva = Lb[5120 + (t + 1) * 64 + rp]; nvb = Lb[5120 + (t + 1) * 64 + rp + 32]; }
                __builtin_amdgcn_sched_barrier(0);
                f32x2 ca = SA[0] * a0.xy, cb = SB[0] * a0.xy; ca = SA[1] * a0.zw + ca; cb = SB[1] * a0.zw + cb; ca = SA[2] * a1.xy + ca; cb = SB[2] * a1.xy + cb; ca = SA[3] * a1.zw + ca; cb = SB[3] * a1.zw + cb;
                float sa = ca.x + ca.y, sb = cb.x + cb.y;
                sa = dpp_add<0xB1>(sa); sb = dpp_add<0xB1>(sb); sa = dpp_add<0x4E>(sa); sb = dpp_add<0x4E>(sb); sa = dpp_add<0x141>(sa); sb = dpp_add<0x141>(sb);
                const f32x2 sa2 = (f32x2){sa, sa}, sb2 = (f32x2){sb, sb}, va2 = (f32x2){va, va}, vb2 = (f32x2){vb, vb};
                SA[0] = SA[0] * w0.xy + (sa2 * b0.xy + va2 * k0.xy); SB[0] = SB[0] * w0.xy + (sb2 * b0.xy + vb2 * k0.xy);
                SA[1] = SA[1] * w0.zw + (sa2 * b0.zw + va2 * k0.zw); SB[1] = SB[1] * w0.zw + (sb2 * b0.zw + vb2 * k0.zw);
                SA[2] = SA[2] * w1.xy + (sa2 * b1.xy + va2 * k1.xy); SB[2] = SB[2] * w1.xy + (sb2 * b1.xy + vb2 * k1.xy);
                SA[3] = SA[3] * w1.zw + (sa2 * b1.zw + va2 * k1.zw); SB[3] = SB[3] * w1.zw + (sb2 * b1.zw + vb2 * k1.zw);
                f32x2 ya = SA[0] * r0.xy, yb2 = SB[0] * r0.xy; ya = SA[1] * r0.zw + ya; yb2 = SB[1] * r0.zw + yb2; ya = SA[2] * r1.xy + ya; yb2 = SB[2] * r1.xy + yb2; ya = SA[3] * r1.zw + ya; yb2 = SB[3] * r1.zw + yb2;
                float ra = ya.x + ya.y, rb = yb2.x + yb2.y;
                ra = dpp_add<0xB1>(ra); rb = dpp_add<0xB1>(rb); ra = dpp_add<0x4E>(ra); rb = dpp_add<0x4E>(rb); ra = dpp_add<0x141>(ra); rb = dpp_add<0x141>(rb);
                yA[t] = ra; yB[t] = rb;
                __builtin_amdgcn_sched_barrier(0);
                if (t + 1 < 16) { a0 = na0; a1 = na1; w0 = nw0; w1 = nw1; b0 = nb0; b1 = nb1; k0 = nk0; k1 = nk1; r0 = nr0; r1 = nr1; va = nva; vb = nvb; }
            }
            if (ks == 0) {
#pragma unroll
                for (int t = 0; t < 16; ++t) { yb[t * 64 + rp] = yA[t]; yb[t * 64 + rp + 32] = yB[t]; } }
        }
        __syncthreads();
    }
    if (producer) RW_OUTPUT(127);
#undef RW_ISSUE
#undef RW_COMMIT
#undef RW_OUTPUT
}

__device__ __forceinline__ void rwkv_chunk_job(const Params& p, int job, LAS unsigned char* lds) {
    const int tid = opq(threadIdx.x), lane = tid & 63, w = tid >> 6, fr = lane & 15, fq = lane >> 4, l32 = lane & 31; const bool lo = lane < 32;
    const int b = job >> 5, hh = job & 31;
    const int tl = 2 * w + (lane >> 5);
    const size_t wbase = ((size_t)b * SEQ * D + hh * 64) / 2 + l32 + (size_t)tl * (D / 2);
    const unsigned* R32 = (const unsigned*)(p.ws + WS_R) + wbase; const unsigned* K32 = (const unsigned*)(p.ws + WS_K) + wbase; const unsigned* V32 = (const unsigned*)(p.ws + WS_V) + wbase;
    const unsigned* E32 = (const unsigned*)(p.ws + WS_WDEC) + wbase; const unsigned* A32 = (const unsigned*)(p.ws + WS_AA) + wbase; const unsigned* G32 = (const unsigned*)(p.ws + WS_GG) + wbase;
    unsigned* Y32 = (unsigned*)(p.ws + WS_YG) + wbase;
    const int ci = hh * 64 + 2 * l32;
    const float2 kkw = *(const float2*)(p.in[25] + ci), kaw = *(const float2*)(p.in[26] + ci), rkw = *(const float2*)(p.in[27] + ci), lnw = *(const float2*)(p.in[32] + ci), lnb = *(const float2*)(p.in[33] + ci);
    LAS float* Av = (LAS float*)(lds + 0);
    LAS float* Bv = (LAS float*)(lds + 4096);
    LAS float* Km = (LAS float*)(lds + 8192);
    LAS float* Rr = (LAS float*)(lds + 12288);
    LAS float* ybuf = (LAS float*)(lds + 16384);
    LAS float* RHS = (LAS float*)(lds + 20480);
    LAS float* Aab = (LAS float*)(lds + 24832);
    LAS float* Wend = (LAS float*)(lds + 25856);
    LAS bf16_t* ET = (LAS bf16_t*)(lds + 26112);
    LAS bf16_t* VT = (LAS bf16_t*)(lds + 31232);
    LAS bf16_t* BtT = (LAS bf16_t*)(lds + 36352);
    LAS bf16_t* KtT = (LAS bf16_t*)(lds + 41472);
    LAS bf16_t* Ub = (LAS bf16_t*)(lds + 46592);
    LAS bf16_t* AakT = (LAS bf16_t*)(lds + 51712);
    LAS bf16_t* AbrT = (LAS bf16_t*)(lds + 52992);
    LAS bf16_t* AkrT = (LAS bf16_t*)(lds + 54272);
    LAS bf16_t* At = (LAS bf16_t*)(lds + 55552);
    LAS bf16_t* Bt = (LAS bf16_t*)(lds + 57856);
    LAS bf16_t* Kt = (LAS bf16_t*)(lds + 60160);
    LAS bf16_t* Rt = (LAS bf16_t*)(lds + 62464);
    LAS bf16_t* S0b = (LAS bf16_t*)(lds + 64768);
    LAS bf16_t* VT1 = (LAS bf16_t*)(lds + 73984);
    constexpr int LDS_END = 73984 + 64 * 40 * 2;
    __syncthreads();
    for (int i = tid; i < LDS_END / 4; i += 512) ((LAS unsigned*)lds)[i] = 0u;
    f32x4 stt[2]; stt[0] = (f32x4){0.f, 0.f, 0.f, 0.f}; stt[1] = stt[0];
    const int vt = w >> 1, kt0 = (w & 1) * 2;
    bf16x8 Lf;
#pragma unroll
    for (int e = 0; e < 8; ++e) { const int i = fq * 8 + e; Lf[e] = (i <= fr && i < 16) ? (short)0x3F80 : (short)0; }
    unsigned rw, kw, vw, ew, aw, gw;
#define RC_ISSUE(t0) do { const size_t off = (size_t)(t0) * (D / 2); rw = R32[off]; kw = K32[off]; vw = V32[off]; ew = E32[off]; aw = A32[off]; gw = G32[off]; } while (0)
#define RC_PREP(chn) do { \
        const float r0_ = bflo(rw), r1_ = bfhi(rw), k0_ = bflo(kw), k1_ = bfhi(kw), v0_ = bflo(vw), v1_ = bfhi(vw), a0_ = bflo(aw), a1_ = bfhi(aw); gn0 = bflo(gw); gn1 = bfhi(gw); \
        const unsigned ewc = ew, vwc = vw; \
        if ((chn) + 1 < 128) RC_ISSUE(((chn) + 1) * 16); \
        const float kkv0 = k0_ * kkw.x, kkv1 = k1_ * kkw.y; const float ssq = half_sum(kkv0 * kkv0 + kkv1 * kkv1, lo); const float rn = rsqrtf(fmaxf(ssq, 1e-24f)); const float kn0 = kkv0 * rn, kn1 = kkv1 * rn; \
        const float km0 = k0_ * (1.0f + (a0_ - 1.0f) * kaw.x), km1 = k1_ * (1.0f + (a1_ - 1.0f) * kaw.y); const float bonus = half_sum(r0_ * km0 * rkw.x + r1_ * km1 * rkw.y, lo); \
        bn0 = bonus * v0_; bn1 = bonus * v1_; \
        { const int o = tl * 64 + 2 * l32; LAS bf16_t* VTw = ((chn) & 1) ? VT1 : VT; \
          *(LAS f32x2*)(Av + o) = (f32x2){-kn0, -kn1}; *(LAS f32x2*)(Bv + o) = (f32x2){kn0 * a0_, kn1 * a1_}; *(LAS f32x2*)(Km + o) = (f32x2){km0, km1}; *(LAS f32x2*)(Rr + o) = (f32x2){r0_, r1_}; \
          ET[(2 * l32) * 40 + tl] = (bf16_t)(ewc & 0xffffu); ET[(2 * l32 + 1) * 40 + tl] = (bf16_t)(ewc >> 16); \
          VTw[(2 * l32) * 40 + tl] = (bf16_t)(vwc & 0xffffu); VTw[(2 * l32 + 1) * 40 + tl] = (bf16_t)(vwc >> 16); } } while (0)
    float gc0 = 0.f, gc1 = 0.f, bc0 = 0.f, bc1 = 0.f, gn0, gn1, bn0, bn1;
    RC_ISSUE(0);
    __syncthreads();
    RC_PREP(0); gc0 = gn0; gc1 = gn1; bc0 = bn0; bc1 = bn1;
    __syncthreads();
    for (int ch = 0; ch < 128; ++ch) {
        LAS bf16_t* VTc = (ch & 1) ? VT1 : VT;
        if (w < 4) {
            const bf16x8 eb = *(LAS bf16x8*)(ET + (w * 16 + fr) * 40 + fq * 8);
            f32x4 ec = (f32x4){0.f, 0.f, 0.f, 0.f}; ec = __builtin_amdgcn_mfma_f32_16x16x32_bf16(Lf, eb, ec, 0, 0, 0);
            const int kk = w * 16 + fr; unsigned bt_pk[2], kt_pk[2]; float btv[4], ktv[4];
#pragma unroll
            for (int i = 0; i < 4; ++i) { const int t = fq * 4 + i; const float et = bf2f(ET[kk * 40 + t]);
                const float Wt = __expf(-ec[i]), Wp = __expf(et - ec[i]), iW = __expf(ec[i]);
                const int o = t * 64 + kk;
                At[t * 72 + kk] = f2bf(Av[o] * Wp); Rt[t * 72 + kk] = f2bf(Rr[o] * Wt);
                btv[i] = Bv[o] * iW; ktv[i] = Km[o] * iW;
                Bt[t * 72 + kk] = f2bf(btv[i]); Kt[t * 72 + kk] = f2bf(ktv[i]);
                if (t == 15) Wend[kk] = Wt; }
            bt_pk[0] = cvt_pk_bf16(btv[0], btv[1]); bt_pk[1] = cvt_pk_bf16(btv[2], btv[3]); kt_pk[0] = cvt_pk_bf16(ktv[0], ktv[1]); kt_pk[1] = cvt_pk_bf16(ktv[2], ktv[3]);
            *(LAS u32x2*)(BtT + kk * 40 + fq * 4) = (u32x2){bt_pk[0], bt_pk[1]}; *(LAS u32x2*)(KtT + kk * 40 + fq * 4) = (u32x2){kt_pk[0], kt_pk[1]};
        }
        __syncthreads();
        if (w < 4) {
            LAS bf16_t* Xr = (w & 1) ? Kt : Bt; LAS bf16_t* Yr = (w & 2) ? Rt : At;
            f32x4 gacc = (f32x4){0.f, 0.f, 0.f, 0.f};
#pragma unroll
            for (int ks = 0; ks < 2; ++ks) { const bf16x8 xa = *(LAS bf16x8*)(Xr + fr * 72 + ks * 32 + fq * 8); const bf16x8 yb_ = *(LAS bf16x8*)(Yr + fr * 72 + ks * 32 + fq * 8); gacc = __builtin_amdgcn_mfma_f32_16x16x32_bf16(xa, yb_, gacc, 0, 0, 0); }
            float gm[4];
#pragma unroll
            for (int i = 0; i < 4; ++i) { const int j = fq * 4 + i; const bool keep = (w & 2) ? (j <= fr) : (j < fr); gm[i] = keep ? gacc[i] : 0.f; }
            if (w == 0) {
#pragma unroll
                for (int i = 0; i < 4; ++i) Aab[(fq * 4 + i) * 16 + fr] = gm[i]; }
            else { LAS bf16_t* dst = (w == 1) ? AakT : (w == 2) ? AbrT : AkrT; *(LAS u32x2*)(dst + fr * 40 + fq * 4) = (u32x2){cvt_pk_bf16(gm[0], gm[1]), cvt_pk_bf16(gm[2], gm[3])}; }
        }
        __syncthreads();
        f32x4 y0 = (f32x4){0.f, 0.f, 0.f, 0.f};
        { const int vtile = w & 3; LAS bf16_t* Yr = (w < 4) ? At : Rt; LAS bf16_t* Gt = (w < 4) ? AakT : AkrT;
#pragma unroll
          for (int ks = 0; ks < 2; ++ks) { const bf16x8 sa = *(LAS bf16x8*)(S0b + (vtile * 16 + fr) * 72 + ks * 32 + fq * 8); const bf16x8 yb_ = *(LAS bf16x8*)(Yr + fr * 72 + ks * 32 + fq * 8); y0 = __builtin_amdgcn_mfma_f32_16x16x32_bf16(sa, yb_, y0, 0, 0, 0); }
          { const bf16x8 va = *(LAS bf16x8*)(VTc + (vtile * 16 + fr) * 40 + fq * 8); const bf16x8 gb = *(LAS bf16x8*)(Gt + fr * 40 + fq * 8); y0 = __builtin_amdgcn_mfma_f32_16x16x32_bf16(va, gb, y0, 0, 0, 0); }
          if (w < 4) {
#pragma unroll
              for (int i = 0; i < 4; ++i) RHS[(vtile * 16 + fq * 4 + i) * 17 + fr] = y0[i]; } }
        __syncthreads();
        if (w == 0) {
            float u[16];
#pragma unroll
            for (int t = 0; t < 16; ++t) u[t] = RHS[lane * 17 + t];
#pragma unroll
            for (int t = 0; t < 15; ++t) {
#pragma unroll
                for (int t2 = t + 1; t2 < 16; ++t2) u[t2] += u[t] * Aab[t * 16 + t2]; }
            u32x4 o0, o1; o0.x = cvt_pk_bf16(u[0], u[1]); o0.y = cvt_pk_bf16(u[2], u[3]); o0.z = cvt_pk_bf16(u[4], u[5]); o0.w = cvt_pk_bf16(u[6], u[7]);
            o1.x = cvt_pk_bf16(u[8], u[9]); o1.y = cvt_pk_bf16(u[10], u[11]); o1.z = cvt_pk_bf16(u[12], u[13]); o1.w = cvt_pk_bf16(u[14], u[15]);
            *(LAS u32x4*)(Ub + lane * 40) = o0; *(LAS u32x4*)(Ub + lane * 40 + 8) = o1;
        }
        if (ch + 1 < 128) RC_PREP(ch + 1);
        __syncthreads();
        if (w >= 4) { const int vtile = w & 3;
            const bf16x8 ua = *(LAS bf16x8*)(Ub + (vtile * 16 + fr) * 40 + fq * 8); const bf16x8 gb = *(LAS bf16x8*)(AbrT + fr * 40 + fq * 8); y0 = __builtin_amdgcn_mfma_f32_16x16x32_bf16(ua, gb, y0, 0, 0, 0);
#pragma unroll
            for (int i = 0; i < 4; ++i) ybuf[fr * 64 + vtile * 16 + fq * 4 + i] = y0[i]; }
        { const bf16x8 ua = *(LAS bf16x8*)(Ub + (vt * 16 + fr) * 40 + fq * 8); const bf16x8 va = *(LAS bf16x8*)(VTc + (vt * 16 + fr) * 40 + fq * 8);
#pragma unroll
          for (int q = 0; q < 2; ++q) { const int kk = (kt0 + q) * 16 + fr;
              const bf16x8 bb = *(LAS bf16x8*)(BtT + kk * 40 + fq * 8); const bf16x8 kb = *(LAS bf16x8*)(KtT + kk * 40 + fq * 8);
              f32x4 acc = stt[q]; acc = __builtin_amdgcn_mfma_f32_16x16x32_bf16(ua, bb, acc, 0, 0, 0); acc = __builtin_amdgcn_mfma_f32_16x16x32_bf16(va, kb, acc, 0, 0, 0);
              const float we = Wend[kk]; acc = acc * we; stt[q] = acc;
#pragma unroll
              for (int i = 0; i < 4; ++i) S0b[(vt * 16 + fq * 4 + i) * 72 + kk] = f2bf(acc[i]); } }
        __syncthreads();
        { const f32x2 y = *(LAS f32x2*)(ybuf + tl * 64 + 2 * l32);
          const float mu = half_sum(y.x + y.y, lo) * (1.0f / 64), d0 = y.x - mu, d1 = y.y - mu, var = half_sum(d0 * d0 + d1 * d1, lo) * (1.0f / 64), rs = rsqrtf(var + 64e-5f);
          Y32[(size_t)(ch * 16) * (D / 2)] = cvt_pk_nv((d0 * rs * lnw.x + lnb.x + bc0) * gc0, (d1 * rs * lnw.y + lnb.y + bc1) * gc1); }
        gc0 = gn0; gc1 = gn1; bc0 = bn0; bc1 = bn1;
    }
#undef RC_ISSUE
#undef RC_PREP
}

#define XB_TMO      128
#define XB_XCNT(j)  (256  + 64 * (j))
#define XB_XSUB(j)  (1280 + 64 * (j))
#define XB_XGEN(j)  (2304 + 64 * (j))
#define XB_TOP      3328
#define XB_TOPGEN   3392
#define XCD_BAR_WORDS 3456
#define XB_SPIN_CAP (1u << 18)

__device__ __forceinline__ unsigned xb_ld(unsigned* p)              { return __hip_atomic_load(p, __ATOMIC_RELAXED, __HIP_MEMORY_SCOPE_AGENT); }
__device__ __forceinline__ unsigned xb_add(unsigned* p, unsigned v) { return __hip_atomic_fetch_add(p, v, __ATOMIC_RELAXED, __HIP_MEMORY_SCOPE_AGENT); }
__device__ __forceinline__ unsigned xb_xcc_id() { return (unsigned)__builtin_amdgcn_s_getreg((3 << 11) | 20) & 0xFu; }
#define XB_SPIN(cond, bar) do { unsigned _sp = 0; while (cond) { __builtin_amdgcn_s_sleep(1); \
    if ((++_sp & 255u) == 0u) { if (xb_ld(&(bar)[XB_TMO])) break; if (_sp > XB_SPIN_CAP) { atomicAdd(&(bar)[XB_TMO], 1u); break; } } } } while (0)

struct XcdBarrier {
    unsigned* bar; unsigned x;
    volatile LAS unsigned* st;
};

__device__ __forceinline__ XcdBarrier xcd_barrier_post(unsigned* bar, volatile LAS unsigned* st) {
    XcdBarrier b; b.bar = bar; b.x = xb_xcc_id(); b.st = st;
    if (threadIdx.x == 0) (void)xb_add(&bar[XB_XCNT(b.x)], 1u);
    return b;
}
__device__ __forceinline__ void xcd_barrier_complete(unsigned* bar, unsigned x, unsigned& nloc, unsigned& nx) {
    const unsigned G = gridDim.x * gridDim.y * gridDim.z;
    unsigned sum, cnt, mine, sp = 0u;
    for (;;) {
        sum = 0u; cnt = 0u; mine = 0u;
#pragma unroll
        for (unsigned j = 0; j < 16; ++j) { const unsigned c = xb_ld(&bar[XB_XCNT(j)]); sum += c; cnt += (c > 0u) ? 1u : 0u; mine = (j == x) ? c : mine; }
        if (sum == G) break;
        __builtin_amdgcn_s_sleep(1);
        if ((++sp & 255u) == 0u) { if (xb_ld(&bar[XB_TMO])) break; if (sp > XB_SPIN_CAP) { atomicAdd(&bar[XB_TMO], 1u); break; } }
    }
    nloc = mine > 0u ? mine : 1u; nx = cnt > 0u ? cnt : 1u;
}

__device__ __forceinline__ void xcd_barrier(const XcdBarrier& b) {
    asm volatile("s_waitcnt vmcnt(0)" ::: "memory");
    __syncthreads();
    if (threadIdx.x == 0) {
        unsigned* bar = b.bar;
        __builtin_amdgcn_s_waitcnt(0);
        unsigned nloc = b.st[0], nx = b.st[1];
        if (nloc == 0u) { xcd_barrier_complete(bar, b.x, nloc, nx); b.st[0] = nloc; b.st[1] = nx; }
        const unsigned old = xb_add(&bar[XB_XSUB(b.x)], 1u);
        const unsigned gen = old / nloc;
        if (old + 1u == (gen + 1u) * nloc) {
            __builtin_amdgcn_fence(__ATOMIC_RELEASE, "agent");
            asm volatile("s_waitcnt vmcnt(0)" ::: "memory");
            const unsigned og = xb_add(&bar[XB_TOP], 1u);
            const unsigned tg = og / nx;
            if (og + 1u == (tg + 1u) * nx) xb_add(&bar[XB_TOPGEN], 1u);
            else XB_SPIN(xb_ld(&bar[XB_TOPGEN]) == tg, bar);
            __builtin_amdgcn_fence(__ATOMIC_ACQUIRE, "agent");
            xb_add(&bar[XB_XGEN(b.x)], 1u);
            asm volatile("s_waitcnt vmcnt(0)" ::: "memory");
        } else {
            XB_SPIN(xb_ld(&bar[XB_XGEN(b.x)]) == gen, bar);
            __builtin_amdgcn_fence(__ATOMIC_ACQUIRE, "agent");
            asm volatile("s_waitcnt vmcnt(0)" ::: "memory");
        }
    }
    __syncthreads();
}


__global__ __launch_bounds__(512, 2) void mega(const Params p_arg) {
    extern __shared__ __attribute__((aligned(16))) unsigned char shm[];
    const Params& p = *(const Params*)(const void*)__builtin_amdgcn_kernarg_segment_ptr();
    LAS unsigned char* lds = (LAS unsigned char*)shm;
    const int G = (int)gridDim.x, bid = (int)blockIdx.x;
    __shared__ uint4 xb_words;
    if (threadIdx.x == 0) xb_words = make_uint4(0u, 0u, 0u, 0u);
    __syncthreads();
    (void)xcd_barrier_post((unsigned*)(p.ws + WS_BAR), (volatile LAS unsigned*)&xb_words);
    const int step_lo = p.step_lo, step_hi = p.step_hi;
    for (int s = step_lo; s < step_hi; ++s) {
        const int kind = p.kind[s], lo = p.lo[s], hi = p.hi[s];
        switch (kind) {
            case K_PRE0:
#ifndef NO_PRE
 convert_tiles(p, lo, hi, lds); rope_table(p); norm_rows(p.in[0], p.in[1], (bf16_t*)(p.ws + WS_H));
#endif
 break;
            case K_GEMMB:
#ifndef NO_GB

                for (int i = lo; i < hi; ++i) { const GemmOp& o = p.g[i]; pg8::Gemm g; g.A = o.A; g.Bt = o.Bt; g.M = o.M; g.N = o.N; g.K = o.K;
                    pg8::StaticOrder S; S.init(o.M, o.N, G, (bid + G - (o.rot % G)) % G);
                    EpiB E; E.O = (bf16_t*)o.out; E.ldc = o.ldc; E.bias = o.bias; E.act = o.act;
                    pg8::gemm_phase<EpiB, pg8::StaticOrder, false>(lds, g, S, E, nullptr); }
                if (p.chi[s] > p.clo[s]) convert_queue(p, p.clo[s], p.chi[s], (unsigned*)(p.ws + WS_BAR + 16384) + 64 * p.cq[s], lds);
#endif
                break;
            case K_GEMMF:
#ifndef NO_GF

                for (int i = lo; i < hi; ++i) { const GemmOp& o = p.g[i]; pg8::Gemm g; g.A = o.A; g.Bt = o.Bt; g.M = o.M; g.N = o.N; g.K = o.K;
                    pg8::StaticOrder S; S.init(o.M, o.N, G, (bid + G - (o.rot % G)) % G);
                    EpiF E; E.C = (float*)o.out; E.ldc = o.ldc; E.res = o.res;
                    pg8::gemm_phase<EpiF, pg8::StaticOrder, false>(lds, g, S, E, nullptr); }
#endif
                break;
            case K_CONVSSD:
#ifndef NO_CONV
 conv_ssd(p);
#endif
 break;
            case K_MIX0:

#ifndef NO_SSD
for (int j = bid; j < 256; j += G) ssd_chunk_job(p, j, lds);
#endif


#ifndef NO_ATT
for (int j = bid; j < 512; j += G) attn_job(p, j, lds);
#endif

                break;
            case K_POST0: post_ssd(p); break;
            case K_NORM: norm_rows(p.out, p.in[2] + lo * D, (bf16_t*)(p.ws + WS_H)); break;
            case K_PRE1: convert_tiles(p, lo, hi, lds); mix_rows(p.out, p.in[1] + D, p.in[16], (bf16_t*)(p.ws + WS_MIX), 0, lds); break;
            case K_MIXES: mix_rows(p.out, p.in[1] + D, p.in[16], (bf16_t*)(p.ws + WS_MIX), 8192, lds); break;
            case K_RWKV:
#ifndef NO_RWKV
 for (int j = bid; j < 256; j += G) rwkv_chunk_job(p, j, lds);
#endif
 break;
            case K_NORMCONV: convert_tiles(p, lo, hi, lds); norm_rows(p.out, p.in[2] + D, (bf16_t*)(p.ws + WS_H)); break;
            default: break;
        }
        if (s + 1 < step_hi) { if (step_hi < 0) cg::this_grid().sync();   XcdBarrier xb; xb.bar = (unsigned*)(p.ws + WS_BAR); xb.x = xb_xcc_id(); xb.st = (volatile LAS unsigned*)&xb_words; xcd_barrier(xb); }
    }
}

#ifndef MK_MULTI
#define MK_MULTI 0
#endif
extern "C" void kernel_launch(void* const* d_in, const int* in_sizes, int n_in, void* d_out, int out_size, void* d_ws, size_t ws_size, hipStream_t stream) {
    static int grid = 0;
    if (grid == 0) {
        int dev = 0, cus = 0, per_cu = 0;
        hipGetDevice(&dev); hipDeviceGetAttribute(&cus, hipDeviceAttributeMultiprocessorCount, dev);
        if (hipFuncSetAttribute((const void*)mega, hipFuncAttributeMaxDynamicSharedMemorySize, LDS_BYTES) != hipSuccess) { fprintf(stderr, "hipFuncSetAttribute failed\n"); grid = -1; return; }
        if (hipOccupancyMaxActiveBlocksPerMultiprocessor(&per_cu, (const void*)mega, 512, LDS_BYTES) != hipSuccess || per_cu < 1) { fprintf(stderr, "occupancy query: %d\n", per_cu); per_cu = 1; }
        (void)hipGetLastError();
        grid = cus * per_cu; if (grid > 256) grid = 256;
        if (n_in != 34 || ws_size < 512 * MiB) { fprintf(stderr, "unexpected n_in %d / ws %zu\n", n_in, ws_size); grid = -1; return; }
    }
    if (grid < 0) return;
    static Params p;
    memset(&p, 0, sizeof(p));
    for (int i = 0; i < 34; ++i) p.in[i] = (const float*)d_in[i];
    p.out = (float*)d_out; p.ws = (unsigned char*)d_ws;
    unsigned char* ws = (unsigned char*)d_ws;
    auto B16 = [&](size_t off) { return (bf16_t*)(ws + off); };
    int ncj = 0, tile_acc = 0;
    auto CJ = [&](const float* src, size_t dst_off, int K, int N, int Kpad, int Npad) { ConvJob& c = p.cj[ncj++]; c.src = src; c.dst = B16(dst_off); c.K = K; c.N = N; c.Kpad = Kpad; c.Npad = Npad; c.tile0 = tile_acc; c.ntiles = (Kpad / 64) * (Npad / 256); tile_acc += c.ntiles; };
    const float* w_up = p.in[3]; const float* w_down = p.in[4];
    tile_acc = 0;
    CJ(p.in[5], WS_WBA, 2048, 4112, 2048, 4352); CJ(p.in[15], WS_WBA + 17 * MiB, 2048, 2048, 2048, 2048);
    tile_acc = 0;
    CJ(w_up, WS_WMLP, 2048, 8192, 2048, 8192); CJ(w_down, WS_WMLP + 32 * MiB, 8192, 2048, 8192, 2048);
    tile_acc = 0;
    CJ(p.in[28], WS_WBA, 2048, 2048, 2048, 2048); CJ(p.in[29], WS_WBA + 8 * MiB, 2048, 2048, 2048, 2048); CJ(p.in[30], WS_WBA + 16 * MiB, 2048, 2048, 2048, 2048); CJ(p.in[31], WS_WBA + 24 * MiB, 2048, 2048, 2048, 2048);
    CJ(p.in[18], WS_WBA + 32 * MiB, 2048, 96, 2048, 256); CJ(p.in[21], WS_WBA + 33 * MiB, 2048, 96, 2048, 256); CJ(p.in[23], WS_WBA + 34 * MiB, 2048, 256, 2048, 256);
    CJ(p.in[19], WS_WBA + 35 * MiB, 96, 2048, 256, 2048); CJ(p.in[22], WS_WBA + 36 * MiB, 96, 2048, 256, 2048); CJ(p.in[24], WS_WBA + 37 * MiB, 256, 2048, 256, 2048);
    tile_acc = 0;
    CJ(w_up + (size_t)2048 * 8192, WS_WMLP1, 2048, 8192, 2048, 8192); CJ(w_down + (size_t)2048 * 8192, WS_WMLP1 + 32 * MiB, 8192, 2048, 8192, 2048);
    int nop = 0;
    auto GO = [&](const bf16_t* A, const bf16_t* Bt, void* out, const float* bias, const float* res, int M, int N, int K, int ldc, int act, int rot) {
        GemmOp& o = p.g[nop++]; o.A = A; o.Bt = Bt; o.out = out; o.bias = bias; o.res = res; o.M = M; o.N = N; o.K = K; o.ldc = ldc; o.act = act; o.rot = rot; };
    GO(B16(WS_H), B16(WS_WBA), B16(WS_PROJ), nullptr, nullptr, MTOK, INWP, 2048, INWP, 0, 0);
    GO(B16(WS_YMIX), B16(WS_WBA + 17 * MiB), d_out, nullptr, p.in[0], MTOK, 2048, 2048, 2048, 0, 0);
    GO(B16(WS_H), B16(WS_WMLP), B16(WS_U), nullptr, nullptr, MTOK, DFF, 2048, DFF, 1, 0);
    GO(B16(WS_U), B16(WS_WMLP + 32 * MiB), d_out, nullptr, (const float*)d_out, MTOK, 2048, DFF, 2048, 0, 0);
    for (int half = 0; half < 2; ++half) {
        const size_t ro = (size_t)half * 8192 * 2048 * 2, lo_ = (size_t)half * 8192 * 256 * 2; const size_t mb = (size_t)8192 * 2048 * 2;
        GO(B16(WS_MIX + 0 * mb), B16(WS_WBA), B16(WS_R + ro), nullptr, nullptr, 8192, 2048, 2048, 2048, 0, 0);
        GO(B16(WS_MIX + 2 * mb), B16(WS_WBA + 8 * MiB), B16(WS_K + ro), nullptr, nullptr, 8192, 2048, 2048, 2048, 0, 0);
        GO(B16(WS_MIX + 3 * mb), B16(WS_WBA + 16 * MiB), B16(WS_V + ro), nullptr, nullptr, 8192, 2048, 2048, 2048, 0, 0);
        GO(B16(WS_MIX + 1 * mb), B16(WS_WBA + 32 * MiB), B16(WS_L1W + lo_), nullptr, nullptr, 8192, 256, 2048, 256, 2, 0);
        GO(B16(WS_MIX + 4 * mb), B16(WS_WBA + 33 * MiB), B16(WS_L1A + lo_), nullptr, nullptr, 8192, 256, 2048, 256, 0, 32);
        GO(B16(WS_MIX + 5 * mb), B16(WS_WBA + 34 * MiB), B16(WS_L1G + lo_), nullptr, nullptr, 8192, 256, 2048, 256, 3, 64);
    }
    GO(B16(WS_L1W), B16(WS_WBA + 35 * MiB), B16(WS_WDEC), p.in[17], nullptr, MTOK, 2048, 256, 2048, 4, 0);
    GO(B16(WS_L1A), B16(WS_WBA + 36 * MiB), B16(WS_AA), p.in[20], nullptr, MTOK, 2048, 256, 2048, 3, 0);
    GO(B16(WS_L1G), B16(WS_WBA + 37 * MiB), B16(WS_GG), nullptr, nullptr, MTOK, 2048, 256, 2048, 0, 0);
    GO(B16(WS_YG), B16(WS_WBA + 24 * MiB), d_out, nullptr, (const float*)d_out, MTOK, 2048, 2048, 2048, 0, 0);
    GO(B16(WS_H), B16(WS_WMLP1), B16(WS_U), nullptr, nullptr, MTOK, DFF, 2048, DFF, 1, 0);
    GO(B16(WS_U), B16(WS_WMLP1 + 32 * MiB), d_out, nullptr, (const float*)d_out, MTOK, 2048, DFF, 2048, 0, 0);
    int ns = 0;
    auto ST = [&](int kind, int lo, int hi, int clo = 0, int chi = 0, int cq = 0) { p.kind[ns] = kind; p.lo[ns] = lo; p.hi[ns] = hi; p.clo[ns] = clo; p.chi[ns] = chi; p.cq[ns] = cq; ++ns; };
    ST(K_PRE0, 0, 2); ST(K_GEMMB, 0, 1, 2, 4, 0); ST(K_CONVSSD, 0, 0); ST(K_MIX0, 0, 0); ST(K_POST0, 0, 0); ST(K_GEMMF, 1, 2); ST(K_NORM, 0, 0); ST(K_GEMMB, 2, 3); ST(K_GEMMF, 3, 4);
    ST(K_PRE1, 4, 14); ST(K_GEMMB, 4, 10, 14, 16, 1); ST(K_MIXES, 0, 0); ST(K_GEMMB, 10, 16, 14, 16, 1); ST(K_GEMMB, 16, 19); ST(K_RWKV, 0, 0); ST(K_GEMMF, 19, 20); ST(K_NORM, 1, 0); ST(K_GEMMB, 20, 21); ST(K_GEMMF, 21, 22);
    (void)hipMemsetAsync(ws + WS_BAR, 0, 16384 + 1024, stream);
#if MK_MULTI
    for (int s = 0; s < ns; ++s) { p.step_lo = s; p.step_hi = s + 1; hipLaunchKernelGGL(mega, dim3(grid), dim3(512), LDS_BYTES, stream, p); }
#else
    p.step_lo = 0; p.step_hi = ns;
    void* args[] = {(void*)&p};
    const hipError_t e = hipLaunchCooperativeKernel((const void*)mega, dim3(grid), dim3(512), args, LDS_BYTES, stream);
    if (e != hipSuccess) fprintf(stderr, "cooperative launch failed: %s (grid %d)\n", hipGetErrorString(e), grid);
#endif
}
```

```cpp
#include <hip/hip_runtime.h>
#include <hip/hip_cooperative_groups.h>
#include <cstdio>
#include <cstring>
namespace cg = cooperative_groups;
__device__ __forceinline__ int opq(int v) { asm volatile("" : "+v"(v)); return v; }
namespace pg8 {
#define PG8_LAS __attribute__((address_space(3)))
typedef unsigned short bf16_t;
typedef short bf16x8 __attribute__((ext_vector_type(8)));
typedef float f32x4 __attribute__((ext_vector_type(4)));
typedef unsigned u32x4 __attribute__((ext_vector_type(4)));
constexpr int BM = 256, BK = 64, HALF = 128, HTB = HALF * BK * 2  , STAGE_BYTES = 8 * HTB, NXCD = 8, WGM = 8;

__host__ __device__ __forceinline__ int lds_byte(int r, int c) { const int st = (r >> 4) * 2 + (c >> 5), rr = r & 15, cc = c & 31, ob = rr * 64 + cc * 2; return st * 1024 + (ob ^ (((ob >> 9) & 1) << 5)); }
__host__ __device__ __forceinline__ void stage_rc(int b, int& R, int& C) { const int st = b / 1024, sb = b % 1024, swz = sb ^ (((sb >> 9) & 1) << 5); R = (st >> 1) * 16 + swz / 64; C = (st & 1) * 32 + (swz % 64) / 2; }
__host__ __device__ __forceinline__ int perm32(int rho) { const int n = rho >> 4, i = rho & 15; return 8 * (i >> 2) + 4 * n + (i & 3); }

struct Unit { int pm, pn, op; };
struct Gemm { const bf16_t* A; const bf16_t* Bt; int M, N, K; };

struct StaticOrder {
    int nM, nN, nwg, G, c;
    __host__ __device__ void init(int M, int N, int G_, int c_) { nM = M / BM; nN = N / BM; nwg = nM * nN; G = G_; c = c_; }
    __host__ __device__ bool next(int i, Unit& u) const {
        const long L = (long)i * G + c; if (L >= nwg) return false;
        int wgid = (int)L; { const int q = nwg / NXCD, r = nwg % NXCD, xcd = wgid % NXCD, off = wgid / NXCD; wgid = (xcd < r ? xcd * (q + 1) : r * (q + 1) + (xcd - r) * q) + off; }
        const int nig = WGM * nN, gid = wgid / nig, fm = gid * WGM, gsz = (nM - fm) < WGM ? (nM - fm) : WGM;
        u.pm = fm + ((wgid % nig) % gsz); u.pn = (wgid % nig) / gsz; u.op = 0; return true;
    }
    __device__ __forceinline__ const char* abase(const Unit&, const Gemm& g) const { return (const char*)g.A; }
    __device__ __forceinline__ const char* bbase(const Unit&, const Gemm& g) const { return (const char*)g.Bt; }
    __device__ __forceinline__ void a_ready(const Unit&) const {}
    __device__ __forceinline__ void done(const Unit&) const {}
};
typedef __bf16 bf16x2_t __attribute__((ext_vector_type(2)));
typedef float f32x2_t __attribute__((ext_vector_type(2)));
__device__ __forceinline__ unsigned cvt_pk_bf16(float lo, float hi) { const f32x2_t f = {lo, hi}; const bf16x2_t v = __builtin_convertvector(f, bf16x2_t); return __builtin_bit_cast(unsigned, v); }
__device__ __forceinline__ unsigned cvt_pk_nv(float lo, float hi) { return cvt_pk_bf16(lo, hi); }

template <class Epi, class Sched, bool STAMP = false>
__device__ __forceinline__ void gemm_phase(PG8_LAS unsigned char* lds, const Gemm g, const Sched& S, const Epi& E, unsigned long long* stamps) {
    const int tid = opq(threadIdx.x), wid = __builtin_amdgcn_readfirstlane(tid >> 6), lane = tid & 63, wr = wid >> 2, wc = wid & 3, fr = lane & 15, fq = lane >> 4;
    const int K = g.K, nt = K / BK;
    int ts_lo = 0, ts_hi = 0, nts = 0; const unsigned long long rt_entry = STAMP ? (unsigned long long)wall_clock64() : 0ull;
#define PG8_STAMP() do { if (STAMP && wid == 0 && nts < 64) { const unsigned long long _c = (unsigned long long)clock64(); \
        ts_lo = (lane == nts) ? (int)(unsigned)_c : ts_lo; ts_hi = (lane == nts) ? (int)(unsigned)(_c >> 32) : ts_hi; ++nts; } } while (0)
    PG8_STAMP();
    unsigned voffA[2], voffB[2];
#pragma unroll
    for (int i = 0; i < 2; ++i) { int R, C; stage_rc(tid * 16 + i * 8192, R, C); const int Rb = Epi::PERM ? ((R & ~31) + perm32(R & 31)) : R;
        voffA[i] = (unsigned)(R * K + C) * 2u; voffB[i] = (unsigned)(Rb * K + C) * 2u; }
    const size_t kstep = (size_t)(BK * 2);
    const size_t hstep = (size_t)HALF * K * 2;
    const size_t tstep = 2 * hstep;
    const unsigned ldsw = (unsigned)wid * 1024u;
    const int aoff = lds_byte(wr * 64 + fr, fq * 8), boff = lds_byte(wc * 32 + fr, fq * 8);
#define PG8_SA(b, h) (((b) * 2 + (h)) * HTB)
#define PG8_SB(b, h) ((4 + (b) * 2 + (h)) * HTB)
#define PG8_STAGE(bufoff, gbase, voff) do { _Pragma("unroll") for (int _i = 0; _i < 2; ++_i) \
        __builtin_amdgcn_global_load_lds((const unsigned*)((const char*)(gbase) + (voff)[_i]), (PG8_LAS unsigned*)(lds + (bufoff) + ldsw + _i * 8192), 16, 0, 0); } while (0)
#define PG8_LDA(dst, b, h) do { _Pragma("unroll") for (int m = 0; m < 4; ++m) _Pragma("unroll") for (int k = 0; k < 2; ++k) dst[m][k] = *(const PG8_LAS bf16x8*)(lds + PG8_SA(b, h) + aoff + m * 2048 + k * 1024); } while (0)
#define PG8_LDB(dst, b, h) do { _Pragma("unroll") for (int n = 0; n < 2; ++n) _Pragma("unroll") for (int k = 0; k < 2; ++k) dst[n][k] = *(const PG8_LAS bf16x8*)(lds + PG8_SB(b, h) + boff + n * 2048 + k * 1024); } while (0)
#define PG8_MMA(ai, bj, At, Bt) do { __builtin_amdgcn_s_setprio(1); _Pragma("unroll") for (int m = 0; m < 4; ++m) _Pragma("unroll") for (int n = 0; n < 2; ++n) _Pragma("unroll") for (int k = 0; k < 2; ++k) \
        acc[ai][bj][m][n] = __builtin_amdgcn_mfma_f32_16x16x32_bf16(Bt[n][k], At[m][k], acc[ai][bj][m][n], 0, 0, 0); __builtin_amdgcn_s_setprio(0); } while (0)
#define PG8_WAIT_V(n) asm volatile("s_waitcnt vmcnt(" #n ")" ::: "memory")
#define PG8_WAIT_L(n) asm volatile("s_waitcnt lgkmcnt(" #n ")" ::: "memory")
#define PG8_BAR __builtin_amdgcn_s_barrier()
#define PG8_SCHED __builtin_amdgcn_sched_barrier(0)
    Unit cur, nxt; int ui = 0;
    if (!S.next(0, cur)) return;
    f32x4 acc[2][2][4][2];
#pragma unroll
    for (int a = 0; a < 2; ++a)
#pragma unroll
        for (int b = 0; b < 2; ++b)
#pragma unroll
            for (int m = 0; m < 4; ++m)
#pragma unroll
                for (int n = 0; n < 2; ++n) acc[a][b][m][n] = (f32x4){0.f, 0.f, 0.f, 0.f};
    bf16x8 At[4][2], B0[2][2], B1[2][2];
    const char* cA = S.abase(cur, g) + (size_t)cur.pm * tstep; const char* cB = S.bbase(cur, g) + (size_t)cur.pn * tstep;
    S.a_ready(cur);
    PG8_STAGE(PG8_SB(0, 0), cB, voffB); PG8_STAGE(PG8_SA(0, 0), cA, voffA); PG8_STAGE(PG8_SB(0, 1), cB + hstep, voffB); PG8_STAGE(PG8_SA(0, 1), cA + hstep, voffA);
    if (wr == 1) PG8_BAR;
    PG8_WAIT_V(4); PG8_BAR;
    PG8_STAGE(PG8_SB(1, 0), cB + kstep, voffB); PG8_STAGE(PG8_SA(1, 0), cA + kstep, voffA); PG8_STAGE(PG8_SB(1, 1), cB + hstep + kstep, voffB);
    PG8_WAIT_V(6); PG8_BAR;
    PG8_STAMP();
    for (;;) {
        const bool has_next = S.next(ui + 1, nxt);
        const char* nA = has_next ? S.abase(nxt, g) + (size_t)nxt.pm * tstep : cA; const char* nB = has_next ? S.bbase(nxt, g) + (size_t)nxt.pn * tstep : cB;
        for (int t = 0; t < nt; t += 2) {
            const bool last = (t == nt - 2);
            const char* a1 = cA + (size_t)(t + 1) * kstep;
            const char* a2 = last ? nA : cA + (size_t)(t + 2) * kstep; const char* b2 = last ? nB : cB + (size_t)(t + 2) * kstep;
            const char* a3 = a2 + kstep; const char* b3 = b2 + kstep;
            if (last && has_next) S.a_ready(nxt);
            PG8_LDB(B0, 0, 0); PG8_SCHED; PG8_LDA(At, 0, 0); PG8_STAGE(PG8_SA(1, 1), a1 + hstep, voffA);
            PG8_WAIT_L(8); PG8_BAR; PG8_WAIT_L(0); PG8_MMA(0, 0, At, B0); PG8_BAR; PG8_SCHED;
            PG8_LDB(B1, 0, 1); PG8_STAGE(PG8_SB(0, 0), b2, voffB);
            PG8_BAR; PG8_WAIT_L(0); PG8_MMA(0, 1, At, B1); PG8_BAR;
            PG8_LDA(At, 0, 1); PG8_STAGE(PG8_SA(0, 0), a2, voffA);
            PG8_BAR; PG8_WAIT_L(0); PG8_MMA(1, 0, At, B0); PG8_BAR; PG8_SCHED;
            PG8_STAGE(PG8_SB(0, 1), b2 + hstep, voffB);
            PG8_WAIT_V(6); PG8_BAR; PG8_MMA(1, 1, At, B1); PG8_BAR;
            PG8_LDB(B0, 1, 0); PG8_SCHED; PG8_LDA(At, 1, 0); PG8_STAGE(PG8_SA(0, 1), a2 + hstep, voffA);
            PG8_WAIT_L(8); PG8_BAR; PG8_WAIT_L(0); PG8_MMA(0, 0, At, B0); PG8_BAR; PG8_SCHED;
            PG8_LDB(B1, 1, 1); PG8_STAGE(PG8_SB(1, 0), b3, voffB);
            PG8_BAR; PG8_WAIT_L(0); PG8_MMA(0, 1, At, B1); PG8_BAR;
            PG8_LDA(At, 1, 1); PG8_STAGE(PG8_SA(1, 0), a3, voffA);
            PG8_BAR; PG8_WAIT_L(0); PG8_MMA(1, 0, At, B0); PG8_BAR; PG8_SCHED;
            PG8_STAGE(PG8_SB(1, 1), b3 + hstep, voffB);
            PG8_WAIT_V(6); PG8_BAR; PG8_MMA(1, 1, At, B1); PG8_BAR;
        }
        PG8_STAMP();
        if constexpr (!Epi::AFTER_DRAIN) { E(acc, cur, wr, wc, fr, fq); S.done(cur); }
        PG8_STAMP();
        if (!has_next) break;
#pragma unroll
        for (int a = 0; a < 2; ++a)
#pragma unroll
            for (int b = 0; b < 2; ++b)
#pragma unroll
                for (int m = 0; m < 4; ++m)
#pragma unroll
                    for (int n = 0; n < 2; ++n) acc[a][b][m][n] = (f32x4){0.f, 0.f, 0.f, 0.f};
        cur = nxt; cA = nA; cB = nB; ++ui;
    }
    PG8_WAIT_V(0);
    if (wr == 0) PG8_BAR;
    PG8_BAR;
    if constexpr (Epi::AFTER_DRAIN) { E.fused(acc, cur, wr, wc, fr, fq, lds, wid, lane); S.done(cur); }
    PG8_STAMP();
    if (STAMP && wid == 0) { stamps[lane] = lane < nts ? (((unsigned long long)(unsigned)ts_hi << 32) | (unsigned)ts_lo) : 0ull;
        if (lane == 62) stamps[62] = rt_entry; if (lane == 63) stamps[63] = (unsigned long long)wall_clock64(); }
#undef PG8_STAMP
#undef PG8_SA
#undef PG8_SB
#undef PG8_STAGE
#undef PG8_LDA
#undef PG8_LDB
#undef PG8_MMA
#undef PG8_WAIT_V
#undef PG8_WAIT_L
#undef PG8_BAR
#undef PG8_SCHED
}
}

#include <cstdio>
#include <ctime>
#include <cstdlib>
#include <cstring>
#include <cmath>
#include <vector>
#include <algorithm>
#define CK(x) do { hipError_t e_ = (x); if (e_ != hipSuccess) { fprintf(stderr, "HIP %s:%d %s\n", __FILE__, __LINE__, hipGetErrorString(e_)); exit(2); } } while (0)
using pg8::bf16_t; using pg8::bf16x8; using pg8::f32x4; using pg8::u32x4; using pg8::cvt_pk_bf16; using pg8::cvt_pk_nv;
#define LAS PG8_LAS

constexpr int D = 2048, SEQ = 2048, MTOK = 16384, DFF = 8192, INWP = 4352;
constexpr int COL_K = 1024, COL_V = 1280, COL_Z = 1536, COL_XBC = 2560, COL_DT = 4096;
constexpr size_t MiB = (size_t)1 << 20;
constexpr size_t WS_WBA = 0, WS_WMLP = 40 * MiB, WS_H = 104 * MiB, WS_PROJ = 168 * MiB, WS_YMIX = 304 * MiB, WS_YRAW = 368 * MiB, WS_XBC = 432 * MiB,
                 WS_DT = 480 * MiB, WS_DA = 481 * MiB, WS_ROPE = 482 * MiB, WS_U = 168 * MiB;
constexpr size_t WS_R = 40 * MiB, WS_K = 104 * MiB, WS_V = 168 * MiB, WS_L1W = 232 * MiB, WS_L1A = 240 * MiB, WS_L1G = 248 * MiB, WS_MIX = 256 * MiB,
                 WS_WDEC = 256 * MiB, WS_AA = 320 * MiB, WS_GG = 384 * MiB, WS_YG = 40 * MiB  , WS_WMLP1 = 448 * MiB;
constexpr size_t WS_BAR = 39 * MiB;
constexpr int LDS_BYTES = 140 * 1024;

enum { K_PRE0 = 0, K_GEMMB, K_GEMMF, K_CONVSSD, K_MIX0, K_POST0, K_NORM, K_PRE1, K_MIXES, K_RWKV, K_NORMCONV };
constexpr int NSTEPS = 48, NOPS = 22, NCJ = 16;
#define REP_GEMMB 1
#define REP_MIX0 1
#define REP_RWKV 1
#define REP_ELEM 1

struct GemmOp { const bf16_t* A; const bf16_t* Bt; void* out; const float* bias; const float* res; int M, N, K, ldc, act, rot, pad0, pad1; };
struct ConvJob { const float* src; bf16_t* dst; int K, N, Kpad, Npad, tile0, ntiles; };
struct Params {
    const float* in[34];
    float* out; unsigned char* ws;
    GemmOp g[NOPS];
    ConvJob cj[NCJ];
    int kind[NSTEPS + 1]; int lo[NSTEPS + 1]; int hi[NSTEPS + 1]; int clo[NSTEPS + 1]; int chi[NSTEPS + 1]; int cq[NSTEPS + 1];
    int step_lo, step_hi;
};

__device__ __forceinline__ float bf2f(unsigned short b) { return __uint_as_float(((unsigned)b) << 16); }
__device__ __forceinline__ float bflo(unsigned w) { return __uint_as_float(w << 16); }
__device__ __forceinline__ float bfhi(unsigned w) { return __uint_as_float(w & 0xffff0000u); }
__device__ __forceinline__ bf16_t f2bf(float f) { return (bf16_t)(cvt_pk_bf16(f, 0.f) & 0xffffu); }
template <int CTRL> __device__ __forceinline__ float dpp_add(float x) {
    const int y = __builtin_amdgcn_update_dpp(0, __builtin_bit_cast(int, x), CTRL, 0xf, 0xf, true);
    return x + __builtin_bit_cast(float, y); }
template <int CTRL> __device__ __forceinline__ float dpp_max(float x) {
    const int y = __builtin_amdgcn_update_dpp(0, __builtin_bit_cast(int, x), CTRL, 0xf, 0xf, true);
    return fmaxf(x, __builtin_bit_cast(float, y)); }
__device__ __forceinline__ float max16(float x) { x = dpp_max<0xB1>(x); x = dpp_max<0x4E>(x); x = dpp_max<0x141>(x); x = dpp_max<0x140>(x); return x; }
__device__ __forceinline__ float red8(float x) { x = dpp_add<0xB1>(x); x = dpp_add<0x4E>(x); x = dpp_add<0x141>(x); return x; }
__device__ __forceinline__ float red16(float x) { x = red8(x); x = dpp_add<0x140>(x); return x; }
__device__ __forceinline__ float wave_sum(float v) {
    v = red16(v);
    const float r0 = __builtin_bit_cast(float, __builtin_amdgcn_readlane(__builtin_bit_cast(int, v), 0)), r1 = __builtin_bit_cast(float, __builtin_amdgcn_readlane(__builtin_bit_cast(int, v), 16));
    const float r2 = __builtin_bit_cast(float, __builtin_amdgcn_readlane(__builtin_bit_cast(int, v), 32)), r3 = __builtin_bit_cast(float, __builtin_amdgcn_readlane(__builtin_bit_cast(int, v), 48));
    return (r0 + r1) + (r2 + r3); }
typedef float f32x2 __attribute__((ext_vector_type(2)));
typedef unsigned u32x2 __attribute__((ext_vector_type(2)));
__device__ __forceinline__ float sigmoidf_(float v) { return __builtin_amdgcn_rcpf(1.0f + __expf(-v)); }
__device__ __forceinline__ void unpack8(const uint4 r, float (&f)[8]) {
    f[0] = bflo(r.x); f[1] = bfhi(r.x); f[2] = bflo(r.y); f[3] = bfhi(r.y); f[4] = bflo(r.z); f[5] = bfhi(r.z); f[6] = bflo(r.w); f[7] = bfhi(r.w); }

__device__ __forceinline__ float act_apply(float v, int act) {
    switch (act) {
        case 1: { const float r = fmaxf(v, 0.f); return r * r; }
        case 2: return 1.0f - 2.0f * __builtin_amdgcn_rcpf(1.0f + __expf(2.0f * v));
        case 3: return sigmoidf_(v);
        case 4: return 0.60653066f * sigmoidf_(v);
        default: return v; }
}
struct EpiB {
    static constexpr bool PERM = true, AFTER_DRAIN = false;
    const GemmOp* ops;
    __device__ __forceinline__ void operator()(const f32x4 (&acc)[2][2][4][2], const pg8::Unit& u, int wr, int wc, int fr, int fq) const {
        const GemmOp& o_ = ops[u.op]; bf16_t* O = (bf16_t*)o_.out; const int ldc = o_.ldc; const float* bias = o_.bias; const int act = o_.act;
        const int row0 = u.pm * 256 + wr * 64 + fr, col0 = u.pn * 256 + wc * 32 + 8 * fq;
        f32x4 bv[2][2];
#pragma unroll
        for (int bj = 0; bj < 2; ++bj)
#pragma unroll
            for (int n = 0; n < 2; ++n) bv[bj][n] = bias ? *(const f32x4*)(bias + col0 + bj * 128 + 4 * n) : (f32x4){0.f, 0.f, 0.f, 0.f};
#pragma unroll
        for (int ai = 0; ai < 2; ++ai)
#pragma unroll
            for (int m = 0; m < 4; ++m) { bf16_t* rowp = O + (size_t)(row0 + ai * 128 + m * 16) * ldc + col0;
#pragma unroll
                for (int bj = 0; bj < 2; ++bj) { f32x4 v0 = acc[ai][bj][m][0], v1 = acc[ai][bj][m][1];
                    v0 += bv[bj][0]; v1 += bv[bj][1];
                    if (act) {
#pragma unroll
                        for (int j = 0; j < 4; ++j) { v0[j] = act_apply(v0[j], act); v1[j] = act_apply(v1[j], act); } }
                    u32x4 w; w.x = cvt_pk_bf16(v0[0], v0[1]); w.y = cvt_pk_bf16(v0[2], v0[3]); w.z = cvt_pk_bf16(v1[0], v1[1]); w.w = cvt_pk_bf16(v1[2], v1[3]);
                    *(u32x4*)(rowp + bj * 128) = w; } }
    }
};
struct MultiOrder {
    const GemmOp* ops; int nops, G, c;
    __device__ __forceinline__ bool next(int i, pg8::Unit& u) const {
        long L = (long)i * G + c; int k = 0, nM = 0, nN = 0, nwg = 0;
        for (; k < nops; ++k) { nM = ops[k].M / 256; nN = ops[k].N / 256; nwg = nM * nN; if (L < nwg) break; L -= nwg; }
        if (k == nops) return false;
        int wgid = (int)L; { const int q = nwg / pg8::NXCD, r = nwg % pg8::NXCD, xcd = wgid % pg8::NXCD, off = wgid / pg8::NXCD; wgid = (xcd < r ? xcd * (q + 1) : r * (q + 1) + (xcd - r) * q) + off; }
        const int nig = pg8::WGM * nN, gid = wgid / nig, fm = gid * pg8::WGM, gsz = (nM - fm) < pg8::WGM ? (nM - fm) : pg8::WGM;
        u.pm = fm + ((wgid % nig) % gsz); u.pn = (wgid % nig) / gsz; u.op = k; return true;
    }
    __device__ __forceinline__ const char* abase(const pg8::Unit& u, const pg8::Gemm&) const { return (const char*)ops[u.op].A; }
    __device__ __forceinline__ const char* bbase(const pg8::Unit& u, const pg8::Gemm&) const { return (const char*)ops[u.op].Bt; }
    __device__ __forceinline__ void a_ready(const pg8::Unit&) const {}
    __device__ __forceinline__ void done(const pg8::Unit&) const {}
};
struct EpiF {
    static constexpr bool PERM = false, AFTER_DRAIN = false;
    float* C; int ldc; const float* res;
    __device__ __forceinline__ void operator()(const f32x4 (&acc)[2][2][4][2], const pg8::Unit& u, int wr, int wc, int fr, int fq) const {
        const int row0 = u.pm * 256 + wr * 64 + fr, col0 = u.pn * 256 + wc * 32 + 4 * fq;
#pragma unroll
        for (int ai = 0; ai < 2; ++ai)
#pragma unroll
            for (int mh = 0; mh < 2; ++mh) { size_t ro[2]; f32x4 r[2][2][2];
#pragma unroll
                for (int mm = 0; mm < 2; ++mm) { ro[mm] = (size_t)(row0 + ai * 128 + (mh * 2 + mm) * 16) * ldc + col0;
#pragma unroll
                    for (int bj = 0; bj < 2; ++bj)
#pragma unroll
                        for (int n = 0; n < 2; ++n) r[mm][bj][n] = *(const f32x4*)(res + ro[mm] + bj * 128 + n * 16); }
#pragma unroll
                for (int mm = 0; mm < 2; ++mm)
#pragma unroll
                    for (int bj = 0; bj < 2; ++bj)
#pragma unroll
                        for (int n = 0; n < 2; ++n) *(f32x4*)(C + ro[mm] + bj * 128 + n * 16) = acc[ai][bj][mh * 2 + mm][n] + r[mm][bj][n]; }
    }
};

__device__ __forceinline__ void convert_one_tile(const Params& p, int jlo, int jhi, int tile, int tid, LAS float* T) {
    int j = jlo; while (j + 1 < jhi && tile >= p.cj[j + 1].tile0) ++j;
    const float* src = p.cj[j].src; bf16_t* dst = p.cj[j].dst; const int K = p.cj[j].K, N = p.cj[j].N, Kpad = p.cj[j].Kpad;
    const int local = tile - p.cj[j].tile0, nkt = Kpad >> 6, kt = local % nkt, nt = local / nkt;
    f32x4 v[8];
#pragma unroll
    for (int i = 0; i < 8; ++i) { const int idx = tid + i * 512, kr = idx >> 6, c4 = idx & 63, k = kt * 64 + kr, n = nt * 256 + c4 * 4;
        v[i] = (f32x4){0.f, 0.f, 0.f, 0.f};
        if (k < K && n < N) v[i] = *(const f32x4*)(src + (size_t)k * N + n); }
#pragma unroll
    for (int i = 0; i < 8; ++i) { const int idx = tid + i * 512, kr = idx >> 6, c4 = idx & 63;
        T[kr * 257 + c4 * 4 + 0] = v[i][0]; T[kr * 257 + c4 * 4 + 1] = v[i][1]; T[kr * 257 + c4 * 4 + 2] = v[i][2]; T[kr * 257 + c4 * 4 + 3] = v[i][3]; }
    __syncthreads();
#pragma unroll
    for (int i = 0; i < 4; ++i) { const int idx = tid + i * 512, nl = idx >> 3, kc = idx & 7; float f[8];
#pragma unroll
        for (int e = 0; e < 8; ++e) f[e] = T[(kc * 8 + e) * 257 + nl];
        u32x4 w; w.x = cvt_pk_nv(f[0], f[1]); w.y = cvt_pk_nv(f[2], f[3]); w.z = cvt_pk_nv(f[4], f[5]); w.w = cvt_pk_nv(f[6], f[7]);
        *(u32x4*)(dst + (size_t)(nt * 256 + nl) * Kpad + kt * 64 + kc * 8) = w; }
    __syncthreads();
}
__device__ __forceinline__ void convert_tiles(const Params& p, int jlo, int jhi, LAS unsigned char* lds) {
    const int tid = opq(threadIdx.x); LAS float* T = (LAS float*)lds;
    const int total = p.cj[jhi - 1].tile0 + p.cj[jhi - 1].ntiles;
    for (int tile = blockIdx.x; tile < total; tile += gridDim.x) convert_one_tile(p, jlo, jhi, tile, tid, T);
}
__device__ __forceinline__ void convert_queue(const Params& p, int jlo, int jhi, unsigned* counter, LAS unsigned char* lds) {
    const int tid = opq(threadIdx.x); LAS float* T = (LAS float*)lds; LAS int* slot = (LAS int*)(lds + 72 * 1024);
    const int total = p.cj[jhi - 1].tile0 + p.cj[jhi - 1].ntiles;
    for (;;) {
        __syncthreads();
        if (tid == 0) *slot = (int)__hip_atomic_fetch_add(counter, 1u, __ATOMIC_RELAXED, __HIP_MEMORY_SCOPE_AGENT);
        __syncthreads();
        const int tile = *slot;
        if (tile >= total) break;
        convert_one_tile(p, jlo, jhi, tile, tid, T);
    }
}

__device__ __forceinline__ void rope_table(const Params& p) {
    float2* tab = (float2*)(p.ws + WS_ROPE);
    for (int idx = blockIdx.x * 512 + opq(threadIdx.x); idx < SEQ * 32; idx += gridDim.x * 512) {
        const int t = idx >> 5, i = idx & 31;
        const float inv = exp2f(-(float)i * 0.41524101186092029f);
        const float angf = (float)t * inv;
        const double ang = (double)angf;
        const double q = rint(ang * 0.6366197723675814);
        const float f = (float)fma(-q, 1.5707963267948966, ang), f2 = f * f;
        const float s = f * (1.0f + f2 * (-1.6666667e-1f + f2 * (8.3333333e-3f + f2 * (-1.9841270e-4f + f2 * 2.7557319e-6f))));
        const float c = 1.0f + f2 * (-0.5f + f2 * (4.1666667e-2f + f2 * (-1.3888889e-3f + f2 * (2.4801587e-5f + f2 * (-2.7557319e-7f)))));
        const int qi = ((int)q) & 3;
        const float sn = (qi == 0) ? s : (qi == 1) ? c : (qi == 2) ? -s : -c;
        const float cs = (qi == 0) ? c : (qi == 1) ? -s : (qi == 2) ? -c : s;
        tab[idx] = make_float2(cs, sn);
    }
}

__device__ __forceinline__ void norm_rows(const float* x, const float* g, bf16_t* h) {
    const int tid_ = opq(threadIdx.x); const int lane = tid_ & 63, wv = tid_ >> 6;
    f32x4 gg[8];
#pragma unroll
    for (int i = 0; i < 8; ++i) gg[i] = *(const f32x4*)(g + i * 256 + lane * 4);
    for (int row = (blockIdx.x * 8 + wv) * 2; row < MTOK; row += gridDim.x * 16) {
        const float* xr = x + (size_t)row * D; f32x4 v[8], u[8]; float ss = 0.f, st = 0.f;
#pragma unroll
        for (int i = 0; i < 8; ++i) { v[i] = *(const f32x4*)(xr + i * 256 + lane * 4); u[i] = *(const f32x4*)(xr + D + i * 256 + lane * 4); }
#pragma unroll
        for (int i = 0; i < 8; ++i) { ss += v[i][0] * v[i][0] + v[i][1] * v[i][1] + v[i][2] * v[i][2] + v[i][3] * v[i][3]; st += u[i][0] * u[i][0] + u[i][1] * u[i][1] + u[i][2] * u[i][2] + u[i][3] * u[i][3]; }
        ss = wave_sum(ss); st = wave_sum(st); const float r = rsqrtf(ss * (1.0f / D) + 1e-6f), r2 = rsqrtf(st * (1.0f / D) + 1e-6f);
#pragma unroll
        for (int i = 0; i < 8; ++i) {
            uint2 w; w.x = cvt_pk_nv(v[i][0] * r * gg[i][0], v[i][1] * r * gg[i][1]); w.y = cvt_pk_nv(v[i][2] * r * gg[i][2], v[i][3] * r * gg[i][3]);
            *(uint2*)(h + (size_t)row * D + i * 256 + lane * 4) = w;
            uint2 w2; w2.x = cvt_pk_nv(u[i][0] * r2 * gg[i][0], u[i][1] * r2 * gg[i][1]); w2.y = cvt_pk_nv(u[i][2] * r2 * gg[i][2], u[i][3] * r2 * gg[i][3]);
            *(uint2*)(h + (size_t)(row + 1) * D + i * 256 + lane * 4) = w2; }
    }
}

__device__ __forceinline__ void mix_rows(const float* x, const float* g, const float* mixw, bf16_t* mixbase, int tok0, LAS unsigned char* lds) {
    const int tid = opq(threadIdx.x), lane = tid & 63, wv = tid >> 6, c = tid * 4;
    LAS float* rs = (LAS float*)lds;
    const f32x4 gg = *(const f32x4*)(g + c); f32x4 mw[6];
#pragma unroll
    for (int m = 0; m < 6; ++m) mw[m] = *(const f32x4*)(mixw + m * D + c);
    for (int chunk = blockIdx.x; chunk < 256; chunk += gridDim.x) {
        const int rl0 = chunk * 32, tokc = tok0 + rl0; const bool hasprev = (tokc & (SEQ - 1)) != 0;
        __syncthreads();
        for (int r = wv; r < 33; r += 8) {
            float ss = 0.f;
            if (r > 0 || hasprev) { const float* xr = x + (size_t)(tokc - 1 + r) * D; f32x4 v[8];
#pragma unroll
                for (int i = 0; i < 8; ++i) v[i] = *(const f32x4*)(xr + i * 256 + lane * 4);
#pragma unroll
                for (int i = 0; i < 8; ++i) ss += v[i][0] * v[i][0] + v[i][1] * v[i][1] + v[i][2] * v[i][2] + v[i][3] * v[i][3]; }
            ss = wave_sum(ss);
            if (lane == 0) rs[r] = (r > 0 || hasprev) ? rsqrtf(ss * (1.0f / D) + 1e-6f) : 0.f;
        }
        __syncthreads();
        f32x4 prev = (f32x4){0.f, 0.f, 0.f, 0.f};
        if (hasprev) { const f32x4 pv = *(const f32x4*)(x + (size_t)(tokc - 1) * D + c); const float rp = rs[0]; prev = pv * rp * gg; }
        for (int r0 = 0; r0 < 32; r0 += 4) {
            f32x4 xv[4];
#pragma unroll
            for (int u = 0; u < 4; ++u) xv[u] = *(const f32x4*)(x + (size_t)(tokc + r0 + u) * D + c);
#pragma unroll
            for (int u = 0; u < 4; ++u) { const float rr = rs[r0 + u + 1]; const f32x4 hn = xv[u] * rr * gg, xx = prev - hn;
#pragma unroll
                for (int m = 0; m < 6; ++m) { const f32x4 o = hn + xx * mw[m];
                    uint2 w; w.x = cvt_pk_nv(o[0], o[1]); w.y = cvt_pk_nv(o[2], o[3]);
                    *(uint2*)(mixbase + (size_t)m * 8192 * D + (size_t)(rl0 + r0 + u) * D + c) = w; }
                prev = hn; }
        }
    }
}

__device__ __forceinline__ void conv_ssd(const Params& p) {
    const bf16_t* proj = (const bf16_t*)(p.ws + WS_PROJ); bf16_t* xbc = (bf16_t*)(p.ws + WS_XBC);
    const float* cw = p.in[6]; const float* cb = p.in[7];
    const int tid = opq(threadIdx.x);
    if (tid < 384) {
        const int c8 = tid % 192, par = tid / 192, c = c8 * 8;
        float w[4][8], bb[8];
#pragma unroll
        for (int j = 0; j < 4; ++j) { const f32x4 w0 = *(const f32x4*)(cw + j * 1536 + c), w1 = *(const f32x4*)(cw + j * 1536 + c + 4);
#pragma unroll
            for (int e = 0; e < 4; ++e) { w[j][e] = w0[e]; w[j][4 + e] = w1[e]; } }
        { const f32x4 b0 = *(const f32x4*)(cb + c), b1 = *(const f32x4*)(cb + c + 4);
#pragma unroll
          for (int e = 0; e < 4; ++e) { bb[e] = b0[e]; bb[4 + e] = b1[e]; } }
        for (int chunk = blockIdx.x; chunk < 256; chunk += gridDim.x) {
            const int t0 = chunk * 64 + par * 32; const bool hasprev = (t0 & (SEQ - 1)) != 0;
            float r0[8], r1[8], r2[8];
            if (hasprev) { const uint4 a = *(const uint4*)(proj + (size_t)(t0 - 3) * INWP + COL_XBC + c), b = *(const uint4*)(proj + (size_t)(t0 - 2) * INWP + COL_XBC + c), d = *(const uint4*)(proj + (size_t)(t0 - 1) * INWP + COL_XBC + c);
                unpack8(a, r0); unpack8(b, r1); unpack8(d, r2); }
            else {
#pragma unroll
                for (int e = 0; e < 8; ++e) { r0[e] = 0.f; r1[e] = 0.f; r2[e] = 0.f; } }
            for (int tg = 0; tg < 32; tg += 4) {
                uint4 rw[4];
#pragma unroll
                for (int u = 0; u < 4; ++u) rw[u] = *(const uint4*)(proj + (size_t)(t0 + tg + u) * INWP + COL_XBC + c);
#pragma unroll
                for (int u = 0; u < 4; ++u) { float cur[8], acc[8]; unpack8(rw[u], cur);
#pragma unroll
                    for (int e = 0; e < 8; ++e) { acc[e] = bb[e] + w[0][e] * r0[e] + w[1][e] * r1[e] + w[2][e] * r2[e] + w[3][e] * cur[e]; acc[e] = acc[e] * sigmoidf_(acc[e]); r0[e] = r1[e]; r1[e] = r2[e]; r2[e] = cur[e]; }
                    u32x4 o; o.x = cvt_pk_nv(acc[0], acc[1]); o.y = cvt_pk_nv(acc[2], acc[3]); o.z = cvt_pk_nv(acc[4], acc[5]); o.w = cvt_pk_nv(acc[6], acc[7]);
                    *(u32x4*)(xbc + (size_t)(t0 + tg + u) * 1536 + c) = o; }
            }
        }
    }
    float* dt = (float*)(p.ws + WS_DT); float* da = (float*)(p.ws + WS_DA);
    for (int idx = blockIdx.x * 512 + opq(threadIdx.x); idx < MTOK * 16; idx += gridDim.x * 512) {
        const int tok = idx >> 4, hh = idx & 15;
        const float v = bf2f(proj[(size_t)tok * INWP + COL_DT + hh]) + p.in[8][hh];
        const float d = fmaxf(v, 0.f) + __logf(1.0f + __expf(-fabsf(v)));
        dt[idx] = d; da[idx] = __expf(-d * __expf(p.in[9][hh]));
    }
}

__device__ __forceinline__ void ssd_scan_job(const Params& p, int job, LAS unsigned char* lds) {
    const int tid = opq(threadIdx.x);
    const int b = job >> 5, hs = (job >> 1) & 15, half = job & 1, grp = hs >> 3, p0 = half * 32;
    const bf16_t* xbc = (const bf16_t*)(p.ws + WS_XBC) + (size_t)b * SEQ * 1536;
    const float* dtp = (const float*)(p.ws + WS_DT) + (size_t)b * SEQ * 16 + hs;
    const float* dap = (const float*)(p.ws + WS_DA) + (size_t)b * SEQ * 16 + hs;
    float* yraw = (float*)(p.ws + WS_YRAW) + (size_t)b * SEQ * 1024 + hs * 64 + p0;
    const float dskip = p.in[10][hs];
    constexpr int BUF_F = 9280;
    LAS float* L = (LAS float*)lds;
    const bool producer = tid >= 256; const int ptid = tid & 255;
    int grow[5], gcol[5], loff[5];
#pragma unroll
    for (int k = 0; k < 5; ++k) { const int q = ptid + k * 256, row = q / 36, pc = q - row * 36; grow[k] = row;
        if (pc < 4) { gcol[k] = hs * 64 + p0 + pc * 8; loff[k] = row * 32 + pc * 8; }
        else if (pc < 20) { gcol[k] = 1024 + grp * 128 + (pc - 4) * 8; loff[k] = 1024 + row * 128 + (pc - 4) * 8; }
        else { gcol[k] = 1280 + grp * 128 + (pc - 20) * 8; loff[k] = 5120 + row * 128 + (pc - 20) * 8; } }
    uint4 rg[5]; float sc = 0.f;
#define SSD_ISSUE(t0) do { _Pragma("unroll") for (int k = 0; k < 5; ++k) if (ptid + k * 256 < 1152) rg[k] = *(const uint4*)(xbc + (size_t)((t0) + grow[k]) * 1536 + gcol[k]); \
        if (ptid < 32) sc = dtp[((t0) + ptid) * 16]; else if (ptid < 64) sc = dap[((t0) + ptid - 32) * 16]; } while (0)
#define SSD_COMMIT(buf) do { LAS float* Lc = L + (buf) * BUF_F; _Pragma("unroll") for (int k = 0; k < 5; ++k) if (ptid + k * 256 < 1152) { float f[8]; unpack8(rg[k], f); \
            *(LAS f32x4*)(Lc + loff[k]) = (f32x4){f[0], f[1], f[2], f[3]}; *(LAS f32x4*)(Lc + loff[k] + 4) = (f32x4){f[4], f[5], f[6], f[7]}; } \
        if (ptid < 32) Lc[9216 + ptid] = sc; else if (ptid < 64) Lc[9248 + ptid - 32] = sc; } while (0)
#define SSD_FLUSH(chp) do { LAS float* yo = L + 2 * BUF_F + ((chp) & 1) * 1024; const f32x4 v = *(LAS f32x4*)(yo + (ptid >> 3) * 32 + (ptid & 7) * 4); \
        *(f32x4*)(yraw + (size_t)((chp) * 32 + (ptid >> 3)) * 1024 + (ptid & 7) * 4) = v; } while (0)
    f32x2 hA[4], hB[4];
#pragma unroll
    for (int i = 0; i < 4; ++i) { hA[i] = (f32x2){0.f, 0.f}; hB[i] = (f32x2){0.f, 0.f}; }
    const int prow = (tid >> 4) & 15, nseg = tid & 15;
    __syncthreads();
    if (producer) { SSD_ISSUE(0); SSD_COMMIT(0); SSD_ISSUE(32); }
    __syncthreads();
    for (int ch = 0; ch < 64; ++ch) {
        const int cur = ch & 1;
        if (producer) {
            if (ch >= 1) SSD_FLUSH(ch - 1);
            if (ch + 1 < 64) SSD_COMMIT(cur ^ 1);
            if (ch + 2 < 64) SSD_ISSUE((ch + 2) * 32);
        } else {
        LAS float* Lb = L + cur * BUF_F; LAS float* yb = L + 2 * BUF_F + cur * 1024;
        for (int tg = 0; tg < 32; tg += 16) {
            float yA[16], yB[16];
            LAS float* qb = Lb + 1024 + tg * 128 + nseg * 8;
            f32x4 b0 = *(LAS f32x4*)(qb), b1 = *(LAS f32x4*)(qb + 4), c0 = *(LAS f32x4*)(qb + 4096), c1 = *(LAS f32x4*)(qb + 4100);
            float dA = Lb[9248 + tg], xa = Lb[tg * 32 + prow], xb = Lb[tg * 32 + prow + 16], dtv = Lb[9216 + tg];
#pragma unroll
            for (int tt = 0; tt < 16; ++tt) {
                f32x4 nb0, nb1, nc0, nc1; float ndA, nxa, nxb, ndtv;
                if (tt + 1 < 16) { LAS float* q = qb + (tt + 1) * 128; nb0 = *(LAS f32x4*)(q); nb1 = *(LAS f32x4*)(q + 4); nc0 = *(LAS f32x4*)(q + 4096); nc1 = *(LAS f32x4*)(q + 4100);
                    ndA = Lb[9248 + tg + tt + 1]; nxa = Lb[(tg + tt + 1) * 32 + prow]; nxb = Lb[(tg + tt + 1) * 32 + prow + 16]; ndtv = Lb[9216 + tg + tt + 1]; }
                __builtin_amdgcn_sched_barrier(0);
                const float xdta = xa * dtv, xdtb = xb * dtv;
                const f32x2 dA2 = (f32x2){dA, dA}, xa2 = (f32x2){xdta, xdta}, xb2 = (f32x2){xdtb, xdtb};
                hA[0] = hA[0] * dA2 + xa2 * b0.xy; hB[0] = hB[0] * dA2 + xb2 * b0.xy; hA[1] = hA[1] * dA2 + xa2 * b0.zw; hB[1] = hB[1] * dA2 + xb2 * b0.zw;
                hA[2] = hA[2] * dA2 + xa2 * b1.xy; hB[2] = hB[2] * dA2 + xb2 * b1.xy; hA[3] = hA[3] * dA2 + xa2 * b1.zw; hB[3] = hB[3] * dA2 + xb2 * b1.zw;
                f32x2 ya = hA[0] * c0.xy, yb2 = hB[0] * c0.xy; ya = hA[1] * c0.zw + ya; yb2 = hB[1] * c0.zw + yb2; ya = hA[2] * c1.xy + ya; yb2 = hB[2] * c1.xy + yb2; ya = hA[3] * c1.zw + ya; yb2 = hB[3] * c1.zw + yb2;
                float ra = ya.x + ya.y, rb = yb2.x + yb2.y;
                ra = dpp_add<0xB1>(ra); rb = dpp_add<0xB1>(rb); ra = dpp_add<0x4E>(ra); rb = dpp_add<0x4E>(rb); ra = dpp_add<0x141>(ra); rb = dpp_add<0x141>(rb); ra = dpp_add<0x140>(ra); rb = dpp_add<0x140>(rb);
                yA[tt] = ra + dskip * xa; yB[tt] = rb + dskip * xb;
                __builtin_amdgcn_sched_barrier(0);
                if (tt + 1 < 16) { b0 = nb0; b1 = nb1; c0 = nc0; c1 = nc1; dA = ndA; xa = nxa; xb = nxb; dtv = ndtv; }
            }
            if (nseg == 0) {
#pragma unroll
                for (int tt = 0; tt < 16; ++tt) { yb[(tg + tt) * 32 + prow] = yA[tt]; yb[(tg + tt) * 32 + prow + 16] = yB[tt]; } }
        }
        }
        __syncthreads();
    }
    if (producer) SSD_FLUSH(63);
#undef SSD_ISSUE
#undef SSD_COMMIT
#undef SSD_FLUSH
}

__device__ __forceinline__ void ssd_chunk_job(const Params& p, int job, LAS unsigned char* lds) {
    const int tid = opq(threadIdx.x), lane = tid & 63, w = tid >> 6, fr = lane & 15, fq = lane >> 4;
    const int b = job >> 5, hs = (job >> 1) & 15, half = job & 1, grp = hs >> 3, p0 = half * 32;
    const bf16_t* xbc = (const bf16_t*)(p.ws + WS_XBC) + (size_t)b * SEQ * 1536;
    const float* dtp = (const float*)(p.ws + WS_DT) + (size_t)b * SEQ * 16 + hs;
    float* yraw = (float*)(p.ws + WS_YRAW) + (size_t)b * SEQ * 1024 + hs * 64 + p0;
    const float dskip = p.in[10][hs], Ah = -__expf(p.in[9][hs]);
    constexpr int RS = 136;
    LAS bf16_t* Cs = (LAS bf16_t*)lds;
    LAS bf16_t* Bs = (LAS bf16_t*)(lds + 34816);
    LAS bf16_t* BTs = (LAS bf16_t*)(lds + 69632);
    LAS bf16_t* XTa = (LAS bf16_t*)(lds + 104448);
    LAS bf16_t* XTb = (LAS bf16_t*)(lds + 113152);
    LAS bf16_t* Ps = (LAS bf16_t*)(lds + 121856);
    LAS float* af = (LAS float*)(lds + 130560);
    LAS float* dtf = (LAS float*)(lds + 131584);
    const int crow0 = tid >> 4, cpc = tid & 15;
    const int xk = tid >> 2, xpc = tid & 3;
    u32x4 rc[4], rb[4], rx; float rdt = 0.f;
#define SC_ISSUE(t0) do { _Pragma("unroll") for (int i = 0; i < 4; ++i) { const bf16_t* rp_ = xbc + (size_t)((t0) + (crow0 + 32 * i)) * 1536 + grp * 128 + cpc * 8; rb[i] = *(const u32x4*)(rp_ + 1024); rc[i] = *(const u32x4*)(rp_ + 1280); } \
        rx = *(const u32x4*)(xbc + (size_t)((t0) + xk) * 1536 + hs * 64 + p0 + xpc * 8); if (tid < 128) rdt = dtp[((t0) + tid) * 16]; } while (0)
    f32x4 st[2];
    st[0] = (f32x4){0.f, 0.f, 0.f, 0.f}; st[1] = st[0];
    __syncthreads();
    for (int i = tid; i < 32 * RS / 2; i += 512) ((LAS unsigned*)Ps)[i] = 0u;
    SC_ISSUE(0);
    for (int ch = 0; ch < 16; ++ch) {
        const int t0 = ch * 128;
        __syncthreads();
#pragma unroll
        for (int i = 0; i < 4; ++i) { *(LAS u32x4*)(Cs + (crow0 + 32 * i) * RS + cpc * 8) = rc[i]; *(LAS u32x4*)(Bs + (crow0 + 32 * i) * RS + cpc * 8) = rb[i];

#pragma unroll
            for (int e = 0; e < 4; ++e) { BTs[(cpc * 8 + 2 * e) * RS + (crow0 + 32 * i)] = (bf16_t)(rb[i][e] & 0xffffu); BTs[(cpc * 8 + 2 * e + 1) * RS + (crow0 + 32 * i)] = (bf16_t)(rb[i][e] >> 16); } }
        float csv = 0.f;
        if (tid < 128) {
            csv = rdt * Ah; dtf[tid] = rdt;
#pragma unroll
            for (int off = 1; off < 64; off <<= 1) { const float t_ = __shfl_up(csv, off); if (lane >= off) csv += t_; }
            if (tid == 63) af[128] = csv;
        }
        float xr[8]; xr[0] = bflo(rx[0]); xr[1] = bfhi(rx[0]); xr[2] = bflo(rx[1]); xr[3] = bfhi(rx[1]); xr[4] = bflo(rx[2]); xr[5] = bfhi(rx[2]); xr[6] = bflo(rx[3]); xr[7] = bfhi(rx[3]);
        __syncthreads();
        if (tid < 128) af[tid] = (tid >= 64) ? csv + af[128] : csv;
        __syncthreads();
        const float cs_last = af[127];
        { const float d = dtf[xk], dout = __expf(cs_last - af[xk]);
#pragma unroll
          for (int e = 0; e < 8; ++e) { const float xa = xr[e] * d; XTa[(xpc * 8 + e) * RS + xk] = f2bf(xa); XTb[(xpc * 8 + e) * RS + xk] = f2bf(xa * dout); } }
        __syncthreads();
        bf16x8 cf[4];
#pragma unroll
        for (int ks = 0; ks < 4; ++ks) cf[ks] = *(LAS bf16x8*)(Cs + (w * 16 + fr) * RS + ks * 32 + fq * 8);
        f32x4 yo[2];
#pragma unroll
        for (int pt = 0; pt < 2; ++pt) { f32x4 acc = (f32x4){0.f, 0.f, 0.f, 0.f};
#pragma unroll
            for (int ks = 0; ks < 4; ++ks) { const bf16x8 pb = *(LAS bf16x8*)(Ps + (pt * 16 + fr) * RS + ks * 32 + fq * 8); acc = __builtin_amdgcn_mfma_f32_16x16x32_bf16(cf[ks], pb, acc, 0, 0, 0); }
            yo[pt] = acc; }
        float csq[4];
#pragma unroll
        for (int i = 0; i < 4; ++i) csq[i] = af[w * 16 + fq * 4 + i];
#pragma unroll
        for (int kt = 0; kt < 8; ++kt) { f32x4 acc = (f32x4){0.f, 0.f, 0.f, 0.f};
            if (kt > w) {
#pragma unroll
                for (int i = 0; i < 4; ++i) Cs[(w * 16 + fq * 4 + i) * RS + kt * 16 + fr] = (bf16_t)0;
                continue; }
#pragma unroll
            for (int ks = 0; ks < 4; ++ks) { const bf16x8 bb = *(LAS bf16x8*)(Bs + (kt * 16 + fr) * RS + ks * 32 + fq * 8); acc = __builtin_amdgcn_mfma_f32_16x16x32_bf16(cf[ks], bb, acc, 0, 0, 0); }
            const int kk = kt * 16 + fr; const float csk = af[kk];
#pragma unroll
            for (int i = 0; i < 4; ++i) { const int qq = w * 16 + fq * 4 + i; const float m = (kk <= qq) ? acc[i] * __expf(csq[i] - csk) : 0.f; Cs[qq * RS + kk] = f2bf(m); } }
        f32x4 yd[2];
        { bf16x8 mf[4];
#pragma unroll
          for (int ks = 0; ks < 4; ++ks) mf[ks] = *(LAS bf16x8*)(Cs + (w * 16 + fr) * RS + ks * 32 + fq * 8);
#pragma unroll
          for (int pt = 0; pt < 2; ++pt) { f32x4 acc = (f32x4){0.f, 0.f, 0.f, 0.f};
#pragma unroll
              for (int ks = 0; ks < 4; ++ks) { const bf16x8 xb = *(LAS bf16x8*)(XTa + (pt * 16 + fr) * RS + ks * 32 + fq * 8); acc = __builtin_amdgcn_mfma_f32_16x16x32_bf16(mf[ks], xb, acc, 0, 0, 0); }
              yd[pt] = acc; } }
#pragma unroll
        for (int pt = 0; pt < 2; ++pt)
#pragma unroll
            for (int i = 0; i < 4; ++i) { const int qq = w * 16 + fq * 4 + i, pp = pt * 16 + fr;
                const float xv = bf2f(xbc[(size_t)(t0 + qq) * 1536 + hs * 64 + p0 + pp]);
                yraw[(size_t)(t0 + qq) * 1024 + pp] = yd[pt][i] + __expf(csq[i]) * yo[pt][i] + dskip * xv; }
        if (ch + 1 < 16) SC_ISSUE(t0 + 128);
        __syncthreads();
        { const float cd = __expf(cs_last);
#pragma unroll
          for (int pt = 0; pt < 2; ++pt) { f32x4 acc = st[pt] * cd;
#pragma unroll
              for (int ks = 0; ks < 4; ++ks) { const bf16x8 xa = *(LAS bf16x8*)(XTb + (pt * 16 + fr) * RS + ks * 32 + fq * 8); const bf16x8 bt = *(LAS bf16x8*)(BTs + (w * 16 + fr) * RS + ks * 32 + fq * 8);
                  acc = __builtin_amdgcn_mfma_f32_16x16x32_bf16(xa, bt, acc, 0, 0, 0); }
              st[pt] = acc;
#pragma unroll
              for (int i = 0; i < 4; ++i) Ps[(pt * 16 + fq * 4 + i) * RS + w * 16 + fr] = f2bf(acc[i]); } }
    }
#undef SC_ISSUE
}

__device__ __forceinline__ void attn_job(const Params& p, int job, LAS unsigned char* lds) {
    const int tid = opq(threadIdx.x), lane = tid & 63, w = tid >> 6, fr = lane & 15, fq = lane >> 4;
    const int b = job >> 6, kvh = (job >> 4) & 3, nb = job & 15;
    const bf16_t* proj = (const bf16_t*)(p.ws + WS_PROJ) + (size_t)b * SEQ * INWP;
    const float2* rope = (const float2*)(p.ws + WS_ROPE);
    LAS bf16_t* Ks = (LAS bf16_t*)lds;
    LAS bf16_t* Vt = (LAS bf16_t*)(lds + 36864);
    LAS bf16_t* Ps = (LAS bf16_t*)(lds + 70656) + w * 16 * 264;
    __syncthreads();
    if (tid < 256) {
        const int kr = tid, tk = (nb - 1) * 128 + kr;
        if (tk >= 0) {
            const bf16_t* src = proj + (size_t)tk * INWP + COL_K + kvh * 64; float x[64]; float ss = 0.f;
#pragma unroll
            for (int c = 0; c < 8; ++c) { const uint4 r = *(const uint4*)(src + c * 8); float f[8]; unpack8(r, f);
#pragma unroll
                for (int e = 0; e < 8; ++e) { x[c * 8 + e] = f[e]; ss += f[e] * f[e]; } }
            const float rinv = rsqrtf(ss * (1.0f / 64) + 1e-6f); const float* kn = p.in[13];
#pragma unroll
            for (int i = 0; i < 64; ++i) x[i] = x[i] * rinv * kn[i];
#pragma unroll
            for (int c = 0; c < 4; ++c) { float o1[8], o2[8];
#pragma unroll
                for (int e = 0; e < 8; ++e) { const int i = c * 8 + e; const float2 cs = rope[tk * 32 + i]; o1[e] = x[i] * cs.x - x[i + 32] * cs.y; o2[e] = x[i + 32] * cs.x + x[i] * cs.y; }
                u32x4 w1, w2; w1.x = cvt_pk_bf16(o1[0], o1[1]); w1.y = cvt_pk_bf16(o1[2], o1[3]); w1.z = cvt_pk_bf16(o1[4], o1[5]); w1.w = cvt_pk_bf16(o1[6], o1[7]);
                w2.x = cvt_pk_bf16(o2[0], o2[1]); w2.y = cvt_pk_bf16(o2[2], o2[3]); w2.z = cvt_pk_bf16(o2[4], o2[5]); w2.w = cvt_pk_bf16(o2[6], o2[7]);
                *(LAS u32x4*)(Ks + kr * 72 + c * 8) = w1; *(LAS u32x4*)(Ks + kr * 72 + 32 + c * 8) = w2;
                __builtin_amdgcn_sched_barrier(0); }
        } else {
#pragma unroll
            for (int c = 0; c < 8; ++c) *(LAS u32x4*)(Ks + kr * 72 + c * 8) = (u32x4){0u, 0u, 0u, 0u};
        }
    } else {
        const int kr = tid - 256, tk = (nb - 1) * 128 + kr;
        const bf16_t* src = proj + (size_t)(tk < 0 ? 0 : tk) * INWP + COL_V + kvh * 64;
#pragma unroll
        for (int c = 0; c < 8; ++c) { uint4 r = *(const uint4*)(src + c * 8); if (tk < 0) r = make_uint4(0u, 0u, 0u, 0u);
            Vt[(c * 8 + 0) * 264 + kr] = (bf16_t)(r.x & 0xffffu); Vt[(c * 8 + 1) * 264 + kr] = (bf16_t)(r.x >> 16);
            Vt[(c * 8 + 2) * 264 + kr] = (bf16_t)(r.y & 0xffffu); Vt[(c * 8 + 3) * 264 + kr] = (bf16_t)(r.y >> 16);
            Vt[(c * 8 + 4) * 264 + kr] = (bf16_t)(r.z & 0xffffu); Vt[(c * 8 + 5) * 264 + kr] = (bf16_t)(r.z >> 16);
            Vt[(c * 8 + 6) * 264 + kr] = (bf16_t)(r.w & 0xffffu); Vt[(c * 8 + 7) * 264 + kr] = (bf16_t)(r.w >> 16); }
    }
    __syncthreads();
    for (int h4 = 0; h4 < 4; ++h4) {
    const int hq = kvh * 4 + h4;
    bf16x8 qa[2];
    { const int tq = nb * 128 + w * 16 + fr; const bf16_t* src = proj + (size_t)tq * INWP + hq * 64;
      const uint4 r0 = *(const uint4*)(src + fq * 8), r1 = *(const uint4*)(src + 32 + fq * 8); float x1[8], x2[8]; unpack8(r0, x1); unpack8(r1, x2);
      float ss = 0.f;
#pragma unroll
      for (int e = 0; e < 8; ++e) ss += x1[e] * x1[e] + x2[e] * x2[e];
      ss += __shfl_xor(ss, 16); ss += __shfl_xor(ss, 32);
      const float rinv = rsqrtf(ss * (1.0f / 64) + 1e-6f) * 0.125f; const float* qn = p.in[12]; float o1[8], o2[8];
#pragma unroll
      for (int e = 0; e < 8; ++e) { const int i = fq * 8 + e; const float a = x1[e] * rinv * qn[i], c = x2[e] * rinv * qn[i + 32]; const float2 cs = rope[tq * 32 + i];
          o1[e] = a * cs.x - c * cs.y; o2[e] = c * cs.x + a * cs.y; }
      u32x4 w1, w2; w1.x = cvt_pk_bf16(o1[0], o1[1]); w1.y = cvt_pk_bf16(o1[2], o1[3]); w1.z = cvt_pk_bf16(o1[4], o1[5]); w1.w = cvt_pk_bf16(o1[6], o1[7]);
      w2.x = cvt_pk_bf16(o2[0], o2[1]); w2.y = cvt_pk_bf16(o2[2], o2[3]); w2.z = cvt_pk_bf16(o2[4], o2[5]); w2.w = cvt_pk_bf16(o2[6], o2[7]);
      qa[0] = __builtin_bit_cast(bf16x8, w1); qa[1] = __builtin_bit_cast(bf16x8, w2); }
    f32x4 s[16];
#pragma unroll
    for (int j = 0; j < 16; ++j) { f32x4 acc = (f32x4){0.f, 0.f, 0.f, 0.f};
#pragma unroll
        for (int ks = 0; ks < 2; ++ks) { const bf16x8 kb = *(LAS bf16x8*)(Ks + (j * 16 + fr) * 72 + ks * 32 + fq * 8); acc = __builtin_amdgcn_mfma_f32_16x16x32_bf16(qa[ks], kb, acc, 0, 0, 0); }
        s[j] = acc; }
    const float sink = p.in[14][hq];
    float mx[4], inv[4];
#pragma unroll
    for (int i = 0; i < 4; ++i) { const int qi = w * 16 + fq * 4 + i + 128; float m = -3.0e38f;
#pragma unroll
        for (int j = 0; j < 16; ++j) { const int kj = j * 16 + fr; const bool ok = (kj <= qi) && (qi - kj < 128) && (nb > 0 || kj >= 128); s[j][i] = ok ? s[j][i] : -3.0e38f; m = fmaxf(m, s[j][i]); }
        m = max16(m);
        m = fmaxf(m, sink); mx[i] = m; float l = 0.f;
#pragma unroll
        for (int j = 0; j < 16; ++j) { const float e = (s[j][i] > -1.0e38f) ? __expf(s[j][i] - m) : 0.f; s[j][i] = e; l += e; }
        l = red16(l);
        inv[i] = 1.0f / (l + __expf(sink - m)); }
#pragma unroll
    for (int j = 0; j < 16; ++j)
#pragma unroll
        for (int i = 0; i < 4; ++i) Ps[(fq * 4 + i) * 264 + j * 16 + fr] = f2bf(s[j][i] * inv[i]);
    f32x4 o[4];
#pragma unroll
    for (int nd = 0; nd < 4; ++nd) o[nd] = (f32x4){0.f, 0.f, 0.f, 0.f};
#pragma unroll
    for (int kk = 0; kk < 8; ++kk) { const bf16x8 pa = *(LAS bf16x8*)(Ps + fr * 264 + kk * 32 + fq * 8);
#pragma unroll
        for (int nd = 0; nd < 4; ++nd) { const bf16x8 vb = *(LAS bf16x8*)(Vt + (nd * 16 + fr) * 264 + kk * 32 + fq * 8); o[nd] = __builtin_amdgcn_mfma_f32_16x16x32_bf16(pa, vb, o[nd], 0, 0, 0); } }
    bf16_t* ymix = (bf16_t*)(p.ws + WS_YMIX) + (size_t)b * SEQ * D + hq * 64;
#pragma unroll
    for (int nd = 0; nd < 4; ++nd)
#pragma unroll
        for (int i = 0; i < 4; ++i) ymix[(size_t)(nb * 128 + w * 16 + fq * 4 + i) * D + nd * 16 + fr] = f2bf(o[nd][i]);
    }
}

__device__ __forceinline__ void post_ssd(const Params& p) {
    const int tid_ = opq(threadIdx.x); const int lane = tid_ & 63, wv = tid_ >> 6;
    const float* yraw = (const float*)(p.ws + WS_YRAW); const bf16_t* proj = (const bf16_t*)(p.ws + WS_PROJ); bf16_t* ymix = (bf16_t*)(p.ws + WS_YMIX);
    for (int it = blockIdx.x * 8 + wv; it < MTOK * 2; it += gridDim.x * 8) {
        const int tok = it >> 1, grp = it & 1, c = grp * 512 + lane * 8;
        const f32x4 y0 = *(const f32x4*)(yraw + (size_t)tok * 1024 + c), y1 = *(const f32x4*)(yraw + (size_t)tok * 1024 + c + 4);
        const uint4 zr = *(const uint4*)(proj + (size_t)tok * INWP + COL_Z + c); float z[8], y[8]; unpack8(zr, z); float ss = 0.f;
#pragma unroll
        for (int e = 0; e < 8; ++e) { const float yy = (e < 4 ? y0[e] : y1[e - 4]); y[e] = yy * z[e] * sigmoidf_(z[e]); ss += y[e] * y[e]; }
        ss = wave_sum(ss); const float r = rsqrtf(ss * (1.0f / 512) + 1e-6f);
        const f32x4 n0 = *(const f32x4*)(p.in[11] + c), n1 = *(const f32x4*)(p.in[11] + c + 4);
        u32x4 w; w.x = cvt_pk_nv(y[0] * r * n0[0], y[1] * r * n0[1]); w.y = cvt_pk_nv(y[2] * r * n0[2], y[3] * r * n0[3]);
        w.z = cvt_pk_nv(y[4] * r * n1[0], y[5] * r * n1[1]); w.w = cvt_pk_nv(y[6] * r * n1[2], y[7] * r * n1[3]);
        *(u32x4*)(ymix + (size_t)tok * D + 1024 + c) = w;
    }
}

__device__ __forceinline__ float half_sum(float v, bool lo) {
    (void)lo; v = red16(v); return v + __shfl_xor(v, 16); }
__device__ __forceinline__ void rwkv_scan_job(const Params& p, int job, LAS unsigned char* lds) {
    const int tid = opq(threadIdx.x), lane = tid & 63, l32 = lane & 31; const bool lo = lane < 32;
    const int b = job >> 5, hh = job & 31;
    LAS float* L = (LAS float*)lds;
    const bool producer = tid >= 256;
    const int pw = (tid >> 6) & 3;
    const int tl0 = 2 * pw + (lane >> 5);
    const size_t wbase = ((size_t)b * SEQ * D + hh * 64) / 2 + l32 + (size_t)tl0 * (D / 2);
    const unsigned* R32 = (const unsigned*)(p.ws + WS_R) + wbase; const unsigned* K32 = (const unsigned*)(p.ws + WS_K) + wbase; const unsigned* V32 = (const unsigned*)(p.ws + WS_V) + wbase;
    const unsigned* E32 = (const unsigned*)(p.ws + WS_WDEC) + wbase; const unsigned* A32 = (const unsigned*)(p.ws + WS_AA) + wbase; const unsigned* G32 = (const unsigned*)(p.ws + WS_GG) + wbase;
    unsigned* Y32 = (unsigned*)(p.ws + WS_YG) + wbase;
    const int ci = hh * 64 + 2 * l32;
    const float2 kkw = *(const float2*)(p.in[25] + ci), kaw = *(const float2*)(p.in[26] + ci), rkw = *(const float2*)(p.in[27] + ci), lnw = *(const float2*)(p.in[32] + ci), lnb = *(const float2*)(p.in[33] + ci);
    unsigned rw[2], kw[2], vw[2], ew[2], aw[2], gw[2];
    const int oo = tl0 * 64 + 2 * l32;
#define RW_ISSUE(t0) do { _Pragma("unroll") for (int i2 = 0; i2 < 2; ++i2) { const size_t off = (size_t)((t0) + 8 * i2) * (D / 2); rw[i2] = R32[off]; kw[i2] = K32[off]; vw[i2] = V32[off]; ew[i2] = E32[off]; aw[i2] = A32[off]; gw[i2] = G32[off]; } } while (0)
#define RW_COMMIT(buf) do { _Pragma("unroll") for (int i2 = 0; i2 < 2; ++i2) { LAS float* Lc = L + (buf) * 8192 + oo + i2 * 512; \
        const float r0_ = bflo(rw[i2]), r1_ = bfhi(rw[i2]), k0_ = bflo(kw[i2]), k1_ = bfhi(kw[i2]), v0_ = bflo(vw[i2]), v1_ = bfhi(vw[i2]), e0_ = bflo(ew[i2]), e1_ = bfhi(ew[i2]), a0_ = bflo(aw[i2]), a1_ = bfhi(aw[i2]), g0_ = bflo(gw[i2]), g1_ = bfhi(gw[i2]); \
        const float kkv0 = k0_ * kkw.x, kkv1 = k1_ * kkw.y; const float ssq = half_sum(kkv0 * kkv0 + kkv1 * kkv1, lo); const float rn = rsqrtf(fmaxf(ssq, 1e-24f)); const float kn0 = kkv0 * rn, kn1 = kkv1 * rn; \
        const float km0 = k0_ * (1.0f + (a0_ - 1.0f) * kaw.x), km1 = k1_ * (1.0f + (a1_ - 1.0f) * kaw.y); const float bonus = half_sum(r0_ * km0 * rkw.x + r1_ * km1 * rkw.y, lo); \
        *(LAS f32x2*)(Lc) = (f32x2){-kn0, -kn1}; *(LAS f32x2*)(Lc + 1024) = (f32x2){__expf(-e0_), __expf(-e1_)}; *(LAS f32x2*)(Lc + 2048) = (f32x2){kn0 * a0_, kn1 * a1_}; *(LAS f32x2*)(Lc + 3072) = (f32x2){km0, km1}; \
        *(LAS f32x2*)(Lc + 4096) = (f32x2){r0_, r1_}; *(LAS f32x2*)(Lc + 5120) = (f32x2){v0_, v1_}; *(LAS f32x2*)(Lc + 6144) = (f32x2){g0_, g1_}; *(LAS f32x2*)(Lc + 7168) = (f32x2){bonus * v0_, bonus * v1_}; } } while (0)
#define RW_OUTPUT(chp) do { LAS float* Lo = L + ((chp) & 1) * 8192; LAS float* yo = L + 16384 + ((chp) & 1) * 1024; _Pragma("unroll") for (int i2 = 0; i2 < 2; ++i2) { const int o2 = oo + i2 * 512; \
        const f32x2 y = *(LAS f32x2*)(yo + o2); \
        const float mu = half_sum(y.x + y.y, lo) * (1.0f / 64), d0 = y.x - mu, d1 = y.y - mu, var = half_sum(d0 * d0 + d1 * d1, lo) * (1.0f / 64), rs = rsqrtf(var + 64e-5f); \
        const f32x2 bv = *(LAS f32x2*)(Lo + 7168 + o2), gg = *(LAS f32x2*)(Lo + 6144 + o2); \
        Y32[(size_t)((chp) * 16 + 8 * i2) * (D / 2)] = cvt_pk_nv((d0 * rs * lnw.x + lnb.x + bv.x) * gg.x, (d1 * rs * lnw.y + lnb.y + bv.y) * gg.y); } } while (0)
    f32x2 SA[4], SB[4];
#pragma unroll
    for (int i = 0; i < 4; ++i) { SA[i] = (f32x2){0.f, 0.f}; SB[i] = (f32x2){0.f, 0.f}; }
    const int rp = (tid >> 3) & 31, ks = tid & 7;
    __syncthreads();
    if (producer) { RW_ISSUE(0); RW_COMMIT(0); RW_ISSUE(16); }
    __syncthreads();
    for (int ch = 0; ch < 128; ++ch) {
        const int cur = ch & 1;
        if (producer) {
            if (ch >= 1) RW_OUTPUT(ch - 1);
            if (ch + 1 < 128) RW_COMMIT(cur ^ 1);
            if (ch + 2 < 128) RW_ISSUE((ch + 2) * 16);
        } else {
            LAS float* Lb = L + cur * 8192; LAS float* yb = L + 16384 + cur * 1024;
            float yA[16], yB[16];
            LAS float* q0 = Lb + ks * 8;
            f32x4 a0 = *(LAS f32x4*)(q0), a1 = *(LAS f32x4*)(q0 + 4), w0 = *(LAS f32x4*)(q0 + 1024), w1 = *(LAS f32x4*)(q0 + 1028), b0 = *(LAS f32x4*)(q0 + 2048), b1 = *(LAS f32x4*)(q0 + 2052);
            f32x4 k0 = *(LAS f32x4*)(q0 + 3072), k1 = *(LAS f32x4*)(q0 + 3076), r0 = *(LAS f32x4*)(q0 + 4096), r1 = *(LAS f32x4*)(q0 + 4100);
            float va = Lb[5120 + rp], vb = Lb[5120 + rp + 32];
#pragma unroll
            for (int t = 0; t < 16; ++t) {
                f32x4 na0, na1, nw0, nw1, nb0, nb1, nk0, nk1, nr0, nr1; float nva, nvb;
                if (t + 1 < 16) { LAS float* q = q0 + (t + 1) * 64;
                    na0 = *(LAS f32x4*)(q); na1 = *(LAS f32x4*)(q + 4); nw0 = *(LAS f32x4*)(q + 1024); nw1 = *(LAS f32x4*)(q + 1028); nb0 = *(LAS f32x4*)(q + 2048); nb1 = *(LAS f32x4*)(q + 2052);
                    nk0 = *(LAS f32x4*)(q + 3072); nk1 = *(LAS f32x4*)(q + 3076); nr0 = *(LAS f32x4*)(q + 4096); nr1 = *(LAS f32x4*)(q + 4100); nva = Lb[5120 + (t + 1) * 64 + rp]; nvb = Lb[5120 + (t + 1) * 64 + rp + 32]; }
                __builtin_amdgcn_sched_barrier(0);
                f32x2 ca = SA[0] * a0.xy, cb = SB[0] * a0.xy; ca = SA[1] * a0.zw + ca; cb = SB[1] * a0.zw + cb; ca = SA[2] * a1.xy + ca; cb = SB[2] * a1.xy + cb; ca = SA[3] * a1.zw + ca; cb = SB[3] * a1.zw + cb;
                float sa = ca.x + ca.y, sb = cb.x + cb.y;
                sa = dpp_add<0xB1>(sa); sb = dpp_add<0xB1>(sb); sa = dpp_add<0x4E>(sa); sb = dpp_add<0x4E>(sb); sa = dpp_add<0x141>(sa); sb = dpp_add<0x141>(sb);
                const f32x2 sa2 = (f32x2){sa, sa}, sb2 = (f32x2){sb, sb}, va2 = (f32x2){va, va}, vb2 = (f32x2){vb, vb};
                SA[0] = SA[0] * w0.xy + (sa2 * b0.xy + va2 * k0.xy); SB[0] = SB[0] * w0.xy + (sb2 * b0.xy + vb2 * k0.xy);
                SA[1] = SA[1] * w0.zw + (sa2 * b0.zw + va2 * k0.zw); SB[1] = SB[1] * w0.zw + (sb2 * b0.zw + vb2 * k0.zw);
                SA[2] = SA[2] * w1.xy + (sa2 * b1.xy + va2 * k1.xy); SB[2] = SB[2] * w1.xy + (sb2 * b1.xy + vb2 * k1.xy);
                SA[3] = SA[3] * w1.zw + (sa2 * b1.zw + va2 * k1.zw); SB[3] = SB[3] * w1.zw + (sb2 * b1.zw + vb2 * k1.zw);
                f32x2 ya = SA[0] * r0.xy, yb2 = SB[0] * r0.xy; ya = SA[1] * r0.zw + ya; yb2 = SB[1] * r0.zw + yb2; ya = SA[2] * r1.xy + ya; yb2 = SB[2] * r1.xy + yb2; ya = SA[3] * r1.zw + ya; yb2 = SB[3] * r1.zw + yb2;
                float ra = ya.x + ya.y, rb = yb2.x + yb2.y;
                ra = dpp_add<0xB1>(ra); rb = dpp_add<0xB1>(rb); ra = dpp_add<0x4E>(ra); rb = dpp_add<0x4E>(rb); ra = dpp_add<0x141>(ra); rb = dpp_add<0x141>(rb);
                yA[t] = ra; yB[t] = rb;
                __builtin_amdgcn_sched_barrier(0);
                if (t + 1 < 16) { a0 = na0; a1 = na1; w0 = nw0; w1 = nw1; b0 = nb0; b1 = nb1; k0 = nk0; k1 = nk1; r0 = nr0; r1 = nr1; va = nva; vb = nvb; }
            }
            if (ks == 0) {
#pragma unroll
                for (int t = 0; t < 16; ++t) { yb[t * 64 + rp] = yA[t]; yb[t * 64 + rp + 32] = yB[t]; } }
        }
        __syncthreads();
    }
    if (producer) RW_OUTPUT(127);
#undef RW_ISSUE
#undef RW_COMMIT
#undef RW_OUTPUT
}

__device__ __forceinline__ void rwkv_chunk_job(const Params& p, int job, LAS unsigned char* lds) {
    const int tid = opq(threadIdx.x), lane = tid & 63, w = tid >> 6, fr = lane & 15, fq = lane >> 4, l32 = lane & 31; const bool lo = lane < 32;
    const int b = job >> 5, hh = job & 31;
    const int tl = 2 * w + (lane >> 5);
    const size_t wbase = ((size_t)b * SEQ * D + hh * 64) / 2 + l32 + (size_t)tl * (D / 2);
    const unsigned* R32 = (const unsigned*)(p.ws + WS_R) + wbase; const unsigned* K32 = (const unsigned*)(p.ws + WS_K) + wbase; const unsigned* V32 = (const unsigned*)(p.ws + WS_V) + wbase;
    const unsigned* E32 = (const unsigned*)(p.ws + WS_WDEC) + wbase; const unsigned* A32 = (const unsigned*)(p.ws + WS_AA) + wbase; const unsigned* G32 = (const unsigned*)(p.ws + WS_GG) + wbase;
    unsigned* Y32 = (unsigned*)(p.ws + WS_YG) + wbase;
    const int ci = hh * 64 + 2 * l32;
    const float2 kkw = *(const float2*)(p.in[25] + ci), kaw = *(const float2*)(p.in[26] + ci), rkw = *(const float2*)(p.in[27] + ci), lnw = *(const float2*)(p.in[32] + ci), lnb = *(const float2*)(p.in[33] + ci);
    LAS float* Av = (LAS float*)(lds + 0);
    LAS float* Bv = (LAS float*)(lds + 4096);
    LAS float* Km = (LAS float*)(lds + 8192);
    LAS float* Rr = (LAS float*)(lds + 12288);
    LAS float* ybuf = (LAS float*)(lds + 16384);
    LAS float* RHS = (LAS float*)(lds + 20480);
    LAS float* Aab = (LAS float*)(lds + 24832);
    LAS float* Wend = (LAS float*)(lds + 25856);
    LAS bf16_t* ET = (LAS bf16_t*)(lds + 26112);
    LAS bf16_t* VT = (LAS bf16_t*)(lds + 31232);
    LAS bf16_t* BtT = (LAS bf16_t*)(lds + 36352);
    LAS bf16_t* KtT = (LAS bf16_t*)(lds + 41472);
    LAS bf16_t* Ub = (LAS bf16_t*)(lds + 46592);
    LAS bf16_t* AakT = (LAS bf16_t*)(lds + 51712);
    LAS bf16_t* AbrT = (LAS bf16_t*)(lds + 52992);
    LAS bf16_t* AkrT = (LAS bf16_t*)(lds + 54272);
    LAS bf16_t* At = (LAS bf16_t*)(lds + 55552);
    LAS bf16_t* Bt = (LAS bf16_t*)(lds + 57856);
    LAS bf16_t* Kt = (LAS bf16_t*)(lds + 60160);
    LAS bf16_t* Rt = (LAS bf16_t*)(lds + 62464);
    LAS bf16_t* S0b = (LAS bf16_t*)(lds + 64768);
    LAS bf16_t* VT1 = (LAS bf16_t*)(lds + 73984);
    constexpr int LDS_END = 73984 + 64 * 40 * 2;
    __syncthreads();
    for (int i = tid; i < LDS_END / 4; i += 512) ((LAS unsigned*)lds)[i] = 0u;
    f32x4 stt[2]; stt[0] = (f32x4){0.f, 0.f, 0.f, 0.f}; stt[1] = stt[0];
    const int vt = w >> 1, kt0 = (w & 1) * 2;
    bf16x8 Lf;
#pragma unroll
    for (int e = 0; e < 8; ++e) { const int i = fq * 8 + e; Lf[e] = (i <= fr && i < 16) ? (short)0x3F80 : (short)0; }
    unsigned rw, kw, vw, ew, aw, gw;
#define RC_ISSUE(t0) do { const size_t off = (size_t)(t0) * (D / 2); rw = R32[off]; kw = K32[off]; vw = V32[off]; ew = E32[off]; aw = A32[off]; gw = G32[off]; } while (0)
#define RC_PREP(chn) do { \
        const float r0_ = bflo(rw), r1_ = bfhi(rw), k0_ = bflo(kw), k1_ = bfhi(kw), v0_ = bflo(vw), v1_ = bfhi(vw), a0_ = bflo(aw), a1_ = bfhi(aw); gn0 = bflo(gw); gn1 = bfhi(gw); \
        const unsigned ewc = ew, vwc = vw; \
        if ((chn) + 1 < 128) RC_ISSUE(((chn) + 1) * 16); \
        const float kkv0 = k0_ * kkw.x, kkv1 = k1_ * kkw.y; const float ssq = half_sum(kkv0 * kkv0 + kkv1 * kkv1, lo); const float rn = rsqrtf(fmaxf(ssq, 1e-24f)); const float kn0 = kkv0 * rn, kn1 = kkv1 * rn; \
        const float km0 = k0_ * (1.0f + (a0_ - 1.0f) * kaw.x), km1 = k1_ * (1.0f + (a1_ - 1.0f) * kaw.y); const float bonus = half_sum(r0_ * km0 * rkw.x + r1_ * km1 * rkw.y, lo); \
        bn0 = bonus * v0_; bn1 = bonus * v1_; \
        { const int o = tl * 64 + 2 * l32; LAS bf16_t* VTw = ((chn) & 1) ? VT1 : VT; \
          *(LAS f32x2*)(Av + o) = (f32x2){-kn0, -kn1}; *(LAS f32x2*)(Bv + o) = (f32x2){kn0 * a0_, kn1 * a1_}; *(LAS f32x2*)(Km + o) = (f32x2){km0, km1}; *(LAS f32x2*)(Rr + o) = (f32x2){r0_, r1_}; \
          ET[(2 * l32) * 40 + tl] = (bf16_t)(ewc & 0xffffu); ET[(2 * l32 + 1) * 40 + tl] = (bf16_t)(ewc >> 16); \
          VTw[(2 * l32) * 40 + tl] = (bf16_t)(vwc & 0xffffu); VTw[(2 * l32 + 1) * 40 + tl] = (bf16_t)(vwc >> 16); } } while (0)
    float gc0 = 0.f, gc1 = 0.f, bc0 = 0.f, bc1 = 0.f, gn0, gn1, bn0, bn1;
    RC_ISSUE(0);
    __syncthreads();
    RC_PREP(0); gc0 = gn0; gc1 = gn1; bc0 = bn0; bc1 = bn1;
    __syncthreads();
    for (int ch = 0; ch < 128; ++ch) {
        LAS bf16_t* VTc = (ch & 1) ? VT1 : VT;
        if (w < 4) {
            const bf16x8 eb = *(LAS bf16x8*)(ET + (w * 16 + fr) * 40 + fq * 8);
            f32x4 ec = (f32x4){0.f, 0.f, 0.f, 0.f}; ec = __builtin_amdgcn_mfma_f32_16x16x32_bf16(Lf, eb, ec, 0, 0, 0);
            const int kk = w * 16 + fr; unsigned bt_pk[2], kt_pk[2]; float btv[4], ktv[4];
#pragma unroll
            for (int i = 0; i < 4; ++i) { const int t = fq * 4 + i; const float et = bf2f(ET[kk * 40 + t]);
                const float Wt = __expf(-ec[i]), Wp = __expf(et - ec[i]), iW = __expf(ec[i]);
                const int o = t * 64 + kk;
                At[t * 72 + kk] = f2bf(Av[o] * Wp); Rt[t * 72 + kk] = f2bf(Rr[o] * Wt);
                btv[i] = Bv[o] * iW; ktv[i] = Km[o] * iW;
                Bt[t * 72 + kk] = f2bf(btv[i]); Kt[t * 72 + kk] = f2bf(ktv[i]);
                if (t == 15) Wend[kk] = Wt; }
            bt_pk[0] = cvt_pk_bf16(btv[0], btv[1]); bt_pk[1] = cvt_pk_bf16(btv[2], btv[3]); kt_pk[0] = cvt_pk_bf16(ktv[0], ktv[1]); kt_pk[1] = cvt_pk_bf16(ktv[2], ktv[3]);
            *(LAS u32x2*)(BtT + kk * 40 + fq * 4) = (u32x2){bt_pk[0], bt_pk[1]}; *(LAS u32x2*)(KtT + kk * 40 + fq * 4) = (u32x2){kt_pk[0], kt_pk[1]};
        }
        __syncthreads();
        if (w < 4) {
            LAS bf16_t* Xr = (w & 1) ? Kt : Bt; LAS bf16_t* Yr = (w & 2) ? Rt : At;
            f32x4 gacc = (f32x4){0.f, 0.f, 0.f, 0.f};
#pragma unroll
            for (int ks = 0; ks < 2; ++ks) { const bf16x8 xa = *(LAS bf16x8*)(Xr + fr * 72 + ks * 32 + fq * 8); const bf16x8 yb_ = *(LAS bf16x8*)(Yr + fr * 72 + ks * 32 + fq * 8); gacc = __builtin_amdgcn_mfma_f32_16x16x32_bf16(xa, yb_, gacc, 0, 0, 0); }
            float gm[4];
#pragma unroll
            for (int i = 0; i < 4; ++i) { const int j = fq * 4 + i; const bool keep = (w & 2) ? (j <= fr) : (j < fr); gm[i] = keep ? gacc[i] : 0.f; }
            if (w == 0) {
#pragma unroll
                for (int i = 0; i < 4; ++i) Aab[(fq * 4 + i) * 16 + fr] = gm[i]; }
            else { LAS bf16_t* dst = (w == 1) ? AakT : (w == 2) ? AbrT : AkrT; *(LAS u32x2*)(dst + fr * 40 + fq * 4) = (u32x2){cvt_pk_bf16(gm[0], gm[1]), cvt_pk_bf16(gm[2], gm[3])}; }
        }
        __syncthreads();
        f32x4 y0 = (f32x4){0.f, 0.f, 0.f, 0.f};
        { const int vtile = w & 3; LAS bf16_t* Yr = (w < 4) ? At : Rt; LAS bf16_t* Gt = (w < 4) ? AakT : AkrT;
#pragma unroll
          for (int ks = 0; ks < 2; ++ks) { const bf16x8 sa = *(LAS bf16x8*)(S0b + (vtile * 16 + fr) * 72 + ks * 32 + fq * 8); const bf16x8 yb_ = *(LAS bf16x8*)(Yr + fr * 72 + ks * 32 + fq * 8); y0 = __builtin_amdgcn_mfma_f32_16x16x32_bf16(sa, yb_, y0, 0, 0, 0); }
          { const bf16x8 va = *(LAS bf16x8*)(VTc + (vtile * 16 + fr) * 40 + fq * 8); const bf16x8 gb = *(LAS bf16x8*)(Gt + fr * 40 + fq * 8); y0 = __builtin_amdgcn_mfma_f32_16x16x32_bf16(va, gb, y0, 0, 0, 0); }
          if (w < 4) {
#pragma unroll
              for (int i = 0; i < 4; ++i) RHS[(vtile * 16 + fq * 4 + i) * 17 + fr] = y0[i]; } }
        __syncthreads();
        if (w == 0) {
            float u[16];
#pragma unroll
            for (int t = 0; t < 16; ++t) u[t] = RHS[lane * 17 + t];
#pragma unroll
            for (int t = 0; t < 15; ++t) {
#pragma unroll
                for (int t2 = t + 1; t2 < 16; ++t2) u[t2] += u[t] * Aab[t * 16 + t2]; }
            u32x4 o0, o1; o0.x = cvt_pk_bf16(u[0], u[1]); o0.y = cvt_pk_bf16(u[2], u[3]); o0.z = cvt_pk_bf16(u[4], u[5]); o0.w = cvt_pk_bf16(u[6], u[7]);
            o1.x = cvt_pk_bf16(u[8], u[9]); o1.y = cvt_pk_bf16(u[10], u[11]); o1.z = cvt_pk_bf16(u[12], u[13]); o1.w = cvt_pk_bf16(u[14], u[15]);
            *(LAS u32x4*)(Ub + lane * 40) = o0; *(LAS u32x4*)(Ub + lane * 40 + 8) = o1;
        }
        if (ch + 1 < 128) RC_PREP(ch + 1);
        __syncthreads();
        if (w >= 4) { const int vtile = w & 3;
            const bf16x8 ua = *(LAS bf16x8*)(Ub + (vtile * 16 + fr) * 40 + fq * 8); const bf16x8 gb = *(LAS bf16x8*)(AbrT + fr * 40 + fq * 8); y0 = __builtin_amdgcn_mfma_f32_16x16x32_bf16(ua, gb, y0, 0, 0, 0);
#pragma unroll
            for (int i = 0; i < 4; ++i) ybuf[fr * 64 + vtile * 16 + fq * 4 + i] = y0[i]; }
        { const bf16x8 ua = *(LAS bf16x8*)(Ub + (vt * 16 + fr) * 40 + fq * 8); const bf16x8 va = *(LAS bf16x8*)(VTc + (vt * 16 + fr) * 40 + fq * 8);
#pragma unroll
          for (int q = 0; q < 2; ++q) { const int kk = (kt0 + q) * 16 + fr;
              const bf16x8 bb = *(LAS bf16x8*)(BtT + kk * 40 + fq * 8); const bf16x8 kb = *(LAS bf16x8*)(KtT + kk * 40 + fq * 8);
              f32x4 acc = stt[q]; acc = __builtin_amdgcn_mfma_f32_16x16x32_bf16(ua, bb, acc, 0, 0, 0); acc = __builtin_amdgcn_mfma_f32_16x16x32_bf16(va, kb, acc, 0, 0, 0);
              const float we = Wend[kk]; acc = acc * we; stt[q] = acc;
#pragma unroll
              for (int i = 0; i < 4; ++i) S0b[(vt * 16 + fq * 4 + i) * 72 + kk] = f2bf(acc[i]); } }
        __syncthreads();
        { const f32x2 y = *(LAS f32x2*)(ybuf + tl * 64 + 2 * l32);
          const float mu = half_sum(y.x + y.y, lo) * (1.0f / 64), d0 = y.x - mu, d1 = y.y - mu, var = half_sum(d0 * d0 + d1 * d1, lo) * (1.0f / 64), rs = rsqrtf(var + 64e-5f);
          Y32[(size_t)(ch * 16) * (D / 2)] = cvt_pk_nv((d0 * rs * lnw.x + lnb.x + bc0) * gc0, (d1 * rs * lnw.y + lnb.y + bc1) * gc1); }
        gc0 = gn0; gc1 = gn1; bc0 = bn0; bc1 = bn1;
    }
#undef RC_ISSUE
#undef RC_PREP
}

#define XB_TMO      128
#define XB_XCNT(j)  (256  + 64 * (j))
#define XB_XSUB(j)  (1280 + 64 * (j))
#define XB_XGEN(j)  (2304 + 64 * (j))
#define XB_TOP      3328
#define XB_TOPGEN   3392
#define XCD_BAR_WORDS 3456
#define XB_SPIN_CAP (1u << 18)

__device__ __forceinline__ unsigned xb_ld(unsigned* p)              { return __hip_atomic_load(p, __ATOMIC_RELAXED, __HIP_MEMORY_SCOPE_AGENT); }
__device__ __forceinline__ unsigned xb_add(unsigned* p, unsigned v) { return __hip_atomic_fetch_add(p, v, __ATOMIC_RELAXED, __HIP_MEMORY_SCOPE_AGENT); }
__device__ __forceinline__ unsigned xb_xcc_id() { return (unsigned)__builtin_amdgcn_s_getreg((3 << 11) | 20) & 0xFu; }
#define XB_SPIN(cond, bar) do { unsigned _sp = 0; while (cond) { __builtin_amdgcn_s_sleep(1); \
    if ((++_sp & 255u) == 0u) { if (xb_ld(&(bar)[XB_TMO])) break; if (_sp > XB_SPIN_CAP) { atomicAdd(&(bar)[XB_TMO], 1u); break; } } } } while (0)

struct XcdBarrier {
    unsigned* bar; unsigned x;
    volatile LAS unsigned* st;
};

__device__ __forceinline__ XcdBarrier xcd_barrier_post(unsigned* bar, volatile LAS unsigned* st) {
    XcdBarrier b; b.bar = bar; b.x = xb_xcc_id(); b.st = st;
    if (threadIdx.x == 0) (void)xb_add(&bar[XB_XCNT(b.x)], 1u);
    return b;
}
__device__ __forceinline__ void xcd_barrier_complete(unsigned* bar, unsigned x, unsigned& nloc, unsigned& nx) {
    const unsigned G = gridDim.x * gridDim.y * gridDim.z;
    unsigned sum, cnt, mine, sp = 0u;
    for (;;) {
        sum = 0u; cnt = 0u; mine = 0u;
#pragma unroll
        for (unsigned j = 0; j < 16; ++j) { const unsigned c = xb_ld(&bar[XB_XCNT(j)]); sum += c; cnt += (c > 0u) ? 1u : 0u; mine = (j == x) ? c : mine; }
        if (sum == G) break;
        __builtin_amdgcn_s_sleep(1);
        if ((++sp & 255u) == 0u) { if (xb_ld(&bar[XB_TMO])) break; if (sp > XB_SPIN_CAP) { atomicAdd(&bar[XB_TMO], 1u); break; } }
    }
    nloc = mine > 0u ? mine : 1u; nx = cnt > 0u ? cnt : 1u;
}

__device__ __forceinline__ void xcd_barrier(const XcdBarrier& b) {
    asm volatile("s_waitcnt vmcnt(0)" ::: "memory");
    __syncthreads();
    if (threadIdx.x == 0) {
        unsigned* bar = b.bar;
        __builtin_amdgcn_s_waitcnt(0);
        unsigned nloc = b.st[0], nx = b.st[1];
        if (nloc == 0u) { xcd_barrier_complete(bar, b.x, nloc, nx); b.st[0] = nloc; b.st[1] = nx; }
        const unsigned old = xb_add(&bar[XB_XSUB(b.x)], 1u);
        const unsigned gen = old / nloc;
        if (old + 1u == (gen + 1u) * nloc) {
            __builtin_amdgcn_fence(__ATOMIC_RELEASE, "agent");
            asm volatile("s_waitcnt vmcnt(0)" ::: "memory");
            const unsigned og = xb_add(&bar[XB_TOP], 1u);
            const unsigned tg = og / nx;
            if (og + 1u == (tg + 1u) * nx) xb_add(&bar[XB_TOPGEN], 1u);
            else XB_SPIN(xb_ld(&bar[XB_TOPGEN]) == tg, bar);
            __builtin_amdgcn_fence(__ATOMIC_ACQUIRE, "agent");
            xb_add(&bar[XB_XGEN(b.x)], 1u);
            asm volatile("s_waitcnt vmcnt(0)" ::: "memory");
        } else {
            XB_SPIN(xb_ld(&bar[XB_XGEN(b.x)]) == gen, bar);
            __builtin_amdgcn_fence(__ATOMIC_ACQUIRE, "agent");
            asm volatile("s_waitcnt vmcnt(0)" ::: "memory");
        }
    }
    __syncthreads();
}


__global__ __launch_bounds__(512, 2) void mega(const Params p_arg) {
    extern __shared__ __attribute__((aligned(16))) unsigned char shm[];
    const Params& p = *(const Params*)(const void*)__builtin_amdgcn_kernarg_segment_ptr();
    LAS unsigned char* lds = (LAS unsigned char*)shm;
    const int G = (int)gridDim.x, bid = (int)blockIdx.x;
    __shared__ uint4 xb_words;
    if (threadIdx.x == 0) xb_words = make_uint4(0u, 0u, 0u, 0u);
    __syncthreads();
    (void)xcd_barrier_post((unsigned*)(p.ws + WS_BAR), (volatile LAS unsigned*)&xb_words);
    const int step_lo = p.step_lo, step_hi = p.step_hi;
    for (int s = step_lo; s < step_hi; ++s) {
        const int kind = p.kind[s], lo = p.lo[s], hi = p.hi[s];
        switch (kind) {
            case K_PRE0:
#ifndef NO_PRE
 convert_tiles(p, lo, hi, lds); rope_table(p); norm_rows(p.in[0], p.in[1], (bf16_t*)(p.ws + WS_H));
#endif
 break;
            case K_GEMMB:
#ifndef NO_GB

                { pg8::Gemm g; g.A = p.g[lo].A; g.Bt = p.g[lo].Bt; g.M = p.g[lo].M; g.N = p.g[lo].N; g.K = p.g[lo].K;
                  MultiOrder S; S.ops = &p.g[lo]; S.nops = hi - lo; S.G = G; S.c = bid;
                  EpiB E; E.ops = &p.g[lo];
                  pg8::gemm_phase<EpiB, MultiOrder, false>(lds, g, S, E, nullptr); }
                if (p.chi[s] > p.clo[s]) convert_queue(p, p.clo[s], p.chi[s], (unsigned*)(p.ws + WS_BAR + 16384) + 64 * p.cq[s], lds);
#endif
                break;
            case K_GEMMF:
#ifndef NO_GF

                for (int i = lo; i < hi; ++i) { const GemmOp& o = p.g[i]; pg8::Gemm g; g.A = o.A; g.Bt = o.Bt; g.M = o.M; g.N = o.N; g.K = o.K;
                    pg8::StaticOrder S; S.init(o.M, o.N, G, (bid + G - (o.rot % G)) % G);
                    EpiF E; E.C = (float*)o.out; E.ldc = o.ldc; E.res = o.res;
                    pg8::gemm_phase<EpiF, pg8::StaticOrder, false>(lds, g, S, E, nullptr); }
#endif
                break;
            case K_CONVSSD:
#ifndef NO_CONV
 conv_ssd(p);
#endif
 break;
            case K_MIX0:

#ifndef NO_SSD
for (int j = bid; j < 256; j += G) ssd_chunk_job(p, j, lds);
#endif


#ifndef NO_ATT
for (int j = bid; j < 512; j += G) attn_job(p, j, lds);
#endif

                break;
            case K_POST0: post_ssd(p); break;
            case K_NORM: norm_rows(p.out, p.in[2] + lo * D, (bf16_t*)(p.ws + WS_H)); break;
            case K_PRE1: convert_tiles(p, lo, hi, lds); mix_rows(p.out, p.in[1] + D, p.in[16], (bf16_t*)(p.ws + WS_MIX), 0, lds); break;
            case K_MIXES: mix_rows(p.out, p.in[1] + D, p.in[16], (bf16_t*)(p.ws + WS_MIX), 8192, lds); break;
            case K_RWKV:
#ifndef NO_RWKV
 for (int j = bid; j < 256; j += G) rwkv_chunk_job(p, j, lds);
#endif
 break;
            case K_NORMCONV: convert_tiles(p, lo, hi, lds); norm_rows(p.out, p.in[2] + D, (bf16_t*)(p.ws + WS_H)); break;
            default: break;
        }
        if (s + 1 < step_hi) { if (step_hi < 0) cg::this_grid().sync();   XcdBarrier xb; xb.bar = (unsigned*)(p.ws + WS_BAR); xb.x = xb_xcc_id(); xb.st = (volatile LAS unsigned*)&xb_words; xcd_barrier(xb); }
    }
}

#ifndef MK_MULTI
#define MK_MULTI 0
#endif
extern "C" void kernel_launch(void* const* d_in, const int* in_sizes, int n_in, void* d_out, int out_size, void* d_ws, size_t ws_size, hipStream_t stream) {
    static int grid = 0;
    if (grid == 0) {
        int dev = 0, cus = 0, per_cu = 0;
        hipGetDevice(&dev); hipDeviceGetAttribute(&cus, hipDeviceAttributeMultiprocessorCount, dev);
        if (hipFuncSetAttribute((const void*)mega, hipFuncAttributeMaxDynamicSharedMemorySize, LDS_BYTES) != hipSuccess) { fprintf(stderr, "hipFuncSetAttribute failed\n"); grid = -1; return; }
        if (hipOccupancyMaxActiveBlocksPerMultiprocessor(&per_cu, (const void*)mega, 512, LDS_BYTES) != hipSuccess || per_cu < 1) { fprintf(stderr, "occupancy query: %d\n", per_cu); per_cu = 1; }
        (void)hipGetLastError();
        grid = cus * per_cu; if (grid > 256) grid = 256;
        if (n_in != 34 || ws_size < 512 * MiB) { fprintf(stderr, "unexpected n_in %d / ws %zu\n", n_in, ws_size); grid = -1; return; }
    }
    if (grid < 0) return;
    static Params p;
    memset(&p, 0, sizeof(p));
    for (int i = 0; i < 34; ++i) p.in[i] = (const float*)d_in[i];
    p.out = (float*)d_out; p.ws = (unsigned char*)d_ws;
    unsigned char* ws = (unsigned char*)d_ws;
    auto B16 = [&](size_t off) { return (bf16_t*)(ws + off); };
    int ncj = 0, tile_acc = 0;
    auto CJ = [&](const float* src, size_t dst_off, int K, int N, int Kpad, int Npad) { ConvJob& c = p.cj[ncj++]; c.src = src; c.dst = B16(dst_off); c.K = K; c.N = N; c.Kpad = Kpad; c.Npad = Npad; c.tile0 = tile_acc; c.ntiles = (Kpad / 64) * (Npad / 256); tile_acc += c.ntiles; };
    const float* w_up = p.in[3]; const float* w_down = p.in[4];
    tile_acc = 0;
    CJ(p.in[5], WS_WBA, 2048, 4112, 2048, 4352); CJ(p.in[15], WS_WBA + 17 * MiB, 2048, 2048, 2048, 2048);
    tile_acc = 0;
    CJ(w_up, WS_WMLP, 2048, 8192, 2048, 8192); CJ(w_down, WS_WMLP + 32 * MiB, 8192, 2048, 8192, 2048);
    tile_acc = 0;
    CJ(p.in[28], WS_WBA, 2048, 2048, 2048, 2048); CJ(p.in[29], WS_WBA + 8 * MiB, 2048, 2048, 2048, 2048); CJ(p.in[30], WS_WBA + 16 * MiB, 2048, 2048, 2048, 2048); CJ(p.in[31], WS_WBA + 24 * MiB, 2048, 2048, 2048, 2048);
    CJ(p.in[18], WS_WBA + 32 * MiB, 2048, 96, 2048, 256); CJ(p.in[21], WS_WBA + 33 * MiB, 2048, 96, 2048, 256); CJ(p.in[23], WS_WBA + 34 * MiB, 2048, 256, 2048, 256);
    CJ(p.in[19], WS_WBA + 35 * MiB, 96, 2048, 256, 2048); CJ(p.in[22], WS_WBA + 36 * MiB, 96, 2048, 256, 2048); CJ(p.in[24], WS_WBA + 37 * MiB, 256, 2048, 256, 2048);
    tile_acc = 0;
    CJ(w_up + (size_t)2048 * 8192, WS_WMLP1, 2048, 8192, 2048, 8192); CJ(w_down + (size_t)2048 * 8192, WS_WMLP1 + 32 * MiB, 8192, 2048, 8192, 2048);
    int nop = 0;
    auto GO = [&](const bf16_t* A, const bf16_t* Bt, void* out, const float* bias, const float* res, int M, int N, int K, int ldc, int act, int rot) {
        GemmOp& o = p.g[nop++]; o.A = A; o.Bt = Bt; o.out = out; o.bias = bias; o.res = res; o.M = M; o.N = N; o.K = K; o.ldc = ldc; o.act = act; o.rot = rot; };
    GO(B16(WS_H), B16(WS_WBA), B16(WS_PROJ), nullptr, nullptr, MTOK, INWP, 2048, INWP, 0, 0);
    GO(B16(WS_YMIX), B16(WS_WBA + 17 * MiB), d_out, nullptr, p.in[0], MTOK, 2048, 2048, 2048, 0, 0);
    GO(B16(WS_H), B16(WS_WMLP), B16(WS_U), nullptr, nullptr, MTOK, DFF, 2048, DFF, 1, 0);
    GO(B16(WS_U), B16(WS_WMLP + 32 * MiB), d_out, nullptr, (const float*)d_out, MTOK, 2048, DFF, 2048, 0, 0);
    for (int half = 0; half < 2; ++half) {
        const size_t ro = (size_t)half * 8192 * 2048 * 2, lo_ = (size_t)half * 8192 * 256 * 2; const size_t mb = (size_t)8192 * 2048 * 2;
        GO(B16(WS_MIX + 0 * mb), B16(WS_WBA), B16(WS_R + ro), nullptr, nullptr, 8192, 2048, 2048, 2048, 0, 0);
        GO(B16(WS_MIX + 2 * mb), B16(WS_WBA + 8 * MiB), B16(WS_K + ro), nullptr, nullptr, 8192, 2048, 2048, 2048, 0, 0);
        GO(B16(WS_MIX + 3 * mb), B16(WS_WBA + 16 * MiB), B16(WS_V + ro), nullptr, nullptr, 8192, 2048, 2048, 2048, 0, 0);
        GO(B16(WS_MIX + 1 * mb), B16(WS_WBA + 32 * MiB), B16(WS_L1W + lo_), nullptr, nullptr, 8192, 256, 2048, 256, 2, 0);
        GO(B16(WS_MIX + 4 * mb), B16(WS_WBA + 33 * MiB), B16(WS_L1A + lo_), nullptr, nullptr, 8192, 256, 2048, 256, 0, 32);
        GO(B16(WS_MIX + 5 * mb), B16(WS_WBA + 34 * MiB), B16(WS_L1G + lo_), nullptr, nullptr, 8192, 256, 2048, 256, 3, 64);
    }
    GO(B16(WS_L1W), B16(WS_WBA + 35 * MiB), B16(WS_WDEC), p.in[17], nullptr, MTOK, 2048, 256, 2048, 4, 0);
    GO(B16(WS_L1A), B16(WS_WBA + 36 * MiB), B16(WS_AA), p.in[20], nullptr, MTOK, 2048, 256, 2048, 3, 0);
    GO(B16(WS_L1G), B16(WS_WBA + 37 * MiB), B16(WS_GG), nullptr, nullptr, MTOK, 2048, 256, 2048, 0, 0);
    GO(B16(WS_YG), B16(WS_WBA + 24 * MiB), d_out, nullptr, (const float*)d_out, MTOK, 2048, 2048, 2048, 0, 0);
    GO(B16(WS_H), B16(WS_WMLP1), B16(WS_U), nullptr, nullptr, MTOK, DFF, 2048, DFF, 1, 0);
    GO(B16(WS_U), B16(WS_WMLP1 + 32 * MiB), d_out, nullptr, (const float*)d_out, MTOK, 2048, DFF, 2048, 0, 0);
    int ns = 0;
    auto ST = [&](int kind, int lo, int hi, int clo = 0, int chi = 0, int cq = 0) { p.kind[ns] = kind; p.lo[ns] = lo; p.hi[ns] = hi; p.clo[ns] = clo; p.chi[ns] = chi; p.cq[ns] = cq; ++ns; };
    ST(K_PRE0, 0, 2); ST(K_GEMMB, 0, 1, 2, 4, 0); ST(K_CONVSSD, 0, 0); ST(K_MIX0, 0, 0); ST(K_POST0, 0, 0); ST(K_GEMMF, 1, 2); ST(K_NORM, 0, 0); ST(K_GEMMB, 2, 3); ST(K_GEMMF, 3, 4);
    ST(K_PRE1, 4, 14); ST(K_GEMMB, 4, 10, 14, 16, 1); ST(K_MIXES, 0, 0); ST(K_GEMMB, 10, 16, 14, 16, 1); ST(K_GEMMB, 16, 19); ST(K_RWKV, 0, 0); ST(K_GEMMF, 19, 20); ST(K_NORM, 1, 0); ST(K_GEMMB, 20, 21); ST(K_GEMMF, 21, 22);
    (void)hipMemsetAsync(ws + WS_BAR, 0, 16384 + 1024, stream);
#if MK_MULTI
    for (int s = 0; s < ns; ++s) { p.step_lo = s; p.step_hi = s + 1; hipLaunchKernelGGL(mega, dim3(grid), dim3(512), LDS_BYTES, stream, p); }
#else
    p.step_lo = 0; p.step_hi = ns;
    void* args[] = {(void*)&p};
    const hipError_t e = hipLaunchCooperativeKernel((const void*)mega, dim3(grid), dim3(512), args, LDS_BYTES, stream);
    if (e != hipSuccess) fprintf(stderr, "cooperative launch failed: %s (grid %d)\n", hipGetErrorString(e), grid);
#endif
}
```

```cpp
#include <hip/hip_runtime.h>
#include <hip/hip_cooperative_groups.h>
#include <cstdio>
#include <cstring>
namespace cg = cooperative_groups;
__device__ __forceinline__ int opq(int v) { asm volatile("" : "+v"(v)); return v; }
namespace pg8 {
#define PG8_LAS __attribute__((address_space(3)))
typedef unsigned short bf16_t;
typedef short bf16x8 __attribute__((ext_vector_type(8)));
typedef float f32x4 __attribute__((ext_vector_type(4)));
typedef unsigned u32x4 __attribute__((ext_vector_type(4)));
constexpr int BM = 256, BK = 64, HALF = 128, HTB = HALF * BK * 2  , STAGE_BYTES = 8 * HTB, NXCD = 8, WGM = 8;

__host__ __device__ __forceinline__ int lds_byte(int r, int c) { const int st = (r >> 4) * 2 + (c >> 5), rr = r & 15, cc = c & 31, ob = rr * 64 + cc * 2; return st * 1024 + (ob ^ (((ob >> 9) & 1) << 5)); }
__host__ __device__ __forceinline__ void stage_rc(int b, int& R, int& C) { const int st = b / 1024, sb = b % 1024, swz = sb ^ (((sb >> 9) & 1) << 5); R = (st >> 1) * 16 + swz / 64; C = (st & 1) * 32 + (swz % 64) / 2; }
__host__ __device__ __forceinline__ int perm32(int rho) { const int n = rho >> 4, i = rho & 15; return 8 * (i >> 2) + 4 * n + (i & 3); }

struct Unit { int pm, pn, op; };
struct Gemm { const bf16_t* A; const bf16_t* Bt; int M, N, K; };

struct StaticOrder {
    int nM, nN, nwg, G, c;
    __host__ __device__ void init(int M, int N, int G_, int c_) { nM = M / BM; nN = N / BM; nwg = nM * nN; G = G_; c = c_; }
    __host__ __device__ bool next(int i, Unit& u) const {
        const long L = (long)i * G + c; if (L >= nwg) return false;
        int wgid = (int)L; { const int q = nwg / NXCD, r = nwg % NXCD, xcd = wgid % NXCD, off = wgid / NXCD; wgid = (xcd < r ? xcd * (q + 1) : r * (q + 1) + (xcd - r) * q) + off; }
        const int nig = WGM * nN, gid = wgid / nig, fm = gid * WGM, gsz = (nM - fm) < WGM ? (nM - fm) : WGM;
        u.pm = fm + ((wgid % nig) % gsz); u.pn = (wgid % nig) / gsz; u.op = 0; return true;
    }
    __device__ __forceinline__ const char* abase(const Unit&, const Gemm& g) const { return (const char*)g.A; }
    __device__ __forceinline__ const char* bbase(const Unit&, const Gemm& g) const { return (const char*)g.Bt; }
    __device__ __forceinline__ void a_ready(const Unit&) const {}
    __device__ __forceinline__ void done(const Unit&) const {}
};
typedef __bf16 bf16x2_t __attribute__((ext_vector_type(2)));
typedef float f32x2_t __attribute__((ext_vector_type(2)));
__device__ __forceinline__ unsigned cvt_pk_bf16(float lo, float hi) { const f32x2_t f = {lo, hi}; const bf16x2_t v = __builtin_convertvector(f, bf16x2_t); return __builtin_bit_cast(unsigned, v); }
__device__ __forceinline__ unsigned cvt_pk_nv(float lo, float hi) { return cvt_pk_bf16(lo, hi); }

template <class Epi, class Sched, bool STAMP = false>
__device__ __forceinline__ void gemm_phase(PG8_LAS unsigned char* lds, const Gemm g, const Sched& S, const Epi& E, unsigned long long* stamps) {
    const int tid = opq(threadIdx.x), wid = __builtin_amdgcn_readfirstlane(tid >> 6), lane = tid & 63, wr = wid >> 2, wc = wid & 3, fr = lane & 15, fq = lane >> 4;
    const int K = g.K, nt = K / BK;
    int ts_lo = 0, ts_hi = 0, nts = 0; const unsigned long long rt_entry = STAMP ? (unsigned long long)wall_clock64() : 0ull;
#define PG8_STAMP() do { if (STAMP && wid == 0 && nts < 64) { const unsigned long long _c = (unsigned long long)clock64(); \
        ts_lo = (lane == nts) ? (int)(unsigned)_c : ts_lo; ts_hi = (lane == nts) ? (int)(unsigned)(_c >> 32) : ts_hi; ++nts; } } while (0)
    PG8_STAMP();
    unsigned voffA[2], voffB[2];
#pragma unroll
    for (int i = 0; i < 2; ++i) { int R, C; stage_rc(tid * 16 + i * 8192, R, C); const int Rb = Epi::PERM ? ((R & ~31) + perm32(R & 31)) : R;
        voffA[i] = (unsigned)(R * K + C) * 2u; voffB[i] = (unsigned)(Rb * K + C) * 2u; }
    const size_t kstep = (size_t)(BK * 2);
    const size_t hstep = (size_t)HALF * K * 2;
    const size_t tstep = 2 * hstep;
    const unsigned ldsw = (unsigned)wid * 1024u;
    const int aoff = lds_byte(wr * 64 + fr, fq * 8), boff = lds_byte(wc * 32 + fr, fq * 8);
#define PG8_SA(b, h) (((b) * 2 + (h)) * HTB)
#define PG8_SB(b, h) ((4 + (b) * 2 + (h)) * HTB)
#define PG8_STAGE(bufoff, gbase, voff) do { _Pragma("unroll") for (int _i = 0; _i < 2; ++_i) \
        __builtin_amdgcn_global_load_lds((const unsigned*)((const char*)(gbase) + (voff)[_i]), (PG8_LAS unsigned*)(lds + (bufoff) + ldsw + _i * 8192), 16, 0, 0); } while (0)
#define PG8_LDA(dst, b, h) do { _Pragma("unroll") for (int m = 0; m < 4; ++m) _Pragma("unroll") for (int k = 0; k < 2; ++k) dst[m][k] = *(const PG8_LAS bf16x8*)(lds + PG8_SA(b, h) + aoff + m * 2048 + k * 1024); } while (0)
#define PG8_LDB(dst, b, h) do { _Pragma("unroll") for (int n = 0; n < 2; ++n) _Pragma("unroll") for (int k = 0; k < 2; ++k) dst[n][k] = *(const PG8_LAS bf16x8*)(lds + PG8_SB(b, h) + boff + n * 2048 + k * 1024); } while (0)
#define PG8_MMA(ai, bj, At, Bt) do { __builtin_amdgcn_s_setprio(1); _Pragma("unroll") for (int m = 0; m < 4; ++m) _Pragma("unroll") for (int n = 0; n < 2; ++n) _Pragma("unroll") for (int k = 0; k < 2; ++k) \
        acc[ai][bj][m][n] = __builtin_amdgcn_mfma_f32_16x16x32_bf16(Bt[n][k], At[m][k], acc[ai][bj][m][n], 0, 0, 0); __builtin_amdgcn_s_setprio(0); } while (0)
#define PG8_WAIT_V(n) asm volatile("s_waitcnt vmcnt(" #n ")" ::: "memory")
#define PG8_WAIT_L(n) asm volatile("s_waitcnt lgkmcnt(" #n ")" ::: "memory")
#define PG8_BAR __builtin_amdgcn_s_barrier()
#define PG8_SCHED __builtin_amdgcn_sched_barrier(0)
    Unit cur, nxt; int ui = 0;
    if (!S.next(0, cur)) return;
    f32x4 acc[2][2][4][2];
#pragma unroll
    for (int a = 0; a < 2; ++a)
#pragma unroll
        for (int b = 0; b < 2; ++b)
#pragma unroll
            for (int m = 0; m < 4; ++m)
#pragma unroll
                for (int n = 0; n < 2; ++n) acc[a][b][m][n] = (f32x4){0.f, 0.f, 0.f, 0.f};
    bf16x8 At[4][2], B0[2][2], B1[2][2];
    const char* cA = S.abase(cur, g) + (size_t)cur.pm * tstep; const char* cB = S.bbase(cur, g) + (size_t)cur.pn * tstep;
    S.a_ready(cur);
    PG8_STAGE(PG8_SB(0, 0), cB, voffB); PG8_STAGE(PG8_SA(0, 0), cA, voffA); PG8_STAGE(PG8_SB(0, 1), cB + hstep, voffB); PG8_STAGE(PG8_SA(0, 1), cA + hstep, voffA);
    if (wr == 1) PG8_BAR;
    PG8_WAIT_V(4); PG8_BAR;
    PG8_STAGE(PG8_SB(1, 0), cB + kstep, voffB); PG8_STAGE(PG8_SA(1, 0), cA + kstep, voffA); PG8_STAGE(PG8_SB(1, 1), cB + hstep + kstep, voffB);
    PG8_WAIT_V(6); PG8_BAR;
    PG8_STAMP();
    for (;;) {
        const bool has_next = S.next(ui + 1, nxt);
        const char* nA = has_next ? S.abase(nxt, g) + (size_t)nxt.pm * tstep : cA; const char* nB = has_next ? S.bbase(nxt, g) + (size_t)nxt.pn * tstep : cB;
        for (int t = 0; t < nt; t += 2) {
            const bool last = (t == nt - 2);
            const char* a1 = cA + (size_t)(t + 1) * kstep;
            const char* a2 = last ? nA : cA + (size_t)(t + 2) * kstep; const char* b2 = last ? nB : cB + (size_t)(t + 2) * kstep;
            const char* a3 = a2 + kstep; const char* b3 = b2 + kstep;
            if (last && has_next) S.a_ready(nxt);
            PG8_LDB(B0, 0, 0); PG8_SCHED; PG8_LDA(At, 0, 0); PG8_STAGE(PG8_SA(1, 1), a1 + hstep, voffA);
            PG8_WAIT_L(8); PG8_BAR; PG8_WAIT_L(0); PG8_MMA(0, 0, At, B0); PG8_BAR; PG8_SCHED;
            PG8_LDB(B1, 0, 1); PG8_STAGE(PG8_SB(0, 0), b2, voffB);
            PG8_BAR; PG8_WAIT_L(0); PG8_MMA(0, 1, At, B1); PG8_BAR;
            PG8_LDA(At, 0, 1); PG8_STAGE(PG8_SA(0, 0), a2, voffA);
            PG8_BAR; PG8_WAIT_L(0); PG8_MMA(1, 0, At, B0); PG8_BAR; PG8_SCHED;
            PG8_STAGE(PG8_SB(0, 1), b2 + hstep, voffB);
            PG8_WAIT_V(6); PG8_BAR; PG8_MMA(1, 1, At, B1); PG8_BAR;
            PG8_LDB(B0, 1, 0); PG8_SCHED; PG8_LDA(At, 1, 0); PG8_STAGE(PG8_SA(0, 1), a2 + hstep, voffA);
            PG8_WAIT_L(8); PG8_BAR; PG8_WAIT_L(0); PG8_MMA(0, 0, At, B0); PG8_BAR; PG8_SCHED;
            PG8_LDB(B1, 1, 1); PG8_STAGE(PG8_SB(1, 0), b3, voffB);
            PG8_BAR; PG8_WAIT_L(0); PG8_MMA(0, 1, At, B1); PG8_BAR;
            PG8_LDA(At, 1, 1); PG8_STAGE(PG8_SA(1, 0), a3, voffA);
            PG8_BAR; PG8_WAIT_L(0); PG8_MMA(1, 0, At, B0); PG8_BAR; PG8_SCHED;
            PG8_STAGE(PG8_SB(1, 1), b3 + hstep, voffB);
            PG8_WAIT_V(6); PG8_BAR; PG8_MMA(1, 1, At, B1); PG8_BAR;
        }
        PG8_STAMP();
        if constexpr (!Epi::AFTER_DRAIN) { E(acc, cur, wr, wc, fr, fq); S.done(cur); }
        PG8_STAMP();
        if (!has_next) break;
#pragma unroll
        for (int a = 0; a < 2; ++a)
#pragma unroll
            for (int b = 0; b < 2; ++b)
#pragma unroll
                for (int m = 0; m < 4; ++m)
#pragma unroll
                    for (int n = 0; n < 2; ++n) acc[a][b][m][n] = (f32x4){0.f, 0.f, 0.f, 0.f};
        cur = nxt; cA = nA; cB = nB; ++ui;
    }
    PG8_WAIT_V(0);
    if (wr == 0) PG8_BAR;
    PG8_BAR;
    if constexpr (Epi::AFTER_DRAIN) { E.fused(acc, cur, wr, wc, fr, fq, lds, wid, lane); S.done(cur); }
    PG8_STAMP();
    if (STAMP && wid == 0) { stamps[lane] = lane < nts ? (((unsigned long long)(unsigned)ts_hi << 32) | (unsigned)ts_lo) : 0ull;
        if (lane == 62) stamps[62] = rt_entry; if (lane == 63) stamps[63] = (unsigned long long)wall_clock64(); }
#undef PG8_STAMP
#undef PG8_SA
#undef PG8_SB
#undef PG8_STAGE
#undef PG8_LDA
#undef PG8_LDB
#undef PG8_MMA
#undef PG8_WAIT_V
#undef PG8_WAIT_L
#undef PG8_BAR
#undef PG8_SCHED
}
}

#include <cstdio>
#include <ctime>
#include <cstdlib>
#include <cstring>
#include <cmath>
#include <vector>
#include <algorithm>
#define CK(x) do { hipError_t e_ = (x); if (e_ != hipSuccess) { fprintf(stderr, "HIP %s:%d %s\n", __FILE__, __LINE__, hipGetErrorString(e_)); exit(2); } } while (0)
using pg8::bf16_t; using pg8::bf16x8; using pg8::f32x4; using pg8::u32x4; using pg8::cvt_pk_bf16; using pg8::cvt_pk_nv;
#define LAS PG8_LAS

constexpr int D = 2048, SEQ = 2048, MTOK = 16384, DFF = 8192, INWP = 4352;
constexpr int COL_K = 1024, COL_V = 1280, COL_Z = 1536, COL_XBC = 2560, COL_DT = 4096;
constexpr size_t MiB = (size_t)1 << 20;
constexpr size_t WS_WBA = 0, WS_WMLP = 40 * MiB, WS_H = 104 * MiB, WS_PROJ = 168 * MiB, WS_YMIX = 304 * MiB, WS_YRAW = 368 * MiB, WS_XBC = 432 * MiB,
                 WS_DT = 480 * MiB, WS_DA = 481 * MiB, WS_ROPE = 482 * MiB, WS_U = 168 * MiB;
constexpr size_t WS_R = 40 * MiB, WS_K = 104 * MiB, WS_V = 168 * MiB, WS_L1W = 232 * MiB, WS_L1A = 240 * MiB, WS_L1G = 248 * MiB, WS_MIX = 256 * MiB,
                 WS_WDEC = 256 * MiB, WS_AA = 320 * MiB, WS_GG = 384 * MiB, WS_YG = 40 * MiB  , WS_WMLP1 = 448 * MiB;
constexpr size_t WS_BAR = 39 * MiB;
constexpr int LDS_BYTES = 140 * 1024;

enum { K_PRE0 = 0, K_GEMMB, K_GEMMF, K_CONVSSD, K_MIX0, K_POST0, K_NORM, K_PRE1, K_MIXES, K_RWKV, K_NORMCONV };
constexpr int NSTEPS = 48, NOPS = 22, NCJ = 16;
#define REP_GEMMB 1
#define REP_MIX0 1
#define REP_RWKV 1
#define REP_ELEM 1

struct GemmOp { const bf16_t* A; const bf16_t* Bt; void* out; const float* bias; const float* res; int M, N, K, ldc, act, rot, pad0, pad1; };
struct ConvJob { const float* src; bf16_t* dst; int K, N, Kpad, Npad, tile0, ntiles; };
struct Params {
    const float* in[34];
    float* out; unsigned char* ws;
    GemmOp g[NOPS];
    ConvJob cj[NCJ];
    int kind[NSTEPS + 1]; int lo[NSTEPS + 1]; int hi[NSTEPS + 1]; int clo[NSTEPS + 1]; int chi[NSTEPS + 1]; int cq[NSTEPS + 1];
    int step_lo, step_hi;
};

__device__ __forceinline__ float bf2f(unsigned short b) { return __uint_as_float(((unsigned)b) << 16); }
__device__ __forceinline__ float bflo(unsigned w) { return __uint_as_float(w << 16); }
__device__ __forceinline__ float bfhi(unsigned w) { return __uint_as_float(w & 0xffff0000u); }
__device__ __forceinline__ bf16_t f2bf(float f) { return (bf16_t)(cvt_pk_bf16(f, 0.f) & 0xffffu); }
template <int CTRL> __device__ __forceinline__ float dpp_add(float x) {
    const int y = __builtin_amdgcn_update_dpp(0, __builtin_bit_cast(int, x), CTRL, 0xf, 0xf, true);
    return x + __builtin_bit_cast(float, y); }
template <int CTRL> __device__ __forceinline__ float dpp_max(float x) {
    const int y = __builtin_amdgcn_update_dpp(0, __builtin_bit_cast(int, x), CTRL, 0xf, 0xf, true);
    return fmaxf(x, __builtin_bit_cast(float, y)); }
__device__ __forceinline__ float max16(float x) { x = dpp_max<0xB1>(x); x = dpp_max<0x4E>(x); x = dpp_max<0x141>(x); x = dpp_max<0x140>(x); return x; }
__device__ __forceinline__ float red8(float x) { x = dpp_add<0xB1>(x); x = dpp_add<0x4E>(x); x = dpp_add<0x141>(x); return x; }
__device__ __forceinline__ float red16(float x) { x = red8(x); x = dpp_add<0x140>(x); return x; }
__device__ __forceinline__ float wave_sum(float v) {
    v = red16(v);
    const float r0 = __builtin_bit_cast(float, __builtin_amdgcn_readlane(__builtin_bit_cast(int, v), 0)), r1 = __builtin_bit_cast(float, __builtin_amdgcn_readlane(__builtin_bit_cast(int, v), 16));
    const float r2 = __builtin_bit_cast(float, __builtin_amdgcn_readlane(__builtin_bit_cast(int, v), 32)), r3 = __builtin_bit_cast(float, __builtin_amdgcn_readlane(__builtin_bit_cast(int, v), 48));
    return (r0 + r1) + (r2 + r3); }
typedef float f32x2 __attribute__((ext_vector_type(2)));
typedef unsigned u32x2 __attribute__((ext_vector_type(2)));
__device__ __forceinline__ float sigmoidf_(float v) { return __builtin_amdgcn_rcpf(1.0f + __expf(-v)); }
__device__ __forceinline__ void unpack8(const uint4 r, float (&f)[8]) {
    f[0] = bflo(r.x); f[1] = bfhi(r.x); f[2] = bflo(r.y); f[3] = bfhi(r.y); f[4] = bflo(r.z); f[5] = bfhi(r.z); f[6] = bflo(r.w); f[7] = bfhi(r.w); }

__device__ __forceinline__ float act_apply(float v, int act) {
    switch (act) {
        case 1: { const float r = fmaxf(v, 0.f); return r * r; }
        case 2: return 1.0f - 2.0f * __builtin_amdgcn_rcpf(1.0f + __expf(2.0f * v));
        case 3: return sigmoidf_(v);
        case 4: return 0.60653066f * sigmoidf_(v);
        default: return v; }
}
struct EpiB {
    static constexpr bool PERM = true, AFTER_DRAIN = false;
    const GemmOp* ops;
    __device__ __forceinline__ void operator()(const f32x4 (&acc)[2][2][4][2], const pg8::Unit& u, int wr, int wc, int fr, int fq) const {
        const GemmOp& o_ = ops[u.op]; bf16_t* O = (bf16_t*)o_.out; const int ldc = o_.ldc; const float* bias = o_.bias; const int act = o_.act;
        const int row0 = u.pm * 256 + wr * 64 + fr, col0 = u.pn * 256 + wc * 32 + 8 * fq;
        f32x4 bv[2][2];
#pragma unroll
        for (int bj = 0; bj < 2; ++bj)
#pragma unroll
            for (int n = 0; n < 2; ++n) bv[bj][n] = bias ? *(const f32x4*)(bias + col0 + bj * 128 + 4 * n) : (f32x4){0.f, 0.f, 0.f, 0.f};
#pragma unroll
        for (int ai = 0; ai < 2; ++ai)
#pragma unroll
            for (int m = 0; m < 4; ++m) { bf16_t* rowp = O + (size_t)(row0 + ai * 128 + m * 16) * ldc + col0;
#pragma unroll
                for (int bj = 0; bj < 2; ++bj) { f32x4 v0 = acc[ai][bj][m][0], v1 = acc[ai][bj][m][1];
                    v0 += bv[bj][0]; v1 += bv[bj][1];
                    if (act) {
#pragma unroll
                        for (int j = 0; j < 4; ++j) { v0[j] = act_apply(v0[j], act); v1[j] = act_apply(v1[j], act); } }
                    u32x4 w; w.x = cvt_pk_bf16(v0[0], v0[1]); w.y = cvt_pk_bf16(v0[2], v0[3]); w.z = cvt_pk_bf16(v1[0], v1[1]); w.w = cvt_pk_bf16(v1[2], v1[3]);
                    *(u32x4*)(rowp + bj * 128) = w; } }
    }
};
struct MultiOrder {
    const GemmOp* ops; int nops, G, c;
    __device__ __forceinline__ bool next(int i, pg8::Unit& u) const {
        long L = (long)i * G + c; int k = 0, nM = 0, nN = 0, nwg = 0;
        for (; k < nops; ++k) { nM = ops[k].M / 256; nN = ops[k].N / 256; nwg = nM * nN; if (L < nwg) break; L -= nwg; }
        if (k == nops) return false;
        int wgid = (int)L; { const int q = nwg / pg8::NXCD, r = nwg % pg8::NXCD, xcd = wgid % pg8::NXCD, off = wgid / pg8::NXCD; wgid = (xcd < r ? xcd * (q + 1) : r * (q + 1) + (xcd - r) * q) + off; }
        const int nig = pg8::WGM * nN, gid = wgid / nig, fm = gid * pg8::WGM, gsz = (nM - fm) < pg8::WGM ? (nM - fm) : pg8::WGM;
        u.pm = fm + ((wgid % nig) % gsz); u.pn = (wgid % nig) / gsz; u.op = k; return true;
    }
    __device__ __forceinline__ const char* abase(const pg8::Unit& u, const pg8::Gemm&) const { return (const char*)ops[u.op].A; }
    __device__ __forceinline__ const char* bbase(const pg8::Unit& u, const pg8::Gemm&) const { return (const char*)ops[u.op].Bt; }
    __device__ __forceinline__ void a_ready(const pg8::Unit&) const {}
    __device__ __forceinline__ void done(const pg8::Unit&) const {}
};
struct EpiF {
    static constexpr bool PERM = false, AFTER_DRAIN = false;
    float* C; int ldc; const float* res;
    __device__ __forceinline__ void operator()(const f32x4 (&acc)[2][2][4][2], const pg8::Unit& u, int wr, int wc, int fr, int fq) const {
        const int row0 = u.pm * 256 + wr * 64 + fr, col0 = u.pn * 256 + wc * 32 + 4 * fq;
#pragma unroll
        for (int ai = 0; ai < 2; ++ai)
#pragma unroll
            for (int mh = 0; mh < 2; ++mh) { size_t ro[2]; f32x4 r[2][2][2];
#pragma unroll
                for (int mm = 0; mm < 2; ++mm) { ro[mm] = (size_t)(row0 + ai * 128 + (mh * 2 + mm) * 16) * ldc + col0;
#pragma unroll
                    for (int bj = 0; bj < 2; ++bj)
#pragma unroll
                        for (int n = 0; n < 2; ++n) r[mm][bj][n] = *(const f32x4*)(res + ro[mm] + bj * 128 + n * 16); }
#pragma unroll
                for (int mm = 0; mm < 2; ++mm)
#pragma unroll
                    for (int bj = 0; bj < 2; ++bj)
#pragma unroll
                        for (int n = 0; n < 2; ++n) *(f32x4*)(C + ro[mm] + bj * 128 + n * 16) = acc[ai][bj][mh * 2 + mm][n] + r[mm][bj][n]; }
    }
};

__device__ __forceinline__ void convert_one_tile(const Params& p, int jlo, int jhi, int tile, int tid, LAS float* T) {
    int j = jlo; while (j + 1 < jhi && tile >= p.cj[j + 1].tile0) ++j;
    const float* src = p.cj[j].src; bf16_t* dst = p.cj[j].dst; const int K = p.cj[j].K, N = p.cj[j].N, Kpad = p.cj[j].Kpad;
    const int local = tile - p.cj[j].tile0, nkt = Kpad >> 6, kt = local % nkt, nt = local / nkt;
    f32x4 v[8];
#pragma unroll
    for (int i = 0; i < 8; ++i) { const int idx = tid + i * 512, kr = idx >> 6, c4 = idx & 63, k = kt * 64 + kr, n = nt * 256 + c4 * 4;
        v[i] = (f32x4){0.f, 0.f, 0.f, 0.f};
        if (k < K && n < N) v[i] = *(const f32x4*)(src + (size_t)k * N + n); }
#pragma unroll
    for (int i = 0; i < 8; ++i) { const int idx = tid + i * 512, kr = idx >> 6, c4 = idx & 63;
        T[kr * 257 + c4 * 4 + 0] = v[i][0]; T[kr * 257 + c4 * 4 + 1] = v[i][1]; T[kr * 257 + c4 * 4 + 2] = v[i][2]; T[kr * 257 + c4 * 4 + 3] = v[i][3]; }
    __syncthreads();
#pragma unroll
    for (int i = 0; i < 4; ++i) { const int idx = tid + i * 512, nl = idx >> 3, kc = idx & 7; float f[8];
#pragma unroll
        for (int e = 0; e < 8; ++e) f[e] = T[(kc * 8 + e) * 257 + nl];
        u32x4 w; w.x = cvt_pk_nv(f[0], f[1]); w.y = cvt_pk_nv(f[2], f[3]); w.z = cvt_pk_nv(f[4], f[5]); w.w = cvt_pk_nv(f[6], f[7]);
        *(u32x4*)(dst + (size_t)(nt * 256 + nl) * Kpad + kt * 64 + kc * 8) = w; }
    __syncthreads();
}
__device__ __forceinline__ void convert_tiles(const Params& p, int jlo, int jhi, LAS unsigned char* lds) {
    const int tid = opq(threadIdx.x); LAS float* T = (LAS float*)lds;
    const int total = p.cj[jhi - 1].tile0 + p.cj[jhi - 1].ntiles;
    for (int tile = blockIdx.x; tile < total; tile += gridDim.x) convert_one_tile(p, jlo, jhi, tile, tid, T);
}
__device__ __forceinline__ void convert_queue(const Params& p, int jlo, int jhi, unsigned* counter, LAS unsigned char* lds) {
    const int tid = opq(threadIdx.x); LAS float* T = (LAS float*)lds; LAS int* slot = (LAS int*)(lds + 72 * 1024);
    const int total = p.cj[jhi - 1].tile0 + p.cj[jhi - 1].ntiles;
    for (;;) {
        __syncthreads();
        if (tid == 0) *slot = (int)__hip_atomic_fetch_add(counter, 1u, __ATOMIC_RELAXED, __HIP_MEMORY_SCOPE_AGENT);
        __syncthreads();
        const int tile = *slot;
        if (tile >= total) break;
        convert_one_tile(p, jlo, jhi, tile, tid, T);
    }
}

__device__ __forceinline__ void rope_table(const Params& p) {
    float2* tab = (float2*)(p.ws + WS_ROPE);
    for (int idx = blockIdx.x * 512 + opq(threadIdx.x); idx < SEQ * 32; idx += gridDim.x * 512) {
        const int t = idx >> 5, i = idx & 31;
        const float inv = exp2f(-(float)i * 0.41524101186092029f);
        const float angf = (float)t * inv;
        const double ang = (double)angf;
        const double q = rint(ang * 0.6366197723675814);
        const float f = (float)fma(-q, 1.5707963267948966, ang), f2 = f * f;
        const float s = f * (1.0f + f2 * (-1.6666667e-1f + f2 * (8.3333333e-3f + f2 * (-1.9841270e-4f + f2 * 2.7557319e-6f))));
        const float c = 1.0f + f2 * (-0.5f + f2 * (4.1666667e-2f + f2 * (-1.3888889e-3f + f2 * (2.4801587e-5f + f2 * (-2.7557319e-7f)))));
        const int qi = ((int)q) & 3;
        const float sn = (qi == 0) ? s : (qi == 1) ? c : (qi == 2) ? -s : -c;
        const float cs = (qi == 0) ? c : (qi == 1) ? -s : (qi == 2) ? -c : s;
        tab[idx] = make_float2(cs, sn);
    }
}

__device__ __forceinline__ void norm_rows(const float* x, const float* g, bf16_t* h) {
    const int tid_ = opq(threadIdx.x); const int lane = tid_ & 63, wv = tid_ >> 6;
    f32x4 gg[8];
#pragma unroll
    for (int i = 0; i < 8; ++i) gg[i] = *(const f32x4*)(g + i * 256 + lane * 4);
    for (int row = (blockIdx.x * 8 + wv) * 2; row < MTOK; row += gridDim.x * 16) {
        const float* xr = x + (size_t)row * D; f32x4 v[8], u[8]; float ss = 0.f, st = 0.f;
#pragma unroll
        for (int i = 0; i < 8; ++i) { v[i] = *(const f32x4*)(xr + i * 256 + lane * 4); u[i] = *(const f32x4*)(xr + D + i * 256 + lane * 4); }
#pragma unroll
        for (int i = 0; i < 8; ++i) { ss += v[i][0] * v[i][0] + v[i][1] * v[i][1] + v[i][2] * v[i][2] + v[i][3] * v[i][3]; st += u[i][0] * u[i][0] + u[i][1] * u[i][1] + u[i][2] * u[i][2] + u[i][3] * u[i][3]; }
        ss = wave_sum(ss); st = wave_sum(st); const float r = rsqrtf(ss * (1.0f / D) + 1e-6f), r2 = rsqrtf(st * (1.0f / D) + 1e-6f);
#pragma unroll
        for (int i = 0; i < 8; ++i) {
            uint2 w; w.x = cvt_pk_nv(v[i][0] * r * gg[i][0], v[i][1] * r * gg[i][1]); w.y = cvt_pk_nv(v[i][2] * r * gg[i][2], v[i][3] * r * gg[i][3]);
            *(uint2*)(h + (size_t)row * D + i * 256 + lane * 4) = w;
            uint2 w2; w2.x = cvt_pk_nv(u[i][0] * r2 * gg[i][0], u[i][1] * r2 * gg[i][1]); w2.y = cvt_pk_nv(u[i][2] * r2 * gg[i][2], u[i][3] * r2 * gg[i][3]);
            *(uint2*)(h + (size_t)(row + 1) * D + i * 256 + lane * 4) = w2; }
    }
}

__device__ __forceinline__ void mix_rows(const float* x, const float* g, const float* mixw, bf16_t* mixbase, int tok0, LAS unsigned char* lds) {
    const int tid = opq(threadIdx.x), lane = tid & 63, wv = tid >> 6, c = tid * 4;
    LAS float* rs = (LAS float*)lds;
    const f32x4 gg = *(const f32x4*)(g + c); f32x4 mw[6];
#pragma unroll
    for (int m = 0; m < 6; ++m) mw[m] = *(const f32x4*)(mixw + m * D + c);
    for (int chunk = blockIdx.x; chunk < 256; chunk += gridDim.x) {
        const int rl0 = chunk * 32, tokc = tok0 + rl0; const bool hasprev = (tokc & (SEQ - 1)) != 0;
        __syncthreads();
        for (int r = wv; r < 33; r += 8) {
            float ss = 0.f;
            if (r > 0 || hasprev) { const float* xr = x + (size_t)(tokc - 1 + r) * D; f32x4 v[8];
#pragma unroll
                for (int i = 0; i < 8; ++i) v[i] = *(const f32x4*)(xr + i * 256 + lane * 4);
#pragma unroll
                for (int i = 0; i < 8; ++i) ss += v[i][0] * v[i][0] + v[i][1] * v[i][1] + v[i][2] * v[i][2] + v[i][3] * v[i][3]; }
            ss = wave_sum(ss);
            if (lane == 0) rs[r] = (r > 0 || hasprev) ? rsqrtf(ss * (1.0f / D) + 1e-6f) : 0.f;
        }
        __syncthreads();
        f32x4 prev = (f32x4){0.f, 0.f, 0.f, 0.f};
        if (hasprev) { const f32x4 pv = *(const f32x4*)(x + (size_t)(tokc - 1) * D + c); const float rp = rs[0]; prev = pv * rp * gg; }
        for (int r0 = 0; r0 < 32; r0 += 4) {
            f32x4 xv[4];
#pragma unroll
            for (int u = 0; u < 4; ++u) xv[u] = *(const f32x4*)(x + (size_t)(tokc + r0 + u) * D + c);
#pragma unroll
            for (int u = 0; u < 4; ++u) { const float rr = rs[r0 + u + 1]; const f32x4 hn = xv[u] * rr * gg, xx = prev - hn;
#pragma unroll
                for (int m = 0; m < 6; ++m) { const f32x4 o = hn + xx * mw[m];
                    uint2 w; w.x = cvt_pk_nv(o[0], o[1]); w.y = cvt_pk_nv(o[2], o[3]);
                    *(uint2*)(mixbase + (size_t)m * 8192 * D + (size_t)(rl0 + r0 + u) * D + c) = w; }
                prev = hn; }
        }
    }
}

__device__ __forceinline__ void conv_ssd(const Params& p) {
    const bf16_t* proj = (const bf16_t*)(p.ws + WS_PROJ); bf16_t* xbc = (bf16_t*)(p.ws + WS_XBC);
    const float* cw = p.in[6]; const float* cb = p.in[7];
    const int tid = opq(threadIdx.x);
    if (tid < 384) {
        const int c8 = tid % 192, par = tid / 192, c = c8 * 8;
        float w[4][8], bb[8];
#pragma unroll
        for (int j = 0; j < 4; ++j) { const f32x4 w0 = *(const f32x4*)(cw + j * 1536 + c), w1 = *(const f32x4*)(cw + j * 1536 + c + 4);
#pragma unroll
            for (int e = 0; e < 4; ++e) { w[j][e] = w0[e]; w[j][4 + e] = w1[e]; } }
        { const f32x4 b0 = *(const f32x4*)(cb + c), b1 = *(const f32x4*)(cb + c + 4);
#pragma unroll
          for (int e = 0; e < 4; ++e) { bb[e] = b0[e]; bb[4 + e] = b1[e]; } }
        for (int chunk = blockIdx.x; chunk < 256; chunk += gridDim.x) {
            const int t0 = chunk * 64 + par * 32; const bool hasprev = (t0 & (SEQ - 1)) != 0;
            float r0[8], r1[8], r2[8];
            if (hasprev) { const uint4 a = *(const uint4*)(proj + (size_t)(t0 - 3) * INWP + COL_XBC + c), b = *(const uint4*)(proj + (size_t)(t0 - 2) * INWP + COL_XBC + c), d = *(const uint4*)(proj + (size_t)(t0 - 1) * INWP + COL_XBC + c);
                unpack8(a, r0); unpack8(b, r1); unpack8(d, r2); }
            else {
#pragma unroll
                for (int e = 0; e < 8; ++e) { r0[e] = 0.f; r1[e] = 0.f; r2[e] = 0.f; } }
            for (int tg = 0; tg < 32; tg += 4) {
                uint4 rw[4];
#pragma unroll
                for (int u = 0; u < 4; ++u) rw[u] = *(const uint4*)(proj + (size_t)(t0 + tg + u) * INWP + COL_XBC + c);
#pragma unroll
                for (int u = 0; u < 4; ++u) { float cur[8], acc[8]; unpack8(rw[u], cur);
#pragma unroll
                    for (int e = 0; e < 8; ++e) { acc[e] = bb[e] + w[0][e] * r0[e] + w[1][e] * r1[e] + w[2][e] * r2[e] + w[3][e] * cur[e]; acc[e] = acc[e] * sigmoidf_(acc[e]); r0[e] = r1[e]; r1[e] = r2[e]; r2[e] = cur[e]; }
                    u32x4 o; o.x = cvt_pk_nv(acc[0], acc[1]); o.y = cvt_pk_nv(acc[2], acc[3]); o.z = cvt_pk_nv(acc[4], acc[5]); o.w = cvt_pk_nv(acc[6], acc[7]);
                    *(u32x4*)(xbc + (size_t)(t0 + tg + u) * 1536 + c) = o; }
            }
        }
    }
    float* dt = (float*)(p.ws + WS_DT); float* da = (float*)(p.ws + WS_DA);
    for (int idx = blockIdx.x * 512 + opq(threadIdx.x); idx < MTOK * 16; idx += gridDim.x * 512) {
        const int tok = idx >> 4, hh = idx & 15;
        const float v = bf2f(proj[(size_t)tok * INWP + COL_DT + hh]) + p.in[8][hh];
        const float d = fmaxf(v, 0.f) + __logf(1.0f + __expf(-fabsf(v)));
        dt[idx] = d; da[idx] = __expf(-d * __expf(p.in[9][hh]));
    }
}

__device__ __forceinline__ void ssd_scan_job(const Params& p, int job, LAS unsigned char* lds) {
    const int tid = opq(threadIdx.x);
    const int b = job >> 5, hs = (job >> 1) & 15, half = job & 1, grp = hs >> 3, p0 = half * 32;
    const bf16_t* xbc = (const bf16_t*)(p.ws + WS_XBC) + (size_t)b * SEQ * 1536;
    const float* dtp = (const float*)(p.ws + WS_DT) + (size_t)b * SEQ * 16 + hs;
    const float* dap = (const float*)(p.ws + WS_DA) + (size_t)b * SEQ * 16 + hs;
    float* yraw = (float*)(p.ws + WS_YRAW) + (size_t)b * SEQ * 1024 + hs * 64 + p0;
    const float dskip = p.in[10][hs];
    constexpr int BUF_F = 9280;
    LAS float* L = (LAS float*)lds;
    const bool producer = tid >= 256; const int ptid = tid & 255;
    int grow[5], gcol[5], loff[5];
#pragma unroll
    for (int k = 0; k < 5; ++k) { const int q = ptid + k * 256, row = q / 36, pc = q - row * 36; grow[k] = row;
        if (pc < 4) { gcol[k] = hs * 64 + p0 + pc * 8; loff[k] = row * 32 + pc * 8; }
        else if (pc < 20) { gcol[k] = 1024 + grp * 128 + (pc - 4) * 8; loff[k] = 1024 + row * 128 + (pc - 4) * 8; }
        else { gcol[k] = 1280 + grp * 128 + (pc - 20) * 8; loff[k] = 5120 + row * 128 + (pc - 20) * 8; } }
    uint4 rg[5]; float sc = 0.f;
#define SSD_ISSUE(t0) do { _Pragma("unroll") for (int k = 0; k < 5; ++k) if (ptid + k * 256 < 1152) rg[k] = *(const uint4*)(xbc + (size_t)((t0) + grow[k]) * 1536 + gcol[k]); \
        if (ptid < 32) sc = dtp[((t0) + ptid) * 16]; else if (ptid < 64) sc = dap[((t0) + ptid - 32) * 16]; } while (0)
#define SSD_COMMIT(buf) do { LAS float* Lc = L + (buf) * BUF_F; _Pragma("unroll") for (int k = 0; k < 5; ++k) if (ptid + k * 256 < 1152) { float f[8]; unpack8(rg[k], f); \
            *(LAS f32x4*)(Lc + loff[k]) = (f32x4){f[0], f[1], f[2], f[3]}; *(LAS f32x4*)(Lc + loff[k] + 4) = (f32x4){f[4], f[5], f[6], f[7]}; } \
        if (ptid < 32) Lc[9216 + ptid] = sc; else if (ptid < 64) Lc[9248 + ptid - 32] = sc; } while (0)
#define SSD_FLUSH(chp) do { LAS float* yo = L + 2 * BUF_F + ((chp) & 1) * 1024; const f32x4 v = *(LAS f32x4*)(yo + (ptid >> 3) * 32 + (ptid & 7) * 4); \
        *(f32x4*)(yraw + (size_t)((chp) * 32 + (ptid >> 3)) * 1024 + (ptid & 7) * 4) = v; } while (0)
    f32x2 hA[4], hB[4];
#pragma unroll
    for (int i = 0; i < 4; ++i) { hA[i] = (f32x2){0.f, 0.f}; hB[i] = (f32x2){0.f, 0.f}; }
    const int prow = (tid >> 4) & 15, nseg = tid & 15;
    __syncthreads();
    if (producer) { SSD_ISSUE(0); SSD_COMMIT(0); SSD_ISSUE(32); }
    __syncthreads();
    for (int ch = 0; ch < 64; ++ch) {
        const int cur = ch & 1;
        if (producer) {
            if (ch >= 1) SSD_FLUSH(ch - 1);
            if (ch + 1 < 64) SSD_COMMIT(cur ^ 1);
            if (ch + 2 < 64) SSD_ISSUE((ch + 2) * 32);
        } else {
        LAS float* Lb = L + cur * BUF_F; LAS float* yb = L + 2 * BUF_F + cur * 1024;
        for (int tg = 0; tg < 32; tg += 16) {
            float yA[16], yB[16];
            LAS float* qb = Lb + 1024 + tg * 128 + nseg * 8;
            f32x4 b0 = *(LAS f32x4*)(qb), b1 = *(LAS f32x4*)(qb + 4), c0 = *(LAS f32x4*)(qb + 4096), c1 = *(LAS f32x4*)(qb + 4100);
            float dA = Lb[9248 + tg], xa = Lb[tg * 32 + prow], xb = Lb[tg * 32 + prow + 16], dtv = Lb[9216 + tg];
#pragma unroll
            for (int tt = 0; tt < 16; ++tt) {
                f32x4 nb0, nb1, nc0, nc1; float ndA, nxa, nxb, ndtv;
                if (tt + 1 < 16) { LAS float* q = qb + (tt + 1) * 128; nb0 = *(LAS f32x4*)(q); nb1 = *(LAS f32x4*)(q + 4); nc0 = *(LAS f32x4*)(q + 4096); nc1 = *(LAS f32x4*)(q + 4100);
                    ndA = Lb[9248 + tg + tt + 1]; nxa = Lb[(tg + tt + 1) * 32 + prow]; nxb = Lb[(tg + tt + 1) * 32 + prow + 16]; ndtv = Lb[9216 + tg + tt + 1]; }
                __builtin_amdgcn_sched_barrier(0);
                const float xdta = xa * dtv, xdtb = xb * dtv;
                const f32x2 dA2 = (f32x2){dA, dA}, xa2 = (f32x2){xdta, xdta}, xb2 = (f32x2){xdtb, xdtb};
                hA[0] = hA[0] * dA2 + xa2 * b0.xy; hB[0] = hB[0] * dA2 + xb2 * b0.xy; hA[1] = hA[1] * dA2 + xa2 * b0.zw; hB[1] = hB[1] * dA2 + xb2 * b0.zw;
                hA[2] = hA[2] * dA2 + xa2 * b1.xy; hB[2] = hB[2] * dA2 + xb2 * b1.xy; hA[3] = hA[3] * dA2 + xa2 * b1.zw; hB[3] = hB[3] * dA2 + xb2 * b1.zw;
                f32x2 ya = hA[0] * c0.xy, yb2 = hB[0] * c0.xy; ya = hA[1] * c0.zw + ya; yb2 = hB[1] * c0.zw + yb2; ya = hA[2] * c1.xy + ya; yb2 = hB[2] * c1.xy + yb2; ya = hA[3] * c1.zw + ya; yb2 = hB[3] * c1.zw + yb2;
                float ra = ya.x + ya.y, rb = yb2.x + yb2.y;
                ra = dpp_add<0xB1>(ra); rb = dpp_add<0xB1>(rb); ra = dpp_add<0x4E>(ra); rb = dpp_add<0x4E>(rb); ra = dpp_add<0x141>(ra); rb = dpp_add<0x141>(rb); ra = dpp_add<0x140>(ra); rb = dpp_add<0x140>(rb);
                yA[tt] = ra + dskip * xa; yB[tt] = rb + dskip * xb;
                __builtin_amdgcn_sched_barrier(0);
                if (tt + 1 < 16) { b0 = nb0; b1 = nb1; c0 = nc0; c1 = nc1; dA = ndA; xa = nxa; xb = nxb; dtv = ndtv; }
            }
            if (nseg == 0) {
#pragma unroll
                for (int tt = 0; tt < 16; ++tt) { yb[(tg + tt) * 32 + prow] = yA[tt]; yb[(tg + tt) * 32 + prow + 16] = yB[tt]; } }
        }
        }
        __syncthreads();
    }
    if (producer) SSD_FLUSH(63);
#undef SSD_ISSUE
#undef SSD_COMMIT
#undef SSD_FLUSH
}

__device__ __forceinline__ void ssd_chunk_job(const Params& p, int job, LAS unsigned char* lds) {
    const int tid = opq(threadIdx.x), lane = tid & 63, w = tid >> 6, fr = lane & 15, fq = lane >> 4;
    const int b = job >> 5, hs = (job >> 1) & 15, half = job & 1, grp = hs >> 3, p0 = half * 32;
    const bf16_t* xbc = (const bf16_t*)(p.ws + WS_XBC) + (size_t)b * SEQ * 1536;
    const float* dtp = (const float*)(p.ws + WS_DT) + (size_t)b * SEQ * 16 + hs;
    float* yraw = (float*)(p.ws + WS_YRAW) + (size_t)b * SEQ * 1024 + hs * 64 + p0;
    const float dskip = p.in[10][hs], Ah = -__expf(p.in[9][hs]);
    constexpr int RS = 136;
    LAS bf16_t* Cs = (LAS bf16_t*)lds;
    LAS bf16_t* Bs = (LAS bf16_t*)(lds + 34816);
    LAS bf16_t* BTs = (LAS bf16_t*)(lds + 69632);
    LAS bf16_t* XTa = (LAS bf16_t*)(lds + 104448);
    LAS bf16_t* XTb = (LAS bf16_t*)(lds + 113152);
    LAS bf16_t* Ps = (LAS bf16_t*)(lds + 121856);
    LAS float* af = (LAS float*)(lds + 130560);
    LAS float* dtf = (LAS float*)(lds + 131584);
    const int crow0 = tid >> 4, cpc = tid & 15;
    const int xk = tid >> 2, xpc = tid & 3;
    u32x4 rc[4], rb[4], rx; float rdt = 0.f;
#define SC_ISSUE(t0) do { _Pragma("unroll") for (int i = 0; i < 4; ++i) { const bf16_t* rp_ = xbc + (size_t)((t0) + (crow0 + 32 * i)) * 1536 + grp * 128 + cpc * 8; rb[i] = *(const u32x4*)(rp_ + 1024); rc[i] = *(const u32x4*)(rp_ + 1280); } \
        rx = *(const u32x4*)(xbc + (size_t)((t0) + xk) * 1536 + hs * 64 + p0 + xpc * 8); if (tid < 128) rdt = dtp[((t0) + tid) * 16]; } while (0)
    f32x4 st[2];
    st[0] = (f32x4){0.f, 0.f, 0.f, 0.f}; st[1] = st[0];
    __syncthreads();
    for (int i = tid; i < 32 * RS / 2; i += 512) ((LAS unsigned*)Ps)[i] = 0u;
    SC_ISSUE(0);
    for (int ch = 0; ch < 16; ++ch) {
        const int t0 = ch * 128;
        __syncthreads();
#pragma unroll
        for (int i = 0; i < 4; ++i) { *(LAS u32x4*)(Cs + (crow0 + 32 * i) * RS + cpc * 8) = rc[i]; *(LAS u32x4*)(Bs + (crow0 + 32 * i) * RS + cpc * 8) = rb[i];

#pragma unroll
            for (int e = 0; e < 4; ++e) { BTs[(cpc * 8 + 2 * e) * RS + (crow0 + 32 * i)] = (bf16_t)(rb[i][e] & 0xffffu); BTs[(cpc * 8 + 2 * e + 1) * RS + (crow0 + 32 * i)] = (bf16_t)(rb[i][e] >> 16); } }
        float csv = 0.f;
        if (tid < 128) {
            csv = rdt * Ah; dtf[tid] = rdt;
#pragma unroll
            for (int off = 1; off < 64; off <<= 1) { const float t_ = __shfl_up(csv, off); if (lane >= off) csv += t_; }
            if (tid == 63) af[128] = csv;
        }
        float xr[8]; xr[0] = bflo(rx[0]); xr[1] = bfhi(rx[0]); xr[2] = bflo(rx[1]); xr[3] = bfhi(rx[1]); xr[4] = bflo(rx[2]); xr[5] = bfhi(rx[2]); xr[6] = bflo(rx[3]); xr[7] = bfhi(rx[3]);
        __syncthreads();
        if (tid < 128) af[tid] = (tid >= 64) ? csv + af[128] : csv;
        __syncthreads();
        const float cs_last = af[127];
        { const float d = dtf[xk], dout = __expf(cs_last - af[xk]);
#pragma unroll
          for (int e = 0; e < 8; ++e) { const float xa = xr[e] * d; XTa[(xpc * 8 + e) * RS + xk] = f2bf(xa); XTb[(xpc * 8 + e) * RS + xk] = f2bf(xa * dout); } }
        __syncthreads();
        bf16x8 cf[4];
#pragma unroll
        for (int ks = 0; ks < 4; ++ks) cf[ks] = *(LAS bf16x8*)(Cs + (w * 16 + fr) * RS + ks * 32 + fq * 8);
        f32x4 yo[2];
#pragma unroll
        for (int pt = 0; pt < 2; ++pt) { f32x4 acc = (f32x4){0.f, 0.f, 0.f, 0.f};
#pragma unroll
            for (int ks = 0; ks < 4; ++ks) { const bf16x8 pb = *(LAS bf16x8*)(Ps + (pt * 16 + fr) * RS + ks * 32 + fq * 8); acc = __builtin_amdgcn_mfma_f32_16x16x32_bf16(cf[ks], pb, acc, 0, 0, 0); }
            yo[pt] = acc; }
        float csq[4];
#pragma unroll
        for (int i = 0; i < 4; ++i) csq[i] = af[w * 16 + fq * 4 + i];
#pragma unroll
        for (int kt = 0; kt < 8; ++kt) { f32x4 acc = (f32x4){0.f, 0.f, 0.f, 0.f};
            if (kt > w) {
#pragma unroll
                for (int i = 0; i < 4; ++i) Cs[(w * 16 + fq * 4 + i) * RS + kt * 16 + fr] = (bf16_t)0;
                continue; }
#pragma unroll
            for (int ks = 0; ks < 4; ++ks) { const bf16x8 bb = *(LAS bf16x8*)(Bs + (kt * 16 + fr) * RS + ks * 32 + fq * 8); acc = __builtin_amdgcn_mfma_f32_16x16x32_bf16(cf[ks], bb, acc, 0, 0, 0); }
            const int kk = kt * 16 + fr; const float csk = af[kk];
#pragma unroll
            for (int i = 0; i < 4; ++i) { const int qq = w * 16 + fq * 4 + i; const float m = (kk <= qq) ? acc[i] * __expf(csq[i] - csk) : 0.f; Cs[qq * RS + kk] = f2bf(m); } }
        f32x4 yd[2];
        { bf16x8 mf[4];
#pragma unroll
          for (int ks = 0; ks < 4; ++ks) mf[ks] = *(LAS bf16x8*)(Cs + (w * 16 + fr) * RS + ks * 32 + fq * 8);
#pragma unroll
          for (int pt = 0; pt < 2; ++pt) { f32x4 acc = (f32x4){0.f, 0.f, 0.f, 0.f};
#pragma unroll
              for (int ks = 0; ks < 4; ++ks) { const bf16x8 xb = *(LAS bf16x8*)(XTa + (pt * 16 + fr) * RS + ks * 32 + fq * 8); acc = __builtin_amdgcn_mfma_f32_16x16x32_bf16(mf[ks], xb, acc, 0, 0, 0); }
              yd[pt] = acc; } }
        if (ch + 1 < 16) SC_ISSUE(t0 + 128);
#pragma unroll
        for (int pt = 0; pt < 2; ++pt)
#pragma unroll
            for (int i = 0; i < 4; ++i) { const int qq = w * 16 + fq * 4 + i, pp = pt * 16 + fr;
                const float xv = bf2f(xbc[(size_t)(t0 + qq) * 1536 + hs * 64 + p0 + pp]);
                yraw[(size_t)(t0 + qq) * 1024 + pp] = yd[pt][i] + __expf(csq[i]) * yo[pt][i] + dskip * xv; }
        __syncthreads();
        { const float cd = __expf(cs_last);
#pragma unroll
          for (int pt = 0; pt < 2; ++pt) { f32x4 acc = st[pt] * cd;
#pragma unroll
              for (int ks = 0; ks < 4; ++ks) { const bf16x8 xa = *(LAS bf16x8*)(XTb + (pt * 16 + fr) * RS + ks * 32 + fq * 8); const bf16x8 bt = *(LAS bf16x8*)(BTs + (w * 16 + fr) * RS + ks * 32 + fq * 8);
                  acc = __builtin_amdgcn_mfma_f32_16x16x32_bf16(xa, bt, acc, 0, 0, 0); }
              st[pt] = acc;
#pragma unroll
              for (int i = 0; i < 4; ++i) Ps[(pt * 16 + fq * 4 + i) * RS + w * 16 + fr] = f2bf(acc[i]); } }
    }
#undef SC_ISSUE
}

__device__ __forceinline__ void attn_job(const Params& p, int job, LAS unsigned char* lds) {
    const int tid = opq(threadIdx.x), lane = tid & 63, w = tid >> 6, fr = lane & 15, fq = lane >> 4;
    const int b = job >> 6, kvh = (job >> 4) & 3, nb = job & 15;
    const bf16_t* proj = (const bf16_t*)(p.ws + WS_PROJ) + (size_t)b * SEQ * INWP;
    const float2* rope = (const float2*)(p.ws + WS_ROPE);
    LAS bf16_t* Ks = (LAS bf16_t*)lds;
    LAS bf16_t* Vt = (LAS bf16_t*)(lds + 36864);
    LAS bf16_t* Ps = (LAS bf16_t*)(lds + 70656) + w * 16 * 264;
    __syncthreads();
    if (tid < 256) {
        const int kr = tid, tk = (nb - 1) * 128 + kr;
        if (tk >= 0) {
            const bf16_t* src = proj + (size_t)tk * INWP + COL_K + kvh * 64; float x[64]; float ss = 0.f;
#pragma unroll
            for (int c = 0; c < 8; ++c) { const uint4 r = *(const uint4*)(src + c * 8); float f[8]; unpack8(r, f);
#pragma unroll
                for (int e = 0; e < 8; ++e) { x[c * 8 + e] = f[e]; ss += f[e] * f[e]; } }
            const float rinv = rsqrtf(ss * (1.0f / 64) + 1e-6f); const float* kn = p.in[13];
#pragma unroll
            for (int i = 0; i < 64; ++i) x[i] = x[i] * rinv * kn[i];
#pragma unroll
            for (int c = 0; c < 4; ++c) { float o1[8], o2[8];
#pragma unroll
                for (int e = 0; e < 8; ++e) { const int i = c * 8 + e; const float2 cs = rope[tk * 32 + i]; o1[e] = x[i] * cs.x - x[i + 32] * cs.y; o2[e] = x[i + 32] * cs.x + x[i] * cs.y; }
                u32x4 w1, w2; w1.x = cvt_pk_bf16(o1[0], o1[1]); w1.y = cvt_pk_bf16(o1[2], o1[3]); w1.z = cvt_pk_bf16(o1[4], o1[5]); w1.w = cvt_pk_bf16(o1[6], o1[7]);
                w2.x = cvt_pk_bf16(o2[0], o2[1]); w2.y = cvt_pk_bf16(o2[2], o2[3]); w2.z = cvt_pk_bf16(o2[4], o2[5]); w2.w = cvt_pk_bf16(o2[6], o2[7]);
                *(LAS u32x4*)(Ks + kr * 72 + c * 8) = w1; *(LAS u32x4*)(Ks + kr * 72 + 32 + c * 8) = w2;
                __builtin_amdgcn_sched_barrier(0); }
        } else {
#pragma unroll
            for (int c = 0; c < 8; ++c) *(LAS u32x4*)(Ks + kr * 72 + c * 8) = (u32x4){0u, 0u, 0u, 0u};
        }
    } else {
        const int kr = tid - 256, tk = (nb - 1) * 128 + kr;
        const bf16_t* src = proj + (size_t)(tk < 0 ? 0 : tk) * INWP + COL_V + kvh * 64;
#pragma unroll
        for (int c = 0; c < 8; ++c) { uint4 r = *(const uint4*)(src + c * 8); if (tk < 0) r = make_uint4(0u, 0u, 0u, 0u);
            Vt[(c * 8 + 0) * 264 + kr] = (bf16_t)(r.x & 0xffffu); Vt[(c * 8 + 1) * 264 + kr] = (bf16_t)(r.x >> 16);
            Vt[(c * 8 + 2) * 264 + kr] = (bf16_t)(r.y & 0xffffu); Vt[(c * 8 + 3) * 264 + kr] = (bf16_t)(r.y >> 16);
            Vt[(c * 8 + 4) * 264 + kr] = (bf16_t)(r.z & 0xffffu); Vt[(c * 8 + 5) * 264 + kr] = (bf16_t)(r.z >> 16);
            Vt[(c * 8 + 6) * 264 + kr] = (bf16_t)(r.w & 0xffffu); Vt[(c * 8 + 7) * 264 + kr] = (bf16_t)(r.w >> 16); }
    }
    __syncthreads();
    const int tq = nb * 128 + w * 16 + fr;
    f32x4 csr[4]; f32x4 qn1[2], qn2[2];
#pragma unroll
    for (int e = 0; e < 4; ++e) csr[e] = *(const f32x4*)(rope + tq * 32 + fq * 8 + 2 * e);
    qn1[0] = *(const f32x4*)(p.in[12] + fq * 8); qn1[1] = *(const f32x4*)(p.in[12] + fq * 8 + 4); qn2[0] = *(const f32x4*)(p.in[12] + 32 + fq * 8); qn2[1] = *(const f32x4*)(p.in[12] + 32 + fq * 8 + 4);
    uint4 r0 = *(const uint4*)(proj + (size_t)tq * INWP + (kvh * 4) * 64 + fq * 8), r1 = *(const uint4*)(proj + (size_t)tq * INWP + (kvh * 4) * 64 + 32 + fq * 8);
    for (int h4 = 0; h4 < 4; ++h4) {
    const int hq = kvh * 4 + h4;
    bf16x8 qa[2];
    uint4 r0n = r0, r1n = r1;
    if (h4 + 1 < 4) { const bf16_t* srcn = proj + (size_t)tq * INWP + (hq + 1) * 64; r0n = *(const uint4*)(srcn + fq * 8); r1n = *(const uint4*)(srcn + 32 + fq * 8); }
    { float x1[8], x2[8]; unpack8(r0, x1); unpack8(r1, x2);
      float ss = 0.f;
#pragma unroll
      for (int e = 0; e < 8; ++e) ss += x1[e] * x1[e] + x2[e] * x2[e];
      ss += __shfl_xor(ss, 16); ss += __shfl_xor(ss, 32);
      const float rinv = rsqrtf(ss * (1.0f / 64) + 1e-6f) * 0.125f; float o1[8], o2[8];
#pragma unroll
      for (int e = 0; e < 8; ++e) { const float a = x1[e] * rinv * qn1[e >> 2][e & 3], c = x2[e] * rinv * qn2[e >> 2][e & 3]; const float cx = csr[e >> 1][(e & 1) * 2], sy = csr[e >> 1][(e & 1) * 2 + 1];
          o1[e] = a * cx - c * sy; o2[e] = c * cx + a * sy; }
      u32x4 w1, w2; w1.x = cvt_pk_bf16(o1[0], o1[1]); w1.y = cvt_pk_bf16(o1[2], o1[3]); w1.z = cvt_pk_bf16(o1[4], o1[5]); w1.w = cvt_pk_bf16(o1[6], o1[7]);
      w2.x = cvt_pk_bf16(o2[0], o2[1]); w2.y = cvt_pk_bf16(o2[2], o2[3]); w2.z = cvt_pk_bf16(o2[4], o2[5]); w2.w = cvt_pk_bf16(o2[6], o2[7]);
      qa[0] = __builtin_bit_cast(bf16x8, w1); qa[1] = __builtin_bit_cast(bf16x8, w2); }
    r0 = r0n; r1 = r1n;
    f32x4 s[16];
#pragma unroll
    for (int j = 0; j < 16; ++j) { f32x4 acc = (f32x4){0.f, 0.f, 0.f, 0.f};
#pragma unroll
        for (int ks = 0; ks < 2; ++ks) { const bf16x8 kb = *(LAS bf16x8*)(Ks + (j * 16 + fr) * 72 + ks * 32 + fq * 8); acc = __builtin_amdgcn_mfma_f32_16x16x32_bf16(qa[ks], kb, acc, 0, 0, 0); }
        s[j] = acc; }
    const float sink = p.in[14][hq];
    float mx[4], inv[4];
#pragma unroll
    for (int i = 0; i < 4; ++i) { const int qi = w * 16 + fq * 4 + i + 128; float m = -3.0e38f;
#pragma unroll
        for (int j = 0; j < 16; ++j) { const int kj = j * 16 + fr; const bool ok = (kj <= qi) && (qi - kj < 128) && (nb > 0 || kj >= 128); s[j][i] = ok ? s[j][i] : -3.0e38f; m = fmaxf(m, s[j][i]); }
        m = max16(m);
        m = fmaxf(m, sink); mx[i] = m; float l = 0.f;
#pragma unroll
        for (int j = 0; j < 16; ++j) { const float e = (s[j][i] > -1.0e38f) ? __expf(s[j][i] - m) : 0.f; s[j][i] = e; l += e; }
        l = red16(l);
        inv[i] = 1.0f / (l + __expf(sink - m)); }
#pragma unroll
    for (int j = 0; j < 16; ++j)
#pragma unroll
        for (int i = 0; i < 4; ++i) Ps[(fq * 4 + i) * 264 + j * 16 + fr] = f2bf(s[j][i] * inv[i]);
    f32x4 o[4];
#pragma unroll
    for (int nd = 0; nd < 4; ++nd) o[nd] = (f32x4){0.f, 0.f, 0.f, 0.f};
#pragma unroll
    for (int kk = 0; kk < 8; ++kk) { const bf16x8 pa = *(LAS bf16x8*)(Ps + fr * 264 + kk * 32 + fq * 8);
#pragma unroll
        for (int nd = 0; nd < 4; ++nd) { const bf16x8 vb = *(LAS bf16x8*)(Vt + (nd * 16 + fr) * 264 + kk * 32 + fq * 8); o[nd] = __builtin_amdgcn_mfma_f32_16x16x32_bf16(pa, vb, o[nd], 0, 0, 0); } }
    bf16_t* ymix = (bf16_t*)(p.ws + WS_YMIX) + (size_t)b * SEQ * D + hq * 64;
#pragma unroll
    for (int nd = 0; nd < 4; ++nd)
#pragma unroll
        for (int i = 0; i < 4; ++i) ymix[(size_t)(nb * 128 + w * 16 + fq * 4 + i) * D + nd * 16 + fr] = f2bf(o[nd][i]);
    }
}

__device__ __forceinline__ void post_ssd(const Params& p) {
    const int tid_ = opq(threadIdx.x); const int lane = tid_ & 63, wv = tid_ >> 6;
    const float* yraw = (const float*)(p.ws + WS_YRAW); const bf16_t* proj = (const bf16_t*)(p.ws + WS_PROJ); bf16_t* ymix = (bf16_t*)(p.ws + WS_YMIX);
    for (int it = blockIdx.x * 8 + wv; it < MTOK * 2; it += gridDim.x * 8) {
        const int tok = it >> 1, grp = it & 1, c = grp * 512 + lane * 8;
        const f32x4 y0 = *(const f32x4*)(yraw + (size_t)tok * 1024 + c), y1 = *(const f32x4*)(yraw + (size_t)tok * 1024 + c + 4);
        const uint4 zr = *(const uint4*)(proj + (size_t)tok * INWP + COL_Z + c); float z[8], y[8]; unpack8(zr, z); float ss = 0.f;
#pragma unroll
        for (int e = 0; e < 8; ++e) { const float yy = (e < 4 ? y0[e] : y1[e - 4]); y[e] = yy * z[e] * sigmoidf_(z[e]); ss += y[e] * y[e]; }
        ss = wave_sum(ss); const float r = rsqrtf(ss * (1.0f / 512) + 1e-6f);
        const f32x4 n0 = *(const f32x4*)(p.in[11] + c), n1 = *(const f32x4*)(p.in[11] + c + 4);
        u32x4 w; w.x = cvt_pk_nv(y[0] * r * n0[0], y[1] * r * n0[1]); w.y = cvt_pk_nv(y[2] * r * n0[2], y[3] * r * n0[3]);
        w.z = cvt_pk_nv(y[4] * r * n1[0], y[5] * r * n1[1]); w.w = cvt_pk_nv(y[6] * r * n1[2], y[7] * r * n1[3]);
        *(u32x4*)(ymix + (size_t)tok * D + 1024 + c) = w;
    }
}

__device__ __forceinline__ float half_sum(float v, bool lo) {
    (void)lo; v = red16(v); return v + __shfl_xor(v, 16); }
__device__ __forceinline__ void rwkv_scan_job(const Params& p, int job, LAS unsigned char* lds) {
    const int tid = opq(threadIdx.x), lane = tid & 63, l32 = lane & 31; const bool lo = lane < 32;
    const int b = job >> 5, hh = job & 31;
    LAS float* L = (LAS float*)lds;
    const bool producer = tid >= 256;
    const int pw = (tid >> 6) & 3;
    const int tl0 = 2 * pw + (lane >> 5);
    const size_t wbase = ((size_t)b * SEQ * D + hh * 64) / 2 + l32 + (size_t)tl0 * (D / 2);
    const unsigned* R32 = (const unsigned*)(p.ws + WS_R) + wbase; const unsigned* K32 = (const unsigned*)(p.ws + WS_K) + wbase; const unsigned* V32 = (const unsigned*)(p.ws + WS_V) + wbase;
    const unsigned* E32 = (const unsigned*)(p.ws + WS_WDEC) + wbase; const unsigned* A32 = (const unsigned*)(p.ws + WS_AA) + wbase; const unsigned* G32 = (const unsigned*)(p.ws + WS_GG) + wbase;
    unsigned* Y32 = (unsigned*)(p.ws + WS_YG) + wbase;
    const int ci = hh * 64 + 2 * l32;
    const float2 kkw = *(const float2*)(p.in[25] + ci), kaw = *(const float2*)(p.in[26] + ci), rkw = *(const float2*)(p.in[27] + ci), lnw = *(const float2*)(p.in[32] + ci), lnb = *(const float2*)(p.in[33] + ci);
    unsigned rw[2], kw[2], vw[2], ew[2], aw[2], gw[2];
    const int oo = tl0 * 64 + 2 * l32;
#define RW_ISSUE(t0) do { _Pragma("unroll") for (int i2 = 0; i2 < 2; ++i2) { const size_t off = (size_t)((t0) + 8 * i2) * (D / 2); rw[i2] = R32[off]; kw[i2] = K32[off]; vw[i2] = V32[off]; ew[i2] = E32[off]; aw[i2] = A32[off]; gw[i2] = G32[off]; } } while (0)
#define RW_COMMIT(buf) do { _Pragma("unroll") for (int i2 = 0; i2 < 2; ++i2) { LAS float* Lc = L + (buf) * 8192 + oo + i2 * 512; \
        const float r0_ = bflo(rw[i2]), r1_ = bfhi(rw[i2]), k0_ = bflo(kw[i2]), k1_ = bfhi(kw[i2]), v0_ = bflo(vw[i2]), v1_ = bfhi(vw[i2]), e0_ = bflo(ew[i2]), e1_ = bfhi(ew[i2]), a0_ = bflo(aw[i2]), a1_ = bfhi(aw[i2]), g0_ = bflo(gw[i2]), g1_ = bfhi(gw[i2]); \
        const float kkv0 = k0_ * kkw.x, kkv1 = k1_ * kkw.y; const float ssq = half_sum(kkv0 * kkv0 + kkv1 * kkv1, lo); const float rn = rsqrtf(fmaxf(ssq, 1e-24f)); const float kn0 = kkv0 * rn, kn1 = kkv1 * rn; \
        const float km0 = k0_ * (1.0f + (a0_ - 1.0f) * kaw.x), km1 = k1_ * (1.0f + (a1_ - 1.0f) * kaw.y); const float bonus = half_sum(r0_ * km0 * rkw.x + r1_ * km1 * rkw.y, lo); \
        *(LAS f32x2*)(Lc) = (f32x2){-kn0, -kn1}; *(LAS f32x2*)(Lc + 1024) = (f32x2){__expf(-e0_), __expf(-e1_)}; *(LAS f32x2*)(Lc + 2048) = (f32x2){kn0 * a0_, kn1 * a1_}; *(LAS f32x2*)(Lc + 3072) = (f32x2){km0, km1}; \
        *(LAS f32x2*)(Lc + 4096) = (f32x2){r0_, r1_}; *(LAS f32x2*)(Lc + 5120) = (f32x2){v0_, v1_}; *(LAS f32x2*)(Lc + 6144) = (f32x2){g0_, g1_}; *(LAS f32x2*)(Lc + 7168) = (f32x2){bonus * v0_, bonus * v1_}; } } while (0)
#define RW_OUTPUT(chp) do { LAS float* Lo = L + ((chp) & 1) * 8192; LAS float* yo = L + 16384 + ((chp) & 1) * 1024; _Pragma("unroll") for (int i2 = 0; i2 < 2; ++i2) { const int o2 = oo + i2 * 512; \
        const f32x2 y = *(LAS f32x2*)(yo + o2); \
        const float mu = half_sum(y.x + y.y, lo) * (1.0f / 64), d0 = y.x - mu, d1 = y.y - mu, var = half_sum(d0 * d0 + d1 * d1, lo) * (1.0f / 64), rs = rsqrtf(var + 64e-5f); \
        const f32x2 bv = *(LAS f32x2*)(Lo + 7168 + o2), gg = *(LAS f32x2*)(Lo + 6144 + o2); \
        Y32[(size_t)((chp) * 16 + 8 * i2) * (D / 2)] = cvt_pk_nv((d0 * rs * lnw.x + lnb.x + bv.x) * gg.x, (d1 * rs * lnw.y + lnb.y + bv.y) * gg.y); } } while (0)
    f32x2 SA[4], SB[4];
#pragma unroll
    for (int i = 0; i < 4; ++i) { SA[i] = (f32x2){0.f, 0.f}; SB[i] = (f32x2){0.f, 0.f}; }
    const int rp = (tid >> 3) & 31, ks = tid & 7;
    __syncthreads();
    if (producer) { RW_ISSUE(0); RW_COMMIT(0); RW_ISSUE(16); }
    __syncthreads();
    for (int ch = 0; ch < 128; ++ch) {
        const int cur = ch & 1;
        if (producer) {
            if (ch >= 1) RW_OUTPUT(ch - 1);
            if (ch + 1 < 128) RW_COMMIT(cur ^ 1);
            if (ch + 2 < 128) RW_ISSUE((ch + 2) * 16);
        } else {
            LAS float* Lb = L + cur * 8192; LAS float* yb = L + 16384 + cur * 1024;
            float yA[16], yB[16];
            LAS float* q0 = Lb + ks * 8;
            f32x4 a0 = *(LAS f32x4*)(q0), a1 = *(LAS f32x4*)(q0 + 4), w0 = *(LAS f32x4*)(q0 + 1024), w1 = *(LAS f32x4*)(q0 + 1028), b0 = *(LAS f32x4*)(q0 + 2048), b1 = *(LAS f32x4*)(q0 + 2052);
            f32x4 k0 = *(LAS f32x4*)(q0 + 3072), k1 = *(LAS f32x4*)(q0 + 3076), r0 = *(LAS f32x4*)(q0 + 4096), r1 = *(LAS f32x4*)(q0 + 4100);
            float va = Lb[5120 + rp], vb = Lb[5120 + rp + 32];
#pragma unroll
            for (int t = 0; t < 16; ++t) {
                f32x4 na0, na1, nw0, nw1, nb0, nb1, nk0, nk1, nr0, nr1; float nva, nvb;
                if (t + 1 < 16) { LAS float* q = q0 + (t + 1) * 64;
                    na0 = *(LAS f32x4*)(q); na1 = *(LAS f32x4*)(q + 4); nw0 = *(LAS f32x4*)(q + 1024); nw1 = *(LAS f32x4*)(q + 1028); nb0 = *(LAS f32x4*)(q + 2048); nb1 = *(LAS f32x4*)(q + 2052);
                    nk0 = *(LAS f32x4*)(q + 3072); nk1 = *(LAS f32x4*)(q + 3076); nr0 = *(LAS f32x4*)(q + 4096); nr1 = *(LAS f32x4*)(q + 4100); nva = Lb[5120 + (t + 1) * 64 + rp]; nvb = Lb[5120 + (t + 1) * 64 + rp + 32]; }
                __builtin_amdgcn_sched_barrier(0);
                f32x2 ca = SA[0] * a0.xy, cb = SB[0] * a0.xy; ca = SA[1] * a0.zw + ca; cb = SB[1] * a0.zw + cb; ca = SA[2] * a1.xy + ca; cb = SB[2] * a1.xy + cb; ca = SA[3] * a1.zw + ca; cb = SB[3] * a1.zw + cb;
                float sa = ca.x + ca.y, sb = cb.x + cb.y;
                sa = dpp_add<0xB1>(sa); sb = dpp_add<0xB1>(sb); sa = dpp_add<0x4E>(sa); sb = dpp_add<0x4E>(sb); sa = dpp_add<0x141>(sa); sb = dpp_add<0x141>(sb);
                const f32x2 sa2 = (f32x2){sa, sa}, sb2 = (f32x2){sb, sb}, va2 = (f32x2){va, va}, vb2 = (f32x2){vb, vb};
                SA[0] = SA[0] * w0.xy + (sa2 * b0.xy + va2 * k0.xy); SB[0] = SB[0] * w0.xy + (sb2 * b0.xy + vb2 * k0.xy);
                SA[1] = SA[1] * w0.zw + (sa2 * b0.zw + va2 * k0.zw); SB[1] = SB[1] * w0.zw + (sb2 * b0.zw + vb2 * k0.zw);
                SA[2] = SA[2] * w1.xy + (sa2 * b1.xy + va2 * k1.xy); SB[2] = SB[2] * w1.xy + (sb2 * b1.xy + vb2 * k1.xy);
                SA[3] = SA[3] * w1.zw + (sa2 * b1.zw + va2 * k1.zw); SB[3] = SB[3] * w1.zw + (sb2 * b1.zw + vb2 * k1.zw);
                f32x2 ya = SA[0] * r0.xy, yb2 = SB[0] * r0.xy; ya = SA[1] * r0.zw + ya; yb2 = SB[1] * r0.zw + yb2; ya = SA[2] * r1.xy + ya; yb2 = SB[2] * r1.xy + yb2; ya = SA[3] * r1.zw + ya; yb2 = SB[3] * r1.zw + yb2;
                float ra = ya.x + ya.y, rb = yb2.x + yb2.y;
                ra = dpp_add<0xB1>(ra); rb = dpp_add<0xB1>(rb); ra = dpp_add<0x4E>(ra); rb = dpp_add<0x4E>(rb); ra = dpp_add<0x141>(ra); rb = dpp_add<0x141>(rb);
                yA[t] = ra; yB[t] = rb;
                __builtin_amdgcn_sched_barrier(0);
                if (t + 1 < 16) { a0 = na0; a1 = na1; w0 = nw0; w1 = nw1; b0 = nb0; b1 = nb1; k0 = nk0; k1 = nk1; r0 = nr0; r1 = nr1; va = nva; vb = nvb; }
            }
            if (ks == 0) {
#pragma unroll
                for (int t = 0; t < 16; ++t) { yb[t * 64 + rp] = yA[t]; yb[t * 64 + rp + 32] = yB[t]; } }
        }
        __syncthreads();
    }
    if (producer) RW_OUTPUT(127);
#undef RW_ISSUE
#undef RW_COMMIT
#undef RW_OUTPUT
}

__device__ __forceinline__ void rwkv_chunk_job(const Params& p, int job, LAS unsigned char* lds) {
    const int tid = opq(threadIdx.x), lane = tid & 63, w = tid >> 6, fr = lane & 15, fq = lane >> 4, l32 = lane & 31; const bool lo = lane < 32;
    const int b = job >> 5, hh = job & 31;
    const int tl = 2 * w + (lane >> 5);
    const size_t wbase = ((size_t)b * SEQ * D + hh * 64) / 2 + l32 + (size_t)tl * (D / 2);
    const unsigned* R32 = (const unsigned*)(p.ws + WS_R) + wbase; const unsigned* K32 = (const unsigned*)(p.ws + WS_K) + wbase; const unsigned* V32 = (const unsigned*)(p.ws + WS_V) + wbase;
    const unsigned* E32 = (const unsigned*)(p.ws + WS_WDEC) + wbase; const unsigned* A32 = (const unsigned*)(p.ws + WS_AA) + wbase; const unsigned* G32 = (const unsigned*)(p.ws + WS_GG) + wbase;
    unsigned* Y32 = (unsigned*)(p.ws + WS_YG) + wbase;
    const int ci = hh * 64 + 2 * l32;
    const float2 kkw = *(const float2*)(p.in[25] + ci), kaw = *(const float2*)(p.in[26] + ci), rkw = *(const float2*)(p.in[27] + ci), lnw = *(const float2*)(p.in[32] + ci), lnb = *(const float2*)(p.in[33] + ci);
    LAS float* Av = (LAS float*)(lds + 0);
    LAS float* Bv = (LAS float*)(lds + 4096);
    LAS float* Km = (LAS float*)(lds + 8192);
    LAS float* Rr = (LAS float*)(lds + 12288);
    LAS float* ybuf = (LAS float*)(lds + 16384);
    LAS float* RHS = (LAS float*)(lds + 20480);
    LAS float* Aab = (LAS float*)(lds + 24832);
    LAS float* Wend = (LAS float*)(lds + 25856);
    LAS bf16_t* ET = (LAS bf16_t*)(lds + 26112);
    LAS bf16_t* VT = (LAS bf16_t*)(lds + 31232);
    LAS bf16_t* BtT = (LAS bf16_t*)(lds + 36352);
    LAS bf16_t* KtT = (LAS bf16_t*)(lds + 41472);
    LAS bf16_t* Ub = (LAS bf16_t*)(lds + 46592);
    LAS bf16_t* AakT = (LAS bf16_t*)(lds + 51712);
    LAS bf16_t* AbrT = (LAS bf16_t*)(lds + 52992);
    LAS bf16_t* AkrT = (LAS bf16_t*)(lds + 54272);
    LAS bf16_t* At = (LAS bf16_t*)(lds + 55552);
    LAS bf16_t* Bt = (LAS bf16_t*)(lds + 57856);
    LAS bf16_t* Kt = (LAS bf16_t*)(lds + 60160);
    LAS bf16_t* Rt = (LAS bf16_t*)(lds + 62464);
    LAS bf16_t* S0b = (LAS bf16_t*)(lds + 64768);
    LAS bf16_t* VT1 = (LAS bf16_t*)(lds + 73984);
    constexpr int LDS_END = 73984 + 64 * 40 * 2;
    __syncthreads();
    for (int i = tid; i < LDS_END / 4; i += 512) ((LAS unsigned*)lds)[i] = 0u;
    f32x4 stt[2]; stt[0] = (f32x4){0.f, 0.f, 0.f, 0.f}; stt[1] = stt[0];
    const int vt = w >> 1, kt0 = (w & 1) * 2;
    bf16x8 Lf;
#pragma unroll
    for (int e = 0; e < 8; ++e) { const int i = fq * 8 + e; Lf[e] = (i <= fr && i < 16) ? (short)0x3F80 : (short)0; }
    unsigned rw, kw, vw, ew, aw, gw;
#define RC_ISSUE(t0) do { const size_t off = (size_t)(t0) * (D / 2); rw = R32[off]; kw = K32[off]; vw = V32[off]; ew = E32[off]; aw = A32[off]; gw = G32[off]; } while (0)
#define RC_PREP(chn) do { \
        const float r0_ = bflo(rw), r1_ = bfhi(rw), k0_ = bflo(kw), k1_ = bfhi(kw), v0_ = bflo(vw), v1_ = bfhi(vw), a0_ = bflo(aw), a1_ = bfhi(aw); gn0 = bflo(gw); gn1 = bfhi(gw); \
        const unsigned ewc = ew, vwc = vw; \
        if ((chn) + 1 < 128) RC_ISSUE(((chn) + 1) * 16); \
        const float kkv0 = k0_ * kkw.x, kkv1 = k1_ * kkw.y; const float ssq = half_sum(kkv0 * kkv0 + kkv1 * kkv1, lo); const float rn = rsqrtf(fmaxf(ssq, 1e-24f)); const float kn0 = kkv0 * rn, kn1 = kkv1 * rn; \
        const float km0 = k0_ * (1.0f + (a0_ - 1.0f) * kaw.x), km1 = k1_ * (1.0f + (a1_ - 1.0f) * kaw.y); const float bonus = half_sum(r0_ * km0 * rkw.x + r1_ * km1 * rkw.y, lo); \
        bn0 = bonus * v0_; bn1 = bonus * v1_; \
        { const int o = tl * 64 + 2 * l32; LAS bf16_t* VTw = ((chn) & 1) ? VT1 : VT; \
          *(LAS f32x2*)(Av + o) = (f32x2){-kn0, -kn1}; *(LAS f32x2*)(Bv + o) = (f32x2){kn0 * a0_, kn1 * a1_}; *(LAS f32x2*)(Km + o) = (f32x2){km0, km1}; *(LAS f32x2*)(Rr + o) = (f32x2){r0_, r1_}; \
          ET[(2 * l32) * 40 + tl] = (bf16_t)(ewc & 0xffffu); ET[(2 * l32 + 1) * 40 + tl] = (bf16_t)(ewc >> 16); \
          VTw[(2 * l32) * 40 + tl] = (bf16_t)(vwc & 0xffffu); VTw[(2 * l32 + 1) * 40 + tl] = (bf16_t)(vwc >> 16); } } while (0)
    float gc0 = 0.f, gc1 = 0.f, bc0 = 0.f, bc1 = 0.f, gn0, gn1, bn0, bn1;
    RC_ISSUE(0);
    __syncthreads();
    RC_PREP(0); gc0 = gn0; gc1 = gn1; bc0 = bn0; bc1 = bn1;
    __syncthreads();
    for (int ch = 0; ch < 128; ++ch) {
        LAS bf16_t* VTc = (ch & 1) ? VT1 : VT;
        if (w < 4) {
            const bf16x8 eb = *(LAS bf16x8*)(ET + (w * 16 + fr) * 40 + fq * 8);
            f32x4 ec = (f32x4){0.f, 0.f, 0.f, 0.f}; ec = __builtin_amdgcn_mfma_f32_16x16x32_bf16(Lf, eb, ec, 0, 0, 0);
            const int kk = w * 16 + fr; unsigned bt_pk[2], kt_pk[2]; float btv[4], ktv[4];
#pragma unroll
            for (int i = 0; i < 4; ++i) { const int t = fq * 4 + i; const float et = bf2f(ET[kk * 40 + t]);
                const float Wt = __expf(-ec[i]), Wp = __expf(et - ec[i]), iW = __expf(ec[i]);
                const int o = t * 64 + kk;
                At[t * 72 + kk] = f2bf(Av[o] * Wp); Rt[t * 72 + kk] = f2bf(Rr[o] * Wt);
                btv[i] = Bv[o] * iW; ktv[i] = Km[o] * iW;
                Bt[t * 72 + kk] = f2bf(btv[i]); Kt[t * 72 + kk] = f2bf(ktv[i]);
                if (t == 15) Wend[kk] = Wt; }
            bt_pk[0] = cvt_pk_bf16(btv[0], btv[1]); bt_pk[1] = cvt_pk_bf16(btv[2], btv[3]); kt_pk[0] = cvt_pk_bf16(ktv[0], ktv[1]); kt_pk[1] = cvt_pk_bf16(ktv[2], ktv[3]);
            *(LAS u32x2*)(BtT + kk * 40 + fq * 4) = (u32x2){bt_pk[0], bt_pk[1]}; *(LAS u32x2*)(KtT + kk * 40 + fq * 4) = (u32x2){kt_pk[0], kt_pk[1]};
        }
        __syncthreads();
        if (w < 4) {
            LAS bf16_t* Xr = (w & 1) ? Kt : Bt; LAS bf16_t* Yr = (w & 2) ? Rt : At;
            f32x4 gacc = (f32x4){0.f, 0.f, 0.f, 0.f};
#pragma unroll
            for (int ks = 0; ks < 2; ++ks) { const bf16x8 xa = *(LAS bf16x8*)(Xr + fr * 72 + ks * 32 + fq * 8); const bf16x8 yb_ = *(LAS bf16x8*)(Yr + fr * 72 + ks * 32 + fq * 8); gacc = __builtin_amdgcn_mfma_f32_16x16x32_bf16(xa, yb_, gacc, 0, 0, 0); }
            float gm[4];
#pragma unroll
            for (int i = 0; i < 4; ++i) { const int j = fq * 4 + i; const bool keep = (w & 2) ? (j <= fr) : (j < fr); gm[i] = keep ? gacc[i] : 0.f; }
            if (w == 0) {
#pragma unroll
                for (int i = 0; i < 4; ++i) Aab[(fq * 4 + i) * 16 + fr] = gm[i]; }
            else { LAS bf16_t* dst = (w == 1) ? AakT : (w == 2) ? AbrT : AkrT; *(LAS u32x2*)(dst + fr * 40 + fq * 4) = (u32x2){cvt_pk_bf16(gm[0], gm[1]), cvt_pk_bf16(gm[2], gm[3])}; }
        }
        __syncthreads();
        f32x4 y0 = (f32x4){0.f, 0.f, 0.f, 0.f};
        { const int vtile = w & 3; LAS bf16_t* Yr = (w < 4) ? At : Rt; LAS bf16_t* Gt = (w < 4) ? AakT : AkrT;
#pragma unroll
          for (int ks = 0; ks < 2; ++ks) { const bf16x8 sa = *(LAS bf16x8*)(S0b + (vtile * 16 + fr) * 72 + ks * 32 + fq * 8); const bf16x8 yb_ = *(LAS bf16x8*)(Yr + fr * 72 + ks * 32 + fq * 8); y0 = __builtin_amdgcn_mfma_f32_16x16x32_bf16(sa, yb_, y0, 0, 0, 0); }
          { const bf16x8 va = *(LAS bf16x8*)(VTc + (vtile * 16 + fr) * 40 + fq * 8); const bf16x8 gb = *(LAS bf16x8*)(Gt + fr * 40 + fq * 8); y0 = __builtin_amdgcn_mfma_f32_16x16x32_bf16(va, gb, y0, 0, 0, 0); }
          if (w < 4) {
#pragma unroll
              for (int i = 0; i < 4; ++i) RHS[(vtile * 16 + fq * 4 + i) * 17 + fr] = y0[i]; } }
        __syncthreads();
        if (w == 0) {
            float u[16];
#pragma unroll
            for (int t = 0; t < 16; ++t) u[t] = RHS[lane * 17 + t];
#pragma unroll
            for (int t = 0; t < 15; ++t) {
#pragma unroll
                for (int t2 = t + 1; t2 < 16; ++t2) u[t2] += u[t] * Aab[t * 16 + t2]; }
            u32x4 o0, o1; o0.x = cvt_pk_bf16(u[0], u[1]); o0.y = cvt_pk_bf16(u[2], u[3]); o0.z = cvt_pk_bf16(u[4], u[5]); o0.w = cvt_pk_bf16(u[6], u[7]);
            o1.x = cvt_pk_bf16(u[8], u[9]); o1.y = cvt_pk_bf16(u[10], u[11]); o1.z = cvt_pk_bf16(u[12], u[13]); o1.w = cvt_pk_bf16(u[14], u[15]);
            *(LAS u32x4*)(Ub + lane * 40) = o0; *(LAS u32x4*)(Ub + lane * 40 + 8) = o1;
        }
        if (ch + 1 < 128) RC_PREP(ch + 1);
        __syncthreads();
        if (w >= 4) { const int vtile = w & 3;
            const bf16x8 ua = *(LAS bf16x8*)(Ub + (vtile * 16 + fr) * 40 + fq * 8); const bf16x8 gb = *(LAS bf16x8*)(AbrT + fr * 40 + fq * 8); y0 = __builtin_amdgcn_mfma_f32_16x16x32_bf16(ua, gb, y0, 0, 0, 0);
#pragma unroll
            for (int i = 0; i < 4; ++i) ybuf[fr * 64 + vtile * 16 + fq * 4 + i] = y0[i]; }
        { const bf16x8 ua = *(LAS bf16x8*)(Ub + (vt * 16 + fr) * 40 + fq * 8); const bf16x8 va = *(LAS bf16x8*)(VTc + (vt * 16 + fr) * 40 + fq * 8);
#pragma unroll
          for (int q = 0; q < 2; ++q) { const int kk = (kt0 + q) * 16 + fr;
              const bf16x8 bb = *(LAS bf16x8*)(BtT + kk * 40 + fq * 8); const bf16x8 kb = *(LAS bf16x8*)(KtT + kk * 40 + fq * 8);
              f32x4 acc = stt[q]; acc = __builtin_amdgcn_mfma_f32_16x16x32_bf16(ua, bb, acc, 0, 0, 0); acc = __builtin_amdgcn_mfma_f32_16x16x32_bf16(va, kb, acc, 0, 0, 0);
              const float we = Wend[kk]; acc = acc * we; stt[q] = acc;
#pragma unroll
              for (int i = 0; i < 4; ++i) S0b[(vt * 16 + fq * 4 + i) * 72 + kk] = f2bf(acc[i]); } }
        __syncthreads();
        { const f32x2 y = *(LAS f32x2*)(ybuf + tl * 64 + 2 * l32);
          const float mu = half_sum(y.x + y.y, lo) * (1.0f / 64), d0 = y.x - mu, d1 = y.y - mu, var = half_sum(d0 * d0 + d1 * d1, lo) * (1.0f / 64), rs = rsqrtf(var + 64e-5f);
          Y32[(size_t)(ch * 16) * (D / 2)] = cvt_pk_nv((d0 * rs * lnw.x + lnb.x + bc0) * gc0, (d1 * rs * lnw.y + lnb.y + bc1) * gc1); }
        gc0 = gn0; gc1 = gn1; bc0 = bn0; bc1 = bn1;
    }
#undef RC_ISSUE
#undef RC_PREP
}

#define XB_TMO      128
#define XB_XCNT(j)  (256  + 64 * (j))
#define XB_XSUB(j)  (1280 + 64 * (j))
#define XB_XGEN(j)  (2304 + 64 * (j))
#define XB_TOP      3328
#define XB_TOPGEN   3392
#define XCD_BAR_WORDS 3456
#define XB_SPIN_CAP (1u << 18)

__device__ __forceinline__ unsigned xb_ld(unsigned* p)              { return __hip_atomic_load(p, __ATOMIC_RELAXED, __HIP_MEMORY_SCOPE_AGENT); }
__device__ __forceinline__ unsigned xb_add(unsigned* p, unsigned v) { return __hip_atomic_fetch_add(p, v, __ATOMIC_RELAXED, __HIP_MEMORY_SCOPE_AGENT); }
__device__ __forceinline__ unsigned xb_xcc_id() { return (unsigned)__builtin_amdgcn_s_getreg((3 << 11) | 20) & 0xFu; }
#define XB_SPIN(cond, bar) do { unsigned _sp = 0; while (cond) { __builtin_amdgcn_s_sleep(1); \
    if ((++_sp & 255u) == 0u) { if (xb_ld(&(bar)[XB_TMO])) break; if (_sp > XB_SPIN_CAP) { atomicAdd(&(bar)[XB_TMO], 1u); break; } } } } while (0)

struct XcdBarrier {
    unsigned* bar; unsigned x;
    volatile LAS unsigned* st;
};

__device__ __forceinline__ XcdBarrier xcd_barrier_post(unsigned* bar, volatile LAS unsigned* st) {
    XcdBarrier b; b.bar = bar; b.x = xb_xcc_id(); b.st = st;
    if (threadIdx.x == 0) (void)xb_add(&bar[XB_XCNT(b.x)], 1u);
    return b;
}
__device__ __forceinline__ void xcd_barrier_complete(unsigned* bar, unsigned x, unsigned& nloc, unsigned& nx) {
    const unsigned G = gridDim.x * gridDim.y * gridDim.z;
    unsigned sum, cnt, mine, sp = 0u;
    for (;;) {
        sum = 0u; cnt = 0u; mine = 0u;
#pragma unroll
        for (unsigned j = 0; j < 16; ++j) { const unsigned c = xb_ld(&bar[XB_XCNT(j)]); sum += c; cnt += (c > 0u) ? 1u : 0u; mine = (j == x) ? c : mine; }
        if (sum == G) break;
        __builtin_amdgcn_s_sleep(1);
        if ((++sp & 255u) == 0u) { if (xb_ld(&bar[XB_TMO])) break; if (sp > XB_SPIN_CAP) { atomicAdd(&bar[XB_TMO], 1u); break; } }
    }
    nloc = mine > 0u ? mine : 1u; nx = cnt > 0u ? cnt : 1u;
}

__device__ __forceinline__ void xcd_barrier(const XcdBarrier& b) {
    asm volatile("s_waitcnt vmcnt(0)" ::: "memory");
    __syncthreads();
    if (threadIdx.x == 0) {
        unsigned* bar = b.bar;
        __builtin_amdgcn_s_waitcnt(0);
        unsigned nloc = b.st[0], nx = b.st[1];
        if (nloc == 0u) { xcd_barrier_complete(bar, b.x, nloc, nx); b.st[0] = nloc; b.st[1] = nx; }
        const unsigned old = xb_add(&bar[XB_XSUB(b.x)], 1u);
        const unsigned gen = old / nloc;
        if (old + 1u == (gen + 1u) * nloc) {
            __builtin_amdgcn_fence(__ATOMIC_RELEASE, "agent");
            asm volatile("s_waitcnt vmcnt(0)" ::: "memory");
            const unsigned og = xb_add(&bar[XB_TOP], 1u);
            const unsigned tg = og / nx;
            if (og + 1u == (tg + 1u) * nx) xb_add(&bar[XB_TOPGEN], 1u);
            else XB_SPIN(xb_ld(&bar[XB_TOPGEN]) == tg, bar);
            __builtin_amdgcn_fence(__ATOMIC_ACQUIRE, "agent");
            xb_add(&bar[XB_XGEN(b.x)], 1u);
            asm volatile("s_waitcnt vmcnt(0)" ::: "memory");
        } else {
            XB_SPIN(xb_ld(&bar[XB_XGEN(b.x)]) == gen, bar);
            __builtin_amdgcn_fence(__ATOMIC_ACQUIRE, "agent");
            asm volatile("s_waitcnt vmcnt(0)" ::: "memory");
        }
    }
    __syncthreads();
}


__global__ __launch_bounds__(512, 2) void mega(const Params p_arg) {
    extern __shared__ __attribute__((aligned(16))) unsigned char shm[];
    const Params& p = *(const Params*)(const void*)__builtin_amdgcn_kernarg_segment_ptr();
    LAS unsigned char* lds = (LAS unsigned char*)shm;
    const int G = (int)gridDim.x, bid = (int)blockIdx.x;
    __shared__ uint4 xb_words;
    if (threadIdx.x == 0) xb_words = make_uint4(0u, 0u, 0u, 0u);
    __syncthreads();
    (void)xcd_barrier_post((unsigned*)(p.ws + WS_BAR), (volatile LAS unsigned*)&xb_words);
    const int step_lo = p.step_lo, step_hi = p.step_hi;
    for (int s = step_lo; s < step_hi; ++s) {
        const int kind = p.kind[s], lo = p.lo[s], hi = p.hi[s];
        switch (kind) {
            case K_PRE0:
#ifndef NO_PRE
 convert_tiles(p, lo, hi, lds); rope_table(p); norm_rows(p.in[0], p.in[1], (bf16_t*)(p.ws + WS_H));
#endif
 break;
            case K_GEMMB:
#ifndef NO_GB

                { pg8::Gemm g; g.A = p.g[lo].A; g.Bt = p.g[lo].Bt; g.M = p.g[lo].M; g.N = p.g[lo].N; g.K = p.g[lo].K;
                  MultiOrder S; S.ops = &p.g[lo]; S.nops = hi - lo; S.G = G; S.c = bid;
                  EpiB E; E.ops = &p.g[lo];
                  pg8::gemm_phase<EpiB, MultiOrder, false>(lds, g, S, E, nullptr); }
                if (p.chi[s] > p.clo[s]) convert_queue(p, p.clo[s], p.chi[s], (unsigned*)(p.ws + WS_BAR + 16384) + 64 * p.cq[s], lds);
#endif
                break;
            case K_GEMMF:
#ifndef NO_GF

                for (int i = lo; i < hi; ++i) { const GemmOp& o = p.g[i]; pg8::Gemm g; g.A = o.A; g.Bt = o.Bt; g.M = o.M; g.N = o.N; g.K = o.K;
                    pg8::StaticOrder S; S.init(o.M, o.N, G, (bid + G - (o.rot % G)) % G);
                    EpiF E; E.C = (float*)o.out; E.ldc = o.ldc; E.res = o.res;
                    pg8::gemm_phase<EpiF, pg8::StaticOrder, false>(lds, g, S, E, nullptr); }
#endif
                break;
            case K_CONVSSD:
#ifndef NO_CONV
 conv_ssd(p);
#endif
 break;
            case K_MIX0:

#ifndef NO_SSD
for (int j = bid; j < 256; j += G) ssd_chunk_job(p, j, lds);
#endif


#ifndef NO_ATT
for (int j = bid; j < 512; j += G) attn_job(p, j, lds);
#endif

                break;
            case K_POST0: post_ssd(p); break;
            case K_NORM: norm_rows(p.out, p.in[2] + lo * D, (bf16_t*)(p.ws + WS_H)); break;
            case K_PRE1: convert_tiles(p, lo, hi, lds); mix_rows(p.out, p.in[1] + D, p.in[16], (bf16_t*)(p.ws + WS_MIX), 0, lds); break;
            case K_MIXES: mix_rows(p.out, p.in[1] + D, p.in[16], (bf16_t*)(p.ws + WS_MIX), 8192, lds); break;
            case K_RWKV:
#ifndef NO_RWKV
 for (int j = bid; j < 256; j += G) rwkv_chunk_job(p, j, lds);
#endif
 break;
            case K_NORMCONV: convert_tiles(p, lo, hi, lds); norm_rows(p.out, p.in[2] + D, (bf16_t*)(p.ws + WS_H)); break;
            default: break;
        }
        if (s + 1 < step_hi) { if (step_hi < 0) cg::this_grid().sync();   XcdBarrier xb; xb.bar = (unsigned*)(p.ws + WS_BAR); xb.x = xb_xcc_id(); xb.st = (volatile LAS unsigned*)&xb_words; xcd_barrier(xb); }
    }
}

#ifndef MK_MULTI
#define MK_MULTI 0
#endif
extern "C" void kernel_launch(void* const* d_in, const int* in_sizes, int n_in, void* d_out, int out_size, void* d_ws, size_t ws_size, hipStream_t stream) {
    static int grid = 0;
    if (grid == 0) {
        int dev = 0, cus = 0, per_cu = 0;
        hipGetDevice(&dev); hipDeviceGetAttribute(&cus, hipDeviceAttributeMultiprocessorCount, dev);
        if (hipFuncSetAttribute((const void*)mega, hipFuncAttributeMaxDynamicSharedMemorySize, LDS_BYTES) != hipSuccess) { fprintf(stderr, "hipFuncSetAttribute failed\n"); grid = -1; return; }
        if (hipOccupancyMaxActiveBlocksPerMultiprocessor(&per_cu, (const void*)mega, 512, LDS_BYTES) != hipSuccess || per_cu < 1) { fprintf(stderr, "occupancy query: %d\n", per_cu); per_cu = 1; }
        (void)hipGetLastError();
        grid = cus * per_cu; if (grid > 256) grid = 256;
        if (n_in != 34 || ws_size < 512 * MiB) { fprintf(stderr, "unexpected n_in %d / ws %zu\n", n_in, ws_size); grid = -1; return; }
    }
    if (grid < 0) return;
    static Params p;
    memset(&p, 0, sizeof(p));
    for (int i = 0; i < 34; ++i) p.in[i] = (const float*)d_in[i];
    p.out = (float*)d_out; p.ws = (unsigned char*)d_ws;
    unsigned char* ws = (unsigned char*)d_ws;
    auto B16 = [&](size_t off) { return (bf16_t*)(ws + off); };
    int ncj = 0, tile_acc = 0;
    auto CJ = [&](const float* src, size_t dst_off, int K, int N, int Kpad, int Npad) { ConvJob& c = p.cj[ncj++]; c.src = src; c.dst = B16(dst_off); c.K = K; c.N = N; c.Kpad = Kpad; c.Npad = Npad; c.tile0 = tile_acc; c.ntiles = (Kpad / 64) * (Npad / 256); tile_acc += c.ntiles; };
    const float* w_up = p.in[3]; const float* w_down = p.in[4];
    tile_acc = 0;
    CJ(p.in[5], WS_WBA, 2048, 4112, 2048, 4352); CJ(p.in[15], WS_WBA + 17 * MiB, 2048, 2048, 2048, 2048);
    tile_acc = 0;
    CJ(w_up, WS_WMLP, 2048, 8192, 2048, 8192); CJ(w_down, WS_WMLP + 32 * MiB, 8192, 2048, 8192, 2048);
    tile_acc = 0;
    CJ(p.in[28], WS_WBA, 2048, 2048, 2048, 2048); CJ(p.in[29], WS_WBA + 8 * MiB, 2048, 2048, 2048, 2048); CJ(p.in[30], WS_WBA + 16 * MiB, 2048, 2048, 2048, 2048); CJ(p.in[31], WS_WBA + 24 * MiB, 2048, 2048, 2048, 2048);
    CJ(p.in[18], WS_WBA + 32 * MiB, 2048, 96, 2048, 256); CJ(p.in[21], WS_WBA + 33 * MiB, 2048, 96, 2048, 256); CJ(p.in[23], WS_WBA + 34 * MiB, 2048, 256, 2048, 256);
    CJ(p.in[19], WS_WBA + 35 * MiB, 96, 2048, 256, 2048); CJ(p.in[22], WS_WBA + 36 * MiB, 96, 2048, 256, 2048); CJ(p.in[24], WS_WBA + 37 * MiB, 256, 2048, 256, 2048);
    tile_acc = 0;
    CJ(w_up + (size_t)2048 * 8192, WS_WMLP1, 2048, 8192, 2048, 8192); CJ(w_down + (size_t)2048 * 8192, WS_WMLP1 + 32 * MiB, 8192, 2048, 8192, 2048);
    int nop = 0;
    auto GO = [&](const bf16_t* A, const bf16_t* Bt, void* out, const float* bias, const float* res, int M, int N, int K, int ldc, int act, int rot) {
        GemmOp& o = p.g[nop++]; o.A = A; o.Bt = Bt; o.out = out; o.bias = bias; o.res = res; o.M = M; o.N = N; o.K = K; o.ldc = ldc; o.act = act; o.rot = rot; };
    GO(B16(WS_H), B16(WS_WBA), B16(WS_PROJ), nullptr, nullptr, MTOK, INWP, 2048, INWP, 0, 0);
    GO(B16(WS_YMIX), B16(WS_WBA + 17 * MiB), d_out, nullptr, p.in[0], MTOK, 2048, 2048, 2048, 0, 0);
    GO(B16(WS_H), B16(WS_WMLP), B16(WS_U), nullptr, nullptr, MTOK, DFF, 2048, DFF, 1, 0);
    GO(B16(WS_U), B16(WS_WMLP + 32 * MiB), d_out, nullptr, (const float*)d_out, MTOK, 2048, DFF, 2048, 0, 0);
    for (int half = 0; half < 2; ++half) {
        const size_t ro = (size_t)half * 8192 * 2048 * 2, lo_ = (size_t)half * 8192 * 256 * 2; const size_t mb = (size_t)8192 * 2048 * 2;
        GO(B16(WS_MIX + 0 * mb), B16(WS_WBA), B16(WS_R + ro), nullptr, nullptr, 8192, 2048, 2048, 2048, 0, 0);
        GO(B16(WS_MIX + 2 * mb), B16(WS_WBA + 8 * MiB), B16(WS_K + ro), nullptr, nullptr, 8192, 2048, 2048, 2048, 0, 0);
        GO(B16(WS_MIX + 3 * mb), B16(WS_WBA + 16 * MiB), B16(WS_V + ro), nullptr, nullptr, 8192, 2048, 2048, 2048, 0, 0);
        GO(B16(WS_MIX + 1 * mb), B16(WS_WBA + 32 * MiB), B16(WS_L1W + lo_), nullptr, nullptr, 8192, 256, 2048, 256, 2, 0);
        GO(B16(WS_MIX + 4 * mb), B16(WS_WBA + 33 * MiB), B16(WS_L1A + lo_), nullptr, nullptr, 8192, 256, 2048, 256, 0, 32);
        GO(B16(WS_MIX + 5 * mb), B16(WS_WBA + 34 * MiB), B16(WS_L1G + lo_), nullptr, nullptr, 8192, 256, 2048, 256, 3, 64);
    }
    GO(B16(WS_L1W), B16(WS_WBA + 35 * MiB), B16(WS_WDEC), p.in[17], nullptr, MTOK, 2048, 256, 2048, 4, 0);
    GO(B16(WS_L1A), B16(WS_WBA + 36 * MiB), B16(WS_AA), p.in[20], nullptr, MTOK, 2048, 256, 2048, 3, 0);
    GO(B16(WS_L1G), B16(WS_WBA + 37 * MiB), B16(WS_GG), nullptr, nullptr, MTOK, 2048, 256, 2048, 0, 0);
    GO(B16(WS_YG), B16(WS_WBA + 24 * MiB), d_out, nullptr, (const float*)d_out, MTOK, 2048, 2048, 2048, 0, 0);
    GO(B16(WS_H), B16(WS_WMLP1), B16(WS_U), nullptr, nullptr, MTOK, DFF, 2048, DFF, 1, 0);
    GO(B16(WS_U), B16(WS_WMLP1 + 32 * MiB), d_out, nullptr, (const float*)d_out, MTOK, 2048, DFF, 2048, 0, 0);
    int ns = 0;
    auto ST = [&](int kind, int lo, int hi, int clo = 0, int chi = 0, int cq = 0) { p.kind[ns] = kind; p.lo[ns] = lo; p.hi[ns] = hi; p.clo[ns] = clo; p.chi[ns] = chi; p.cq[ns] = cq; ++ns; };
    ST(K_PRE0, 0, 2); ST(K_GEMMB, 0, 1, 2, 4, 0); ST(K_CONVSSD, 0, 0); ST(K_MIX0, 0, 0); ST(K_POST0, 0, 0); ST(K_GEMMF, 1, 2); ST(K_NORM, 0, 0); ST(K_GEMMB, 2, 3); ST(K_GEMMF, 3, 4);
    ST(K_PRE1, 4, 14); ST(K_GEMMB, 4, 10, 14, 16, 1); ST(K_MIXES, 0, 0); ST(K_GEMMB, 10, 16, 14, 16, 1); ST(K_GEMMB, 16, 19); ST(K_RWKV, 0, 0); ST(K_GEMMF, 19, 20); ST(K_NORM, 1, 0); ST(K_GEMMB, 20, 21); ST(K_GEMMF, 21, 22);
    (void)hipMemsetAsync(ws + WS_BAR, 0, 16384 + 1024, stream);
#if MK_MULTI
    for (int s = 0; s < ns; ++s) { p.step_lo = s; p.step_hi = s + 1; hipLaunchKernelGGL(mega, dim3(grid), dim3(512), LDS_BYTES, stream, p); }
#else
    p.step_lo = 0; p.step_hi = ns;
    void* args[] = {(void*)&p};
    const hipError_t e = hipLaunchCooperativeKernel((const void*)mega, dim3(grid), dim3(512), args, LDS_BYTES, stream);
    if (e != hipSuccess) fprintf(stderr, "cooperative launch failed: %s (grid %d)\n", hipGetErrorString(e), grid);
#endif
}
```

```cpp
#include <hip/hip_runtime.h>
#include <hip/hip_cooperative_groups.h>
#include <cstdio>
#include <cstring>
namespace cg = cooperative_groups;
__device__ __forceinline__ int opq(int v) { asm volatile("" : "+v"(v)); return v; }
namespace pg8 {
#define PG8_LAS __attribute__((address_space(3)))
typedef unsigned short bf16_t;
typedef short bf16x8 __attribute__((ext_vector_type(8)));
typedef float f32x4 __attribute__((ext_vector_type(4)));
typedef unsigned u32x4 __attribute__((ext_vector_type(4)));
constexpr int BM = 256, BK = 64, HALF = 128, HTB = HALF * BK * 2  , STAGE_BYTES = 8 * HTB, NXCD = 8, WGM = 8;

__host__ __device__ __forceinline__ int lds_byte(int r, int c) { const int st = (r >> 4) * 2 + (c >> 5), rr = r & 15, cc = c & 31, ob = rr * 64 + cc * 2; return st * 1024 + (ob ^ (((ob >> 9) & 1) << 5)); }
__host__ __device__ __forceinline__ void stage_rc(int b, int& R, int& C) { const int st = b / 1024, sb = b % 1024, swz = sb ^ (((sb >> 9) & 1) << 5); R = (st >> 1) * 16 + swz / 64; C = (st & 1) * 32 + (swz % 64) / 2; }
__host__ __device__ __forceinline__ int perm32(int rho) { const int n = rho >> 4, i = rho & 15; return 8 * (i >> 2) + 4 * n + (i & 3); }

struct Unit { int pm, pn, op; };
struct Gemm { const bf16_t* A; const bf16_t* Bt; int M, N, K; };

struct StaticOrder {
    int nM, nN, nwg, G, c;
    __host__ __device__ void init(int M, int N, int G_, int c_) { nM = M / BM; nN = N / BM; nwg = nM * nN; G = G_; c = c_; }
    __host__ __device__ bool next(int i, Unit& u) const {
        const long L = (long)i * G + c; if (L >= nwg) return false;
        int wgid = (int)L; { const int q = nwg / NXCD, r = nwg % NXCD, xcd = wgid % NXCD, off = wgid / NXCD; wgid = (xcd < r ? xcd * (q + 1) : r * (q + 1) + (xcd - r) * q) + off; }
        const int nig = WGM * nN, gid = wgid / nig, fm = gid * WGM, gsz = (nM - fm) < WGM ? (nM - fm) : WGM;
        u.pm = fm + ((wgid % nig) % gsz); u.pn = (wgid % nig) / gsz; u.op = 0; return true;
    }
    __device__ __forceinline__ const char* abase(const Unit&, const Gemm& g) const { return (const char*)g.A; }
    __device__ __forceinline__ const char* bbase(const Unit&, const Gemm& g) const { return (const char*)g.Bt; }
    __device__ __forceinline__ void a_ready(const Unit&) const {}
    __device__ __forceinline__ void done(const Unit&) const {}
};
typedef __bf16 bf16x2_t __attribute__((ext_vector_type(2)));
typedef float f32x2_t __attribute__((ext_vector_type(2)));
__device__ __forceinline__ unsigned cvt_pk_bf16(float lo, float hi) { const f32x2_t f = {lo, hi}; const bf16x2_t v = __builtin_convertvector(f, bf16x2_t); return __builtin_bit_cast(unsigned, v); }
__device__ __forceinline__ unsigned cvt_pk_nv(float lo, float hi) { return cvt_pk_bf16(lo, hi); }

template <class Epi, class Sched, bool STAMP = false>
__device__ __forceinline__ void gemm_phase(PG8_LAS unsigned char* lds, const Gemm g, const Sched& S, const Epi& E, unsigned long long* stamps) {
    const int tid = opq(threadIdx.x), wid = __builtin_amdgcn_readfirstlane(tid >> 6), lane = tid & 63, wr = wid >> 2, wc = wid & 3, fr = lane & 15, fq = lane >> 4;
    const int K = g.K, nt = K / BK;
    int ts_lo = 0, ts_hi = 0, nts = 0; const unsigned long long rt_entry = STAMP ? (unsigned long long)wall_clock64() : 0ull;
#define PG8_STAMP() do { if (STAMP && wid == 0 && nts < 64) { const unsigned long long _c = (unsigned long long)clock64(); \
        ts_lo = (lane == nts) ? (int)(unsigned)_c : ts_lo; ts_hi = (lane == nts) ? (int)(unsigned)(_c >> 32) : ts_hi; ++nts; } } while (0)
    PG8_STAMP();
    unsigned voffA[2], voffB[2];
#pragma unroll
    for (int i = 0; i < 2; ++i) { int R, C; stage_rc(tid * 16 + i * 8192, R, C); const int Rb = Epi::PERM ? ((R & ~31) + perm32(R & 31)) : R;
        voffA[i] = (unsigned)(R * K + C) * 2u; voffB[i] = (unsigned)(Rb * K + C) * 2u; }
    const size_t kstep = (size_t)(BK * 2);
    const size_t hstep = (size_t)HALF * K * 2;
    const size_t tstep = 2 * hstep;
    const unsigned ldsw = (unsigned)wid * 1024u;
    const int aoff = lds_byte(wr * 64 + fr, fq * 8), boff = lds_byte(wc * 32 + fr, fq * 8);
#define PG8_SA(b, h) (((b) * 2 + (h)) * HTB)
#define PG8_SB(b, h) ((4 + (b) * 2 + (h)) * HTB)
#define PG8_STAGE(bufoff, gbase, voff) do { _Pragma("unroll") for (int _i = 0; _i < 2; ++_i) \
        __builtin_amdgcn_global_load_lds((const unsigned*)((const char*)(gbase) + (voff)[_i]), (PG8_LAS unsigned*)(lds + (bufoff) + ldsw + _i * 8192), 16, 0, 0); } while (0)
#define PG8_LDA(dst, b, h) do { _Pragma("unroll") for (int m = 0; m < 4; ++m) _Pragma("unroll") for (int k = 0; k < 2; ++k) dst[m][k] = *(const PG8_LAS bf16x8*)(lds + PG8_SA(b, h) + aoff + m * 2048 + k * 1024); } while (0)
#define PG8_LDB(dst, b, h) do { _Pragma("unroll") for (int n = 0; n < 2; ++n) _Pragma("unroll") for (int k = 0; k < 2; ++k) dst[n][k] = *(const PG8_LAS bf16x8*)(lds + PG8_SB(b, h) + boff + n * 2048 + k * 1024); } while (0)
#define PG8_MMA(ai, bj, At, Bt) do { __builtin_amdgcn_s_setprio(1); _Pragma("unroll") for (int m = 0; m < 4; ++m) _Pragma("unroll") for (int n = 0; n < 2; ++n) _Pragma("unroll") for (int k = 0; k < 2; ++k) \
        acc[ai][bj][m][n] = __builtin_amdgcn_mfma_f32_16x16x32_bf16(Bt[n][k], At[m][k], acc[ai][bj][m][n], 0, 0, 0); __builtin_amdgcn_s_setprio(0); } while (0)
#define PG8_WAIT_V(n) asm volatile("s_waitcnt vmcnt(" #n ")" ::: "memory")
#define PG8_WAIT_L(n) asm volatile("s_waitcnt lgkmcnt(" #n ")" ::: "memory")
#define PG8_BAR __builtin_amdgcn_s_barrier()
#define PG8_SCHED __builtin_amdgcn_sched_barrier(0)
    Unit cur, nxt; int ui = 0;
    if (!S.next(0, cur)) return;
    f32x4 acc[2][2][4][2];
#pragma unroll
    for (int a = 0; a < 2; ++a)
#pragma unroll
        for (int b = 0; b < 2; ++b)
#pragma unroll
            for (int m = 0; m < 4; ++m)
#pragma unroll
                for (int n = 0; n < 2; ++n) acc[a][b][m][n] = (f32x4){0.f, 0.f, 0.f, 0.f};
    bf16x8 At[4][2], B0[2][2], B1[2][2];
    const char* cA = S.abase(cur, g) + (size_t)cur.pm * tstep; const char* cB = S.bbase(cur, g) + (size_t)cur.pn * tstep;
    S.a_ready(cur);
    PG8_STAGE(PG8_SB(0, 0), cB, voffB); PG8_STAGE(PG8_SA(0, 0), cA, voffA); PG8_STAGE(PG8_SB(0, 1), cB + hstep, voffB); PG8_STAGE(PG8_SA(0, 1), cA + hstep, voffA);
    if (wr == 1) PG8_BAR;
    PG8_WAIT_V(4); PG8_BAR;
    PG8_STAGE(PG8_SB(1, 0), cB + kstep, voffB); PG8_STAGE(PG8_SA(1, 0), cA + kstep, voffA); PG8_STAGE(PG8_SB(1, 1), cB + hstep + kstep, voffB);
    PG8_WAIT_V(6); PG8_BAR;
    PG8_STAMP();
    for (;;) {
        const bool has_next = S.next(ui + 1, nxt);
        const char* nA = has_next ? S.abase(nxt, g) + (size_t)nxt.pm * tstep : cA; const char* nB = has_next ? S.bbase(nxt, g) + (size_t)nxt.pn * tstep : cB;
        for (int t = 0; t < nt; t += 2) {
            const bool last = (t == nt - 2);
            const char* a1 = cA + (size_t)(t + 1) * kstep;
            const char* a2 = last ? nA : cA + (size_t)(t + 2) * kstep; const char* b2 = last ? nB : cB + (size_t)(t + 2) * kstep;
            const char* a3 = a2 + kstep; const char* b3 = b2 + kstep;
            if (last && has_next) S.a_ready(nxt);
            PG8_LDB(B0, 0, 0); PG8_SCHED; PG8_LDA(At, 0, 0); PG8_STAGE(PG8_SA(1, 1), a1 + hstep, voffA);
            PG8_WAIT_L(8); PG8_BAR; PG8_WAIT_L(0); PG8_MMA(0, 0, At, B0); PG8_BAR; PG8_SCHED;
            PG8_LDB(B1, 0, 1); PG8_STAGE(PG8_SB(0, 0), b2, voffB);
            PG8_BAR; PG8_WAIT_L(0); PG8_MMA(0, 1, At, B1); PG8_BAR;
            PG8_LDA(At, 0, 1); PG8_STAGE(PG8_SA(0, 0), a2, voffA);
            PG8_BAR; PG8_WAIT_L(0); PG8_MMA(1, 0, At, B0); PG8_BAR; PG8_SCHED;
            PG8_STAGE(PG8_SB(0, 1), b2 + hstep, voffB);
            PG8_WAIT_V(6); PG8_BAR; PG8_MMA(1, 1, At, B1); PG8_BAR;
            PG8_LDB(B0, 1, 0); PG8_SCHED; PG8_LDA(At, 1, 0); PG8_STAGE(PG8_SA(0, 1), a2 + hstep, voffA);
            PG8_WAIT_L(8); PG8_BAR; PG8_WAIT_L(0); PG8_MMA(0, 0, At, B0); PG8_BAR; PG8_SCHED;
            PG8_LDB(B1, 1, 1); PG8_STAGE(PG8_SB(1, 0), b3, voffB);
            PG8_BAR; PG8_WAIT_L(0); PG8_MMA(0, 1, At, B1); PG8_BAR;
            PG8_LDA(At, 1, 1); PG8_STAGE(PG8_SA(1, 0), a3, voffA);
            PG8_BAR; PG8_WAIT_L(0); PG8_MMA(1, 0, At, B0); PG8_BAR; PG8_SCHED;
            PG8_STAGE(PG8_SB(1, 1), b3 + hstep, voffB);
            PG8_WAIT_V(6); PG8_BAR; PG8_MMA(1, 1, At, B1); PG8_BAR;
        }
        PG8_STAMP();
        if constexpr (!Epi::AFTER_DRAIN) { E(acc, cur, wr, wc, fr, fq); S.done(cur); }
        PG8_STAMP();
        if (!has_next) break;
#pragma unroll
        for (int a = 0; a < 2; ++a)
#pragma unroll
            for (int b = 0; b < 2; ++b)
#pragma unroll
                for (int m = 0; m < 4; ++m)
#pragma unroll
                    for (int n = 0; n < 2; ++n) acc[a][b][m][n] = (f32x4){0.f, 0.f, 0.f, 0.f};
        cur = nxt; cA = nA; cB = nB; ++ui;
    }
    PG8_WAIT_V(0);
    if (wr == 0) PG8_BAR;
    PG8_BAR;
    if constexpr (Epi::AFTER_DRAIN) { E.fused(acc, cur, wr, wc, fr, fq, lds, wid, lane); S.done(cur); }
    PG8_STAMP();
    if (STAMP && wid == 0) { stamps[lane] = lane < nts ? (((unsigned long long)(unsigned)ts_hi << 32) | (unsigned)ts_lo) : 0ull;
        if (lane == 62) stamps[62] = rt_entry; if (lane == 63) stamps[63] = (unsigned long long)wall_clock64(); }
#undef PG8_STAMP
#undef PG8_SA
#undef PG8_SB
#undef PG8_STAGE
#undef PG8_LDA
#undef PG8_LDB
#undef PG8_MMA
#undef PG8_WAIT_V
#undef PG8_WAIT_L
#undef PG8_BAR
#undef PG8_SCHED
}
}

#include <cstdio>
#include <ctime>
#include <cstdlib>
#include <cstring>
#include <cmath>
#include <vector>
#include <algorithm>
#define CK(x) do { hipError_t e_ = (x); if (e_ != hipSuccess) { fprintf(stderr, "HIP %s:%d %s\n", __FILE__, __LINE__, hipGetErrorString(e_)); exit(2); } } while (0)
using pg8::bf16_t; using pg8::bf16x8; using pg8::f32x4; using pg8::u32x4; using pg8::cvt_pk_bf16; using pg8::cvt_pk_nv;
#define LAS PG8_LAS

constexpr int D = 2048, SEQ = 2048, MTOK = 16384, DFF = 8192, INWP = 4352;
constexpr int COL_K = 1024, COL_V = 1280, COL_Z = 1536, COL_XBC = 2560, COL_DT = 4096;
constexpr size_t MiB = (size_t)1 << 20;
constexpr size_t WS_WBA = 0, WS_WMLP = 40 * MiB, WS_H = 104 * MiB, WS_PROJ = 168 * MiB, WS_YMIX = 304 * MiB, WS_YRAW = 368 * MiB, WS_XBC = 432 * MiB,
                 WS_DT = 480 * MiB, WS_DA = 481 * MiB, WS_ROPE = 482 * MiB, WS_U = 168 * MiB;
constexpr size_t WS_R = 40 * MiB, WS_K = 104 * MiB, WS_V = 168 * MiB, WS_L1W = 232 * MiB, WS_L1A = 240 * MiB, WS_L1G = 248 * MiB, WS_MIX = 256 * MiB,
                 WS_WDEC = 256 * MiB, WS_AA = 320 * MiB, WS_GG = 384 * MiB, WS_YG = 40 * MiB  , WS_WMLP1 = 448 * MiB;
constexpr size_t WS_BAR = 39 * MiB;
constexpr int LDS_BYTES = 140 * 1024;

enum { K_PRE0 = 0, K_GEMMB, K_GEMMF, K_CONVSSD, K_MIX0, K_POST0, K_NORM, K_PRE1, K_MIXES, K_RWKV, K_NORMCONV };
constexpr int NSTEPS = 48, NOPS = 22, NCJ = 16;
#define REP_GEMMB 1
#define REP_MIX0 1
#define REP_RWKV 1
#define REP_ELEM 1

struct GemmOp { const bf16_t* A; const bf16_t* Bt; void* out; const float* bias; const float* res; int M, N, K, ldc, act, rot, pad0, pad1; };
struct ConvJob { const float* src; bf16_t* dst; int K, N, Kpad, Npad, tile0, ntiles; };
struct Params {
    const float* in[34];
    float* out; unsigned char* ws;
    GemmOp g[NOPS];
    ConvJob cj[NCJ];
    int kind[NSTEPS + 1]; int lo[NSTEPS + 1]; int hi[NSTEPS + 1]; int clo[NSTEPS + 1]; int chi[NSTEPS + 1]; int cq[NSTEPS + 1];
    int step_lo, step_hi;
};

__device__ __forceinline__ float bf2f(unsigned short b) { return __uint_as_float(((unsigned)b) << 16); }
__device__ __forceinline__ float bflo(unsigned w) { return __uint_as_float(w << 16); }
__device__ __forceinline__ float bfhi(unsigned w) { return __uint_as_float(w & 0xffff0000u); }
__device__ __forceinline__ bf16_t f2bf(float f) { return (bf16_t)(cvt_pk_bf16(f, 0.f) & 0xffffu); }
template <int CTRL> __device__ __forceinline__ float dpp_add(float x) {
    const int y = __builtin_amdgcn_update_dpp(0, __builtin_bit_cast(int, x), CTRL, 0xf, 0xf, true);
    return x + __builtin_bit_cast(float, y); }
template <int CTRL> __device__ __forceinline__ float dpp_max(float x) {
    const int y = __builtin_amdgcn_update_dpp(0, __builtin_bit_cast(int, x), CTRL, 0xf, 0xf, true);
    return fmaxf(x, __builtin_bit_cast(float, y)); }
__device__ __forceinline__ float max16(float x) { x = dpp_max<0xB1>(x); x = dpp_max<0x4E>(x); x = dpp_max<0x141>(x); x = dpp_max<0x140>(x); return x; }
__device__ __forceinline__ float red8(float x) { x = dpp_add<0xB1>(x); x = dpp_add<0x4E>(x); x = dpp_add<0x141>(x); return x; }
__device__ __forceinline__ float red16(float x) { x = red8(x); x = dpp_add<0x140>(x); return x; }
__device__ __forceinline__ float wave_sum(float v) {
    v = red16(v);
    const float r0 = __builtin_bit_cast(float, __builtin_amdgcn_readlane(__builtin_bit_cast(int, v), 0)), r1 = __builtin_bit_cast(float, __builtin_amdgcn_readlane(__builtin_bit_cast(int, v), 16));
    const float r2 = __builtin_bit_cast(float, __builtin_amdgcn_readlane(__builtin_bit_cast(int, v), 32)), r3 = __builtin_bit_cast(float, __builtin_amdgcn_readlane(__builtin_bit_cast(int, v), 48));
    return (r0 + r1) + (r2 + r3); }
typedef float f32x2 __attribute__((ext_vector_type(2)));
typedef unsigned u32x2 __attribute__((ext_vector_type(2)));
__device__ __forceinline__ float sigmoidf_(float v) { return __builtin_amdgcn_rcpf(1.0f + __expf(-v)); }
__device__ __forceinline__ void unpack8(const uint4 r, float (&f)[8]) {
    f[0] = bflo(r.x); f[1] = bfhi(r.x); f[2] = bflo(r.y); f[3] = bfhi(r.y); f[4] = bflo(r.z); f[5] = bfhi(r.z); f[6] = bflo(r.w); f[7] = bfhi(r.w); }

__device__ __forceinline__ float act_apply(float v, int act) {
    switch (act) {
        case 1: { const float r = fmaxf(v, 0.f); return r * r; }
        case 2: return 1.0f - 2.0f * __builtin_amdgcn_rcpf(1.0f + __expf(2.0f * v));
        case 3: return sigmoidf_(v);
        case 4: return 0.60653066f * sigmoidf_(v);
        default: return v; }
}
struct EpiB {
    static constexpr bool PERM = true, AFTER_DRAIN = false;
    const GemmOp* ops;
    __device__ __forceinline__ void operator()(const f32x4 (&acc)[2][2][4][2], const pg8::Unit& u, int wr, int wc, int fr, int fq) const {
        const GemmOp& o_ = ops[u.op]; bf16_t* O = (bf16_t*)o_.out; const int ldc = o_.ldc; const float* bias = o_.bias; const int act = o_.act;
        const int row0 = u.pm * 256 + wr * 64 + fr, col0 = u.pn * 256 + wc * 32 + 8 * fq;
        f32x4 bv[2][2];
#pragma unroll
        for (int bj = 0; bj < 2; ++bj)
#pragma unroll
            for (int n = 0; n < 2; ++n) bv[bj][n] = bias ? *(const f32x4*)(bias + col0 + bj * 128 + 4 * n) : (f32x4){0.f, 0.f, 0.f, 0.f};
#pragma unroll
        for (int ai = 0; ai < 2; ++ai)
#pragma unroll
            for (int m = 0; m < 4; ++m) { bf16_t* rowp = O + (size_t)(row0 + ai * 128 + m * 16) * ldc + col0;
#pragma unroll
                for (int bj = 0; bj < 2; ++bj) { f32x4 v0 = acc[ai][bj][m][0], v1 = acc[ai][bj][m][1];
                    v0 += bv[bj][0]; v1 += bv[bj][1];
                    if (act) {
#pragma unroll
                        for (int j = 0; j < 4; ++j) { v0[j] = act_apply(v0[j], act); v1[j] = act_apply(v1[j], act); } }
                    u32x4 w; w.x = cvt_pk_bf16(v0[0], v0[1]); w.y = cvt_pk_bf16(v0[2], v0[3]); w.z = cvt_pk_bf16(v1[0], v1[1]); w.w = cvt_pk_bf16(v1[2], v1[3]);
                    *(u32x4*)(rowp + bj * 128) = w; } }
    }
};
struct MultiOrder {
    const GemmOp* ops; int nops, G, c;
    __device__ __forceinline__ bool next(int i, pg8::Unit& u) const {
        long L = (long)i * G + c; int k = 0, nM = 0, nN = 0, nwg = 0;
        for (; k < nops; ++k) { nM = ops[k].M / 256; nN = ops[k].N / 256; nwg = nM * nN; if (L < nwg) break; L -= nwg; }
        if (k == nops) return false;
        int wgid = (int)L; { const int q = nwg / pg8::NXCD, r = nwg % pg8::NXCD, xcd = wgid % pg8::NXCD, off = wgid / pg8::NXCD; wgid = (xcd < r ? xcd * (q + 1) : r * (q + 1) + (xcd - r) * q) + off; }
        const int nig = pg8::WGM * nN, gid = wgid / nig, fm = gid * pg8::WGM, gsz = (nM - fm) < pg8::WGM ? (nM - fm) : pg8::WGM;
        u.pm = fm + ((wgid % nig) % gsz); u.pn = (wgid % nig) / gsz; u.op = k; return true;
    }
    __device__ __forceinline__ const char* abase(const pg8::Unit& u, const pg8::Gemm&) const { return (const char*)ops[u.op].A; }
    __device__ __forceinline__ const char* bbase(const pg8::Unit& u, const pg8::Gemm&) const { return (const char*)ops[u.op].Bt; }
    __device__ __forceinline__ void a_ready(const pg8::Unit&) const {}
    __device__ __forceinline__ void done(const pg8::Unit&) const {}
};
struct EpiF {
    static constexpr bool PERM = false, AFTER_DRAIN = false;
    float* C; int ldc; const float* res;
    __device__ __forceinline__ void operator()(const f32x4 (&acc)[2][2][4][2], const pg8::Unit& u, int wr, int wc, int fr, int fq) const {
        const int row0 = u.pm * 256 + wr * 64 + fr, col0 = u.pn * 256 + wc * 32 + 4 * fq;
#pragma unroll
        for (int ai = 0; ai < 2; ++ai)
#pragma unroll
            for (int mh = 0; mh < 2; ++mh) { size_t ro[2]; f32x4 r[2][2][2];
#pragma unroll
                for (int mm = 0; mm < 2; ++mm) { ro[mm] = (size_t)(row0 + ai * 128 + (mh * 2 + mm) * 16) * ldc + col0;
#pragma unroll
                    for (int bj = 0; bj < 2; ++bj)
#pragma unroll
                        for (int n = 0; n < 2; ++n) r[mm][bj][n] = *(const f32x4*)(res + ro[mm] + bj * 128 + n * 16); }
#pragma unroll
                for (int mm = 0; mm < 2; ++mm)
#pragma unroll
                    for (int bj = 0; bj < 2; ++bj)
#pragma unroll
                        for (int n = 0; n < 2; ++n) *(f32x4*)(C + ro[mm] + bj * 128 + n * 16) = acc[ai][bj][mh * 2 + mm][n] + r[mm][bj][n]; }
    }
};

__device__ __forceinline__ void convert_one_tile(const Params& p, int jlo, int jhi, int tile, int tid, LAS float* T) {
    int j = jlo; while (j + 1 < jhi && tile >= p.cj[j + 1].tile0) ++j;
    const float* src = p.cj[j].src; bf16_t* dst = p.cj[j].dst; const int K = p.cj[j].K, N = p.cj[j].N, Kpad = p.cj[j].Kpad;
    const int local = tile - p.cj[j].tile0, nkt = Kpad >> 6, kt = local % nkt, nt = local / nkt;
    f32x4 v[8];
#pragma unroll
    for (int i = 0; i < 8; ++i) { const int idx = tid + i * 512, kr = idx >> 6, c4 = idx & 63, k = kt * 64 + kr, n = nt * 256 + c4 * 4;
        v[i] = (f32x4){0.f, 0.f, 0.f, 0.f};
        if (k < K && n < N) v[i] = *(const f32x4*)(src + (size_t)k * N + n); }
#pragma unroll
    for (int i = 0; i < 8; ++i) { const int idx = tid + i * 512, kr = idx >> 6, c4 = idx & 63;
        T[kr * 257 + c4 * 4 + 0] = v[i][0]; T[kr * 257 + c4 * 4 + 1] = v[i][1]; T[kr * 257 + c4 * 4 + 2] = v[i][2]; T[kr * 257 + c4 * 4 + 3] = v[i][3]; }
    __syncthreads();
#pragma unroll
    for (int i = 0; i < 4; ++i) { const int idx = tid + i * 512, nl = idx >> 3, kc = idx & 7; float f[8];
#pragma unroll
        for (int e = 0; e < 8; ++e) f[e] = T[(kc * 8 + e) * 257 + nl];
        u32x4 w; w.x = cvt_pk_nv(f[0], f[1]); w.y = cvt_pk_nv(f[2], f[3]); w.z = cvt_pk_nv(f[4], f[5]); w.w = cvt_pk_nv(f[6], f[7]);
        *(u32x4*)(dst + (size_t)(nt * 256 + nl) * Kpad + kt * 64 + kc * 8) = w; }
    __syncthreads();
}
__device__ __forceinline__ void convert_tiles(const Params& p, int jlo, int jhi, LAS unsigned char* lds) {
    const int tid = opq(threadIdx.x); LAS float* T = (LAS float*)lds;
    const int total = p.cj[jhi - 1].tile0 + p.cj[jhi - 1].ntiles;
    for (int tile = blockIdx.x; tile < total; tile += gridDim.x) convert_one_tile(p, jlo, jhi, tile, tid, T);
}
__device__ __forceinline__ void convert_queue(const Params& p, int jlo, int jhi, unsigned* counter, LAS unsigned char* lds) {
    const int tid = opq(threadIdx.x); LAS float* T = (LAS float*)lds; LAS int* slot = (LAS int*)(lds + 72 * 1024);
    const int total = p.cj[jhi - 1].tile0 + p.cj[jhi - 1].ntiles;
    for (;;) {
        __syncthreads();
        if (tid == 0) *slot = (int)__hip_atomic_fetch_add(counter, 1u, __ATOMIC_RELAXED, __HIP_MEMORY_SCOPE_AGENT);
        __syncthreads();
        const int tile = *slot;
        if (tile >= total) break;
        convert_one_tile(p, jlo, jhi, tile, tid, T);
    }
}

__device__ __forceinline__ void rope_table(const Params& p) {
    float2* tab = (float2*)(p.ws + WS_ROPE);
    for (int idx = blockIdx.x * 512 + opq(threadIdx.x); idx < SEQ * 32; idx += gridDim.x * 512) {
        const int t = idx >> 5, i = idx & 31;
        const float inv = exp2f(-(float)i * 0.41524101186092029f);
        const float angf = (float)t * inv;
        const double ang = (double)angf;
        const double q = rint(ang * 0.6366197723675814);
        const float f = (float)fma(-q, 1.5707963267948966, ang), f2 = f * f;
        const float s = f * (1.0f + f2 * (-1.6666667e-1f + f2 * (8.3333333e-3f + f2 * (-1.9841270e-4f + f2 * 2.7557319e-6f))));
        const float c = 1.0f + f2 * (-0.5f + f2 * (4.1666667e-2f + f2 * (-1.3888889e-3f + f2 * (2.4801587e-5f + f2 * (-2.7557319e-7f)))));
        const int qi = ((int)q) & 3;
        const float sn = (qi == 0) ? s : (qi == 1) ? c : (qi == 2) ? -s : -c;
        const float cs = (qi == 0) ? c : (qi == 1) ? -s : (qi == 2) ? -c : s;
        tab[idx] = make_float2(cs, sn);
    }
}

__device__ __forceinline__ void norm_rows(const float* x, const float* g, bf16_t* h) {
    const int tid_ = opq(threadIdx.x); const int lane = tid_ & 63, wv = tid_ >> 6;
    f32x4 gg[8];
#pragma unroll
    for (int i = 0; i < 8; ++i) gg[i] = *(const f32x4*)(g + i * 256 + lane * 4);
    for (int row = (blockIdx.x * 8 + wv) * 2; row < MTOK; row += gridDim.x * 16) {
        const float* xr = x + (size_t)row * D; f32x4 v[8], u[8]; float ss = 0.f, st = 0.f;
#pragma unroll
        for (int i = 0; i < 8; ++i) { v[i] = *(const f32x4*)(xr + i * 256 + lane * 4); u[i] = *(const f32x4*)(xr + D + i * 256 + lane * 4); }
#pragma unroll
        for (int i = 0; i < 8; ++i) { ss += v[i][0] * v[i][0] + v[i][1] * v[i][1] + v[i][2] * v[i][2] + v[i][3] * v[i][3]; st += u[i][0] * u[i][0] + u[i][1] * u[i][1] + u[i][2] * u[i][2] + u[i][3] * u[i][3]; }
        ss = wave_sum(ss); st = wave_sum(st); const float r = rsqrtf(ss * (1.0f / D) + 1e-6f), r2 = rsqrtf(st * (1.0f / D) + 1e-6f);
#pragma unroll
        for (int i = 0; i < 8; ++i) {
            uint2 w; w.x = cvt_pk_nv(v[i][0] * r * gg[i][0], v[i][1] * r * gg[i][1]); w.y = cvt_pk_nv(v[i][2] * r * gg[i][2], v[i][3] * r * gg[i][3]);
            *(uint2*)(h + (size_t)row * D + i * 256 + lane * 4) = w;
            uint2 w2; w2.x = cvt_pk_nv(u[i][0] * r2 * gg[i][0], u[i][1] * r2 * gg[i][1]); w2.y = cvt_pk_nv(u[i][2] * r2 * gg[i][2], u[i][3] * r2 * gg[i][3]);
            *(uint2*)(h + (size_t)(row + 1) * D + i * 256 + lane * 4) = w2; }
    }
}

__device__ __forceinline__ void mix_rows(const float* x, const float* g, const float* mixw, bf16_t* mixbase, int tok0, LAS unsigned char* lds) {
    const int tid = opq(threadIdx.x), lane = tid & 63, wv = tid >> 6, c = tid * 4;
    LAS float* rs = (LAS float*)lds;
    const f32x4 gg = *(const f32x4*)(g + c); f32x4 mw[6];
#pragma unroll
    for (int m = 0; m < 6; ++m) mw[m] = *(const f32x4*)(mixw + m * D + c);
    for (int chunk = blockIdx.x; chunk < 256; chunk += gridDim.x) {
        const int rl0 = chunk * 32, tokc = tok0 + rl0; const bool hasprev = (tokc & (SEQ - 1)) != 0;
        __syncthreads();
        for (int r = wv; r < 33; r += 8) {
            float ss = 0.f;
            if (r > 0 || hasprev) { const float* xr = x + (size_t)(tokc - 1 + r) * D; f32x4 v[8];
#pragma unroll
                for (int i = 0; i < 8; ++i) v[i] = *(const f32x4*)(xr + i * 256 + lane * 4);
#pragma unroll
                for (int i = 0; i < 8; ++i) ss += v[i][0] * v[i][0] + v[i][1] * v[i][1] + v[i][2] * v[i][2] + v[i][3] * v[i][3]; }
            ss = wave_sum(ss);
            if (lane == 0) rs[r] = (r > 0 || hasprev) ? rsqrtf(ss * (1.0f / D) + 1e-6f) : 0.f;
        }
        __syncthreads();
        f32x4 prev = (f32x4){0.f, 0.f, 0.f, 0.f};
        if (hasprev) { const f32x4 pv = *(const f32x4*)(x + (size_t)(tokc - 1) * D + c); const float rp = rs[0]; prev = pv * rp * gg; }
        for (int r0 = 0; r0 < 32; r0 += 4) {
            f32x4 xv[4];
#pragma unroll
            for (int u = 0; u < 4; ++u) xv[u] = *(const f32x4*)(x + (size_t)(tokc + r0 + u) * D + c);
#pragma unroll
            for (int u = 0; u < 4; ++u) { const float rr = rs[r0 + u + 1]; const f32x4 hn = xv[u] * rr * gg, xx = prev - hn;
#pragma unroll
                for (int m = 0; m < 6; ++m) { const f32x4 o = hn + xx * mw[m];
                    uint2 w; w.x = cvt_pk_nv(o[0], o[1]); w.y = cvt_pk_nv(o[2], o[3]);
                    *(uint2*)(mixbase + (size_t)m * 8192 * D + (size_t)(rl0 + r0 + u) * D + c) = w; }
                prev = hn; }
        }
    }
}

__device__ __forceinline__ void conv_ssd(const Params& p) {
    const bf16_t* proj = (const bf16_t*)(p.ws + WS_PROJ); bf16_t* xbc = (bf16_t*)(p.ws + WS_XBC);
    const float* cw = p.in[6]; const float* cb = p.in[7];
    const int tid = opq(threadIdx.x);
    if (tid < 384) {
        const int c8 = tid % 192, par = tid / 192, c = c8 * 8;
        float w[4][8], bb[8];
#pragma unroll
        for (int j = 0; j < 4; ++j) { const f32x4 w0 = *(const f32x4*)(cw + j * 1536 + c), w1 = *(const f32x4*)(cw + j * 1536 + c + 4);
#pragma unroll
            for (int e = 0; e < 4; ++e) { w[j][e] = w0[e]; w[j][4 + e] = w1[e]; } }
        { const f32x4 b0 = *(const f32x4*)(cb + c), b1 = *(const f32x4*)(cb + c + 4);
#pragma unroll
          for (int e = 0; e < 4; ++e) { bb[e] = b0[e]; bb[4 + e] = b1[e]; } }
        for (int chunk = blockIdx.x; chunk < 256; chunk += gridDim.x) {
            const int t0 = chunk * 64 + par * 32; const bool hasprev = (t0 & (SEQ - 1)) != 0;
            float r0[8], r1[8], r2[8];
            if (hasprev) { const uint4 a = *(const uint4*)(proj + (size_t)(t0 - 3) * INWP + COL_XBC + c), b = *(const uint4*)(proj + (size_t)(t0 - 2) * INWP + COL_XBC + c), d = *(const uint4*)(proj + (size_t)(t0 - 1) * INWP + COL_XBC + c);
                unpack8(a, r0); unpack8(b, r1); unpack8(d, r2); }
            else {
#pragma unroll
                for (int e = 0; e < 8; ++e) { r0[e] = 0.f; r1[e] = 0.f; r2[e] = 0.f; } }
            for (int tg = 0; tg < 32; tg += 4) {
                uint4 rw[4];
#pragma unroll
                for (int u = 0; u < 4; ++u) rw[u] = *(const uint4*)(proj + (size_t)(t0 + tg + u) * INWP + COL_XBC + c);
#pragma unroll
                for (int u = 0; u < 4; ++u) { float cur[8], acc[8]; unpack8(rw[u], cur);
#pragma unroll
                    for (int e = 0; e < 8; ++e) { acc[e] = bb[e] + w[0][e] * r0[e] + w[1][e] * r1[e] + w[2][e] * r2[e] + w[3][e] * cur[e]; acc[e] = acc[e] * sigmoidf_(acc[e]); r0[e] = r1[e]; r1[e] = r2[e]; r2[e] = cur[e]; }
                    u32x4 o; o.x = cvt_pk_nv(acc[0], acc[1]); o.y = cvt_pk_nv(acc[2], acc[3]); o.z = cvt_pk_nv(acc[4], acc[5]); o.w = cvt_pk_nv(acc[6], acc[7]);
                    *(u32x4*)(xbc + (size_t)(t0 + tg + u) * 1536 + c) = o; }
            }
        }
    }
    float* dt = (float*)(p.ws + WS_DT); float* da = (float*)(p.ws + WS_DA);
    for (int idx = blockIdx.x * 512 + opq(threadIdx.x); idx < MTOK * 16; idx += gridDim.x * 512) {
        const int tok = idx >> 4, hh = idx & 15;
        const float v = bf2f(proj[(size_t)tok * INWP + COL_DT + hh]) + p.in[8][hh];
        const float d = fmaxf(v, 0.f) + __logf(1.0f + __expf(-fabsf(v)));
        dt[idx] = d; da[idx] = __expf(-d * __expf(p.in[9][hh]));
    }
}

__device__ __forceinline__ void ssd_scan_job(const Params& p, int job, LAS unsigned char* lds) {
    const int tid = opq(threadIdx.x);
    const int b = job >> 5, hs = (job >> 1) & 15, half = job & 1, grp = hs >> 3, p0 = half * 32;
    const bf16_t* xbc = (const bf16_t*)(p.ws + WS_XBC) + (size_t)b * SEQ * 1536;
    const float* dtp = (const float*)(p.ws + WS_DT) + (size_t)b * SEQ * 16 + hs;
    const float* dap = (const float*)(p.ws + WS_DA) + (size_t)b * SEQ * 16 + hs;
    float* yraw = (float*)(p.ws + WS_YRAW) + (size_t)b * SEQ * 1024 + hs * 64 + p0;
    const float dskip = p.in[10][hs];
    constexpr int BUF_F = 9280;
    LAS float* L = (LAS float*)lds;
    const bool producer = tid >= 256; const int ptid = tid & 255;
    int grow[5], gcol[5], loff[5];
#pragma unroll
    for (int k = 0; k < 5; ++k) { const int q = ptid + k * 256, row = q / 36, pc = q - row * 36; grow[k] = row;
        if (pc < 4) { gcol[k] = hs * 64 + p0 + pc * 8; loff[k] = row * 32 + pc * 8; }
        else if (pc < 20) { gcol[k] = 1024 + grp * 128 + (pc - 4) * 8; loff[k] = 1024 + row * 128 + (pc - 4) * 8; }
        else { gcol[k] = 1280 + grp * 128 + (pc - 20) * 8; loff[k] = 5120 + row * 128 + (pc - 20) * 8; } }
    uint4 rg[5]; float sc = 0.f;
#define SSD_ISSUE(t0) do { _Pragma("unroll") for (int k = 0; k < 5; ++k) if (ptid + k * 256 < 1152) rg[k] = *(const uint4*)(xbc + (size_t)((t0) + grow[k]) * 1536 + gcol[k]); \
        if (ptid < 32) sc = dtp[((t0) + ptid) * 16]; else if (ptid < 64) sc = dap[((t0) + ptid - 32) * 16]; } while (0)
#define SSD_COMMIT(buf) do { LAS float* Lc = L + (buf) * BUF_F; _Pragma("unroll") for (int k = 0; k < 5; ++k) if (ptid + k * 256 < 1152) { float f[8]; unpack8(rg[k], f); \
            *(LAS f32x4*)(Lc + loff[k]) = (f32x4){f[0], f[1], f[2], f[3]}; *(LAS f32x4*)(Lc + loff[k] + 4) = (f32x4){f[4], f[5], f[6], f[7]}; } \
        if (ptid < 32) Lc[9216 + ptid] = sc; else if (ptid < 64) Lc[9248 + ptid - 32] = sc; } while (0)
#define SSD_FLUSH(chp) do { LAS float* yo = L + 2 * BUF_F + ((chp) & 1) * 1024; const f32x4 v = *(LAS f32x4*)(yo + (ptid >> 3) * 32 + (ptid & 7) * 4); \
        *(f32x4*)(yraw + (size_t)((chp) * 32 + (ptid >> 3)) * 1024 + (ptid & 7) * 4) = v; } while (0)
    f32x2 hA[4], hB[4];
#pragma unroll
    for (int i = 0; i < 4; ++i) { hA[i] = (f32x2){0.f, 0.f}; hB[i] = (f32x2){0.f, 0.f}; }
    const int prow = (tid >> 4) & 15, nseg = tid & 15;
    __syncthreads();
    if (producer) { SSD_ISSUE(0); SSD_COMMIT(0); SSD_ISSUE(32); }
    __syncthreads();
    for (int ch = 0; ch < 64; ++ch) {
        const int cur = ch & 1;
        if (producer) {
            if (ch >= 1) SSD_FLUSH(ch - 1);
            if (ch + 1 < 64) SSD_COMMIT(cur ^ 1);
            if (ch + 2 < 64) SSD_ISSUE((ch + 2) * 32);
        } else {
        LAS float* Lb = L + cur * BUF_F; LAS float* yb = L + 2 * BUF_F + cur * 1024;
        for (int tg = 0; tg < 32; tg += 16) {
            float yA[16], yB[16];
            LAS float* qb = Lb + 1024 + tg * 128 + nseg * 8;
            f32x4 b0 = *(LAS f32x4*)(qb), b1 = *(LAS f32x4*)(qb + 4), c0 = *(LAS f32x4*)(qb + 4096), c1 = *(LAS f32x4*)(qb + 4100);
            float dA = Lb[9248 + tg], xa = Lb[tg * 32 + prow], xb = Lb[tg * 32 + prow + 16], dtv = Lb[9216 + tg];
#pragma unroll
            for (int tt = 0; tt < 16; ++tt) {
                f32x4 nb0, nb1, nc0, nc1; float ndA, nxa, nxb, ndtv;
                if (tt + 1 < 16) { LAS float* q = qb + (tt + 1) * 128; nb0 = *(LAS f32x4*)(q); nb1 = *(LAS f32x4*)(q + 4); nc0 = *(LAS f32x4*)(q + 4096); nc1 = *(LAS f32x4*)(q + 4100);
                    ndA = Lb[9248 + tg + tt + 1]; nxa = Lb[(tg + tt + 1) * 32 + prow]; nxb = Lb[(tg + tt + 1) * 32 + prow + 16]; ndtv = Lb[9216 + tg + tt + 1]; }
                __builtin_amdgcn_sched_barrier(0);
                const float xdta = xa * dtv, xdtb = xb * dtv;
                const f32x2 dA2 = (f32x2){dA, dA}, xa2 = (f32x2){xdta, xdta}, xb2 = (f32x2){xdtb, xdtb};
                hA[0] = hA[0] * dA2 + xa2 * b0.xy; hB[0] = hB[0] * dA2 + xb2 * b0.xy; hA[1] = hA[1] * dA2 + xa2 * b0.zw; hB[1] = hB[1] * dA2 + xb2 * b0.zw;
                hA[2] = hA[2] * dA2 + xa2 * b1.xy; hB[2] = hB[2] * dA2 + xb2 * b1.xy; hA[3] = hA[3] * dA2 + xa2 * b1.zw; hB[3] = hB[3] * dA2 + xb2 * b1.zw;
                f32x2 ya = hA[0] * c0.xy, yb2 = hB[0] * c0.xy; ya = hA[1] * c0.zw + ya; yb2 = hB[1] * c0.zw + yb2; ya = hA[2] * c1.xy + ya; yb2 = hB[2] * c1.xy + yb2; ya = hA[3] * c1.zw + ya; yb2 = hB[3] * c1.zw + yb2;
                float ra = ya.x + ya.y, rb = yb2.x + yb2.y;
                ra = dpp_add<0xB1>(ra); rb = dpp_add<0xB1>(rb); ra = dpp_add<0x4E>(ra); rb = dpp_add<0x4E>(rb); ra = dpp_add<0x141>(ra); rb = dpp_add<0x141>(rb); ra = dpp_add<0x140>(ra); rb = dpp_add<0x140>(rb);
                yA[tt] = ra + dskip * xa; yB[tt] = rb + dskip * xb;
                __builtin_amdgcn_sched_barrier(0);
                if (tt + 1 < 16) { b0 = nb0; b1 = nb1; c0 = nc0; c1 = nc1; dA = ndA; xa = nxa; xb = nxb; dtv = ndtv; }
            }
            if (nseg == 0) {
#pragma unroll
                for (int tt = 0; tt < 16; ++tt) { yb[(tg + tt) * 32 + prow] = yA[tt]; yb[(tg + tt) * 32 + prow + 16] = yB[tt]; } }
        }
        }
        __syncthreads();
    }
    if (producer) SSD_FLUSH(63);
#undef SSD_ISSUE
#undef SSD_COMMIT
#undef SSD_FLUSH
}

__device__ __forceinline__ void ssd_chunk_job(const Params& p, int job, LAS unsigned char* lds) {
    const int tid = opq(threadIdx.x), lane = tid & 63, w = tid >> 6, fr = lane & 15, fq = lane >> 4;
    const int b = job >> 5, hs = (job >> 1) & 15, half = job & 1, grp = hs >> 3, p0 = half * 32;
    const bf16_t* xbc = (const bf16_t*)(p.ws + WS_XBC) + (size_t)b * SEQ * 1536;
    const float* dtp = (const float*)(p.ws + WS_DT) + (size_t)b * SEQ * 16 + hs;
    float* yraw = (float*)(p.ws + WS_YRAW) + (size_t)b * SEQ * 1024 + hs * 64 + p0;
    const float dskip = p.in[10][hs], Ah = -__expf(p.in[9][hs]);
    constexpr int RS = 136;
    LAS bf16_t* Cs = (LAS bf16_t*)lds;
    LAS bf16_t* Bs = (LAS bf16_t*)(lds + 34816);
    LAS bf16_t* BTs = (LAS bf16_t*)(lds + 69632);
    LAS bf16_t* XTa = (LAS bf16_t*)(lds + 104448);
    LAS bf16_t* XTb = (LAS bf16_t*)(lds + 113152);
    LAS bf16_t* Ps = (LAS bf16_t*)(lds + 121856);
    LAS float* af = (LAS float*)(lds + 130560);
    LAS float* dtf = (LAS float*)(lds + 131584);
    const int crow0 = tid >> 4, cpc = tid & 15;
    const int xk = tid >> 2, xpc = tid & 3;
    u32x4 rc[4], rb[4], rx; float rdt = 0.f;
#define SC_ISSUE(t0) do { _Pragma("unroll") for (int i = 0; i < 4; ++i) { const bf16_t* rp_ = xbc + (size_t)((t0) + (crow0 + 32 * i)) * 1536 + grp * 128 + cpc * 8; rb[i] = *(const u32x4*)(rp_ + 1024); rc[i] = *(const u32x4*)(rp_ + 1280); } \
        rx = *(const u32x4*)(xbc + (size_t)((t0) + xk) * 1536 + hs * 64 + p0 + xpc * 8); if (tid < 128) rdt = dtp[((t0) + tid) * 16]; } while (0)
    f32x4 st[2];
    st[0] = (f32x4){0.f, 0.f, 0.f, 0.f}; st[1] = st[0];
    __syncthreads();
    for (int i = tid; i < 32 * RS / 2; i += 512) ((LAS unsigned*)Ps)[i] = 0u;
    SC_ISSUE(0);
    for (int ch = 0; ch < 16; ++ch) {
        const int t0 = ch * 128;
        __syncthreads();
#pragma unroll
        for (int i = 0; i < 4; ++i) { *(LAS u32x4*)(Cs + (crow0 + 32 * i) * RS + cpc * 8) = rc[i]; *(LAS u32x4*)(Bs + (crow0 + 32 * i) * RS + cpc * 8) = rb[i];

#pragma unroll
            for (int e = 0; e < 4; ++e) { BTs[(cpc * 8 + 2 * e) * RS + (crow0 + 32 * i)] = (bf16_t)(rb[i][e] & 0xffffu); BTs[(cpc * 8 + 2 * e + 1) * RS + (crow0 + 32 * i)] = (bf16_t)(rb[i][e] >> 16); } }
        float csv = 0.f;
        if (tid < 128) {
            csv = rdt * Ah; dtf[tid] = rdt;
#pragma unroll
            for (int off = 1; off < 64; off <<= 1) { const float t_ = __shfl_up(csv, off); if (lane >= off) csv += t_; }
            if (tid == 63) af[128] = csv;
        }
        float xr[8]; xr[0] = bflo(rx[0]); xr[1] = bfhi(rx[0]); xr[2] = bflo(rx[1]); xr[3] = bfhi(rx[1]); xr[4] = bflo(rx[2]); xr[5] = bfhi(rx[2]); xr[6] = bflo(rx[3]); xr[7] = bfhi(rx[3]);
        __syncthreads();
        if (tid < 128) af[tid] = (tid >= 64) ? csv + af[128] : csv;
        __syncthreads();
        const float cs_last = af[127];
        { const float d = dtf[xk], dout = __expf(cs_last - af[xk]);
#pragma unroll
          for (int e = 0; e < 8; ++e) { const float xa = xr[e] * d; XTa[(xpc * 8 + e) * RS + xk] = f2bf(xa); XTb[(xpc * 8 + e) * RS + xk] = f2bf(xa * dout); } }
        __syncthreads();
        bf16x8 cf[4];
#pragma unroll
        for (int ks = 0; ks < 4; ++ks) cf[ks] = *(LAS bf16x8*)(Cs + (w * 16 + fr) * RS + ks * 32 + fq * 8);
        f32x4 yo[2];
#pragma unroll
        for (int pt = 0; pt < 2; ++pt) { f32x4 acc = (f32x4){0.f, 0.f, 0.f, 0.f};
#pragma unroll
            for (int ks = 0; ks < 4; ++ks) { const bf16x8 pb = *(LAS bf16x8*)(Ps + (pt * 16 + fr) * RS + ks * 32 + fq * 8); acc = __builtin_amdgcn_mfma_f32_16x16x32_bf16(cf[ks], pb, acc, 0, 0, 0); }
            yo[pt] = acc; }
        float csq[4];
#pragma unroll
        for (int i = 0; i < 4; ++i) csq[i] = af[w * 16 + fq * 4 + i];
#pragma unroll
        for (int kt = 0; kt < 8; ++kt) { f32x4 acc = (f32x4){0.f, 0.f, 0.f, 0.f};
            if (kt > w) {
#pragma unroll
                for (int i = 0; i < 4; ++i) Cs[(w * 16 + fq * 4 + i) * RS + kt * 16 + fr] = (bf16_t)0;
                continue; }
#pragma unroll
            for (int ks = 0; ks < 4; ++ks) { const bf16x8 bb = *(LAS bf16x8*)(Bs + (kt * 16 + fr) * RS + ks * 32 + fq * 8); acc = __builtin_amdgcn_mfma_f32_16x16x32_bf16(cf[ks], bb, acc, 0, 0, 0); }
            const int kk = kt * 16 + fr; const float csk = af[kk];
#pragma unroll
            for (int i = 0; i < 4; ++i) { const int qq = w * 16 + fq * 4 + i; const float m = (kk <= qq) ? acc[i] * __expf(csq[i] - csk) : 0.f; Cs[qq * RS + kk] = f2bf(m); } }
        f32x4 yd[2];
        { bf16x8 mf[4];
#pragma unroll
          for (int ks = 0; ks < 4; ++ks) mf[ks] = *(LAS bf16x8*)(Cs + (w * 16 + fr) * RS + ks * 32 + fq * 8);
#pragma unroll
          for (int pt = 0; pt < 2; ++pt) { f32x4 acc = (f32x4){0.f, 0.f, 0.f, 0.f};
#pragma unroll
              for (int ks = 0; ks < 4; ++ks) { const bf16x8 xb = *(LAS bf16x8*)(XTa + (pt * 16 + fr) * RS + ks * 32 + fq * 8); acc = __builtin_amdgcn_mfma_f32_16x16x32_bf16(mf[ks], xb, acc, 0, 0, 0); }
              yd[pt] = acc; } }
        SC_ISSUE((ch + 1 < 16 ? ch + 1 : 15) * 128);
#pragma unroll
        for (int pt = 0; pt < 2; ++pt)
#pragma unroll
            for (int i = 0; i < 4; ++i) { const int qq = w * 16 + fq * 4 + i, pp = pt * 16 + fr;
                const float xv = bf2f(xbc[(size_t)(t0 + qq) * 1536 + hs * 64 + p0 + pp]);
                yraw[(size_t)(t0 + qq) * 1024 + pp] = yd[pt][i] + __expf(csq[i]) * yo[pt][i] + dskip * xv; }
        __syncthreads();
        { const float cd = __expf(cs_last);
#pragma unroll
          for (int pt = 0; pt < 2; ++pt) { f32x4 acc = st[pt] * cd;
#pragma unroll
              for (int ks = 0; ks < 4; ++ks) { const bf16x8 xa = *(LAS bf16x8*)(XTb + (pt * 16 + fr) * RS + ks * 32 + fq * 8); const bf16x8 bt = *(LAS bf16x8*)(BTs + (w * 16 + fr) * RS + ks * 32 + fq * 8);
                  acc = __builtin_amdgcn_mfma_f32_16x16x32_bf16(xa, bt, acc, 0, 0, 0); }
              st[pt] = acc;
#pragma unroll
              for (int i = 0; i < 4; ++i) Ps[(pt * 16 + fq * 4 + i) * RS + w * 16 + fr] = f2bf(acc[i]); } }
    }
#undef SC_ISSUE
}

__device__ __forceinline__ void attn_job(const Params& p, int job, LAS unsigned char* lds) {
    const int tid = opq(threadIdx.x), lane = tid & 63, w = tid >> 6, fr = lane & 15, fq = lane >> 4;
    const int b = job >> 6, kvh = (job >> 4) & 3, nb = job & 15;
    const bf16_t* proj = (const bf16_t*)(p.ws + WS_PROJ) + (size_t)b * SEQ * INWP;
    const float2* rope = (const float2*)(p.ws + WS_ROPE);
    LAS bf16_t* Ks = (LAS bf16_t*)lds;
    LAS bf16_t* Vt = (LAS bf16_t*)(lds + 36864);
    LAS bf16_t* Ps = (LAS bf16_t*)(lds + 70656) + w * 16 * 264;
    __syncthreads();
    if (tid < 256) {
        const int kr = tid, tk = (nb - 1) * 128 + kr;
        if (tk >= 0) {
            const bf16_t* src = proj + (size_t)tk * INWP + COL_K + kvh * 64; float x[64]; float ss = 0.f;
#pragma unroll
            for (int c = 0; c < 8; ++c) { const uint4 r = *(const uint4*)(src + c * 8); float f[8]; unpack8(r, f);
#pragma unroll
                for (int e = 0; e < 8; ++e) { x[c * 8 + e] = f[e]; ss += f[e] * f[e]; } }
            const float rinv = rsqrtf(ss * (1.0f / 64) + 1e-6f); const float* kn = p.in[13];
#pragma unroll
            for (int i = 0; i < 64; ++i) x[i] = x[i] * rinv * kn[i];
#pragma unroll
            for (int c = 0; c < 4; ++c) { float o1[8], o2[8];
#pragma unroll
                for (int e = 0; e < 8; ++e) { const int i = c * 8 + e; const float2 cs = rope[tk * 32 + i]; o1[e] = x[i] * cs.x - x[i + 32] * cs.y; o2[e] = x[i + 32] * cs.x + x[i] * cs.y; }
                u32x4 w1, w2; w1.x = cvt_pk_bf16(o1[0], o1[1]); w1.y = cvt_pk_bf16(o1[2], o1[3]); w1.z = cvt_pk_bf16(o1[4], o1[5]); w1.w = cvt_pk_bf16(o1[6], o1[7]);
                w2.x = cvt_pk_bf16(o2[0], o2[1]); w2.y = cvt_pk_bf16(o2[2], o2[3]); w2.z = cvt_pk_bf16(o2[4], o2[5]); w2.w = cvt_pk_bf16(o2[6], o2[7]);
                *(LAS u32x4*)(Ks + kr * 72 + c * 8) = w1; *(LAS u32x4*)(Ks + kr * 72 + 32 + c * 8) = w2;
                __builtin_amdgcn_sched_barrier(0); }
        } else {
#pragma unroll
            for (int c = 0; c < 8; ++c) *(LAS u32x4*)(Ks + kr * 72 + c * 8) = (u32x4){0u, 0u, 0u, 0u};
        }
    } else {
        const int kr = tid - 256, tk = (nb - 1) * 128 + kr;
        const bf16_t* src = proj + (size_t)(tk < 0 ? 0 : tk) * INWP + COL_V + kvh * 64;
#pragma unroll
        for (int c = 0; c < 8; ++c) { uint4 r = *(const uint4*)(src + c * 8); if (tk < 0) r = make_uint4(0u, 0u, 0u, 0u);
            Vt[(c * 8 + 0) * 264 + kr] = (bf16_t)(r.x & 0xffffu); Vt[(c * 8 + 1) * 264 + kr] = (bf16_t)(r.x >> 16);
            Vt[(c * 8 + 2) * 264 + kr] = (bf16_t)(r.y & 0xffffu); Vt[(c * 8 + 3) * 264 + kr] = (bf16_t)(r.y >> 16);
            Vt[(c * 8 + 4) * 264 + kr] = (bf16_t)(r.z & 0xffffu); Vt[(c * 8 + 5) * 264 + kr] = (bf16_t)(r.z >> 16);
            Vt[(c * 8 + 6) * 264 + kr] = (bf16_t)(r.w & 0xffffu); Vt[(c * 8 + 7) * 264 + kr] = (bf16_t)(r.w >> 16); }
    }
    __syncthreads();
    const int tq = nb * 128 + w * 16 + fr;
    f32x4 csr[4]; f32x4 qn1[2], qn2[2];
#pragma unroll
    for (int e = 0; e < 4; ++e) csr[e] = *(const f32x4*)(rope + tq * 32 + fq * 8 + 2 * e);
    qn1[0] = *(const f32x4*)(p.in[12] + fq * 8); qn1[1] = *(const f32x4*)(p.in[12] + fq * 8 + 4); qn2[0] = *(const f32x4*)(p.in[12] + 32 + fq * 8); qn2[1] = *(const f32x4*)(p.in[12] + 32 + fq * 8 + 4);
    uint4 r0 = *(const uint4*)(proj + (size_t)tq * INWP + (kvh * 4) * 64 + fq * 8), r1 = *(const uint4*)(proj + (size_t)tq * INWP + (kvh * 4) * 64 + 32 + fq * 8);
    for (int h4 = 0; h4 < 4; ++h4) {
    const int hq = kvh * 4 + h4;
    bf16x8 qa[2];
    const bf16_t* srcn = proj + (size_t)tq * INWP + (kvh * 4 + (h4 + 1 < 4 ? h4 + 1 : 3)) * 64;
    const uint4 r0n = *(const uint4*)(srcn + fq * 8), r1n = *(const uint4*)(srcn + 32 + fq * 8);
    { float x1[8], x2[8]; unpack8(r0, x1); unpack8(r1, x2);
      float ss = 0.f;
#pragma unroll
      for (int e = 0; e < 8; ++e) ss += x1[e] * x1[e] + x2[e] * x2[e];
      ss += __shfl_xor(ss, 16); ss += __shfl_xor(ss, 32);
      const float rinv = rsqrtf(ss * (1.0f / 64) + 1e-6f) * 0.125f; float o1[8], o2[8];
#pragma unroll
      for (int e = 0; e < 8; ++e) { const float a = x1[e] * rinv * qn1[e >> 2][e & 3], c = x2[e] * rinv * qn2[e >> 2][e & 3]; const float cx = csr[e >> 1][(e & 1) * 2], sy = csr[e >> 1][(e & 1) * 2 + 1];
          o1[e] = a * cx - c * sy; o2[e] = c * cx + a * sy; }
      u32x4 w1, w2; w1.x = cvt_pk_bf16(o1[0], o1[1]); w1.y = cvt_pk_bf16(o1[2], o1[3]); w1.z = cvt_pk_bf16(o1[4], o1[5]); w1.w = cvt_pk_bf16(o1[6], o1[7]);
      w2.x = cvt_pk_bf16(o2[0], o2[1]); w2.y = cvt_pk_bf16(o2[2], o2[3]); w2.z = cvt_pk_bf16(o2[4], o2[5]); w2.w = cvt_pk_bf16(o2[6], o2[7]);
      qa[0] = __builtin_bit_cast(bf16x8, w1); qa[1] = __builtin_bit_cast(bf16x8, w2); }
    r0 = r0n; r1 = r1n;
    f32x4 s[16];
#pragma unroll
    for (int j = 0; j < 16; ++j) { f32x4 acc = (f32x4){0.f, 0.f, 0.f, 0.f};
#pragma unroll
        for (int ks = 0; ks < 2; ++ks) { const bf16x8 kb = *(LAS bf16x8*)(Ks + (j * 16 + fr) * 72 + ks * 32 + fq * 8); acc = __builtin_amdgcn_mfma_f32_16x16x32_bf16(qa[ks], kb, acc, 0, 0, 0); }
        s[j] = acc; }
    const float sink = p.in[14][hq];
    float mx[4], inv[4];
#pragma unroll
    for (int i = 0; i < 4; ++i) { const int qi = w * 16 + fq * 4 + i + 128; float m = -3.0e38f;
#pragma unroll
        for (int j = 0; j < 16; ++j) { const int kj = j * 16 + fr; const bool ok = (kj <= qi) && (qi - kj < 128) && (nb > 0 || kj >= 128); s[j][i] = ok ? s[j][i] : -3.0e38f; m = fmaxf(m, s[j][i]); }
        m = max16(m);
        m = fmaxf(m, sink); mx[i] = m; float l = 0.f;
#pragma unroll
        for (int j = 0; j < 16; ++j) { const float e = (s[j][i] > -1.0e38f) ? __expf(s[j][i] - m) : 0.f; s[j][i] = e; l += e; }
        l = red16(l);
        inv[i] = 1.0f / (l + __expf(sink - m)); }
#pragma unroll
    for (int j = 0; j < 16; ++j)
#pragma unroll
        for (int i = 0; i < 4; ++i) Ps[(fq * 4 + i) * 264 + j * 16 + fr] = f2bf(s[j][i] * inv[i]);
    f32x4 o[4];
#pragma unroll
    for (int nd = 0; nd < 4; ++nd) o[nd] = (f32x4){0.f, 0.f, 0.f, 0.f};
#pragma unroll
    for (int kk = 0; kk < 8; ++kk) { const bf16x8 pa = *(LAS bf16x8*)(Ps + fr * 264 + kk * 32 + fq * 8);
#pragma unroll
        for (int nd = 0; nd < 4; ++nd) { const bf16x8 vb = *(LAS bf16x8*)(Vt + (nd * 16 + fr) * 264 + kk * 32 + fq * 8); o[nd] = __builtin_amdgcn_mfma_f32_16x16x32_bf16(pa, vb, o[nd], 0, 0, 0); } }
    bf16_t* ymix = (bf16_t*)(p.ws + WS_YMIX) + (size_t)b * SEQ * D + hq * 64;
#pragma unroll
    for (int nd = 0; nd < 4; ++nd)
#pragma unroll
        for (int i = 0; i < 4; ++i) ymix[(size_t)(nb * 128 + w * 16 + fq * 4 + i) * D + nd * 16 + fr] = f2bf(o[nd][i]);
    }
}

__device__ __forceinline__ void post_ssd(const Params& p) {
    const int tid_ = opq(threadIdx.x); const int lane = tid_ & 63, wv = tid_ >> 6;
    const float* yraw = (const float*)(p.ws + WS_YRAW); const bf16_t* proj = (const bf16_t*)(p.ws + WS_PROJ); bf16_t* ymix = (bf16_t*)(p.ws + WS_YMIX);
    for (int it = blockIdx.x * 8 + wv; it < MTOK * 2; it += gridDim.x * 8) {
        const int tok = it >> 1, grp = it & 1, c = grp * 512 + lane * 8;
        const f32x4 y0 = *(const f32x4*)(yraw + (size_t)tok * 1024 + c), y1 = *(const f32x4*)(yraw + (size_t)tok * 1024 + c + 4);
        const uint4 zr = *(const uint4*)(proj + (size_t)tok * INWP + COL_Z + c); float z[8], y[8]; unpack8(zr, z); float ss = 0.f;
#pragma unroll
        for (int e = 0; e < 8; ++e) { const float yy = (e < 4 ? y0[e] : y1[e - 4]); y[e] = yy * z[e] * sigmoidf_(z[e]); ss += y[e] * y[e]; }
        ss = wave_sum(ss); const float r = rsqrtf(ss * (1.0f / 512) + 1e-6f);
        const f32x4 n0 = *(const f32x4*)(p.in[11] + c), n1 = *(const f32x4*)(p.in[11] + c + 4);
        u32x4 w; w.x = cvt_pk_nv(y[0] * r * n0[0], y[1] * r * n0[1]); w.y = cvt_pk_nv(y[2] * r * n0[2], y[3] * r * n0[3]);
        w.z = cvt_pk_nv(y[4] * r * n1[0], y[5] * r * n1[1]); w.w = cvt_pk_nv(y[6] * r * n1[2], y[7] * r * n1[3]);
        *(u32x4*)(ymix + (size_t)tok * D + 1024 + c) = w;
    }
}

__device__ __forceinline__ float half_sum(float v, bool lo) {
    (void)lo; v = red16(v); return v + __shfl_xor(v, 16); }
__device__ __forceinline__ void rwkv_scan_job(const Params& p, int job, LAS unsigned char* lds) {
    const int tid = opq(threadIdx.x), lane = tid & 63, l32 = lane & 31; const bool lo = lane < 32;
    const int b = job >> 5, hh = job & 31;
    LAS float* L = (LAS float*)lds;
    const bool producer = tid >= 256;
    const int pw = (tid >> 6) & 3;
    const int tl0 = 2 * pw + (lane >> 5);
    const size_t wbase = ((size_t)b * SEQ * D + hh * 64) / 2 + l32 + (size_t)tl0 * (D / 2);
    const unsigned* R32 = (const unsigned*)(p.ws + WS_R) + wbase; const unsigned* K32 = (const unsigned*)(p.ws + WS_K) + wbase; const unsigned* V32 = (const unsigned*)(p.ws + WS_V) + wbase;
    const unsigned* E32 = (const unsigned*)(p.ws + WS_WDEC) + wbase; const unsigned* A32 = (const unsigned*)(p.ws + WS_AA) + wbase; const unsigned* G32 = (const unsigned*)(p.ws + WS_GG) + wbase;
    unsigned* Y32 = (unsigned*)(p.ws + WS_YG) + wbase;
    const int ci = hh * 64 + 2 * l32;
    const float2 kkw = *(const float2*)(p.in[25] + ci), kaw = *(const float2*)(p.in[26] + ci), rkw = *(const float2*)(p.in[27] + ci), lnw = *(const float2*)(p.in[32] + ci), lnb = *(const float2*)(p.in[33] + ci);
    unsigned rw[2], kw[2], vw[2], ew[2], aw[2], gw[2];
    const int oo = tl0 * 64 + 2 * l32;
#define RW_ISSUE(t0) do { _Pragma("unroll") for (int i2 = 0; i2 < 2; ++i2) { const size_t off = (size_t)((t0) + 8 * i2) * (D / 2); rw[i2] = R32[off]; kw[i2] = K32[off]; vw[i2] = V32[off]; ew[i2] = E32[off]; aw[i2] = A32[off]; gw[i2] = G32[off]; } } while (0)
#define RW_COMMIT(buf) do { _Pragma("unroll") for (int i2 = 0; i2 < 2; ++i2) { LAS float* Lc = L + (buf) * 8192 + oo + i2 * 512; \
        const float r0_ = bflo(rw[i2]), r1_ = bfhi(rw[i2]), k0_ = bflo(kw[i2]), k1_ = bfhi(kw[i2]), v0_ = bflo(vw[i2]), v1_ = bfhi(vw[i2]), e0_ = bflo(ew[i2]), e1_ = bfhi(ew[i2]), a0_ = bflo(aw[i2]), a1_ = bfhi(aw[i2]), g0_ = bflo(gw[i2]), g1_ = bfhi(gw[i2]); \
        const float kkv0 = k0_ * kkw.x, kkv1 = k1_ * kkw.y; const float ssq = half_sum(kkv0 * kkv0 + kkv1 * kkv1, lo); const float rn = rsqrtf(fmaxf(ssq, 1e-24f)); const float kn0 = kkv0 * rn, kn1 = kkv1 * rn; \
        const float km0 = k0_ * (1.0f + (a0_ - 1.0f) * kaw.x), km1 = k1_ * (1.0f + (a1_ - 1.0f) * kaw.y); const float bonus = half_sum(r0_ * km0 * rkw.x + r1_ * km1 * rkw.y, lo); \
        *(LAS f32x2*)(Lc) = (f32x2){-kn0, -kn1}; *(LAS f32x2*)(Lc + 1024) = (f32x2){__expf(-e0_), __expf(-e1_)}; *(LAS f32x2*)(Lc + 2048) = (f32x2){kn0 * a0_, kn1 * a1_}; *(LAS f32x2*)(Lc + 3072) = (f32x2){km0, km1}; \
        *(LAS f32x2*)(Lc + 4096) = (f32x2){r0_, r1_}; *(LAS f32x2*)(Lc + 5120) = (f32x2){v0_, v1_}; *(LAS f32x2*)(Lc + 6144) = (f32x2){g0_, g1_}; *(LAS f32x2*)(Lc + 7168) = (f32x2){bonus * v0_, bonus * v1_}; } } while (0)
#define RW_OUTPUT(chp) do { LAS float* Lo = L + ((chp) & 1) * 8192; LAS float* yo = L + 16384 + ((chp) & 1) * 1024; _Pragma("unroll") for (int i2 = 0; i2 < 2; ++i2) { const int o2 = oo + i2 * 512; \
        const f32x2 y = *(LAS f32x2*)(yo + o2); \
        const float mu = half_sum(y.x + y.y, lo) * (1.0f / 64), d0 = y.x - mu, d1 = y.y - mu, var = half_sum(d0 * d0 + d1 * d1, lo) * (1.0f / 64), rs = rsqrtf(var + 64e-5f); \
        const f32x2 bv = *(LAS f32x2*)(Lo + 7168 + o2), gg = *(LAS f32x2*)(Lo + 6144 + o2); \
        Y32[(size_t)((chp) * 16 + 8 * i2) * (D / 2)] = cvt_pk_nv((d0 * rs * lnw.x + lnb.x + bv.x) * gg.x, (d1 * rs * lnw.y + lnb.y + bv.y) * gg.y); } } while (0)
    f32x2 SA[4], SB[4];
#pragma unroll
    for (int i = 0; i < 4; ++i) { SA[i] = (f32x2){0.f, 0.f}; SB[i] = (f32x2){0.f, 0.f}; }
    const int rp = (tid >> 3) & 31, ks = tid & 7;
    __syncthreads();
    if (producer) { RW_ISSUE(0); RW_COMMIT(0); RW_ISSUE(16); }
    __syncthreads();
    for (int ch = 0; ch < 128; ++ch) {
        const int cur = ch & 1;
        if (producer) {
            if (ch >= 1) RW_OUTPUT(ch - 1);
            if (ch + 1 < 128) RW_COMMIT(cur ^ 1);
            if (ch + 2 < 128) RW_ISSUE((ch + 2) * 16);
        } else {
            LAS float* Lb = L + cur * 8192; LAS float* yb = L + 16384 + cur * 1024;
            float yA[16], yB[16];
            LAS float* q0 = Lb + ks * 8;
            f32x4 a0 = *(LAS f32x4*)(q0), a1 = *(LAS f32x4*)(q0 + 4), w0 = *(LAS f32x4*)(q0 + 1024), w1 = *(LAS f32x4*)(q0 + 1028), b0 = *(LAS f32x4*)(q0 + 2048), b1 = *(LAS f32x4*)(q0 + 2052);
            f32x4 k0 = *(LAS f32x4*)(q0 + 3072), k1 = *(LAS f32x4*)(q0 + 3076), r0 = *(LAS f32x4*)(q0 + 4096), r1 = *(LAS f32x4*)(q0 + 4100);
            float va = Lb[5120 + rp], vb = Lb[5120 + rp + 32];
#pragma unroll
            for (int t = 0; t < 16; ++t) {
                f32x4 na0, na1, nw0, nw1, nb0, nb1, nk0, nk1, nr0, nr1; float nva, nvb;
                if (t + 1 < 16) { LAS float* q = q0 + (t + 1) * 64;
                    na0 = *(LAS f32x4*)(q); na1 = *(LAS f32x4*)(q + 4); nw0 = *(LAS f32x4*)(q + 1024); nw1 = *(LAS f32x4*)(q + 1028); nb0 = *(LAS f32x4*)(q + 2048); nb1 = *(LAS f32x4*)(q + 2052);
                    nk0 = *(LAS f32x4*)(q + 3072); nk1 = *(LAS f32x4*)(q + 3076); nr0 = *(LAS f32x4*)(q + 4096); nr1 = *(LAS f32x4*)(q + 4100); nva = Lb[5120 + (t + 1) * 64 + rp]; nvb = Lb[5120 + (t + 1) * 64 + rp + 32]; }
                __builtin_amdgcn_sched_barrier(0);
                f32x2 ca = SA[0] * a0.xy, cb = SB[0] * a0.xy; ca = SA[1] * a0.zw + ca; cb = SB[1] * a0.zw + cb; ca = SA[2] * a1.xy + ca; cb = SB[2] * a1.xy + cb; ca = SA[3] * a1.zw + ca; cb = SB[3] * a1.zw + cb;
                float sa = ca.x + ca.y, sb = cb.x + cb.y;
                sa = dpp_add<0xB1>(sa); sb = dpp_add<0xB1>(sb); sa = dpp_add<0x4E>(sa); sb = dpp_add<0x4E>(sb); sa = dpp_add<0x141>(sa); sb = dpp_add<0x141>(sb);
                const f32x2 sa2 = (f32x2){sa, sa}, sb2 = (f32x2){sb, sb}, va2 = (f32x2){va, va}, vb2 = (f32x2){vb, vb};
                SA[0] = SA[0] * w0.xy + (sa2 * b0.xy + va2 * k0.xy); SB[0] = SB[0] * w0.xy + (sb2 * b0.xy + vb2 * k0.xy);
                SA[1] = SA[1] * w0.zw + (sa2 * b0.zw + va2 * k0.zw); SB[1] = SB[1] * w0.zw + (sb2 * b0.zw + vb2 * k0.zw);
                SA[2] = SA[2] * w1.xy + (sa2 * b1.xy + va2 * k1.xy); SB[2] = SB[2] * w1.xy + (sb2 * b1.xy + vb2 * k1.xy);
                SA[3] = SA[3] * w1.zw + (sa2 * b1.zw + va2 * k1.zw); SB[3] = SB[3] * w1.zw + (sb2 * b1.zw + vb2 * k1.zw);
                f32x2 ya = SA[0] * r0.xy, yb2 = SB[0] * r0.xy; ya = SA[1] * r0.zw + ya; yb2 = SB[1] * r0.zw + yb2; ya = SA[2] * r1.xy + ya; yb2 = SB[2] * r1.xy + yb2; ya = SA[3] * r1.zw + ya; yb2 = SB[3] * r1.zw + yb2;
                float ra = ya.x + ya.y, rb = yb2.x + yb2.y;
                ra = dpp_add<0xB1>(ra); rb = dpp_add<0xB1>(rb); ra = dpp_add<0x4E>(ra); rb = dpp_add<0x4E>(rb); ra = dpp_add<0x141>(ra); rb = dpp_add<0x141>(rb);
                yA[t] = ra; yB[t] = rb;
                __builtin_amdgcn_sched_barrier(0);
                if (t + 1 < 16) { a0 = na0; a1 = na1; w0 = nw0; w1 = nw1; b0 = nb0; b1 = nb1; k0 = nk0; k1 = nk1; r0 = nr0; r1 = nr1; va = nva; vb = nvb; }
            }
            if (ks == 0) {
#pragma unroll
                for (int t = 0; t < 16; ++t) { yb[t * 64 + rp] = yA[t]; yb[t * 64 + rp + 32] = yB[t]; } }
        }
        __syncthreads();
    }
    if (producer) RW_OUTPUT(127);
#undef RW_ISSUE
#undef RW_COMMIT
#undef RW_OUTPUT
}

__device__ __forceinline__ void rwkv_chunk_job(const Params& p, int job, LAS unsigned char* lds) {
    const int tid = opq(threadIdx.x), lane = tid & 63, w = tid >> 6, fr = lane & 15, fq = lane >> 4, l32 = lane & 31; const bool lo = lane < 32;
    const int b = job >> 5, hh = job & 31;
    const int tl = 2 * w + (lane >> 5);
    const size_t wbase = ((size_t)b * SEQ * D + hh * 64) / 2 + l32 + (size_t)tl * (D / 2);
    const unsigned* R32 = (const unsigned*)(p.ws + WS_R) + wbase; const unsigned* K32 = (const unsigned*)(p.ws + WS_K) + wbase; const unsigned* V32 = (const unsigned*)(p.ws + WS_V) + wbase;
    const unsigned* E32 = (const unsigned*)(p.ws + WS_WDEC) + wbase; const unsigned* A32 = (const unsigned*)(p.ws + WS_AA) + wbase; const unsigned* G32 = (const unsigned*)(p.ws + WS_GG) + wbase;
    unsigned* Y32 = (unsigned*)(p.ws + WS_YG) + wbase;
    const int ci = hh * 64 + 2 * l32;
    const float2 kkw = *(const float2*)(p.in[25] + ci), kaw = *(const float2*)(p.in[26] + ci), rkw = *(const float2*)(p.in[27] + ci), lnw = *(const float2*)(p.in[32] + ci), lnb = *(const float2*)(p.in[33] + ci);
    LAS float* Av = (LAS float*)(lds + 0);
    LAS float* Bv = (LAS float*)(lds + 4096);
    LAS float* Km = (LAS float*)(lds + 8192);
    LAS float* Rr = (LAS float*)(lds + 12288);
    LAS float* ybuf = (LAS float*)(lds + 16384);
    LAS float* RHS = (LAS float*)(lds + 20480);
    LAS float* Aab = (LAS float*)(lds + 24832);
    LAS float* Wend = (LAS float*)(lds + 25856);
    LAS bf16_t* ET = (LAS bf16_t*)(lds + 26112);
    LAS bf16_t* VT = (LAS bf16_t*)(lds + 31232);
    LAS bf16_t* BtT = (LAS bf16_t*)(lds + 36352);
    LAS bf16_t* KtT = (LAS bf16_t*)(lds + 41472);
    LAS bf16_t* Ub = (LAS bf16_t*)(lds + 46592);
    LAS bf16_t* AakT = (LAS bf16_t*)(lds + 51712);
    LAS bf16_t* AbrT = (LAS bf16_t*)(lds + 52992);
    LAS bf16_t* AkrT = (LAS bf16_t*)(lds + 54272);
    LAS bf16_t* At = (LAS bf16_t*)(lds + 55552);
    LAS bf16_t* Bt = (LAS bf16_t*)(lds + 57856);
    LAS bf16_t* Kt = (LAS bf16_t*)(lds + 60160);
    LAS bf16_t* Rt = (LAS bf16_t*)(lds + 62464);
    LAS bf16_t* S0b = (LAS bf16_t*)(lds + 64768);
    LAS bf16_t* VT1 = (LAS bf16_t*)(lds + 73984);
    constexpr int LDS_END = 73984 + 64 * 40 * 2;
    __syncthreads();
    for (int i = tid; i < LDS_END / 4; i += 512) ((LAS unsigned*)lds)[i] = 0u;
    f32x4 stt[2]; stt[0] = (f32x4){0.f, 0.f, 0.f, 0.f}; stt[1] = stt[0];
    const int vt = w >> 1, kt0 = (w & 1) * 2;
    bf16x8 Lf;
#pragma unroll
    for (int e = 0; e < 8; ++e) { const int i = fq * 8 + e; Lf[e] = (i <= fr && i < 16) ? (short)0x3F80 : (short)0; }
    unsigned rw, kw, vw, ew, aw, gw;
#define RC_ISSUE(t0) do { const size_t off = (size_t)(t0) * (D / 2); rw = R32[off]; kw = K32[off]; vw = V32[off]; ew = E32[off]; aw = A32[off]; gw = G32[off]; } while (0)
#define RC_PREP(chn) do { \
        const float r0_ = bflo(rw), r1_ = bfhi(rw), k0_ = bflo(kw), k1_ = bfhi(kw), v0_ = bflo(vw), v1_ = bfhi(vw), a0_ = bflo(aw), a1_ = bfhi(aw); gn0 = bflo(gw); gn1 = bfhi(gw); \
        const unsigned ewc = ew, vwc = vw; \
        RC_ISSUE((((chn) + 1 < 128) ? (chn) + 1 : 127) * 16);     \
        const float kkv0 = k0_ * kkw.x, kkv1 = k1_ * kkw.y; const float ssq = half_sum(kkv0 * kkv0 + kkv1 * kkv1, lo); const float rn = rsqrtf(fmaxf(ssq, 1e-24f)); const float kn0 = kkv0 * rn, kn1 = kkv1 * rn; \
        const float km0 = k0_ * (1.0f + (a0_ - 1.0f) * kaw.x), km1 = k1_ * (1.0f + (a1_ - 1.0f) * kaw.y); const float bonus = half_sum(r0_ * km0 * rkw.x + r1_ * km1 * rkw.y, lo); \
        bn0 = bonus * v0_; bn1 = bonus * v1_; \
        { const int o = tl * 64 + 2 * l32; LAS bf16_t* VTw = ((chn) & 1) ? VT1 : VT; \
          *(LAS f32x2*)(Av + o) = (f32x2){-kn0, -kn1}; *(LAS f32x2*)(Bv + o) = (f32x2){kn0 * a0_, kn1 * a1_}; *(LAS f32x2*)(Km + o) = (f32x2){km0, km1}; *(LAS f32x2*)(Rr + o) = (f32x2){r0_, r1_}; \
          ET[(2 * l32) * 40 + tl] = (bf16_t)(ewc & 0xffffu); ET[(2 * l32 + 1) * 40 + tl] = (bf16_t)(ewc >> 16); \
          VTw[(2 * l32) * 40 + tl] = (bf16_t)(vwc & 0xffffu); VTw[(2 * l32 + 1) * 40 + tl] = (bf16_t)(vwc >> 16); } } while (0)
    float gc0 = 0.f, gc1 = 0.f, bc0 = 0.f, bc1 = 0.f, gn0, gn1, bn0, bn1;
    RC_ISSUE(0);
    __syncthreads();
    RC_PREP(0); gc0 = gn0; gc1 = gn1; bc0 = bn0; bc1 = bn1;
    __syncthreads();
    for (int ch = 0; ch < 128; ++ch) {
        LAS bf16_t* VTc = (ch & 1) ? VT1 : VT;
        if (w < 4) {
            const bf16x8 eb = *(LAS bf16x8*)(ET + (w * 16 + fr) * 40 + fq * 8);
            f32x4 ec = (f32x4){0.f, 0.f, 0.f, 0.f}; ec = __builtin_amdgcn_mfma_f32_16x16x32_bf16(Lf, eb, ec, 0, 0, 0);
            const int kk = w * 16 + fr; unsigned bt_pk[2], kt_pk[2]; float btv[4], ktv[4];
#pragma unroll
            for (int i = 0; i < 4; ++i) { const int t = fq * 4 + i; const float et = bf2f(ET[kk * 40 + t]);
                const float Wt = __expf(-ec[i]), Wp = __expf(et - ec[i]), iW = __expf(ec[i]);
                const int o = t * 64 + kk;
                At[t * 72 + kk] = f2bf(Av[o] * Wp); Rt[t * 72 + kk] = f2bf(Rr[o] * Wt);
                btv[i] = Bv[o] * iW; ktv[i] = Km[o] * iW;
                Bt[t * 72 + kk] = f2bf(btv[i]); Kt[t * 72 + kk] = f2bf(ktv[i]);
                if (t == 15) Wend[kk] = Wt; }
            bt_pk[0] = cvt_pk_bf16(btv[0], btv[1]); bt_pk[1] = cvt_pk_bf16(btv[2], btv[3]); kt_pk[0] = cvt_pk_bf16(ktv[0], ktv[1]); kt_pk[1] = cvt_pk_bf16(ktv[2], ktv[3]);
            *(LAS u32x2*)(BtT + kk * 40 + fq * 4) = (u32x2){bt_pk[0], bt_pk[1]}; *(LAS u32x2*)(KtT + kk * 40 + fq * 4) = (u32x2){kt_pk[0], kt_pk[1]};
        }
        __syncthreads();
        if (w < 4) {
            LAS bf16_t* Xr = (w & 1) ? Kt : Bt; LAS bf16_t* Yr = (w & 2) ? Rt : At;
            f32x4 gacc = (f32x4){0.f, 0.f, 0.f, 0.f};
#pragma unroll
            for (int ks = 0; ks < 2; ++ks) { const bf16x8 xa = *(LAS bf16x8*)(Xr + fr * 72 + ks * 32 + fq * 8); const bf16x8 yb_ = *(LAS bf16x8*)(Yr + fr * 72 + ks * 32 + fq * 8); gacc = __builtin_amdgcn_mfma_f32_16x16x32_bf16(xa, yb_, gacc, 0, 0, 0); }
            float gm[4];
#pragma unroll
            for (int i = 0; i < 4; ++i) { const int j = fq * 4 + i; const bool keep = (w & 2) ? (j <= fr) : (j < fr); gm[i] = keep ? gacc[i] : 0.f; }
            if (w == 0) {
#pragma unroll
                for (int i = 0; i < 4; ++i) Aab[(fq * 4 + i) * 16 + fr] = gm[i]; }
            else { LAS bf16_t* dst = (w == 1) ? AakT : (w == 2) ? AbrT : AkrT; *(LAS u32x2*)(dst + fr * 40 + fq * 4) = (u32x2){cvt_pk_bf16(gm[0], gm[1]), cvt_pk_bf16(gm[2], gm[3])}; }
        }
        __syncthreads();
        f32x4 y0 = (f32x4){0.f, 0.f, 0.f, 0.f};
        { const int vtile = w & 3; LAS bf16_t* Yr = (w < 4) ? At : Rt; LAS bf16_t* Gt = (w < 4) ? AakT : AkrT;
#pragma unroll
          for (int ks = 0; ks < 2; ++ks) { const bf16x8 sa = *(LAS bf16x8*)(S0b + (vtile * 16 + fr) * 72 + ks * 32 + fq * 8); const bf16x8 yb_ = *(LAS bf16x8*)(Yr + fr * 72 + ks * 32 + fq * 8); y0 = __builtin_amdgcn_mfma_f32_16x16x32_bf16(sa, yb_, y0, 0, 0, 0); }
          { const bf16x8 va = *(LAS bf16x8*)(VTc + (vtile * 16 + fr) * 40 + fq * 8); const bf16x8 gb = *(LAS bf16x8*)(Gt + fr * 40 + fq * 8); y0 = __builtin_amdgcn_mfma_f32_16x16x32_bf16(va, gb, y0, 0, 0, 0); }
          if (w < 4) {
#pragma unroll
              for (int i = 0; i < 4; ++i) RHS[(vtile * 16 + fq * 4 + i) * 17 + fr] = y0[i]; } }
        __syncthreads();
        if (w == 0) {
            float u[16];
#pragma unroll
            for (int t = 0; t < 16; ++t) u[t] = RHS[lane * 17 + t];
#pragma unroll
            for (int t = 0; t < 15; ++t) {
#pragma unroll
                for (int t2 = t + 1; t2 < 16; ++t2) u[t2] += u[t] * Aab[t * 16 + t2]; }
            u32x4 o0, o1; o0.x = cvt_pk_bf16(u[0], u[1]); o0.y = cvt_pk_bf16(u[2], u[3]); o0.z = cvt_pk_bf16(u[4], u[5]); o0.w = cvt_pk_bf16(u[6], u[7]);
            o1.x = cvt_pk_bf16(u[8], u[9]); o1.y = cvt_pk_bf16(u[10], u[11]); o1.z = cvt_pk_bf16(u[12], u[13]); o1.w = cvt_pk_bf16(u[14], u[15]);
            *(LAS u32x4*)(Ub + lane * 40) = o0; *(LAS u32x4*)(Ub + lane * 40 + 8) = o1;
        }
        RC_PREP(ch + 1);
        __syncthreads();
        if (w >= 4) { const int vtile = w & 3;
            const bf16x8 ua = *(LAS bf16x8*)(Ub + (vtile * 16 + fr) * 40 + fq * 8); const bf16x8 gb = *(LAS bf16x8*)(AbrT + fr * 40 + fq * 8); y0 = __builtin_amdgcn_mfma_f32_16x16x32_bf16(ua, gb, y0, 0, 0, 0);
#pragma unroll
            for (int i = 0; i < 4; ++i) ybuf[fr * 64 + vtile * 16 + fq * 4 + i] = y0[i]; }
        { const bf16x8 ua = *(LAS bf16x8*)(Ub + (vt * 16 + fr) * 40 + fq * 8); const bf16x8 va = *(LAS bf16x8*)(VTc + (vt * 16 + fr) * 40 + fq * 8);
#pragma unroll
          for (int q = 0; q < 2; ++q) { const int kk = (kt0 + q) * 16 + fr;
              const bf16x8 bb = *(LAS bf16x8*)(BtT + kk * 40 + fq * 8); const bf16x8 kb = *(LAS bf16x8*)(KtT + kk * 40 + fq * 8);
              f32x4 acc = stt[q]; acc = __builtin_amdgcn_mfma_f32_16x16x32_bf16(ua, bb, acc, 0, 0, 0); acc = __builtin_amdgcn_mfma_f32_16x16x32_bf16(va, kb, acc, 0, 0, 0);
              const float we = Wend[kk]; acc = acc * we; stt[q] = acc;
#pragma unroll
              for (int i = 0; i < 4; ++i) S0b[(vt * 16 + fq * 4 + i) * 72 + kk] = f2bf(acc[i]); } }
        __syncthreads();
        { const f32x2 y = *(LAS f32x2*)(ybuf + tl * 64 + 2 * l32);
          const float mu = half_sum(y.x + y.y, lo) * (1.0f / 64), d0 = y.x - mu, d1 = y.y - mu, var = half_sum(d0 * d0 + d1 * d1, lo) * (1.0f / 64), rs = rsqrtf(var + 64e-5f);
          Y32[(size_t)(ch * 16) * (D / 2)] = cvt_pk_nv((d0 * rs * lnw.x + lnb.x + bc0) * gc0, (d1 * rs * lnw.y + lnb.y + bc1) * gc1); }
        gc0 = gn0; gc1 = gn1; bc0 = bn0; bc1 = bn1;
    }
#undef RC_ISSUE
#undef RC_PREP
}

#define XB_TMO      128
#define XB_XCNT(j)  (256  + 64 * (j))
#define XB_XSUB(j)  (1280 + 64 * (j))
#define XB_XGEN(j)  (2304 + 64 * (j))
#define XB_TOP      3328
#define XB_TOPGEN   3392
#define XCD_BAR_WORDS 3456
#define XB_SPIN_CAP (1u << 18)

__device__ __forceinline__ unsigned xb_ld(unsigned* p)              { return __hip_atomic_load(p, __ATOMIC_RELAXED, __HIP_MEMORY_SCOPE_AGENT); }
__device__ __forceinline__ unsigned xb_add(unsigned* p, unsigned v) { return __hip_atomic_fetch_add(p, v, __ATOMIC_RELAXED, __HIP_MEMORY_SCOPE_AGENT); }
__device__ __forceinline__ unsigned xb_xcc_id() { return (unsigned)__builtin_amdgcn_s_getreg((3 << 11) | 20) & 0xFu; }
#define XB_SPIN(cond, bar) do { unsigned _sp = 0; while (cond) { __builtin_amdgcn_s_sleep(1); \
    if ((++_sp & 255u) == 0u) { if (xb_ld(&(bar)[XB_TMO])) break; if (_sp > XB_SPIN_CAP) { atomicAdd(&(bar)[XB_TMO], 1u); break; } } } } while (0)

struct XcdBarrier {
    unsigned* bar; unsigned x;
    volatile LAS unsigned* st;
};

__device__ __forceinline__ XcdBarrier xcd_barrier_post(unsigned* bar, volatile LAS unsigned* st) {
    XcdBarrier b; b.bar = bar; b.x = xb_xcc_id(); b.st = st;
    if (threadIdx.x == 0) (void)xb_add(&bar[XB_XCNT(b.x)], 1u);
    return b;
}
__device__ __forceinline__ void xcd_barrier_complete(unsigned* bar, unsigned x, unsigned& nloc, unsigned& nx) {
    const unsigned G = gridDim.x * gridDim.y * gridDim.z;
    unsigned sum, cnt, mine, sp = 0u;
    for (;;) {
        sum = 0u; cnt = 0u; mine = 0u;
#pragma unroll
        for (unsigned j = 0; j < 16; ++j) { const unsigned c = xb_ld(&bar[XB_XCNT(j)]); sum += c; cnt += (c > 0u) ? 1u : 0u; mine = (j == x) ? c : mine; }
        if (sum == G) break;
        __builtin_amdgcn_s_sleep(1);
        if ((++sp & 255u) == 0u) { if (xb_ld(&bar[XB_TMO])) break; if (sp > XB_SPIN_CAP) { atomicAdd(&bar[XB_TMO], 1u); break; } }
    }
    nloc = mine > 0u ? mine : 1u; nx = cnt > 0u ? cnt : 1u;
}

__device__ __forceinline__ void xcd_barrier(const XcdBarrier& b) {
    asm volatile("s_waitcnt vmcnt(0)" ::: "memory");
    __syncthreads();
    if (threadIdx.x == 0) {
        unsigned* bar = b.bar;
        __builtin_amdgcn_s_waitcnt(0);
        unsigned nloc = b.st[0], nx = b.st[1];
        if (nloc == 0u) { xcd_barrier_complete(bar, b.x, nloc, nx); b.st[0] = nloc; b.st[1] = nx; }
        const unsigned old = xb_add(&bar[XB_XSUB(b.x)], 1u);
        const unsigned gen = old / nloc;
        if (old + 1u == (gen + 1u) * nloc) {
            __builtin_amdgcn_fence(__ATOMIC_RELEASE, "agent");
            asm volatile("s_waitcnt vmcnt(0)" ::: "memory");
            const unsigned og = xb_add(&bar[XB_TOP], 1u);
            const unsigned tg = og / nx;
            if (og + 1u == (tg + 1u) * nx) xb_add(&bar[XB_TOPGEN], 1u);
            else XB_SPIN(xb_ld(&bar[XB_TOPGEN]) == tg, bar);
            __builtin_amdgcn_fence(__ATOMIC_ACQUIRE, "agent");
            xb_add(&bar[XB_XGEN(b.x)], 1u);
            asm volatile("s_waitcnt vmcnt(0)" ::: "memory");
        } else {
            XB_SPIN(xb_ld(&bar[XB_XGEN(b.x)]) == gen, bar);
            __builtin_amdgcn_fence(__ATOMIC_ACQUIRE, "agent");
            asm volatile("s_waitcnt vmcnt(0)" ::: "memory");
        }
    }
    __syncthreads();
}


__global__ __launch_bounds__(512, 2) void mega(const Params p_arg) {
    extern __shared__ __attribute__((aligned(16))) unsigned char shm[];
    const Params& p = *(const Params*)(const void*)__builtin_amdgcn_kernarg_segment_ptr();
    LAS unsigned char* lds = (LAS unsigned char*)shm;
    const int G = (int)gridDim.x, bid = (int)blockIdx.x;
    __shared__ uint4 xb_words;
    if (threadIdx.x == 0) xb_words = make_uint4(0u, 0u, 0u, 0u);
    __syncthreads();
    (void)xcd_barrier_post((unsigned*)(p.ws + WS_BAR), (volatile LAS unsigned*)&xb_words);
    const int step_lo = p.step_lo, step_hi = p.step_hi;
    for (int s = step_lo; s < step_hi; ++s) {
        const int kind = p.kind[s], lo = p.lo[s], hi = p.hi[s];
        switch (kind) {
            case K_PRE0:
#ifndef NO_PRE
 convert_tiles(p, lo, hi, lds); rope_table(p); norm_rows(p.in[0], p.in[1], (bf16_t*)(p.ws + WS_H));
#endif
 break;
            case K_GEMMB:
#ifndef NO_GB

                { pg8::Gemm g; g.A = p.g[lo].A; g.Bt = p.g[lo].Bt; g.M = p.g[lo].M; g.N = p.g[lo].N; g.K = p.g[lo].K;
                  MultiOrder S; S.ops = &p.g[lo]; S.nops = hi - lo; S.G = G; S.c = bid;
                  EpiB E; E.ops = &p.g[lo];
                  pg8::gemm_phase<EpiB, MultiOrder, false>(lds, g, S, E, nullptr); }
                if (p.chi[s] > p.clo[s]) convert_queue(p, p.clo[s], p.chi[s], (unsigned*)(p.ws + WS_BAR + 16384) + 64 * p.cq[s], lds);
#endif
                break;
            case K_GEMMF:
#ifndef NO_GF

                for (int i = lo; i < hi; ++i) { const GemmOp& o = p.g[i]; pg8::Gemm g; g.A = o.A; g.Bt = o.Bt; g.M = o.M; g.N = o.N; g.K = o.K;
                    pg8::StaticOrder S; S.init(o.M, o.N, G, (bid + G - (o.rot % G)) % G);
                    EpiF E; E.C = (float*)o.out; E.ldc = o.ldc; E.res = o.res;
                    pg8::gemm_phase<EpiF, pg8::StaticOrder, false>(lds, g, S, E, nullptr); }
#endif
                break;
            case K_CONVSSD:
#ifndef NO_CONV
 conv_ssd(p);
#endif
 break;
            case K_MIX0:

#ifndef NO_SSD
for (int j = bid; j < 256; j += G) ssd_chunk_job(p, j, lds);
#endif


#ifndef NO_ATT
for (int j = bid; j < 512; j += G) attn_job(p, j, lds);
#endif

                break;
            case K_POST0: post_ssd(p); break;
            case K_NORM: norm_rows(p.out, p.in[2] + lo * D, (bf16_t*)(p.ws + WS_H)); break;
            case K_PRE1: convert_tiles(p, lo, hi, lds); mix_rows(p.out, p.in[1] + D, p.in[16], (bf16_t*)(p.ws + WS_MIX), 0, lds); break;
            case K_MIXES: mix_rows(p.out, p.in[1] + D, p.in[16], (bf16_t*)(p.ws + WS_MIX), 8192, lds); break;
            case K_RWKV:
#ifndef NO_RWKV
 for (int j = bid; j < 256; j += G) rwkv_chunk_job(p, j, lds);
#endif
 break;
            case K_NORMCONV: convert_tiles(p, lo, hi, lds); norm_rows(p.out, p.in[2] + D, (bf16_t*)(p.ws + WS_H)); break;
            default: break;
        }
        if (s + 1 < step_hi) { if (step_hi < 0) cg::this_grid().sync();   XcdBarrier xb; xb.bar = (unsigned*)(p.ws + WS_BAR); xb.x = xb_xcc_id(); xb.st = (volatile LAS unsigned*)&xb_words; xcd_barrier(xb); }
    }
}

#ifndef MK_MULTI
#define MK_MULTI 0
#endif
extern "C" void kernel_launch(void* const* d_in, const int* in_sizes, int n_in, void* d_out, int out_size, void* d_ws, size_t ws_size, hipStream_t stream) {
    static int grid = 0;
    if (grid == 0) {
        int dev = 0, cus = 0, per_cu = 0;
        hipGetDevice(&dev); hipDeviceGetAttribute(&cus, hipDeviceAttributeMultiprocessorCount, dev);
        if (hipFuncSetAttribute((const void*)mega, hipFuncAttributeMaxDynamicSharedMemorySize, LDS_BYTES) != hipSuccess) { fprintf(stderr, "hipFuncSetAttribute failed\n"); grid = -1; return; }
        if (hipOccupancyMaxActiveBlocksPerMultiprocessor(&per_cu, (const void*)mega, 512, LDS_BYTES) != hipSuccess || per_cu < 1) { fprintf(stderr, "occupancy query: %d\n", per_cu); per_cu = 1; }
        (void)hipGetLastError();
        grid = cus * per_cu; if (grid > 256) grid = 256;
        if (n_in != 34 || ws_size < 512 * MiB) { fprintf(stderr, "unexpected n_in %d / ws %zu\n", n_in, ws_size); grid = -1; return; }
    }
    if (grid < 0) return;
    static Params p;
    memset(&p, 0, sizeof(p));
    for (int i = 0; i < 34; ++i) p.in[i] = (const float*)d_in[i];
    p.out = (float*)d_out; p.ws = (unsigned char*)d_ws;
    unsigned char* ws = (unsigned char*)d_ws;
    auto B16 = [&](size_t off) { return (bf16_t*)(ws + off); };
    int ncj = 0, tile_acc = 0;
    auto CJ = [&](const float* src, size_t dst_off, int K, int N, int Kpad, int Npad) { ConvJob& c = p.cj[ncj++]; c.src = src; c.dst = B16(dst_off); c.K = K; c.N = N; c.Kpad = Kpad; c.Npad = Npad; c.tile0 = tile_acc; c.ntiles = (Kpad / 64) * (Npad / 256); tile_acc += c.ntiles; };
    const float* w_up = p.in[3]; const float* w_down = p.in[4];
    tile_acc = 0;
    CJ(p.in[5], WS_WBA, 2048, 4112, 2048, 4352); CJ(p.in[15], WS_WBA + 17 * MiB, 2048, 2048, 2048, 2048);
    tile_acc = 0;
    CJ(w_up, WS_WMLP, 2048, 8192, 2048, 8192); CJ(w_down, WS_WMLP + 32 * MiB, 8192, 2048, 8192, 2048);
    tile_acc = 0;
    CJ(p.in[28], WS_WBA, 2048, 2048, 2048, 2048); CJ(p.in[29], WS_WBA + 8 * MiB, 2048, 2048, 2048, 2048); CJ(p.in[30], WS_WBA + 16 * MiB, 2048, 2048, 2048, 2048); CJ(p.in[31], WS_WBA + 24 * MiB, 2048, 2048, 2048, 2048);
    CJ(p.in[18], WS_WBA + 32 * MiB, 2048, 96, 2048, 256); CJ(p.in[21], WS_WBA + 33 * MiB, 2048, 96, 2048, 256); CJ(p.in[23], WS_WBA + 34 * MiB, 2048, 256, 2048, 256);
    CJ(p.in[19], WS_WBA + 35 * MiB, 96, 2048, 256, 2048); CJ(p.in[22], WS_WBA + 36 * MiB, 96, 2048, 256, 2048); CJ(p.in[24], WS_WBA + 37 * MiB, 256, 2048, 256, 2048);
    tile_acc = 0;
    CJ(w_up + (size_t)2048 * 8192, WS_WMLP1, 2048, 8192, 2048, 8192); CJ(w_down + (size_t)2048 * 8192, WS_WMLP1 + 32 * MiB, 8192, 2048, 8192, 2048);
    int nop = 0;
    auto GO = [&](const bf16_t* A, const bf16_t* Bt, void* out, const float* bias, const float* res, int M, int N, int K, int ldc, int act, int rot) {
        GemmOp& o = p.g[nop++]; o.A = A; o.Bt = Bt; o.out = out; o.bias = bias; o.res = res; o.M = M; o.N = N; o.K = K; o.ldc = ldc; o.act = act; o.rot = rot; };
    GO(B16(WS_H), B16(WS_WBA), B16(WS_PROJ), nullptr, nullptr, MTOK, INWP, 2048, INWP, 0, 0);
    GO(B16(WS_YMIX), B16(WS_WBA + 17 * MiB), d_out, nullptr, p.in[0], MTOK, 2048, 2048, 2048, 0, 0);
    GO(B16(WS_H), B16(WS_WMLP), B16(WS_U), nullptr, nullptr, MTOK, DFF, 2048, DFF, 1, 0);
    GO(B16(WS_U), B16(WS_WMLP + 32 * MiB), d_out, nullptr, (const float*)d_out, MTOK, 2048, DFF, 2048, 0, 0);
    for (int half = 0; half < 2; ++half) {
        const size_t ro = (size_t)half * 8192 * 2048 * 2, lo_ = (size_t)half * 8192 * 256 * 2; const size_t mb = (size_t)8192 * 2048 * 2;
        GO(B16(WS_MIX + 0 * mb), B16(WS_WBA), B16(WS_R + ro), nullptr, nullptr, 8192, 2048, 2048, 2048, 0, 0);
        GO(B16(WS_MIX + 2 * mb), B16(WS_WBA + 8 * MiB), B16(WS_K + ro), nullptr, nullptr, 8192, 2048, 2048, 2048, 0, 0);
        GO(B16(WS_MIX + 3 * mb), B16(WS_WBA + 16 * MiB), B16(WS_V + ro), nullptr, nullptr, 8192, 2048, 2048, 2048, 0, 0);
        GO(B16(WS_MIX + 1 * mb), B16(WS_WBA + 32 * MiB), B16(WS_L1W + lo_), nullptr, nullptr, 8192, 256, 2048, 256, 2, 0);
        GO(B16(WS_MIX + 4 * mb), B16(WS_WBA + 33 * MiB), B16(WS_L1A + lo_), nullptr, nullptr, 8192, 256, 2048, 256, 0, 32);
        GO(B16(WS_MIX + 5 * mb), B16(WS_WBA + 34 * MiB), B16(WS_L1G + lo_), nullptr, nullptr, 8192, 256, 2048, 256, 3, 64);
    }
    GO(B16(WS_L1W), B16(WS_WBA + 35 * MiB), B16(WS_WDEC), p.in[17], nullptr, MTOK, 2048, 256, 2048, 4, 0);
    GO(B16(WS_L1A), B16(WS_WBA + 36 * MiB), B16(WS_AA), p.in[20], nullptr, MTOK, 2048, 256, 2048, 3, 0);
    GO(B16(WS_L1G), B16(WS_WBA + 37 * MiB), B16(WS_GG), nullptr, nullptr, MTOK, 2048, 256, 2048, 0, 0);
    GO(B16(WS_YG), B16(WS_WBA + 24 * MiB), d_out, nullptr, (const float*)d_out, MTOK, 2048, 2048, 2048, 0, 0);
    GO(B16(WS_H), B16(WS_WMLP1), B16(WS_U), nullptr, nullptr, MTOK, DFF, 2048, DFF, 1, 0);
    GO(B16(WS_U), B16(WS_WMLP1 + 32 * MiB), d_out, nullptr, (const float*)d_out, MTOK, 2048, DFF, 2048, 0, 0);
    int ns = 0;
    auto ST = [&](int kind, int lo, int hi, int clo = 0, int chi = 0, int cq = 0) { p.kind[ns] = kind; p.lo[ns] = lo; p.hi[ns] = hi; p.clo[ns] = clo; p.chi[ns] = chi; p.cq[ns] = cq; ++ns; };
    ST(K_PRE0, 0, 2); ST(K_GEMMB, 0, 1, 2, 4, 0); ST(K_CONVSSD, 0, 0); ST(K_MIX0, 0, 0); ST(K_POST0, 0, 0); ST(K_GEMMF, 1, 2); ST(K_NORM, 0, 0); ST(K_GEMMB, 2, 3); ST(K_GEMMF, 3, 4);
    ST(K_PRE1, 4, 14); ST(K_GEMMB, 4, 10, 14, 16, 1); ST(K_MIXES, 0, 0); ST(K_GEMMB, 10, 16, 14, 16, 1); ST(K_GEMMB, 16, 19); ST(K_RWKV, 0, 0); ST(K_GEMMF, 19, 20); ST(K_NORM, 1, 0); ST(K_GEMMB, 20, 21); ST(K_GEMMF, 21, 22);
    (void)hipMemsetAsync(ws + WS_BAR, 0, 16384 + 1024, stream);
#if MK_MULTI
    for (int s = 0; s < ns; ++s) { p.step_lo = s; p.step_hi = s + 1; hipLaunchKernelGGL(mega, dim3(grid), dim3(512), LDS_BYTES, stream, p); }
#else
    p.step_lo = 0; p.step_hi = ns;
    void* args[] = {(void*)&p};
    const hipError_t e = hipLaunchCooperativeKernel((const void*)mega, dim3(grid), dim3(512), args, LDS_BYTES, stream);
    if (e != hipSuccess) fprintf(stderr, "cooperative launch failed: %s (grid %d)\n", hipGetErrorString(e), grid);
#endif
}
```

```cpp
#include <hip/hip_runtime.h>
#include <hip/hip_cooperative_groups.h>
#include <cstdio>
#include <cstring>
namespace cg = cooperative_groups;
__device__ __forceinline__ int opq(int v) { asm volatile("" : "+v"(v)); return v; }
namespace pg8 {
#define PG8_LAS __attribute__((address_space(3)))
typedef unsigned short bf16_t;
typedef short bf16x8 __attribute__((ext_vector_type(8)));
typedef float f32x4 __attribute__((ext_vector_type(4)));
typedef unsigned u32x4 __attribute__((ext_vector_type(4)));
constexpr int BM = 256, BK = 64, HALF = 128, HTB = HALF * BK * 2  , STAGE_BYTES = 8 * HTB, NXCD = 8, WGM = 8;

__host__ __device__ __forceinline__ int lds_byte(int r, int c) { const int st = (r >> 4) * 2 + (c >> 5), rr = r & 15, cc = c & 31, ob = rr * 64 + cc * 2; return st * 1024 + (ob ^ (((ob >> 9) & 1) << 5)); }
__host__ __device__ __forceinline__ void stage_rc(int b, int& R, int& C) { const int st = b / 1024, sb = b % 1024, swz = sb ^ (((sb >> 9) & 1) << 5); R = (st >> 1) * 16 + swz / 64; C = (st & 1) * 32 + (swz % 64) / 2; }
__host__ __device__ __forceinline__ int perm32(int rho) { const int n = rho >> 4, i = rho & 15; return 8 * (i >> 2) + 4 * n + (i & 3); }

struct Unit { int pm, pn, op; };
struct Gemm { const bf16_t* A; const bf16_t* Bt; int M, N, K; };

struct StaticOrder {
    int nM, nN, nwg, G, c;
    __host__ __device__ void init(int M, int N, int G_, int c_) { nM = M / BM; nN = N / BM; nwg = nM * nN; G = G_; c = c_; }
    __host__ __device__ bool next(int i, Unit& u) const {
        const long L = (long)i * G + c; if (L >= nwg) return false;
        int wgid = (int)L; { const int q = nwg / NXCD, r = nwg % NXCD, xcd = wgid % NXCD, off = wgid / NXCD; wgid = (xcd < r ? xcd * (q + 1) : r * (q + 1) + (xcd - r) * q) + off; }
        const int nig = WGM * nN, gid = wgid / nig, fm = gid * WGM, gsz = (nM - fm) < WGM ? (nM - fm) : WGM;
        u.pm = fm + ((wgid % nig) % gsz); u.pn = (wgid % nig) / gsz; u.op = 0; return true;
    }
    __device__ __forceinline__ const char* abase(const Unit&, const Gemm& g) const { return (const char*)g.A; }
    __device__ __forceinline__ const char* bbase(const Unit&, const Gemm& g) const { return (const char*)g.Bt; }
    __device__ __forceinline__ void a_ready(const Unit&) const {}
    __device__ __forceinline__ void done(const Unit&) const {}
};
typedef __bf16 bf16x2_t __attribute__((ext_vector_type(2)));
typedef float f32x2_t __attribute__((ext_vector_type(2)));
__device__ __forceinline__ unsigned cvt_pk_bf16(float lo, float hi) { const f32x2_t f = {lo, hi}; const bf16x2_t v = __builtin_convertvector(f, bf16x2_t); return __builtin_bit_cast(unsigned, v); }
__device__ __forceinline__ unsigned cvt_pk_nv(float lo, float hi) { return cvt_pk_bf16(lo, hi); }

template <class Epi, class Sched, bool STAMP = false>
__device__ __forceinline__ void gemm_phase(PG8_LAS unsigned char* lds, const Gemm g, const Sched& S, const Epi& E, unsigned long long* stamps) {
    const int tid = opq(threadIdx.x), wid = __builtin_amdgcn_readfirstlane(tid >> 6), lane = tid & 63, wr = wid >> 2, wc = wid & 3, fr = lane & 15, fq = lane >> 4;
    const int K = g.K, nt = K / BK;
    int ts_lo = 0, ts_hi = 0, nts = 0; const unsigned long long rt_entry = STAMP ? (unsigned long long)wall_clock64() : 0ull;
#define PG8_STAMP() do { if (STAMP && wid == 0 && nts < 64) { const unsigned long long _c = (unsigned long long)clock64(); \
        ts_lo = (lane == nts) ? (int)(unsigned)_c : ts_lo; ts_hi = (lane == nts) ? (int)(unsigned)(_c >> 32) : ts_hi; ++nts; } } while (0)
    PG8_STAMP();
    unsigned voffA[2], voffB[2];
#pragma unroll
    for (int i = 0; i < 2; ++i) { int R, C; stage_rc(tid * 16 + i * 8192, R, C); const int Rb = Epi::PERM ? ((R & ~31) + perm32(R & 31)) : R;
        voffA[i] = (unsigned)(R * K + C) * 2u; voffB[i] = (unsigned)(Rb * K + C) * 2u; }
    const size_t kstep = (size_t)(BK * 2);
    const size_t hstep = (size_t)HALF * K * 2;
    const size_t tstep = 2 * hstep;
    const unsigned ldsw = (unsigned)wid * 1024u;
    const int aoff = lds_byte(wr * 64 + fr, fq * 8), boff = lds_byte(wc * 32 + fr, fq * 8);
#define PG8_SA(b, h) (((b) * 2 + (h)) * HTB)
#define PG8_SB(b, h) ((4 + (b) * 2 + (h)) * HTB)
#define PG8_STAGE(bufoff, gbase, voff) do { _Pragma("unroll") for (int _i = 0; _i < 2; ++_i) \
        __builtin_amdgcn_global_load_lds((const unsigned*)((const char*)(gbase) + (voff)[_i]), (PG8_LAS unsigned*)(lds + (bufoff) + ldsw + _i * 8192), 16, 0, 0); } while (0)
#define PG8_LDA(dst, b, h) do { _Pragma("unroll") for (int m = 0; m < 4; ++m) _Pragma("unroll") for (int k = 0; k < 2; ++k) dst[m][k] = *(const PG8_LAS bf16x8*)(lds + PG8_SA(b, h) + aoff + m * 2048 + k * 1024); } while (0)
#define PG8_LDB(dst, b, h) do { _Pragma("unroll") for (int n = 0; n < 2; ++n) _Pragma("unroll") for (int k = 0; k < 2; ++k) dst[n][k] = *(const PG8_LAS bf16x8*)(lds + PG8_SB(b, h) + boff + n * 2048 + k * 1024); } while (0)
#define PG8_MMA(ai, bj, At, Bt) do { __builtin_amdgcn_s_setprio(1); _Pragma("unroll") for (int m = 0; m < 4; ++m) _Pragma("unroll") for (int n = 0; n < 2; ++n) _Pragma("unroll") for (int k = 0; k < 2; ++k) \
        acc[ai][bj][m][n] = __builtin_amdgcn_mfma_f32_16x16x32_bf16(Bt[n][k], At[m][k], acc[ai][bj][m][n], 0, 0, 0); __builtin_amdgcn_s_setprio(0); } while (0)
#define PG8_WAIT_V(n) asm volatile("s_waitcnt vmcnt(" #n ")" ::: "memory")
#define PG8_WAIT_L(n) asm volatile("s_waitcnt lgkmcnt(" #n ")" ::: "memory")
#define PG8_BAR __builtin_amdgcn_s_barrier()
#define PG8_SCHED __builtin_amdgcn_sched_barrier(0)
    Unit cur, nxt; int ui = 0;
    if (!S.next(0, cur)) return;
    f32x4 acc[2][2][4][2];
#pragma unroll
    for (int a = 0; a < 2; ++a)
#pragma unroll
        for (int b = 0; b < 2; ++b)
#pragma unroll
            for (int m = 0; m < 4; ++m)
#pragma unroll
                for (int n = 0; n < 2; ++n) acc[a][b][m][n] = (f32x4){0.f, 0.f, 0.f, 0.f};
    bf16x8 At[4][2], B0[2][2], B1[2][2];
    const char* cA = S.abase(cur, g) + (size_t)cur.pm * tstep; const char* cB = S.bbase(cur, g) + (size_t)cur.pn * tstep;
    S.a_ready(cur);
    PG8_STAGE(PG8_SB(0, 0), cB, voffB); PG8_STAGE(PG8_SA(0, 0), cA, voffA); PG8_STAGE(PG8_SB(0, 1), cB + hstep, voffB); PG8_STAGE(PG8_SA(0, 1), cA + hstep, voffA);
    if (wr == 1) PG8_BAR;
    PG8_WAIT_V(4); PG8_BAR;
    PG8_STAGE(PG8_SB(1, 0), cB + kstep, voffB); PG8_STAGE(PG8_SA(1, 0), cA + kstep, voffA); PG8_STAGE(PG8_SB(1, 1), cB + hstep + kstep, voffB);
    PG8_WAIT_V(6); PG8_BAR;
    PG8_STAMP();
    for (;;) {
        const bool has_next = S.next(ui + 1, nxt);
        const char* nA = has_next ? S.abase(nxt, g) + (size_t)nxt.pm * tstep : cA; const char* nB = has_next ? S.bbase(nxt, g) + (size_t)nxt.pn * tstep : cB;
        for (int t = 0; t < nt; t += 2) {
            const bool last = (t == nt - 2);
            const char* a1 = cA + (size_t)(t + 1) * kstep;
            const char* a2 = last ? nA : cA + (size_t)(t + 2) * kstep; const char* b2 = last ? nB : cB + (size_t)(t + 2) * kstep;
            const char* a3 = a2 + kstep; const char* b3 = b2 + kstep;
            if (last && has_next) S.a_ready(nxt);
            PG8_LDB(B0, 0, 0); PG8_SCHED; PG8_LDA(At, 0, 0); PG8_STAGE(PG8_SA(1, 1), a1 + hstep, voffA);
            PG8_WAIT_L(8); PG8_BAR; PG8_WAIT_L(0); PG8_MMA(0, 0, At, B0); PG8_BAR; PG8_SCHED;
            PG8_LDB(B1, 0, 1); PG8_STAGE(PG8_SB(0, 0), b2, voffB);
            PG8_BAR; PG8_WAIT_L(0); PG8_MMA(0, 1, At, B1); PG8_BAR;
            PG8_LDA(At, 0, 1); PG8_STAGE(PG8_SA(0, 0), a2, voffA);
            PG8_BAR; PG8_WAIT_L(0); PG8_MMA(1, 0, At, B0); PG8_BAR; PG8_SCHED;
            PG8_STAGE(PG8_SB(0, 1), b2 + hstep, voffB);
            PG8_WAIT_V(6); PG8_BAR; PG8_MMA(1, 1, At, B1); PG8_BAR;
            PG8_LDB(B0, 1, 0); PG8_SCHED; PG8_LDA(At, 1, 0); PG8_STAGE(PG8_SA(0, 1), a2 + hstep, voffA);
            PG8_WAIT_L(8); PG8_BAR; PG8_WAIT_L(0); PG8_MMA(0, 0, At, B0); PG8_BAR; PG8_SCHED;
            PG8_LDB(B1, 1, 1); PG8_STAGE(PG8_SB(1, 0), b3, voffB);
            PG8_BAR; PG8_WAIT_L(0); PG8_MMA(0, 1, At, B1); PG8_BAR;
            PG8_LDA(At, 1, 1); PG8_STAGE(PG8_SA(1, 0), a3, voffA);
            PG8_BAR; PG8_WAIT_L(0); PG8_MMA(1, 0, At, B0); PG8_BAR; PG8_SCHED;
            PG8_STAGE(PG8_SB(1, 1), b3 + hstep, voffB);
            PG8_WAIT_V(6); PG8_BAR; PG8_MMA(1, 1, At, B1); PG8_BAR;
        }
        PG8_STAMP();
        if constexpr (!Epi::AFTER_DRAIN) { E(acc, cur, wr, wc, fr, fq); S.done(cur); }
        PG8_STAMP();
        if (!has_next) break;
#pragma unroll
        for (int a = 0; a < 2; ++a)
#pragma unroll
            for (int b = 0; b < 2; ++b)
#pragma unroll
                for (int m = 0; m < 4; ++m)
#pragma unroll
                    for (int n = 0; n < 2; ++n) acc[a][b][m][n] = (f32x4){0.f, 0.f, 0.f, 0.f};
        cur = nxt; cA = nA; cB = nB; ++ui;
    }
    PG8_WAIT_V(0);
    if (wr == 0) PG8_BAR;
    PG8_BAR;
    if constexpr (Epi::AFTER_DRAIN) { E.fused(acc, cur, wr, wc, fr, fq, lds, wid, lane); S.done(cur); }
    PG8_STAMP();
    if (STAMP && wid == 0) { stamps[lane] = lane < nts ? (((unsigned long long)(unsigned)ts_hi << 32) | (unsigned)ts_lo) : 0ull;
        if (lane == 62) stamps[62] = rt_entry; if (lane == 63) stamps[63] = (unsigned long long)wall_clock64(); }
#undef PG8_STAMP
#undef PG8_SA
#undef PG8_SB
#undef PG8_STAGE
#undef PG8_LDA
#undef PG8_LDB
#undef PG8_MMA
#undef PG8_WAIT_V
#undef PG8_WAIT_L
#undef PG8_BAR
#undef PG8_SCHED
}
}

#include <cstdio>
#include <ctime>
#include <cstdlib>
#include <cstring>
#include <cmath>
#include <vector>
#include <algorithm>
#define CK(x) do { hipError_t e_ = (x); if (e_ != hipSuccess) { fprintf(stderr, "HIP %s:%d %s\n", __FILE__, __LINE__, hipGetErrorString(e_)); exit(2); } } while (0)
using pg8::bf16_t; using pg8::bf16x8; using pg8::f32x4; using pg8::u32x4; using pg8::cvt_pk_bf16; using pg8::cvt_pk_nv;
#define LAS PG8_LAS

constexpr int D = 2048, SEQ = 2048, MTOK = 16384, DFF = 8192, INWP = 4352;
constexpr int COL_K = 1024, COL_V = 1280, COL_Z = 1536, COL_XBC = 2560, COL_DT = 4096;
constexpr size_t MiB = (size_t)1 << 20;
constexpr size_t WS_WBA = 0, WS_WMLP = 40 * MiB, WS_H = 104 * MiB, WS_PROJ = 168 * MiB, WS_YMIX = 304 * MiB, WS_YRAW = 368 * MiB, WS_XBC = 432 * MiB,
                 WS_DT = 480 * MiB, WS_DA = 481 * MiB, WS_ROPE = 482 * MiB, WS_U = 168 * MiB;
constexpr size_t WS_R = 40 * MiB, WS_K = 104 * MiB, WS_V = 168 * MiB, WS_L1W = 232 * MiB, WS_L1A = 240 * MiB, WS_L1G = 248 * MiB, WS_MIX = 256 * MiB,
                 WS_WDEC = 256 * MiB, WS_AA = 320 * MiB, WS_GG = 384 * MiB, WS_YG = 40 * MiB  , WS_WMLP1 = 448 * MiB;
constexpr size_t WS_BAR = 39 * MiB;
constexpr int LDS_BYTES = 140 * 1024;

enum { K_PRE0 = 0, K_GEMMB, K_GEMMF, K_CONVSSD, K_MIX0, K_POST0, K_NORM, K_PRE1, K_MIXES, K_RWKV, K_NORMCONV };
constexpr int NSTEPS = 48, NOPS = 22, NCJ = 16;
#define REP_GEMMB 1
#define REP_MIX0 1
#define REP_RWKV 1
#define REP_ELEM 1

struct GemmOp { const bf16_t* A; const bf16_t* Bt; void* out; const float* bias; const float* res; int M, N, K, ldc, act, rot, pad0, pad1; };
struct ConvJob { const float* src; bf16_t* dst; int K, N, Kpad, Npad, tile0, ntiles; };
struct Params {
    const float* in[34];
    float* out; unsigned char* ws;
    GemmOp g[NOPS];
    ConvJob cj[NCJ];
    int kind[NSTEPS + 1]; int lo[NSTEPS + 1]; int hi[NSTEPS + 1]; int clo[NSTEPS + 1]; int chi[NSTEPS + 1]; int cq[NSTEPS + 1];
    int step_lo, step_hi;
};

__device__ __forceinline__ float bf2f(unsigned short b) { return __uint_as_float(((unsigned)b) << 16); }
__device__ __forceinline__ float bflo(unsigned w) { return __uint_as_float(w << 16); }
__device__ __forceinline__ float bfhi(unsigned w) { return __uint_as_float(w & 0xffff0000u); }
__device__ __forceinline__ bf16_t f2bf(float f) { return (bf16_t)(cvt_pk_bf16(f, 0.f) & 0xffffu); }
template <int CTRL> __device__ __forceinline__ float dpp_add(float x) {
    const int y = __builtin_amdgcn_update_dpp(0, __builtin_bit_cast(int, x), CTRL, 0xf, 0xf, true);
    return x + __builtin_bit_cast(float, y); }
template <int CTRL> __device__ __forceinline__ float dpp_max(float x) {
    const int y = __builtin_amdgcn_update_dpp(0, __builtin_bit_cast(int, x), CTRL, 0xf, 0xf, true);
    return fmaxf(x, __builtin_bit_cast(float, y)); }
__device__ __forceinline__ float max16(float x) { x = dpp_max<0xB1>(x); x = dpp_max<0x4E>(x); x = dpp_max<0x141>(x); x = dpp_max<0x140>(x); return x; }
__device__ __forceinline__ float red8(float x) { x = dpp_add<0xB1>(x); x = dpp_add<0x4E>(x); x = dpp_add<0x141>(x); return x; }
__device__ __forceinline__ float red16(float x) { x = red8(x); x = dpp_add<0x140>(x); return x; }
__device__ __forceinline__ float wave_sum(float v) {
    v = red16(v);
    const float r0 = __builtin_bit_cast(float, __builtin_amdgcn_readlane(__builtin_bit_cast(int, v), 0)), r1 = __builtin_bit_cast(float, __builtin_amdgcn_readlane(__builtin_bit_cast(int, v), 16));
    const float r2 = __builtin_bit_cast(float, __builtin_amdgcn_readlane(__builtin_bit_cast(int, v), 32)), r3 = __builtin_bit_cast(float, __builtin_amdgcn_readlane(__builtin_bit_cast(int, v), 48));
    return (r0 + r1) + (r2 + r3); }
typedef float f32x2 __attribute__((ext_vector_type(2)));
typedef unsigned u32x2 __attribute__((ext_vector_type(2)));
__device__ __forceinline__ float sigmoidf_(float v) { return __builtin_amdgcn_rcpf(1.0f + __expf(-v)); }
__device__ __forceinline__ void unpack8(const uint4 r, float (&f)[8]) {
    f[0] = bflo(r.x); f[1] = bfhi(r.x); f[2] = bflo(r.y); f[3] = bfhi(r.y); f[4] = bflo(r.z); f[5] = bfhi(r.z); f[6] = bflo(r.w); f[7] = bfhi(r.w); }

__device__ __forceinline__ float act_apply(float v, int act) {
    switch (act) {
        case 1: { const float r = fmaxf(v, 0.f); return r * r; }
        case 2: return 1.0f - 2.0f * __builtin_amdgcn_rcpf(1.0f + __expf(2.0f * v));
        case 3: return sigmoidf_(v);
        case 4: return 0.60653066f * sigmoidf_(v);
        default: return v; }
}
struct EpiB {
    static constexpr bool PERM = true, AFTER_DRAIN = false;
    const GemmOp* ops;
    __device__ __forceinline__ void operator()(const f32x4 (&acc)[2][2][4][2], const pg8::Unit& u, int wr, int wc, int fr, int fq) const {
        const GemmOp& o_ = ops[u.op]; bf16_t* O = (bf16_t*)o_.out; const int ldc = o_.ldc; const float* bias = o_.bias; const int act = o_.act;
        const int row0 = u.pm * 256 + wr * 64 + fr, col0 = u.pn * 256 + wc * 32 + 8 * fq;
        f32x4 bv[2][2];
#pragma unroll
        for (int bj = 0; bj < 2; ++bj)
#pragma unroll
            for (int n = 0; n < 2; ++n) bv[bj][n] = bias ? *(const f32x4*)(bias + col0 + bj * 128 + 4 * n) : (f32x4){0.f, 0.f, 0.f, 0.f};
#pragma unroll
        for (int ai = 0; ai < 2; ++ai)
#pragma unroll
            for (int m = 0; m < 4; ++m) { bf16_t* rowp = O + (size_t)(row0 + ai * 128 + m * 16) * ldc + col0;
#pragma unroll
                for (int bj = 0; bj < 2; ++bj) { f32x4 v0 = acc[ai][bj][m][0], v1 = acc[ai][bj][m][1];
                    v0 += bv[bj][0]; v1 += bv[bj][1];
                    if (act) {
#pragma unroll
                        for (int j = 0; j < 4; ++j) { v0[j] = act_apply(v0[j], act); v1[j] = act_apply(v1[j], act); } }
                    u32x4 w; w.x = cvt_pk_bf16(v0[0], v0[1]); w.y = cvt_pk_bf16(v0[2], v0[3]); w.z = cvt_pk_bf16(v1[0], v1[1]); w.w = cvt_pk_bf16(v1[2], v1[3]);
                    *(u32x4*)(rowp + bj * 128) = w; } }
    }
};
struct MultiOrder {
    const GemmOp* ops; int nops, G, c;
    __device__ __forceinline__ bool next(int i, pg8::Unit& u) const {
        long L = (long)i * G + c; int k = 0, nM = 0, nN = 0, nwg = 0;
        for (; k < nops; ++k) { nM = ops[k].M / 256; nN = ops[k].N / 256; nwg = nM * nN; if (L < nwg) break; L -= nwg; }
        if (k == nops) return false;
        int wgid = (int)L; { const int q = nwg / pg8::NXCD, r = nwg % pg8::NXCD, xcd = wgid % pg8::NXCD, off = wgid / pg8::NXCD; wgid = (xcd < r ? xcd * (q + 1) : r * (q + 1) + (xcd - r) * q) + off; }
        const int nig = pg8::WGM * nN, gid = wgid / nig, fm = gid * pg8::WGM, gsz = (nM - fm) < pg8::WGM ? (nM - fm) : pg8::WGM;
        u.pm = fm + ((wgid % nig) % gsz); u.pn = (wgid % nig) / gsz; u.op = k; return true;
    }
    __device__ __forceinline__ const char* abase(const pg8::Unit& u, const pg8::Gemm&) const { return (const char*)ops[u.op].A; }
    __device__ __forceinline__ const char* bbase(const pg8::Unit& u, const pg8::Gemm&) const { return (const char*)ops[u.op].Bt; }
    __device__ __forceinline__ void a_ready(const pg8::Unit&) const {}
    __device__ __forceinline__ void done(const pg8::Unit&) const {}
};
struct EpiF {
    static constexpr bool PERM = false, AFTER_DRAIN = false;
    float* C; int ldc; const float* res;
    __device__ __forceinline__ void operator()(const f32x4 (&acc)[2][2][4][2], const pg8::Unit& u, int wr, int wc, int fr, int fq) const {
        const int row0 = u.pm * 256 + wr * 64 + fr, col0 = u.pn * 256 + wc * 32 + 4 * fq;
#pragma unroll
        for (int ai = 0; ai < 2; ++ai)
#pragma unroll
            for (int mh = 0; mh < 2; ++mh) { size_t ro[2]; f32x4 r[2][2][2];
#pragma unroll
                for (int mm = 0; mm < 2; ++mm) { ro[mm] = (size_t)(row0 + ai * 128 + (mh * 2 + mm) * 16) * ldc + col0;
#pragma unroll
                    for (int bj = 0; bj < 2; ++bj)
#pragma unroll
                        for (int n = 0; n < 2; ++n) r[mm][bj][n] = *(const f32x4*)(res + ro[mm] + bj * 128 + n * 16); }
#pragma unroll
                for (int mm = 0; mm < 2; ++mm)
#pragma unroll
                    for (int bj = 0; bj < 2; ++bj)
#pragma unroll
                        for (int n = 0; n < 2; ++n) *(f32x4*)(C + ro[mm] + bj * 128 + n * 16) = acc[ai][bj][mh * 2 + mm][n] + r[mm][bj][n]; }
    }
};

__device__ __forceinline__ void convert_one_tile(const Params& p, int jlo, int jhi, int tile, int tid, LAS float* T) {
    int j = jlo; while (j + 1 < jhi && tile >= p.cj[j + 1].tile0) ++j;
    const float* src = p.cj[j].src; bf16_t* dst = p.cj[j].dst; const int K = p.cj[j].K, N = p.cj[j].N, Kpad = p.cj[j].Kpad;
    const int local = tile - p.cj[j].tile0, nkt = Kpad >> 6, kt = local % nkt, nt = local / nkt;
    f32x4 v[8];
#pragma unroll
    for (int i = 0; i < 8; ++i) { const int idx = tid + i * 512, kr = idx >> 6, c4 = idx & 63, k = kt * 64 + kr, n = nt * 256 + c4 * 4;
        v[i] = (f32x4){0.f, 0.f, 0.f, 0.f};
        if (k < K && n < N) v[i] = *(const f32x4*)(src + (size_t)k * N + n); }
#pragma unroll
    for (int i = 0; i < 8; ++i) { const int idx = tid + i * 512, kr = idx >> 6, c4 = idx & 63;
        T[kr * 257 + c4 * 4 + 0] = v[i][0]; T[kr * 257 + c4 * 4 + 1] = v[i][1]; T[kr * 257 + c4 * 4 + 2] = v[i][2]; T[kr * 257 + c4 * 4 + 3] = v[i][3]; }
    __syncthreads();
#pragma unroll
    for (int i = 0; i < 4; ++i) { const int idx = tid + i * 512, nl = idx >> 3, kc = idx & 7; float f[8];
#pragma unroll
        for (int e = 0; e < 8; ++e) f[e] = T[(kc * 8 + e) * 257 + nl];
        u32x4 w; w.x = cvt_pk_nv(f[0], f[1]); w.y = cvt_pk_nv(f[2], f[3]); w.z = cvt_pk_nv(f[4], f[5]); w.w = cvt_pk_nv(f[6], f[7]);
        *(u32x4*)(dst + (size_t)(nt * 256 + nl) * Kpad + kt * 64 + kc * 8) = w; }
    __syncthreads();
}
__device__ __forceinline__ void convert_tiles(const Params& p, int jlo, int jhi, LAS unsigned char* lds) {
    const int tid = opq(threadIdx.x); LAS float* T = (LAS float*)lds;
    const int total = p.cj[jhi - 1].tile0 + p.cj[jhi - 1].ntiles;
    for (int tile = blockIdx.x; tile < total; tile += gridDim.x) convert_one_tile(p, jlo, jhi, tile, tid, T);
}
__device__ __forceinline__ void convert_queue(const Params& p, int jlo, int jhi, unsigned* counter, LAS unsigned char* lds) {
    const int tid = opq(threadIdx.x); LAS float* T = (LAS float*)lds; LAS int* slot = (LAS int*)(lds + 72 * 1024);
    const int total = p.cj[jhi - 1].tile0 + p.cj[jhi - 1].ntiles;
    for (;;) {
        __syncthreads();
        if (tid == 0) *slot = (int)__hip_atomic_fetch_add(counter, 1u, __ATOMIC_RELAXED, __HIP_MEMORY_SCOPE_AGENT);
        __syncthreads();
        const int tile = *slot;
        if (tile >= total) break;
        convert_one_tile(p, jlo, jhi, tile, tid, T);
    }
}

__device__ __forceinline__ void rope_table(const Params& p) {
    float2* tab = (float2*)(p.ws + WS_ROPE);
    for (int idx = blockIdx.x * 512 + opq(threadIdx.x); idx < SEQ * 32; idx += gridDim.x * 512) {
        const int t = idx >> 5, i = idx & 31;
        const float inv = exp2f(-(float)i * 0.41524101186092029f);
        const float angf = (float)t * inv;
        const double ang = (double)angf;
        const double q = rint(ang * 0.6366197723675814);
        const float f = (float)fma(-q, 1.5707963267948966, ang), f2 = f * f;
        const float s = f * (1.0f + f2 * (-1.6666667e-1f + f2 * (8.3333333e-3f + f2 * (-1.9841270e-4f + f2 * 2.7557319e-6f))));
        const float c = 1.0f + f2 * (-0.5f + f2 * (4.1666667e-2f + f2 * (-1.3888889e-3f + f2 * (2.4801587e-5f + f2 * (-2.7557319e-7f)))));
        const int qi = ((int)q) & 3;
        const float sn = (qi == 0) ? s : (qi == 1) ? c : (qi == 2) ? -s : -c;
        const float cs = (qi == 0) ? c : (qi == 1) ? -s : (qi == 2) ? -c : s;
        tab[idx] = make_float2(cs, sn);
    }
}

__device__ __forceinline__ void norm_rows(const float* x, const float* g, bf16_t* h) {
    const int tid_ = opq(threadIdx.x); const int lane = tid_ & 63, wv = tid_ >> 6;
    f32x4 gg[8];
#pragma unroll
    for (int i = 0; i < 8; ++i) gg[i] = *(const f32x4*)(g + i * 256 + lane * 4);
    for (int row = (blockIdx.x * 8 + wv) * 2; row < MTOK; row += gridDim.x * 16) {
        const float* xr = x + (size_t)row * D; f32x4 v[8], u[8]; float ss = 0.f, st = 0.f;
#pragma unroll
        for (int i = 0; i < 8; ++i) { v[i] = *(const f32x4*)(xr + i * 256 + lane * 4); u[i] = *(const f32x4*)(xr + D + i * 256 + lane * 4); }
#pragma unroll
        for (int i = 0; i < 8; ++i) { ss += v[i][0] * v[i][0] + v[i][1] * v[i][1] + v[i][2] * v[i][2] + v[i][3] * v[i][3]; st += u[i][0] * u[i][0] + u[i][1] * u[i][1] + u[i][2] * u[i][2] + u[i][3] * u[i][3]; }
        ss = wave_sum(ss); st = wave_sum(st); const float r = rsqrtf(ss * (1.0f / D) + 1e-6f), r2 = rsqrtf(st * (1.0f / D) + 1e-6f);
#pragma unroll
        for (int i = 0; i < 8; ++i) {
            uint2 w; w.x = cvt_pk_nv(v[i][0] * r * gg[i][0], v[i][1] * r * gg[i][1]); w.y = cvt_pk_nv(v[i][2] * r * gg[i][2], v[i][3] * r * gg[i][3]);
            *(uint2*)(h + (size_t)row * D + i * 256 + lane * 4) = w;
            uint2 w2; w2.x = cvt_pk_nv(u[i][0] * r2 * gg[i][0], u[i][1] * r2 * gg[i][1]); w2.y = cvt_pk_nv(u[i][2] * r2 * gg[i][2], u[i][3] * r2 * gg[i][3]);
            *(uint2*)(h + (size_t)(row + 1) * D + i * 256 + lane * 4) = w2; }
    }
}

__device__ __forceinline__ void mix_rows(const float* x, const float* g, const float* mixw, bf16_t* mixbase, int tok0, LAS unsigned char* lds) {
    const int tid = opq(threadIdx.x), lane = tid & 63, wv = tid >> 6, c = tid * 4;
    LAS float* rs = (LAS float*)lds;
    const f32x4 gg = *(const f32x4*)(g + c); f32x4 mw[6];
#pragma unroll
    for (int m = 0; m < 6; ++m) mw[m] = *(const f32x4*)(mixw + m * D + c);
    for (int chunk = blockIdx.x; chunk < 256; chunk += gridDim.x) {
        const int rl0 = chunk * 32, tokc = tok0 + rl0; const bool hasprev = (tokc & (SEQ - 1)) != 0;
        __syncthreads();
        for (int r = wv; r < 33; r += 8) {
            float ss = 0.f;
            if (r > 0 || hasprev) { const float* xr = x + (size_t)(tokc - 1 + r) * D; f32x4 v[8];
#pragma unroll
                for (int i = 0; i < 8; ++i) v[i] = *(const f32x4*)(xr + i * 256 + lane * 4);
#pragma unroll
                for (int i = 0; i < 8; ++i) ss += v[i][0] * v[i][0] + v[i][1] * v[i][1] + v[i][2] * v[i][2] + v[i][3] * v[i][3]; }
            ss = wave_sum(ss);
            if (lane == 0) rs[r] = (r > 0 || hasprev) ? rsqrtf(ss * (1.0f / D) + 1e-6f) : 0.f;
        }
        __syncthreads();
        f32x4 prev = (f32x4){0.f, 0.f, 0.f, 0.f};
        if (hasprev) { const f32x4 pv = *(const f32x4*)(x + (size_t)(tokc - 1) * D + c); const float rp = rs[0]; prev = pv * rp * gg; }
        for (int r0 = 0; r0 < 32; r0 += 4) {
            f32x4 xv[4];
#pragma unroll
            for (int u = 0; u < 4; ++u) xv[u] = *(const f32x4*)(x + (size_t)(tokc + r0 + u) * D + c);
#pragma unroll
            for (int u = 0; u < 4; ++u) { const float rr = rs[r0 + u + 1]; const f32x4 hn = xv[u] * rr * gg, xx = prev - hn;
#pragma unroll
                for (int m = 0; m < 6; ++m) { const f32x4 o = hn + xx * mw[m];
                    uint2 w; w.x = cvt_pk_nv(o[0], o[1]); w.y = cvt_pk_nv(o[2], o[3]);
                    *(uint2*)(mixbase + (size_t)m * 8192 * D + (size_t)(rl0 + r0 + u) * D + c) = w; }
                prev = hn; }
        }
    }
}

__device__ __forceinline__ void conv_ssd(const Params& p) {
    const bf16_t* proj = (const bf16_t*)(p.ws + WS_PROJ); bf16_t* xbc = (bf16_t*)(p.ws + WS_XBC);
    const float* cw = p.in[6]; const float* cb = p.in[7];
    const int tid = opq(threadIdx.x);
    if (tid < 384) {
        const int c8 = tid % 192, par = tid / 192, c = c8 * 8;
        float w[4][8], bb[8];
#pragma unroll
        for (int j = 0; j < 4; ++j) { const f32x4 w0 = *(const f32x4*)(cw + j * 1536 + c), w1 = *(const f32x4*)(cw + j * 1536 + c + 4);
#pragma unroll
            for (int e = 0; e < 4; ++e) { w[j][e] = w0[e]; w[j][4 + e] = w1[e]; } }
        { const f32x4 b0 = *(const f32x4*)(cb + c), b1 = *(const f32x4*)(cb + c + 4);
#pragma unroll
          for (int e = 0; e < 4; ++e) { bb[e] = b0[e]; bb[4 + e] = b1[e]; } }
        for (int chunk = blockIdx.x; chunk < 256; chunk += gridDim.x) {
            const int t0 = chunk * 64 + par * 32; const bool hasprev = (t0 & (SEQ - 1)) != 0;
            float r0[8], r1[8], r2[8];
            if (hasprev) { const uint4 a = *(const uint4*)(proj + (size_t)(t0 - 3) * INWP + COL_XBC + c), b = *(const uint4*)(proj + (size_t)(t0 - 2) * INWP + COL_XBC + c), d = *(const uint4*)(proj + (size_t)(t0 - 1) * INWP + COL_XBC + c);
                unpack8(a, r0); unpack8(b, r1); unpack8(d, r2); }
            else {
#pragma unroll
                for (int e = 0; e < 8; ++e) { r0[e] = 0.f; r1[e] = 0.f; r2[e] = 0.f; } }
            for (int tg = 0; tg < 32; tg += 4) {
                uint4 rw[4];
#pragma unroll
                for (int u = 0; u < 4; ++u) rw[u] = *(const uint4*)(proj + (size_t)(t0 + tg + u) * INWP + COL_XBC + c);
#pragma unroll
                for (int u = 0; u < 4; ++u) { float cur[8], acc[8]; unpack8(rw[u], cur);
#pragma unroll
                    for (int e = 0; e < 8; ++e) { acc[e] = bb[e] + w[0][e] * r0[e] + w[1][e] * r1[e] + w[2][e] * r2[e] + w[3][e] * cur[e]; acc[e] = acc[e] * sigmoidf_(acc[e]); r0[e] = r1[e]; r1[e] = r2[e]; r2[e] = cur[e]; }
                    u32x4 o; o.x = cvt_pk_nv(acc[0], acc[1]); o.y = cvt_pk_nv(acc[2], acc[3]); o.z = cvt_pk_nv(acc[4], acc[5]); o.w = cvt_pk_nv(acc[6], acc[7]);
                    *(u32x4*)(xbc + (size_t)(t0 + tg + u) * 1536 + c) = o; }
            }
        }
    }
    float* dt = (float*)(p.ws + WS_DT); float* da = (float*)(p.ws + WS_DA);
    for (int idx = blockIdx.x * 512 + opq(threadIdx.x); idx < MTOK * 16; idx += gridDim.x * 512) {
        const int tok = idx >> 4, hh = idx & 15;
        const float v = bf2f(proj[(size_t)tok * INWP + COL_DT + hh]) + p.in[8][hh];
        const float d = fmaxf(v, 0.f) + __logf(1.0f + __expf(-fabsf(v)));
        dt[idx] = d; da[idx] = __expf(-d * __expf(p.in[9][hh]));
    }
}

__device__ __forceinline__ void ssd_scan_job(const Params& p, int job, LAS unsigned char* lds) {
    const int tid = opq(threadIdx.x);
    const int b = job >> 5, hs = (job >> 1) & 15, half = job & 1, grp = hs >> 3, p0 = half * 32;
    const bf16_t* xbc = (const bf16_t*)(p.ws + WS_XBC) + (size_t)b * SEQ * 1536;
    const float* dtp = (const float*)(p.ws + WS_DT) + (size_t)b * SEQ * 16 + hs;
    const float* dap = (const float*)(p.ws + WS_DA) + (size_t)b * SEQ * 16 + hs;
    float* yraw = (float*)(p.ws + WS_YRAW) + (size_t)b * SEQ * 1024 + hs * 64 + p0;
    const float dskip = p.in[10][hs];
    constexpr int BUF_F = 9280;
    LAS float* L = (LAS float*)lds;
    const bool producer = tid >= 256; const int ptid = tid & 255;
    int grow[5], gcol[5], loff[5];
#pragma unroll
    for (int k = 0; k < 5; ++k) { const int q = ptid + k * 256, row = q / 36, pc = q - row * 36; grow[k] = row;
        if (pc < 4) { gcol[k] = hs * 64 + p0 + pc * 8; loff[k] = row * 32 + pc * 8; }
        else if (pc < 20) { gcol[k] = 1024 + grp * 128 + (pc - 4) * 8; loff[k] = 1024 + row * 128 + (pc - 4) * 8; }
        else { gcol[k] = 1280 + grp * 128 + (pc - 20) * 8; loff[k] = 5120 + row * 128 + (pc - 20) * 8; } }
    uint4 rg[5]; float sc = 0.f;
#define SSD_ISSUE(t0) do { _Pragma("unroll") for (int k = 0; k < 5; ++k) if (ptid + k * 256 < 1152) rg[k] = *(const uint4*)(xbc + (size_t)((t0) + grow[k]) * 1536 + gcol[k]); \
        if (ptid < 32) sc = dtp[((t0) + ptid) * 16]; else if (ptid < 64) sc = dap[((t0) + ptid - 32) * 16]; } while (0)
#define SSD_COMMIT(buf) do { LAS float* Lc = L + (buf) * BUF_F; _Pragma("unroll") for (int k = 0; k < 5; ++k) if (ptid + k * 256 < 1152) { float f[8]; unpack8(rg[k], f); \
            *(LAS f32x4*)(Lc + loff[k]) = (f32x4){f[0], f[1], f[2], f[3]}; *(LAS f32x4*)(Lc + loff[k] + 4) = (f32x4){f[4], f[5], f[6], f[7]}; } \
        if (ptid < 32) Lc[9216 + ptid] = sc; else if (ptid < 64) Lc[9248 + ptid - 32] = sc; } while (0)
#define SSD_FLUSH(chp) do { LAS float* yo = L + 2 * BUF_F + ((chp) & 1) * 1024; const f32x4 v = *(LAS f32x4*)(yo + (ptid >> 3) * 32 + (ptid & 7) * 4); \
        *(f32x4*)(yraw + (size_t)((chp) * 32 + (ptid >> 3)) * 1024 + (ptid & 7) * 4) = v; } while (0)
    f32x2 hA[4], hB[4];
#pragma unroll
    for (int i = 0; i < 4; ++i) { hA[i] = (f32x2){0.f, 0.f}; hB[i] = (f32x2){0.f, 0.f}; }
    const int prow = (tid >> 4) & 15, nseg = tid & 15;
    __syncthreads();
    if (producer) { SSD_ISSUE(0); SSD_COMMIT(0); SSD_ISSUE(32); }
    __syncthreads();
    for (int ch = 0; ch < 64; ++ch) {
        const int cur = ch & 1;
        if (producer) {
            if (ch >= 1) SSD_FLUSH(ch - 1);
            if (ch + 1 < 64) SSD_COMMIT(cur ^ 1);
            if (ch + 2 < 64) SSD_ISSUE((ch + 2) * 32);
        } else {
        LAS float* Lb = L + cur * BUF_F; LAS float* yb = L + 2 * BUF_F + cur * 1024;
        for (int tg = 0; tg < 32; tg += 16) {
            float yA[16], yB[16];
            LAS float* qb = Lb + 1024 + tg * 128 + nseg * 8;
            f32x4 b0 = *(LAS f32x4*)(qb), b1 = *(LAS f32x4*)(qb + 4), c0 = *(LAS f32x4*)(qb + 4096), c1 = *(LAS f32x4*)(qb + 4100);
            float dA = Lb[9248 + tg], xa = Lb[tg * 32 + prow], xb = Lb[tg * 32 + prow + 16], dtv = Lb[9216 + tg];
#pragma unroll
            for (int tt = 0; tt < 16; ++tt) {
                f32x4 nb0, nb1, nc0, nc1; float ndA, nxa, nxb, ndtv;
                if (tt + 1 < 16) { LAS float* q = qb + (tt + 1) * 128; nb0 = *(LAS f32x4*)(q); nb1 = *(LAS f32x4*)(q + 4); nc0 = *(LAS f32x4*)(q + 4096); nc1 = *(LAS f32x4*)(q + 4100);
                    ndA = Lb[9248 + tg + tt + 1]; nxa = Lb[(tg + tt + 1) * 32 + prow]; nxb = Lb[(tg + tt + 1) * 32 + prow + 16]; ndtv = Lb[9216 + tg + tt + 1]; }
                __builtin_amdgcn_sched_barrier(0);
                const float xdta = xa * dtv, xdtb = xb * dtv;
                const f32x2 dA2 = (f32x2){dA, dA}, xa2 = (f32x2){xdta, xdta}, xb2 = (f32x2){xdtb, xdtb};
                hA[0] = hA[0] * dA2 + xa2 * b0.xy; hB[0] = hB[0] * dA2 + xb2 * b0.xy; hA[1] = hA[1] * dA2 + xa2 * b0.zw; hB[1] = hB[1] * dA2 + xb2 * b0.zw;
                hA[2] = hA[2] * dA2 + xa2 * b1.xy; hB[2] = hB[2] * dA2 + xb2 * b1.xy; hA[3] = hA[3] * dA2 + xa2 * b1.zw; hB[3] = hB[3] * dA2 + xb2 * b1.zw;
                f32x2 ya = hA[0] * c0.xy, yb2 = hB[0] * c0.xy; ya = hA[1] * c0.zw + ya; yb2 = hB[1] * c0.zw + yb2; ya = hA[2] * c1.xy + ya; yb2 = hB[2] * c1.xy + yb2; ya = hA[3] * c1.zw + ya; yb2 = hB[3] * c1.zw + yb2;
                float ra = ya.x + ya.y, rb = yb2.x + yb2.y;
                ra = dpp_add<0xB1>(ra); rb = dpp_add<0xB1>(rb); ra = dpp_add<0x4E>(ra); rb = dpp_add<0x4E>(rb); ra = dpp_add<0x141>(ra); rb = dpp_add<0x141>(rb); ra = dpp_add<0x140>(ra); rb = dpp_add<0x140>(rb);
                yA[tt] = ra + dskip * xa; yB[tt] = rb + dskip * xb;
                __builtin_amdgcn_sched_barrier(0);
                if (tt + 1 < 16) { b0 = nb0; b1 = nb1; c0 = nc0; c1 = nc1; dA = ndA; xa = nxa; xb = nxb; dtv = ndtv; }
            }
            if (nseg == 0) {
#pragma unroll
                for (int tt = 0; tt < 16; ++tt) { yb[(tg + tt) * 32 + prow] = yA[tt]; yb[(tg + tt) * 32 + prow + 16] = yB[tt]; } }
        }
        }
        __syncthreads();
    }
    if (producer) SSD_FLUSH(63);
#undef SSD_ISSUE
#undef SSD_COMMIT
#undef SSD_FLUSH
}

__device__ __forceinline__ void ssd_chunk_job(const Params& p, int job, LAS unsigned char* lds) {
    const int tid = opq(threadIdx.x), lane = tid & 63, w = tid >> 6, fr = lane & 15, fq = lane >> 4;
    const int b = job >> 5, hs = (job >> 1) & 15, half = job & 1, grp = hs >> 3, p0 = half * 32;
    const bf16_t* xbc = (const bf16_t*)(p.ws + WS_XBC) + (size_t)b * SEQ * 1536;
    const float* dtp = (const float*)(p.ws + WS_DT) + (size_t)b * SEQ * 16 + hs;
    float* yraw = (float*)(p.ws + WS_YRAW) + (size_t)b * SEQ * 1024 + hs * 64 + p0;
    const float dskip = p.in[10][hs], Ah = -__expf(p.in[9][hs]);
    constexpr int RS = 136;
    LAS bf16_t* Cs = (LAS bf16_t*)lds;
    LAS bf16_t* Bs = (LAS bf16_t*)(lds + 34816);
    LAS bf16_t* BTs = (LAS bf16_t*)(lds + 69632);
    LAS bf16_t* XTa = (LAS bf16_t*)(lds + 104448);
    LAS bf16_t* XTb = (LAS bf16_t*)(lds + 113152);
    LAS bf16_t* Ps = (LAS bf16_t*)(lds + 121856);
    LAS float* af = (LAS float*)(lds + 130560);
    LAS float* dtf = (LAS float*)(lds + 131584);
    const int crow0 = tid >> 4, cpc = tid & 15;
    const int xk = tid >> 2, xpc = tid & 3;
    u32x4 rc[4], rb[4], rx; float rdt = 0.f;
#define SC_ISSUE(t0) do { _Pragma("unroll") for (int i = 0; i < 4; ++i) { const bf16_t* rp_ = xbc + (size_t)((t0) + (crow0 + 32 * i)) * 1536 + grp * 128 + cpc * 8; rb[i] = *(const u32x4*)(rp_ + 1024); rc[i] = *(const u32x4*)(rp_ + 1280); } \
        rx = *(const u32x4*)(xbc + (size_t)((t0) + xk) * 1536 + hs * 64 + p0 + xpc * 8); if (tid < 128) rdt = dtp[((t0) + tid) * 16]; } while (0)
    f32x4 st[2];
    st[0] = (f32x4){0.f, 0.f, 0.f, 0.f}; st[1] = st[0];
    __syncthreads();
    for (int i = tid; i < 32 * RS / 2; i += 512) ((LAS unsigned*)Ps)[i] = 0u;
    SC_ISSUE(0);
    for (int ch = 0; ch < 16; ++ch) {
        const int t0 = ch * 128;
        __syncthreads();
#pragma unroll
        for (int i = 0; i < 4; ++i) { *(LAS u32x4*)(Cs + (crow0 + 32 * i) * RS + cpc * 8) = rc[i]; *(LAS u32x4*)(Bs + (crow0 + 32 * i) * RS + cpc * 8) = rb[i];

#pragma unroll
            for (int e = 0; e < 4; ++e) { BTs[(cpc * 8 + 2 * e) * RS + (crow0 + 32 * i)] = (bf16_t)(rb[i][e] & 0xffffu); BTs[(cpc * 8 + 2 * e + 1) * RS + (crow0 + 32 * i)] = (bf16_t)(rb[i][e] >> 16); } }
        float csv = 0.f;
        if (tid < 128) {
            csv = rdt * Ah; dtf[tid] = rdt;
#pragma unroll
            for (int off = 1; off < 64; off <<= 1) { const float t_ = __shfl_up(csv, off); if (lane >= off) csv += t_; }
            if (tid == 63) af[128] = csv;
        }
        float xr[8]; xr[0] = bflo(rx[0]); xr[1] = bfhi(rx[0]); xr[2] = bflo(rx[1]); xr[3] = bfhi(rx[1]); xr[4] = bflo(rx[2]); xr[5] = bfhi(rx[2]); xr[6] = bflo(rx[3]); xr[7] = bfhi(rx[3]);
        __syncthreads();
        if (tid < 128) af[tid] = (tid >= 64) ? csv + af[128] : csv;
        __syncthreads();
        const float cs_last = af[127];
        { const float d = dtf[xk], dout = __expf(cs_last - af[xk]);
#pragma unroll
          for (int e = 0; e < 8; ++e) { const float xa = xr[e] * d; XTa[(xpc * 8 + e) * RS + xk] = f2bf(xa); XTb[(xpc * 8 + e) * RS + xk] = f2bf(xa * dout); } }
        __syncthreads();
        bf16x8 cf[4];
#pragma unroll
        for (int ks = 0; ks < 4; ++ks) cf[ks] = *(LAS bf16x8*)(Cs + (w * 16 + fr) * RS + ks * 32 + fq * 8);
        f32x4 yo[2];
#pragma unroll
        for (int pt = 0; pt < 2; ++pt) { f32x4 acc = (f32x4){0.f, 0.f, 0.f, 0.f};
#pragma unroll
            for (int ks = 0; ks < 4; ++ks) { const bf16x8 pb = *(LAS bf16x8*)(Ps + (pt * 16 + fr) * RS + ks * 32 + fq * 8); acc = __builtin_amdgcn_mfma_f32_16x16x32_bf16(cf[ks], pb, acc, 0, 0, 0); }
            yo[pt] = acc; }
        float csq[4];
#pragma unroll
        for (int i = 0; i < 4; ++i) csq[i] = af[w * 16 + fq * 4 + i];
#pragma unroll
        for (int kt = 0; kt < 8; ++kt) { f32x4 acc = (f32x4){0.f, 0.f, 0.f, 0.f};
            if (kt > w) {
#pragma unroll
                for (int i = 0; i < 4; ++i) Cs[(w * 16 + fq * 4 + i) * RS + kt * 16 + fr] = (bf16_t)0;
                continue; }
#pragma unroll
            for (int ks = 0; ks < 4; ++ks) { const bf16x8 bb = *(LAS bf16x8*)(Bs + (kt * 16 + fr) * RS + ks * 32 + fq * 8); acc = __builtin_amdgcn_mfma_f32_16x16x32_bf16(cf[ks], bb, acc, 0, 0, 0); }
            const int kk = kt * 16 + fr; const float csk = af[kk];
#pragma unroll
            for (int i = 0; i < 4; ++i) { const int qq = w * 16 + fq * 4 + i; const float m = (kk <= qq) ? acc[i] * __expf(csq[i] - csk) : 0.f; Cs[qq * RS + kk] = f2bf(m); } }
        f32x4 yd[2];
        { bf16x8 mf[4];
#pragma unroll
          for (int ks = 0; ks < 4; ++ks) mf[ks] = *(LAS bf16x8*)(Cs + (w * 16 + fr) * RS + ks * 32 + fq * 8);
#pragma unroll
          for (int pt = 0; pt < 2; ++pt) { f32x4 acc = (f32x4){0.f, 0.f, 0.f, 0.f};
#pragma unroll
              for (int ks = 0; ks < 4; ++ks) { const bf16x8 xb = *(LAS bf16x8*)(XTa + (pt * 16 + fr) * RS + ks * 32 + fq * 8); acc = __builtin_amdgcn_mfma_f32_16x16x32_bf16(mf[ks], xb, acc, 0, 0, 0); }
              yd[pt] = acc; } }
        if (ch + 1 < 16) SC_ISSUE(t0 + 128);
#pragma unroll
        for (int pt = 0; pt < 2; ++pt)
#pragma unroll
            for (int i = 0; i < 4; ++i) { const int qq = w * 16 + fq * 4 + i, pp = pt * 16 + fr;
                const float xv = bf2f(xbc[(size_t)(t0 + qq) * 1536 + hs * 64 + p0 + pp]);
                yraw[(size_t)(t0 + qq) * 1024 + pp] = yd[pt][i] + __expf(csq[i]) * yo[pt][i] + dskip * xv; }
        __syncthreads();
        { const float cd = __expf(cs_last);
#pragma unroll
          for (int pt = 0; pt < 2; ++pt) { f32x4 acc = st[pt] * cd;
#pragma unroll
              for (int ks = 0; ks < 4; ++ks) { const bf16x8 xa = *(LAS bf16x8*)(XTb + (pt * 16 + fr) * RS + ks * 32 + fq * 8); const bf16x8 bt = *(LAS bf16x8*)(BTs + (w * 16 + fr) * RS + ks * 32 + fq * 8);
                  acc = __builtin_amdgcn_mfma_f32_16x16x32_bf16(xa, bt, acc, 0, 0, 0); }
              st[pt] = acc;
#pragma unroll
              for (int i = 0; i < 4; ++i) Ps[(pt * 16 + fq * 4 + i) * RS + w * 16 + fr] = f2bf(acc[i]); } }
    }
#undef SC_ISSUE
}

__device__ __forceinline__ void attn_job(const Params& p, int job, LAS unsigned char* lds) {
    const int tid = opq(threadIdx.x), lane = tid & 63, w = tid >> 6, fr = lane & 15, fq = lane >> 4;
    const int b = job >> 6, kvh = (job >> 4) & 3, nb = job & 15;
    const bf16_t* proj = (const bf16_t*)(p.ws + WS_PROJ) + (size_t)b * SEQ * INWP;
    const float2* rope = (const float2*)(p.ws + WS_ROPE);
    LAS bf16_t* Ks = (LAS bf16_t*)lds;
    LAS bf16_t* Vt = (LAS bf16_t*)(lds + 36864);
    LAS bf16_t* Ps = (LAS bf16_t*)(lds + 70656) + w * 16 * 264;
    __syncthreads();
    if (tid < 256) {
        const int kr = tid, tk = (nb - 1) * 128 + kr;
        if (tk >= 0) {
            const bf16_t* src = proj + (size_t)tk * INWP + COL_K + kvh * 64; float x[64]; float ss = 0.f;
#pragma unroll
            for (int c = 0; c < 8; ++c) { const uint4 r = *(const uint4*)(src + c * 8); float f[8]; unpack8(r, f);
#pragma unroll
                for (int e = 0; e < 8; ++e) { x[c * 8 + e] = f[e]; ss += f[e] * f[e]; } }
            const float rinv = rsqrtf(ss * (1.0f / 64) + 1e-6f); const float* kn = p.in[13];
#pragma unroll
            for (int i = 0; i < 64; ++i) x[i] = x[i] * rinv * kn[i];
#pragma unroll
            for (int c = 0; c < 4; ++c) { float o1[8], o2[8];
#pragma unroll
                for (int e = 0; e < 8; ++e) { const int i = c * 8 + e; const float2 cs = rope[tk * 32 + i]; o1[e] = x[i] * cs.x - x[i + 32] * cs.y; o2[e] = x[i + 32] * cs.x + x[i] * cs.y; }
                u32x4 w1, w2; w1.x = cvt_pk_bf16(o1[0], o1[1]); w1.y = cvt_pk_bf16(o1[2], o1[3]); w1.z = cvt_pk_bf16(o1[4], o1[5]); w1.w = cvt_pk_bf16(o1[6], o1[7]);
                w2.x = cvt_pk_bf16(o2[0], o2[1]); w2.y = cvt_pk_bf16(o2[2], o2[3]); w2.z = cvt_pk_bf16(o2[4], o2[5]); w2.w = cvt_pk_bf16(o2[6], o2[7]);
                *(LAS u32x4*)(Ks + kr * 72 + c * 8) = w1; *(LAS u32x4*)(Ks + kr * 72 + 32 + c * 8) = w2;
                __builtin_amdgcn_sched_barrier(0); }
        } else {
#pragma unroll
            for (int c = 0; c < 8; ++c) *(LAS u32x4*)(Ks + kr * 72 + c * 8) = (u32x4){0u, 0u, 0u, 0u};
        }
    } else {
        const int kr = tid - 256, tk = (nb - 1) * 128 + kr;
        const bf16_t* src = proj + (size_t)(tk < 0 ? 0 : tk) * INWP + COL_V + kvh * 64;
#pragma unroll
        for (int c = 0; c < 8; ++c) { uint4 r = *(const uint4*)(src + c * 8); if (tk < 0) r = make_uint4(0u, 0u, 0u, 0u);
            Vt[(c * 8 + 0) * 264 + kr] = (bf16_t)(r.x & 0xffffu); Vt[(c * 8 + 1) * 264 + kr] = (bf16_t)(r.x >> 16);
            Vt[(c * 8 + 2) * 264 + kr] = (bf16_t)(r.y & 0xffffu); Vt[(c * 8 + 3) * 264 + kr] = (bf16_t)(r.y >> 16);
            Vt[(c * 8 + 4) * 264 + kr] = (bf16_t)(r.z & 0xffffu); Vt[(c * 8 + 5) * 264 + kr] = (bf16_t)(r.z >> 16);
            Vt[(c * 8 + 6) * 264 + kr] = (bf16_t)(r.w & 0xffffu); Vt[(c * 8 + 7) * 264 + kr] = (bf16_t)(r.w >> 16); }
    }
    __syncthreads();
    const int tq = nb * 128 + w * 16 + fr;
    f32x4 csr[4]; f32x4 qn1[2], qn2[2];
#pragma unroll
    for (int e = 0; e < 4; ++e) csr[e] = *(const f32x4*)(rope + tq * 32 + fq * 8 + 2 * e);
    qn1[0] = *(const f32x4*)(p.in[12] + fq * 8); qn1[1] = *(const f32x4*)(p.in[12] + fq * 8 + 4); qn2[0] = *(const f32x4*)(p.in[12] + 32 + fq * 8); qn2[1] = *(const f32x4*)(p.in[12] + 32 + fq * 8 + 4);
    uint4 r0 = *(const uint4*)(proj + (size_t)tq * INWP + (kvh * 4) * 64 + fq * 8), r1 = *(const uint4*)(proj + (size_t)tq * INWP + (kvh * 4) * 64 + 32 + fq * 8);
    for (int h4 = 0; h4 < 4; ++h4) {
    const int hq = kvh * 4 + h4;
    bf16x8 qa[2];
    uint4 r0n = r0, r1n = r1;
    if (h4 + 1 < 4) { const bf16_t* srcn = proj + (size_t)tq * INWP + (hq + 1) * 64; r0n = *(const uint4*)(srcn + fq * 8); r1n = *(const uint4*)(srcn + 32 + fq * 8); }
    { float x1[8], x2[8]; unpack8(r0, x1); unpack8(r1, x2);
      float ss = 0.f;
#pragma unroll
      for (int e = 0; e < 8; ++e) ss += x1[e] * x1[e] + x2[e] * x2[e];
      ss += __shfl_xor(ss, 16); ss += __shfl_xor(ss, 32);
      const float rinv = rsqrtf(ss * (1.0f / 64) + 1e-6f) * 0.125f; float o1[8], o2[8];
#pragma unroll
      for (int e = 0; e < 8; ++e) { const float a = x1[e] * rinv * qn1[e >> 2][e & 3], c = x2[e] * rinv * qn2[e >> 2][e & 3]; const float cx = csr[e >> 1][(e & 1) * 2], sy = csr[e >> 1][(e & 1) * 2 + 1];
          o1[e] = a * cx - c * sy; o2[e] = c * cx + a * sy; }
      u32x4 w1, w2; w1.x = cvt_pk_bf16(o1[0], o1[1]); w1.y = cvt_pk_bf16(o1[2], o1[3]); w1.z = cvt_pk_bf16(o1[4], o1[5]); w1.w = cvt_pk_bf16(o1[6], o1[7]);
      w2.x = cvt_pk_bf16(o2[0], o2[1]); w2.y = cvt_pk_bf16(o2[2], o2[3]); w2.z = cvt_pk_bf16(o2[4], o2[5]); w2.w = cvt_pk_bf16(o2[6], o2[7]);
      qa[0] = __builtin_bit_cast(bf16x8, w1); qa[1] = __builtin_bit_cast(bf16x8, w2); }
    r0 = r0n; r1 = r1n;
    f32x4 s[16];
#pragma unroll
    for (int j = 0; j < 16; ++j) { f32x4 acc = (f32x4){0.f, 0.f, 0.f, 0.f};
#pragma unroll
        for (int ks = 0; ks < 2; ++ks) { const bf16x8 kb = *(LAS bf16x8*)(Ks + (j * 16 + fr) * 72 + ks * 32 + fq * 8); acc = __builtin_amdgcn_mfma_f32_16x16x32_bf16(qa[ks], kb, acc, 0, 0, 0); }
        s[j] = acc; }
    const float sink = p.in[14][hq];
    float mx[4], inv[4];
#pragma unroll
    for (int i = 0; i < 4; ++i) { const int qi = w * 16 + fq * 4 + i + 128; float m = -3.0e38f;
#pragma unroll
        for (int j = 0; j < 16; ++j) { const int kj = j * 16 + fr; const bool ok = (kj <= qi) && (qi - kj < 128) && (nb > 0 || kj >= 128); s[j][i] = ok ? s[j][i] : -3.0e38f; m = fmaxf(m, s[j][i]); }
        m = max16(m);
        m = fmaxf(m, sink); mx[i] = m; float l = 0.f;
#pragma unroll
        for (int j = 0; j < 16; ++j) { const float e = (s[j][i] > -1.0e38f) ? __expf(s[j][i] - m) : 0.f; s[j][i] = e; l += e; }
        l = red16(l);
        inv[i] = 1.0f / (l + __expf(sink - m)); }
#pragma unroll
    for (int j = 0; j < 16; ++j)
#pragma unroll
        for (int i = 0; i < 4; ++i) Ps[(fq * 4 + i) * 264 + j * 16 + fr] = f2bf(s[j][i] * inv[i]);
    f32x4 o[4];
#pragma unroll
    for (int nd = 0; nd < 4; ++nd) o[nd] = (f32x4){0.f, 0.f, 0.f, 0.f};
#pragma unroll
    for (int kk = 0; kk < 8; ++kk) { const bf16x8 pa = *(LAS bf16x8*)(Ps + fr * 264 + kk * 32 + fq * 8);
#pragma unroll
        for (int nd = 0; nd < 4; ++nd) { const bf16x8 vb = *(LAS bf16x8*)(Vt + (nd * 16 + fr) * 264 + kk * 32 + fq * 8); o[nd] = __builtin_amdgcn_mfma_f32_16x16x32_bf16(pa, vb, o[nd], 0, 0, 0); } }
    bf16_t* ymix = (bf16_t*)(p.ws + WS_YMIX) + (size_t)b * SEQ * D + hq * 64;
#pragma unroll
    for (int nd = 0; nd < 4; ++nd)
#pragma unroll
        for (int i = 0; i < 4; ++i) ymix[(size_t)(nb * 128 + w * 16 + fq * 4 + i) * D + nd * 16 + fr] = f2bf(o[nd][i]);
    }
}

__device__ __forceinline__ void post_ssd(const Params& p) {
    const int tid_ = opq(threadIdx.x); const int lane = tid_ & 63, wv = tid_ >> 6;
    const float* yraw = (const float*)(p.ws + WS_YRAW); const bf16_t* proj = (const bf16_t*)(p.ws + WS_PROJ); bf16_t* ymix = (bf16_t*)(p.ws + WS_YMIX);
    for (int it = blockIdx.x * 8 + wv; it < MTOK * 2; it += gridDim.x * 8) {
        const int tok = it >> 1, grp = it & 1, c = grp * 512 + lane * 8;
        const f32x4 y0 = *(const f32x4*)(yraw + (size_t)tok * 1024 + c), y1 = *(const f32x4*)(yraw + (size_t)tok * 1024 + c + 4);
        const uint4 zr = *(const uint4*)(proj + (size_t)tok * INWP + COL_Z + c); float z[8], y[8]; unpack8(zr, z); float ss = 0.f;
#pragma unroll
        for (int e = 0; e < 8; ++e) { const float yy = (e < 4 ? y0[e] : y1[e - 4]); y[e] = yy * z[e] * sigmoidf_(z[e]); ss += y[e] * y[e]; }
        ss = wave_sum(ss); const float r = rsqrtf(ss * (1.0f / 512) + 1e-6f);
        const f32x4 n0 = *(const f32x4*)(p.in[11] + c), n1 = *(const f32x4*)(p.in[11] + c + 4);
        u32x4 w; w.x = cvt_pk_nv(y[0] * r * n0[0], y[1] * r * n0[1]); w.y = cvt_pk_nv(y[2] * r * n0[2], y[3] * r * n0[3]);
        w.z = cvt_pk_nv(y[4] * r * n1[0], y[5] * r * n1[1]); w.w = cvt_pk_nv(y[6] * r * n1[2], y[7] * r * n1[3]);
        *(u32x4*)(ymix + (size_t)tok * D + 1024 + c) = w;
    }
}

__device__ __forceinline__ float half_sum(float v, bool lo) {
    (void)lo; v = red16(v); return v + __shfl_xor(v, 16); }
__device__ __forceinline__ void rwkv_scan_job(const Params& p, int job, LAS unsigned char* lds) {
    const int tid = opq(threadIdx.x), lane = tid & 63, l32 = lane & 31; const bool lo = lane < 32;
    const int b = job >> 5, hh = job & 31;
    LAS float* L = (LAS float*)lds;
    const bool producer = tid >= 256;
    const int pw = (tid >> 6) & 3;
    const int tl0 = 2 * pw + (lane >> 5);
    const size_t wbase = ((size_t)b * SEQ * D + hh * 64) / 2 + l32 + (size_t)tl0 * (D / 2);
    const unsigned* R32 = (const unsigned*)(p.ws + WS_R) + wbase; const unsigned* K32 = (const unsigned*)(p.ws + WS_K) + wbase; const unsigned* V32 = (const unsigned*)(p.ws + WS_V) + wbase;
    const unsigned* E32 = (const unsigned*)(p.ws + WS_WDEC) + wbase; const unsigned* A32 = (const unsigned*)(p.ws + WS_AA) + wbase; const unsigned* G32 = (const unsigned*)(p.ws + WS_GG) + wbase;
    unsigned* Y32 = (unsigned*)(p.ws + WS_YG) + wbase;
    const int ci = hh * 64 + 2 * l32;
    const float2 kkw = *(const float2*)(p.in[25] + ci), kaw = *(const float2*)(p.in[26] + ci), rkw = *(const float2*)(p.in[27] + ci), lnw = *(const float2*)(p.in[32] + ci), lnb = *(const float2*)(p.in[33] + ci);
    unsigned rw[2], kw[2], vw[2], ew[2], aw[2], gw[2];
    const int oo = tl0 * 64 + 2 * l32;
#define RW_ISSUE(t0) do { _Pragma("unroll") for (int i2 = 0; i2 < 2; ++i2) { const size_t off = (size_t)((t0) + 8 * i2) * (D / 2); rw[i2] = R32[off]; kw[i2] = K32[off]; vw[i2] = V32[off]; ew[i2] = E32[off]; aw[i2] = A32[off]; gw[i2] = G32[off]; } } while (0)
#define RW_COMMIT(buf) do { _Pragma("unroll") for (int i2 = 0; i2 < 2; ++i2) { LAS float* Lc = L + (buf) * 8192 + oo + i2 * 512; \
        const float r0_ = bflo(rw[i2]), r1_ = bfhi(rw[i2]), k0_ = bflo(kw[i2]), k1_ = bfhi(kw[i2]), v0_ = bflo(vw[i2]), v1_ = bfhi(vw[i2]), e0_ = bflo(ew[i2]), e1_ = bfhi(ew[i2]), a0_ = bflo(aw[i2]), a1_ = bfhi(aw[i2]), g0_ = bflo(gw[i2]), g1_ = bfhi(gw[i2]); \
        const float kkv0 = k0_ * kkw.x, kkv1 = k1_ * kkw.y; const float ssq = half_sum(kkv0 * kkv0 + kkv1 * kkv1, lo); const float rn = rsqrtf(fmaxf(ssq, 1e-24f)); const float kn0 = kkv0 * rn, kn1 = kkv1 * rn; \
        const float km0 = k0_ * (1.0f + (a0_ - 1.0f) * kaw.x), km1 = k1_ * (1.0f + (a1_ - 1.0f) * kaw.y); const float bonus = half_sum(r0_ * km0 * rkw.x + r1_ * km1 * rkw.y, lo); \
        *(LAS f32x2*)(Lc) = (f32x2){-kn0, -kn1}; *(LAS f32x2*)(Lc + 1024) = (f32x2){__expf(-e0_), __expf(-e1_)}; *(LAS f32x2*)(Lc + 2048) = (f32x2){kn0 * a0_, kn1 * a1_}; *(LAS f32x2*)(Lc + 3072) = (f32x2){km0, km1}; \
        *(LAS f32x2*)(Lc + 4096) = (f32x2){r0_, r1_}; *(LAS f32x2*)(Lc + 5120) = (f32x2){v0_, v1_}; *(LAS f32x2*)(Lc + 6144) = (f32x2){g0_, g1_}; *(LAS f32x2*)(Lc + 7168) = (f32x2){bonus * v0_, bonus * v1_}; } } while (0)
#define RW_OUTPUT(chp) do { LAS float* Lo = L + ((chp) & 1) * 8192; LAS float* yo = L + 16384 + ((chp) & 1) * 1024; _Pragma("unroll") for (int i2 = 0; i2 < 2; ++i2) { const int o2 = oo + i2 * 512; \
        const f32x2 y = *(LAS f32x2*)(yo + o2); \
        const float mu = half_sum(y.x + y.y, lo) * (1.0f / 64), d0 = y.x - mu, d1 = y.y - mu, var = half_sum(d0 * d0 + d1 * d1, lo) * (1.0f / 64), rs = rsqrtf(var + 64e-5f); \
        const f32x2 bv = *(LAS f32x2*)(Lo + 7168 + o2), gg = *(LAS f32x2*)(Lo + 6144 + o2); \
        Y32[(size_t)((chp) * 16 + 8 * i2) * (D / 2)] = cvt_pk_nv((d0 * rs * lnw.x + lnb.x + bv.x) * gg.x, (d1 * rs * lnw.y + lnb.y + bv.y) * gg.y); } } while (0)
    f32x2 SA[4], SB[4];
#pragma unroll
    for (int i = 0; i < 4; ++i) { SA[i] = (f32x2){0.f, 0.f}; SB[i] = (f32x2){0.f, 0.f}; }
    const int rp = (tid >> 3) & 31, ks = tid & 7;
    __syncthreads();
    if (producer) { RW_ISSUE(0); RW_COMMIT(0); RW_ISSUE(16); }
    __syncthreads();
    for (int ch = 0; ch < 128; ++ch) {
        const int cur = ch & 1;
        if (producer) {
            if (ch >= 1) RW_OUTPUT(ch - 1);
            if (ch + 1 < 128) RW_COMMIT(cur ^ 1);
            if (ch + 2 < 128) RW_ISSUE((ch + 2) * 16);
        } else {
            LAS float* Lb = L + cur * 8192; LAS float* yb = L + 16384 + cur * 1024;
            float yA[16], yB[16];
            LAS float* q0 = Lb + ks * 8;
            f32x4 a0 = *(LAS f32x4*)(q0), a1 = *(LAS f32x4*)(q0 + 4), w0 = *(LAS f32x4*)(q0 + 1024), w1 = *(LAS f32x4*)(q0 + 1028), b0 = *(LAS f32x4*)(q0 + 2048), b1 = *(LAS f32x4*)(q0 + 2052);
            f32x4 k0 = *(LAS f32x4*)(q0 + 3072), k1 = *(LAS f32x4*)(q0 + 3076), r0 = *(LAS f32x4*)(q0 + 4096), r1 = *(LAS f32x4*)(q0 + 4100);
            float va = Lb[5120 + rp], vb = Lb[5120 + rp + 32];
#pragma unroll
            for (int t = 0; t < 16; ++t) {
                f32x4 na0, na1, nw0, nw1, nb0, nb1, nk0, nk1, nr0, nr1; float nva, nvb;
                if (t + 1 < 16) { LAS float* q = q0 + (t + 1) * 64;
                    na0 = *(LAS f32x4*)(q); na1 = *(LAS f32x4*)(q + 4); nw0 = *(LAS f32x4*)(q + 1024); nw1 = *(LAS f32x4*)(q + 1028); nb0 = *(LAS f32x4*)(q + 2048); nb1 = *(LAS f32x4*)(q + 2052);
                    nk0 = *(LAS f32x4*)(q + 3072); nk1 = *(LAS f32x4*)(q + 3076); nr0 = *(LAS f32x4*)(q + 4096); nr1 = *(LAS f32x4*)(q + 4100); nva = Lb[5120 + (t + 1) * 64 + rp]; nvb = Lb[5120 + (t + 1) * 64 + rp + 32]; }
                __builtin_amdgcn_sched_barrier(0);
                f32x2 ca = SA[0] * a0.xy, cb = SB[0] * a0.xy; ca = SA[1] * a0.zw + ca; cb = SB[1] * a0.zw + cb; ca = SA[2] * a1.xy + ca; cb = SB[2] * a1.xy + cb; ca = SA[3] * a1.zw + ca; cb = SB[3] * a1.zw + cb;
                float sa = ca.x + ca.y, sb = cb.x + cb.y;
                sa = dpp_add<0xB1>(sa); sb = dpp_add<0xB1>(sb); sa = dpp_add<0x4E>(sa); sb = dpp_add<0x4E>(sb); sa = dpp_add<0x141>(sa); sb = dpp_add<0x141>(sb);
                const f32x2 sa2 = (f32x2){sa, sa}, sb2 = (f32x2){sb, sb}, va2 = (f32x2){va, va}, vb2 = (f32x2){vb, vb};
                SA[0] = SA[0] * w0.xy + (sa2 * b0.xy + va2 * k0.xy); SB[0] = SB[0] * w0.xy + (sb2 * b0.xy + vb2 * k0.xy);
                SA[1] = SA[1] * w0.zw + (sa2 * b0.zw + va2 * k0.zw); SB[1] = SB[1] * w0.zw + (sb2 * b0.zw + vb2 * k0.zw);
                SA[2] = SA[2] * w1.xy + (sa2 * b1.xy + va2 * k1.xy); SB[2] = SB[2] * w1.xy + (sb2 * b1.xy + vb2 * k1.xy);
                SA[3] = SA[3] * w1.zw + (sa2 * b1.zw + va2 * k1.zw); SB[3] = SB[3] * w1.zw + (sb2 * b1.zw + vb2 * k1.zw);
                f32x2 ya = SA[0] * r0.xy, yb2 = SB[0] * r0.xy; ya = SA[1] * r0.zw + ya; yb2 = SB[1] * r0.zw + yb2; ya = SA[2] * r1.xy + ya; yb2 = SB[2] * r1.xy + yb2; ya = SA[3] * r1.zw + ya; yb2 = SB[3] * r1.zw + yb2;
                float ra = ya.x + ya.y, rb = yb2.x + yb2.y;
                ra = dpp_add<0xB1>(ra); rb = dpp_add<0xB1>(rb); ra = dpp_add<0x4E>(ra); rb = dpp_add<0x4E>(rb); ra = dpp_add<0x141>(ra); rb = dpp_add<0x141>(rb);
                yA[t] = ra; yB[t] = rb;
                __builtin_amdgcn_sched_barrier(0);
                if (t + 1 < 16) { a0 = na0; a1 = na1; w0 = nw0; w1 = nw1; b0 = nb0; b1 = nb1; k0 = nk0; k1 = nk1; r0 = nr0; r1 = nr1; va = nva; vb = nvb; }
            }
            if (ks == 0) {
#pragma unroll
                for (int t = 0; t < 16; ++t) { yb[t * 64 + rp] = yA[t]; yb[t * 64 + rp + 32] = yB[t]; } }
        }
        __syncthreads();
    }
    if (producer) RW_OUTPUT(127);
#undef RW_ISSUE
#undef RW_COMMIT
#undef RW_OUTPUT
}

__device__ __forceinline__ void rwkv_chunk_job(const Params& p, int job, LAS unsigned char* lds) {
    const int tid = opq(threadIdx.x), lane = tid & 63, w = tid >> 6, fr = lane & 15, fq = lane >> 4, l16 = lane & 15;
    const int b = job >> 5, hh = job & 31;
    const int tl = 4 * (w & 3) + (lane >> 4);
    const size_t wbase = ((size_t)b * SEQ * D + hh * 64) / 4 + l16 + (size_t)tl * (D / 4);
    const uint2* R64 = (const uint2*)(p.ws + WS_R) + wbase; const uint2* K64 = (const uint2*)(p.ws + WS_K) + wbase; const uint2* V64 = (const uint2*)(p.ws + WS_V) + wbase;
    const uint2* E64 = (const uint2*)(p.ws + WS_WDEC) + wbase; const uint2* A64 = (const uint2*)(p.ws + WS_AA) + wbase; const uint2* G64 = (const uint2*)(p.ws + WS_GG) + wbase;
    uint2* Y64 = (uint2*)(p.ws + WS_YG) + wbase;
    const int ci = hh * 64 + 4 * l16;
    const f32x4 kkw = *(const f32x4*)(p.in[25] + ci), kaw = *(const f32x4*)(p.in[26] + ci), rkw = *(const f32x4*)(p.in[27] + ci), lnw = *(const f32x4*)(p.in[32] + ci), lnb = *(const f32x4*)(p.in[33] + ci);
    LAS float* Av = (LAS float*)(lds + 0);
    LAS float* Bv = (LAS float*)(lds + 4096);
    LAS float* Km = (LAS float*)(lds + 8192);
    LAS float* Rr = (LAS float*)(lds + 12288);
    LAS float* ybuf = (LAS float*)(lds + 16384);
    LAS float* RHS = (LAS float*)(lds + 20480);
    LAS float* Aab = (LAS float*)(lds + 24832);
    LAS float* Wend = (LAS float*)(lds + 25856);
    LAS bf16_t* ET = (LAS bf16_t*)(lds + 26112);
    LAS bf16_t* VT = (LAS bf16_t*)(lds + 31232);
    LAS bf16_t* BtT = (LAS bf16_t*)(lds + 36352);
    LAS bf16_t* KtT = (LAS bf16_t*)(lds + 41472);
    LAS bf16_t* Ub = (LAS bf16_t*)(lds + 46592);
    LAS bf16_t* AakT = (LAS bf16_t*)(lds + 51712);
    LAS bf16_t* AbrT = (LAS bf16_t*)(lds + 52992);
    LAS bf16_t* AkrT = (LAS bf16_t*)(lds + 54272);
    LAS bf16_t* At = (LAS bf16_t*)(lds + 55552);
    LAS bf16_t* Bt = (LAS bf16_t*)(lds + 57856);
    LAS bf16_t* Kt = (LAS bf16_t*)(lds + 60160);
    LAS bf16_t* Rt = (LAS bf16_t*)(lds + 62464);
    LAS bf16_t* S0b = (LAS bf16_t*)(lds + 64768);
    LAS bf16_t* VT1 = (LAS bf16_t*)(lds + 73984);
    constexpr int LDS_END = 73984 + 64 * 40 * 2;
    __syncthreads();
    for (int i = tid; i < LDS_END / 4; i += 512) ((LAS unsigned*)lds)[i] = 0u;
    f32x4 stt[2]; stt[0] = (f32x4){0.f, 0.f, 0.f, 0.f}; stt[1] = stt[0];
    const int vt = w >> 1, kt0 = (w & 1) * 2;
    bf16x8 Lf;
#pragma unroll
    for (int e = 0; e < 8; ++e) { const int i = fq * 8 + e; Lf[e] = (i <= fr && i < 16) ? (short)0x3F80 : (short)0; }
    uint2 rw, kw, vw, ew, aw, gw;
#define RC_ISSUE(t0) do { const size_t off = (size_t)(t0) * (D / 4); rw = R64[off]; kw = K64[off]; vw = V64[off]; ew = E64[off]; aw = A64[off]; gw = G64[off]; } while (0)
#define RC_PREP(chn) do { \
        const f32x4 r_ = (f32x4){bflo(rw.x), bfhi(rw.x), bflo(rw.y), bfhi(rw.y)}, k_ = (f32x4){bflo(kw.x), bfhi(kw.x), bflo(kw.y), bfhi(kw.y)}, v_ = (f32x4){bflo(vw.x), bfhi(vw.x), bflo(vw.y), bfhi(vw.y)}; \
        const f32x4 a_ = (f32x4){bflo(aw.x), bfhi(aw.x), bflo(aw.y), bfhi(aw.y)}; gn = (f32x4){bflo(gw.x), bfhi(gw.x), bflo(gw.y), bfhi(gw.y)}; \
        const uint2 ewc = ew, vwc = vw; \
        RC_ISSUE((((chn) + 1 < 128) ? (chn) + 1 : 127) * 16);     \
        const f32x4 kkv = k_ * kkw; const float ssq = red16(kkv[0] * kkv[0] + kkv[1] * kkv[1] + kkv[2] * kkv[2] + kkv[3] * kkv[3]); const float rn = rsqrtf(fmaxf(ssq, 1e-24f)); const f32x4 kn = kkv * rn; \
        const f32x4 km = k_ * ((a_ - 1.0f) * kaw + 1.0f); const f32x4 rk_ = r_ * km * rkw; const float bonus = red16(rk_[0] + rk_[1] + rk_[2] + rk_[3]); \
        bn = v_ * bonus; \
        { const int o = tl * 64 + 4 * l16; LAS bf16_t* VTw = ((chn) & 1) ? VT1 : VT; \
          *(LAS f32x4*)(Av + o) = -kn; *(LAS f32x4*)(Bv + o) = kn * a_; *(LAS f32x4*)(Km + o) = km; *(LAS f32x4*)(Rr + o) = r_; \
          ET[(4 * l16) * 40 + tl] = (bf16_t)(ewc.x & 0xffffu); ET[(4 * l16 + 1) * 40 + tl] = (bf16_t)(ewc.x >> 16); ET[(4 * l16 + 2) * 40 + tl] = (bf16_t)(ewc.y & 0xffffu); ET[(4 * l16 + 3) * 40 + tl] = (bf16_t)(ewc.y >> 16); \
          VTw[(4 * l16) * 40 + tl] = (bf16_t)(vwc.x & 0xffffu); VTw[(4 * l16 + 1) * 40 + tl] = (bf16_t)(vwc.x >> 16); VTw[(4 * l16 + 2) * 40 + tl] = (bf16_t)(vwc.y & 0xffffu); VTw[(4 * l16 + 3) * 40 + tl] = (bf16_t)(vwc.y >> 16); } } while (0)
    f32x4 gc = (f32x4){0.f, 0.f, 0.f, 0.f}, bc = gc, gn = gc, bn = gc;
    if (w >= 4) RC_ISSUE(0);
    __syncthreads();
    if (w >= 4) { RC_PREP(0); gc = gn; bc = bn; }
    __syncthreads();
    for (int ch = 0; ch < 128; ++ch) {
        LAS bf16_t* VTc = (ch & 1) ? VT1 : VT;
        if (w < 4) {
            const bf16x8 eb = *(LAS bf16x8*)(ET + (w * 16 + fr) * 40 + fq * 8);
            f32x4 ec = (f32x4){0.f, 0.f, 0.f, 0.f}; ec = __builtin_amdgcn_mfma_f32_16x16x32_bf16(Lf, eb, ec, 0, 0, 0);
            const int kk = w * 16 + fr; unsigned bt_pk[2], kt_pk[2]; float btv[4], ktv[4];
#pragma unroll
            for (int i = 0; i < 4; ++i) { const int t = fq * 4 + i; const float et = bf2f(ET[kk * 40 + t]);
                const float Wt = __expf(-ec[i]), Wp = __expf(et - ec[i]), iW = __expf(ec[i]);
                const int o = t * 64 + kk;
                At[t * 72 + kk] = f2bf(Av[o] * Wp); Rt[t * 72 + kk] = f2bf(Rr[o] * Wt);
                btv[i] = Bv[o] * iW; ktv[i] = Km[o] * iW;
                Bt[t * 72 + kk] = f2bf(btv[i]); Kt[t * 72 + kk] = f2bf(ktv[i]);
                if (t == 15) Wend[kk] = Wt; }
            bt_pk[0] = cvt_pk_bf16(btv[0], btv[1]); bt_pk[1] = cvt_pk_bf16(btv[2], btv[3]); kt_pk[0] = cvt_pk_bf16(ktv[0], ktv[1]); kt_pk[1] = cvt_pk_bf16(ktv[2], ktv[3]);
            *(LAS u32x2*)(BtT + kk * 40 + fq * 4) = (u32x2){bt_pk[0], bt_pk[1]}; *(LAS u32x2*)(KtT + kk * 40 + fq * 4) = (u32x2){kt_pk[0], kt_pk[1]};
        }
        __syncthreads();
        if (w < 4) {
            LAS bf16_t* Xr = (w & 1) ? Kt : Bt; LAS bf16_t* Yr = (w & 2) ? Rt : At;
            f32x4 gacc = (f32x4){0.f, 0.f, 0.f, 0.f};
#pragma unroll
            for (int ks = 0; ks < 2; ++ks) { const bf16x8 xa = *(LAS bf16x8*)(Xr + fr * 72 + ks * 32 + fq * 8); const bf16x8 yb_ = *(LAS bf16x8*)(Yr + fr * 72 + ks * 32 + fq * 8); gacc = __builtin_amdgcn_mfma_f32_16x16x32_bf16(xa, yb_, gacc, 0, 0, 0); }
            float gm[4];
#pragma unroll
            for (int i = 0; i < 4; ++i) { const int j = fq * 4 + i; const bool keep = (w & 2) ? (j <= fr) : (j < fr); gm[i] = keep ? gacc[i] : 0.f; }
            if (w == 0) {
#pragma unroll
                for (int i = 0; i < 4; ++i) Aab[(fq * 4 + i) * 16 + fr] = gm[i]; }
            else { LAS bf16_t* dst = (w == 1) ? AakT : (w == 2) ? AbrT : AkrT; *(LAS u32x2*)(dst + fr * 40 + fq * 4) = (u32x2){cvt_pk_bf16(gm[0], gm[1]), cvt_pk_bf16(gm[2], gm[3])}; }
        }
        __syncthreads();
        f32x4 y0 = (f32x4){0.f, 0.f, 0.f, 0.f};
        { const int vtile = w & 3; LAS bf16_t* Yr = (w < 4) ? At : Rt; LAS bf16_t* Gt = (w < 4) ? AakT : AkrT;
#pragma unroll
          for (int ks = 0; ks < 2; ++ks) { const bf16x8 sa = *(LAS bf16x8*)(S0b + (vtile * 16 + fr) * 72 + ks * 32 + fq * 8); const bf16x8 yb_ = *(LAS bf16x8*)(Yr + fr * 72 + ks * 32 + fq * 8); y0 = __builtin_amdgcn_mfma_f32_16x16x32_bf16(sa, yb_, y0, 0, 0, 0); }
          { const bf16x8 va = *(LAS bf16x8*)(VTc + (vtile * 16 + fr) * 40 + fq * 8); const bf16x8 gb = *(LAS bf16x8*)(Gt + fr * 40 + fq * 8); y0 = __builtin_amdgcn_mfma_f32_16x16x32_bf16(va, gb, y0, 0, 0, 0); }
          if (w < 4) {
#pragma unroll
              for (int i = 0; i < 4; ++i) RHS[(vtile * 16 + fq * 4 + i) * 17 + fr] = y0[i]; } }
        __syncthreads();
        if (w == 0) {
            float u[16];
#pragma unroll
            for (int t = 0; t < 16; ++t) u[t] = RHS[lane * 17 + t];
#pragma unroll
            for (int t = 0; t < 15; ++t) {
#pragma unroll
                for (int t2 = t + 1; t2 < 16; ++t2) u[t2] += u[t] * Aab[t * 16 + t2]; }
            u32x4 o0, o1; o0.x = cvt_pk_bf16(u[0], u[1]); o0.y = cvt_pk_bf16(u[2], u[3]); o0.z = cvt_pk_bf16(u[4], u[5]); o0.w = cvt_pk_bf16(u[6], u[7]);
            o1.x = cvt_pk_bf16(u[8], u[9]); o1.y = cvt_pk_bf16(u[10], u[11]); o1.z = cvt_pk_bf16(u[12], u[13]); o1.w = cvt_pk_bf16(u[14], u[15]);
            *(LAS u32x4*)(Ub + lane * 40) = o0; *(LAS u32x4*)(Ub + lane * 40 + 8) = o1;
        }
        if (w >= 4) { RC_PREP(ch + 1); }
        __syncthreads();
        if (w >= 4) { const int vtile = w & 3;
            const bf16x8 ua = *(LAS bf16x8*)(Ub + (vtile * 16 + fr) * 40 + fq * 8); const bf16x8 gb = *(LAS bf16x8*)(AbrT + fr * 40 + fq * 8); y0 = __builtin_amdgcn_mfma_f32_16x16x32_bf16(ua, gb, y0, 0, 0, 0);
#pragma unroll
            for (int i = 0; i < 4; ++i) ybuf[fr * 64 + vtile * 16 + fq * 4 + i] = y0[i]; }
        { const bf16x8 ua = *(LAS bf16x8*)(Ub + (vt * 16 + fr) * 40 + fq * 8); const bf16x8 va = *(LAS bf16x8*)(VTc + (vt * 16 + fr) * 40 + fq * 8);
#pragma unroll
          for (int q = 0; q < 2; ++q) { const int kk = (kt0 + q) * 16 + fr;
              const bf16x8 bb = *(LAS bf16x8*)(BtT + kk * 40 + fq * 8); const bf16x8 kb = *(LAS bf16x8*)(KtT + kk * 40 + fq * 8);
              f32x4 acc = stt[q]; acc = __builtin_amdgcn_mfma_f32_16x16x32_bf16(ua, bb, acc, 0, 0, 0); acc = __builtin_amdgcn_mfma_f32_16x16x32_bf16(va, kb, acc, 0, 0, 0);
              const float we = Wend[kk]; acc = acc * we; stt[q] = acc;
#pragma unroll
              for (int i = 0; i < 4; ++i) S0b[(vt * 16 + fq * 4 + i) * 72 + kk] = f2bf(acc[i]); } }
        __syncthreads();
        if (w >= 4) { const f32x4 y = *(LAS f32x4*)(ybuf + tl * 64 + 4 * l16);
          const float mu = red16(y[0] + y[1] + y[2] + y[3]) * (1.0f / 64); const f32x4 d = y - mu;
          const float var = red16(d[0] * d[0] + d[1] * d[1] + d[2] * d[2] + d[3] * d[3]) * (1.0f / 64), rs = rsqrtf(var + 64e-5f);
          const f32x4 o4 = (d * rs * lnw + lnb + bc) * gc;
          Y64[(size_t)(ch * 16) * (D / 4)] = make_uint2(cvt_pk_nv(o4[0], o4[1]), cvt_pk_nv(o4[2], o4[3]));
          gc = gn; bc = bn; }
    }
#undef RC_ISSUE
#undef RC_PREP
}

#define XB_TMO      128
#define XB_XCNT(j)  (256  + 64 * (j))
#define XB_XSUB(j)  (1280 + 64 * (j))
#define XB_XGEN(j)  (2304 + 64 * (j))
#define XB_TOP      3328
#define XB_TOPGEN   3392
#define XCD_BAR_WORDS 3456
#define XB_SPIN_CAP (1u << 18)

__device__ __forceinline__ unsigned xb_ld(unsigned* p)              { return __hip_atomic_load(p, __ATOMIC_RELAXED, __HIP_MEMORY_SCOPE_AGENT); }
__device__ __forceinline__ unsigned xb_add(unsigned* p, unsigned v) { return __hip_atomic_fetch_add(p, v, __ATOMIC_RELAXED, __HIP_MEMORY_SCOPE_AGENT); }
__device__ __forceinline__ unsigned xb_xcc_id() { return (unsigned)__builtin_amdgcn_s_getreg((3 << 11) | 20) & 0xFu; }
#define XB_SPIN(cond, bar) do { unsigned _sp = 0; while (cond) { __builtin_amdgcn_s_sleep(1); \
    if ((++_sp & 255u) == 0u) { if (xb_ld(&(bar)[XB_TMO])) break; if (_sp > XB_SPIN_CAP) { atomicAdd(&(bar)[XB_TMO], 1u); break; } } } } while (0)

struct XcdBarrier {
    unsigned* bar; unsigned x;
    volatile LAS unsigned* st;
};

__device__ __forceinline__ XcdBarrier xcd_barrier_post(unsigned* bar, volatile LAS unsigned* st) {
    XcdBarrier b; b.bar = bar; b.x = xb_xcc_id(); b.st = st;
    if (threadIdx.x == 0) (void)xb_add(&bar[XB_XCNT(b.x)], 1u);
    return b;
}
__device__ __forceinline__ void xcd_barrier_complete(unsigned* bar, unsigned x, unsigned& nloc, unsigned& nx) {
    const unsigned G = gridDim.x * gridDim.y * gridDim.z;
    unsigned sum, cnt, mine, sp = 0u;
    for (;;) {
        sum = 0u; cnt = 0u; mine = 0u;
#pragma unroll
        for (unsigned j = 0; j < 16; ++j) { const unsigned c = xb_ld(&bar[XB_XCNT(j)]); sum += c; cnt += (c > 0u) ? 1u : 0u; mine = (j == x) ? c : mine; }
        if (sum == G) break;
        __builtin_amdgcn_s_sleep(1);
        if ((++sp & 255u) == 0u) { if (xb_ld(&bar[XB_TMO])) break; if (sp > XB_SPIN_CAP) { atomicAdd(&bar[XB_TMO], 1u); break; } }
    }
    nloc = mine > 0u ? mine : 1u; nx = cnt > 0u ? cnt : 1u;
}

__device__ __forceinline__ void xcd_barrier(const XcdBarrier& b) {
    asm volatile("s_waitcnt vmcnt(0)" ::: "memory");
    __syncthreads();
    if (threadIdx.x == 0) {
        unsigned* bar = b.bar;
        __builtin_amdgcn_s_waitcnt(0);
        unsigned nloc = b.st[0], nx = b.st[1];
        if (nloc == 0u) { xcd_barrier_complete(bar, b.x, nloc, nx); b.st[0] = nloc; b.st[1] = nx; }
        const unsigned old = xb_add(&bar[XB_XSUB(b.x)], 1u);
        const unsigned gen = old / nloc;
        if (old + 1u == (gen + 1u) * nloc) {
            __builtin_amdgcn_fence(__ATOMIC_RELEASE, "agent");
            asm volatile("s_waitcnt vmcnt(0)" ::: "memory");
            const unsigned og = xb_add(&bar[XB_TOP], 1u);
            const unsigned tg = og / nx;
            if (og + 1u == (tg + 1u) * nx) xb_add(&bar[XB_TOPGEN], 1u);
            else XB_SPIN(xb_ld(&bar[XB_TOPGEN]) == tg, bar);
            __builtin_amdgcn_fence(__ATOMIC_ACQUIRE, "agent");
            xb_add(&bar[XB_XGEN(b.x)], 1u);
            asm volatile("s_waitcnt vmcnt(0)" ::: "memory");
        } else {
            XB_SPIN(xb_ld(&bar[XB_XGEN(b.x)]) == gen, bar);
            __builtin_amdgcn_fence(__ATOMIC_ACQUIRE, "agent");
            asm volatile("s_waitcnt vmcnt(0)" ::: "memory");
        }
    }
    __syncthreads();
}


__global__ __launch_bounds__(512, 2) void mega(const Params p_arg) {
    extern __shared__ __attribute__((aligned(16))) unsigned char shm[];
    const Params& p = *(const Params*)(const void*)__builtin_amdgcn_kernarg_segment_ptr();
    LAS unsigned char* lds = (LAS unsigned char*)shm;
    const int G = (int)gridDim.x, bid = (int)blockIdx.x;
    __shared__ uint4 xb_words;
    if (threadIdx.x == 0) xb_words = make_uint4(0u, 0u, 0u, 0u);
    __syncthreads();
    (void)xcd_barrier_post((unsigned*)(p.ws + WS_BAR), (volatile LAS unsigned*)&xb_words);
    const int step_lo = p.step_lo, step_hi = p.step_hi;
    for (int s = step_lo; s < step_hi; ++s) {
        const int kind = p.kind[s], lo = p.lo[s], hi = p.hi[s];
        switch (kind) {
            case K_PRE0:
#ifndef NO_PRE
 convert_tiles(p, lo, hi, lds); rope_table(p); norm_rows(p.in[0], p.in[1], (bf16_t*)(p.ws + WS_H));
#endif
 break;
            case K_GEMMB:
#ifndef NO_GB

                { pg8::Gemm g; g.A = p.g[lo].A; g.Bt = p.g[lo].Bt; g.M = p.g[lo].M; g.N = p.g[lo].N; g.K = p.g[lo].K;
                  MultiOrder S; S.ops = &p.g[lo]; S.nops = hi - lo; S.G = G; S.c = bid;
                  EpiB E; E.ops = &p.g[lo];
                  pg8::gemm_phase<EpiB, MultiOrder, false>(lds, g, S, E, nullptr); }
                if (p.chi[s] > p.clo[s]) convert_queue(p, p.clo[s], p.chi[s], (unsigned*)(p.ws + WS_BAR + 16384) + 64 * p.cq[s], lds);
#endif
                break;
            case K_GEMMF:
#ifndef NO_GF

                for (int i = lo; i < hi; ++i) { const GemmOp& o = p.g[i]; pg8::Gemm g; g.A = o.A; g.Bt = o.Bt; g.M = o.M; g.N = o.N; g.K = o.K;
                    pg8::StaticOrder S; S.init(o.M, o.N, G, (bid + G - (o.rot % G)) % G);
                    EpiF E; E.C = (float*)o.out; E.ldc = o.ldc; E.res = o.res;
                    pg8::gemm_phase<EpiF, pg8::StaticOrder, false>(lds, g, S, E, nullptr); }
#endif
                break;
            case K_CONVSSD:
#ifndef NO_CONV
 conv_ssd(p);
#endif
 break;
            case K_MIX0:

#ifndef NO_SSD
for (int j = bid; j < 256; j += G) ssd_chunk_job(p, j, lds);
#endif


#ifndef NO_ATT
for (int j = bid; j < 512; j += G) attn_job(p, j, lds);
#endif

                break;
            case K_POST0: post_ssd(p); break;
            case K_NORM: norm_rows(p.out, p.in[2] + lo * D, (bf16_t*)(p.ws + WS_H)); break;
            case K_PRE1: convert_tiles(p, lo, hi, lds); mix_rows(p.out, p.in[1] + D, p.in[16], (bf16_t*)(p.ws + WS_MIX), 0, lds); break;
            case K_MIXES: mix_rows(p.out, p.in[1] + D, p.in[16], (bf16_t*)(p.ws + WS_MIX), 8192, lds); break;
            case K_RWKV:
#ifndef NO_RWKV
 for (int j = bid; j < 256; j += G) rwkv_chunk_job(p, j, lds);
#endif
 break;
            case K_NORMCONV: convert_tiles(p, lo, hi, lds); norm_rows(p.out, p.in[2] + D, (bf16_t*)(p.ws + WS_H)); break;
            default: break;
        }
        if (s + 1 < step_hi) { if (step_hi < 0) cg::this_grid().sync();   XcdBarrier xb; xb.bar = (unsigned*)(p.ws + WS_BAR); xb.x = xb_xcc_id(); xb.st = (volatile LAS unsigned*)&xb_words; xcd_barrier(xb); }
    }
}

#ifndef MK_MULTI
#define MK_MULTI 0
#endif
extern "C" void kernel_launch(void* const* d_in, const int* in_sizes, int n_in, void* d_out, int out_size, void* d_ws, size_t ws_size, hipStream_t stream) {
    static int grid = 0;
    if (grid == 0) {
        int dev = 0, cus = 0, per_cu = 0;
        hipGetDevice(&dev); hipDeviceGetAttribute(&cus, hipDeviceAttributeMultiprocessorCount, dev);
        if (hipFuncSetAttribute((const void*)mega, hipFuncAttributeMaxDynamicSharedMemorySize, LDS_BYTES) != hipSuccess) { fprintf(stderr, "hipFuncSetAttribute failed\n"); grid = -1; return; }
        if (hipOccupancyMaxActiveBlocksPerMultiprocessor(&per_cu, (const void*)mega, 512, LDS_BYTES) != hipSuccess || per_cu < 1) { fprintf(stderr, "occupancy query: %d\n", per_cu); per_cu = 1; }
        (void)hipGetLastError();
        grid = cus * per_cu; if (grid > 256) grid = 256;
        if (n_in != 34 || ws_size < 512 * MiB) { fprintf(stderr, "unexpected n_in %d / ws %zu\n", n_in, ws_size); grid = -1; return; }
    }
    if (grid < 0) return;
    static Params p;
    memset(&p, 0, sizeof(p));
    for (int i = 0; i < 34; ++i) p.in[i] = (const float*)d_in[i];
    p.out = (float*)d_out; p.ws = (unsigned char*)d_ws;
    unsigned char* ws = (unsigned char*)d_ws;
    auto B16 = [&](size_t off) { return (bf16_t*)(ws + off); };
    int ncj = 0, tile_acc = 0;
    auto CJ = [&](const float* src, size_t dst_off, int K, int N, int Kpad, int Npad) { ConvJob& c = p.cj[ncj++]; c.src = src; c.dst = B16(dst_off); c.K = K; c.N = N; c.Kpad = Kpad; c.Npad = Npad; c.tile0 = tile_acc; c.ntiles = (Kpad / 64) * (Npad / 256); tile_acc += c.ntiles; };
    const float* w_up = p.in[3]; const float* w_down = p.in[4];
    tile_acc = 0;
    CJ(p.in[5], WS_WBA, 2048, 4112, 2048, 4352); CJ(p.in[15], WS_WBA + 17 * MiB, 2048, 2048, 2048, 2048);
    tile_acc = 0;
    CJ(w_up, WS_WMLP, 2048, 8192, 2048, 8192); CJ(w_down, WS_WMLP + 32 * MiB, 8192, 2048, 8192, 2048);
    tile_acc = 0;
    CJ(p.in[28], WS_WBA, 2048, 2048, 2048, 2048); CJ(p.in[29], WS_WBA + 8 * MiB, 2048, 2048, 2048, 2048); CJ(p.in[30], WS_WBA + 16 * MiB, 2048, 2048, 2048, 2048); CJ(p.in[31], WS_WBA + 24 * MiB, 2048, 2048, 2048, 2048);
    CJ(p.in[18], WS_WBA + 32 * MiB, 2048, 96, 2048, 256); CJ(p.in[21], WS_WBA + 33 * MiB, 2048, 96, 2048, 256); CJ(p.in[23], WS_WBA + 34 * MiB, 2048, 256, 2048, 256);
    CJ(p.in[19], WS_WBA + 35 * MiB, 96, 2048, 256, 2048); CJ(p.in[22], WS_WBA + 36 * MiB, 96, 2048, 256, 2048); CJ(p.in[24], WS_WBA + 37 * MiB, 256, 2048, 256, 2048);
    tile_acc = 0;
    CJ(w_up + (size_t)2048 * 8192, WS_WMLP1, 2048, 8192, 2048, 8192); CJ(w_down + (size_t)2048 * 8192, WS_WMLP1 + 32 * MiB, 8192, 2048, 8192, 2048);
    int nop = 0;
    auto GO = [&](const bf16_t* A, const bf16_t* Bt, void* out, const float* bias, const float* res, int M, int N, int K, int ldc, int act, int rot) {
        GemmOp& o = p.g[nop++]; o.A = A; o.Bt = Bt; o.out = out; o.bias = bias; o.res = res; o.M = M; o.N = N; o.K = K; o.ldc = ldc; o.act = act; o.rot = rot; };
    GO(B16(WS_H), B16(WS_WBA), B16(WS_PROJ), nullptr, nullptr, MTOK, INWP, 2048, INWP, 0, 0);
    GO(B16(WS_YMIX), B16(WS_WBA + 17 * MiB), d_out, nullptr, p.in[0], MTOK, 2048, 2048, 2048, 0, 0);
    GO(B16(WS_H), B16(WS_WMLP), B16(WS_U), nullptr, nullptr, MTOK, DFF, 2048, DFF, 1, 0);
    GO(B16(WS_U), B16(WS_WMLP + 32 * MiB), d_out, nullptr, (const float*)d_out, MTOK, 2048, DFF, 2048, 0, 0);
    for (int half = 0; half < 2; ++half) {
        const size_t ro = (size_t)half * 8192 * 2048 * 2, lo_ = (size_t)half * 8192 * 256 * 2; const size_t mb = (size_t)8192 * 2048 * 2;
        GO(B16(WS_MIX + 0 * mb), B16(WS_WBA), B16(WS_R + ro), nullptr, nullptr, 8192, 2048, 2048, 2048, 0, 0);
        GO(B16(WS_MIX + 2 * mb), B16(WS_WBA + 8 * MiB), B16(WS_K + ro), nullptr, nullptr, 8192, 2048, 2048, 2048, 0, 0);
        GO(B16(WS_MIX + 3 * mb), B16(WS_WBA + 16 * MiB), B16(WS_V + ro), nullptr, nullptr, 8192, 2048, 2048, 2048, 0, 0);
        GO(B16(WS_MIX + 1 * mb), B16(WS_WBA + 32 * MiB), B16(WS_L1W + lo_), nullptr, nullptr, 8192, 256, 2048, 256, 2, 0);
        GO(B16(WS_MIX + 4 * mb), B16(WS_WBA + 33 * MiB), B16(WS_L1A + lo_), nullptr, nullptr, 8192, 256, 2048, 256, 0, 32);
        GO(B16(WS_MIX + 5 * mb), B16(WS_WBA + 34 * MiB), B16(WS_L1G + lo_), nullptr, nullptr, 8192, 256, 2048, 256, 3, 64);
    }
    GO(B16(WS_L1W), B16(WS_WBA + 35 * MiB), B16(WS_WDEC), p.in[17], nullptr, MTOK, 2048, 256, 2048, 4, 0);
    GO(B16(WS_L1A), B16(WS_WBA + 36 * MiB), B16(WS_AA), p.in[20], nullptr, MTOK, 2048, 256, 2048, 3, 0);
    GO(B16(WS_L1G), B16(WS_WBA + 37 * MiB), B16(WS_GG), nullptr, nullptr, MTOK, 2048, 256, 2048, 0, 0);
    GO(B16(WS_YG), B16(WS_WBA + 24 * MiB), d_out, nullptr, (const float*)d_out, MTOK, 2048, 2048, 2048, 0, 0);
    GO(B16(WS_H), B16(WS_WMLP1), B16(WS_U), nullptr, nullptr, MTOK, DFF, 2048, DFF, 1, 0);
    GO(B16(WS_U), B16(WS_WMLP1 + 32 * MiB), d_out, nullptr, (const float*)d_out, MTOK, 2048, DFF, 2048, 0, 0);
    int ns = 0;
    auto ST = [&](int kind, int lo, int hi, int clo = 0, int chi = 0, int cq = 0) { p.kind[ns] = kind; p.lo[ns] = lo; p.hi[ns] = hi; p.clo[ns] = clo; p.chi[ns] = chi; p.cq[ns] = cq; ++ns; };
    ST(K_PRE0, 0, 2); ST(K_GEMMB, 0, 1, 2, 4, 0); ST(K_CONVSSD, 0, 0); ST(K_MIX0, 0, 0); ST(K_POST0, 0, 0); ST(K_GEMMF, 1, 2); ST(K_NORM, 0, 0); ST(K_GEMMB, 2, 3); ST(K_GEMMF, 3, 4);
    ST(K_PRE1, 4, 14); ST(K_GEMMB, 4, 10, 14, 16, 1); ST(K_MIXES, 0, 0); ST(K_GEMMB, 10, 16, 14, 16, 1); ST(K_GEMMB, 16, 19); ST(K_RWKV, 0, 0); ST(K_GEMMF, 19, 20); ST(K_NORM, 1, 0); ST(K_GEMMB, 20, 21); ST(K_GEMMF, 21, 22);
    (void)hipMemsetAsync(ws + WS_BAR, 0, 16384 + 1024, stream);
#if MK_MULTI
    for (int s = 0; s < ns; ++s) { p.step_lo = s; p.step_hi = s + 1; hipLaunchKernelGGL(mega, dim3(grid), dim3(512), LDS_BYTES, stream, p); }
#else
    p.step_lo = 0; p.step_hi = ns;
    void* args[] = {(void*)&p};
    const hipError_t e = hipLaunchCooperativeKernel((const void*)mega, dim3(grid), dim3(512), args, LDS_BYTES, stream);
    if (e != hipSuccess) fprintf(stderr, "cooperative launch failed: %s (grid %d)\n", hipGetErrorString(e), grid);
#endif
}
```

```cpp
#include <hip/hip_runtime.h>
#include <hip/hip_cooperative_groups.h>
#include <cstdio>
#include <cstring>
namespace cg = cooperative_groups;
__device__ __forceinline__ int opq(int v) { asm volatile("" : "+v"(v)); return v; }
namespace pg8 {
#define PG8_LAS __attribute__((address_space(3)))
typedef unsigned short bf16_t;
typedef short bf16x8 __attribute__((ext_vector_type(8)));
typedef float f32x4 __attribute__((ext_vector_type(4)));
typedef unsigned u32x4 __attribute__((ext_vector_type(4)));
constexpr int BM = 256, BK = 64, HALF = 128, HTB = HALF * BK * 2  , STAGE_BYTES = 8 * HTB, NXCD = 8, WGM = 8;

__host__ __device__ __forceinline__ int lds_byte(int r, int c) { const int st = (r >> 4) * 2 + (c >> 5), rr = r & 15, cc = c & 31, ob = rr * 64 + cc * 2; return st * 1024 + (ob ^ (((ob >> 9) & 1) << 5)); }
__host__ __device__ __forceinline__ void stage_rc(int b, int& R, int& C) { const int st = b / 1024, sb = b % 1024, swz = sb ^ (((sb >> 9) & 1) << 5); R = (st >> 1) * 16 + swz / 64; C = (st & 1) * 32 + (swz % 64) / 2; }
__host__ __device__ __forceinline__ int perm32(int rho) { const int n = rho >> 4, i = rho & 15; return 8 * (i >> 2) + 4 * n + (i & 3); }

struct Unit { int pm, pn, op; };
struct Gemm { const bf16_t* A; const bf16_t* Bt; int M, N, K; };

struct StaticOrder {
    int nM, nN, nwg, G, c;
    __host__ __device__ void init(int M, int N, int G_, int c_) { nM = M / BM; nN = N / BM; nwg = nM * nN; G = G_; c = c_; }
    __host__ __device__ bool next(int i, Unit& u) const {
        const long L = (long)i * G + c; if (L >= nwg) return false;
        int wgid = (int)L; { const int q = nwg / NXCD, r = nwg % NXCD, xcd = wgid % NXCD, off = wgid / NXCD; wgid = (xcd < r ? xcd * (q + 1) : r * (q + 1) + (xcd - r) * q) + off; }
        const int nig = WGM * nN, gid = wgid / nig, fm = gid * WGM, gsz = (nM - fm) < WGM ? (nM - fm) : WGM;
        u.pm = fm + ((wgid % nig) % gsz); u.pn = (wgid % nig) / gsz; u.op = 0; return true;
    }
    __device__ __forceinline__ const char* abase(const Unit&, const Gemm& g) const { return (const char*)g.A; }
    __device__ __forceinline__ const char* bbase(const Unit&, const Gemm& g) const { return (const char*)g.Bt; }
    __device__ __forceinline__ void a_ready(const Unit&) const {}
    __device__ __forceinline__ void done(const Unit&) const {}
};
typedef __bf16 bf16x2_t __attribute__((ext_vector_type(2)));
typedef float f32x2_t __attribute__((ext_vector_type(2)));
__device__ __forceinline__ unsigned cvt_pk_bf16(float lo, float hi) { const f32x2_t f = {lo, hi}; const bf16x2_t v = __builtin_convertvector(f, bf16x2_t); return __builtin_bit_cast(unsigned, v); }
__device__ __forceinline__ unsigned cvt_pk_nv(float lo, float hi) { return cvt_pk_bf16(lo, hi); }

template <class Epi, class Sched, bool STAMP = false>
__device__ __forceinline__ void gemm_phase(PG8_LAS unsigned char* lds, const Gemm g, const Sched& S, const Epi& E, unsigned long long* stamps) {
    const int tid = opq(threadIdx.x), wid = __builtin_amdgcn_readfirstlane(tid >> 6), lane = tid & 63, wr = wid >> 2, wc = wid & 3, fr = lane & 15, fq = lane >> 4;
    const int K = g.K, nt = K / BK;
    int ts_lo = 0, ts_hi = 0, nts = 0; const unsigned long long rt_entry = STAMP ? (unsigned long long)wall_clock64() : 0ull;
#define PG8_STAMP() do { if (STAMP && wid == 0 && nts < 64) { const unsigned long long _c = (unsigned long long)clock64(); \
        ts_lo = (lane == nts) ? (int)(unsigned)_c : ts_lo; ts_hi = (lane == nts) ? (int)(unsigned)(_c >> 32) : ts_hi; ++nts; } } while (0)
    PG8_STAMP();
    unsigned voffA[2], voffB[2];
#pragma unroll
    for (int i = 0; i < 2; ++i) { int R, C; stage_rc(tid * 16 + i * 8192, R, C); const int Rb = Epi::PERM ? ((R & ~31) + perm32(R & 31)) : R;
        voffA[i] = (unsigned)(R * K + C) * 2u; voffB[i] = (unsigned)(Rb * K + C) * 2u; }
    const size_t kstep = (size_t)(BK * 2);
    const size_t hstep = (size_t)HALF * K * 2;
    const size_t tstep = 2 * hstep;
    const unsigned ldsw = (unsigned)wid * 1024u;
    const int aoff = lds_byte(wr * 64 + fr, fq * 8), boff = lds_byte(wc * 32 + fr, fq * 8);
#define PG8_SA(b, h) (((b) * 2 + (h)) * HTB)
#define PG8_SB(b, h) ((4 + (b) * 2 + (h)) * HTB)
#define PG8_STAGE(bufoff, gbase, voff) do { _Pragma("unroll") for (int _i = 0; _i < 2; ++_i) \
        __builtin_amdgcn_global_load_lds((const unsigned*)((const char*)(gbase) + (voff)[_i]), (PG8_LAS unsigned*)(lds + (bufoff) + ldsw + _i * 8192), 16, 0, 0); } while (0)
#define PG8_LDA(dst, b, h) do { _Pragma("unroll") for (int m = 0; m < 4; ++m) _Pragma("unroll") for (int k = 0; k < 2; ++k) dst[m][k] = *(const PG8_LAS bf16x8*)(lds + PG8_SA(b, h) + aoff + m * 2048 + k * 1024); } while (0)
#define PG8_LDB(dst, b, h) do { _Pragma("unroll") for (int n = 0; n < 2; ++n) _Pragma("unroll") for (int k = 0; k < 2; ++k) dst[n][k] = *(const PG8_LAS bf16x8*)(lds + PG8_SB(b, h) + boff + n * 2048 + k * 1024); } while (0)
#define PG8_MMA(ai, bj, At, Bt) do { __builtin_amdgcn_s_setprio(1); _Pragma("unroll") for (int m = 0; m < 4; ++m) _Pragma("unroll") for (int n = 0; n < 2; ++n) _Pragma("unroll") for (int k = 0; k < 2; ++k) \
        acc[ai][bj][m][n] = __builtin_amdgcn_mfma_f32_16x16x32_bf16(Bt[n][k], At[m][k], acc[ai][bj][m][n], 0, 0, 0); __builtin_amdgcn_s_setprio(0); } while (0)
#define PG8_WAIT_V(n) asm volatile("s_waitcnt vmcnt(" #n ")" ::: "memory")
#define PG8_WAIT_L(n) asm volatile("s_waitcnt lgkmcnt(" #n ")" ::: "memory")
#define PG8_BAR __builtin_amdgcn_s_barrier()
#define PG8_SCHED __builtin_amdgcn_sched_barrier(0)
    Unit cur, nxt; int ui = 0;
    if (!S.next(0, cur)) return;
    f32x4 acc[2][2][4][2];
#pragma unroll
    for (int a = 0; a < 2; ++a)
#pragma unroll
        for (int b = 0; b < 2; ++b)
#pragma unroll
            for (int m = 0; m < 4; ++m)
#pragma unroll
                for (int n = 0; n < 2; ++n) acc[a][b][m][n] = (f32x4){0.f, 0.f, 0.f, 0.f};
    bf16x8 At[4][2], B0[2][2], B1[2][2];
    const char* cA = S.abase(cur, g) + (size_t)cur.pm * tstep; const char* cB = S.bbase(cur, g) + (size_t)cur.pn * tstep;
    S.a_ready(cur);
    PG8_STAGE(PG8_SB(0, 0), cB, voffB); PG8_STAGE(PG8_SA(0, 0), cA, voffA); PG8_STAGE(PG8_SB(0, 1), cB + hstep, voffB); PG8_STAGE(PG8_SA(0, 1), cA + hstep, voffA);
    if (wr == 1) PG8_BAR;
    PG8_WAIT_V(4); PG8_BAR;
    PG8_STAGE(PG8_SB(1, 0), cB + kstep, voffB); PG8_STAGE(PG8_SA(1, 0), cA + kstep, voffA); PG8_STAGE(PG8_SB(1, 1), cB + hstep + kstep, voffB);
    PG8_WAIT_V(6); PG8_BAR;
    PG8_STAMP();
    for (;;) {
        const bool has_next = S.next(ui + 1, nxt);
        const char* nA = has_next ? S.abase(nxt, g) + (size_t)nxt.pm * tstep : cA; const char* nB = has_next ? S.bbase(nxt, g) + (size_t)nxt.pn * tstep : cB;
        for (int t = 0; t < nt; t += 2) {
            const bool last = (t == nt - 2);
            const char* a1 = cA + (size_t)(t + 1) * kstep;
            const char* a2 = last ? nA : cA + (size_t)(t + 2) * kstep; const char* b2 = last ? nB : cB + (size_t)(t + 2) * kstep;
            const char* a3 = a2 + kstep; const char* b3 = b2 + kstep;
            if (last && has_next) S.a_ready(nxt);
            PG8_LDB(B0, 0, 0); PG8_SCHED; PG8_LDA(At, 0, 0); PG8_STAGE(PG8_SA(1, 1), a1 + hstep, voffA);
            PG8_WAIT_L(8); PG8_BAR; PG8_WAIT_L(0); PG8_MMA(0, 0, At, B0); PG8_BAR; PG8_SCHED;
            PG8_LDB(B1, 0, 1); PG8_STAGE(PG8_SB(0, 0), b2, voffB);
            PG8_BAR; PG8_WAIT_L(0); PG8_MMA(0, 1, At, B1); PG8_BAR;
            PG8_LDA(At, 0, 1); PG8_STAGE(PG8_SA(0, 0), a2, voffA);
            PG8_BAR; PG8_WAIT_L(0); PG8_MMA(1, 0, At, B0); PG8_BAR; PG8_SCHED;
            PG8_STAGE(PG8_SB(0, 1), b2 + hstep, voffB);
            PG8_WAIT_V(6); PG8_BAR; PG8_MMA(1, 1, At, B1); PG8_BAR;
            PG8_LDB(B0, 1, 0); PG8_SCHED; PG8_LDA(At, 1, 0); PG8_STAGE(PG8_SA(0, 1), a2 + hstep, voffA);
            PG8_WAIT_L(8); PG8_BAR; PG8_WAIT_L(0); PG8_MMA(0, 0, At, B0); PG8_BAR; PG8_SCHED;
            PG8_LDB(B1, 1, 1); PG8_STAGE(PG8_SB(1, 0), b3, voffB);
            PG8_BAR; PG8_WAIT_L(0); PG8_MMA(0, 1, At, B1); PG8_BAR;
            PG8_LDA(At, 1, 1); PG8_STAGE(PG8_SA(1, 0), a3, voffA);
            PG8_BAR; PG8_WAIT_L(0); PG8_MMA(1, 0, At, B0); PG8_BAR; PG8_SCHED;
            PG8_STAGE(PG8_SB(1, 1), b3 + hstep, voffB);
            PG8_WAIT_V(6); PG8_BAR; PG8_MMA(1, 1, At, B1); PG8_BAR;
        }
        PG8_STAMP();
        if constexpr (!Epi::AFTER_DRAIN) { E(acc, cur, wr, wc, fr, fq); S.done(cur); }
        PG8_STAMP();
        if (!has_next) break;
#pragma unroll
        for (int a = 0; a < 2; ++a)
#pragma unroll
            for (int b = 0; b < 2; ++b)
#pragma unroll
                for (int m = 0; m < 4; ++m)
#pragma unroll
                    for (int n = 0; n < 2; ++n) acc[a][b][m][n] = (f32x4){0.f, 0.f, 0.f, 0.f};
        cur = nxt; cA = nA; cB = nB; ++ui;
    }
    PG8_WAIT_V(0);
    if (wr == 0) PG8_BAR;
    PG8_BAR;
    if constexpr (Epi::AFTER_DRAIN) { E.fused(acc, cur, wr, wc, fr, fq, lds, wid, lane); S.done(cur); }
    PG8_STAMP();
    if (STAMP && wid == 0) { stamps[lane] = lane < nts ? (((unsigned long long)(unsigned)ts_hi << 32) | (unsigned)ts_lo) : 0ull;
        if (lane == 62) stamps[62] = rt_entry; if (lane == 63) stamps[63] = (unsigned long long)wall_clock64(); }
#undef PG8_STAMP
#undef PG8_SA
#undef PG8_SB
#undef PG8_STAGE
#undef PG8_LDA
#undef PG8_LDB
#undef PG8_MMA
#undef PG8_WAIT_V
#undef PG8_WAIT_L
#undef PG8_BAR
#undef PG8_SCHED
}
}

#include <cstdio>
#include <ctime>
#include <cstdlib>
#include <cstring>
#include <cmath>
#include <vector>
#include <algorithm>
#define CK(x) do { hipError_t e_ = (x); if (e_ != hipSuccess) { fprintf(stderr, "HIP %s:%d %s\n", __FILE__, __LINE__, hipGetErrorString(e_)); exit(2); } } while (0)
using pg8::bf16_t; using pg8::bf16x8; using pg8::f32x4; using pg8::u32x4; using pg8::cvt_pk_bf16; using pg8::cvt_pk_nv;
#define LAS PG8_LAS

constexpr int D = 2048, SEQ = 2048, MTOK = 16384, DFF = 8192, INWP = 4352;
constexpr int COL_K = 1024, COL_V = 1280, COL_Z = 1536, COL_XBC = 2560, COL_DT = 4096;
constexpr size_t MiB = (size_t)1 << 20;
constexpr size_t WS_WBA = 0, WS_WMLP = 40 * MiB, WS_H = 104 * MiB, WS_PROJ = 168 * MiB, WS_YMIX = 304 * MiB, WS_YRAW = 368 * MiB, WS_XBC = 432 * MiB,
                 WS_DT = 480 * MiB, WS_DA = 481 * MiB, WS_ROPE = 482 * MiB, WS_U = 168 * MiB;
constexpr size_t WS_R = 40 * MiB, WS_K = 104 * MiB, WS_V = 168 * MiB, WS_L1W = 232 * MiB, WS_L1A = 240 * MiB, WS_L1G = 248 * MiB, WS_MIX = 256 * MiB,
                 WS_WDEC = 256 * MiB, WS_AA = 320 * MiB, WS_GG = 384 * MiB, WS_YG = 40 * MiB  , WS_WMLP1 = 448 * MiB;
constexpr size_t WS_BAR = 39 * MiB;
constexpr int LDS_BYTES = 140 * 1024;

enum { K_PRE0 = 0, K_GEMMB, K_GEMMF, K_CONVSSD, K_MIX0, K_POST0, K_NORM, K_PRE1, K_MIXES, K_RWKV, K_NORMCONV };
constexpr int NSTEPS = 48, NOPS = 22, NCJ = 16;
#define REP_GEMMB 1
#define REP_MIX0 1
#define REP_RWKV 1
#define REP_ELEM 1

struct GemmOp { const bf16_t* A; const bf16_t* Bt; void* out; const float* bias; const float* res; int M, N, K, ldc, act, rot, pad0, pad1; };
struct ConvJob { const float* src; bf16_t* dst; int K, N, Kpad, Npad, tile0, ntiles; };
struct Params {
    const float* in[34];
    float* out; unsigned char* ws;
    GemmOp g[NOPS];
    ConvJob cj[NCJ];
    int kind[NSTEPS + 1]; int lo[NSTEPS + 1]; int hi[NSTEPS + 1]; int clo[NSTEPS + 1]; int chi[NSTEPS + 1]; int cq[NSTEPS + 1];
    int step_lo, step_hi;
};

__device__ __forceinline__ float bf2f(unsigned short b) { return __uint_as_float(((unsigned)b) << 16); }
__device__ __forceinline__ float bflo(unsigned w) { return __uint_as_float(w << 16); }
__device__ __forceinline__ float bfhi(unsigned w) { return __uint_as_float(w & 0xffff0000u); }
__device__ __forceinline__ bf16_t f2bf(float f) { return (bf16_t)(cvt_pk_bf16(f, 0.f) & 0xffffu); }
template <int CTRL> __device__ __forceinline__ float dpp_add(float x) {
    const int y = __builtin_amdgcn_update_dpp(0, __builtin_bit_cast(int, x), CTRL, 0xf, 0xf, true);
    return x + __builtin_bit_cast(float, y); }
template <int CTRL> __device__ __forceinline__ float dpp_max(float x) {
    const int y = __builtin_amdgcn_update_dpp(0, __builtin_bit_cast(int, x), CTRL, 0xf, 0xf, true);
    return fmaxf(x, __builtin_bit_cast(float, y)); }
__device__ __forceinline__ float max16(float x) { x = dpp_max<0xB1>(x); x = dpp_max<0x4E>(x); x = dpp_max<0x141>(x); x = dpp_max<0x140>(x); return x; }
__device__ __forceinline__ float red8(float x) { x = dpp_add<0xB1>(x); x = dpp_add<0x4E>(x); x = dpp_add<0x141>(x); return x; }
__device__ __forceinline__ float red16(float x) { x = red8(x); x = dpp_add<0x140>(x); return x; }
__device__ __forceinline__ float wave_sum(float v) {
    v = red16(v);
    const float r0 = __builtin_bit_cast(float, __builtin_amdgcn_readlane(__builtin_bit_cast(int, v), 0)), r1 = __builtin_bit_cast(float, __builtin_amdgcn_readlane(__builtin_bit_cast(int, v), 16));
    const float r2 = __builtin_bit_cast(float, __builtin_amdgcn_readlane(__builtin_bit_cast(int, v), 32)), r3 = __builtin_bit_cast(float, __builtin_amdgcn_readlane(__builtin_bit_cast(int, v), 48));
    return (r0 + r1) + (r2 + r3); }
typedef float f32x2 __attribute__((ext_vector_type(2)));
typedef unsigned u32x2 __attribute__((ext_vector_type(2)));
__device__ __forceinline__ float sigmoidf_(float v) { return __builtin_amdgcn_rcpf(1.0f + __expf(-v)); }
__device__ __forceinline__ void unpack8(const uint4 r, float (&f)[8]) {
    f[0] = bflo(r.x); f[1] = bfhi(r.x); f[2] = bflo(r.y); f[3] = bfhi(r.y); f[4] = bflo(r.z); f[5] = bfhi(r.z); f[6] = bflo(r.w); f[7] = bfhi(r.w); }

__device__ __forceinline__ float act_apply(float v, int act) {
    switch (act) {
        case 1: { const float r = fmaxf(v, 0.f); return r * r; }
        case 2: return 1.0f - 2.0f * __builtin_amdgcn_rcpf(1.0f + __expf(2.0f * v));
        case 3: return sigmoidf_(v);
        case 4: return 0.60653066f * sigmoidf_(v);
        default: return v; }
}
struct EpiB {
    static constexpr bool PERM = true, AFTER_DRAIN = false;
    const GemmOp* ops;
    __device__ __forceinline__ void operator()(const f32x4 (&acc)[2][2][4][2], const pg8::Unit& u, int wr, int wc, int fr, int fq) const {
        const GemmOp& o_ = ops[u.op]; bf16_t* O = (bf16_t*)o_.out; const int ldc = o_.ldc; const float* bias = o_.bias; const int act = o_.act;
        const int row0 = u.pm * 256 + wr * 64 + fr, col0 = u.pn * 256 + wc * 32 + 8 * fq;
        f32x4 bv[2][2];
#pragma unroll
        for (int bj = 0; bj < 2; ++bj)
#pragma unroll
            for (int n = 0; n < 2; ++n) bv[bj][n] = bias ? *(const f32x4*)(bias + col0 + bj * 128 + 4 * n) : (f32x4){0.f, 0.f, 0.f, 0.f};
#pragma unroll
        for (int ai = 0; ai < 2; ++ai)
#pragma unroll
            for (int m = 0; m < 4; ++m) { bf16_t* rowp = O + (size_t)(row0 + ai * 128 + m * 16) * ldc + col0;
#pragma unroll
                for (int bj = 0; bj < 2; ++bj) { f32x4 v0 = acc[ai][bj][m][0], v1 = acc[ai][bj][m][1];
                    v0 += bv[bj][0]; v1 += bv[bj][1];
                    if (act) {
#pragma unroll
                        for (int j = 0; j < 4; ++j) { v0[j] = act_apply(v0[j], act); v1[j] = act_apply(v1[j], act); } }
                    u32x4 w; w.x = cvt_pk_bf16(v0[0], v0[1]); w.y = cvt_pk_bf16(v0[2], v0[3]); w.z = cvt_pk_bf16(v1[0], v1[1]); w.w = cvt_pk_bf16(v1[2], v1[3]);
                    *(u32x4*)(rowp + bj * 128) = w; } }
    }
};
struct MultiOrder {
    const GemmOp* ops; int nops, G, c;
    __device__ __forceinline__ bool next(int i, pg8::Unit& u) const {
        long L = (long)i * G + c; int k = 0, nM = 0, nN = 0, nwg = 0;
        for (; k < nops; ++k) { nM = ops[k].M / 256; nN = ops[k].N / 256; nwg = nM * nN; if (L < nwg) break; L -= nwg; }
        if (k == nops) return false;
        int wgid = (int)L; { const int q = nwg / pg8::NXCD, r = nwg % pg8::NXCD, xcd = wgid % pg8::NXCD, off = wgid / pg8::NXCD; wgid = (xcd < r ? xcd * (q + 1) : r * (q + 1) + (xcd - r) * q) + off; }
        const int nig = pg8::WGM * nN, gid = wgid / nig, fm = gid * pg8::WGM, gsz = (nM - fm) < pg8::WGM ? (nM - fm) : pg8::WGM;
        u.pm = fm + ((wgid % nig) % gsz); u.pn = (wgid % nig) / gsz; u.op = k; return true;
    }
    __device__ __forceinline__ const char* abase(const pg8::Unit& u, const pg8::Gemm&) const { return (const char*)ops[u.op].A; }
    __device__ __forceinline__ const char* bbase(const pg8::Unit& u, const pg8::Gemm&) const { return (const char*)ops[u.op].Bt; }
    __device__ __forceinline__ void a_ready(const pg8::Unit&) const {}
    __device__ __forceinline__ void done(const pg8::Unit&) const {}
};
struct EpiF {
    static constexpr bool PERM = false, AFTER_DRAIN = false;
    float* C; int ldc; const float* res;
    __device__ __forceinline__ void operator()(const f32x4 (&acc)[2][2][4][2], const pg8::Unit& u, int wr, int wc, int fr, int fq) const {
        const int row0 = u.pm * 256 + wr * 64 + fr, col0 = u.pn * 256 + wc * 32 + 4 * fq;
#pragma unroll
        for (int ai = 0; ai < 2; ++ai)
#pragma unroll
            for (int mh = 0; mh < 2; ++mh) { size_t ro[2]; f32x4 r[2][2][2];
#pragma unroll
                for (int mm = 0; mm < 2; ++mm) { ro[mm] = (size_t)(row0 + ai * 128 + (mh * 2 + mm) * 16) * ldc + col0;
#pragma unroll
                    for (int bj = 0; bj < 2; ++bj)
#pragma unroll
                        for (int n = 0; n < 2; ++n) r[mm][bj][n] = *(const f32x4*)(res + ro[mm] + bj * 128 + n * 16); }
#pragma unroll
                for (int mm = 0; mm < 2; ++mm)
#pragma unroll
                    for (int bj = 0; bj < 2; ++bj)
#pragma unroll
                        for (int n = 0; n < 2; ++n) *(f32x4*)(C + ro[mm] + bj * 128 + n * 16) = acc[ai][bj][mh * 2 + mm][n] + r[mm][bj][n]; }
    }
};

__device__ __forceinline__ void convert_one_tile(const Params& p, int jlo, int jhi, int tile, int tid, LAS float* T) {
    int j = jlo; while (j + 1 < jhi && tile >= p.cj[j + 1].tile0) ++j;
    const float* src = p.cj[j].src; bf16_t* dst = p.cj[j].dst; const int K = p.cj[j].K, N = p.cj[j].N, Kpad = p.cj[j].Kpad;
    const int local = tile - p.cj[j].tile0, nkt = Kpad >> 6, kt = local % nkt, nt = local / nkt;
    f32x4 v[8];
#pragma unroll
    for (int i = 0; i < 8; ++i) { const int idx = tid + i * 512, kr = idx >> 6, c4 = idx & 63, k = kt * 64 + kr, n = nt * 256 + c4 * 4;
        v[i] = (f32x4){0.f, 0.f, 0.f, 0.f};
        if (k < K && n < N) v[i] = *(const f32x4*)(src + (size_t)k * N + n); }
#pragma unroll
    for (int i = 0; i < 8; ++i) { const int idx = tid + i * 512, kr = idx >> 6, c4 = idx & 63;
        T[kr * 257 + c4 * 4 + 0] = v[i][0]; T[kr * 257 + c4 * 4 + 1] = v[i][1]; T[kr * 257 + c4 * 4 + 2] = v[i][2]; T[kr * 257 + c4 * 4 + 3] = v[i][3]; }
    __syncthreads();
#pragma unroll
    for (int i = 0; i < 4; ++i) { const int idx = tid + i * 512, nl = idx >> 3, kc = idx & 7; float f[8];
#pragma unroll
        for (int e = 0; e < 8; ++e) f[e] = T[(kc * 8 + e) * 257 + nl];
        u32x4 w; w.x = cvt_pk_nv(f[0], f[1]); w.y = cvt_pk_nv(f[2], f[3]); w.z = cvt_pk_nv(f[4], f[5]); w.w = cvt_pk_nv(f[6], f[7]);
        *(u32x4*)(dst + (size_t)(nt * 256 + nl) * Kpad + kt * 64 + kc * 8) = w; }
    __syncthreads();
}
__device__ __forceinline__ void convert_tiles(const Params& p, int jlo, int jhi, LAS unsigned char* lds) {
    const int tid = opq(threadIdx.x); LAS float* T = (LAS float*)lds;
    const int total = p.cj[jhi - 1].tile0 + p.cj[jhi - 1].ntiles;
    for (int tile = blockIdx.x; tile < total; tile += gridDim.x) convert_one_tile(p, jlo, jhi, tile, tid, T);
}
__device__ __forceinline__ void convert_queue(const Params& p, int jlo, int jhi, unsigned* counter, LAS unsigned char* lds) {
    const int tid = opq(threadIdx.x); LAS float* T = (LAS float*)lds; LAS int* slot = (LAS int*)(lds + 72 * 1024);
    const int total = p.cj[jhi - 1].tile0 + p.cj[jhi - 1].ntiles;
    for (;;) {
        __syncthreads();
        if (tid == 0) *slot = (int)__hip_atomic_fetch_add(counter, 1u, __ATOMIC_RELAXED, __HIP_MEMORY_SCOPE_AGENT);
        __syncthreads();
        const int tile = *slot;
        if (tile >= total) break;
        convert_one_tile(p, jlo, jhi, tile, tid, T);
    }
}

__device__ __forceinline__ void rope_table(const Params& p) {
    float2* tab = (float2*)(p.ws + WS_ROPE);
    for (int idx = blockIdx.x * 512 + opq(threadIdx.x); idx < SEQ * 32; idx += gridDim.x * 512) {
        const int t = idx >> 5, i = idx & 31;
        const float inv = exp2f(-(float)i * 0.41524101186092029f);
        const float angf = (float)t * inv;
        const double ang = (double)angf;
        const double q = rint(ang * 0.6366197723675814);
        const float f = (float)fma(-q, 1.5707963267948966, ang), f2 = f * f;
        const float s = f * (1.0f + f2 * (-1.6666667e-1f + f2 * (8.3333333e-3f + f2 * (-1.9841270e-4f + f2 * 2.7557319e-6f))));
        const float c = 1.0f + f2 * (-0.5f + f2 * (4.1666667e-2f + f2 * (-1.3888889e-3f + f2 * (2.4801587e-5f + f2 * (-2.7557319e-7f)))));
        const int qi = ((int)q) & 3;
        const float sn = (qi == 0) ? s : (qi == 1) ? c : (qi == 2) ? -s : -c;
        const float cs = (qi == 0) ? c : (qi == 1) ? -s : (qi == 2) ? -c : s;
        tab[idx] = make_float2(cs, sn);
    }
}

__device__ __forceinline__ void norm_rows(const float* x, const float* g, bf16_t* h) {
    const int tid_ = opq(threadIdx.x); const int lane = tid_ & 63, wv = tid_ >> 6;
    f32x4 gg[8];
#pragma unroll
    for (int i = 0; i < 8; ++i) gg[i] = *(const f32x4*)(g + i * 256 + lane * 4);
    for (int row = (blockIdx.x * 8 + wv) * 2; row < MTOK; row += gridDim.x * 16) {
        const float* xr = x + (size_t)row * D; f32x4 v[8], u[8]; float ss = 0.f, st = 0.f;
#pragma unroll
        for (int i = 0; i < 8; ++i) { v[i] = *(const f32x4*)(xr + i * 256 + lane * 4); u[i] = *(const f32x4*)(xr + D + i * 256 + lane * 4); }
#pragma unroll
        for (int i = 0; i < 8; ++i) { ss += v[i][0] * v[i][0] + v[i][1] * v[i][1] + v[i][2] * v[i][2] + v[i][3] * v[i][3]; st += u[i][0] * u[i][0] + u[i][1] * u[i][1] + u[i][2] * u[i][2] + u[i][3] * u[i][3]; }
        ss = wave_sum(ss); st = wave_sum(st); const float r = rsqrtf(ss * (1.0f / D) + 1e-6f), r2 = rsqrtf(st * (1.0f / D) + 1e-6f);
#pragma unroll
        for (int i = 0; i < 8; ++i) {
            uint2 w; w.x = cvt_pk_nv(v[i][0] * r * gg[i][0], v[i][1] * r * gg[i][1]); w.y = cvt_pk_nv(v[i][2] * r * gg[i][2], v[i][3] * r * gg[i][3]);
            *(uint2*)(h + (size_t)row * D + i * 256 + lane * 4) = w;
            uint2 w2; w2.x = cvt_pk_nv(u[i][0] * r2 * gg[i][0], u[i][1] * r2 * gg[i][1]); w2.y = cvt_pk_nv(u[i][2] * r2 * gg[i][2], u[i][3] * r2 * gg[i][3]);
            *(uint2*)(h + (size_t)(row + 1) * D + i * 256 + lane * 4) = w2; }
    }
}

__device__ __forceinline__ void mix_rows(const float* x, const float* g, const float* mixw, bf16_t* mixbase, int tok0, LAS unsigned char* lds) {
    const int tid = opq(threadIdx.x), lane = tid & 63, wv = tid >> 6, c = tid * 4;
    LAS float* rs = (LAS float*)lds;
    const f32x4 gg = *(const f32x4*)(g + c); f32x4 mw[6];
#pragma unroll
    for (int m = 0; m < 6; ++m) mw[m] = *(const f32x4*)(mixw + m * D + c);
    for (int chunk = blockIdx.x; chunk < 256; chunk += gridDim.x) {
        const int rl0 = chunk * 32, tokc = tok0 + rl0; const bool hasprev = (tokc & (SEQ - 1)) != 0;
        __syncthreads();
        for (int r = wv; r < 33; r += 8) {
            float ss = 0.f;
            if (r > 0 || hasprev) { const float* xr = x + (size_t)(tokc - 1 + r) * D; f32x4 v[8];
#pragma unroll
                for (int i = 0; i < 8; ++i) v[i] = *(const f32x4*)(xr + i * 256 + lane * 4);
#pragma unroll
                for (int i = 0; i < 8; ++i) ss += v[i][0] * v[i][0] + v[i][1] * v[i][1] + v[i][2] * v[i][2] + v[i][3] * v[i][3]; }
            ss = wave_sum(ss);
            if (lane == 0) rs[r] = (r > 0 || hasprev) ? rsqrtf(ss * (1.0f / D) + 1e-6f) : 0.f;
        }
        __syncthreads();
        f32x4 prev = (f32x4){0.f, 0.f, 0.f, 0.f};
        if (hasprev) { const f32x4 pv = *(const f32x4*)(x + (size_t)(tokc - 1) * D + c); const float rp = rs[0]; prev = pv * rp * gg; }
        for (int r0 = 0; r0 < 32; r0 += 4) {
            f32x4 xv[4];
#pragma unroll
            for (int u = 0; u < 4; ++u) xv[u] = *(const f32x4*)(x + (size_t)(tokc + r0 + u) * D + c);
#pragma unroll
            for (int u = 0; u < 4; ++u) { const float rr = rs[r0 + u + 1]; const f32x4 hn = xv[u] * rr * gg, xx = prev - hn;
#pragma unroll
                for (int m = 0; m < 6; ++m) { const f32x4 o = hn + xx * mw[m];
                    uint2 w; w.x = cvt_pk_nv(o[0], o[1]); w.y = cvt_pk_nv(o[2], o[3]);
                    *(uint2*)(mixbase + (size_t)m * 8192 * D + (size_t)(rl0 + r0 + u) * D + c) = w; }
                prev = hn; }
        }
    }
}

__device__ __forceinline__ void conv_ssd(const Params& p) {
    const bf16_t* proj = (const bf16_t*)(p.ws + WS_PROJ); bf16_t* xbc = (bf16_t*)(p.ws + WS_XBC);
    const float* cw = p.in[6]; const float* cb = p.in[7];
    const int tid = opq(threadIdx.x);
    if (tid < 384) {
        const int c8 = tid % 192, par = tid / 192, c = c8 * 8;
        float w[4][8], bb[8];
#pragma unroll
        for (int j = 0; j < 4; ++j) { const f32x4 w0 = *(const f32x4*)(cw + j * 1536 + c), w1 = *(const f32x4*)(cw + j * 1536 + c + 4);
#pragma unroll
            for (int e = 0; e < 4; ++e) { w[j][e] = w0[e]; w[j][4 + e] = w1[e]; } }
        { const f32x4 b0 = *(const f32x4*)(cb + c), b1 = *(const f32x4*)(cb + c + 4);
#pragma unroll
          for (int e = 0; e < 4; ++e) { bb[e] = b0[e]; bb[4 + e] = b1[e]; } }
        for (int chunk = blockIdx.x; chunk < 256; chunk += gridDim.x) {
            const int t0 = chunk * 64 + par * 32; const bool hasprev = (t0 & (SEQ - 1)) != 0;
            float r0[8], r1[8], r2[8];
            if (hasprev) { const uint4 a = *(const uint4*)(proj + (size_t)(t0 - 3) * INWP + COL_XBC + c), b = *(const uint4*)(proj + (size_t)(t0 - 2) * INWP + COL_XBC + c), d = *(const uint4*)(proj + (size_t)(t0 - 1) * INWP + COL_XBC + c);
                unpack8(a, r0); unpack8(b, r1); unpack8(d, r2); }
            else {
#pragma unroll
                for (int e = 0; e < 8; ++e) { r0[e] = 0.f; r1[e] = 0.f; r2[e] = 0.f; } }
            for (int tg = 0; tg < 32; tg += 4) {
                uint4 rw[4];
#pragma unroll
                for (int u = 0; u < 4; ++u) rw[u] = *(const uint4*)(proj + (size_t)(t0 + tg + u) * INWP + COL_XBC + c);
#pragma unroll
                for (int u = 0; u < 4; ++u) { float cur[8], acc[8]; unpack8(rw[u], cur);
#pragma unroll
                    for (int e = 0; e < 8; ++e) { acc[e] = bb[e] + w[0][e] * r0[e] + w[1][e] * r1[e] + w[2][e] * r2[e] + w[3][e] * cur[e]; acc[e] = acc[e] * sigmoidf_(acc[e]); r0[e] = r1[e]; r1[e] = r2[e]; r2[e] = cur[e]; }
                    u32x4 o; o.x = cvt_pk_nv(acc[0], acc[1]); o.y = cvt_pk_nv(acc[2], acc[3]); o.z = cvt_pk_nv(acc[4], acc[5]); o.w = cvt_pk_nv(acc[6], acc[7]);
                    *(u32x4*)(xbc + (size_t)(t0 + tg + u) * 1536 + c) = o; }
            }
        }
    }
    float* dt = (float*)(p.ws + WS_DT); float* da = (float*)(p.ws + WS_DA);
    for (int idx = blockIdx.x * 512 + opq(threadIdx.x); idx < MTOK * 16; idx += gridDim.x * 512) {
        const int tok = idx >> 4, hh = idx & 15;
        const float v = bf2f(proj[(size_t)tok * INWP + COL_DT + hh]) + p.in[8][hh];
        const float d = fmaxf(v, 0.f) + __logf(1.0f + __expf(-fabsf(v)));
        dt[idx] = d; da[idx] = __expf(-d * __expf(p.in[9][hh]));
    }
}

__device__ __forceinline__ void ssd_scan_job(const Params& p, int job, LAS unsigned char* lds) {
    const int tid = opq(threadIdx.x);
    const int b = job >> 5, hs = (job >> 1) & 15, half = job & 1, grp = hs >> 3, p0 = half * 32;
    const bf16_t* xbc = (const bf16_t*)(p.ws + WS_XBC) + (size_t)b * SEQ * 1536;
    const float* dtp = (const float*)(p.ws + WS_DT) + (size_t)b * SEQ * 16 + hs;
    const float* dap = (const float*)(p.ws + WS_DA) + (size_t)b * SEQ * 16 + hs;
    float* yraw = (float*)(p.ws + WS_YRAW) + (size_t)b * SEQ * 1024 + hs * 64 + p0;
    const float dskip = p.in[10][hs];
    constexpr int BUF_F = 9280;
    LAS float* L = (LAS float*)lds;
    const bool producer = tid >= 256; const int ptid = tid & 255;
    int grow[5], gcol[5], loff[5];
#pragma unroll
    for (int k = 0; k < 5; ++k) { const int q = ptid + k * 256, row = q / 36, pc = q - row * 36; grow[k] = row;
        if (pc < 4) { gcol[k] = hs * 64 + p0 + pc * 8; loff[k] = row * 32 + pc * 8; }
        else if (pc < 20) { gcol[k] = 1024 + grp * 128 + (pc - 4) * 8; loff[k] = 1024 + row * 128 + (pc - 4) * 8; }
        else { gcol[k] = 1280 + grp * 128 + (pc - 20) * 8; loff[k] = 5120 + row * 128 + (pc - 20) * 8; } }
    uint4 rg[5]; float sc = 0.f;
#define SSD_ISSUE(t0) do { _Pragma("unroll") for (int k = 0; k < 5; ++k) if (ptid + k * 256 < 1152) rg[k] = *(const uint4*)(xbc + (size_t)((t0) + grow[k]) * 1536 + gcol[k]); \
        if (ptid < 32) sc = dtp[((t0) + ptid) * 16]; else if (ptid < 64) sc = dap[((t0) + ptid - 32) * 16]; } while (0)
#define SSD_COMMIT(buf) do { LAS float* Lc = L + (buf) * BUF_F; _Pragma("unroll") for (int k = 0; k < 5; ++k) if (ptid + k * 256 < 1152) { float f[8]; unpack8(rg[k], f); \
            *(LAS f32x4*)(Lc + loff[k]) = (f32x4){f[0], f[1], f[2], f[3]}; *(LAS f32x4*)(Lc + loff[k] + 4) = (f32x4){f[4], f[5], f[6], f[7]}; } \
        if (ptid < 32) Lc[9216 + ptid] = sc; else if (ptid < 64) Lc[9248 + ptid - 32] = sc; } while (0)
#define SSD_FLUSH(chp) do { LAS float* yo = L + 2 * BUF_F + ((chp) & 1) * 1024; const f32x4 v = *(LAS f32x4*)(yo + (ptid >> 3) * 32 + (ptid & 7) * 4); \
        *(f32x4*)(yraw + (size_t)((chp) * 32 + (ptid >> 3)) * 1024 + (ptid & 7) * 4) = v; } while (0)
    f32x2 hA[4], hB[4];
#pragma unroll
    for (int i = 0; i < 4; ++i) { hA[i] = (f32x2){0.f, 0.f}; hB[i] = (f32x2){0.f, 0.f}; }
    const int prow = (tid >> 4) & 15, nseg = tid & 15;
    __syncthreads();
    if (producer) { SSD_ISSUE(0); SSD_COMMIT(0); SSD_ISSUE(32); }
    __syncthreads();
    for (int ch = 0; ch < 64; ++ch) {
        const int cur = ch & 1;
        if (producer) {
            if (ch >= 1) SSD_FLUSH(ch - 1);
            if (ch + 1 < 64) SSD_COMMIT(cur ^ 1);
            if (ch + 2 < 64) SSD_ISSUE((ch + 2) * 32);
        } else {
        LAS float* Lb = L + cur * BUF_F; LAS float* yb = L + 2 * BUF_F + cur * 1024;
        for (int tg = 0; tg < 32; tg += 16) {
            float yA[16], yB[16];
            LAS float* qb = Lb + 1024 + tg * 128 + nseg * 8;
            f32x4 b0 = *(LAS f32x4*)(qb), b1 = *(LAS f32x4*)(qb + 4), c0 = *(LAS f32x4*)(qb + 4096), c1 = *(LAS f32x4*)(qb + 4100);
            float dA = Lb[9248 + tg], xa = Lb[tg * 32 + prow], xb = Lb[tg * 32 + prow + 16], dtv = Lb[9216 + tg];
#pragma unroll
            for (int tt = 0; tt < 16; ++tt) {
                f32x4 nb0, nb1, nc0, nc1; float ndA, nxa, nxb, ndtv;
                if (tt + 1 < 16) { LAS float* q = qb + (tt + 1) * 128; nb0 = *(LAS f32x4*)(q); nb1 = *(LAS f32x4*)(q + 4); nc0 = *(LAS f32x4*)(q + 4096); nc1 = *(LAS f32x4*)(q + 4100);
                    ndA = Lb[9248 + tg + tt + 1]; nxa = Lb[(tg + tt + 1) * 32 + prow]; nxb = Lb[(tg + tt + 1) * 32 + prow + 16]; ndtv = Lb[9216 + tg + tt + 1]; }
                __builtin_amdgcn_sched_barrier(0);
                const float xdta = xa * dtv, xdtb = xb * dtv;
                const f32x2 dA2 = (f32x2){dA, dA}, xa2 = (f32x2){xdta, xdta}, xb2 = (f32x2){xdtb, xdtb};
                hA[0] = hA[0] * dA2 + xa2 * b0.xy; hB[0] = hB[0] * dA2 + xb2 * b0.xy; hA[1] = hA[1] * dA2 + xa2 * b0.zw; hB[1] = hB[1] * dA2 + xb2 * b0.zw;
                hA[2] = hA[2] * dA2 + xa2 * b1.xy; hB[2] = hB[2] * dA2 + xb2 * b1.xy; hA[3] = hA[3] * dA2 + xa2 * b1.zw; hB[3] = hB[3] * dA2 + xb2 * b1.zw;
                f32x2 ya = hA[0] * c0.xy, yb2 = hB[0] * c0.xy; ya = hA[1] * c0.zw + ya; yb2 = hB[1] * c0.zw + yb2; ya = hA[2] * c1.xy + ya; yb2 = hB[2] * c1.xy + yb2; ya = hA[3] * c1.zw + ya; yb2 = hB[3] * c1.zw + yb2;
                float ra = ya.x + ya.y, rb = yb2.x + yb2.y;
                ra = dpp_add<0xB1>(ra); rb = dpp_add<0xB1>(rb); ra = dpp_add<0x4E>(ra); rb = dpp_add<0x4E>(rb); ra = dpp_add<0x141>(ra); rb = dpp_add<0x141>(rb); ra = dpp_add<0x140>(ra); rb = dpp_add<0x140>(rb);
                yA[tt] = ra + dskip * xa; yB[tt] = rb + dskip * xb;
                __builtin_amdgcn_sched_barrier(0);
                if (tt + 1 < 16) { b0 = nb0; b1 = nb1; c0 = nc0; c1 = nc1; dA = ndA; xa = nxa; xb = nxb; dtv = ndtv; }
            }
            if (nseg == 0) {
#pragma unroll
                for (int tt = 0; tt < 16; ++tt) { yb[(tg + tt) * 32 + prow] = yA[tt]; yb[(tg + tt) * 32 + prow + 16] = yB[tt]; } }
        }
        }
        __syncthreads();
    }
    if (producer) SSD_FLUSH(63);
#undef SSD_ISSUE
#undef SSD_COMMIT
#undef SSD_FLUSH
}

__device__ __forceinline__ void ssd_chunk_job(const Params& p, int job, LAS unsigned char* lds) {
    const int tid = opq(threadIdx.x), lane = tid & 63, w = tid >> 6, fr = lane & 15, fq = lane >> 4;
    const int b = job >> 5, hs = (job >> 1) & 15, half = job & 1, grp = hs >> 3, p0 = half * 32;
    const bf16_t* xbc = (const bf16_t*)(p.ws + WS_XBC) + (size_t)b * SEQ * 1536;
    const float* dtp = (const float*)(p.ws + WS_DT) + (size_t)b * SEQ * 16 + hs;
    float* yraw = (float*)(p.ws + WS_YRAW) + (size_t)b * SEQ * 1024 + hs * 64 + p0;
    const float dskip = p.in[10][hs], Ah = -__expf(p.in[9][hs]);
    constexpr int RS = 136;
    LAS bf16_t* Cs = (LAS bf16_t*)lds;
    LAS bf16_t* Bs = (LAS bf16_t*)(lds + 34816);
    LAS bf16_t* BTs = (LAS bf16_t*)(lds + 69632);
    LAS bf16_t* XTa = (LAS bf16_t*)(lds + 104448);
    LAS bf16_t* XTb = (LAS bf16_t*)(lds + 113152);
    LAS bf16_t* Ps = (LAS bf16_t*)(lds + 121856);
    LAS float* af = (LAS float*)(lds + 130560);
    LAS float* dtf = (LAS float*)(lds + 131584);
    const int crow0 = tid >> 4, cpc = tid & 15;
    const int xk = tid >> 2, xpc = tid & 3;
    u32x4 rc[4], rb[4], rx; float rdt = 0.f;
#define SC_ISSUE(t0) do { _Pragma("unroll") for (int i = 0; i < 4; ++i) { const bf16_t* rp_ = xbc + (size_t)((t0) + (crow0 + 32 * i)) * 1536 + grp * 128 + cpc * 8; rb[i] = *(const u32x4*)(rp_ + 1024); rc[i] = *(const u32x4*)(rp_ + 1280); } \
        rx = *(const u32x4*)(xbc + (size_t)((t0) + xk) * 1536 + hs * 64 + p0 + xpc * 8); if (tid < 128) rdt = dtp[((t0) + tid) * 16]; } while (0)
    f32x4 st[2];
    st[0] = (f32x4){0.f, 0.f, 0.f, 0.f}; st[1] = st[0];
    __syncthreads();
    for (int i = tid; i < 32 * RS / 2; i += 512) ((LAS unsigned*)Ps)[i] = 0u;
    SC_ISSUE(0);
    for (int ch = 0; ch < 16; ++ch) {
        const int t0 = ch * 128;
        __syncthreads();
#pragma unroll
        for (int i = 0; i < 4; ++i) { *(LAS u32x4*)(Cs + (crow0 + 32 * i) * RS + cpc * 8) = rc[i]; *(LAS u32x4*)(Bs + (crow0 + 32 * i) * RS + cpc * 8) = rb[i];

#pragma unroll
            for (int e = 0; e < 4; ++e) { BTs[(cpc * 8 + 2 * e) * RS + (crow0 + 32 * i)] = (bf16_t)(rb[i][e] & 0xffffu); BTs[(cpc * 8 + 2 * e + 1) * RS + (crow0 + 32 * i)] = (bf16_t)(rb[i][e] >> 16); } }
        float csv = 0.f;
        if (tid < 128) {
            csv = rdt * Ah; dtf[tid] = rdt;
#pragma unroll
            for (int off = 1; off < 64; off <<= 1) { const float t_ = __shfl_up(csv, off); if (lane >= off) csv += t_; }
            if (tid == 63) af[128] = csv;
        }
        float xr[8]; xr[0] = bflo(rx[0]); xr[1] = bfhi(rx[0]); xr[2] = bflo(rx[1]); xr[3] = bfhi(rx[1]); xr[4] = bflo(rx[2]); xr[5] = bfhi(rx[2]); xr[6] = bflo(rx[3]); xr[7] = bfhi(rx[3]);
        __syncthreads();
        if (tid < 128) af[tid] = (tid >= 64) ? csv + af[128] : csv;
        __syncthreads();
        const float cs_last = af[127];
        { const float d = dtf[xk], dout = __expf(cs_last - af[xk]);
#pragma unroll
          for (int e = 0; e < 8; ++e) { const float xa = xr[e] * d; XTa[(xpc * 8 + e) * RS + xk] = f2bf(xa); XTb[(xpc * 8 + e) * RS + xk] = f2bf(xa * dout); } }
        __syncthreads();
        bf16x8 cf[4];
#pragma unroll
        for (int ks = 0; ks < 4; ++ks) cf[ks] = *(LAS bf16x8*)(Cs + (w * 16 + fr) * RS + ks * 32 + fq * 8);
        f32x4 yo[2];
#pragma unroll
        for (int pt = 0; pt < 2; ++pt) { f32x4 acc = (f32x4){0.f, 0.f, 0.f, 0.f};
#pragma unroll
            for (int ks = 0; ks < 4; ++ks) { const bf16x8 pb = *(LAS bf16x8*)(Ps + (pt * 16 + fr) * RS + ks * 32 + fq * 8); acc = __builtin_amdgcn_mfma_f32_16x16x32_bf16(cf[ks], pb, acc, 0, 0, 0); }
            yo[pt] = acc; }
        float csq[4];
#pragma unroll
        for (int i = 0; i < 4; ++i) csq[i] = af[w * 16 + fq * 4 + i];
#pragma unroll
        for (int kt = 0; kt < 8; ++kt) { f32x4 acc = (f32x4){0.f, 0.f, 0.f, 0.f};
            if (kt > w) {
#pragma unroll
                for (int i = 0; i < 4; ++i) Cs[(w * 16 + fq * 4 + i) * RS + kt * 16 + fr] = (bf16_t)0;
                continue; }
#pragma unroll
            for (int ks = 0; ks < 4; ++ks) { const bf16x8 bb = *(LAS bf16x8*)(Bs + (kt * 16 + fr) * RS + ks * 32 + fq * 8); acc = __builtin_amdgcn_mfma_f32_16x16x32_bf16(cf[ks], bb, acc, 0, 0, 0); }
            const int kk = kt * 16 + fr; const float csk = af[kk];
#pragma unroll
            for (int i = 0; i < 4; ++i) { const int qq = w * 16 + fq * 4 + i; const float m = (kk <= qq) ? acc[i] * __expf(csq[i] - csk) : 0.f; Cs[qq * RS + kk] = f2bf(m); } }
        f32x4 yd[2];
        { bf16x8 mf[4];
#pragma unroll
          for (int ks = 0; ks < 4; ++ks) mf[ks] = *(LAS bf16x8*)(Cs + (w * 16 + fr) * RS + ks * 32 + fq * 8);
#pragma unroll
          for (int pt = 0; pt < 2; ++pt) { f32x4 acc = (f32x4){0.f, 0.f, 0.f, 0.f};
#pragma unroll
              for (int ks = 0; ks < 4; ++ks) { const bf16x8 xb = *(LAS bf16x8*)(XTa + (pt * 16 + fr) * RS + ks * 32 + fq * 8); acc = __builtin_amdgcn_mfma_f32_16x16x32_bf16(mf[ks], xb, acc, 0, 0, 0); }
              yd[pt] = acc; } }
        if (ch + 1 < 16) SC_ISSUE(t0 + 128);
#pragma unroll
        for (int pt = 0; pt < 2; ++pt)
#pragma unroll
            for (int i = 0; i < 4; ++i) { const int qq = w * 16 + fq * 4 + i, pp = pt * 16 + fr;
                const float xv = bf2f(xbc[(size_t)(t0 + qq) * 1536 + hs * 64 + p0 + pp]);
                yraw[(size_t)(t0 + qq) * 1024 + pp] = yd[pt][i] + __expf(csq[i]) * yo[pt][i] + dskip * xv; }
        __syncthreads();
        { const float cd = __expf(cs_last);
#pragma unroll
          for (int pt = 0; pt < 2; ++pt) { f32x4 acc = st[pt] * cd;
#pragma unroll
              for (int ks = 0; ks < 4; ++ks) { const bf16x8 xa = *(LAS bf16x8*)(XTb + (pt * 16 + fr) * RS + ks * 32 + fq * 8); const bf16x8 bt = *(LAS bf16x8*)(BTs + (w * 16 + fr) * RS + ks * 32 + fq * 8);
                  acc = __builtin_amdgcn_mfma_f32_16x16x32_bf16(xa, bt, acc, 0, 0, 0); }
              st[pt] = acc;
#pragma unroll
              for (int i = 0; i < 4; ++i) Ps[(pt * 16 + fq * 4 + i) * RS + w * 16 + fr] = f2bf(acc[i]); } }
    }
#undef SC_ISSUE
}

__device__ __forceinline__ void attn_job(const Params& p, int job, LAS unsigned char* lds) {
    const int tid = opq(threadIdx.x), lane = tid & 63, w = tid >> 6, fr = lane & 15, fq = lane >> 4;
    const int b = job >> 6, kvh = (job >> 4) & 3, nb = job & 15;
    const bf16_t* proj = (const bf16_t*)(p.ws + WS_PROJ) + (size_t)b * SEQ * INWP;
    const float2* rope = (const float2*)(p.ws + WS_ROPE);
    LAS bf16_t* Ks = (LAS bf16_t*)lds;
    LAS bf16_t* Vt = (LAS bf16_t*)(lds + 36864);
    LAS bf16_t* Ps = (LAS bf16_t*)(lds + 70656) + w * 16 * 264;
    __syncthreads();
    if (tid < 256) {
        const int kr = tid, tk = (nb - 1) * 128 + kr;
        if (tk >= 0) {
            const bf16_t* src = proj + (size_t)tk * INWP + COL_K + kvh * 64; float x[64]; float ss = 0.f;
#pragma unroll
            for (int c = 0; c < 8; ++c) { const uint4 r = *(const uint4*)(src + c * 8); float f[8]; unpack8(r, f);
#pragma unroll
                for (int e = 0; e < 8; ++e) { x[c * 8 + e] = f[e]; ss += f[e] * f[e]; } }
            const float rinv = rsqrtf(ss * (1.0f / 64) + 1e-6f); const float* kn = p.in[13];
#pragma unroll
            for (int i = 0; i < 64; ++i) x[i] = x[i] * rinv * kn[i];
#pragma unroll
            for (int c = 0; c < 4; ++c) { float o1[8], o2[8];
#pragma unroll
                for (int e = 0; e < 8; ++e) { const int i = c * 8 + e; const float2 cs = rope[tk * 32 + i]; o1[e] = x[i] * cs.x - x[i + 32] * cs.y; o2[e] = x[i + 32] * cs.x + x[i] * cs.y; }
                u32x4 w1, w2; w1.x = cvt_pk_bf16(o1[0], o1[1]); w1.y = cvt_pk_bf16(o1[2], o1[3]); w1.z = cvt_pk_bf16(o1[4], o1[5]); w1.w = cvt_pk_bf16(o1[6], o1[7]);
                w2.x = cvt_pk_bf16(o2[0], o2[1]); w2.y = cvt_pk_bf16(o2[2], o2[3]); w2.z = cvt_pk_bf16(o2[4], o2[5]); w2.w = cvt_pk_bf16(o2[6], o2[7]);
                *(LAS u32x4*)(Ks + kr * 72 + c * 8) = w1; *(LAS u32x4*)(Ks + kr * 72 + 32 + c * 8) = w2;
                __builtin_amdgcn_sched_barrier(0); }
        } else {
#pragma unroll
            for (int c = 0; c < 8; ++c) *(LAS u32x4*)(Ks + kr * 72 + c * 8) = (u32x4){0u, 0u, 0u, 0u};
        }
    } else {
        const int kr = tid - 256, tk = (nb - 1) * 128 + kr;
        const bf16_t* src = proj + (size_t)(tk < 0 ? 0 : tk) * INWP + COL_V + kvh * 64;
#pragma unroll
        for (int c = 0; c < 8; ++c) { uint4 r = *(const uint4*)(src + c * 8); if (tk < 0) r = make_uint4(0u, 0u, 0u, 0u);
            Vt[(c * 8 + 0) * 264 + kr] = (bf16_t)(r.x & 0xffffu); Vt[(c * 8 + 1) * 264 + kr] = (bf16_t)(r.x >> 16);
            Vt[(c * 8 + 2) * 264 + kr] = (bf16_t)(r.y & 0xffffu); Vt[(c * 8 + 3) * 264 + kr] = (bf16_t)(r.y >> 16);
            Vt[(c * 8 + 4) * 264 + kr] = (bf16_t)(r.z & 0xffffu); Vt[(c * 8 + 5) * 264 + kr] = (bf16_t)(r.z >> 16);
            Vt[(c * 8 + 6) * 264 + kr] = (bf16_t)(r.w & 0xffffu); Vt[(c * 8 + 7) * 264 + kr] = (bf16_t)(r.w >> 16); }
    }
    __syncthreads();
    const int tq = nb * 128 + w * 16 + fr;
    f32x4 csr[4]; f32x4 qn1[2], qn2[2];
#pragma unroll
    for (int e = 0; e < 4; ++e) csr[e] = *(const f32x4*)(rope + tq * 32 + fq * 8 + 2 * e);
    qn1[0] = *(const f32x4*)(p.in[12] + fq * 8); qn1[1] = *(const f32x4*)(p.in[12] + fq * 8 + 4); qn2[0] = *(const f32x4*)(p.in[12] + 32 + fq * 8); qn2[1] = *(const f32x4*)(p.in[12] + 32 + fq * 8 + 4);
    uint4 r0 = *(const uint4*)(proj + (size_t)tq * INWP + (kvh * 4) * 64 + fq * 8), r1 = *(const uint4*)(proj + (size_t)tq * INWP + (kvh * 4) * 64 + 32 + fq * 8);
    for (int h4 = 0; h4 < 4; ++h4) {
    const int hq = kvh * 4 + h4;
    bf16x8 qa[2];
    uint4 r0n = r0, r1n = r1;
    if (h4 + 1 < 4) { const bf16_t* srcn = proj + (size_t)tq * INWP + (hq + 1) * 64; r0n = *(const uint4*)(srcn + fq * 8); r1n = *(const uint4*)(srcn + 32 + fq * 8); }
    { float x1[8], x2[8]; unpack8(r0, x1); unpack8(r1, x2);
      float ss = 0.f;
#pragma unroll
      for (int e = 0; e < 8; ++e) ss += x1[e] * x1[e] + x2[e] * x2[e];
      ss += __shfl_xor(ss, 16); ss += __shfl_xor(ss, 32);
      const float rinv = rsqrtf(ss * (1.0f / 64) + 1e-6f) * 0.125f; float o1[8], o2[8];
#pragma unroll
      for (int e = 0; e < 8; ++e) { const float a = x1[e] * rinv * qn1[e >> 2][e & 3], c = x2[e] * rinv * qn2[e >> 2][e & 3]; const float cx = csr[e >> 1][(e & 1) * 2], sy = csr[e >> 1][(e & 1) * 2 + 1];
          o1[e] = a * cx - c * sy; o2[e] = c * cx + a * sy; }
      u32x4 w1, w2; w1.x = cvt_pk_bf16(o1[0], o1[1]); w1.y = cvt_pk_bf16(o1[2], o1[3]); w1.z = cvt_pk_bf16(o1[4], o1[5]); w1.w = cvt_pk_bf16(o1[6], o1[7]);
      w2.x = cvt_pk_bf16(o2[0], o2[1]); w2.y = cvt_pk_bf16(o2[2], o2[3]); w2.z = cvt_pk_bf16(o2[4], o2[5]); w2.w = cvt_pk_bf16(o2[6], o2[7]);
      qa[0] = __builtin_bit_cast(bf16x8, w1); qa[1] = __builtin_bit_cast(bf16x8, w2); }
    r0 = r0n; r1 = r1n;
    f32x4 s[16];
#pragma unroll
    for (int j = 0; j < 16; ++j) { f32x4 acc = (f32x4){0.f, 0.f, 0.f, 0.f};
#pragma unroll
        for (int ks = 0; ks < 2; ++ks) { const bf16x8 kb = *(LAS bf16x8*)(Ks + (j * 16 + fr) * 72 + ks * 32 + fq * 8); acc = __builtin_amdgcn_mfma_f32_16x16x32_bf16(qa[ks], kb, acc, 0, 0, 0); }
        s[j] = acc; }
    const float sink = p.in[14][hq];
    float mx[4], inv[4];
#pragma unroll
    for (int i = 0; i < 4; ++i) { const int qi = w * 16 + fq * 4 + i + 128; float m = -3.0e38f;
#pragma unroll
        for (int j = 0; j < 16; ++j) { const int kj = j * 16 + fr; const bool ok = (kj <= qi) && (qi - kj < 128) && (nb > 0 || kj >= 128); s[j][i] = ok ? s[j][i] : -3.0e38f; m = fmaxf(m, s[j][i]); }
        m = max16(m);
        m = fmaxf(m, sink); mx[i] = m; float l = 0.f;
#pragma unroll
        for (int j = 0; j < 16; ++j) { const float e = (s[j][i] > -1.0e38f) ? __expf(s[j][i] - m) : 0.f; s[j][i] = e; l += e; }
        l = red16(l);
        inv[i] = 1.0f / (l + __expf(sink - m)); }
#pragma unroll
    for (int j = 0; j < 16; ++j)
#pragma unroll
        for (int i = 0; i < 4; ++i) Ps[(fq * 4 + i) * 264 + j * 16 + fr] = f2bf(s[j][i] * inv[i]);
    f32x4 o[4];
#pragma unroll
    for (int nd = 0; nd < 4; ++nd) o[nd] = (f32x4){0.f, 0.f, 0.f, 0.f};
#pragma unroll
    for (int kk = 0; kk < 8; ++kk) { const bf16x8 pa = *(LAS bf16x8*)(Ps + fr * 264 + kk * 32 + fq * 8);
#pragma unroll
        for (int nd = 0; nd < 4; ++nd) { const bf16x8 vb = *(LAS bf16x8*)(Vt + (nd * 16 + fr) * 264 + kk * 32 + fq * 8); o[nd] = __builtin_amdgcn_mfma_f32_16x16x32_bf16(pa, vb, o[nd], 0, 0, 0); } }
    bf16_t* ymix = (bf16_t*)(p.ws + WS_YMIX) + (size_t)b * SEQ * D + hq * 64;
#pragma unroll
    for (int nd = 0; nd < 4; ++nd)
#pragma unroll
        for (int i = 0; i < 4; ++i) ymix[(size_t)(nb * 128 + w * 16 + fq * 4 + i) * D + nd * 16 + fr] = f2bf(o[nd][i]);
    }
}

__device__ __forceinline__ void post_ssd(const Params& p) {
    const int tid_ = opq(threadIdx.x); const int lane = tid_ & 63, wv = tid_ >> 6;
    const float* yraw = (const float*)(p.ws + WS_YRAW); const bf16_t* proj = (const bf16_t*)(p.ws + WS_PROJ); bf16_t* ymix = (bf16_t*)(p.ws + WS_YMIX);
    for (int it = blockIdx.x * 8 + wv; it < MTOK * 2; it += gridDim.x * 8) {
        const int tok = it >> 1, grp = it & 1, c = grp * 512 + lane * 8;
        const f32x4 y0 = *(const f32x4*)(yraw + (size_t)tok * 1024 + c), y1 = *(const f32x4*)(yraw + (size_t)tok * 1024 + c + 4);
        const uint4 zr = *(const uint4*)(proj + (size_t)tok * INWP + COL_Z + c); float z[8], y[8]; unpack8(zr, z); float ss = 0.f;
#pragma unroll
        for (int e = 0; e < 8; ++e) { const float yy = (e < 4 ? y0[e] : y1[e - 4]); y[e] = yy * z[e] * sigmoidf_(z[e]); ss += y[e] * y[e]; }
        ss = wave_sum(ss); const float r = rsqrtf(ss * (1.0f / 512) + 1e-6f);
        const f32x4 n0 = *(const f32x4*)(p.in[11] + c), n1 = *(const f32x4*)(p.in[11] + c + 4);
        u32x4 w; w.x = cvt_pk_nv(y[0] * r * n0[0], y[1] * r * n0[1]); w.y = cvt_pk_nv(y[2] * r * n0[2], y[3] * r * n0[3]);
        w.z = cvt_pk_nv(y[4] * r * n1[0], y[5] * r * n1[1]); w.w = cvt_pk_nv(y[6] * r * n1[2], y[7] * r * n1[3]);
        *(u32x4*)(ymix + (size_t)tok * D + 1024 + c) = w;
    }
}

__device__ __forceinline__ float half_sum(float v, bool lo) {
    (void)lo; v = red16(v); return v + __shfl_xor(v, 16); }
__device__ __forceinline__ void rwkv_scan_job(const Params& p, int job, LAS unsigned char* lds) {
    const int tid = opq(threadIdx.x), lane = tid & 63, l32 = lane & 31; const bool lo = lane < 32;
    const int b = job >> 5, hh = job & 31;
    LAS float* L = (LAS float*)lds;
    const bool producer = tid >= 256;
    const int pw = (tid >> 6) & 3;
    const int tl0 = 2 * pw + (lane >> 5);
    const size_t wbase = ((size_t)b * SEQ * D + hh * 64) / 2 + l32 + (size_t)tl0 * (D / 2);
    const unsigned* R32 = (const unsigned*)(p.ws + WS_R) + wbase; const unsigned* K32 = (const unsigned*)(p.ws + WS_K) + wbase; const unsigned* V32 = (const unsigned*)(p.ws + WS_V) + wbase;
    const unsigned* E32 = (const unsigned*)(p.ws + WS_WDEC) + wbase; const unsigned* A32 = (const unsigned*)(p.ws + WS_AA) + wbase; const unsigned* G32 = (const unsigned*)(p.ws + WS_GG) + wbase;
    unsigned* Y32 = (unsigned*)(p.ws + WS_YG) + wbase;
    const int ci = hh * 64 + 2 * l32;
    const float2 kkw = *(const float2*)(p.in[25] + ci), kaw = *(const float2*)(p.in[26] + ci), rkw = *(const float2*)(p.in[27] + ci), lnw = *(const float2*)(p.in[32] + ci), lnb = *(const float2*)(p.in[33] + ci);
    unsigned rw[2], kw[2], vw[2], ew[2], aw[2], gw[2];
    const int oo = tl0 * 64 + 2 * l32;
#define RW_ISSUE(t0) do { _Pragma("unroll") for (int i2 = 0; i2 < 2; ++i2) { const size_t off = (size_t)((t0) + 8 * i2) * (D / 2); rw[i2] = R32[off]; kw[i2] = K32[off]; vw[i2] = V32[off]; ew[i2] = E32[off]; aw[i2] = A32[off]; gw[i2] = G32[off]; } } while (0)
#define RW_COMMIT(buf) do { _Pragma("unroll") for (int i2 = 0; i2 < 2; ++i2) { LAS float* Lc = L + (buf) * 8192 + oo + i2 * 512; \
        const float r0_ = bflo(rw[i2]), r1_ = bfhi(rw[i2]), k0_ = bflo(kw[i2]), k1_ = bfhi(kw[i2]), v0_ = bflo(vw[i2]), v1_ = bfhi(vw[i2]), e0_ = bflo(ew[i2]), e1_ = bfhi(ew[i2]), a0_ = bflo(aw[i2]), a1_ = bfhi(aw[i2]), g0_ = bflo(gw[i2]), g1_ = bfhi(gw[i2]); \
        const float kkv0 = k0_ * kkw.x, kkv1 = k1_ * kkw.y; const float ssq = half_sum(kkv0 * kkv0 + kkv1 * kkv1, lo); const float rn = rsqrtf(fmaxf(ssq, 1e-24f)); const float kn0 = kkv0 * rn, kn1 = kkv1 * rn; \
        const float km0 = k0_ * (1.0f + (a0_ - 1.0f) * kaw.x), km1 = k1_ * (1.0f + (a1_ - 1.0f) * kaw.y); const float bonus = half_sum(r0_ * km0 * rkw.x + r1_ * km1 * rkw.y, lo); \
        *(LAS f32x2*)(Lc) = (f32x2){-kn0, -kn1}; *(LAS f32x2*)(Lc + 1024) = (f32x2){__expf(-e0_), __expf(-e1_)}; *(LAS f32x2*)(Lc + 2048) = (f32x2){kn0 * a0_, kn1 * a1_}; *(LAS f32x2*)(Lc + 3072) = (f32x2){km0, km1}; \
        *(LAS f32x2*)(Lc + 4096) = (f32x2){r0_, r1_}; *(LAS f32x2*)(Lc + 5120) = (f32x2){v0_, v1_}; *(LAS f32x2*)(Lc + 6144) = (f32x2){g0_, g1_}; *(LAS f32x2*)(Lc + 7168) = (f32x2){bonus * v0_, bonus * v1_}; } } while (0)
#define RW_OUTPUT(chp) do { LAS float* Lo = L + ((chp) & 1) * 8192; LAS float* yo = L + 16384 + ((chp) & 1) * 1024; _Pragma("unroll") for (int i2 = 0; i2 < 2; ++i2) { const int o2 = oo + i2 * 512; \
        const f32x2 y = *(LAS f32x2*)(yo + o2); \
        const float mu = half_sum(y.x + y.y, lo) * (1.0f / 64), d0 = y.x - mu, d1 = y.y - mu, var = half_sum(d0 * d0 + d1 * d1, lo) * (1.0f / 64), rs = rsqrtf(var + 64e-5f); \
        const f32x2 bv = *(LAS f32x2*)(Lo + 7168 + o2), gg = *(LAS f32x2*)(Lo + 6144 + o2); \
        Y32[(size_t)((chp) * 16 + 8 * i2) * (D / 2)] = cvt_pk_nv((d0 * rs * lnw.x + lnb.x + bv.x) * gg.x, (d1 * rs * lnw.y + lnb.y + bv.y) * gg.y); } } while (0)
    f32x2 SA[4], SB[4];
#pragma unroll
    for (int i = 0; i < 4; ++i) { SA[i] = (f32x2){0.f, 0.f}; SB[i] = (f32x2){0.f, 0.f}; }
    const int rp = (tid >> 3) & 31, ks = tid & 7;
    __syncthreads();
    if (producer) { RW_ISSUE(0); RW_COMMIT(0); RW_ISSUE(16); }
    __syncthreads();
    for (int ch = 0; ch < 128; ++ch) {
        const int cur = ch & 1;
        if (producer) {
            if (ch >= 1) RW_OUTPUT(ch - 1);
            if (ch + 1 < 128) RW_COMMIT(cur ^ 1);
            if (ch + 2 < 128) RW_ISSUE((ch + 2) * 16);
        } else {
            LAS float* Lb = L + cur * 8192; LAS float* yb = L + 16384 + cur * 1024;
            float yA[16], yB[16];
            LAS float* q0 = Lb + ks * 8;
            f32x4 a0 = *(LAS f32x4*)(q0), a1 = *(LAS f32x4*)(q0 + 4), w0 = *(LAS f32x4*)(q0 + 1024), w1 = *(LAS f32x4*)(q0 + 1028), b0 = *(LAS f32x4*)(q0 + 2048), b1 = *(LAS f32x4*)(q0 + 2052);
            f32x4 k0 = *(LAS f32x4*)(q0 + 3072), k1 = *(LAS f32x4*)(q0 + 3076), r0 = *(LAS f32x4*)(q0 + 4096), r1 = *(LAS f32x4*)(q0 + 4100);
            float va = Lb[5120 + rp], vb = Lb[5120 + rp + 32];
#pragma unroll
            for (int t = 0; t < 16; ++t) {
                f32x4 na0, na1, nw0, nw1, nb0, nb1, nk0, nk1, nr0, nr1; float nva, nvb;
                if (t + 1 < 16) { LAS float* q = q0 + (t + 1) * 64;
                    na0 = *(LAS f32x4*)(q); na1 = *(LAS f32x4*)(q + 4); nw0 = *(LAS f32x4*)(q + 1024); nw1 = *(LAS f32x4*)(q + 1028); nb0 = *(LAS f32x4*)(q + 2048); nb1 = *(LAS f32x4*)(q + 2052);
                    nk0 = *(LAS f32x4*)(q + 3072); nk1 = *(LAS f32x4*)(q + 3076); nr0 = *(LAS f32x4*)(q + 4096); nr1 = *(LAS f32x4*)(q + 4100); nva = Lb[5120 + (t + 1) * 64 + rp]; nvb = Lb[5120 + (t + 1) * 64 + rp + 32]; }
                __builtin_amdgcn_sched_barrier(0);
                f32x2 ca = SA[0] * a0.xy, cb = SB[0] * a0.xy; ca = SA[1] * a0.zw + ca; cb = SB[1] * a0.zw + cb; ca = SA[2] * a1.xy + ca; cb = SB[2] * a1.xy + cb; ca = SA[3] * a1.zw + ca; cb = SB[3] * a1.zw + cb;
                float sa = ca.x + ca.y, sb = cb.x + cb.y;
                sa = dpp_add<0xB1>(sa); sb = dpp_add<0xB1>(sb); sa = dpp_add<0x4E>(sa); sb = dpp_add<0x4E>(sb); sa = dpp_add<0x141>(sa); sb = dpp_add<0x141>(sb);
                const f32x2 sa2 = (f32x2){sa, sa}, sb2 = (f32x2){sb, sb}, va2 = (f32x2){va, va}, vb2 = (f32x2){vb, vb};
                SA[0] = SA[0] * w0.xy + (sa2 * b0.xy + va2 * k0.xy); SB[0] = SB[0] * w0.xy + (sb2 * b0.xy + vb2 * k0.xy);
                SA[1] = SA[1] * w0.zw + (sa2 * b0.zw + va2 * k0.zw); SB[1] = SB[1] * w0.zw + (sb2 * b0.zw + vb2 * k0.zw);
                SA[2] = SA[2] * w1.xy + (sa2 * b1.xy + va2 * k1.xy); SB[2] = SB[2] * w1.xy + (sb2 * b1.xy + vb2 * k1.xy);
                SA[3] = SA[3] * w1.zw + (sa2 * b1.zw + va2 * k1.zw); SB[3] = SB[3] * w1.zw + (sb2 * b1.zw + vb2 * k1.zw);
                f32x2 ya = SA[0] * r0.xy, yb2 = SB[0] * r0.xy; ya = SA[1] * r0.zw + ya; yb2 = SB[1] * r0.zw + yb2; ya = SA[2] * r1.xy + ya; yb2 = SB[2] * r1.xy + yb2; ya = SA[3] * r1.zw + ya; yb2 = SB[3] * r1.zw + yb2;
                float ra = ya.x + ya.y, rb = yb2.x + yb2.y;
                ra = dpp_add<0xB1>(ra); rb = dpp_add<0xB1>(rb); ra = dpp_add<0x4E>(ra); rb = dpp_add<0x4E>(rb); ra = dpp_add<0x141>(ra); rb = dpp_add<0x141>(rb);
                yA[t] = ra; yB[t] = rb;
                __builtin_amdgcn_sched_barrier(0);
                if (t + 1 < 16) { a0 = na0; a1 = na1; w0 = nw0; w1 = nw1; b0 = nb0; b1 = nb1; k0 = nk0; k1 = nk1; r0 = nr0; r1 = nr1; va = nva; vb = nvb; }
            }
            if (ks == 0) {
#pragma unroll
                for (int t = 0; t < 16; ++t) { yb[t * 64 + rp] = yA[t]; yb[t * 64 + rp + 32] = yB[t]; } }
        }
        __syncthreads();
    }
    if (producer) RW_OUTPUT(127);
#undef RW_ISSUE
#undef RW_COMMIT
#undef RW_OUTPUT
}

__device__ __forceinline__ void rwkv_chunk_job(const Params& p, int job, LAS unsigned char* lds) {
    const int tid = opq(threadIdx.x), lane = tid & 63, w = tid >> 6, fr = lane & 15, fq = lane >> 4, l16 = lane & 15;
    const int b = job >> 5, hh = job & 31;
    const int tl = 4 * (w & 3) + (lane >> 4);
    const size_t wbase = ((size_t)b * SEQ * D + hh * 64) / 4 + l16 + (size_t)tl * (D / 4);
    const uint2* R64 = (const uint2*)(p.ws + WS_R) + wbase; const uint2* K64 = (const uint2*)(p.ws + WS_K) + wbase; const uint2* V64 = (const uint2*)(p.ws + WS_V) + wbase;
    const uint2* E64 = (const uint2*)(p.ws + WS_WDEC) + wbase; const uint2* A64 = (const uint2*)(p.ws + WS_AA) + wbase; const uint2* G64 = (const uint2*)(p.ws + WS_GG) + wbase;
    uint2* Y64 = (uint2*)(p.ws + WS_YG) + wbase;
    const int ci = hh * 64 + 4 * l16;
    const f32x4 kkw = *(const f32x4*)(p.in[25] + ci), kaw = *(const f32x4*)(p.in[26] + ci), rkw = *(const f32x4*)(p.in[27] + ci), lnw = *(const f32x4*)(p.in[32] + ci), lnb = *(const f32x4*)(p.in[33] + ci);
    LAS float* Av = (LAS float*)(lds + 0);
    LAS float* Bv = (LAS float*)(lds + 4096);
    LAS float* Km = (LAS float*)(lds + 8192);
    LAS float* Rr = (LAS float*)(lds + 12288);
    LAS float* ybuf = (LAS float*)(lds + 16384);
    LAS float* RHS = (LAS float*)(lds + 20480);
    LAS float* Aab = (LAS float*)(lds + 24832);
    LAS float* Wend = (LAS float*)(lds + 25856);
    LAS bf16_t* ET = (LAS bf16_t*)(lds + 26112);
    LAS bf16_t* VT = (LAS bf16_t*)(lds + 31232);
    LAS bf16_t* BtT = (LAS bf16_t*)(lds + 36352);
    LAS bf16_t* KtT = (LAS bf16_t*)(lds + 41472);
    LAS bf16_t* Ub = (LAS bf16_t*)(lds + 46592);
    LAS bf16_t* AakT = (LAS bf16_t*)(lds + 51712);
    LAS bf16_t* AbrT = (LAS bf16_t*)(lds + 52992);
    LAS bf16_t* AkrT = (LAS bf16_t*)(lds + 54272);
    LAS bf16_t* At = (LAS bf16_t*)(lds + 55552);
    LAS bf16_t* Bt = (LAS bf16_t*)(lds + 57856);
    LAS bf16_t* Kt = (LAS bf16_t*)(lds + 60160);
    LAS bf16_t* Rt = (LAS bf16_t*)(lds + 62464);
    LAS bf16_t* S0b = (LAS bf16_t*)(lds + 64768);
    LAS bf16_t* VT1 = (LAS bf16_t*)(lds + 73984);
    constexpr int LDS_END = 73984 + 64 * 40 * 2;
    __syncthreads();
    for (int i = tid; i < LDS_END / 4; i += 512) ((LAS unsigned*)lds)[i] = 0u;
    f32x4 stt[2]; stt[0] = (f32x4){0.f, 0.f, 0.f, 0.f}; stt[1] = stt[0];
    const int vt = w >> 1, kt0 = (w & 1) * 2;
    bf16x8 Lf;
#pragma unroll
    for (int e = 0; e < 8; ++e) { const int i = fq * 8 + e; Lf[e] = (i <= fr && i < 16) ? (short)0x3F80 : (short)0; }
    uint2 rw, kw, vw, ew, aw, gw;
#define RC_ISSUE(t0) do { const size_t off = (size_t)(t0) * (D / 4); rw = R64[off]; kw = K64[off]; vw = V64[off]; ew = E64[off]; aw = A64[off]; gw = G64[off]; } while (0)
#define RC_PREP(chn) do { \
        const f32x4 r_ = (f32x4){bflo(rw.x), bfhi(rw.x), bflo(rw.y), bfhi(rw.y)}, k_ = (f32x4){bflo(kw.x), bfhi(kw.x), bflo(kw.y), bfhi(kw.y)}, v_ = (f32x4){bflo(vw.x), bfhi(vw.x), bflo(vw.y), bfhi(vw.y)}; \
        const f32x4 a_ = (f32x4){bflo(aw.x), bfhi(aw.x), bflo(aw.y), bfhi(aw.y)}; gn = (f32x4){bflo(gw.x), bfhi(gw.x), bflo(gw.y), bfhi(gw.y)}; \
        const uint2 ewc = ew, vwc = vw; \
        RC_ISSUE((((chn) + 1 < 128) ? (chn) + 1 : 127) * 16);     \
        const f32x4 kkv = k_ * kkw; const float ssq = red16(kkv[0] * kkv[0] + kkv[1] * kkv[1] + kkv[2] * kkv[2] + kkv[3] * kkv[3]); const float rn = rsqrtf(fmaxf(ssq, 1e-24f)); const f32x4 kn = kkv * rn; \
        const f32x4 km = k_ * ((a_ - 1.0f) * kaw + 1.0f); const f32x4 rk_ = r_ * km * rkw; const float bonus = red16(rk_[0] + rk_[1] + rk_[2] + rk_[3]); \
        bn = v_ * bonus; \
        { const int o = tl * 64 + 4 * l16; LAS bf16_t* VTw = ((chn) & 1) ? VT1 : VT; \
          pa = -kn; pb = kn * a_; pk = km; pr = r_; pe = ewc; (void)o; \
          ET[(4 * l16) * 40 + tl] = (bf16_t)(ewc.x & 0xffffu); ET[(4 * l16 + 1) * 40 + tl] = (bf16_t)(ewc.x >> 16); ET[(4 * l16 + 2) * 40 + tl] = (bf16_t)(ewc.y & 0xffffu); ET[(4 * l16 + 3) * 40 + tl] = (bf16_t)(ewc.y >> 16); \
          VTw[(4 * l16) * 40 + tl] = (bf16_t)(vwc.x & 0xffffu); VTw[(4 * l16 + 1) * 40 + tl] = (bf16_t)(vwc.x >> 16); VTw[(4 * l16 + 2) * 40 + tl] = (bf16_t)(vwc.y & 0xffffu); VTw[(4 * l16 + 3) * 40 + tl] = (bf16_t)(vwc.y >> 16); } } while (0)
    f32x4 gc = (f32x4){0.f, 0.f, 0.f, 0.f}, bc = gc, gn = gc, bn = gc;
    f32x4 pa = gc, pb = gc, pk = gc, pr = gc; uint2 pe = make_uint2(0u, 0u);
    LAS float* Ecum = Av;
#define RC_P1A() do { const bf16x8 eb = *(LAS bf16x8*)(ET + (w * 16 + fr) * 40 + fq * 8); f32x4 ec = (f32x4){0.f, 0.f, 0.f, 0.f}; ec = __builtin_amdgcn_mfma_f32_16x16x32_bf16(Lf, eb, ec, 0, 0, 0); \
        _Pragma("unroll") for (int i = 0; i < 4; ++i) Ecum[(fq * 4 + i) * 64 + w * 16 + fr] = ec[i]; } while (0)
#define RC_P1B() do { const f32x4 E = *(LAS f32x4*)(Ecum + tl * 64 + 4 * l16); const f32x4 et = (f32x4){bflo(pe.x), bfhi(pe.x), bflo(pe.y), bfhi(pe.y)}; \
        f32x4 Wt, Wp, iW; _Pragma("unroll") for (int e = 0; e < 4; ++e) { Wt[e] = __expf(-E[e]); Wp[e] = __expf(et[e] - E[e]); iW[e] = __builtin_amdgcn_rcpf(Wt[e]); } \
        const f32x4 at = pa * Wp, rt = pr * Wt, bt = pb * iW, kt = pk * iW; const int o2 = tl * 72 + 4 * l16; \
        *(LAS u32x2*)(At + o2) = (u32x2){cvt_pk_bf16(at[0], at[1]), cvt_pk_bf16(at[2], at[3])}; *(LAS u32x2*)(Rt + o2) = (u32x2){cvt_pk_bf16(rt[0], rt[1]), cvt_pk_bf16(rt[2], rt[3])}; \
        *(LAS u32x2*)(Bt + o2) = (u32x2){cvt_pk_bf16(bt[0], bt[1]), cvt_pk_bf16(bt[2], bt[3])}; *(LAS u32x2*)(Kt + o2) = (u32x2){cvt_pk_bf16(kt[0], kt[1]), cvt_pk_bf16(kt[2], kt[3])}; \
        _Pragma("unroll") for (int e = 0; e < 4; ++e) { BtT[(4 * l16 + e) * 40 + tl] = f2bf(bt[e]); KtT[(4 * l16 + e) * 40 + tl] = f2bf(kt[e]); } \
        if (tl == 15) *(LAS f32x4*)(Wend + 4 * l16) = Wt; } while (0)

    if (w >= 4) RC_ISSUE(0);
    __syncthreads();
    if (w >= 4) { RC_PREP(0); gc = gn; bc = bn; }
    __syncthreads();
    if (w < 4) RC_P1A();
    __syncthreads();
    if (w >= 4) RC_P1B();
    __syncthreads();
    for (int ch = 0; ch < 128; ++ch) {
        LAS bf16_t* VTc = (ch & 1) ? VT1 : VT;
        if (w < 4) {
            LAS bf16_t* Xr = (w & 1) ? Kt : Bt; LAS bf16_t* Yr = (w & 2) ? Rt : At;
            f32x4 gacc = (f32x4){0.f, 0.f, 0.f, 0.f};
#pragma unroll
            for (int ks = 0; ks < 2; ++ks) { const bf16x8 xa = *(LAS bf16x8*)(Xr + fr * 72 + ks * 32 + fq * 8); const bf16x8 yb_ = *(LAS bf16x8*)(Yr + fr * 72 + ks * 32 + fq * 8); gacc = __builtin_amdgcn_mfma_f32_16x16x32_bf16(xa, yb_, gacc, 0, 0, 0); }
            float gm[4];
#pragma unroll
            for (int i = 0; i < 4; ++i) { const int j = fq * 4 + i; const bool keep = (w & 2) ? (j <= fr) : (j < fr); gm[i] = keep ? gacc[i] : 0.f; }
            if (w == 0) {
#pragma unroll
                for (int i = 0; i < 4; ++i) Aab[(fq * 4 + i) * 16 + fr] = gm[i]; }
            else { LAS bf16_t* dst = (w == 1) ? AakT : (w == 2) ? AbrT : AkrT; *(LAS u32x2*)(dst + fr * 40 + fq * 4) = (u32x2){cvt_pk_bf16(gm[0], gm[1]), cvt_pk_bf16(gm[2], gm[3])}; }
        }
        __syncthreads();
        f32x4 y0 = (f32x4){0.f, 0.f, 0.f, 0.f};
        { const int vtile = w & 3; LAS bf16_t* Yr = (w < 4) ? At : Rt; LAS bf16_t* Gt = (w < 4) ? AakT : AkrT;
#pragma unroll
          for (int ks = 0; ks < 2; ++ks) { const bf16x8 sa = *(LAS bf16x8*)(S0b + (vtile * 16 + fr) * 72 + ks * 32 + fq * 8); const bf16x8 yb_ = *(LAS bf16x8*)(Yr + fr * 72 + ks * 32 + fq * 8); y0 = __builtin_amdgcn_mfma_f32_16x16x32_bf16(sa, yb_, y0, 0, 0, 0); }
          { const bf16x8 va = *(LAS bf16x8*)(VTc + (vtile * 16 + fr) * 40 + fq * 8); const bf16x8 gb = *(LAS bf16x8*)(Gt + fr * 40 + fq * 8); y0 = __builtin_amdgcn_mfma_f32_16x16x32_bf16(va, gb, y0, 0, 0, 0); }
          if (w < 4) {
#pragma unroll
              for (int i = 0; i < 4; ++i) RHS[(vtile * 16 + fq * 4 + i) * 17 + fr] = y0[i]; } }
        __syncthreads();
        if (w == 0) {
            float u[16];
#pragma unroll
            for (int t = 0; t < 16; ++t) u[t] = RHS[lane * 17 + t];
#pragma unroll
            for (int t = 0; t < 15; ++t) {
#pragma unroll
                for (int t2 = t + 1; t2 < 16; ++t2) u[t2] += u[t] * Aab[t * 16 + t2]; }
            u32x4 o0, o1; o0.x = cvt_pk_bf16(u[0], u[1]); o0.y = cvt_pk_bf16(u[2], u[3]); o0.z = cvt_pk_bf16(u[4], u[5]); o0.w = cvt_pk_bf16(u[6], u[7]);
            o1.x = cvt_pk_bf16(u[8], u[9]); o1.y = cvt_pk_bf16(u[10], u[11]); o1.z = cvt_pk_bf16(u[12], u[13]); o1.w = cvt_pk_bf16(u[14], u[15]);
            *(LAS u32x4*)(Ub + lane * 40) = o0; *(LAS u32x4*)(Ub + lane * 40 + 8) = o1;
        }
        if (w >= 4) { RC_PREP(ch + 1); }
        __syncthreads();
        if (w >= 4) { const int vtile = w & 3;
            const bf16x8 ua = *(LAS bf16x8*)(Ub + (vtile * 16 + fr) * 40 + fq * 8); const bf16x8 gb = *(LAS bf16x8*)(AbrT + fr * 40 + fq * 8); y0 = __builtin_amdgcn_mfma_f32_16x16x32_bf16(ua, gb, y0, 0, 0, 0);
#pragma unroll
            for (int i = 0; i < 4; ++i) ybuf[fr * 64 + vtile * 16 + fq * 4 + i] = y0[i]; }
        { const bf16x8 ua = *(LAS bf16x8*)(Ub + (vt * 16 + fr) * 40 + fq * 8); const bf16x8 va = *(LAS bf16x8*)(VTc + (vt * 16 + fr) * 40 + fq * 8);
#pragma unroll
          for (int q = 0; q < 2; ++q) { const int kk = (kt0 + q) * 16 + fr;
              const bf16x8 bb = *(LAS bf16x8*)(BtT + kk * 40 + fq * 8); const bf16x8 kb = *(LAS bf16x8*)(KtT + kk * 40 + fq * 8);
              f32x4 acc = stt[q]; acc = __builtin_amdgcn_mfma_f32_16x16x32_bf16(ua, bb, acc, 0, 0, 0); acc = __builtin_amdgcn_mfma_f32_16x16x32_bf16(va, kb, acc, 0, 0, 0);
              const float we = Wend[kk]; acc = acc * we; stt[q] = acc;
#pragma unroll
              for (int i = 0; i < 4; ++i) S0b[(vt * 16 + fq * 4 + i) * 72 + kk] = f2bf(acc[i]); } }
        if (w < 4 && ch + 1 < 128) RC_P1A();
        __syncthreads();
        if (w >= 4) { const f32x4 y = *(LAS f32x4*)(ybuf + tl * 64 + 4 * l16);
          const float mu = red16(y[0] + y[1] + y[2] + y[3]) * (1.0f / 64); const f32x4 d = y - mu;
          const float var = red16(d[0] * d[0] + d[1] * d[1] + d[2] * d[2] + d[3] * d[3]) * (1.0f / 64), rs = rsqrtf(var + 64e-5f);
          const f32x4 o4 = (d * rs * lnw + lnb + bc) * gc;
          Y64[(size_t)(ch * 16) * (D / 4)] = make_uint2(cvt_pk_nv(o4[0], o4[1]), cvt_pk_nv(o4[2], o4[3]));
          gc = gn; bc = bn;
          if (ch + 1 < 128) RC_P1B(); }
        __syncthreads();
    }
#undef RC_P1A
#undef RC_P1B
#undef RC_ISSUE
#undef RC_PREP
}

#define XB_TMO      128
#define XB_XCNT(j)  (256  + 64 * (j))
#define XB_XSUB(j)  (1280 + 64 * (j))
#define XB_XGEN(j)  (2304 + 64 * (j))
#define XB_TOP      3328
#define XB_TOPGEN   3392
#define XCD_BAR_WORDS 3456
#define XB_SPIN_CAP (1u << 18)

__device__ __forceinline__ unsigned xb_ld(unsigned* p)              { return __hip_atomic_load(p, __ATOMIC_RELAXED, __HIP_MEMORY_SCOPE_AGENT); }
__device__ __forceinline__ unsigned xb_add(unsigned* p, unsigned v) { return __hip_atomic_fetch_add(p, v, __ATOMIC_RELAXED, __HIP_MEMORY_SCOPE_AGENT); }
__device__ __forceinline__ unsigned xb_xcc_id() { return (unsigned)__builtin_amdgcn_s_getreg((3 << 11) | 20) & 0xFu; }
#define XB_SPIN(cond, bar) do { unsigned _sp = 0; while (cond) { __builtin_amdgcn_s_sleep(1); \
    if ((++_sp & 255u) == 0u) { if (xb_ld(&(bar)[XB_TMO])) break; if (_sp > XB_SPIN_CAP) { atomicAdd(&(bar)[XB_TMO], 1u); break; } } } } while (0)

struct XcdBarrier {
    unsigned* bar; unsigned x;
    volatile LAS unsigned* st;
};

__device__ __forceinline__ XcdBarrier xcd_barrier_post(unsigned* bar, volatile LAS unsigned* st) {
    XcdBarrier b; b.bar = bar; b.x = xb_xcc_id(); b.st = st;
    if (threadIdx.x == 0) (void)xb_add(&bar[XB_XCNT(b.x)], 1u);
    return b;
}
__device__ __forceinline__ void xcd_barrier_complete(unsigned* bar, unsigned x, unsigned& nloc, unsigned& nx) {
    const unsigned G = gridDim.x * gridDim.y * gridDim.z;
    unsigned sum, cnt, mine, sp = 0u;
    for (;;) {
        sum = 0u; cnt = 0u; mine = 0u;
#pragma unroll
        for (unsigned j = 0; j < 16; ++j) { const unsigned c = xb_ld(&bar[XB_XCNT(j)]); sum += c; cnt += (c > 0u) ? 1u : 0u; mine = (j == x) ? c : mine; }
        if (sum == G) break;
        __builtin_amdgcn_s_sleep(1);
        if ((++sp & 255u) == 0u) { if (xb_ld(&bar[XB_TMO])) break; if (sp > XB_SPIN_CAP) { atomicAdd(&bar[XB_TMO], 1u); break; } }
    }
    nloc = mine > 0u ? mine : 1u; nx = cnt > 0u ? cnt : 1u;
}

__device__ __forceinline__ void xcd_barrier(const XcdBarrier& b) {
    asm volatile("s_waitcnt vmcnt(0)" ::: "memory");
    __syncthreads();
    if (threadIdx.x == 0) {
        unsigned* bar = b.bar;
        __builtin_amdgcn_s_waitcnt(0);
        unsigned nloc = b.st[0], nx = b.st[1];
        if (nloc == 0u) { xcd_barrier_complete(bar, b.x, nloc, nx); b.st[0] = nloc; b.st[1] = nx; }
        const unsigned old = xb_add(&bar[XB_XSUB(b.x)], 1u);
        const unsigned gen = old / nloc;
        if (old + 1u == (gen + 1u) * nloc) {
            __builtin_amdgcn_fence(__ATOMIC_RELEASE, "agent");
            asm volatile("s_waitcnt vmcnt(0)" ::: "memory");
            const unsigned og = xb_add(&bar[XB_TOP], 1u);
            const unsigned tg = og / nx;
            if (og + 1u == (tg + 1u) * nx) xb_add(&bar[XB_TOPGEN], 1u);
            else XB_SPIN(xb_ld(&bar[XB_TOPGEN]) == tg, bar);
            __builtin_amdgcn_fence(__ATOMIC_ACQUIRE, "agent");
            xb_add(&bar[XB_XGEN(b.x)], 1u);
            asm volatile("s_waitcnt vmcnt(0)" ::: "memory");
        } else {
            XB_SPIN(xb_ld(&bar[XB_XGEN(b.x)]) == gen, bar);
            __builtin_amdgcn_fence(__ATOMIC_ACQUIRE, "agent");
            asm volatile("s_waitcnt vmcnt(0)" ::: "memory");
        }
    }
    __syncthreads();
}


__global__ __launch_bounds__(512, 2) void mega(const Params p_arg) {
    extern __shared__ __attribute__((aligned(16))) unsigned char shm[];
    const Params& p = *(const Params*)(const void*)__builtin_amdgcn_kernarg_segment_ptr();
    LAS unsigned char* lds = (LAS unsigned char*)shm;
    const int G = (int)gridDim.x, bid = (int)blockIdx.x;
    __shared__ uint4 xb_words;
    if (threadIdx.x == 0) xb_words = make_uint4(0u, 0u, 0u, 0u);
    __syncthreads();
    (void)xcd_barrier_post((unsigned*)(p.ws + WS_BAR), (volatile LAS unsigned*)&xb_words);
    const int step_lo = p.step_lo, step_hi = p.step_hi;
    for (int s = step_lo; s < step_hi; ++s) {
        const int kind = p.kind[s], lo = p.lo[s], hi = p.hi[s];
        switch (kind) {
            case K_PRE0:
#ifndef NO_PRE
 convert_tiles(p, lo, hi, lds); rope_table(p); norm_rows(p.in[0], p.in[1], (bf16_t*)(p.ws + WS_H));
#endif
 break;
            case K_GEMMB:
#ifndef NO_GB

                { pg8::Gemm g; g.A = p.g[lo].A; g.Bt = p.g[lo].Bt; g.M = p.g[lo].M; g.N = p.g[lo].N; g.K = p.g[lo].K;
                  MultiOrder S; S.ops = &p.g[lo]; S.nops = hi - lo; S.G = G; S.c = bid;
                  EpiB E; E.ops = &p.g[lo];
                  pg8::gemm_phase<EpiB, MultiOrder, false>(lds, g, S, E, nullptr); }
                if (p.chi[s] > p.clo[s]) convert_queue(p, p.clo[s], p.chi[s], (unsigned*)(p.ws + WS_BAR + 16384) + 64 * p.cq[s], lds);
#endif
                break;
            case K_GEMMF:
#ifndef NO_GF

                for (int i = lo; i < hi; ++i) { const GemmOp& o = p.g[i]; pg8::Gemm g; g.A = o.A; g.Bt = o.Bt; g.M = o.M; g.N = o.N; g.K = o.K;
                    pg8::StaticOrder S; S.init(o.M, o.N, G, (bid + G - (o.rot % G)) % G);
                    EpiF E; E.C = (float*)o.out; E.ldc = o.ldc; E.res = o.res;
                    pg8::gemm_phase<EpiF, pg8::StaticOrder, false>(lds, g, S, E, nullptr); }
#endif
                break;
            case K_CONVSSD:
#ifndef NO_CONV
 conv_ssd(p);
#endif
 break;
            case K_MIX0:

#ifndef NO_SSD
for (int j = bid; j < 256; j += G) ssd_chunk_job(p, j, lds);
#endif


#ifndef NO_ATT
for (int j = bid; j < 512; j += G) attn_job(p, j, lds);
#endif

                break;
            case K_POST0: post_ssd(p); break;
            case K_NORM: norm_rows(p.out, p.in[2] + lo * D, (bf16_t*)(p.ws + WS_H)); break;
            case K_PRE1: convert_tiles(p, lo, hi, lds); mix_rows(p.out, p.in[1] + D, p.in[16], (bf16_t*)(p.ws + WS_MIX), 0, lds); break;
            case K_MIXES: mix_rows(p.out, p.in[1] + D, p.in[16], (bf16_t*)(p.ws + WS_MIX), 8192, lds); break;
            case K_RWKV:
#ifndef NO_RWKV
 for (int j = bid; j < 256; j += G) rwkv_chunk_job(p, j, lds);
#endif
 break;
            case K_NORMCONV: convert_tiles(p, lo, hi, lds); norm_rows(p.out, p.in[2] + D, (bf16_t*)(p.ws + WS_H)); break;
            default: break;
        }
        if (s + 1 < step_hi) { if (step_hi < 0) cg::this_grid().sync();   XcdBarrier xb; xb.bar = (unsigned*)(p.ws + WS_BAR); xb.x = xb_xcc_id(); xb.st = (volatile LAS unsigned*)&xb_words; xcd_barrier(xb); }
    }
}

#ifndef MK_MULTI
#define MK_MULTI 0
#endif
extern "C" void kernel_launch(void* const* d_in, const int* in_sizes, int n_in, void* d_out, int out_size, void* d_ws, size_t ws_size, hipStream_t stream) {
    static int grid = 0;
    if (grid == 0) {
        int dev = 0, cus = 0, per_cu = 0;
        hipGetDevice(&dev); hipDeviceGetAttribute(&cus, hipDeviceAttributeMultiprocessorCount, dev);
        if (hipFuncSetAttribute((const void*)mega, hipFuncAttributeMaxDynamicSharedMemorySize, LDS_BYTES) != hipSuccess) { fprintf(stderr, "hipFuncSetAttribute failed\n"); grid = -1; return; }
        if (hipOccupancyMaxActiveBlocksPerMultiprocessor(&per_cu, (const void*)mega, 512, LDS_BYTES) != hipSuccess || per_cu < 1) { fprintf(stderr, "occupancy query: %d\n", per_cu); per_cu = 1; }
        (void)hipGetLastError();
        grid = cus * per_cu; if (grid > 256) grid = 256;
        if (n_in != 34 || ws_size < 512 * MiB) { fprintf(stderr, "unexpected n_in %d / ws %zu\n", n_in, ws_size); grid = -1; return; }
    }
    if (grid < 0) return;
    static Params p;
    memset(&p, 0, sizeof(p));
    for (int i = 0; i < 34; ++i) p.in[i] = (const float*)d_in[i];
    p.out = (float*)d_out; p.ws = (unsigned char*)d_ws;
    unsigned char* ws = (unsigned char*)d_ws;
    auto B16 = [&](size_t off) { return (bf16_t*)(ws + off); };
    int ncj = 0, tile_acc = 0;
    auto CJ = [&](const float* src, size_t dst_off, int K, int N, int Kpad, int Npad) { ConvJob& c = p.cj[ncj++]; c.src = src; c.dst = B16(dst_off); c.K = K; c.N = N; c.Kpad = Kpad; c.Npad = Npad; c.tile0 = tile_acc; c.ntiles = (Kpad / 64) * (Npad / 256); tile_acc += c.ntiles; };
    const float* w_up = p.in[3]; const float* w_down = p.in[4];
    tile_acc = 0;
    CJ(p.in[5], WS_WBA, 2048, 4112, 2048, 4352); CJ(p.in[15], WS_WBA + 17 * MiB, 2048, 2048, 2048, 2048);
    tile_acc = 0;
    CJ(w_up, WS_WMLP, 2048, 8192, 2048, 8192); CJ(w_down, WS_WMLP + 32 * MiB, 8192, 2048, 8192, 2048);
    tile_acc = 0;
    CJ(p.in[28], WS_WBA, 2048, 2048, 2048, 2048); CJ(p.in[29], WS_WBA + 8 * MiB, 2048, 2048, 2048, 2048); CJ(p.in[30], WS_WBA + 16 * MiB, 2048, 2048, 2048, 2048); CJ(p.in[31], WS_WBA + 24 * MiB, 2048, 2048, 2048, 2048);
    CJ(p.in[18], WS_WBA + 32 * MiB, 2048, 96, 2048, 256); CJ(p.in[21], WS_WBA + 33 * MiB, 2048, 96, 2048, 256); CJ(p.in[23], WS_WBA + 34 * MiB, 2048, 256, 2048, 256);
    CJ(p.in[19], WS_WBA + 35 * MiB, 96, 2048, 256, 2048); CJ(p.in[22], WS_WBA + 36 * MiB, 96, 2048, 256, 2048); CJ(p.in[24], WS_WBA + 37 * MiB, 256, 2048, 256, 2048);
    tile_acc = 0;
    CJ(w_up + (size_t)2048 * 8192, WS_WMLP1, 2048, 8192, 2048, 8192); CJ(w_down + (size_t)2048 * 8192, WS_WMLP1 + 32 * MiB, 8192, 2048, 8192, 2048);
    int nop = 0;
    auto GO = [&](const bf16_t* A, const bf16_t* Bt, void* out, const float* bias, const float* res, int M, int N, int K, int ldc, int act, int rot) {
        GemmOp& o = p.g[nop++]; o.A = A; o.Bt = Bt; o.out = out; o.bias = bias; o.res = res; o.M = M; o.N = N; o.K = K; o.ldc = ldc; o.act = act; o.rot = rot; };
    GO(B16(WS_H), B16(WS_WBA), B16(WS_PROJ), nullptr, nullptr, MTOK, INWP, 2048, INWP, 0, 0);
    GO(B16(WS_YMIX), B16(WS_WBA + 17 * MiB), d_out, nullptr, p.in[0], MTOK, 2048, 2048, 2048, 0, 0);
    GO(B16(WS_H), B16(WS_WMLP), B16(WS_U), nullptr, nullptr, MTOK, DFF, 2048, DFF, 1, 0);
    GO(B16(WS_U), B16(WS_WMLP + 32 * MiB), d_out, nullptr, (const float*)d_out, MTOK, 2048, DFF, 2048, 0, 0);
    for (int half = 0; half < 2; ++half) {
        const size_t ro = (size_t)half * 8192 * 2048 * 2, lo_ = (size_t)half * 8192 * 256 * 2; const size_t mb = (size_t)8192 * 2048 * 2;
        GO(B16(WS_MIX + 0 * mb), B16(WS_WBA), B16(WS_R + ro), nullptr, nullptr, 8192, 2048, 2048, 2048, 0, 0);
        GO(B16(WS_MIX + 2 * mb), B16(WS_WBA + 8 * MiB), B16(WS_K + ro), nullptr, nullptr, 8192, 2048, 2048, 2048, 0, 0);
        GO(B16(WS_MIX + 3 * mb), B16(WS_WBA + 16 * MiB), B16(WS_V + ro), nullptr, nullptr, 8192, 2048, 2048, 2048, 0, 0);
        GO(B16(WS_MIX + 1 * mb), B16(WS_WBA + 32 * MiB), B16(WS_L1W + lo_), nullptr, nullptr, 8192, 256, 2048, 256, 2, 0);
        GO(B16(WS_MIX + 4 * mb), B16(WS_WBA + 33 * MiB), B16(WS_L1A + lo_), nullptr, nullptr, 8192, 256, 2048, 256, 0, 32);
        GO(B16(WS_MIX + 5 * mb), B16(WS_WBA + 34 * MiB), B16(WS_L1G + lo_), nullptr, nullptr, 8192, 256, 2048, 256, 3, 64);
    }
    GO(B16(WS_L1W), B16(WS_WBA + 35 * MiB), B16(WS_WDEC), p.in[17], nullptr, MTOK, 2048, 256, 2048, 4, 0);
    GO(B16(WS_L1A), B16(WS_WBA + 36 * MiB), B16(WS_AA), p.in[20], nullptr, MTOK, 2048, 256, 2048, 3, 0);
    GO(B16(WS_L1G), B16(WS_WBA + 37 * MiB), B16(WS_GG), nullptr, nullptr, MTOK, 2048, 256, 2048, 0, 0);
    GO(B16(WS_YG), B16(WS_WBA + 24 * MiB), d_out, nullptr, (const float*)d_out, MTOK, 2048, 2048, 2048, 0, 0);
    GO(B16(WS_H), B16(WS_WMLP1), B16(WS_U), nullptr, nullptr, MTOK, DFF, 2048, DFF, 1, 0);
    GO(B16(WS_U), B16(WS_WMLP1 + 32 * MiB), d_out, nullptr, (const float*)d_out, MTOK, 2048, DFF, 2048, 0, 0);
    int ns = 0;
    auto ST = [&](int kind, int lo, int hi, int clo = 0, int chi = 0, int cq = 0) { p.kind[ns] = kind; p.lo[ns] = lo; p.hi[ns] = hi; p.clo[ns] = clo; p.chi[ns] = chi; p.cq[ns] = cq; ++ns; };
    ST(K_PRE0, 0, 2); ST(K_GEMMB, 0, 1, 2, 4, 0); ST(K_CONVSSD, 0, 0); ST(K_MIX0, 0, 0); ST(K_POST0, 0, 0); ST(K_GEMMF, 1, 2); ST(K_NORM, 0, 0); ST(K_GEMMB, 2, 3); ST(K_GEMMF, 3, 4);
    ST(K_PRE1, 4, 14); ST(K_GEMMB, 4, 10, 14, 16, 1); ST(K_MIXES, 0, 0); ST(K_GEMMB, 10, 16, 14, 16, 1); ST(K_GEMMB, 16, 19); ST(K_RWKV, 0, 0); ST(K_GEMMF, 19, 20); ST(K_NORM, 1, 0); ST(K_GEMMB, 20, 21); ST(K_GEMMF, 21, 22);
    (void)hipMemsetAsync(ws + WS_BAR, 0, 16384 + 1024, stream);
#if MK_MULTI
    for (int s = 0; s < ns; ++s) { p.step_lo = s; p.step_hi = s + 1; hipLaunchKernelGGL(mega, dim3(grid), dim3(512), LDS_BYTES, stream, p); }
#else
    p.step_lo = 0; p.step_hi = ns;
    void* args[] = {(void*)&p};
    const hipError_t e = hipLaunchCooperativeKernel((const void*)mega, dim3(grid), dim3(512), args, LDS_BYTES, stream);
    if (e != hipSuccess) fprintf(stderr, "cooperative launch failed: %s (grid %d)\n", hipGetErrorString(e), grid);
#endif
}
```

```cpp
#include <hip/hip_runtime.h>
#include <hip/hip_cooperative_groups.h>
#include <cstdio>
#include <cstring>
namespace cg = cooperative_groups;
__device__ __forceinline__ int opq(int v) { asm volatile("" : "+v"(v)); return v; }
namespace pg8 {
#define PG8_LAS __attribute__((address_space(3)))
typedef unsigned short bf16_t;
typedef short bf16x8 __attribute__((ext_vector_type(8)));
typedef float f32x4 __attribute__((ext_vector_type(4)));
typedef unsigned u32x4 __attribute__((ext_vector_type(4)));
constexpr int BM = 256, BK = 64, HALF = 128, HTB = HALF * BK * 2  , STAGE_BYTES = 8 * HTB, NXCD = 8, WGM = 8;

__host__ __device__ __forceinline__ int lds_byte(int r, int c) { const int st = (r >> 4) * 2 + (c >> 5), rr = r & 15, cc = c & 31, ob = rr * 64 + cc * 2; return st * 1024 + (ob ^ (((ob >> 9) & 1) << 5)); }
__host__ __device__ __forceinline__ void stage_rc(int b, int& R, int& C) { const int st = b / 1024, sb = b % 1024, swz = sb ^ (((sb >> 9) & 1) << 5); R = (st >> 1) * 16 + swz / 64; C = (st & 1) * 32 + (swz % 64) / 2; }
__host__ __device__ __forceinline__ int perm32(int rho) { const int n = rho >> 4, i = rho & 15; return 8 * (i >> 2) + 4 * n + (i & 3); }

struct Unit { int pm, pn, op; };
struct Gemm { const bf16_t* A; const bf16_t* Bt; int M, N, K; };

struct StaticOrder {
    int nM, nN, nwg, G, c;
    __host__ __device__ void init(int M, int N, int G_, int c_) { nM = M / BM; nN = N / BM; nwg = nM * nN; G = G_; c = c_; }
    __host__ __device__ bool next(int i, Unit& u) const {
        const long L = (long)i * G + c; if (L >= nwg) return false;
        int wgid = (int)L; { const int q = nwg / NXCD, r = nwg % NXCD, xcd = wgid % NXCD, off = wgid / NXCD; wgid = (xcd < r ? xcd * (q + 1) : r * (q + 1) + (xcd - r) * q) + off; }
        const int nig = WGM * nN, gid = wgid / nig, fm = gid * WGM, gsz = (nM - fm) < WGM ? (nM - fm) : WGM;
        u.pm = fm + ((wgid % nig) % gsz); u.pn = (wgid % nig) / gsz; u.op = 0; return true;
    }
    __device__ __forceinline__ const char* abase(const Unit&, const Gemm& g) const { return (const char*)g.A; }
    __device__ __forceinline__ const char* bbase(const Unit&, const Gemm& g) const { return (const char*)g.Bt; }
    __device__ __forceinline__ void a_ready(const Unit&) const {}
    __device__ __forceinline__ void done(const Unit&) const {}
};
typedef __bf16 bf16x2_t __attribute__((ext_vector_type(2)));
typedef float f32x2_t __attribute__((ext_vector_type(2)));
__device__ __forceinline__ unsigned cvt_pk_bf16(float lo, float hi) { const f32x2_t f = {lo, hi}; const bf16x2_t v = __builtin_convertvector(f, bf16x2_t); return __builtin_bit_cast(unsigned, v); }
__device__ __forceinline__ unsigned cvt_pk_nv(float lo, float hi) { return cvt_pk_bf16(lo, hi); }

template <class Epi, class Sched, bool STAMP = false>
__device__ __forceinline__ void gemm_phase(PG8_LAS unsigned char* lds, const Gemm g, const Sched& S, const Epi& E, unsigned long long* stamps) {
    const int tid = opq(threadIdx.x), wid = __builtin_amdgcn_readfirstlane(tid >> 6), lane = tid & 63, wr = wid >> 2, wc = wid & 3, fr = lane & 15, fq = lane >> 4;
    const int K = g.K, nt = K / BK;
    int ts_lo = 0, ts_hi = 0, nts = 0; const unsigned long long rt_entry = STAMP ? (unsigned long long)wall_clock64() : 0ull;
#define PG8_STAMP() do { if (STAMP && wid == 0 && nts < 64) { const unsigned long long _c = (unsigned long long)clock64(); \
        ts_lo = (lane == nts) ? (int)(unsigned)_c : ts_lo; ts_hi = (lane == nts) ? (int)(unsigned)(_c >> 32) : ts_hi; ++nts; } } while (0)
    PG8_STAMP();
    unsigned voffA[2], voffB[2];
#pragma unroll
    for (int i = 0; i < 2; ++i) { int R, C; stage_rc(tid * 16 + i * 8192, R, C); const int Rb = Epi::PERM ? ((R & ~31) + perm32(R & 31)) : R;
        voffA[i] = (unsigned)(R * K + C) * 2u; voffB[i] = (unsigned)(Rb * K + C) * 2u; }
    const size_t kstep = (size_t)(BK * 2);
    const size_t hstep = (size_t)HALF * K * 2;
    const size_t tstep = 2 * hstep;
    const unsigned ldsw = (unsigned)wid * 1024u;
    const int aoff = lds_byte(wr * 64 + fr, fq * 8), boff = lds_byte(wc * 32 + fr, fq * 8);
#define PG8_SA(b, h) (((b) * 2 + (h)) * HTB)
#define PG8_SB(b, h) ((4 + (b) * 2 + (h)) * HTB)
#define PG8_STAGE(bufoff, gbase, voff) do { _Pragma("unroll") for (int _i = 0; _i < 2; ++_i) \
        __builtin_amdgcn_global_load_lds((const unsigned*)((const char*)(gbase) + (voff)[_i]), (PG8_LAS unsigned*)(lds + (bufoff) + ldsw + _i * 8192), 16, 0, 0); } while (0)
#define PG8_LDA(dst, b, h) do { _Pragma("unroll") for (int m = 0; m < 4; ++m) _Pragma("unroll") for (int k = 0; k < 2; ++k) dst[m][k] = *(const PG8_LAS bf16x8*)(lds + PG8_SA(b, h) + aoff + m * 2048 + k * 1024); } while (0)
#define PG8_LDB(dst, b, h) do { _Pragma("unroll") for (int n = 0; n < 2; ++n) _Pragma("unroll") for (int k = 0; k < 2; ++k) dst[n][k] = *(const PG8_LAS bf16x8*)(lds + PG8_SB(b, h) + boff + n * 2048 + k * 1024); } while (0)
#define PG8_MMA(ai, bj, At, Bt) do { __builtin_amdgcn_s_setprio(1); _Pragma("unroll") for (int m = 0; m < 4; ++m) _Pragma("unroll") for (int n = 0; n < 2; ++n) _Pragma("unroll") for (int k = 0; k < 2; ++k) \
        acc[ai][bj][m][n] = __builtin_amdgcn_mfma_f32_16x16x32_bf16(Bt[n][k], At[m][k], acc[ai][bj][m][n], 0, 0, 0); __builtin_amdgcn_s_setprio(0); } while (0)
#define PG8_WAIT_V(n) asm volatile("s_waitcnt vmcnt(" #n ")" ::: "memory")
#define PG8_WAIT_L(n) asm volatile("s_waitcnt lgkmcnt(" #n ")" ::: "memory")
#define PG8_BAR __builtin_amdgcn_s_barrier()
#define PG8_SCHED __builtin_amdgcn_sched_barrier(0)
    Unit cur, nxt; int ui = 0;
    if (!S.next(0, cur)) return;
    f32x4 acc[2][2][4][2];
#pragma unroll
    for (int a = 0; a < 2; ++a)
#pragma unroll
        for (int b = 0; b < 2; ++b)
#pragma unroll
            for (int m = 0; m < 4; ++m)
#pragma unroll
                for (int n = 0; n < 2; ++n) acc[a][b][m][n] = (f32x4){0.f, 0.f, 0.f, 0.f};
    bf16x8 At[4][2], B0[2][2], B1[2][2];
    const char* cA = S.abase(cur, g) + (size_t)cur.pm * tstep; const char* cB = S.bbase(cur, g) + (size_t)cur.pn * tstep;
    S.a_ready(cur);
    PG8_STAGE(PG8_SB(0, 0), cB, voffB); PG8_STAGE(PG8_SA(0, 0), cA, voffA); PG8_STAGE(PG8_SB(0, 1), cB + hstep, voffB); PG8_STAGE(PG8_SA(0, 1), cA + hstep, voffA);
    if (wr == 1) PG8_BAR;
    PG8_WAIT_V(4); PG8_BAR;
    PG8_STAGE(PG8_SB(1, 0), cB + kstep, voffB); PG8_STAGE(PG8_SA(1, 0), cA + kstep, voffA); PG8_STAGE(PG8_SB(1, 1), cB + hstep + kstep, voffB);
    PG8_WAIT_V(6); PG8_BAR;
    PG8_STAMP();
    for (;;) {
        const bool has_next = S.next(ui + 1, nxt);
        const char* nA = has_next ? S.abase(nxt, g) + (size_t)nxt.pm * tstep : cA; const char* nB = has_next ? S.bbase(nxt, g) + (size_t)nxt.pn * tstep : cB;
        for (int t = 0; t < nt; t += 2) {
            const bool last = (t == nt - 2);
            const char* a1 = cA + (size_t)(t + 1) * kstep;
            const char* a2 = last ? nA : cA + (size_t)(t + 2) * kstep; const char* b2 = last ? nB : cB + (size_t)(t + 2) * kstep;
            const char* a3 = a2 + kstep; const char* b3 = b2 + kstep;
            if (last && has_next) S.a_ready(nxt);
            PG8_LDB(B0, 0, 0); PG8_SCHED; PG8_LDA(At, 0, 0); PG8_STAGE(PG8_SA(1, 1), a1 + hstep, voffA);
            PG8_WAIT_L(8); PG8_BAR; PG8_WAIT_L(0); PG8_MMA(0, 0, At, B0); PG8_BAR; PG8_SCHED;
            PG8_LDB(B1, 0, 1); PG8_STAGE(PG8_SB(0, 0), b2, voffB);
            PG8_BAR; PG8_WAIT_L(0); PG8_MMA(0, 1, At, B1); PG8_BAR;
            PG8_LDA(At, 0, 1); PG8_STAGE(PG8_SA(0, 0), a2, voffA);
            PG8_BAR; PG8_WAIT_L(0); PG8_MMA(1, 0, At, B0); PG8_BAR; PG8_SCHED;
            PG8_STAGE(PG8_SB(0, 1), b2 + hstep, voffB);
            PG8_WAIT_V(6); PG8_BAR; PG8_MMA(1, 1, At, B1); PG8_BAR;
            PG8_LDB(B0, 1, 0); PG8_SCHED; PG8_LDA(At, 1, 0); PG8_STAGE(PG8_SA(0, 1), a2 + hstep, voffA);
            PG8_WAIT_L(8); PG8_BAR; PG8_WAIT_L(0); PG8_MMA(0, 0, At, B0); PG8_BAR; PG8_SCHED;
            PG8_LDB(B1, 1, 1); PG8_STAGE(PG8_SB(1, 0), b3, voffB);
            PG8_BAR; PG8_WAIT_L(0); PG8_MMA(0, 1, At, B1); PG8_BAR;
            PG8_LDA(At, 1, 1); PG8_STAGE(PG8_SA(1, 0), a3, voffA);
            PG8_BAR; PG8_WAIT_L(0); PG8_MMA(1, 0, At, B0); PG8_BAR; PG8_SCHED;
            PG8_STAGE(PG8_SB(1, 1), b3 + hstep, voffB);
            PG8_WAIT_V(6); PG8_BAR; PG8_MMA(1, 1, At, B1); PG8_BAR;
        }
        PG8_STAMP();
        if constexpr (!Epi::AFTER_DRAIN) { E(acc, cur, wr, wc, fr, fq); S.done(cur); }
        PG8_STAMP();
        if (!has_next) break;
#pragma unroll
        for (int a = 0; a < 2; ++a)
#pragma unroll
            for (int b = 0; b < 2; ++b)
#pragma unroll
                for (int m = 0; m < 4; ++m)
#pragma unroll
                    for (int n = 0; n < 2; ++n) acc[a][b][m][n] = (f32x4){0.f, 0.f, 0.f, 0.f};
        cur = nxt; cA = nA; cB = nB; ++ui;
    }
    PG8_WAIT_V(0);
    if (wr == 0) PG8_BAR;
    PG8_BAR;
    if constexpr (Epi::AFTER_DRAIN) { E.fused(acc, cur, wr, wc, fr, fq, lds, wid, lane); S.done(cur); }
    PG8_STAMP();
    if (STAMP && wid == 0) { stamps[lane] = lane < nts ? (((unsigned long long)(unsigned)ts_hi << 32) | (unsigned)ts_lo) : 0ull;
        if (lane == 62) stamps[62] = rt_entry; if (lane == 63) stamps[63] = (unsigned long long)wall_clock64(); }
#undef PG8_STAMP
#undef PG8_SA
#undef PG8_SB
#undef PG8_STAGE
#undef PG8_LDA
#undef PG8_LDB
#undef PG8_MMA
#undef PG8_WAIT_V
#undef PG8_WAIT_L
#undef PG8_BAR
#undef PG8_SCHED
}
}

#include <cstdio>
#include <ctime>
#include <cstdlib>
#include <cstring>
#include <cmath>
#include <vector>
#include <algorithm>
#define CK(x) do { hipError_t e_ = (x); if (e_ != hipSuccess) { fprintf(stderr, "HIP %s:%d %s\n", __FILE__, __LINE__, hipGetErrorString(e_)); exit(2); } } while (0)
using pg8::bf16_t; using pg8::bf16x8; using pg8::f32x4; using pg8::u32x4; using pg8::cvt_pk_bf16; using pg8::cvt_pk_nv;
#define LAS PG8_LAS

constexpr int D = 2048, SEQ = 2048, MTOK = 16384, DFF = 8192, INWP = 4352;
constexpr int COL_K = 1024, COL_V = 1280, COL_Z = 1536, COL_XBC = 2560, COL_DT = 4096;
constexpr size_t MiB = (size_t)1 << 20;
constexpr size_t WS_WBA = 0, WS_WMLP = 40 * MiB, WS_H = 104 * MiB, WS_PROJ = 168 * MiB, WS_YMIX = 304 * MiB, WS_YRAW = 368 * MiB, WS_XBC = 432 * MiB,
                 WS_DT = 480 * MiB, WS_DA = 481 * MiB, WS_ROPE = 482 * MiB, WS_U = 168 * MiB;
constexpr size_t WS_R = 40 * MiB, WS_K = 104 * MiB, WS_V = 168 * MiB, WS_L1W = 232 * MiB, WS_L1A = 240 * MiB, WS_L1G = 248 * MiB, WS_MIX = 256 * MiB,
                 WS_WDEC = 256 * MiB, WS_AA = 320 * MiB, WS_GG = 384 * MiB, WS_YG = 40 * MiB  , WS_WMLP1 = 448 * MiB;
constexpr size_t WS_BAR = 39 * MiB;
constexpr int LDS_BYTES = 140 * 1024;

enum { K_PRE0 = 0, K_GEMMB, K_GEMMF, K_CONVSSD, K_MIX0, K_POST0, K_NORM, K_PRE1, K_MIXES, K_RWKV, K_NORMCONV };
constexpr int NSTEPS = 48, NOPS = 22, NCJ = 16;
#define REP_GEMMB 1
#define REP_MIX0 1
#define REP_RWKV 1
#define REP_ELEM 1

struct GemmOp { const bf16_t* A; const bf16_t* Bt; void* out; const float* bias; const float* res; int M, N, K, ldc, act, rot, pad0, pad1; };
struct ConvJob { const float* src; bf16_t* dst; int K, N, Kpad, Npad, tile0, ntiles; };
struct Params {
    const float* in[34];
    float* out; unsigned char* ws;
    GemmOp g[NOPS];
    ConvJob cj[NCJ];
    int kind[NSTEPS + 1]; int lo[NSTEPS + 1]; int hi[NSTEPS + 1]; int clo[NSTEPS + 1]; int chi[NSTEPS + 1]; int cq[NSTEPS + 1];
    int step_lo, step_hi;
};

__device__ __forceinline__ float bf2f(unsigned short b) { return __uint_as_float(((unsigned)b) << 16); }
__device__ __forceinline__ float bflo(unsigned w) { return __uint_as_float(w << 16); }
__device__ __forceinline__ float bfhi(unsigned w) { return __uint_as_float(w & 0xffff0000u); }
__device__ __forceinline__ bf16_t f2bf(float f) { return (bf16_t)(cvt_pk_bf16(f, 0.f) & 0xffffu); }
template <int CTRL> __device__ __forceinline__ float dpp_add(float x) {
    const int y = __builtin_amdgcn_update_dpp(0, __builtin_bit_cast(int, x), CTRL, 0xf, 0xf, true);
    return x + __builtin_bit_cast(float, y); }
template <int CTRL> __device__ __forceinline__ float dpp_max(float x) {
    const int y = __builtin_amdgcn_update_dpp(0, __builtin_bit_cast(int, x), CTRL, 0xf, 0xf, true);
    return fmaxf(x, __builtin_bit_cast(float, y)); }
__device__ __forceinline__ float max16(float x) { x = dpp_max<0xB1>(x); x = dpp_max<0x4E>(x); x = dpp_max<0x141>(x); x = dpp_max<0x140>(x); return x; }
__device__ __forceinline__ float red8(float x) { x = dpp_add<0xB1>(x); x = dpp_add<0x4E>(x); x = dpp_add<0x141>(x); return x; }
__device__ __forceinline__ float red16(float x) { x = red8(x); x = dpp_add<0x140>(x); return x; }
__device__ __forceinline__ float wave_sum(float v) {
    v = red16(v);
    const float r0 = __builtin_bit_cast(float, __builtin_amdgcn_readlane(__builtin_bit_cast(int, v), 0)), r1 = __builtin_bit_cast(float, __builtin_amdgcn_readlane(__builtin_bit_cast(int, v), 16));
    const float r2 = __builtin_bit_cast(float, __builtin_amdgcn_readlane(__builtin_bit_cast(int, v), 32)), r3 = __builtin_bit_cast(float, __builtin_amdgcn_readlane(__builtin_bit_cast(int, v), 48));
    return (r0 + r1) + (r2 + r3); }
typedef float f32x2 __attribute__((ext_vector_type(2)));
typedef unsigned u32x2 __attribute__((ext_vector_type(2)));
__device__ __forceinline__ float sigmoidf_(float v) { return __builtin_amdgcn_rcpf(1.0f + __expf(-v)); }
__device__ __forceinline__ void unpack8(const uint4 r, float (&f)[8]) {
    f[0] = bflo(r.x); f[1] = bfhi(r.x); f[2] = bflo(r.y); f[3] = bfhi(r.y); f[4] = bflo(r.z); f[5] = bfhi(r.z); f[6] = bflo(r.w); f[7] = bfhi(r.w); }

__device__ __forceinline__ float act_apply(float v, int act) {
    switch (act) {
        case 1: { const float r = fmaxf(v, 0.f); return r * r; }
        case 2: return 1.0f - 2.0f * __builtin_amdgcn_rcpf(1.0f + __expf(2.0f * v));
        case 3: return sigmoidf_(v);
        case 4: return 0.60653066f * sigmoidf_(v);
        default: return v; }
}
struct EpiB {
    static constexpr bool PERM = true, AFTER_DRAIN = false;
    const GemmOp* ops;
    template <int MODE  >
    __device__ __forceinline__ void body(const f32x4 (&acc)[2][2][4][2], bf16_t* O, int ldc, const float* bias, int act, int row0, int col0) const {
        f32x4 bv[2][2];
        if (MODE == 2) {
#pragma unroll
            for (int bj = 0; bj < 2; ++bj)
#pragma unroll
                for (int n = 0; n < 2; ++n) bv[bj][n] = bias ? *(const f32x4*)(bias + col0 + bj * 128 + 4 * n) : (f32x4){0.f, 0.f, 0.f, 0.f}; }
#pragma unroll
        for (int ai = 0; ai < 2; ++ai)
#pragma unroll
            for (int m = 0; m < 4; ++m) { bf16_t* rowp = O + (size_t)(row0 + ai * 128 + m * 16) * ldc + col0;
#pragma unroll
                for (int bj = 0; bj < 2; ++bj) { f32x4 v0 = acc[ai][bj][m][0], v1 = acc[ai][bj][m][1];
                    if (MODE == 1) {
#pragma unroll
                        for (int j = 0; j < 4; ++j) { const float a0 = fmaxf(v0[j], 0.f), a1 = fmaxf(v1[j], 0.f); v0[j] = a0 * a0; v1[j] = a1 * a1; } }
                    if (MODE == 2) { v0 += bv[bj][0]; v1 += bv[bj][1];
                        if (act) {
#pragma unroll
                            for (int j = 0; j < 4; ++j) { v0[j] = act_apply(v0[j], act); v1[j] = act_apply(v1[j], act); } } }
                    u32x4 w; w.x = cvt_pk_bf16(v0[0], v0[1]); w.y = cvt_pk_bf16(v0[2], v0[3]); w.z = cvt_pk_bf16(v1[0], v1[1]); w.w = cvt_pk_bf16(v1[2], v1[3]);
                    *(u32x4*)(rowp + bj * 128) = w; } }
    }
    __device__ __forceinline__ void operator()(const f32x4 (&acc)[2][2][4][2], const pg8::Unit& u, int wr, int wc, int fr, int fq) const {
        const GemmOp& o_ = ops[u.op]; bf16_t* O = (bf16_t*)o_.out; const int ldc = o_.ldc; const float* bias = o_.bias; const int act = o_.act;
        const int row0 = u.pm * 256 + wr * 64 + fr, col0 = u.pn * 256 + wc * 32 + 8 * fq;
        if (act == 0 && bias == nullptr) body<0>(acc, O, ldc, bias, act, row0, col0);
        else if (act == 1 && bias == nullptr) body<1>(acc, O, ldc, bias, act, row0, col0);
        else body<2>(acc, O, ldc, bias, act, row0, col0);
    }
};

struct MultiOrder {
    const GemmOp* ops; int nops, G, c;
    __device__ __forceinline__ bool next(int i, pg8::Unit& u) const {
        long L = (long)i * G + c; int k = 0, nM = 0, nN = 0, nwg = 0;
        for (; k < nops; ++k) { nM = ops[k].M / 256; nN = ops[k].N / 256; nwg = nM * nN; if (L < nwg) break; L -= nwg; }
        if (k == nops) return false;
        int wgid = (int)L; { const int q = nwg / pg8::NXCD, r = nwg % pg8::NXCD, xcd = wgid % pg8::NXCD, off = wgid / pg8::NXCD; wgid = (xcd < r ? xcd * (q + 1) : r * (q + 1) + (xcd - r) * q) + off; }
        const int nig = pg8::WGM * nN, gid = wgid / nig, fm = gid * pg8::WGM, gsz = (nM - fm) < pg8::WGM ? (nM - fm) : pg8::WGM;
        u.pm = fm + ((wgid % nig) % gsz); u.pn = (wgid % nig) / gsz; u.op = k; return true;
    }
    __device__ __forceinline__ const char* abase(const pg8::Unit& u, const pg8::Gemm&) const { return (const char*)ops[u.op].A; }
    __device__ __forceinline__ const char* bbase(const pg8::Unit& u, const pg8::Gemm&) const { return (const char*)ops[u.op].Bt; }
    __device__ __forceinline__ void a_ready(const pg8::Unit&) const {}
    __device__ __forceinline__ void done(const pg8::Unit&) const {}
};
struct EpiF {
    static constexpr bool PERM = false, AFTER_DRAIN = false;
    float* C; int ldc; const float* res;
    __device__ __forceinline__ void operator()(const f32x4 (&acc)[2][2][4][2], const pg8::Unit& u, int wr, int wc, int fr, int fq) const {
        const int row0 = u.pm * 256 + wr * 64 + fr, col0 = u.pn * 256 + wc * 32 + 4 * fq;
#pragma unroll
        for (int ai = 0; ai < 2; ++ai)
#pragma unroll
            for (int mh = 0; mh < 2; ++mh) { size_t ro[2]; f32x4 r[2][2][2];
#pragma unroll
                for (int mm = 0; mm < 2; ++mm) { ro[mm] = (size_t)(row0 + ai * 128 + (mh * 2 + mm) * 16) * ldc + col0;
#pragma unroll
                    for (int bj = 0; bj < 2; ++bj)
#pragma unroll
                        for (int n = 0; n < 2; ++n) r[mm][bj][n] = *(const f32x4*)(res + ro[mm] + bj * 128 + n * 16); }
#pragma unroll
                for (int mm = 0; mm < 2; ++mm)
#pragma unroll
                    for (int bj = 0; bj < 2; ++bj)
#pragma unroll
                        for (int n = 0; n < 2; ++n) *(f32x4*)(C + ro[mm] + bj * 128 + n * 16) = acc[ai][bj][mh * 2 + mm][n] + r[mm][bj][n]; }
    }
};

__device__ __forceinline__ void convert_one_tile(const Params& p, int jlo, int jhi, int tile, int tid, LAS float* T) {
    int j = jlo; while (j + 1 < jhi && tile >= p.cj[j + 1].tile0) ++j;
    const float* src = p.cj[j].src; bf16_t* dst = p.cj[j].dst; const int K = p.cj[j].K, N = p.cj[j].N, Kpad = p.cj[j].Kpad;
    const int local = tile - p.cj[j].tile0, nkt = Kpad >> 6, kt = local % nkt, nt = local / nkt;
    f32x4 v[8];
#pragma unroll
    for (int i = 0; i < 8; ++i) { const int idx = tid + i * 512, kr = idx >> 6, c4 = idx & 63, k = kt * 64 + kr, n = nt * 256 + c4 * 4;
        v[i] = (f32x4){0.f, 0.f, 0.f, 0.f};
        if (k < K && n < N) v[i] = *(const f32x4*)(src + (size_t)k * N + n); }
#pragma unroll
    for (int i = 0; i < 8; ++i) { const int idx = tid + i * 512, kr = idx >> 6, c4 = idx & 63;
        T[kr * 257 + c4 * 4 + 0] = v[i][0]; T[kr * 257 + c4 * 4 + 1] = v[i][1]; T[kr * 257 + c4 * 4 + 2] = v[i][2]; T[kr * 257 + c4 * 4 + 3] = v[i][3]; }
    __syncthreads();
#pragma unroll
    for (int i = 0; i < 4; ++i) { const int idx = tid + i * 512, nl = idx >> 3, kc = idx & 7; float f[8];
#pragma unroll
        for (int e = 0; e < 8; ++e) f[e] = T[(kc * 8 + e) * 257 + nl];
        u32x4 w; w.x = cvt_pk_nv(f[0], f[1]); w.y = cvt_pk_nv(f[2], f[3]); w.z = cvt_pk_nv(f[4], f[5]); w.w = cvt_pk_nv(f[6], f[7]);
        *(u32x4*)(dst + (size_t)(nt * 256 + nl) * Kpad + kt * 64 + kc * 8) = w; }
    __syncthreads();
}
__device__ __forceinline__ void convert_tiles(const Params& p, int jlo, int jhi, LAS unsigned char* lds) {
    const int tid = opq(threadIdx.x); LAS float* T = (LAS float*)lds;
    const int total = p.cj[jhi - 1].tile0 + p.cj[jhi - 1].ntiles;
    for (int tile = blockIdx.x; tile < total; tile += gridDim.x) convert_one_tile(p, jlo, jhi, tile, tid, T);
}
__device__ __forceinline__ void convert_queue(const Params& p, int jlo, int jhi, unsigned* counter, LAS unsigned char* lds) {
    const int tid = opq(threadIdx.x); LAS float* T = (LAS float*)lds; LAS int* slot = (LAS int*)(lds + 72 * 1024);
    const int total = p.cj[jhi - 1].tile0 + p.cj[jhi - 1].ntiles;
    for (;;) {
        __syncthreads();
        if (tid == 0) *slot = (int)__hip_atomic_fetch_add(counter, 1u, __ATOMIC_RELAXED, __HIP_MEMORY_SCOPE_AGENT);
        __syncthreads();
        const int tile = *slot;
        if (tile >= total) break;
        convert_one_tile(p, jlo, jhi, tile, tid, T);
    }
}

__device__ __forceinline__ void rope_table(const Params& p) {
    float2* tab = (float2*)(p.ws + WS_ROPE);
    for (int idx = blockIdx.x * 512 + opq(threadIdx.x); idx < SEQ * 32; idx += gridDim.x * 512) {
        const int t = idx >> 5, i = idx & 31;
        const float inv = exp2f(-(float)i * 0.41524101186092029f);
        const float angf = (float)t * inv;
        const double ang = (double)angf;
        const double q = rint(ang * 0.6366197723675814);
        const float f = (float)fma(-q, 1.5707963267948966, ang), f2 = f * f;
        const float s = f * (1.0f + f2 * (-1.6666667e-1f + f2 * (8.3333333e-3f + f2 * (-1.9841270e-4f + f2 * 2.7557319e-6f))));
        const float c = 1.0f + f2 * (-0.5f + f2 * (4.1666667e-2f + f2 * (-1.3888889e-3f + f2 * (2.4801587e-5f + f2 * (-2.7557319e-7f)))));
        const int qi = ((int)q) & 3;
        const float sn = (qi == 0) ? s : (qi == 1) ? c : (qi == 2) ? -s : -c;
        const float cs = (qi == 0) ? c : (qi == 1) ? -s : (qi == 2) ? -c : s;
        tab[idx] = make_float2(cs, sn);
    }
}

__device__ __forceinline__ void norm_rows(const float* x, const float* g, bf16_t* h) {
    const int tid_ = opq(threadIdx.x); const int lane = tid_ & 63, wv = tid_ >> 6;
    f32x4 gg[8];
#pragma unroll
    for (int i = 0; i < 8; ++i) gg[i] = *(const f32x4*)(g + i * 256 + lane * 4);
    for (int row = (blockIdx.x * 8 + wv) * 2; row < MTOK; row += gridDim.x * 16) {
        const float* xr = x + (size_t)row * D; f32x4 v[8], u[8]; float ss = 0.f, st = 0.f;
#pragma unroll
        for (int i = 0; i < 8; ++i) { v[i] = *(const f32x4*)(xr + i * 256 + lane * 4); u[i] = *(const f32x4*)(xr + D + i * 256 + lane * 4); }
#pragma unroll
        for (int i = 0; i < 8; ++i) { ss += v[i][0] * v[i][0] + v[i][1] * v[i][1] + v[i][2] * v[i][2] + v[i][3] * v[i][3]; st += u[i][0] * u[i][0] + u[i][1] * u[i][1] + u[i][2] * u[i][2] + u[i][3] * u[i][3]; }
        ss = wave_sum(ss); st = wave_sum(st); const float r = rsqrtf(ss * (1.0f / D) + 1e-6f), r2 = rsqrtf(st * (1.0f / D) + 1e-6f);
#pragma unroll
        for (int i = 0; i < 8; ++i) {
            uint2 w; w.x = cvt_pk_nv(v[i][0] * r * gg[i][0], v[i][1] * r * gg[i][1]); w.y = cvt_pk_nv(v[i][2] * r * gg[i][2], v[i][3] * r * gg[i][3]);
            *(uint2*)(h + (size_t)row * D + i * 256 + lane * 4) = w;
            uint2 w2; w2.x = cvt_pk_nv(u[i][0] * r2 * gg[i][0], u[i][1] * r2 * gg[i][1]); w2.y = cvt_pk_nv(u[i][2] * r2 * gg[i][2], u[i][3] * r2 * gg[i][3]);
            *(uint2*)(h + (size_t)(row + 1) * D + i * 256 + lane * 4) = w2; }
    }
}

__device__ __forceinline__ void mix_rows(const float* x, const float* g, const float* mixw, bf16_t* mixbase, int tok0, LAS unsigned char* lds) {
    const int tid = opq(threadIdx.x), lane = tid & 63, wv = tid >> 6, c = tid * 4;
    LAS float* rs = (LAS float*)lds;
    const f32x4 gg = *(const f32x4*)(g + c); f32x4 mw[6];
#pragma unroll
    for (int m = 0; m < 6; ++m) mw[m] = *(const f32x4*)(mixw + m * D + c);
    for (int chunk = blockIdx.x; chunk < 256; chunk += gridDim.x) {
        const int rl0 = chunk * 32, tokc = tok0 + rl0; const bool hasprev = (tokc & (SEQ - 1)) != 0;
        __syncthreads();
        for (int r = wv; r < 33; r += 8) {
            float ss = 0.f;
            if (r > 0 || hasprev) { const float* xr = x + (size_t)(tokc - 1 + r) * D; f32x4 v[8];
#pragma unroll
                for (int i = 0; i < 8; ++i) v[i] = *(const f32x4*)(xr + i * 256 + lane * 4);
#pragma unroll
                for (int i = 0; i < 8; ++i) ss += v[i][0] * v[i][0] + v[i][1] * v[i][1] + v[i][2] * v[i][2] + v[i][3] * v[i][3]; }
            ss = wave_sum(ss);
            if (lane == 0) rs[r] = (r > 0 || hasprev) ? rsqrtf(ss * (1.0f / D) + 1e-6f) : 0.f;
        }
        __syncthreads();
        f32x4 prev = (f32x4){0.f, 0.f, 0.f, 0.f};
        if (hasprev) { const f32x4 pv = *(const f32x4*)(x + (size_t)(tokc - 1) * D + c); const float rp = rs[0]; prev = pv * rp * gg; }
        for (int r0 = 0; r0 < 32; r0 += 4) {
            f32x4 xv[4];
#pragma unroll
            for (int u = 0; u < 4; ++u) xv[u] = *(const f32x4*)(x + (size_t)(tokc + r0 + u) * D + c);
#pragma unroll
            for (int u = 0; u < 4; ++u) { const float rr = rs[r0 + u + 1]; const f32x4 hn = xv[u] * rr * gg, xx = prev - hn;
#pragma unroll
                for (int m = 0; m < 6; ++m) { const f32x4 o = hn + xx * mw[m];
                    uint2 w; w.x = cvt_pk_nv(o[0], o[1]); w.y = cvt_pk_nv(o[2], o[3]);
                    *(uint2*)(mixbase + (size_t)m * 8192 * D + (size_t)(rl0 + r0 + u) * D + c) = w; }
                prev = hn; }
        }
    }
}

__device__ __forceinline__ void conv_ssd(const Params& p) {
    const bf16_t* proj = (const bf16_t*)(p.ws + WS_PROJ); bf16_t* xbc = (bf16_t*)(p.ws + WS_XBC);
    const float* cw = p.in[6]; const float* cb = p.in[7];
    const int tid = opq(threadIdx.x);
    if (tid < 384) {
        const int c8 = tid % 192, par = tid / 192, c = c8 * 8;
        float w[4][8], bb[8];
#pragma unroll
        for (int j = 0; j < 4; ++j) { const f32x4 w0 = *(const f32x4*)(cw + j * 1536 + c), w1 = *(const f32x4*)(cw + j * 1536 + c + 4);
#pragma unroll
            for (int e = 0; e < 4; ++e) { w[j][e] = w0[e]; w[j][4 + e] = w1[e]; } }
        { const f32x4 b0 = *(const f32x4*)(cb + c), b1 = *(const f32x4*)(cb + c + 4);
#pragma unroll
          for (int e = 0; e < 4; ++e) { bb[e] = b0[e]; bb[4 + e] = b1[e]; } }
        for (int chunk = blockIdx.x; chunk < 256; chunk += gridDim.x) {
            const int t0 = chunk * 64 + par * 32; const bool hasprev = (t0 & (SEQ - 1)) != 0;
            float r0[8], r1[8], r2[8];
            if (hasprev) { const uint4 a = *(const uint4*)(proj + (size_t)(t0 - 3) * INWP + COL_XBC + c), b = *(const uint4*)(proj + (size_t)(t0 - 2) * INWP + COL_XBC + c), d = *(const uint4*)(proj + (size_t)(t0 - 1) * INWP + COL_XBC + c);
                unpack8(a, r0); unpack8(b, r1); unpack8(d, r2); }
            else {
#pragma unroll
                for (int e = 0; e < 8; ++e) { r0[e] = 0.f; r1[e] = 0.f; r2[e] = 0.f; } }
            for (int tg = 0; tg < 32; tg += 4) {
                uint4 rw[4];
#pragma unroll
                for (int u = 0; u < 4; ++u) rw[u] = *(const uint4*)(proj + (size_t)(t0 + tg + u) * INWP + COL_XBC + c);
#pragma unroll
                for (int u = 0; u < 4; ++u) { float cur[8], acc[8]; unpack8(rw[u], cur);
#pragma unroll
                    for (int e = 0; e < 8; ++e) { acc[e] = bb[e] + w[0][e] * r0[e] + w[1][e] * r1[e] + w[2][e] * r2[e] + w[3][e] * cur[e]; acc[e] = acc[e] * sigmoidf_(acc[e]); r0[e] = r1[e]; r1[e] = r2[e]; r2[e] = cur[e]; }
                    u32x4 o; o.x = cvt_pk_nv(acc[0], acc[1]); o.y = cvt_pk_nv(acc[2], acc[3]); o.z = cvt_pk_nv(acc[4], acc[5]); o.w = cvt_pk_nv(acc[6], acc[7]);
                    *(u32x4*)(xbc + (size_t)(t0 + tg + u) * 1536 + c) = o; }
            }
        }
    }
    float* dt = (float*)(p.ws + WS_DT); float* da = (float*)(p.ws + WS_DA);
    for (int idx = blockIdx.x * 512 + opq(threadIdx.x); idx < MTOK * 16; idx += gridDim.x * 512) {
        const int tok = idx >> 4, hh = idx & 15;
        const float v = bf2f(proj[(size_t)tok * INWP + COL_DT + hh]) + p.in[8][hh];
        const float d = fmaxf(v, 0.f) + __logf(1.0f + __expf(-fabsf(v)));
        dt[idx] = d; da[idx] = __expf(-d * __expf(p.in[9][hh]));
    }
}

__device__ __forceinline__ void ssd_scan_job(const Params& p, int job, LAS unsigned char* lds) {
    const int tid = opq(threadIdx.x);
    const int b = job >> 5, hs = (job >> 1) & 15, half = job & 1, grp = hs >> 3, p0 = half * 32;
    const bf16_t* xbc = (const bf16_t*)(p.ws + WS_XBC) + (size_t)b * SEQ * 1536;
    const float* dtp = (const float*)(p.ws + WS_DT) + (size_t)b * SEQ * 16 + hs;
    const float* dap = (const float*)(p.ws + WS_DA) + (size_t)b * SEQ * 16 + hs;
    float* yraw = (float*)(p.ws + WS_YRAW) + (size_t)b * SEQ * 1024 + hs * 64 + p0;
    const float dskip = p.in[10][hs];
    constexpr int BUF_F = 9280;
    LAS float* L = (LAS float*)lds;
    const bool producer = tid >= 256; const int ptid = tid & 255;
    int grow[5], gcol[5], loff[5];
#pragma unroll
    for (int k = 0; k < 5; ++k) { const int q = ptid + k * 256, row = q / 36, pc = q - row * 36; grow[k] = row;
        if (pc < 4) { gcol[k] = hs * 64 + p0 + pc * 8; loff[k] = row * 32 + pc * 8; }
        else if (pc < 20) { gcol[k] = 1024 + grp * 128 + (pc - 4) * 8; loff[k] = 1024 + row * 128 + (pc - 4) * 8; }
        else { gcol[k] = 1280 + grp * 128 + (pc - 20) * 8; loff[k] = 5120 + row * 128 + (pc - 20) * 8; } }
    uint4 rg[5]; float sc = 0.f;
#define SSD_ISSUE(t0) do { _Pragma("unroll") for (int k = 0; k < 5; ++k) if (ptid + k * 256 < 1152) rg[k] = *(const uint4*)(xbc + (size_t)((t0) + grow[k]) * 1536 + gcol[k]); \
        if (ptid < 32) sc = dtp[((t0) + ptid) * 16]; else if (ptid < 64) sc = dap[((t0) + ptid - 32) * 16]; } while (0)
#define SSD_COMMIT(buf) do { LAS float* Lc = L + (buf) * BUF_F; _Pragma("unroll") for (int k = 0; k < 5; ++k) if (ptid + k * 256 < 1152) { float f[8]; unpack8(rg[k], f); \
            *(LAS f32x4*)(Lc + loff[k]) = (f32x4){f[0], f[1], f[2], f[3]}; *(LAS f32x4*)(Lc + loff[k] + 4) = (f32x4){f[4], f[5], f[6], f[7]}; } \
        if (ptid < 32) Lc[9216 + ptid] = sc; else if (ptid < 64) Lc[9248 + ptid - 32] = sc; } while (0)
#define SSD_FLUSH(chp) do { LAS float* yo = L + 2 * BUF_F + ((chp) & 1) * 1024; const f32x4 v = *(LAS f32x4*)(yo + (ptid >> 3) * 32 + (ptid & 7) * 4); \
        *(f32x4*)(yraw + (size_t)((chp) * 32 + (ptid >> 3)) * 1024 + (ptid & 7) * 4) = v; } while (0)
    f32x2 hA[4], hB[4];
#pragma unroll
    for (int i = 0; i < 4; ++i) { hA[i] = (f32x2){0.f, 0.f}; hB[i] = (f32x2){0.f, 0.f}; }
    const int prow = (tid >> 4) & 15, nseg = tid & 15;
    __syncthreads();
    if (producer) { SSD_ISSUE(0); SSD_COMMIT(0); SSD_ISSUE(32); }
    __syncthreads();
    for (int ch = 0; ch < 64; ++ch) {
        const int cur = ch & 1;
        if (producer) {
            if (ch >= 1) SSD_FLUSH(ch - 1);
            if (ch + 1 < 64) SSD_COMMIT(cur ^ 1);
            if (ch + 2 < 64) SSD_ISSUE((ch + 2) * 32);
        } else {
        LAS float* Lb = L + cur * BUF_F; LAS float* yb = L + 2 * BUF_F + cur * 1024;
        for (int tg = 0; tg < 32; tg += 16) {
            float yA[16], yB[16];
            LAS float* qb = Lb + 1024 + tg * 128 + nseg * 8;
            f32x4 b0 = *(LAS f32x4*)(qb), b1 = *(LAS f32x4*)(qb + 4), c0 = *(LAS f32x4*)(qb + 4096), c1 = *(LAS f32x4*)(qb + 4100);
            float dA = Lb[9248 + tg], xa = Lb[tg * 32 + prow], xb = Lb[tg * 32 + prow + 16], dtv = Lb[9216 + tg];
#pragma unroll
            for (int tt = 0; tt < 16; ++tt) {
                f32x4 nb0, nb1, nc0, nc1; float ndA, nxa, nxb, ndtv;
                if (tt + 1 < 16) { LAS float* q = qb + (tt + 1) * 128; nb0 = *(LAS f32x4*)(q); nb1 = *(LAS f32x4*)(q + 4); nc0 = *(LAS f32x4*)(q + 4096); nc1 = *(LAS f32x4*)(q + 4100);
                    ndA = Lb[9248 + tg + tt + 1]; nxa = Lb[(tg + tt + 1) * 32 + prow]; nxb = Lb[(tg + tt + 1) * 32 + prow + 16]; ndtv = Lb[9216 + tg + tt + 1]; }
                __builtin_amdgcn_sched_barrier(0);
                const float xdta = xa * dtv, xdtb = xb * dtv;
                const f32x2 dA2 = (f32x2){dA, dA}, xa2 = (f32x2){xdta, xdta}, xb2 = (f32x2){xdtb, xdtb};
                hA[0] = hA[0] * dA2 + xa2 * b0.xy; hB[0] = hB[0] * dA2 + xb2 * b0.xy; hA[1] = hA[1] * dA2 + xa2 * b0.zw; hB[1] = hB[1] * dA2 + xb2 * b0.zw;
                hA[2] = hA[2] * dA2 + xa2 * b1.xy; hB[2] = hB[2] * dA2 + xb2 * b1.xy; hA[3] = hA[3] * dA2 + xa2 * b1.zw; hB[3] = hB[3] * dA2 + xb2 * b1.zw;
                f32x2 ya = hA[0] * c0.xy, yb2 = hB[0] * c0.xy; ya = hA[1] * c0.zw + ya; yb2 = hB[1] * c0.zw + yb2; ya = hA[2] * c1.xy + ya; yb2 = hB[2] * c1.xy + yb2; ya = hA[3] * c1.zw + ya; yb2 = hB[3] * c1.zw + yb2;
                float ra = ya.x + ya.y, rb = yb2.x + yb2.y;
                ra = dpp_add<0xB1>(ra); rb = dpp_add<0xB1>(rb); ra = dpp_add<0x4E>(ra); rb = dpp_add<0x4E>(rb); ra = dpp_add<0x141>(ra); rb = dpp_add<0x141>(rb); ra = dpp_add<0x140>(ra); rb = dpp_add<0x140>(rb);
                yA[tt] = ra + dskip * xa; yB[tt] = rb + dskip * xb;
                __builtin_amdgcn_sched_barrier(0);
                if (tt + 1 < 16) { b0 = nb0; b1 = nb1; c0 = nc0; c1 = nc1; dA = ndA; xa = nxa; xb = nxb; dtv = ndtv; }
            }
            if (nseg == 0) {
#pragma unroll
                for (int tt = 0; tt < 16; ++tt) { yb[(tg + tt) * 32 + prow] = yA[tt]; yb[(tg + tt) * 32 + prow + 16] = yB[tt]; } }
        }
        }
        __syncthreads();
    }
    if (producer) SSD_FLUSH(63);
#undef SSD_ISSUE
#undef SSD_COMMIT
#undef SSD_FLUSH
}

__device__ __forceinline__ void ssd_chunk_job(const Params& p, int job, LAS unsigned char* lds) {
    const int tid = opq(threadIdx.x), lane = tid & 63, w = tid >> 6, fr = lane & 15, fq = lane >> 4;
    const int b = job >> 5, hs = (job >> 1) & 15, half = job & 1, grp = hs >> 3, p0 = half * 32;
    const bf16_t* xbc = (const bf16_t*)(p.ws + WS_XBC) + (size_t)b * SEQ * 1536;
    const float* dtp = (const float*)(p.ws + WS_DT) + (size_t)b * SEQ * 16 + hs;
    float* yraw = (float*)(p.ws + WS_YRAW) + (size_t)b * SEQ * 1024 + hs * 64 + p0;
    const float dskip = p.in[10][hs], Ah = -__expf(p.in[9][hs]);
    constexpr int RS = 136;
    LAS bf16_t* Cs = (LAS bf16_t*)lds;
    LAS bf16_t* Bs = (LAS bf16_t*)(lds + 34816);
    LAS bf16_t* BTs = (LAS bf16_t*)(lds + 69632);
    LAS bf16_t* XTa = (LAS bf16_t*)(lds + 104448);
    LAS bf16_t* XTb = (LAS bf16_t*)(lds + 113152);
    LAS bf16_t* Ps = (LAS bf16_t*)(lds + 121856);
    LAS float* af = (LAS float*)(lds + 130560);
    LAS float* dtf = (LAS float*)(lds + 131584);
    const int crow0 = tid >> 4, cpc = tid & 15;
    const int xk = tid >> 2, xpc = tid & 3;
    u32x4 rc[4], rb[4], rx; float rdt = 0.f;
#define SC_ISSUE(t0) do { _Pragma("unroll") for (int i = 0; i < 4; ++i) { const bf16_t* rp_ = xbc + (size_t)((t0) + (crow0 + 32 * i)) * 1536 + grp * 128 + cpc * 8; rb[i] = *(const u32x4*)(rp_ + 1024); rc[i] = *(const u32x4*)(rp_ + 1280); } \
        rx = *(const u32x4*)(xbc + (size_t)((t0) + xk) * 1536 + hs * 64 + p0 + xpc * 8); if (tid < 128) rdt = dtp[((t0) + tid) * 16]; } while (0)
    f32x4 st[2];
    st[0] = (f32x4){0.f, 0.f, 0.f, 0.f}; st[1] = st[0];
    __syncthreads();
    for (int i = tid; i < 32 * RS / 2; i += 512) ((LAS unsigned*)Ps)[i] = 0u;
    SC_ISSUE(0);
    for (int ch = 0; ch < 16; ++ch) {
        const int t0 = ch * 128;
        __syncthreads();
#pragma unroll
        for (int i = 0; i < 4; ++i) { *(LAS u32x4*)(Cs + (crow0 + 32 * i) * RS + cpc * 8) = rc[i]; *(LAS u32x4*)(Bs + (crow0 + 32 * i) * RS + cpc * 8) = rb[i];

#pragma unroll
            for (int e = 0; e < 4; ++e) { BTs[(cpc * 8 + 2 * e) * RS + (crow0 + 32 * i)] = (bf16_t)(rb[i][e] & 0xffffu); BTs[(cpc * 8 + 2 * e + 1) * RS + (crow0 + 32 * i)] = (bf16_t)(rb[i][e] >> 16); } }
        float csv = 0.f;
        if (tid < 128) {
            csv = rdt * Ah; dtf[tid] = rdt;
#pragma unroll
            for (int off = 1; off < 64; off <<= 1) { const float t_ = __shfl_up(csv, off); if (lane >= off) csv += t_; }
            if (tid == 63) af[128] = csv;
        }
        float xr[8]; xr[0] = bflo(rx[0]); xr[1] = bfhi(rx[0]); xr[2] = bflo(rx[1]); xr[3] = bfhi(rx[1]); xr[4] = bflo(rx[2]); xr[5] = bfhi(rx[2]); xr[6] = bflo(rx[3]); xr[7] = bfhi(rx[3]);
        __syncthreads();
        if (tid < 128) af[tid] = (tid >= 64) ? csv + af[128] : csv;
        __syncthreads();
        const float cs_last = af[127];
        { const float d = dtf[xk], dout = __expf(cs_last - af[xk]);
#pragma unroll
          for (int e = 0; e < 8; ++e) { const float xa = xr[e] * d; XTa[(xpc * 8 + e) * RS + xk] = f2bf(xa); XTb[(xpc * 8 + e) * RS + xk] = f2bf(xa * dout); } }
        __syncthreads();
        bf16x8 cf[4];
#pragma unroll
        for (int ks = 0; ks < 4; ++ks) cf[ks] = *(LAS bf16x8*)(Cs + (w * 16 + fr) * RS + ks * 32 + fq * 8);
        f32x4 yo[2];
#pragma unroll
        for (int pt = 0; pt < 2; ++pt) { f32x4 acc = (f32x4){0.f, 0.f, 0.f, 0.f};
#pragma unroll
            for (int ks = 0; ks < 4; ++ks) { const bf16x8 pb = *(LAS bf16x8*)(Ps + (pt * 16 + fr) * RS + ks * 32 + fq * 8); acc = __builtin_amdgcn_mfma_f32_16x16x32_bf16(cf[ks], pb, acc, 0, 0, 0); }
            yo[pt] = acc; }
        float csq[4];
#pragma unroll
        for (int i = 0; i < 4; ++i) csq[i] = af[w * 16 + fq * 4 + i];
#pragma unroll
        for (int kt = 0; kt < 8; ++kt) { f32x4 acc = (f32x4){0.f, 0.f, 0.f, 0.f};
            if (kt > w) {
#pragma unroll
                for (int i = 0; i < 4; ++i) Cs[(w * 16 + fq * 4 + i) * RS + kt * 16 + fr] = (bf16_t)0;
                continue; }
#pragma unroll
            for (int ks = 0; ks < 4; ++ks) { const bf16x8 bb = *(LAS bf16x8*)(Bs + (kt * 16 + fr) * RS + ks * 32 + fq * 8); acc = __builtin_amdgcn_mfma_f32_16x16x32_bf16(cf[ks], bb, acc, 0, 0, 0); }
            const int kk = kt * 16 + fr; const float csk = af[kk];
#pragma unroll
            for (int i = 0; i < 4; ++i) { const int qq = w * 16 + fq * 4 + i; const float m = (kk <= qq) ? acc[i] * __expf(csq[i] - csk) : 0.f; Cs[qq * RS + kk] = f2bf(m); } }
        f32x4 yd[2];
        { bf16x8 mf[4];
#pragma unroll
          for (int ks = 0; ks < 4; ++ks) mf[ks] = *(LAS bf16x8*)(Cs + (w * 16 + fr) * RS + ks * 32 + fq * 8);
#pragma unroll
          for (int pt = 0; pt < 2; ++pt) { f32x4 acc = (f32x4){0.f, 0.f, 0.f, 0.f};
#pragma unroll
              for (int ks = 0; ks < 4; ++ks) { const bf16x8 xb = *(LAS bf16x8*)(XTa + (pt * 16 + fr) * RS + ks * 32 + fq * 8); acc = __builtin_amdgcn_mfma_f32_16x16x32_bf16(mf[ks], xb, acc, 0, 0, 0); }
              yd[pt] = acc; } }
        if (ch + 1 < 16) SC_ISSUE(t0 + 128);
#pragma unroll
        for (int pt = 0; pt < 2; ++pt)
#pragma unroll
            for (int i = 0; i < 4; ++i) { const int qq = w * 16 + fq * 4 + i, pp = pt * 16 + fr;
                const float xv = bf2f(xbc[(size_t)(t0 + qq) * 1536 + hs * 64 + p0 + pp]);
                yraw[(size_t)(t0 + qq) * 1024 + pp] = yd[pt][i] + __expf(csq[i]) * yo[pt][i] + dskip * xv; }
        __syncthreads();
        { const float cd = __expf(cs_last);
#pragma unroll
          for (int pt = 0; pt < 2; ++pt) { f32x4 acc = st[pt] * cd;
#pragma unroll
              for (int ks = 0; ks < 4; ++ks) { const bf16x8 xa = *(LAS bf16x8*)(XTb + (pt * 16 + fr) * RS + ks * 32 + fq * 8); const bf16x8 bt = *(LAS bf16x8*)(BTs + (w * 16 + fr) * RS + ks * 32 + fq * 8);
                  acc = __builtin_amdgcn_mfma_f32_16x16x32_bf16(xa, bt, acc, 0, 0, 0); }
              st[pt] = acc;
#pragma unroll
              for (int i = 0; i < 4; ++i) Ps[(pt * 16 + fq * 4 + i) * RS + w * 16 + fr] = f2bf(acc[i]); } }
    }
#undef SC_ISSUE
}

__device__ __forceinline__ void attn_job(const Params& p, int job, LAS unsigned char* lds) {
    const int tid = opq(threadIdx.x), lane = tid & 63, w = tid >> 6, fr = lane & 15, fq = lane >> 4;
    const int b = job >> 6, kvh = (job >> 4) & 3, nb = job & 15;
    const bf16_t* proj = (const bf16_t*)(p.ws + WS_PROJ) + (size_t)b * SEQ * INWP;
    const float2* rope = (const float2*)(p.ws + WS_ROPE);
    LAS bf16_t* Ks = (LAS bf16_t*)lds;
    LAS bf16_t* Vt = (LAS bf16_t*)(lds + 36864);
    LAS bf16_t* Ps = (LAS bf16_t*)(lds + 70656) + w * 16 * 264;
    __syncthreads();
    if (tid < 256) {
        const int kr = tid, tk = (nb - 1) * 128 + kr;
        if (tk >= 0) {
            const bf16_t* src = proj + (size_t)tk * INWP + COL_K + kvh * 64; float x[64]; float ss = 0.f;
#pragma unroll
            for (int c = 0; c < 8; ++c) { const uint4 r = *(const uint4*)(src + c * 8); float f[8]; unpack8(r, f);
#pragma unroll
                for (int e = 0; e < 8; ++e) { x[c * 8 + e] = f[e]; ss += f[e] * f[e]; } }
            const float rinv = rsqrtf(ss * (1.0f / 64) + 1e-6f); const float* kn = p.in[13];
#pragma unroll
            for (int i = 0; i < 64; ++i) x[i] = x[i] * rinv * kn[i];
#pragma unroll
            for (int c = 0; c < 4; ++c) { float o1[8], o2[8];
#pragma unroll
                for (int e = 0; e < 8; ++e) { const int i = c * 8 + e; const float2 cs = rope[tk * 32 + i]; o1[e] = x[i] * cs.x - x[i + 32] * cs.y; o2[e] = x[i + 32] * cs.x + x[i] * cs.y; }
                u32x4 w1, w2; w1.x = cvt_pk_bf16(o1[0], o1[1]); w1.y = cvt_pk_bf16(o1[2], o1[3]); w1.z = cvt_pk_bf16(o1[4], o1[5]); w1.w = cvt_pk_bf16(o1[6], o1[7]);
                w2.x = cvt_pk_bf16(o2[0], o2[1]); w2.y = cvt_pk_bf16(o2[2], o2[3]); w2.z = cvt_pk_bf16(o2[4], o2[5]); w2.w = cvt_pk_bf16(o2[6], o2[7]);
                *(LAS u32x4*)(Ks + kr * 72 + c * 8) = w1; *(LAS u32x4*)(Ks + kr * 72 + 32 + c * 8) = w2;
                __builtin_amdgcn_sched_barrier(0); }
        } else {
#pragma unroll
            for (int c = 0; c < 8; ++c) *(LAS u32x4*)(Ks + kr * 72 + c * 8) = (u32x4){0u, 0u, 0u, 0u};
        }
    } else {
        const int kr = tid - 256, tk = (nb - 1) * 128 + kr;
        const bf16_t* src = proj + (size_t)(tk < 0 ? 0 : tk) * INWP + COL_V + kvh * 64;
#pragma unroll
        for (int c = 0; c < 8; ++c) { uint4 r = *(const uint4*)(src + c * 8); if (tk < 0) r = make_uint4(0u, 0u, 0u, 0u);
            Vt[(c * 8 + 0) * 264 + kr] = (bf16_t)(r.x & 0xffffu); Vt[(c * 8 + 1) * 264 + kr] = (bf16_t)(r.x >> 16);
            Vt[(c * 8 + 2) * 264 + kr] = (bf16_t)(r.y & 0xffffu); Vt[(c * 8 + 3) * 264 + kr] = (bf16_t)(r.y >> 16);
            Vt[(c * 8 + 4) * 264 + kr] = (bf16_t)(r.z & 0xffffu); Vt[(c * 8 + 5) * 264 + kr] = (bf16_t)(r.z >> 16);
            Vt[(c * 8 + 6) * 264 + kr] = (bf16_t)(r.w & 0xffffu); Vt[(c * 8 + 7) * 264 + kr] = (bf16_t)(r.w >> 16); }
    }
    __syncthreads();
    const int tq = nb * 128 + w * 16 + fr;
    f32x4 csr[4]; f32x4 qn1[2], qn2[2];
#pragma unroll
    for (int e = 0; e < 4; ++e) csr[e] = *(const f32x4*)(rope + tq * 32 + fq * 8 + 2 * e);
    qn1[0] = *(const f32x4*)(p.in[12] + fq * 8); qn1[1] = *(const f32x4*)(p.in[12] + fq * 8 + 4); qn2[0] = *(const f32x4*)(p.in[12] + 32 + fq * 8); qn2[1] = *(const f32x4*)(p.in[12] + 32 + fq * 8 + 4);
    uint4 r0 = *(const uint4*)(proj + (size_t)tq * INWP + (kvh * 4) * 64 + fq * 8), r1 = *(const uint4*)(proj + (size_t)tq * INWP + (kvh * 4) * 64 + 32 + fq * 8);
    for (int h4 = 0; h4 < 4; ++h4) {
    const int hq = kvh * 4 + h4;
    bf16x8 qa[2];
    uint4 r0n = r0, r1n = r1;
    if (h4 + 1 < 4) { const bf16_t* srcn = proj + (size_t)tq * INWP + (hq + 1) * 64; r0n = *(const uint4*)(srcn + fq * 8); r1n = *(const uint4*)(srcn + 32 + fq * 8); }
    { float x1[8], x2[8]; unpack8(r0, x1); unpack8(r1, x2);
      float ss = 0.f;
#pragma unroll
      for (int e = 0; e < 8; ++e) ss += x1[e] * x1[e] + x2[e] * x2[e];
      ss += __shfl_xor(ss, 16); ss += __shfl_xor(ss, 32);
      const float rinv = rsqrtf(ss * (1.0f / 64) + 1e-6f) * 0.125f; float o1[8], o2[8];
#pragma unroll
      for (int e = 0; e < 8; ++e) { const float a = x1[e] * rinv * qn1[e >> 2][e & 3], c = x2[e] * rinv * qn2[e >> 2][e & 3]; const float cx = csr[e >> 1][(e & 1) * 2], sy = csr[e >> 1][(e & 1) * 2 + 1];
          o1[e] = a * cx - c * sy; o2[e] = c * cx + a * sy; }
      u32x4 w1, w2; w1.x = cvt_pk_bf16(o1[0], o1[1]); w1.y = cvt_pk_bf16(o1[2], o1[3]); w1.z = cvt_pk_bf16(o1[4], o1[5]); w1.w = cvt_pk_bf16(o1[6], o1[7]);
      w2.x = cvt_pk_bf16(o2[0], o2[1]); w2.y = cvt_pk_bf16(o2[2], o2[3]); w2.z = cvt_pk_bf16(o2[4], o2[5]); w2.w = cvt_pk_bf16(o2[6], o2[7]);
      qa[0] = __builtin_bit_cast(bf16x8, w1); qa[1] = __builtin_bit_cast(bf16x8, w2); }
    r0 = r0n; r1 = r1n;
    f32x4 s[16];
#pragma unroll
    for (int j = 0; j < 16; ++j) { f32x4 acc = (f32x4){0.f, 0.f, 0.f, 0.f};
#pragma unroll
        for (int ks = 0; ks < 2; ++ks) { const bf16x8 kb = *(LAS bf16x8*)(Ks + (j * 16 + fr) * 72 + ks * 32 + fq * 8); acc = __builtin_amdgcn_mfma_f32_16x16x32_bf16(qa[ks], kb, acc, 0, 0, 0); }
        s[j] = acc; }
    const float sink = p.in[14][hq];
    float mx[4], inv[4];
#pragma unroll
    for (int i = 0; i < 4; ++i) { const int qi = w * 16 + fq * 4 + i + 128; float m = -3.0e38f;
#pragma unroll
        for (int j = 0; j < 16; ++j) { const int kj = j * 16 + fr; const bool ok = (kj <= qi) && (qi - kj < 128) && (nb > 0 || kj >= 128); s[j][i] = ok ? s[j][i] : -3.0e38f; m = fmaxf(m, s[j][i]); }
        m = max16(m);
        m = fmaxf(m, sink); mx[i] = m; float l = 0.f;
#pragma unroll
        for (int j = 0; j < 16; ++j) { const float e = (s[j][i] > -1.0e38f) ? __expf(s[j][i] - m) : 0.f; s[j][i] = e; l += e; }
        l = red16(l);
        inv[i] = 1.0f / (l + __expf(sink - m)); }
#pragma unroll
    for (int j = 0; j < 16; ++j)
#pragma unroll
        for (int i = 0; i < 4; ++i) Ps[(fq * 4 + i) * 264 + j * 16 + fr] = f2bf(s[j][i] * inv[i]);
    f32x4 o[4];
#pragma unroll
    for (int nd = 0; nd < 4; ++nd) o[nd] = (f32x4){0.f, 0.f, 0.f, 0.f};
#pragma unroll
    for (int kk = 0; kk < 8; ++kk) { const bf16x8 pa = *(LAS bf16x8*)(Ps + fr * 264 + kk * 32 + fq * 8);
#pragma unroll
        for (int nd = 0; nd < 4; ++nd) { const bf16x8 vb = *(LAS bf16x8*)(Vt + (nd * 16 + fr) * 264 + kk * 32 + fq * 8); o[nd] = __builtin_amdgcn_mfma_f32_16x16x32_bf16(pa, vb, o[nd], 0, 0, 0); } }
    bf16_t* ymix = (bf16_t*)(p.ws + WS_YMIX) + (size_t)b * SEQ * D + hq * 64;
#pragma unroll
    for (int nd = 0; nd < 4; ++nd)
#pragma unroll
        for (int i = 0; i < 4; ++i) ymix[(size_t)(nb * 128 + w * 16 + fq * 4 + i) * D + nd * 16 + fr] = f2bf(o[nd][i]);
    }
}

__device__ __forceinline__ void post_ssd(const Params& p) {
    const int tid_ = opq(threadIdx.x); const int lane = tid_ & 63, wv = tid_ >> 6;
    const float* yraw = (const float*)(p.ws + WS_YRAW); const bf16_t* proj = (const bf16_t*)(p.ws + WS_PROJ); bf16_t* ymix = (bf16_t*)(p.ws + WS_YMIX);
    for (int it = blockIdx.x * 8 + wv; it < MTOK * 2; it += gridDim.x * 8) {
        const int tok = it >> 1, grp = it & 1, c = grp * 512 + lane * 8;
        const f32x4 y0 = *(const f32x4*)(yraw + (size_t)tok * 1024 + c), y1 = *(const f32x4*)(yraw + (size_t)tok * 1024 + c + 4);
        const uint4 zr = *(const uint4*)(proj + (size_t)tok * INWP + COL_Z + c); float z[8], y[8]; unpack8(zr, z); float ss = 0.f;
#pragma unroll
        for (int e = 0; e < 8; ++e) { const float yy = (e < 4 ? y0[e] : y1[e - 4]); y[e] = yy * z[e] * sigmoidf_(z[e]); ss += y[e] * y[e]; }
        ss = wave_sum(ss); const float r = rsqrtf(ss * (1.0f / 512) + 1e-6f);
        const f32x4 n0 = *(const f32x4*)(p.in[11] + c), n1 = *(const f32x4*)(p.in[11] + c + 4);
        u32x4 w; w.x = cvt_pk_nv(y[0] * r * n0[0], y[1] * r * n0[1]); w.y = cvt_pk_nv(y[2] * r * n0[2], y[3] * r * n0[3]);
        w.z = cvt_pk_nv(y[4] * r * n1[0], y[5] * r * n1[1]); w.w = cvt_pk_nv(y[6] * r * n1[2], y[7] * r * n1[3]);
        *(u32x4*)(ymix + (size_t)tok * D + 1024 + c) = w;
    }
}

__device__ __forceinline__ float half_sum(float v, bool lo) {
    (void)lo; v = red16(v); return v + __shfl_xor(v, 16); }
__device__ __forceinline__ void rwkv_scan_job(const Params& p, int job, LAS unsigned char* lds) {
    const int tid = opq(threadIdx.x), lane = tid & 63, l32 = lane & 31; const bool lo = lane < 32;
    const int b = job >> 5, hh = job & 31;
    LAS float* L = (LAS float*)lds;
    const bool producer = tid >= 256;
    const int pw = (tid >> 6) & 3;
    const int tl0 = 2 * pw + (lane >> 5);
    const size_t wbase = ((size_t)b * SEQ * D + hh * 64) / 2 + l32 + (size_t)tl0 * (D / 2);
    const unsigned* R32 = (const unsigned*)(p.ws + WS_R) + wbase; const unsigned* K32 = (const unsigned*)(p.ws + WS_K) + wbase; const unsigned* V32 = (const unsigned*)(p.ws + WS_V) + wbase;
    const unsigned* E32 = (const unsigned*)(p.ws + WS_WDEC) + wbase; const unsigned* A32 = (const unsigned*)(p.ws + WS_AA) + wbase; const unsigned* G32 = (const unsigned*)(p.ws + WS_GG) + wbase;
    unsigned* Y32 = (unsigned*)(p.ws + WS_YG) + wbase;
    const int ci = hh * 64 + 2 * l32;
    const float2 kkw = *(const float2*)(p.in[25] + ci), kaw = *(const float2*)(p.in[26] + ci), rkw = *(const float2*)(p.in[27] + ci), lnw = *(const float2*)(p.in[32] + ci), lnb = *(const float2*)(p.in[33] + ci);
    unsigned rw[2], kw[2], vw[2], ew[2], aw[2], gw[2];
    const int oo = tl0 * 64 + 2 * l32;
#define RW_ISSUE(t0) do { _Pragma("unroll") for (int i2 = 0; i2 < 2; ++i2) { const size_t off = (size_t)((t0) + 8 * i2) * (D / 2); rw[i2] = R32[off]; kw[i2] = K32[off]; vw[i2] = V32[off]; ew[i2] = E32[off]; aw[i2] = A32[off]; gw[i2] = G32[off]; } } while (0)
#define RW_COMMIT(buf) do { _Pragma("unroll") for (int i2 = 0; i2 < 2; ++i2) { LAS float* Lc = L + (buf) * 8192 + oo + i2 * 512; \
        const float r0_ = bflo(rw[i2]), r1_ = bfhi(rw[i2]), k0_ = bflo(kw[i2]), k1_ = bfhi(kw[i2]), v0_ = bflo(vw[i2]), v1_ = bfhi(vw[i2]), e0_ = bflo(ew[i2]), e1_ = bfhi(ew[i2]), a0_ = bflo(aw[i2]), a1_ = bfhi(aw[i2]), g0_ = bflo(gw[i2]), g1_ = bfhi(gw[i2]); \
        const float kkv0 = k0_ * kkw.x, kkv1 = k1_ * kkw.y; const float ssq = half_sum(kkv0 * kkv0 + kkv1 * kkv1, lo); const float rn = rsqrtf(fmaxf(ssq, 1e-24f)); const float kn0 = kkv0 * rn, kn1 = kkv1 * rn; \
        const float km0 = k0_ * (1.0f + (a0_ - 1.0f) * kaw.x), km1 = k1_ * (1.0f + (a1_ - 1.0f) * kaw.y); const float bonus = half_sum(r0_ * km0 * rkw.x + r1_ * km1 * rkw.y, lo); \
        *(LAS f32x2*)(Lc) = (f32x2){-kn0, -kn1}; *(LAS f32x2*)(Lc + 1024) = (f32x2){__expf(-e0_), __expf(-e1_)}; *(LAS f32x2*)(Lc + 2048) = (f32x2){kn0 * a0_, kn1 * a1_}; *(LAS f32x2*)(Lc + 3072) = (f32x2){km0, km1}; \
        *(LAS f32x2*)(Lc + 4096) = (f32x2){r0_, r1_}; *(LAS f32x2*)(Lc + 5120) = (f32x2){v0_, v1_}; *(LAS f32x2*)(Lc + 6144) = (f32x2){g0_, g1_}; *(LAS f32x2*)(Lc + 7168) = (f32x2){bonus * v0_, bonus * v1_}; } } while (0)
#define RW_OUTPUT(chp) do { LAS float* Lo = L + ((chp) & 1) * 8192; LAS float* yo = L + 16384 + ((chp) & 1) * 1024; _Pragma("unroll") for (int i2 = 0; i2 < 2; ++i2) { const int o2 = oo + i2 * 512; \
        const f32x2 y = *(LAS f32x2*)(yo + o2); \
        const float mu = half_sum(y.x + y.y, lo) * (1.0f / 64), d0 = y.x - mu, d1 = y.y - mu, var = half_sum(d0 * d0 + d1 * d1, lo) * (1.0f / 64), rs = rsqrtf(var + 64e-5f); \
        const f32x2 bv = *(LAS f32x2*)(Lo + 7168 + o2), gg = *(LAS f32x2*)(Lo + 6144 + o2); \
        Y32[(size_t)((chp) * 16 + 8 * i2) * (D / 2)] = cvt_pk_nv((d0 * rs * lnw.x + lnb.x + bv.x) * gg.x, (d1 * rs * lnw.y + lnb.y + bv.y) * gg.y); } } while (0)
    f32x2 SA[4], SB[4];
#pragma unroll
    for (int i = 0; i < 4; ++i) { SA[i] = (f32x2){0.f, 0.f}; SB[i] = (f32x2){0.f, 0.f}; }
    const int rp = (tid >> 3) & 31, ks = tid & 7;
    __syncthreads();
    if (producer) { RW_ISSUE(0); RW_COMMIT(0); RW_ISSUE(16); }
    __syncthreads();
    for (int ch = 0; ch < 128; ++ch) {
        const int cur = ch & 1;
        if (producer) {
            if (ch >= 1) RW_OUTPUT(ch - 1);
            if (ch + 1 < 128) RW_COMMIT(cur ^ 1);
            if (ch + 2 < 128) RW_ISSUE((ch + 2) * 16);
        } else {
            LAS float* Lb = L + cur * 8192; LAS float* yb = L + 16384 + cur * 1024;
            float yA[16], yB[16];
            LAS float* q0 = Lb + ks * 8;
            f32x4 a0 = *(LAS f32x4*)(q0), a1 = *(LAS f32x4*)(q0 + 4), w0 = *(LAS f32x4*)(q0 + 1024), w1 = *(LAS f32x4*)(q0 + 1028), b0 = *(LAS f32x4*)(q0 + 2048), b1 = *(LAS f32x4*)(q0 + 2052);
            f32x4 k0 = *(LAS f32x4*)(q0 + 3072), k1 = *(LAS f32x4*)(q0 + 3076), r0 = *(LAS f32x4*)(q0 + 4096), r1 = *(LAS f32x4*)(q0 + 4100);
            float va = Lb[5120 + rp], vb = Lb[5120 + rp + 32];
#pragma unroll
            for (int t = 0; t < 16; ++t) {
                f32x4 na0, na1, nw0, nw1, nb0, nb1, nk0, nk1, nr0, nr1; float nva, nvb;
                if (t + 1 < 16) { LAS float* q = q0 + (t + 1) * 64;
                    na0 = *(LAS f32x4*)(q); na1 = *(LAS f32x4*)(q + 4); nw0 = *(LAS f32x4*)(q + 1024); nw1 = *(LAS f32x4*)(q + 1028); nb0 = *(LAS f32x4*)(q + 2048); nb1 = *(LAS f32x4*)(q + 2052);
                    nk0 = *(LAS f32x4*)(q + 3072); nk1 = *(LAS f32x4*)(q + 3076); nr0 = *(LAS f32x4*)(q + 4096); nr1 = *(LAS f32x4*)(q + 4100); nva = Lb[5120 + (t + 1) * 64 + rp]; nvb = Lb[5120 + (t + 1) * 64 + rp + 32]; }
                __builtin_amdgcn_sched_barrier(0);
                f32x2 ca = SA[0] * a0.xy, cb = SB[0] * a0.xy; ca = SA[1] * a0.zw + ca; cb = SB[1] * a0.zw + cb; ca = SA[2] * a1.xy + ca; cb = SB[2] * a1.xy + cb; ca = SA[3] * a1.zw + ca; cb = SB[3] * a1.zw + cb;
                float sa = ca.x + ca.y, sb = cb.x + cb.y;
                sa = dpp_add<0xB1>(sa); sb = dpp_add<0xB1>(sb); sa = dpp_add<0x4E>(sa); sb = dpp_add<0x4E>(sb); sa = dpp_add<0x141>(sa); sb = dpp_add<0x141>(sb);
                const f32x2 sa2 = (f32x2){sa, sa}, sb2 = (f32x2){sb, sb}, va2 = (f32x2){va, va}, vb2 = (f32x2){vb, vb};
                SA[0] = SA[0] * w0.xy + (sa2 * b0.xy + va2 * k0.xy); SB[0] = SB[0] * w0.xy + (sb2 * b0.xy + vb2 * k0.xy);
                SA[1] = SA[1] * w0.zw + (sa2 * b0.zw + va2 * k0.zw); SB[1] = SB[1] * w0.zw + (sb2 * b0.zw + vb2 * k0.zw);
                SA[2] = SA[2] * w1.xy + (sa2 * b1.xy + va2 * k1.xy); SB[2] = SB[2] * w1.xy + (sb2 * b1.xy + vb2 * k1.xy);
                SA[3] = SA[3] * w1.zw + (sa2 * b1.zw + va2 * k1.zw); SB[3] = SB[3] * w1.zw + (sb2 * b1.zw + vb2 * k1.zw);
                f32x2 ya = SA[0] * r0.xy, yb2 = SB[0] * r0.xy; ya = SA[1] * r0.zw + ya; yb2 = SB[1] * r0.zw + yb2; ya = SA[2] * r1.xy + ya; yb2 = SB[2] * r1.xy + yb2; ya = SA[3] * r1.zw + ya; yb2 = SB[3] * r1.zw + yb2;
                float ra = ya.x + ya.y, rb = yb2.x + yb2.y;
                ra = dpp_add<0xB1>(ra); rb = dpp_add<0xB1>(rb); ra = dpp_add<0x4E>(ra); rb = dpp_add<0x4E>(rb); ra = dpp_add<0x141>(ra); rb = dpp_add<0x141>(rb);
                yA[t] = ra; yB[t] = rb;
                __builtin_amdgcn_sched_barrier(0);
                if (t + 1 < 16) { a0 = na0; a1 = na1; w0 = nw0; w1 = nw1; b0 = nb0; b1 = nb1; k0 = nk0; k1 = nk1; r0 = nr0; r1 = nr1; va = nva; vb = nvb; }
            }
            if (ks == 0) {
#pragma unroll
                for (int t = 0; t < 16; ++t) { yb[t * 64 + rp] = yA[t]; yb[t * 64 + rp + 32] = yB[t]; } }
        }
        __syncthreads();
    }
    if (producer) RW_OUTPUT(127);
#undef RW_ISSUE
#undef RW_COMMIT
#undef RW_OUTPUT
}

__device__ __forceinline__ void rwkv_chunk_job(const Params& p, int job, LAS unsigned char* lds) {
    const int tid = opq(threadIdx.x), lane = tid & 63, w = tid >> 6, fr = lane & 15, fq = lane >> 4, l16 = lane & 15;
    const int b = job >> 5, hh = job & 31;
    const int tl = 4 * (w & 3) + (lane >> 4);
    const size_t wbase = ((size_t)b * SEQ * D + hh * 64) / 4 + l16 + (size_t)tl * (D / 4);
    const uint2* R64 = (const uint2*)(p.ws + WS_R) + wbase; const uint2* K64 = (const uint2*)(p.ws + WS_K) + wbase; const uint2* V64 = (const uint2*)(p.ws + WS_V) + wbase;
    const uint2* E64 = (const uint2*)(p.ws + WS_WDEC) + wbase; const uint2* A64 = (const uint2*)(p.ws + WS_AA) + wbase; const uint2* G64 = (const uint2*)(p.ws + WS_GG) + wbase;
    uint2* Y64 = (uint2*)(p.ws + WS_YG) + wbase;
    const int ci = hh * 64 + 4 * l16;
    const f32x4 kkw = *(const f32x4*)(p.in[25] + ci), kaw = *(const f32x4*)(p.in[26] + ci), rkw = *(const f32x4*)(p.in[27] + ci), lnw = *(const f32x4*)(p.in[32] + ci), lnb = *(const f32x4*)(p.in[33] + ci);
    LAS float* Av = (LAS float*)(lds + 0);
    LAS float* Bv = (LAS float*)(lds + 4096);
    LAS float* Km = (LAS float*)(lds + 8192);
    LAS float* Rr = (LAS float*)(lds + 12288);
    LAS float* ybuf = (LAS float*)(lds + 16384);
    LAS float* RHS = (LAS float*)(lds + 20480);
    LAS float* Aab = (LAS float*)(lds + 24832);
    LAS float* Wend = (LAS float*)(lds + 25856);
    LAS bf16_t* ET = (LAS bf16_t*)(lds + 26112);
    LAS bf16_t* VT = (LAS bf16_t*)(lds + 31232);
    LAS bf16_t* BtT = (LAS bf16_t*)(lds + 36352);
    LAS bf16_t* KtT = (LAS bf16_t*)(lds + 41472);
    LAS bf16_t* Ub = (LAS bf16_t*)(lds + 46592);
    LAS bf16_t* AakT = (LAS bf16_t*)(lds + 51712);
    LAS bf16_t* AbrT = (LAS bf16_t*)(lds + 52992);
    LAS bf16_t* AkrT = (LAS bf16_t*)(lds + 54272);
    LAS bf16_t* At = (LAS bf16_t*)(lds + 55552);
    LAS bf16_t* Bt = (LAS bf16_t*)(lds + 57856);
    LAS bf16_t* Kt = (LAS bf16_t*)(lds + 60160);
    LAS bf16_t* Rt = (LAS bf16_t*)(lds + 62464);
    LAS bf16_t* S0b = (LAS bf16_t*)(lds + 64768);
    LAS bf16_t* VT1 = (LAS bf16_t*)(lds + 73984);
    constexpr int LDS_END = 73984 + 64 * 40 * 2;
    __syncthreads();
    for (int i = tid; i < LDS_END / 4; i += 512) ((LAS unsigned*)lds)[i] = 0u;
    f32x4 stt[2]; stt[0] = (f32x4){0.f, 0.f, 0.f, 0.f}; stt[1] = stt[0];
    const int vt = w >> 1, kt0 = (w & 1) * 2;
    bf16x8 Lf;
#pragma unroll
    for (int e = 0; e < 8; ++e) { const int i = fq * 8 + e; Lf[e] = (i <= fr && i < 16) ? (short)0x3F80 : (short)0; }
    uint2 rw, kw, vw, ew, aw, gw;
#define RC_ISSUE(t0) do { const size_t off = (size_t)(t0) * (D / 4); rw = R64[off]; kw = K64[off]; vw = V64[off]; ew = E64[off]; aw = A64[off]; gw = G64[off]; } while (0)
#define RC_PREP(chn) do { \
        const f32x4 r_ = (f32x4){bflo(rw.x), bfhi(rw.x), bflo(rw.y), bfhi(rw.y)}, k_ = (f32x4){bflo(kw.x), bfhi(kw.x), bflo(kw.y), bfhi(kw.y)}, v_ = (f32x4){bflo(vw.x), bfhi(vw.x), bflo(vw.y), bfhi(vw.y)}; \
        const f32x4 a_ = (f32x4){bflo(aw.x), bfhi(aw.x), bflo(aw.y), bfhi(aw.y)}; gn = (f32x4){bflo(gw.x), bfhi(gw.x), bflo(gw.y), bfhi(gw.y)}; \
        const uint2 ewc = ew, vwc = vw; \
        RC_ISSUE((((chn) + 1 < 128) ? (chn) + 1 : 127) * 16);     \
        const f32x4 kkv = k_ * kkw; const float ssq = red16(kkv[0] * kkv[0] + kkv[1] * kkv[1] + kkv[2] * kkv[2] + kkv[3] * kkv[3]); const float rn = rsqrtf(fmaxf(ssq, 1e-24f)); const f32x4 kn = kkv * rn; \
        const f32x4 km = k_ * ((a_ - 1.0f) * kaw + 1.0f); const f32x4 rk_ = r_ * km * rkw; const float bonus = red16(rk_[0] + rk_[1] + rk_[2] + rk_[3]); \
        bn = v_ * bonus; \
        { const int o = tl * 64 + 4 * l16; LAS bf16_t* VTw = ((chn) & 1) ? VT1 : VT; \
          pa = -kn; pb = kn * a_; pk = km; pr = r_; pe = ewc; (void)o; \
          ET[(4 * l16) * 40 + tl] = (bf16_t)(ewc.x & 0xffffu); ET[(4 * l16 + 1) * 40 + tl] = (bf16_t)(ewc.x >> 16); ET[(4 * l16 + 2) * 40 + tl] = (bf16_t)(ewc.y & 0xffffu); ET[(4 * l16 + 3) * 40 + tl] = (bf16_t)(ewc.y >> 16); \
          VTw[(4 * l16) * 40 + tl] = (bf16_t)(vwc.x & 0xffffu); VTw[(4 * l16 + 1) * 40 + tl] = (bf16_t)(vwc.x >> 16); VTw[(4 * l16 + 2) * 40 + tl] = (bf16_t)(vwc.y & 0xffffu); VTw[(4 * l16 + 3) * 40 + tl] = (bf16_t)(vwc.y >> 16); } } while (0)
    f32x4 gc = (f32x4){0.f, 0.f, 0.f, 0.f}, bc = gc, gn = gc, bn = gc;
    f32x4 pa = gc, pb = gc, pk = gc, pr = gc; uint2 pe = make_uint2(0u, 0u);
    LAS float* Ecum = Av;
#define RC_P1A() do { const bf16x8 eb = *(LAS bf16x8*)(ET + (w * 16 + fr) * 40 + fq * 8); f32x4 ec = (f32x4){0.f, 0.f, 0.f, 0.f}; ec = __builtin_amdgcn_mfma_f32_16x16x32_bf16(Lf, eb, ec, 0, 0, 0); \
        _Pragma("unroll") for (int i = 0; i < 4; ++i) Ecum[(fq * 4 + i) * 64 + w * 16 + fr] = ec[i]; } while (0)
#define RC_P1B() do { const f32x4 E = *(LAS f32x4*)(Ecum + tl * 64 + 4 * l16); const f32x4 et = (f32x4){bflo(pe.x), bfhi(pe.x), bflo(pe.y), bfhi(pe.y)}; \
        f32x4 Wt, Wp, iW; _Pragma("unroll") for (int e = 0; e < 4; ++e) { Wt[e] = __expf(-E[e]); Wp[e] = __expf(et[e] - E[e]); iW[e] = __builtin_amdgcn_rcpf(Wt[e]); } \
        const f32x4 at = pa * Wp, rt = pr * Wt, bt = pb * iW, kt = pk * iW; const int o2 = tl * 72 + 4 * l16; \
        *(LAS u32x2*)(At + o2) = (u32x2){cvt_pk_bf16(at[0], at[1]), cvt_pk_bf16(at[2], at[3])}; *(LAS u32x2*)(Rt + o2) = (u32x2){cvt_pk_bf16(rt[0], rt[1]), cvt_pk_bf16(rt[2], rt[3])}; \
        *(LAS u32x2*)(Bt + o2) = (u32x2){cvt_pk_bf16(bt[0], bt[1]), cvt_pk_bf16(bt[2], bt[3])}; *(LAS u32x2*)(Kt + o2) = (u32x2){cvt_pk_bf16(kt[0], kt[1]), cvt_pk_bf16(kt[2], kt[3])}; \
        _Pragma("unroll") for (int e = 0; e < 4; ++e) { BtT[(4 * l16 + e) * 40 + tl] = f2bf(bt[e]); KtT[(4 * l16 + e) * 40 + tl] = f2bf(kt[e]); } \
        if (tl == 15) *(LAS f32x4*)(Wend + 4 * l16) = Wt; } while (0)

    if (w >= 4) RC_ISSUE(0);
    __syncthreads();
    if (w >= 4) { RC_PREP(0); gc = gn; bc = bn; }
    __syncthreads();
    if (w < 4) RC_P1A();
    __syncthreads();
    if (w >= 4) RC_P1B();
    __syncthreads();
    for (int ch = 0; ch < 128; ++ch) {
        LAS bf16_t* VTc = (ch & 1) ? VT1 : VT;
        if (w < 4) {
            LAS bf16_t* Xr = (w & 1) ? Kt : Bt; LAS bf16_t* Yr = (w & 2) ? Rt : At;
            f32x4 gacc = (f32x4){0.f, 0.f, 0.f, 0.f};
#pragma unroll
            for (int ks = 0; ks < 2; ++ks) { const bf16x8 xa = *(LAS bf16x8*)(Xr + fr * 72 + ks * 32 + fq * 8); const bf16x8 yb_ = *(LAS bf16x8*)(Yr + fr * 72 + ks * 32 + fq * 8); gacc = __builtin_amdgcn_mfma_f32_16x16x32_bf16(xa, yb_, gacc, 0, 0, 0); }
            float gm[4];
#pragma unroll
            for (int i = 0; i < 4; ++i) { const int j = fq * 4 + i; const bool keep = (w & 2) ? (j <= fr) : (j < fr); gm[i] = keep ? gacc[i] : 0.f; }
            if (w == 0) {
#pragma unroll
                for (int i = 0; i < 4; ++i) Aab[(fq * 4 + i) * 16 + fr] = gm[i]; }
            else { LAS bf16_t* dst = (w == 1) ? AakT : (w == 2) ? AbrT : AkrT; *(LAS u32x2*)(dst + fr * 40 + fq * 4) = (u32x2){cvt_pk_bf16(gm[0], gm[1]), cvt_pk_bf16(gm[2], gm[3])}; }
        }
        __syncthreads();
        f32x4 y0 = (f32x4){0.f, 0.f, 0.f, 0.f};
        { const int vtile = w & 3; LAS bf16_t* Yr = (w < 4) ? At : Rt; LAS bf16_t* Gt = (w < 4) ? AakT : AkrT;
#pragma unroll
          for (int ks = 0; ks < 2; ++ks) { const bf16x8 sa = *(LAS bf16x8*)(S0b + (vtile * 16 + fr) * 72 + ks * 32 + fq * 8); const bf16x8 yb_ = *(LAS bf16x8*)(Yr + fr * 72 + ks * 32 + fq * 8); y0 = __builtin_amdgcn_mfma_f32_16x16x32_bf16(sa, yb_, y0, 0, 0, 0); }
          { const bf16x8 va = *(LAS bf16x8*)(VTc + (vtile * 16 + fr) * 40 + fq * 8); const bf16x8 gb = *(LAS bf16x8*)(Gt + fr * 40 + fq * 8); y0 = __builtin_amdgcn_mfma_f32_16x16x32_bf16(va, gb, y0, 0, 0, 0); }
          if (w < 4) {
#pragma unroll
              for (int i = 0; i < 4; ++i) RHS[(vtile * 16 + fq * 4 + i) * 17 + fr] = y0[i]; } }
        __syncthreads();
        if (w == 0) {
            float u[16];
#pragma unroll
            for (int t = 0; t < 16; ++t) u[t] = RHS[lane * 17 + t];
#pragma unroll
            for (int t = 0; t < 15; ++t) {
#pragma unroll
                for (int t2 = t + 1; t2 < 16; ++t2) u[t2] += u[t] * Aab[t * 16 + t2]; }
            u32x4 o0, o1; o0.x = cvt_pk_bf16(u[0], u[1]); o0.y = cvt_pk_bf16(u[2], u[3]); o0.z = cvt_pk_bf16(u[4], u[5]); o0.w = cvt_pk_bf16(u[6], u[7]);
            o1.x = cvt_pk_bf16(u[8], u[9]); o1.y = cvt_pk_bf16(u[10], u[11]); o1.z = cvt_pk_bf16(u[12], u[13]); o1.w = cvt_pk_bf16(u[14], u[15]);
            *(LAS u32x4*)(Ub + lane * 40) = o0; *(LAS u32x4*)(Ub + lane * 40 + 8) = o1;
        }
        if (w >= 4) { RC_PREP(ch + 1); }
        __syncthreads();
        if (w >= 4) { const int vtile = w & 3;
            const bf16x8 ua = *(LAS bf16x8*)(Ub + (vtile * 16 + fr) * 40 + fq * 8); const bf16x8 gb = *(LAS bf16x8*)(AbrT + fr * 40 + fq * 8); y0 = __builtin_amdgcn_mfma_f32_16x16x32_bf16(ua, gb, y0, 0, 0, 0);
#pragma unroll
            for (int i = 0; i < 4; ++i) ybuf[fr * 64 + vtile * 16 + fq * 4 + i] = y0[i]; }
        { const bf16x8 ua = *(LAS bf16x8*)(Ub + (vt * 16 + fr) * 40 + fq * 8); const bf16x8 va = *(LAS bf16x8*)(VTc + (vt * 16 + fr) * 40 + fq * 8);
#pragma unroll
          for (int q = 0; q < 2; ++q) { const int kk = (kt0 + q) * 16 + fr;
              const bf16x8 bb = *(LAS bf16x8*)(BtT + kk * 40 + fq * 8); const bf16x8 kb = *(LAS bf16x8*)(KtT + kk * 40 + fq * 8);
              f32x4 acc = stt[q]; acc = __builtin_amdgcn_mfma_f32_16x16x32_bf16(ua, bb, acc, 0, 0, 0); acc = __builtin_amdgcn_mfma_f32_16x16x32_bf16(va, kb, acc, 0, 0, 0);
              const float we = Wend[kk]; acc = acc * we; stt[q] = acc;
#pragma unroll
              for (int i = 0; i < 4; ++i) S0b[(vt * 16 + fq * 4 + i) * 72 + kk] = f2bf(acc[i]); } }
        if (w < 4 && ch + 1 < 128) RC_P1A();
        __syncthreads();
        if (w >= 4) { const f32x4 y = *(LAS f32x4*)(ybuf + tl * 64 + 4 * l16);
          const float mu = red16(y[0] + y[1] + y[2] + y[3]) * (1.0f / 64); const f32x4 d = y - mu;
          const float var = red16(d[0] * d[0] + d[1] * d[1] + d[2] * d[2] + d[3] * d[3]) * (1.0f / 64), rs = rsqrtf(var + 64e-5f);
          const f32x4 o4 = (d * rs * lnw + lnb + bc) * gc;
          Y64[(size_t)(ch * 16) * (D / 4)] = make_uint2(cvt_pk_nv(o4[0], o4[1]), cvt_pk_nv(o4[2], o4[3]));
          gc = gn; bc = bn;
          if (ch + 1 < 128) RC_P1B(); }
        __syncthreads();
    }
#undef RC_P1A
#undef RC_P1B
#undef RC_ISSUE
#undef RC_PREP
}

#define XB_TMO      128
#define XB_XCNT(j)  (256  + 64 * (j))
#define XB_XSUB(j)  (1280 + 64 * (j))
#define XB_XGEN(j)  (2304 + 64 * (j))
#define XB_TOP      3328
#define XB_TOPGEN   3392
#define XCD_BAR_WORDS 3456
#define XB_SPIN_CAP (1u << 18)

__device__ __forceinline__ unsigned xb_ld(unsigned* p)              { return __hip_atomic_load(p, __ATOMIC_RELAXED, __HIP_MEMORY_SCOPE_AGENT); }
__device__ __forceinline__ unsigned xb_add(unsigned* p, unsigned v) { return __hip_atomic_fetch_add(p, v, __ATOMIC_RELAXED, __HIP_MEMORY_SCOPE_AGENT); }
__device__ __forceinline__ unsigned xb_xcc_id() { return (unsigned)__builtin_amdgcn_s_getreg((3 << 11) | 20) & 0xFu; }
#define XB_SPIN(cond, bar) do { unsigned _sp = 0; while (cond) { __builtin_amdgcn_s_sleep(1); \
    if ((++_sp & 255u) == 0u) { if (xb_ld(&(bar)[XB_TMO])) break; if (_sp > XB_SPIN_CAP) { atomicAdd(&(bar)[XB_TMO], 1u); break; } } } } while (0)

struct XcdBarrier {
    unsigned* bar; unsigned x;
    volatile LAS unsigned* st;
};

__device__ __forceinline__ XcdBarrier xcd_barrier_post(unsigned* bar, volatile LAS unsigned* st) {
    XcdBarrier b; b.bar = bar; b.x = xb_xcc_id(); b.st = st;
    if (threadIdx.x == 0) (void)xb_add(&bar[XB_XCNT(b.x)], 1u);
    return b;
}
__device__ __forceinline__ void xcd_barrier_complete(unsigned* bar, unsigned x, unsigned& nloc, unsigned& nx) {
    const unsigned G = gridDim.x * gridDim.y * gridDim.z;
    unsigned sum, cnt, mine, sp = 0u;
    for (;;) {
        sum = 0u; cnt = 0u; mine = 0u;
#pragma unroll
        for (unsigned j = 0; j < 16; ++j) { const unsigned c = xb_ld(&bar[XB_XCNT(j)]); sum += c; cnt += (c > 0u) ? 1u : 0u; mine = (j == x) ? c : mine; }
        if (sum == G) break;
        __builtin_amdgcn_s_sleep(1);
        if ((++sp & 255u) == 0u) { if (xb_ld(&bar[XB_TMO])) break; if (sp > XB_SPIN_CAP) { atomicAdd(&bar[XB_TMO], 1u); break; } }
    }
    nloc = mine > 0u ? mine : 1u; nx = cnt > 0u ? cnt : 1u;
}

__device__ __forceinline__ void xcd_barrier(const XcdBarrier& b) {
    asm volatile("s_waitcnt vmcnt(0)" ::: "memory");
    __syncthreads();
    if (threadIdx.x == 0) {
        unsigned* bar = b.bar;
        __builtin_amdgcn_s_waitcnt(0);
        unsigned nloc = b.st[0], nx = b.st[1];
        if (nloc == 0u) { xcd_barrier_complete(bar, b.x, nloc, nx); b.st[0] = nloc; b.st[1] = nx; }
        const unsigned old = xb_add(&bar[XB_XSUB(b.x)], 1u);
        const unsigned gen = old / nloc;
        if (old + 1u == (gen + 1u) * nloc) {
            __builtin_amdgcn_fence(__ATOMIC_RELEASE, "agent");
            asm volatile("s_waitcnt vmcnt(0)" ::: "memory");
            const unsigned og = xb_add(&bar[XB_TOP], 1u);
            const unsigned tg = og / nx;
            if (og + 1u == (tg + 1u) * nx) xb_add(&bar[XB_TOPGEN], 1u);
            else XB_SPIN(xb_ld(&bar[XB_TOPGEN]) == tg, bar);
            __builtin_amdgcn_fence(__ATOMIC_ACQUIRE, "agent");
            xb_add(&bar[XB_XGEN(b.x)], 1u);
            asm volatile("s_waitcnt vmcnt(0)" ::: "memory");
        } else {
            XB_SPIN(xb_ld(&bar[XB_XGEN(b.x)]) == gen, bar);
            __builtin_amdgcn_fence(__ATOMIC_ACQUIRE, "agent");
            asm volatile("s_waitcnt vmcnt(0)" ::: "memory");
        }
    }
    __syncthreads();
}


__global__ __launch_bounds__(512, 2) void mega(const Params p_arg) {
    extern __shared__ __attribute__((aligned(16))) unsigned char shm[];
    const Params& p = *(const Params*)(const void*)__builtin_amdgcn_kernarg_segment_ptr();
    LAS unsigned char* lds = (LAS unsigned char*)shm;
    const int G = (int)gridDim.x, bid = (int)blockIdx.x;
    __shared__ uint4 xb_words;
    if (threadIdx.x == 0) xb_words = make_uint4(0u, 0u, 0u, 0u);
    __syncthreads();
    (void)xcd_barrier_post((unsigned*)(p.ws + WS_BAR), (volatile LAS unsigned*)&xb_words);
    const int step_lo = p.step_lo, step_hi = p.step_hi;
    for (int s = step_lo; s < step_hi; ++s) {
        const int kind = p.kind[s], lo = p.lo[s], hi = p.hi[s];
        switch (kind) {
            case K_PRE0:
#ifndef NO_PRE
 convert_tiles(p, lo, hi, lds); rope_table(p); norm_rows(p.in[0], p.in[1], (bf16_t*)(p.ws + WS_H));
#endif
 break;
            case K_GEMMB:
#ifndef NO_GB

                { pg8::Gemm g; g.A = p.g[lo].A; g.Bt = p.g[lo].Bt; g.M = p.g[lo].M; g.N = p.g[lo].N; g.K = p.g[lo].K;
                  MultiOrder S; S.ops = &p.g[lo]; S.nops = hi - lo; S.G = G; S.c = bid;
                  EpiB E; E.ops = &p.g[lo];
                  pg8::gemm_phase<EpiB, MultiOrder, false>(lds, g, S, E, nullptr); }
                if (p.chi[s] > p.clo[s]) convert_queue(p, p.clo[s], p.chi[s], (unsigned*)(p.ws + WS_BAR + 16384) + 64 * p.cq[s], lds);
#endif
                break;
            case K_GEMMF:
#ifndef NO_GF

                for (int i = lo; i < hi; ++i) { const GemmOp& o = p.g[i]; pg8::Gemm g; g.A = o.A; g.Bt = o.Bt; g.M = o.M; g.N = o.N; g.K = o.K;
                    pg8::StaticOrder S; S.init(o.M, o.N, G, (bid + G - (o.rot % G)) % G);
                    EpiF E; E.C = (float*)o.out; E.ldc = o.ldc; E.res = o.res;
                    pg8::gemm_phase<EpiF, pg8::StaticOrder, false>(lds, g, S, E, nullptr); }
#endif
                break;
            case K_CONVSSD:
#ifndef NO_CONV
 conv_ssd(p);
#endif
 break;
            case K_MIX0:

#ifndef NO_SSD
for (int j = bid; j < 256; j += G) ssd_chunk_job(p, j, lds);
#endif


#ifndef NO_ATT
for (int j = bid; j < 512; j += G) attn_job(p, j, lds);
#endif

                break;
            case K_POST0: post_ssd(p); break;
            case K_NORM: norm_rows(p.out, p.in[2] + lo * D, (bf16_t*)(p.ws + WS_H)); break;
            case K_PRE1: convert_tiles(p, lo, hi, lds); mix_rows(p.out, p.in[1] + D, p.in[16], (bf16_t*)(p.ws + WS_MIX), 0, lds); break;
            case K_MIXES: mix_rows(p.out, p.in[1] + D, p.in[16], (bf16_t*)(p.ws + WS_MIX), 8192, lds); break;
            case K_RWKV:
#ifndef NO_RWKV
 for (int j = bid; j < 256; j += G) rwkv_chunk_job(p, j, lds);
#endif
 break;
            case K_NORMCONV: convert_tiles(p, lo, hi, lds); norm_rows(p.out, p.in[2] + D, (bf16_t*)(p.ws + WS_H)); break;
            default: break;
        }
        if (s + 1 < step_hi) { if (step_hi < 0) cg::this_grid().sync();   XcdBarrier xb; xb.bar = (unsigned*)(p.ws + WS_BAR); xb.x = xb_xcc_id(); xb.st = (volatile LAS unsigned*)&xb_words; xcd_barrier(xb); }
    }
}

#ifndef MK_MULTI
#define MK_MULTI 0
#endif
extern "C" void kernel_launch(void* const* d_in, const int* in_sizes, int n_in, void* d_out, int out_size, void* d_ws, size_t ws_size, hipStream_t stream) {
    static int grid = 0;
    if (grid == 0) {
        int dev = 0, cus = 0, per_cu = 0;
        hipGetDevice(&dev); hipDeviceGetAttribute(&cus, hipDeviceAttributeMultiprocessorCount, dev);
        if (hipFuncSetAttribute((const void*)mega, hipFuncAttributeMaxDynamicSharedMemorySize, LDS_BYTES) != hipSuccess) { fprintf(stderr, "hipFuncSetAttribute failed\n"); grid = -1; return; }
        if (hipOccupancyMaxActiveBlocksPerMultiprocessor(&per_cu, (const void*)mega, 512, LDS_BYTES) != hipSuccess || per_cu < 1) { fprintf(stderr, "occupancy query: %d\n", per_cu); per_cu = 1; }
        (void)hipGetLastError();
        grid = cus * per_cu; if (grid > 256) grid = 256;
        if (n_in != 34 || ws_size < 512 * MiB) { fprintf(stderr, "unexpected n_in %d / ws %zu\n", n_in, ws_size); grid = -1; return; }
    }
    if (grid < 0) return;
    static Params p;
    memset(&p, 0, sizeof(p));
    for (int i = 0; i < 34; ++i) p.in[i] = (const float*)d_in[i];
    p.out = (float*)d_out; p.ws = (unsigned char*)d_ws;
    unsigned char* ws = (unsigned char*)d_ws;
    auto B16 = [&](size_t off) { return (bf16_t*)(ws + off); };
    int ncj = 0, tile_acc = 0;
    auto CJ = [&](const float* src, size_t dst_off, int K, int N, int Kpad, int Npad) { ConvJob& c = p.cj[ncj++]; c.src = src; c.dst = B16(dst_off); c.K = K; c.N = N; c.Kpad = Kpad; c.Npad = Npad; c.tile0 = tile_acc; c.ntiles = (Kpad / 64) * (Npad / 256); tile_acc += c.ntiles; };
    const float* w_up = p.in[3]; const float* w_down = p.in[4];
    tile_acc = 0;
    CJ(p.in[5], WS_WBA, 2048, 4112, 2048, 4352); CJ(p.in[15], WS_WBA + 17 * MiB, 2048, 2048, 2048, 2048);
    tile_acc = 0;
    CJ(w_up, WS_WMLP, 2048, 8192, 2048, 8192); CJ(w_down, WS_WMLP + 32 * MiB, 8192, 2048, 8192, 2048);
    tile_acc = 0;
    CJ(p.in[28], WS_WBA, 2048, 2048, 2048, 2048); CJ(p.in[29], WS_WBA + 8 * MiB, 2048, 2048, 2048, 2048); CJ(p.in[30], WS_WBA + 16 * MiB, 2048, 2048, 2048, 2048); CJ(p.in[31], WS_WBA + 24 * MiB, 2048, 2048, 2048, 2048);
    CJ(p.in[18], WS_WBA + 32 * MiB, 2048, 96, 2048, 256); CJ(p.in[21], WS_WBA + 33 * MiB, 2048, 96, 2048, 256); CJ(p.in[23], WS_WBA + 34 * MiB, 2048, 256, 2048, 256);
    CJ(p.in[19], WS_WBA + 35 * MiB, 96, 2048, 256, 2048); CJ(p.in[22], WS_WBA + 36 * MiB, 96, 2048, 256, 2048); CJ(p.in[24], WS_WBA + 37 * MiB, 256, 2048, 256, 2048);
    tile_acc = 0;
    CJ(w_up + (size_t)2048 * 8192, WS_WMLP1, 2048, 8192, 2048, 8192); CJ(w_down + (size_t)2048 * 8192, WS_WMLP1 + 32 * MiB, 8192, 2048, 8192, 2048);
    int nop = 0;
    auto GO = [&](const bf16_t* A, const bf16_t* Bt, void* out, const float* bias, const float* res, int M, int N, int K, int ldc, int act, int rot) {
        GemmOp& o = p.g[nop++]; o.A = A; o.Bt = Bt; o.out = out; o.bias = bias; o.res = res; o.M = M; o.N = N; o.K = K; o.ldc = ldc; o.act = act; o.rot = rot; };
    GO(B16(WS_H), B16(WS_WBA), B16(WS_PROJ), nullptr, nullptr, MTOK, INWP, 2048, INWP, 0, 0);
    GO(B16(WS_YMIX), B16(WS_WBA + 17 * MiB), d_out, nullptr, p.in[0], MTOK, 2048, 2048, 2048, 0, 0);
    GO(B16(WS_H), B16(WS_WMLP), B16(WS_U), nullptr, nullptr, MTOK, DFF, 2048, DFF, 1, 0);
    GO(B16(WS_U), B16(WS_WMLP + 32 * MiB), d_out, nullptr, (const float*)d_out, MTOK, 2048, DFF, 2048, 0, 0);
    for (int half = 0; half < 2; ++half) {
        const size_t ro = (size_t)half * 8192 * 2048 * 2, lo_ = (size_t)half * 8192 * 256 * 2; const size_t mb = (size_t)8192 * 2048 * 2;
        GO(B16(WS_MIX + 0 * mb), B16(WS_WBA), B16(WS_R + ro), nullptr, nullptr, 8192, 2048, 2048, 2048, 0, 0);
        GO(B16(WS_MIX + 2 * mb), B16(WS_WBA + 8 * MiB), B16(WS_K + ro), nullptr, nullptr, 8192, 2048, 2048, 2048, 0, 0);
        GO(B16(WS_MIX + 3 * mb), B16(WS_WBA + 16 * MiB), B16(WS_V + ro), nullptr, nullptr, 8192, 2048, 2048, 2048, 0, 0);
        GO(B16(WS_MIX + 1 * mb), B16(WS_WBA + 32 * MiB), B16(WS_L1W + lo_), nullptr, nullptr, 8192, 256, 2048, 256, 2, 0);
        GO(B16(WS_MIX + 4 * mb), B16(WS_WBA + 33 * MiB), B16(WS_L1A + lo_), nullptr, nullptr, 8192, 256, 2048, 256, 0, 32);
        GO(B16(WS_MIX + 5 * mb), B16(WS_WBA + 34 * MiB), B16(WS_L1G + lo_), nullptr, nullptr, 8192, 256, 2048, 256, 3, 64);
    }
    GO(B16(WS_L1W), B16(WS_WBA + 35 * MiB), B16(WS_WDEC), p.in[17], nullptr, MTOK, 2048, 256, 2048, 4, 0);
    GO(B16(WS_L1A), B16(WS_WBA + 36 * MiB), B16(WS_AA), p.in[20], nullptr, MTOK, 2048, 256, 2048, 3, 0);
    GO(B16(WS_L1G), B16(WS_WBA + 37 * MiB), B16(WS_GG), nullptr, nullptr, MTOK, 2048, 256, 2048, 0, 0);
    GO(B16(WS_YG), B16(WS_WBA + 24 * MiB), d_out, nullptr, (const float*)d_out, MTOK, 2048, 2048, 2048, 0, 0);
    GO(B16(WS_H), B16(WS_WMLP1), B16(WS_U), nullptr, nullptr, MTOK, DFF, 2048, DFF, 1, 0);
    GO(B16(WS_U), B16(WS_WMLP1 + 32 * MiB), d_out, nullptr, (const float*)d_out, MTOK, 2048, DFF, 2048, 0, 0);
    int ns = 0;
    auto ST = [&](int kind, int lo, int hi, int clo = 0, int chi = 0, int cq = 0) { p.kind[ns] = kind; p.lo[ns] = lo; p.hi[ns] = hi; p.clo[ns] = clo; p.chi[ns] = chi; p.cq[ns] = cq; ++ns; };
    ST(K_PRE0, 0, 2); ST(K_GEMMB, 0, 1, 2, 4, 0); ST(K_CONVSSD, 0, 0); ST(K_MIX0, 0, 0); ST(K_POST0, 0, 0); ST(K_GEMMF, 1, 2); ST(K_NORM, 0, 0); ST(K_GEMMB, 2, 3); ST(K_GEMMF, 3, 4);
    ST(K_PRE1, 4, 14); ST(K_GEMMB, 4, 10, 14, 16, 1); ST(K_MIXES, 0, 0); ST(K_GEMMB, 10, 16, 14, 16, 1); ST(K_GEMMB, 16, 19); ST(K_RWKV, 0, 0); ST(K_GEMMF, 19, 20); ST(K_NORM, 1, 0); ST(K_GEMMB, 20, 21); ST(K_GEMMF, 21, 22);
    (void)hipMemsetAsync(ws + WS_BAR, 0, 16384 + 1024, stream);
#if MK_MULTI
    for (int s = 0; s < ns; ++s) { p.step_lo = s; p.step_hi = s + 1; hipLaunchKernelGGL(mega, dim3(grid), dim3(512), LDS_BYTES, stream, p); }
#else
    p.step_lo = 0; p.step_hi = ns;
    void* args[] = {(void*)&p};
    const hipError_t e = hipLaunchCooperativeKernel((const void*)mega, dim3(grid), dim3(512), args, LDS_BYTES, stream);
    if (e != hipSuccess) fprintf(stderr, "cooperative launch failed: %s (grid %d)\n", hipGetErrorString(e), grid);
#endif
}
```

```cpp
#include <hip/hip_runtime.h>
#include <hip/hip_cooperative_groups.h>
#include <cstdio>
#include <cstring>
namespace cg = cooperative_groups;
__device__ __forceinline__ int opq(int v) { asm volatile("" : "+v"(v)); return v; }
namespace pg8 {
#define PG8_LAS __attribute__((address_space(3)))
typedef unsigned short bf16_t;
typedef short bf16x8 __attribute__((ext_vector_type(8)));
typedef float f32x4 __attribute__((ext_vector_type(4)));
typedef unsigned u32x4 __attribute__((ext_vector_type(4)));
constexpr int BM = 256, BK = 64, HALF = 128, HTB = HALF * BK * 2  , STAGE_BYTES = 8 * HTB, NXCD = 8, WGM = 8;

__host__ __device__ __forceinline__ int lds_byte(int r, int c) { const int st = (r >> 4) * 2 + (c >> 5), rr = r & 15, cc = c & 31, ob = rr * 64 + cc * 2; return st * 1024 + (ob ^ (((ob >> 9) & 1) << 5)); }
__host__ __device__ __forceinline__ void stage_rc(int b, int& R, int& C) { const int st = b / 1024, sb = b % 1024, swz = sb ^ (((sb >> 9) & 1) << 5); R = (st >> 1) * 16 + swz / 64; C = (st & 1) * 32 + (swz % 64) / 2; }
__host__ __device__ __forceinline__ int perm32(int rho) { const int n = rho >> 4, i = rho & 15; return 8 * (i >> 2) + 4 * n + (i & 3); }

struct Unit { int pm, pn, op; };
struct Gemm { const bf16_t* A; const bf16_t* Bt; int M, N, K; };

struct StaticOrder {
    int nM, nN, nwg, G, c;
    __host__ __device__ void init(int M, int N, int G_, int c_) { nM = M / BM; nN = N / BM; nwg = nM * nN; G = G_; c = c_; }
    __host__ __device__ bool next(int i, Unit& u) const {
        const long L = (long)i * G + c; if (L >= nwg) return false;
        int wgid = (int)L; { const int q = nwg / NXCD, r = nwg % NXCD, xcd = wgid % NXCD, off = wgid / NXCD; wgid = (xcd < r ? xcd * (q + 1) : r * (q + 1) + (xcd - r) * q) + off; }
        const int nig = WGM * nN, gid = wgid / nig, fm = gid * WGM, gsz = (nM - fm) < WGM ? (nM - fm) : WGM;
        u.pm = fm + ((wgid % nig) % gsz); u.pn = (wgid % nig) / gsz; u.op = 0; return true;
    }
    __device__ __forceinline__ const char* abase(const Unit&, const Gemm& g) const { return (const char*)g.A; }
    __device__ __forceinline__ const char* bbase(const Unit&, const Gemm& g) const { return (const char*)g.Bt; }
    __device__ __forceinline__ void a_ready(const Unit&) const {}
    __device__ __forceinline__ void done(const Unit&) const {}
};
typedef __bf16 bf16x2_t __attribute__((ext_vector_type(2)));
typedef float f32x2_t __attribute__((ext_vector_type(2)));
__device__ __forceinline__ unsigned cvt_pk_bf16(float lo, float hi) { const f32x2_t f = {lo, hi}; const bf16x2_t v = __builtin_convertvector(f, bf16x2_t); return __builtin_bit_cast(unsigned, v); }
__device__ __forceinline__ unsigned cvt_pk_nv(float lo, float hi) { return cvt_pk_bf16(lo, hi); }

template <class Epi, class Sched, bool STAMP = false>
__device__ __forceinline__ void gemm_phase(PG8_LAS unsigned char* lds, const Gemm g, const Sched& S, const Epi& E, unsigned long long* stamps) {
    const int tid = opq(threadIdx.x), wid = __builtin_amdgcn_readfirstlane(tid >> 6), lane = tid & 63, wr = wid >> 2, wc = wid & 3, fr = lane & 15, fq = lane >> 4;
    const int K = g.K, nt = K / BK;
    int ts_lo = 0, ts_hi = 0, nts = 0; const unsigned long long rt_entry = STAMP ? (unsigned long long)wall_clock64() : 0ull;
#define PG8_STAMP() do { if (STAMP && wid == 0 && nts < 64) { const unsigned long long _c = (unsigned long long)clock64(); \
        ts_lo = (lane == nts) ? (int)(unsigned)_c : ts_lo; ts_hi = (lane == nts) ? (int)(unsigned)(_c >> 32) : ts_hi; ++nts; } } while (0)
    PG8_STAMP();
    unsigned voffA[2], voffB[2];
#pragma unroll
    for (int i = 0; i < 2; ++i) { int R, C; stage_rc(tid * 16 + i * 8192, R, C); const int Rb = Epi::PERM ? ((R & ~31) + perm32(R & 31)) : R;
        voffA[i] = (unsigned)(R * K + C) * 2u; voffB[i] = (unsigned)(Rb * K + C) * 2u; }
    const size_t kstep = (size_t)(BK * 2);
    const size_t hstep = (size_t)HALF * K * 2;
    const size_t tstep = 2 * hstep;
    const unsigned ldsw = (unsigned)wid * 1024u;
    const int aoff = lds_byte(wr * 64 + fr, fq * 8), boff = lds_byte(wc * 32 + fr, fq * 8);
#define PG8_SA(b, h) (((b) * 2 + (h)) * HTB)
#define PG8_SB(b, h) ((4 + (b) * 2 + (h)) * HTB)
#define PG8_STAGE(bufoff, gbase, voff) do { _Pragma("unroll") for (int _i = 0; _i < 2; ++_i) \
        __builtin_amdgcn_global_load_lds((const unsigned*)((const char*)(gbase) + (voff)[_i]), (PG8_LAS unsigned*)(lds + (bufoff) + ldsw + _i * 8192), 16, 0, 0); } while (0)
#define PG8_LDA(dst, b, h) do { _Pragma("unroll") for (int m = 0; m < 4; ++m) _Pragma("unroll") for (int k = 0; k < 2; ++k) dst[m][k] = *(const PG8_LAS bf16x8*)(lds + PG8_SA(b, h) + aoff + m * 2048 + k * 1024); } while (0)
#define PG8_LDB(dst, b, h) do { _Pragma("unroll") for (int n = 0; n < 2; ++n) _Pragma("unroll") for (int k = 0; k < 2; ++k) dst[n][k] = *(const PG8_LAS bf16x8*)(lds + PG8_SB(b, h) + boff + n * 2048 + k * 1024); } while (0)
#define PG8_MMA(ai, bj, At, Bt) do { __builtin_amdgcn_s_setprio(1); _Pragma("unroll") for (int m = 0; m < 4; ++m) _Pragma("unroll") for (int n = 0; n < 2; ++n) _Pragma("unroll") for (int k = 0; k < 2; ++k) \
        acc[ai][bj][m][n] = __builtin_amdgcn_mfma_f32_16x16x32_bf16(Bt[n][k], At[m][k], acc[ai][bj][m][n], 0, 0, 0); __builtin_amdgcn_s_setprio(0); } while (0)
#define PG8_WAIT_V(n) asm volatile("s_waitcnt vmcnt(" #n ")" ::: "memory")
#define PG8_WAIT_L(n) asm volatile("s_waitcnt lgkmcnt(" #n ")" ::: "memory")
#define PG8_BAR __builtin_amdgcn_s_barrier()
#define PG8_SCHED __builtin_amdgcn_sched_barrier(0)
    Unit cur, nxt; int ui = 0;
    if (!S.next(0, cur)) return;
    f32x4 acc[2][2][4][2];
#pragma unroll
    for (int a = 0; a < 2; ++a)
#pragma unroll
        for (int b = 0; b < 2; ++b)
#pragma unroll
            for (int m = 0; m < 4; ++m)
#pragma unroll
                for (int n = 0; n < 2; ++n) acc[a][b][m][n] = (f32x4){0.f, 0.f, 0.f, 0.f};
    bf16x8 At[4][2], B0[2][2], B1[2][2];
    const char* cA = S.abase(cur, g) + (size_t)cur.pm * tstep; const char* cB = S.bbase(cur, g) + (size_t)cur.pn * tstep;
    S.a_ready(cur);
    PG8_STAGE(PG8_SB(0, 0), cB, voffB); PG8_STAGE(PG8_SA(0, 0), cA, voffA); PG8_STAGE(PG8_SB(0, 1), cB + hstep, voffB); PG8_STAGE(PG8_SA(0, 1), cA + hstep, voffA);
    if (wr == 1) PG8_BAR;
    PG8_WAIT_V(4); PG8_BAR;
    PG8_STAGE(PG8_SB(1, 0), cB + kstep, voffB); PG8_STAGE(PG8_SA(1, 0), cA + kstep, voffA); PG8_STAGE(PG8_SB(1, 1), cB + hstep + kstep, voffB);
    PG8_WAIT_V(6); PG8_BAR;
    PG8_STAMP();
    for (;;) {
        const bool has_next = S.next(ui + 1, nxt);
        const char* nA = has_next ? S.abase(nxt, g) + (size_t)nxt.pm * tstep : cA; const char* nB = has_next ? S.bbase(nxt, g) + (size_t)nxt.pn * tstep : cB;
        for (int t = 0; t < nt; t += 2) {
            const bool last = (t == nt - 2);
            const char* a1 = cA + (size_t)(t + 1) * kstep;
            const char* a2 = last ? nA : cA + (size_t)(t + 2) * kstep; const char* b2 = last ? nB : cB + (size_t)(t + 2) * kstep;
            const char* a3 = a2 + kstep; const char* b3 = b2 + kstep;
            if (last && has_next) S.a_ready(nxt);
            PG8_LDB(B0, 0, 0); PG8_SCHED; PG8_LDA(At, 0, 0); PG8_STAGE(PG8_SA(1, 1), a1 + hstep, voffA);
            PG8_WAIT_L(8); PG8_BAR; PG8_WAIT_L(0); PG8_MMA(0, 0, At, B0); PG8_BAR; PG8_SCHED;
            PG8_LDB(B1, 0, 1); PG8_STAGE(PG8_SB(0, 0), b2, voffB);
            PG8_BAR; PG8_WAIT_L(0); PG8_MMA(0, 1, At, B1); PG8_BAR;
            PG8_LDA(At, 0, 1); PG8_STAGE(PG8_SA(0, 0), a2, voffA);
            PG8_BAR; PG8_WAIT_L(0); PG8_MMA(1, 0, At, B0); PG8_BAR; PG8_SCHED;
            PG8_STAGE(PG8_SB(0, 1), b2 + hstep, voffB);
            PG8_WAIT_V(6); PG8_BAR; PG8_MMA(1, 1, At, B1); PG8_BAR;
            PG8_LDB(B0, 1, 0); PG8_SCHED; PG8_LDA(At, 1, 0); PG8_STAGE(PG8_SA(0, 1), a2 + hstep, voffA);
            PG8_WAIT_L(8); PG8_BAR; PG8_WAIT_L(0); PG8_MMA(0, 0, At, B0); PG8_BAR; PG8_SCHED;
            PG8_LDB(B1, 1, 1); PG8_STAGE(PG8_SB(1, 0), b3, voffB);
            PG8_BAR; PG8_WAIT_L(0); PG8_MMA(0, 1, At, B1); PG8_BAR;
            PG8_LDA(At, 1, 1); PG8_STAGE(PG8_SA(1, 0), a3, voffA);
            PG8_BAR; PG8_WAIT_L(0); PG8_MMA(1, 0, At, B0); PG8_BAR; PG8_SCHED;
            PG8_STAGE(PG8_SB(1, 1), b3 + hstep, voffB);
            PG8_WAIT_V(6); PG8_BAR; PG8_MMA(1, 1, At, B1); PG8_BAR;
        }
        PG8_STAMP();
        if constexpr (!Epi::AFTER_DRAIN) { E(acc, cur, wr, wc, fr, fq); S.done(cur); }
        PG8_STAMP();
        if (!has_next) break;
#pragma unroll
        for (int a = 0; a < 2; ++a)
#pragma unroll
            for (int b = 0; b < 2; ++b)
#pragma unroll
                for (int m = 0; m < 4; ++m)
#pragma unroll
                    for (int n = 0; n < 2; ++n) acc[a][b][m][n] = (f32x4){0.f, 0.f, 0.f, 0.f};
        cur = nxt; cA = nA; cB = nB; ++ui;
    }
    PG8_WAIT_V(0);
    if (wr == 0) PG8_BAR;
    PG8_BAR;
    if constexpr (Epi::AFTER_DRAIN) { E.fused(acc, cur, wr, wc, fr, fq, lds, wid, lane); S.done(cur); }
    PG8_STAMP();
    if (STAMP && wid == 0) { stamps[lane] = lane < nts ? (((unsigned long long)(unsigned)ts_hi << 32) | (unsigned)ts_lo) : 0ull;
        if (lane == 62) stamps[62] = rt_entry; if (lane == 63) stamps[63] = (unsigned long long)wall_clock64(); }
#undef PG8_STAMP
#undef PG8_SA
#undef PG8_SB
#undef PG8_STAGE
#undef PG8_LDA
#undef PG8_LDB
#undef PG8_MMA
#undef PG8_WAIT_V
#undef PG8_WAIT_L
#undef PG8_BAR
#undef PG8_SCHED
}
}

#include <cstdio>
#include <ctime>
#include <cstdlib>
#include <cstring>
#include <cmath>
#include <vector>
#include <algorithm>
#define CK(x) do { hipError_t e_ = (x); if (e_ != hipSuccess) { fprintf(stderr, "HIP %s:%d %s\n", __FILE__, __LINE__, hipGetErrorString(e_)); exit(2); } } while (0)
using pg8::bf16_t; using pg8::bf16x8; using pg8::f32x4; using pg8::u32x4; using pg8::cvt_pk_bf16; using pg8::cvt_pk_nv;
#define LAS PG8_LAS

constexpr int D = 2048, SEQ = 2048, MTOK = 16384, DFF = 8192, INWP = 4352;
constexpr int COL_K = 1024, COL_V = 1280, COL_Z = 1536, COL_XBC = 2560, COL_DT = 4096;
constexpr size_t MiB = (size_t)1 << 20;
constexpr size_t WS_WBA = 0, WS_WMLP = 40 * MiB, WS_H = 104 * MiB, WS_PROJ = 168 * MiB, WS_YMIX = 304 * MiB, WS_YRAW = 368 * MiB, WS_XBC = 432 * MiB,
                 WS_DT = 480 * MiB, WS_DA = 481 * MiB, WS_ROPE = 482 * MiB, WS_U = 168 * MiB;
constexpr size_t WS_R = 40 * MiB, WS_K = 104 * MiB, WS_V = 168 * MiB, WS_L1W = 232 * MiB, WS_L1A = 240 * MiB, WS_L1G = 248 * MiB, WS_MIX = 256 * MiB,
                 WS_WDEC = 256 * MiB, WS_AA = 320 * MiB, WS_GG = 384 * MiB, WS_YG = 40 * MiB  , WS_WMLP1 = 448 * MiB;
constexpr size_t WS_BAR = 39 * MiB;
constexpr int LDS_BYTES = 140 * 1024;

enum { K_PRE0 = 0, K_GEMMB, K_GEMMF, K_CONVSSD, K_MIX0, K_POST0, K_NORM, K_PRE1, K_MIXES, K_RWKV, K_NORMCONV };
constexpr int NSTEPS = 48, NOPS = 22, NCJ = 16;
#define REP_GEMMB 1
#define REP_MIX0 1
#define REP_RWKV 1
#define REP_ELEM 1

struct GemmOp { const bf16_t* A; const bf16_t* Bt; void* out; const float* bias; const float* res; int M, N, K, ldc, act, rot, pad0, pad1; };
struct ConvJob { const float* src; bf16_t* dst; int K, N, Kpad, Npad, tile0, ntiles; };
struct Params {
    const float* in[34];
    float* out; unsigned char* ws;
    GemmOp g[NOPS];
    ConvJob cj[NCJ];
    int kind[NSTEPS + 1]; int lo[NSTEPS + 1]; int hi[NSTEPS + 1]; int clo[NSTEPS + 1]; int chi[NSTEPS + 1]; int cq[NSTEPS + 1];
    int step_lo, step_hi;
};

__device__ __forceinline__ float bf2f(unsigned short b) { return __uint_as_float(((unsigned)b) << 16); }
__device__ __forceinline__ float bflo(unsigned w) { return __uint_as_float(w << 16); }
__device__ __forceinline__ float bfhi(unsigned w) { return __uint_as_float(w & 0xffff0000u); }
__device__ __forceinline__ bf16_t f2bf(float f) { return (bf16_t)(cvt_pk_bf16(f, 0.f) & 0xffffu); }
template <int CTRL> __device__ __forceinline__ float dpp_add(float x) {
    const int y = __builtin_amdgcn_update_dpp(0, __builtin_bit_cast(int, x), CTRL, 0xf, 0xf, true);
    return x + __builtin_bit_cast(float, y); }
template <int CTRL> __device__ __forceinline__ float dpp_max(float x) {
    const int y = __builtin_amdgcn_update_dpp(0, __builtin_bit_cast(int, x), CTRL, 0xf, 0xf, true);
    return fmaxf(x, __builtin_bit_cast(float, y)); }
__device__ __forceinline__ float max16(float x) { x = dpp_max<0xB1>(x); x = dpp_max<0x4E>(x); x = dpp_max<0x141>(x); x = dpp_max<0x140>(x); return x; }
__device__ __forceinline__ float red8(float x) { x = dpp_add<0xB1>(x); x = dpp_add<0x4E>(x); x = dpp_add<0x141>(x); return x; }
__device__ __forceinline__ float red16(float x) { x = red8(x); x = dpp_add<0x140>(x); return x; }
__device__ __forceinline__ float wave_sum(float v) {
    v = red16(v);
    const float r0 = __builtin_bit_cast(float, __builtin_amdgcn_readlane(__builtin_bit_cast(int, v), 0)), r1 = __builtin_bit_cast(float, __builtin_amdgcn_readlane(__builtin_bit_cast(int, v), 16));
    const float r2 = __builtin_bit_cast(float, __builtin_amdgcn_readlane(__builtin_bit_cast(int, v), 32)), r3 = __builtin_bit_cast(float, __builtin_amdgcn_readlane(__builtin_bit_cast(int, v), 48));
    return (r0 + r1) + (r2 + r3); }
typedef float f32x2 __attribute__((ext_vector_type(2)));
typedef unsigned u32x2 __attribute__((ext_vector_type(2)));
__device__ __forceinline__ float sigmoidf_(float v) { return __builtin_amdgcn_rcpf(1.0f + __expf(-v)); }
__device__ __forceinline__ void unpack8(const uint4 r, float (&f)[8]) {
    f[0] = bflo(r.x); f[1] = bfhi(r.x); f[2] = bflo(r.y); f[3] = bfhi(r.y); f[4] = bflo(r.z); f[5] = bfhi(r.z); f[6] = bflo(r.w); f[7] = bfhi(r.w); }

__device__ __forceinline__ float act_apply(float v, int act) {
    switch (act) {
        case 1: { const float r = fmaxf(v, 0.f); return r * r; }
        case 2: return 1.0f - 2.0f * __builtin_amdgcn_rcpf(1.0f + __expf(2.0f * v));
        case 3: return sigmoidf_(v);
        case 4: return 0.60653066f * sigmoidf_(v);
        default: return v; }
}
struct EpiB {
    static constexpr bool PERM = true, AFTER_DRAIN = false;
    const GemmOp* ops;
    template <int MODE  >
    __device__ __forceinline__ void body(const f32x4 (&acc)[2][2][4][2], bf16_t* O, int ldc, const float* bias, float scale, int row0, int col0) const {
        f32x4 bv[2][2];
        if (MODE == 3) {
#pragma unroll
            for (int bj = 0; bj < 2; ++bj)
#pragma unroll
                for (int n = 0; n < 2; ++n) bv[bj][n] = bias ? *(const f32x4*)(bias + col0 + bj * 128 + 4 * n) : (f32x4){0.f, 0.f, 0.f, 0.f}; }
#pragma unroll
        for (int ai = 0; ai < 2; ++ai)
#pragma unroll
            for (int m = 0; m < 4; ++m) { bf16_t* rowp = O + (size_t)(row0 + ai * 128 + m * 16) * ldc + col0;
#pragma unroll
                for (int bj = 0; bj < 2; ++bj) { f32x4 v0 = acc[ai][bj][m][0], v1 = acc[ai][bj][m][1];
                    if (MODE == 1) {
#pragma unroll
                        for (int j = 0; j < 4; ++j) { const float a0 = fmaxf(v0[j], 0.f), a1 = fmaxf(v1[j], 0.f); v0[j] = a0 * a0; v1[j] = a1 * a1; } }
                    if (MODE == 3) { v0 += bv[bj][0]; v1 += bv[bj][1];
#pragma unroll
                        for (int j = 0; j < 4; ++j) { v0[j] = scale * __builtin_amdgcn_rcpf(1.0f + __expf(-v0[j])); v1[j] = scale * __builtin_amdgcn_rcpf(1.0f + __expf(-v1[j])); } }
                    if (MODE == 4) {
#pragma unroll
                        for (int j = 0; j < 4; ++j) { v0[j] = 1.0f - 2.0f * __builtin_amdgcn_rcpf(1.0f + __expf(2.0f * v0[j])); v1[j] = 1.0f - 2.0f * __builtin_amdgcn_rcpf(1.0f + __expf(2.0f * v1[j])); } }
                    u32x4 w; w.x = cvt_pk_bf16(v0[0], v0[1]); w.y = cvt_pk_bf16(v0[2], v0[3]); w.z = cvt_pk_bf16(v1[0], v1[1]); w.w = cvt_pk_bf16(v1[2], v1[3]);
                    *(u32x4*)(rowp + bj * 128) = w; } }
    }
    __device__ __forceinline__ void operator()(const f32x4 (&acc)[2][2][4][2], const pg8::Unit& u, int wr, int wc, int fr, int fq) const {
        const GemmOp& o_ = ops[u.op]; bf16_t* O = (bf16_t*)o_.out; const int ldc = o_.ldc; const float* bias = o_.bias; const int act = o_.act;
        const int row0 = u.pm * 256 + wr * 64 + fr, col0 = u.pn * 256 + wc * 32 + 8 * fq;
        if (act == 0) body<0>(acc, O, ldc, bias, 1.0f, row0, col0);
        else if (act == 1) body<1>(acc, O, ldc, bias, 1.0f, row0, col0);
        else if (act == 2) body<4>(acc, O, ldc, bias, 1.0f, row0, col0);
        else body<3>(acc, O, ldc, bias, act == 4 ? 0.60653066f : 1.0f, row0, col0);
    }
};

struct MultiOrder {
    const GemmOp* ops; int nops, G, c;
    __device__ __forceinline__ bool next(int i, pg8::Unit& u) const {
        long L = (long)i * G + c; int k = 0, nM = 0, nN = 0, nwg = 0;
        for (; k < nops; ++k) { nM = ops[k].M / 256; nN = ops[k].N / 256; nwg = nM * nN; if (L < nwg) break; L -= nwg; }
        if (k == nops) return false;
        int wgid = (int)L; { const int q = nwg / pg8::NXCD, r = nwg % pg8::NXCD, xcd = wgid % pg8::NXCD, off = wgid / pg8::NXCD; wgid = (xcd < r ? xcd * (q + 1) : r * (q + 1) + (xcd - r) * q) + off; }
        const int nig = pg8::WGM * nN, gid = wgid / nig, fm = gid * pg8::WGM, gsz = (nM - fm) < pg8::WGM ? (nM - fm) : pg8::WGM;
        u.pm = fm + ((wgid % nig) % gsz); u.pn = (wgid % nig) / gsz; u.op = k; return true;
    }
    __device__ __forceinline__ const char* abase(const pg8::Unit& u, const pg8::Gemm&) const { return (const char*)ops[u.op].A; }
    __device__ __forceinline__ const char* bbase(const pg8::Unit& u, const pg8::Gemm&) const { return (const char*)ops[u.op].Bt; }
    __device__ __forceinline__ void a_ready(const pg8::Unit&) const {}
    __device__ __forceinline__ void done(const pg8::Unit&) const {}
};
struct EpiF {
    static constexpr bool PERM = false, AFTER_DRAIN = false;
    float* C; int ldc; const float* res;
    __device__ __forceinline__ void operator()(const f32x4 (&acc)[2][2][4][2], const pg8::Unit& u, int wr, int wc, int fr, int fq) const {
        const int row0 = u.pm * 256 + wr * 64 + fr, col0 = u.pn * 256 + wc * 32 + 4 * fq;
#pragma unroll
        for (int ai = 0; ai < 2; ++ai)
#pragma unroll
            for (int mh = 0; mh < 2; ++mh) { size_t ro[2]; f32x4 r[2][2][2];
#pragma unroll
                for (int mm = 0; mm < 2; ++mm) { ro[mm] = (size_t)(row0 + ai * 128 + (mh * 2 + mm) * 16) * ldc + col0;
#pragma unroll
                    for (int bj = 0; bj < 2; ++bj)
#pragma unroll
                        for (int n = 0; n < 2; ++n) r[mm][bj][n] = *(const f32x4*)(res + ro[mm] + bj * 128 + n * 16); }
#pragma unroll
                for (int mm = 0; mm < 2; ++mm)
#pragma unroll
                    for (int bj = 0; bj < 2; ++bj)
#pragma unroll
                        for (int n = 0; n < 2; ++n) *(f32x4*)(C + ro[mm] + bj * 128 + n * 16) = acc[ai][bj][mh * 2 + mm][n] + r[mm][bj][n]; }
    }
};

__device__ __forceinline__ void convert_one_tile(const Params& p, int jlo, int jhi, int tile, int tid, LAS float* T) {
    int j = jlo; while (j + 1 < jhi && tile >= p.cj[j + 1].tile0) ++j;
    const float* src = p.cj[j].src; bf16_t* dst = p.cj[j].dst; const int K = p.cj[j].K, N = p.cj[j].N, Kpad = p.cj[j].Kpad;
    const int local = tile - p.cj[j].tile0, nkt = Kpad >> 6, kt = local % nkt, nt = local / nkt;
    f32x4 v[8];
#pragma unroll
    for (int i = 0; i < 8; ++i) { const int idx = tid + i * 512, kr = idx >> 6, c4 = idx & 63, k = kt * 64 + kr, n = nt * 256 + c4 * 4;
        v[i] = (f32x4){0.f, 0.f, 0.f, 0.f};
        if (k < K && n < N) v[i] = *(const f32x4*)(src + (size_t)k * N + n); }
#pragma unroll
    for (int i = 0; i < 8; ++i) { const int idx = tid + i * 512, kr = idx >> 6, c4 = idx & 63;
        T[kr * 257 + c4 * 4 + 0] = v[i][0]; T[kr * 257 + c4 * 4 + 1] = v[i][1]; T[kr * 257 + c4 * 4 + 2] = v[i][2]; T[kr * 257 + c4 * 4 + 3] = v[i][3]; }
    __syncthreads();
#pragma unroll
    for (int i = 0; i < 4; ++i) { const int idx = tid + i * 512, nl = idx >> 3, kc = idx & 7; float f[8];
#pragma unroll
        for (int e = 0; e < 8; ++e) f[e] = T[(kc * 8 + e) * 257 + nl];
        u32x4 w; w.x = cvt_pk_nv(f[0], f[1]); w.y = cvt_pk_nv(f[2], f[3]); w.z = cvt_pk_nv(f[4], f[5]); w.w = cvt_pk_nv(f[6], f[7]);
        *(u32x4*)(dst + (size_t)(nt * 256 + nl) * Kpad + kt * 64 + kc * 8) = w; }
    __syncthreads();
}
__device__ __forceinline__ void convert_tiles(const Params& p, int jlo, int jhi, LAS unsigned char* lds) {
    const int tid = opq(threadIdx.x); LAS float* T = (LAS float*)lds;
    const int total = p.cj[jhi - 1].tile0 + p.cj[jhi - 1].ntiles;
    for (int tile = blockIdx.x; tile < total; tile += gridDim.x) convert_one_tile(p, jlo, jhi, tile, tid, T);
}
__device__ __forceinline__ void convert_queue(const Params& p, int jlo, int jhi, unsigned* counter, LAS unsigned char* lds) {
    const int tid = opq(threadIdx.x); LAS float* T = (LAS float*)lds; LAS int* slot = (LAS int*)(lds + 72 * 1024);
    const int total = p.cj[jhi - 1].tile0 + p.cj[jhi - 1].ntiles;
    for (;;) {
        __syncthreads();
        if (tid == 0) *slot = (int)__hip_atomic_fetch_add(counter, 1u, __ATOMIC_RELAXED, __HIP_MEMORY_SCOPE_AGENT);
        __syncthreads();
        const int tile = *slot;
        if (tile >= total) break;
        convert_one_tile(p, jlo, jhi, tile, tid, T);
    }
}

__device__ __forceinline__ void rope_table(const Params& p) {
    float2* tab = (float2*)(p.ws + WS_ROPE);
    for (int idx = blockIdx.x * 512 + opq(threadIdx.x); idx < SEQ * 32; idx += gridDim.x * 512) {
        const int t = idx >> 5, i = idx & 31;
        const float inv = exp2f(-(float)i * 0.41524101186092029f);
        const float angf = (float)t * inv;
        const double ang = (double)angf;
        const double q = rint(ang * 0.6366197723675814);
        const float f = (float)fma(-q, 1.5707963267948966, ang), f2 = f * f;
        const float s = f * (1.0f + f2 * (-1.6666667e-1f + f2 * (8.3333333e-3f + f2 * (-1.9841270e-4f + f2 * 2.7557319e-6f))));
        const float c = 1.0f + f2 * (-0.5f + f2 * (4.1666667e-2f + f2 * (-1.3888889e-3f + f2 * (2.4801587e-5f + f2 * (-2.7557319e-7f)))));
        const int qi = ((int)q) & 3;
        const float sn = (qi == 0) ? s : (qi == 1) ? c : (qi == 2) ? -s : -c;
        const float cs = (qi == 0) ? c : (qi == 1) ? -s : (qi == 2) ? -c : s;
        tab[idx] = make_float2(cs, sn);
    }
}

__device__ __forceinline__ void norm_rows(const float* x, const float* g, bf16_t* h) {
    const int tid_ = opq(threadIdx.x); const int lane = tid_ & 63, wv = tid_ >> 6;
    f32x4 gg[8];
#pragma unroll
    for (int i = 0; i < 8; ++i) gg[i] = *(const f32x4*)(g + i * 256 + lane * 4);
    for (int row = (blockIdx.x * 8 + wv) * 2; row < MTOK; row += gridDim.x * 16) {
        const float* xr = x + (size_t)row * D; f32x4 v[8], u[8]; float ss = 0.f, st = 0.f;
#pragma unroll
        for (int i = 0; i < 8; ++i) { v[i] = *(const f32x4*)(xr + i * 256 + lane * 4); u[i] = *(const f32x4*)(xr + D + i * 256 + lane * 4); }
#pragma unroll
        for (int i = 0; i < 8; ++i) { ss += v[i][0] * v[i][0] + v[i][1] * v[i][1] + v[i][2] * v[i][2] + v[i][3] * v[i][3]; st += u[i][0] * u[i][0] + u[i][1] * u[i][1] + u[i][2] * u[i][2] + u[i][3] * u[i][3]; }
        ss = wave_sum(ss); st = wave_sum(st); const float r = rsqrtf(ss * (1.0f / D) + 1e-6f), r2 = rsqrtf(st * (1.0f / D) + 1e-6f);
#pragma unroll
        for (int i = 0; i < 8; ++i) {
            uint2 w; w.x = cvt_pk_nv(v[i][0] * r * gg[i][0], v[i][1] * r * gg[i][1]); w.y = cvt_pk_nv(v[i][2] * r * gg[i][2], v[i][3] * r * gg[i][3]);
            *(uint2*)(h + (size_t)row * D + i * 256 + lane * 4) = w;
            uint2 w2; w2.x = cvt_pk_nv(u[i][0] * r2 * gg[i][0], u[i][1] * r2 * gg[i][1]); w2.y = cvt_pk_nv(u[i][2] * r2 * gg[i][2], u[i][3] * r2 * gg[i][3]);
            *(uint2*)(h + (size_t)(row + 1) * D + i * 256 + lane * 4) = w2; }
    }
}

__device__ __forceinline__ void mix_rows(const float* x, const float* g, const float* mixw, bf16_t* mixbase, int tok0, LAS unsigned char* lds) {
    const int tid = opq(threadIdx.x), lane = tid & 63, wv = tid >> 6, c = tid * 4;
    LAS float* rs = (LAS float*)lds;
    const f32x4 gg = *(const f32x4*)(g + c); f32x4 mw[6];
#pragma unroll
    for (int m = 0; m < 6; ++m) mw[m] = *(const f32x4*)(mixw + m * D + c);
    for (int chunk = blockIdx.x; chunk < 256; chunk += gridDim.x) {
        const int rl0 = chunk * 32, tokc = tok0 + rl0; const bool hasprev = (tokc & (SEQ - 1)) != 0;
        __syncthreads();
        for (int r = wv; r < 33; r += 8) {
            float ss = 0.f;
            if (r > 0 || hasprev) { const float* xr = x + (size_t)(tokc - 1 + r) * D; f32x4 v[8];
#pragma unroll
                for (int i = 0; i < 8; ++i) v[i] = *(const f32x4*)(xr + i * 256 + lane * 4);
#pragma unroll
                for (int i = 0; i < 8; ++i) ss += v[i][0] * v[i][0] + v[i][1] * v[i][1] + v[i][2] * v[i][2] + v[i][3] * v[i][3]; }
            ss = wave_sum(ss);
            if (lane == 0) rs[r] = (r > 0 || hasprev) ? rsqrtf(ss * (1.0f / D) + 1e-6f) : 0.f;
        }
        __syncthreads();
        f32x4 prev = (f32x4){0.f, 0.f, 0.f, 0.f};
        if (hasprev) { const f32x4 pv = *(const f32x4*)(x + (size_t)(tokc - 1) * D + c); const float rp = rs[0]; prev = pv * rp * gg; }
        for (int r0 = 0; r0 < 32; r0 += 4) {
            f32x4 xv[4];
#pragma unroll
            for (int u = 0; u < 4; ++u) xv[u] = *(const f32x4*)(x + (size_t)(tokc + r0 + u) * D + c);
#pragma unroll
            for (int u = 0; u < 4; ++u) { const float rr = rs[r0 + u + 1]; const f32x4 hn = xv[u] * rr * gg, xx = prev - hn;
#pragma unroll
                for (int m = 0; m < 6; ++m) { const f32x4 o = hn + xx * mw[m];
                    uint2 w; w.x = cvt_pk_nv(o[0], o[1]); w.y = cvt_pk_nv(o[2], o[3]);
                    *(uint2*)(mixbase + (size_t)m * 8192 * D + (size_t)(rl0 + r0 + u) * D + c) = w; }
                prev = hn; }
        }
    }
}

__device__ __forceinline__ void conv_ssd(const Params& p) {
    const bf16_t* proj = (const bf16_t*)(p.ws + WS_PROJ); bf16_t* xbc = (bf16_t*)(p.ws + WS_XBC);
    const float* cw = p.in[6]; const float* cb = p.in[7];
    const int tid = opq(threadIdx.x);
    if (tid < 384) {
        const int c8 = tid % 192, par = tid / 192, c = c8 * 8;
        float w[4][8], bb[8];
#pragma unroll
        for (int j = 0; j < 4; ++j) { const f32x4 w0 = *(const f32x4*)(cw + j * 1536 + c), w1 = *(const f32x4*)(cw + j * 1536 + c + 4);
#pragma unroll
            for (int e = 0; e < 4; ++e) { w[j][e] = w0[e]; w[j][4 + e] = w1[e]; } }
        { const f32x4 b0 = *(const f32x4*)(cb + c), b1 = *(const f32x4*)(cb + c + 4);
#pragma unroll
          for (int e = 0; e < 4; ++e) { bb[e] = b0[e]; bb[4 + e] = b1[e]; } }
        for (int chunk = blockIdx.x; chunk < 256; chunk += gridDim.x) {
            const int t0 = chunk * 64 + par * 32; const bool hasprev = (t0 & (SEQ - 1)) != 0;
            float r0[8], r1[8], r2[8];
            if (hasprev) { const uint4 a = *(const uint4*)(proj + (size_t)(t0 - 3) * INWP + COL_XBC + c), b = *(const uint4*)(proj + (size_t)(t0 - 2) * INWP + COL_XBC + c), d = *(const uint4*)(proj + (size_t)(t0 - 1) * INWP + COL_XBC + c);
                unpack8(a, r0); unpack8(b, r1); unpack8(d, r2); }
            else {
#pragma unroll
                for (int e = 0; e < 8; ++e) { r0[e] = 0.f; r1[e] = 0.f; r2[e] = 0.f; } }
            for (int tg = 0; tg < 32; tg += 4) {
                uint4 rw[4];
#pragma unroll
                for (int u = 0; u < 4; ++u) rw[u] = *(const uint4*)(proj + (size_t)(t0 + tg + u) * INWP + COL_XBC + c);
#pragma unroll
                for (int u = 0; u < 4; ++u) { float cur[8], acc[8]; unpack8(rw[u], cur);
#pragma unroll
                    for (int e = 0; e < 8; ++e) { acc[e] = bb[e] + w[0][e] * r0[e] + w[1][e] * r1[e] + w[2][e] * r2[e] + w[3][e] * cur[e]; acc[e] = acc[e] * sigmoidf_(acc[e]); r0[e] = r1[e]; r1[e] = r2[e]; r2[e] = cur[e]; }
                    u32x4 o; o.x = cvt_pk_nv(acc[0], acc[1]); o.y = cvt_pk_nv(acc[2], acc[3]); o.z = cvt_pk_nv(acc[4], acc[5]); o.w = cvt_pk_nv(acc[6], acc[7]);
                    *(u32x4*)(xbc + (size_t)(t0 + tg + u) * 1536 + c) = o; }
            }
        }
    }
    float* dt = (float*)(p.ws + WS_DT); float* da = (float*)(p.ws + WS_DA);
    for (int idx = blockIdx.x * 512 + opq(threadIdx.x); idx < MTOK * 16; idx += gridDim.x * 512) {
        const int tok = idx >> 4, hh = idx & 15;
        const float v = bf2f(proj[(size_t)tok * INWP + COL_DT + hh]) + p.in[8][hh];
        const float d = fmaxf(v, 0.f) + __logf(1.0f + __expf(-fabsf(v)));
        dt[idx] = d; da[idx] = __expf(-d * __expf(p.in[9][hh]));
    }
}

__device__ __forceinline__ void ssd_scan_job(const Params& p, int job, LAS unsigned char* lds) {
    const int tid = opq(threadIdx.x);
    const int b = job >> 5, hs = (job >> 1) & 15, half = job & 1, grp = hs >> 3, p0 = half * 32;
    const bf16_t* xbc = (const bf16_t*)(p.ws + WS_XBC) + (size_t)b * SEQ * 1536;
    const float* dtp = (const float*)(p.ws + WS_DT) + (size_t)b * SEQ * 16 + hs;
    const float* dap = (const float*)(p.ws + WS_DA) + (size_t)b * SEQ * 16 + hs;
    float* yraw = (float*)(p.ws + WS_YRAW) + (size_t)b * SEQ * 1024 + hs * 64 + p0;
    const float dskip = p.in[10][hs];
    constexpr int BUF_F = 9280;
    LAS float* L = (LAS float*)lds;
    const bool producer = tid >= 256; const int ptid = tid & 255;
    int grow[5], gcol[5], loff[5];
#pragma unroll
    for (int k = 0; k < 5; ++k) { const int q = ptid + k * 256, row = q / 36, pc = q - row * 36; grow[k] = row;
        if (pc < 4) { gcol[k] = hs * 64 + p0 + pc * 8; loff[k] = row * 32 + pc * 8; }
        else if (pc < 20) { gcol[k] = 1024 + grp * 128 + (pc - 4) * 8; loff[k] = 1024 + row * 128 + (pc - 4) * 8; }
        else { gcol[k] = 1280 + grp * 128 + (pc - 20) * 8; loff[k] = 5120 + row * 128 + (pc - 20) * 8; } }
    uint4 rg[5]; float sc = 0.f;
#define SSD_ISSUE(t0) do { _Pragma("unroll") for (int k = 0; k < 5; ++k) if (ptid + k * 256 < 1152) rg[k] = *(const uint4*)(xbc + (size_t)((t0) + grow[k]) * 1536 + gcol[k]); \
        if (ptid < 32) sc = dtp[((t0) + ptid) * 16]; else if (ptid < 64) sc = dap[((t0) + ptid - 32) * 16]; } while (0)
#define SSD_COMMIT(buf) do { LAS float* Lc = L + (buf) * BUF_F; _Pragma("unroll") for (int k = 0; k < 5; ++k) if (ptid + k * 256 < 1152) { float f[8]; unpack8(rg[k], f); \
            *(LAS f32x4*)(Lc + loff[k]) = (f32x4){f[0], f[1], f[2], f[3]}; *(LAS f32x4*)(Lc + loff[k] + 4) = (f32x4){f[4], f[5], f[6], f[7]}; } \
        if (ptid < 32) Lc[9216 + ptid] = sc; else if (ptid < 64) Lc[9248 + ptid - 32] = sc; } while (0)
#define SSD_FLUSH(chp) do { LAS float* yo = L + 2 * BUF_F + ((chp) & 1) * 1024; const f32x4 v = *(LAS f32x4*)(yo + (ptid >> 3) * 32 + (ptid & 7) * 4); \
        *(f32x4*)(yraw + (size_t)((chp) * 32 + (ptid >> 3)) * 1024 + (ptid & 7) * 4) = v; } while (0)
    f32x2 hA[4], hB[4];
#pragma unroll
    for (int i = 0; i < 4; ++i) { hA[i] = (f32x2){0.f, 0.f}; hB[i] = (f32x2){0.f, 0.f}; }
    const int prow = (tid >> 4) & 15, nseg = tid & 15;
    __syncthreads();
    if (producer) { SSD_ISSUE(0); SSD_COMMIT(0); SSD_ISSUE(32); }
    __syncthreads();
    for (int ch = 0; ch < 64; ++ch) {
        const int cur = ch & 1;
        if (producer) {
            if (ch >= 1) SSD_FLUSH(ch - 1);
            if (ch + 1 < 64) SSD_COMMIT(cur ^ 1);
            if (ch + 2 < 64) SSD_ISSUE((ch + 2) * 32);
        } else {
        LAS float* Lb = L + cur * BUF_F; LAS float* yb = L + 2 * BUF_F + cur * 1024;
        for (int tg = 0; tg < 32; tg += 16) {
            float yA[16], yB[16];
            LAS float* qb = Lb + 1024 + tg * 128 + nseg * 8;
            f32x4 b0 = *(LAS f32x4*)(qb), b1 = *(LAS f32x4*)(qb + 4), c0 = *(LAS f32x4*)(qb + 4096), c1 = *(LAS f32x4*)(qb + 4100);
            float dA = Lb[9248 + tg], xa = Lb[tg * 32 + prow], xb = Lb[tg * 32 + prow + 16], dtv = Lb[9216 + tg];
#pragma unroll
            for (int tt = 0; tt < 16; ++tt) {
                f32x4 nb0, nb1, nc0, nc1; float ndA, nxa, nxb, ndtv;
                if (tt + 1 < 16) { LAS float* q = qb + (tt + 1) * 128; nb0 = *(LAS f32x4*)(q); nb1 = *(LAS f32x4*)(q + 4); nc0 = *(LAS f32x4*)(q + 4096); nc1 = *(LAS f32x4*)(q + 4100);
                    ndA = Lb[9248 + tg + tt + 1]; nxa = Lb[(tg + tt + 1) * 32 + prow]; nxb = Lb[(tg + tt + 1) * 32 + prow + 16]; ndtv = Lb[9216 + tg + tt + 1]; }
                __builtin_amdgcn_sched_barrier(0);
                const float xdta = xa * dtv, xdtb = xb * dtv;
                const f32x2 dA2 = (f32x2){dA, dA}, xa2 = (f32x2){xdta, xdta}, xb2 = (f32x2){xdtb, xdtb};
                hA[0] = hA[0] * dA2 + xa2 * b0.xy; hB[0] = hB[0] * dA2 + xb2 * b0.xy; hA[1] = hA[1] * dA2 + xa2 * b0.zw; hB[1] = hB[1] * dA2 + xb2 * b0.zw;
                hA[2] = hA[2] * dA2 + xa2 * b1.xy; hB[2] = hB[2] * dA2 + xb2 * b1.xy; hA[3] = hA[3] * dA2 + xa2 * b1.zw; hB[3] = hB[3] * dA2 + xb2 * b1.zw;
                f32x2 ya = hA[0] * c0.xy, yb2 = hB[0] * c0.xy; ya = hA[1] * c0.zw + ya; yb2 = hB[1] * c0.zw + yb2; ya = hA[2] * c1.xy + ya; yb2 = hB[2] * c1.xy + yb2; ya = hA[3] * c1.zw + ya; yb2 = hB[3] * c1.zw + yb2;
                float ra = ya.x + ya.y, rb = yb2.x + yb2.y;
                ra = dpp_add<0xB1>(ra); rb = dpp_add<0xB1>(rb); ra = dpp_add<0x4E>(ra); rb = dpp_add<0x4E>(rb); ra = dpp_add<0x141>(ra); rb = dpp_add<0x141>(rb); ra = dpp_add<0x140>(ra); rb = dpp_add<0x140>(rb);
                yA[tt] = ra + dskip * xa; yB[tt] = rb + dskip * xb;
                __builtin_amdgcn_sched_barrier(0);
                if (tt + 1 < 16) { b0 = nb0; b1 = nb1; c0 = nc0; c1 = nc1; dA = ndA; xa = nxa; xb = nxb; dtv = ndtv; }
            }
            if (nseg == 0) {
#pragma unroll
                for (int tt = 0; tt < 16; ++tt) { yb[(tg + tt) * 32 + prow] = yA[tt]; yb[(tg + tt) * 32 + prow + 16] = yB[tt]; } }
        }
        }
        __syncthreads();
    }
    if (producer) SSD_FLUSH(63);
#undef SSD_ISSUE
#undef SSD_COMMIT
#undef SSD_FLUSH
}

__device__ __forceinline__ void ssd_chunk_job(const Params& p, int job, LAS unsigned char* lds) {
    const int tid = opq(threadIdx.x), lane = tid & 63, w = tid >> 6, fr = lane & 15, fq = lane >> 4;
    const int b = job >> 5, hs = (job >> 1) & 15, half = job & 1, grp = hs >> 3, p0 = half * 32;
    const bf16_t* xbc = (const bf16_t*)(p.ws + WS_XBC) + (size_t)b * SEQ * 1536;
    const float* dtp = (const float*)(p.ws + WS_DT) + (size_t)b * SEQ * 16 + hs;
    float* yraw = (float*)(p.ws + WS_YRAW) + (size_t)b * SEQ * 1024 + hs * 64 + p0;
    const float dskip = p.in[10][hs], Ah = -__expf(p.in[9][hs]);
    constexpr int RS = 136;
    LAS bf16_t* Cs = (LAS bf16_t*)lds;
    LAS bf16_t* Bs = (LAS bf16_t*)(lds + 34816);
    LAS bf16_t* BTs = (LAS bf16_t*)(lds + 69632);
    LAS bf16_t* XTa = (LAS bf16_t*)(lds + 104448);
    LAS bf16_t* XTb = (LAS bf16_t*)(lds + 113152);
    LAS bf16_t* Ps = (LAS bf16_t*)(lds + 121856);
    LAS float* af = (LAS float*)(lds + 130560);
    LAS float* dtf = (LAS float*)(lds + 131584);
    const int crow0 = tid >> 4, cpc = tid & 15;
    const int xk = tid >> 2, xpc = tid & 3;
    u32x4 rc[4], rb[4], rx; float rdt = 0.f;
#define SC_ISSUE(t0) do { _Pragma("unroll") for (int i = 0; i < 4; ++i) { const bf16_t* rp_ = xbc + (size_t)((t0) + (crow0 + 32 * i)) * 1536 + grp * 128 + cpc * 8; rb[i] = *(const u32x4*)(rp_ + 1024); rc[i] = *(const u32x4*)(rp_ + 1280); } \
        rx = *(const u32x4*)(xbc + (size_t)((t0) + xk) * 1536 + hs * 64 + p0 + xpc * 8); if (tid < 128) rdt = dtp[((t0) + tid) * 16]; } while (0)
    f32x4 st[2];
    st[0] = (f32x4){0.f, 0.f, 0.f, 0.f}; st[1] = st[0];
    __syncthreads();
    for (int i = tid; i < 32 * RS / 2; i += 512) ((LAS unsigned*)Ps)[i] = 0u;
    SC_ISSUE(0);
    for (int ch = 0; ch < 16; ++ch) {
        const int t0 = ch * 128;
        __syncthreads();
#pragma unroll
        for (int i = 0; i < 4; ++i) { *(LAS u32x4*)(Cs + (crow0 + 32 * i) * RS + cpc * 8) = rc[i]; *(LAS u32x4*)(Bs + (crow0 + 32 * i) * RS + cpc * 8) = rb[i];

#pragma unroll
            for (int e = 0; e < 4; ++e) { BTs[(cpc * 8 + 2 * e) * RS + (crow0 + 32 * i)] = (bf16_t)(rb[i][e] & 0xffffu); BTs[(cpc * 8 + 2 * e + 1) * RS + (crow0 + 32 * i)] = (bf16_t)(rb[i][e] >> 16); } }
        float csv = 0.f;
        if (tid < 128) {
            csv = rdt * Ah; dtf[tid] = rdt;
#pragma unroll
            for (int off = 1; off < 64; off <<= 1) { const float t_ = __shfl_up(csv, off); if (lane >= off) csv += t_; }
            if (tid == 63) af[128] = csv;
        }
        float xr[8]; xr[0] = bflo(rx[0]); xr[1] = bfhi(rx[0]); xr[2] = bflo(rx[1]); xr[3] = bfhi(rx[1]); xr[4] = bflo(rx[2]); xr[5] = bfhi(rx[2]); xr[6] = bflo(rx[3]); xr[7] = bfhi(rx[3]);
        __syncthreads();
        if (tid < 128) af[tid] = (tid >= 64) ? csv + af[128] : csv;
        __syncthreads();
        const float cs_last = af[127];
        { const float d = dtf[xk], dout = __expf(cs_last - af[xk]);
#pragma unroll
          for (int e = 0; e < 8; ++e) { const float xa = xr[e] * d; XTa[(xpc * 8 + e) * RS + xk] = f2bf(xa); XTb[(xpc * 8 + e) * RS + xk] = f2bf(xa * dout); } }
        __syncthreads();
        bf16x8 cf[4];
#pragma unroll
        for (int ks = 0; ks < 4; ++ks) cf[ks] = *(LAS bf16x8*)(Cs + (w * 16 + fr) * RS + ks * 32 + fq * 8);
        f32x4 yo[2];
#pragma unroll
        for (int pt = 0; pt < 2; ++pt) { f32x4 acc = (f32x4){0.f, 0.f, 0.f, 0.f};
#pragma unroll
            for (int ks = 0; ks < 4; ++ks) { const bf16x8 pb = *(LAS bf16x8*)(Ps + (pt * 16 + fr) * RS + ks * 32 + fq * 8); acc = __builtin_amdgcn_mfma_f32_16x16x32_bf16(cf[ks], pb, acc, 0, 0, 0); }
            yo[pt] = acc; }
        float csq[4];
#pragma unroll
        for (int i = 0; i < 4; ++i) csq[i] = af[w * 16 + fq * 4 + i];
#pragma unroll
        for (int kt = 0; kt < 8; ++kt) { f32x4 acc = (f32x4){0.f, 0.f, 0.f, 0.f};
            if (kt > w) {
#pragma unroll
                for (int i = 0; i < 4; ++i) Cs[(w * 16 + fq * 4 + i) * RS + kt * 16 + fr] = (bf16_t)0;
                continue; }
#pragma unroll
            for (int ks = 0; ks < 4; ++ks) { const bf16x8 bb = *(LAS bf16x8*)(Bs + (kt * 16 + fr) * RS + ks * 32 + fq * 8); acc = __builtin_amdgcn_mfma_f32_16x16x32_bf16(cf[ks], bb, acc, 0, 0, 0); }
            const int kk = kt * 16 + fr; const float csk = af[kk];
#pragma unroll
            for (int i = 0; i < 4; ++i) { const int qq = w * 16 + fq * 4 + i; const float m = (kk <= qq) ? acc[i] * __expf(csq[i] - csk) : 0.f; Cs[qq * RS + kk] = f2bf(m); } }
        f32x4 yd[2];
        { bf16x8 mf[4];
#pragma unroll
          for (int ks = 0; ks < 4; ++ks) mf[ks] = *(LAS bf16x8*)(Cs + (w * 16 + fr) * RS + ks * 32 + fq * 8);
#pragma unroll
          for (int pt = 0; pt < 2; ++pt) { f32x4 acc = (f32x4){0.f, 0.f, 0.f, 0.f};
#pragma unroll
              for (int ks = 0; ks < 4; ++ks) { const bf16x8 xb = *(LAS bf16x8*)(XTa + (pt * 16 + fr) * RS + ks * 32 + fq * 8); acc = __builtin_amdgcn_mfma_f32_16x16x32_bf16(mf[ks], xb, acc, 0, 0, 0); }
              yd[pt] = acc; } }
        if (ch + 1 < 16) SC_ISSUE(t0 + 128);
#pragma unroll
        for (int pt = 0; pt < 2; ++pt)
#pragma unroll
            for (int i = 0; i < 4; ++i) { const int qq = w * 16 + fq * 4 + i, pp = pt * 16 + fr;
                const float xv = bf2f(xbc[(size_t)(t0 + qq) * 1536 + hs * 64 + p0 + pp]);
                yraw[(size_t)(t0 + qq) * 1024 + pp] = yd[pt][i] + __expf(csq[i]) * yo[pt][i] + dskip * xv; }
        __syncthreads();
        { const float cd = __expf(cs_last);
#pragma unroll
          for (int pt = 0; pt < 2; ++pt) { f32x4 acc = st[pt] * cd;
#pragma unroll
              for (int ks = 0; ks < 4; ++ks) { const bf16x8 xa = *(LAS bf16x8*)(XTb + (pt * 16 + fr) * RS + ks * 32 + fq * 8); const bf16x8 bt = *(LAS bf16x8*)(BTs + (w * 16 + fr) * RS + ks * 32 + fq * 8);
                  acc = __builtin_amdgcn_mfma_f32_16x16x32_bf16(xa, bt, acc, 0, 0, 0); }
              st[pt] = acc;
#pragma unroll
              for (int i = 0; i < 4; ++i) Ps[(pt * 16 + fq * 4 + i) * RS + w * 16 + fr] = f2bf(acc[i]); } }
    }
#undef SC_ISSUE
}

__device__ __forceinline__ void attn_job(const Params& p, int job, LAS unsigned char* lds) {
    const int tid = opq(threadIdx.x), lane = tid & 63, w = tid >> 6, fr = lane & 15, fq = lane >> 4;
    const int b = job >> 6, kvh = (job >> 4) & 3, nb = job & 15;
    const bf16_t* proj = (const bf16_t*)(p.ws + WS_PROJ) + (size_t)b * SEQ * INWP;
    const float2* rope = (const float2*)(p.ws + WS_ROPE);
    LAS bf16_t* Ks = (LAS bf16_t*)lds;
    LAS bf16_t* Vt = (LAS bf16_t*)(lds + 36864);
    LAS bf16_t* Ps = (LAS bf16_t*)(lds + 70656) + w * 16 * 264;
    __syncthreads();
    if (tid < 256) {
        const int kr = tid, tk = (nb - 1) * 128 + kr;
        if (tk >= 0) {
            const bf16_t* src = proj + (size_t)tk * INWP + COL_K + kvh * 64; float x[64]; float ss = 0.f;
#pragma unroll
            for (int c = 0; c < 8; ++c) { const uint4 r = *(const uint4*)(src + c * 8); float f[8]; unpack8(r, f);
#pragma unroll
                for (int e = 0; e < 8; ++e) { x[c * 8 + e] = f[e]; ss += f[e] * f[e]; } }
            const float rinv = rsqrtf(ss * (1.0f / 64) + 1e-6f); const float* kn = p.in[13];
#pragma unroll
            for (int i = 0; i < 64; ++i) x[i] = x[i] * rinv * kn[i];
#pragma unroll
            for (int c = 0; c < 4; ++c) { float o1[8], o2[8];
#pragma unroll
                for (int e = 0; e < 8; ++e) { const int i = c * 8 + e; const float2 cs = rope[tk * 32 + i]; o1[e] = x[i] * cs.x - x[i + 32] * cs.y; o2[e] = x[i + 32] * cs.x + x[i] * cs.y; }
                u32x4 w1, w2; w1.x = cvt_pk_bf16(o1[0], o1[1]); w1.y = cvt_pk_bf16(o1[2], o1[3]); w1.z = cvt_pk_bf16(o1[4], o1[5]); w1.w = cvt_pk_bf16(o1[6], o1[7]);
                w2.x = cvt_pk_bf16(o2[0], o2[1]); w2.y = cvt_pk_bf16(o2[2], o2[3]); w2.z = cvt_pk_bf16(o2[4], o2[5]); w2.w = cvt_pk_bf16(o2[6], o2[7]);
                *(LAS u32x4*)(Ks + kr * 72 + c * 8) = w1; *(LAS u32x4*)(Ks + kr * 72 + 32 + c * 8) = w2;
                __builtin_amdgcn_sched_barrier(0); }
        } else {
#pragma unroll
            for (int c = 0; c < 8; ++c) *(LAS u32x4*)(Ks + kr * 72 + c * 8) = (u32x4){0u, 0u, 0u, 0u};
        }
    } else {
        const int kr = tid - 256, tk = (nb - 1) * 128 + kr;
        const bf16_t* src = proj + (size_t)(tk < 0 ? 0 : tk) * INWP + COL_V + kvh * 64;
#pragma unroll
        for (int c = 0; c < 8; ++c) { uint4 r = *(const uint4*)(src + c * 8); if (tk < 0) r = make_uint4(0u, 0u, 0u, 0u);
            Vt[(c * 8 + 0) * 264 + kr] = (bf16_t)(r.x & 0xffffu); Vt[(c * 8 + 1) * 264 + kr] = (bf16_t)(r.x >> 16);
            Vt[(c * 8 + 2) * 264 + kr] = (bf16_t)(r.y & 0xffffu); Vt[(c * 8 + 3) * 264 + kr] = (bf16_t)(r.y >> 16);
            Vt[(c * 8 + 4) * 264 + kr] = (bf16_t)(r.z & 0xffffu); Vt[(c * 8 + 5) * 264 + kr] = (bf16_t)(r.z >> 16);
            Vt[(c * 8 + 6) * 264 + kr] = (bf16_t)(r.w & 0xffffu); Vt[(c * 8 + 7) * 264 + kr] = (bf16_t)(r.w >> 16); }
    }
    __syncthreads();
    const int tq = nb * 128 + w * 16 + fr;
    f32x4 csr[4]; f32x4 qn1[2], qn2[2];
#pragma unroll
    for (int e = 0; e < 4; ++e) csr[e] = *(const f32x4*)(rope + tq * 32 + fq * 8 + 2 * e);
    qn1[0] = *(const f32x4*)(p.in[12] + fq * 8); qn1[1] = *(const f32x4*)(p.in[12] + fq * 8 + 4); qn2[0] = *(const f32x4*)(p.in[12] + 32 + fq * 8); qn2[1] = *(const f32x4*)(p.in[12] + 32 + fq * 8 + 4);
    uint4 r0 = *(const uint4*)(proj + (size_t)tq * INWP + (kvh * 4) * 64 + fq * 8), r1 = *(const uint4*)(proj + (size_t)tq * INWP + (kvh * 4) * 64 + 32 + fq * 8);
    for (int h4 = 0; h4 < 4; ++h4) {
    const int hq = kvh * 4 + h4;
    bf16x8 qa[2];
    uint4 r0n = r0, r1n = r1;
    if (h4 + 1 < 4) { const bf16_t* srcn = proj + (size_t)tq * INWP + (hq + 1) * 64; r0n = *(const uint4*)(srcn + fq * 8); r1n = *(const uint4*)(srcn + 32 + fq * 8); }
    { float x1[8], x2[8]; unpack8(r0, x1); unpack8(r1, x2);
      float ss = 0.f;
#pragma unroll
      for (int e = 0; e < 8; ++e) ss += x1[e] * x1[e] + x2[e] * x2[e];
      ss += __shfl_xor(ss, 16); ss += __shfl_xor(ss, 32);
      const float rinv = rsqrtf(ss * (1.0f / 64) + 1e-6f) * 0.125f; float o1[8], o2[8];
#pragma unroll
      for (int e = 0; e < 8; ++e) { const float a = x1[e] * rinv * qn1[e >> 2][e & 3], c = x2[e] * rinv * qn2[e >> 2][e & 3]; const float cx = csr[e >> 1][(e & 1) * 2], sy = csr[e >> 1][(e & 1) * 2 + 1];
          o1[e] = a * cx - c * sy; o2[e] = c * cx + a * sy; }
      u32x4 w1, w2; w1.x = cvt_pk_bf16(o1[0], o1[1]); w1.y = cvt_pk_bf16(o1[2], o1[3]); w1.z = cvt_pk_bf16(o1[4], o1[5]); w1.w = cvt_pk_bf16(o1[6], o1[7]);
      w2.x = cvt_pk_bf16(o2[0], o2[1]); w2.y = cvt_pk_bf16(o2[2], o2[3]); w2.z = cvt_pk_bf16(o2[4], o2[5]); w2.w = cvt_pk_bf16(o2[6], o2[7]);
      qa[0] = __builtin_bit_cast(bf16x8, w1); qa[1] = __builtin_bit_cast(bf16x8, w2); }
    r0 = r0n; r1 = r1n;
    f32x4 s[16];
#pragma unroll
    for (int j = 0; j < 16; ++j) { f32x4 acc = (f32x4){0.f, 0.f, 0.f, 0.f};
#pragma unroll
        for (int ks = 0; ks < 2; ++ks) { const bf16x8 kb = *(LAS bf16x8*)(Ks + (j * 16 + fr) * 72 + ks * 32 + fq * 8); acc = __builtin_amdgcn_mfma_f32_16x16x32_bf16(qa[ks], kb, acc, 0, 0, 0); }
        s[j] = acc; }
    const float sink = p.in[14][hq];
    float mx[4], inv[4];
#pragma unroll
    for (int i = 0; i < 4; ++i) { const int qi = w * 16 + fq * 4 + i + 128; float m = -3.0e38f;
#pragma unroll
        for (int j = 0; j < 16; ++j) { const int kj = j * 16 + fr; const bool ok = (kj <= qi) && (qi - kj < 128) && (nb > 0 || kj >= 128); s[j][i] = ok ? s[j][i] : -3.0e38f; m = fmaxf(m, s[j][i]); }
        m = max16(m);
        m = fmaxf(m, sink); mx[i] = m; float l = 0.f;
#pragma unroll
        for (int j = 0; j < 16; ++j) { const float e = (s[j][i] > -1.0e38f) ? __expf(s[j][i] - m) : 0.f; s[j][i] = e; l += e; }
        l = red16(l);
        inv[i] = 1.0f / (l + __expf(sink - m)); }
#pragma unroll
    for (int j = 0; j < 16; ++j)
#pragma unroll
        for (int i = 0; i < 4; ++i) Ps[(fq * 4 + i) * 264 + j * 16 + fr] = f2bf(s[j][i] * inv[i]);
    f32x4 o[4];
#pragma unroll
    for (int nd = 0; nd < 4; ++nd) o[nd] = (f32x4){0.f, 0.f, 0.f, 0.f};
#pragma unroll
    for (int kk = 0; kk < 8; ++kk) { const bf16x8 pa = *(LAS bf16x8*)(Ps + fr * 264 + kk * 32 + fq * 8);
#pragma unroll
        for (int nd = 0; nd < 4; ++nd) { const bf16x8 vb = *(LAS bf16x8*)(Vt + (nd * 16 + fr) * 264 + kk * 32 + fq * 8); o[nd] = __builtin_amdgcn_mfma_f32_16x16x32_bf16(pa, vb, o[nd], 0, 0, 0); } }
    bf16_t* ymix = (bf16_t*)(p.ws + WS_YMIX) + (size_t)b * SEQ * D + hq * 64;
#pragma unroll
    for (int nd = 0; nd < 4; ++nd)
#pragma unroll
        for (int i = 0; i < 4; ++i) ymix[(size_t)(nb * 128 + w * 16 + fq * 4 + i) * D + nd * 16 + fr] = f2bf(o[nd][i]);
    }
}

__device__ __forceinline__ void post_ssd(const Params& p) {
    const int tid_ = opq(threadIdx.x); const int lane = tid_ & 63, wv = tid_ >> 6;
    const float* yraw = (const float*)(p.ws + WS_YRAW); const bf16_t* proj = (const bf16_t*)(p.ws + WS_PROJ); bf16_t* ymix = (bf16_t*)(p.ws + WS_YMIX);
    for (int it = blockIdx.x * 8 + wv; it < MTOK * 2; it += gridDim.x * 8) {
        const int tok = it >> 1, grp = it & 1, c = grp * 512 + lane * 8;
        const f32x4 y0 = *(const f32x4*)(yraw + (size_t)tok * 1024 + c), y1 = *(const f32x4*)(yraw + (size_t)tok * 1024 + c + 4);
        const uint4 zr = *(const uint4*)(proj + (size_t)tok * INWP + COL_Z + c); float z[8], y[8]; unpack8(zr, z); float ss = 0.f;
#pragma unroll
        for (int e = 0; e < 8; ++e) { const float yy = (e < 4 ? y0[e] : y1[e - 4]); y[e] = yy * z[e] * sigmoidf_(z[e]); ss += y[e] * y[e]; }
        ss = wave_sum(ss); const float r = rsqrtf(ss * (1.0f / 512) + 1e-6f);
        const f32x4 n0 = *(const f32x4*)(p.in[11] + c), n1 = *(const f32x4*)(p.in[11] + c + 4);
        u32x4 w; w.x = cvt_pk_nv(y[0] * r * n0[0], y[1] * r * n0[1]); w.y = cvt_pk_nv(y[2] * r * n0[2], y[3] * r * n0[3]);
        w.z = cvt_pk_nv(y[4] * r * n1[0], y[5] * r * n1[1]); w.w = cvt_pk_nv(y[6] * r * n1[2], y[7] * r * n1[3]);
        *(u32x4*)(ymix + (size_t)tok * D + 1024 + c) = w;
    }
}

__device__ __forceinline__ float half_sum(float v, bool lo) {
    (void)lo; v = red16(v); return v + __shfl_xor(v, 16); }
__device__ __forceinline__ void rwkv_scan_job(const Params& p, int job, LAS unsigned char* lds) {
    const int tid = opq(threadIdx.x), lane = tid & 63, l32 = lane & 31; const bool lo = lane < 32;
    const int b = job >> 5, hh = job & 31;
    LAS float* L = (LAS float*)lds;
    const bool producer = tid >= 256;
    const int pw = (tid >> 6) & 3;
    const int tl0 = 2 * pw + (lane >> 5);
    const size_t wbase = ((size_t)b * SEQ * D + hh * 64) / 2 + l32 + (size_t)tl0 * (D / 2);
    const unsigned* R32 = (const unsigned*)(p.ws + WS_R) + wbase; const unsigned* K32 = (const unsigned*)(p.ws + WS_K) + wbase; const unsigned* V32 = (const unsigned*)(p.ws + WS_V) + wbase;
    const unsigned* E32 = (const unsigned*)(p.ws + WS_WDEC) + wbase; const unsigned* A32 = (const unsigned*)(p.ws + WS_AA) + wbase; const unsigned* G32 = (const unsigned*)(p.ws + WS_GG) + wbase;
    unsigned* Y32 = (unsigned*)(p.ws + WS_YG) + wbase;
    const int ci = hh * 64 + 2 * l32;
    const float2 kkw = *(const float2*)(p.in[25] + ci), kaw = *(const float2*)(p.in[26] + ci), rkw = *(const float2*)(p.in[27] + ci), lnw = *(const float2*)(p.in[32] + ci), lnb = *(const float2*)(p.in[33] + ci);
    unsigned rw[2], kw[2], vw[2], ew[2], aw[2], gw[2];
    const int oo = tl0 * 64 + 2 * l32;
#define RW_ISSUE(t0) do { _Pragma("unroll") for (int i2 = 0; i2 < 2; ++i2) { const size_t off = (size_t)((t0) + 8 * i2) * (D / 2); rw[i2] = R32[off]; kw[i2] = K32[off]; vw[i2] = V32[off]; ew[i2] = E32[off]; aw[i2] = A32[off]; gw[i2] = G32[off]; } } while (0)
#define RW_COMMIT(buf) do { _Pragma("unroll") for (int i2 = 0; i2 < 2; ++i2) { LAS float* Lc = L + (buf) * 8192 + oo + i2 * 512; \
        const float r0_ = bflo(rw[i2]), r1_ = bfhi(rw[i2]), k0_ = bflo(kw[i2]), k1_ = bfhi(kw[i2]), v0_ = bflo(vw[i2]), v1_ = bfhi(vw[i2]), e0_ = bflo(ew[i2]), e1_ = bfhi(ew[i2]), a0_ = bflo(aw[i2]), a1_ = bfhi(aw[i2]), g0_ = bflo(gw[i2]), g1_ = bfhi(gw[i2]); \
        const float kkv0 = k0_ * kkw.x, kkv1 = k1_ * kkw.y; const float ssq = half_sum(kkv0 * kkv0 + kkv1 * kkv1, lo); const float rn = rsqrtf(fmaxf(ssq, 1e-24f)); const float kn0 = kkv0 * rn, kn1 = kkv1 * rn; \
        const float km0 = k0_ * (1.0f + (a0_ - 1.0f) * kaw.x), km1 = k1_ * (1.0f + (a1_ - 1.0f) * kaw.y); const float bonus = half_sum(r0_ * km0 * rkw.x + r1_ * km1 * rkw.y, lo); \
        *(LAS f32x2*)(Lc) = (f32x2){-kn0, -kn1}; *(LAS f32x2*)(Lc + 1024) = (f32x2){__expf(-e0_), __expf(-e1_)}; *(LAS f32x2*)(Lc + 2048) = (f32x2){kn0 * a0_, kn1 * a1_}; *(LAS f32x2*)(Lc + 3072) = (f32x2){km0, km1}; \
        *(LAS f32x2*)(Lc + 4096) = (f32x2){r0_, r1_}; *(LAS f32x2*)(Lc + 5120) = (f32x2){v0_, v1_}; *(LAS f32x2*)(Lc + 6144) = (f32x2){g0_, g1_}; *(LAS f32x2*)(Lc + 7168) = (f32x2){bonus * v0_, bonus * v1_}; } } while (0)
#define RW_OUTPUT(chp) do { LAS float* Lo = L + ((chp) & 1) * 8192; LAS float* yo = L + 16384 + ((chp) & 1) * 1024; _Pragma("unroll") for (int i2 = 0; i2 < 2; ++i2) { const int o2 = oo + i2 * 512; \
        const f32x2 y = *(LAS f32x2*)(yo + o2); \
        const float mu = half_sum(y.x + y.y, lo) * (1.0f / 64), d0 = y.x - mu, d1 = y.y - mu, var = half_sum(d0 * d0 + d1 * d1, lo) * (1.0f / 64), rs = rsqrtf(var + 64e-5f); \
        const f32x2 bv = *(LAS f32x2*)(Lo + 7168 + o2), gg = *(LAS f32x2*)(Lo + 6144 + o2); \
        Y32[(size_t)((chp) * 16 + 8 * i2) * (D / 2)] = cvt_pk_nv((d0 * rs * lnw.x + lnb.x + bv.x) * gg.x, (d1 * rs * lnw.y + lnb.y + bv.y) * gg.y); } } while (0)
    f32x2 SA[4], SB[4];
#pragma unroll
    for (int i = 0; i < 4; ++i) { SA[i] = (f32x2){0.f, 0.f}; SB[i] = (f32x2){0.f, 0.f}; }
    const int rp = (tid >> 3) & 31, ks = tid & 7;
    __syncthreads();
    if (producer) { RW_ISSUE(0); RW_COMMIT(0); RW_ISSUE(16); }
    __syncthreads();
    for (int ch = 0; ch < 128; ++ch) {
        const int cur = ch & 1;
        if (producer) {
            if (ch >= 1) RW_OUTPUT(ch - 1);
            if (ch + 1 < 128) RW_COMMIT(cur ^ 1);
            if (ch + 2 < 128) RW_ISSUE((ch + 2) * 16);
        } else {
            LAS float* Lb = L + cur * 8192; LAS float* yb = L + 16384 + cur * 1024;
            float yA[16], yB[16];
            LAS float* q0 = Lb + ks * 8;
            f32x4 a0 = *(LAS f32x4*)(q0), a1 = *(LAS f32x4*)(q0 + 4), w0 = *(LAS f32x4*)(q0 + 1024), w1 = *(LAS f32x4*)(q0 + 1028), b0 = *(LAS f32x4*)(q0 + 2048), b1 = *(LAS f32x4*)(q0 + 2052);
            f32x4 k0 = *(LAS f32x4*)(q0 + 3072), k1 = *(LAS f32x4*)(q0 + 3076), r0 = *(LAS f32x4*)(q0 + 4096), r1 = *(LAS f32x4*)(q0 + 4100);
            float va = Lb[5120 + rp], vb = Lb[5120 + rp + 32];
#pragma unroll
            for (int t = 0; t < 16; ++t) {
                f32x4 na0, na1, nw0, nw1, nb0, nb1, nk0, nk1, nr0, nr1; float nva, nvb;
                if (t + 1 < 16) { LAS float* q = q0 + (t + 1) * 64;
                    na0 = *(LAS f32x4*)(q); na1 = *(LAS f32x4*)(q + 4); nw0 = *(LAS f32x4*)(q + 1024); nw1 = *(LAS f32x4*)(q + 1028); nb0 = *(LAS f32x4*)(q + 2048); nb1 = *(LAS f32x4*)(q + 2052);
                    nk0 = *(LAS f32x4*)(q + 3072); nk1 = *(LAS f32x4*)(q + 3076); nr0 = *(LAS f32x4*)(q + 4096); nr1 = *(LAS f32x4*)(q + 4100); nva = Lb[5120 + (t + 1) * 64 + rp]; nvb = Lb[5120 + (t + 1) * 64 + rp + 32]; }
                __builtin_amdgcn_sched_barrier(0);
                f32x2 ca = SA[0] * a0.xy, cb = SB[0] * a0.xy; ca = SA[1] * a0.zw + ca; cb = SB[1] * a0.zw + cb; ca = SA[2] * a1.xy + ca; cb = SB[2] * a1.xy + cb; ca = SA[3] * a1.zw + ca; cb = SB[3] * a1.zw + cb;
                float sa = ca.x + ca.y, sb = cb.x + cb.y;
                sa = dpp_add<0xB1>(sa); sb = dpp_add<0xB1>(sb); sa = dpp_add<0x4E>(sa); sb = dpp_add<0x4E>(sb); sa = dpp_add<0x141>(sa); sb = dpp_add<0x141>(sb);
                const f32x2 sa2 = (f32x2){sa, sa}, sb2 = (f32x2){sb, sb}, va2 = (f32x2){va, va}, vb2 = (f32x2){vb, vb};
                SA[0] = SA[0] * w0.xy + (sa2 * b0.xy + va2 * k0.xy); SB[0] = SB[0] * w0.xy + (sb2 * b0.xy + vb2 * k0.xy);
                SA[1] = SA[1] * w0.zw + (sa2 * b0.zw + va2 * k0.zw); SB[1] = SB[1] * w0.zw + (sb2 * b0.zw + vb2 * k0.zw);
                SA[2] = SA[2] * w1.xy + (sa2 * b1.xy + va2 * k1.xy); SB[2] = SB[2] * w1.xy + (sb2 * b1.xy + vb2 * k1.xy);
                SA[3] = SA[3] * w1.zw + (sa2 * b1.zw + va2 * k1.zw); SB[3] = SB[3] * w1.zw + (sb2 * b1.zw + vb2 * k1.zw);
                f32x2 ya = SA[0] * r0.xy, yb2 = SB[0] * r0.xy; ya = SA[1] * r0.zw + ya; yb2 = SB[1] * r0.zw + yb2; ya = SA[2] * r1.xy + ya; yb2 = SB[2] * r1.xy + yb2; ya = SA[3] * r1.zw + ya; yb2 = SB[3] * r1.zw + yb2;
                float ra = ya.x + ya.y, rb = yb2.x + yb2.y;
                ra = dpp_add<0xB1>(ra); rb = dpp_add<0xB1>(rb); ra = dpp_add<0x4E>(ra); rb = dpp_add<0x4E>(rb); ra = dpp_add<0x141>(ra); rb = dpp_add<0x141>(rb);
                yA[t] = ra; yB[t] = rb;
                __builtin_amdgcn_sched_barrier(0);
                if (t + 1 < 16) { a0 = na0; a1 = na1; w0 = nw0; w1 = nw1; b0 = nb0; b1 = nb1; k0 = nk0; k1 = nk1; r0 = nr0; r1 = nr1; va = nva; vb = nvb; }
            }
            if (ks == 0) {
#pragma unroll
                for (int t = 0; t < 16; ++t) { yb[t * 64 + rp] = yA[t]; yb[t * 64 + rp + 32] = yB[t]; } }
        }
        __syncthreads();
    }
    if (producer) RW_OUTPUT(127);
#undef RW_ISSUE
#undef RW_COMMIT
#undef RW_OUTPUT
}

__device__ __forceinline__ void rwkv_chunk_job(const Params& p, int job, LAS unsigned char* lds) {
    const int tid = opq(threadIdx.x), lane = tid & 63, w = tid >> 6, fr = lane & 15, fq = lane >> 4, l16 = lane & 15;
    const int b = job >> 5, hh = job & 31;
    const int tl = 4 * (w & 3) + (lane >> 4);
    const size_t wbase = ((size_t)b * SEQ * D + hh * 64) / 4 + l16 + (size_t)tl * (D / 4);
    const uint2* R64 = (const uint2*)(p.ws + WS_R) + wbase; const uint2* K64 = (const uint2*)(p.ws + WS_K) + wbase; const uint2* V64 = (const uint2*)(p.ws + WS_V) + wbase;
    const uint2* E64 = (const uint2*)(p.ws + WS_WDEC) + wbase; const uint2* A64 = (const uint2*)(p.ws + WS_AA) + wbase; const uint2* G64 = (const uint2*)(p.ws + WS_GG) + wbase;
    uint2* Y64 = (uint2*)(p.ws + WS_YG) + wbase;
    const int ci = hh * 64 + 4 * l16;
    const f32x4 kkw = *(const f32x4*)(p.in[25] + ci), kaw = *(const f32x4*)(p.in[26] + ci), rkw = *(const f32x4*)(p.in[27] + ci), lnw = *(const f32x4*)(p.in[32] + ci), lnb = *(const f32x4*)(p.in[33] + ci);
    LAS float* Av = (LAS float*)(lds + 0);
    LAS float* Bv = (LAS float*)(lds + 4096);
    LAS float* Km = (LAS float*)(lds + 8192);
    LAS float* Rr = (LAS float*)(lds + 12288);
    LAS float* ybuf = (LAS float*)(lds + 16384);
    LAS float* RHS = (LAS float*)(lds + 20480);
    LAS float* Aab = (LAS float*)(lds + 24832);
    LAS float* Wend = (LAS float*)(lds + 25856);
    LAS bf16_t* ET = (LAS bf16_t*)(lds + 26112);
    LAS bf16_t* VT = (LAS bf16_t*)(lds + 31232);
    LAS bf16_t* BtT = (LAS bf16_t*)(lds + 36352);
    LAS bf16_t* KtT = (LAS bf16_t*)(lds + 41472);
    LAS bf16_t* Ub = (LAS bf16_t*)(lds + 46592);
    LAS bf16_t* AakT = (LAS bf16_t*)(lds + 51712);
    LAS bf16_t* AbrT = (LAS bf16_t*)(lds + 52992);
    LAS bf16_t* AkrT = (LAS bf16_t*)(lds + 54272);
    LAS bf16_t* At = (LAS bf16_t*)(lds + 55552);
    LAS bf16_t* Bt = (LAS bf16_t*)(lds + 57856);
    LAS bf16_t* Kt = (LAS bf16_t*)(lds + 60160);
    LAS bf16_t* Rt = (LAS bf16_t*)(lds + 62464);
    LAS bf16_t* S0b = (LAS bf16_t*)(lds + 64768);
    LAS bf16_t* VT1 = (LAS bf16_t*)(lds + 73984);
    constexpr int LDS_END = 73984 + 64 * 40 * 2;
    __syncthreads();
    for (int i = tid; i < LDS_END / 4; i += 512) ((LAS unsigned*)lds)[i] = 0u;
    f32x4 stt[2]; stt[0] = (f32x4){0.f, 0.f, 0.f, 0.f}; stt[1] = stt[0];
    const int vt = w >> 1, kt0 = (w & 1) * 2;
    bf16x8 Lf;
#pragma unroll
    for (int e = 0; e < 8; ++e) { const int i = fq * 8 + e; Lf[e] = (i <= fr && i < 16) ? (short)0x3F80 : (short)0; }
    uint2 rw, kw, vw, ew, aw, gw;
#define RC_ISSUE(t0) do { const size_t off = (size_t)(t0) * (D / 4); rw = R64[off]; kw = K64[off]; vw = V64[off]; ew = E64[off]; aw = A64[off]; gw = G64[off]; } while (0)
#define RC_PREP(chn) do { \
        const f32x4 r_ = (f32x4){bflo(rw.x), bfhi(rw.x), bflo(rw.y), bfhi(rw.y)}, k_ = (f32x4){bflo(kw.x), bfhi(kw.x), bflo(kw.y), bfhi(kw.y)}, v_ = (f32x4){bflo(vw.x), bfhi(vw.x), bflo(vw.y), bfhi(vw.y)}; \
        const f32x4 a_ = (f32x4){bflo(aw.x), bfhi(aw.x), bflo(aw.y), bfhi(aw.y)}; gn = (f32x4){bflo(gw.x), bfhi(gw.x), bflo(gw.y), bfhi(gw.y)}; \
        const uint2 ewc = ew, vwc = vw; \
        RC_ISSUE((((chn) + 1 < 128) ? (chn) + 1 : 127) * 16);     \
        const f32x4 kkv = k_ * kkw; const float ssq = red16(kkv[0] * kkv[0] + kkv[1] * kkv[1] + kkv[2] * kkv[2] + kkv[3] * kkv[3]); const float rn = rsqrtf(fmaxf(ssq, 1e-24f)); const f32x4 kn = kkv * rn; \
        const f32x4 km = k_ * ((a_ - 1.0f) * kaw + 1.0f); const f32x4 rk_ = r_ * km * rkw; const float bonus = red16(rk_[0] + rk_[1] + rk_[2] + rk_[3]); \
        bn = v_ * bonus; \
        { const int o = tl * 64 + 4 * l16; LAS bf16_t* VTw = ((chn) & 1) ? VT1 : VT; \
          pa = -kn; pb = kn * a_; pk = km; pr = r_; pe = ewc; (void)o; \
          ET[(4 * l16) * 40 + tl] = (bf16_t)(ewc.x & 0xffffu); ET[(4 * l16 + 1) * 40 + tl] = (bf16_t)(ewc.x >> 16); ET[(4 * l16 + 2) * 40 + tl] = (bf16_t)(ewc.y & 0xffffu); ET[(4 * l16 + 3) * 40 + tl] = (bf16_t)(ewc.y >> 16); \
          VTw[(4 * l16) * 40 + tl] = (bf16_t)(vwc.x & 0xffffu); VTw[(4 * l16 + 1) * 40 + tl] = (bf16_t)(vwc.x >> 16); VTw[(4 * l16 + 2) * 40 + tl] = (bf16_t)(vwc.y & 0xffffu); VTw[(4 * l16 + 3) * 40 + tl] = (bf16_t)(vwc.y >> 16); } } while (0)
    f32x4 gc = (f32x4){0.f, 0.f, 0.f, 0.f}, bc = gc, gn = gc, bn = gc;
    f32x4 pa = gc, pb = gc, pk = gc, pr = gc; uint2 pe = make_uint2(0u, 0u);
    LAS float* Ecum = Av;
#define RC_P1A() do { const bf16x8 eb = *(LAS bf16x8*)(ET + (w * 16 + fr) * 40 + fq * 8); f32x4 ec = (f32x4){0.f, 0.f, 0.f, 0.f}; ec = __builtin_amdgcn_mfma_f32_16x16x32_bf16(Lf, eb, ec, 0, 0, 0); \
        _Pragma("unroll") for (int i = 0; i < 4; ++i) Ecum[(fq * 4 + i) * 64 + w * 16 + fr] = ec[i]; } while (0)
#define RC_P1B() do { const f32x4 E = *(LAS f32x4*)(Ecum + tl * 64 + 4 * l16); const f32x4 et = (f32x4){bflo(pe.x), bfhi(pe.x), bflo(pe.y), bfhi(pe.y)}; \
        f32x4 Wt, Wp, iW; _Pragma("unroll") for (int e = 0; e < 4; ++e) { Wt[e] = __expf(-E[e]); Wp[e] = __expf(et[e] - E[e]); iW[e] = __builtin_amdgcn_rcpf(Wt[e]); } \
        const f32x4 at = pa * Wp, rt = pr * Wt, bt = pb * iW, kt = pk * iW; const int o2 = tl * 72 + 4 * l16; \
        *(LAS u32x2*)(At + o2) = (u32x2){cvt_pk_bf16(at[0], at[1]), cvt_pk_bf16(at[2], at[3])}; *(LAS u32x2*)(Rt + o2) = (u32x2){cvt_pk_bf16(rt[0], rt[1]), cvt_pk_bf16(rt[2], rt[3])}; \
        *(LAS u32x2*)(Bt + o2) = (u32x2){cvt_pk_bf16(bt[0], bt[1]), cvt_pk_bf16(bt[2], bt[3])}; *(LAS u32x2*)(Kt + o2) = (u32x2){cvt_pk_bf16(kt[0], kt[1]), cvt_pk_bf16(kt[2], kt[3])}; \
        _Pragma("unroll") for (int e = 0; e < 4; ++e) { BtT[(4 * l16 + e) * 40 + tl] = f2bf(bt[e]); KtT[(4 * l16 + e) * 40 + tl] = f2bf(kt[e]); } \
        if (tl == 15) *(LAS f32x4*)(Wend + 4 * l16) = Wt; } while (0)

    if (w >= 4) RC_ISSUE(0);
    __syncthreads();
    if (w >= 4) { RC_PREP(0); gc = gn; bc = bn; }
    __syncthreads();
    if (w < 4) RC_P1A();
    __syncthreads();
    if (w >= 4) RC_P1B();
    __syncthreads();
    for (int ch = 0; ch < 128; ++ch) {
        LAS bf16_t* VTc = (ch & 1) ? VT1 : VT;
        if (w < 4) {
            LAS bf16_t* Xr = (w & 1) ? Kt : Bt; LAS bf16_t* Yr = (w & 2) ? Rt : At;
            f32x4 gacc = (f32x4){0.f, 0.f, 0.f, 0.f};
#pragma unroll
            for (int ks = 0; ks < 2; ++ks) { const bf16x8 xa = *(LAS bf16x8*)(Xr + fr * 72 + ks * 32 + fq * 8); const bf16x8 yb_ = *(LAS bf16x8*)(Yr + fr * 72 + ks * 32 + fq * 8); gacc = __builtin_amdgcn_mfma_f32_16x16x32_bf16(xa, yb_, gacc, 0, 0, 0); }
            float gm[4];
#pragma unroll
            for (int i = 0; i < 4; ++i) { const int j = fq * 4 + i; const bool keep = (w & 2) ? (j <= fr) : (j < fr); gm[i] = keep ? gacc[i] : 0.f; }
            if (w == 0) {
#pragma unroll
                for (int i = 0; i < 4; ++i) Aab[(fq * 4 + i) * 16 + fr] = gm[i]; }
            else { LAS bf16_t* dst = (w == 1) ? AakT : (w == 2) ? AbrT : AkrT; *(LAS u32x2*)(dst + fr * 40 + fq * 4) = (u32x2){cvt_pk_bf16(gm[0], gm[1]), cvt_pk_bf16(gm[2], gm[3])}; }
        }
        __syncthreads();
        f32x4 y0 = (f32x4){0.f, 0.f, 0.f, 0.f};
        { const int vtile = w & 3; LAS bf16_t* Yr = (w < 4) ? At : Rt; LAS bf16_t* Gt = (w < 4) ? AakT : AkrT;
#pragma unroll
          for (int ks = 0; ks < 2; ++ks) { const bf16x8 sa = *(LAS bf16x8*)(S0b + (vtile * 16 + fr) * 72 + ks * 32 + fq * 8); const bf16x8 yb_ = *(LAS bf16x8*)(Yr + fr * 72 + ks * 32 + fq * 8); y0 = __builtin_amdgcn_mfma_f32_16x16x32_bf16(sa, yb_, y0, 0, 0, 0); }
          { const bf16x8 va = *(LAS bf16x8*)(VTc + (vtile * 16 + fr) * 40 + fq * 8); const bf16x8 gb = *(LAS bf16x8*)(Gt + fr * 40 + fq * 8); y0 = __builtin_amdgcn_mfma_f32_16x16x32_bf16(va, gb, y0, 0, 0, 0); }
          if (w < 4) {
#pragma unroll
              for (int i = 0; i < 4; ++i) RHS[(vtile * 16 + fq * 4 + i) * 17 + fr] = y0[i]; } }
        __syncthreads();
        if (w == 0) {
            float u[16];
#pragma unroll
            for (int t = 0; t < 16; ++t) u[t] = RHS[lane * 17 + t];
#pragma unroll
            for (int t = 0; t < 15; ++t) {
#pragma unroll
                for (int t2 = t + 1; t2 < 16; ++t2) u[t2] += u[t] * Aab[t * 16 + t2]; }
            u32x4 o0, o1; o0.x = cvt_pk_bf16(u[0], u[1]); o0.y = cvt_pk_bf16(u[2], u[3]); o0.z = cvt_pk_bf16(u[4], u[5]); o0.w = cvt_pk_bf16(u[6], u[7]);
            o1.x = cvt_pk_bf16(u[8], u[9]); o1.y = cvt_pk_bf16(u[10], u[11]); o1.z = cvt_pk_bf16(u[12], u[13]); o1.w = cvt_pk_bf16(u[14], u[15]);
            *(LAS u32x4*)(Ub + lane * 40) = o0; *(LAS u32x4*)(Ub + lane * 40 + 8) = o1;
        }
        if (w >= 4) { RC_PREP(ch + 1); }
        __syncthreads();
        if (w >= 4) { const int vtile = w & 3;
            const bf16x8 ua = *(LAS bf16x8*)(Ub + (vtile * 16 + fr) * 40 + fq * 8); const bf16x8 gb = *(LAS bf16x8*)(AbrT + fr * 40 + fq * 8); y0 = __builtin_amdgcn_mfma_f32_16x16x32_bf16(ua, gb, y0, 0, 0, 0);
#pragma unroll
            for (int i = 0; i < 4; ++i) ybuf[fr * 64 + vtile * 16 + fq * 4 + i] = y0[i]; }
        { const bf16x8 ua = *(LAS bf16x8*)(Ub + (vt * 16 + fr) * 40 + fq * 8); const bf16x8 va = *(LAS bf16x8*)(VTc + (vt * 16 + fr) * 40 + fq * 8);
#pragma unroll
          for (int q = 0; q < 2; ++q) { const int kk = (kt0 + q) * 16 + fr;
              const bf16x8 bb = *(LAS bf16x8*)(BtT + kk * 40 + fq * 8); const bf16x8 kb = *(LAS bf16x8*)(KtT + kk * 40 + fq * 8);
              f32x4 acc = stt[q]; acc = __builtin_amdgcn_mfma_f32_16x16x32_bf16(ua, bb, acc, 0, 0, 0); acc = __builtin_amdgcn_mfma_f32_16x16x32_bf16(va, kb, acc, 0, 0, 0);
              const float we = Wend[kk]; acc = acc * we; stt[q] = acc;
#pragma unroll
              for (int i = 0; i < 4; ++i) S0b[(vt * 16 + fq * 4 + i) * 72 + kk] = f2bf(acc[i]); } }
        if (w < 4 && ch + 1 < 128) RC_P1A();
        __syncthreads();
        if (w >= 4) { const f32x4 y = *(LAS f32x4*)(ybuf + tl * 64 + 4 * l16);
          const float mu = red16(y[0] + y[1] + y[2] + y[3]) * (1.0f / 64); const f32x4 d = y - mu;
          const float var = red16(d[0] * d[0] + d[1] * d[1] + d[2] * d[2] + d[3] * d[3]) * (1.0f / 64), rs = rsqrtf(var + 64e-5f);
          const f32x4 o4 = (d * rs * lnw + lnb + bc) * gc;
          Y64[(size_t)(ch * 16) * (D / 4)] = make_uint2(cvt_pk_nv(o4[0], o4[1]), cvt_pk_nv(o4[2], o4[3]));
          gc = gn; bc = bn;
          if (ch + 1 < 128) RC_P1B(); }
        __syncthreads();
    }
#undef RC_P1A
#undef RC_P1B
#undef RC_ISSUE
#undef RC_PREP
}

#define XB_TMO      128
#define XB_XCNT(j)  (256  + 64 * (j))
#define XB_XSUB(j)  (1280 + 64 * (j))
#define XB_XGEN(j)  (2304 + 64 * (j))
#define XB_TOP      3328
#define XB_TOPGEN   3392
#define XCD_BAR_WORDS 3456
#define XB_SPIN_CAP (1u << 18)

__device__ __forceinline__ unsigned xb_ld(unsigned* p)              { return __hip_atomic_load(p, __ATOMIC_RELAXED, __HIP_MEMORY_SCOPE_AGENT); }
__device__ __forceinline__ unsigned xb_add(unsigned* p, unsigned v) { return __hip_atomic_fetch_add(p, v, __ATOMIC_RELAXED, __HIP_MEMORY_SCOPE_AGENT); }
__device__ __forceinline__ unsigned xb_xcc_id() { return (unsigned)__builtin_amdgcn_s_getreg((3 << 11) | 20) & 0xFu; }
#define XB_SPIN(cond, bar) do { unsigned _sp = 0; while (cond) { __builtin_amdgcn_s_sleep(1); \
    if ((++_sp & 255u) == 0u) { if (xb_ld(&(bar)[XB_TMO])) break; if (_sp > XB_SPIN_CAP) { atomicAdd(&(bar)[XB_TMO], 1u); break; } } } } while (0)

struct XcdBarrier {
    unsigned* bar; unsigned x;
    volatile LAS unsigned* st;
};

__device__ __forceinline__ XcdBarrier xcd_barrier_post(unsigned* bar, volatile LAS unsigned* st) {
    XcdBarrier b; b.bar = bar; b.x = xb_xcc_id(); b.st = st;
    if (threadIdx.x == 0) (void)xb_add(&bar[XB_XCNT(b.x)], 1u);
    return b;
}
__device__ __forceinline__ void xcd_barrier_complete(unsigned* bar, unsigned x, unsigned& nloc, unsigned& nx) {
    const unsigned G = gridDim.x * gridDim.y * gridDim.z;
    unsigned sum, cnt, mine, sp = 0u;
    for (;;) {
        sum = 0u; cnt = 0u; mine = 0u;
#pragma unroll
        for (unsigned j = 0; j < 16; ++j) { const unsigned c = xb_ld(&bar[XB_XCNT(j)]); sum += c; cnt += (c > 0u) ? 1u : 0u; mine = (j == x) ? c : mine; }
        if (sum == G) break;
        __builtin_amdgcn_s_sleep(1);
        if ((++sp & 255u) == 0u) { if (xb_ld(&bar[XB_TMO])) break; if (sp > XB_SPIN_CAP) { atomicAdd(&bar[XB_TMO], 1u); break; } }
    }
    nloc = mine > 0u ? mine : 1u; nx = cnt > 0u ? cnt : 1u;
}

__device__ __forceinline__ void xcd_barrier(const XcdBarrier& b) {
    asm volatile("s_waitcnt vmcnt(0)" ::: "memory");
    __syncthreads();
    if (threadIdx.x == 0) {
        unsigned* bar = b.bar;
        __builtin_amdgcn_s_waitcnt(0);
        unsigned nloc = b.st[0], nx = b.st[1];
        if (nloc == 0u) { xcd_barrier_complete(bar, b.x, nloc, nx); b.st[0] = nloc; b.st[1] = nx; }
        const unsigned old = xb_add(&bar[XB_XSUB(b.x)], 1u);
        const unsigned gen = old / nloc;
        if (old + 1u == (gen + 1u) * nloc) {
            __builtin_amdgcn_fence(__ATOMIC_RELEASE, "agent");
            asm volatile("s_waitcnt vmcnt(0)" ::: "memory");
            const unsigned og = xb_add(&bar[XB_TOP], 1u);
            const unsigned tg = og / nx;
            if (og + 1u == (tg + 1u) * nx) xb_add(&bar[XB_TOPGEN], 1u);
            else XB_SPIN(xb_ld(&bar[XB_TOPGEN]) == tg, bar);
            __builtin_amdgcn_fence(__ATOMIC_ACQUIRE, "agent");
            xb_add(&bar[XB_XGEN(b.x)], 1u);
            asm volatile("s_waitcnt vmcnt(0)" ::: "memory");
        } else {
            XB_SPIN(xb_ld(&bar[XB_XGEN(b.x)]) == gen, bar);
            __builtin_amdgcn_fence(__ATOMIC_ACQUIRE, "agent");
            asm volatile("s_waitcnt vmcnt(0)" ::: "memory");
        }
    }
    __syncthreads();
}


__global__ __launch_bounds__(512, 2) void mega(const Params p_arg) {
    extern __shared__ __attribute__((aligned(16))) unsigned char shm[];
    const Params& p = *(const Params*)(const void*)__builtin_amdgcn_kernarg_segment_ptr();
    LAS unsigned char* lds = (LAS unsigned char*)shm;
    const int G = (int)gridDim.x, bid = (int)blockIdx.x;
    __shared__ uint4 xb_words;
    if (threadIdx.x == 0) xb_words = make_uint4(0u, 0u, 0u, 0u);
    __syncthreads();
    (void)xcd_barrier_post((unsigned*)(p.ws + WS_BAR), (volatile LAS unsigned*)&xb_words);
    const int step_lo = p.step_lo, step_hi = p.step_hi;
    for (int s = step_lo; s < step_hi; ++s) {
        const int kind = p.kind[s], lo = p.lo[s], hi = p.hi[s];
        switch (kind) {
            case K_PRE0:
#ifndef NO_PRE
 convert_tiles(p, lo, hi, lds); rope_table(p); norm_rows(p.in[0], p.in[1], (bf16_t*)(p.ws + WS_H));
#endif
 break;
            case K_GEMMB:
#ifndef NO_GB

                { pg8::Gemm g; g.A = p.g[lo].A; g.Bt = p.g[lo].Bt; g.M = p.g[lo].M; g.N = p.g[lo].N; g.K = p.g[lo].K;
                  MultiOrder S; S.ops = &p.g[lo]; S.nops = hi - lo; S.G = G; S.c = bid;
                  EpiB E; E.ops = &p.g[lo];
                  pg8::gemm_phase<EpiB, MultiOrder, false>(lds, g, S, E, nullptr); }
                if (p.chi[s] > p.clo[s]) convert_queue(p, p.clo[s], p.chi[s], (unsigned*)(p.ws + WS_BAR + 16384) + 64 * p.cq[s], lds);
#endif
                break;
            case K_GEMMF:
#ifndef NO_GF

                for (int i = lo; i < hi; ++i) { const GemmOp& o = p.g[i]; pg8::Gemm g; g.A = o.A; g.Bt = o.Bt; g.M = o.M; g.N = o.N; g.K = o.K;
                    pg8::StaticOrder S; S.init(o.M, o.N, G, (bid + G - (o.rot % G)) % G);
                    EpiF E; E.C = (float*)o.out; E.ldc = o.ldc; E.res = o.res;
                    pg8::gemm_phase<EpiF, pg8::StaticOrder, false>(lds, g, S, E, nullptr); }
#endif
                break;
            case K_CONVSSD:
#ifndef NO_CONV
 conv_ssd(p);
#endif
 break;
            case K_MIX0:

#ifndef NO_SSD
for (int j = bid; j < 256; j += G) ssd_chunk_job(p, j, lds);
#endif


#ifndef NO_ATT
for (int j = bid; j < 512; j += G) attn_job(p, j, lds);
#endif

                break;
            case K_POST0: post_ssd(p); break;
            case K_NORM: norm_rows(p.out, p.in[2] + lo * D, (bf16_t*)(p.ws + WS_H)); break;
            case K_PRE1: convert_tiles(p, lo, hi, lds); mix_rows(p.out, p.in[1] + D, p.in[16], (bf16_t*)(p.ws + WS_MIX), 0, lds); break;
            case K_MIXES: mix_rows(p.out, p.in[1] + D, p.in[16], (bf16_t*)(p.ws + WS_MIX), 8192, lds); break;
            case K_RWKV:
#ifndef NO_RWKV
 for (int j = bid; j < 256; j += G) rwkv_chunk_job(p, j, lds);
#endif
 break;
            case K_NORMCONV: convert_tiles(p, lo, hi, lds); norm_rows(p.out, p.in[2] + D, (bf16_t*)(p.ws + WS_H)); break;
            default: break;
        }
        if (s + 1 < step_hi) { if (step_hi < 0) cg::this_grid().sync();   XcdBarrier xb; xb.bar = (unsigned*)(p.ws + WS_BAR); xb.x = xb_xcc_id(); xb.st = (volatile LAS unsigned*)&xb_words; xcd_barrier(xb); }
    }
}

#ifndef MK_MULTI
#define MK_MULTI 0
#endif
extern "C" void kernel_launch(void* const* d_in, const int* in_sizes, int n_in, void* d_out, int out_size, void* d_ws, size_t ws_size, hipStream_t stream) {
    static int grid = 0;
    if (grid == 0) {
        int dev = 0, cus = 0, per_cu = 0;
        hipGetDevice(&dev); hipDeviceGetAttribute(&cus, hipDeviceAttributeMultiprocessorCount, dev);
        if (hipFuncSetAttribute((const void*)mega, hipFuncAttributeMaxDynamicSharedMemorySize, LDS_BYTES) != hipSuccess) { fprintf(stderr, "hipFuncSetAttribute failed\n"); grid = -1; return; }
        if (hipOccupancyMaxActiveBlocksPerMultiprocessor(&per_cu, (const void*)mega, 512, LDS_BYTES) != hipSuccess || per_cu < 1) { fprintf(stderr, "occupancy query: %d\n", per_cu); per_cu = 1; }
        (void)hipGetLastError();
        grid = cus * per_cu; if (grid > 256) grid = 256;
        if (n_in != 34 || ws_size < 512 * MiB) { fprintf(stderr, "unexpected n_in %d / ws %zu\n", n_in, ws_size); grid = -1; return; }
    }
    if (grid < 0) return;
    static Params p;
    memset(&p, 0, sizeof(p));
    for (int i = 0; i < 34; ++i) p.in[i] = (const float*)d_in[i];
    p.out = (float*)d_out; p.ws = (unsigned char*)d_ws;
    unsigned char* ws = (unsigned char*)d_ws;
    auto B16 = [&](size_t off) { return (bf16_t*)(ws + off); };
    int ncj = 0, tile_acc = 0;
    auto CJ = [&](const float* src, size_t dst_off, int K, int N, int Kpad, int Npad) { ConvJob& c = p.cj[ncj++]; c.src = src; c.dst = B16(dst_off); c.K = K; c.N = N; c.Kpad = Kpad; c.Npad = Npad; c.tile0 = tile_acc; c.ntiles = (Kpad / 64) * (Npad / 256); tile_acc += c.ntiles; };
    const float* w_up = p.in[3]; const float* w_down = p.in[4];
    tile_acc = 0;
    CJ(p.in[5], WS_WBA, 2048, 4112, 2048, 4352); CJ(p.in[15], WS_WBA + 17 * MiB, 2048, 2048, 2048, 2048);
    tile_acc = 0;
    CJ(w_up, WS_WMLP, 2048, 8192, 2048, 8192); CJ(w_down, WS_WMLP + 32 * MiB, 8192, 2048, 8192, 2048);
    tile_acc = 0;
    CJ(p.in[28], WS_WBA, 2048, 2048, 2048, 2048); CJ(p.in[29], WS_WBA + 8 * MiB, 2048, 2048, 2048, 2048); CJ(p.in[30], WS_WBA + 16 * MiB, 2048, 2048, 2048, 2048); CJ(p.in[31], WS_WBA + 24 * MiB, 2048, 2048, 2048, 2048);
    CJ(p.in[18], WS_WBA + 32 * MiB, 2048, 96, 2048, 256); CJ(p.in[21], WS_WBA + 33 * MiB, 2048, 96, 2048, 256); CJ(p.in[23], WS_WBA + 34 * MiB, 2048, 256, 2048, 256);
    CJ(p.in[19], WS_WBA + 35 * MiB, 96, 2048, 256, 2048); CJ(p.in[22], WS_WBA + 36 * MiB, 96, 2048, 256, 2048); CJ(p.in[24], WS_WBA + 37 * MiB, 256, 2048, 256, 2048);
    tile_acc = 0;
    CJ(w_up + (size_t)2048 * 8192, WS_WMLP1, 2048, 8192, 2048, 8192); CJ(w_down + (size_t)2048 * 8192, WS_WMLP1 + 32 * MiB, 8192, 2048, 8192, 2048);
    int nop = 0;
    auto GO = [&](const bf16_t* A, const bf16_t* Bt, void* out, const float* bias, const float* res, int M, int N, int K, int ldc, int act, int rot) {
        GemmOp& o = p.g[nop++]; o.A = A; o.Bt = Bt; o.out = out; o.bias = bias; o.res = res; o.M = M; o.N = N; o.K = K; o.ldc = ldc; o.act = act; o.rot = rot; };
    GO(B16(WS_H), B16(WS_WBA), B16(WS_PROJ), nullptr, nullptr, MTOK, INWP, 2048, INWP, 0, 0);
    GO(B16(WS_YMIX), B16(WS_WBA + 17 * MiB), d_out, nullptr, p.in[0], MTOK, 2048, 2048, 2048, 0, 0);
    GO(B16(WS_H), B16(WS_WMLP), B16(WS_U), nullptr, nullptr, MTOK, DFF, 2048, DFF, 1, 0);
    GO(B16(WS_U), B16(WS_WMLP + 32 * MiB), d_out, nullptr, (const float*)d_out, MTOK, 2048, DFF, 2048, 0, 0);
    for (int half = 0; half < 2; ++half) {
        const size_t ro = (size_t)half * 8192 * 2048 * 2, lo_ = (size_t)half * 8192 * 256 * 2; const size_t mb = (size_t)8192 * 2048 * 2;
        GO(B16(WS_MIX + 0 * mb), B16(WS_WBA), B16(WS_R + ro), nullptr, nullptr, 8192, 2048, 2048, 2048, 0, 0);
        GO(B16(WS_MIX + 2 * mb), B16(WS_WBA + 8 * MiB), B16(WS_K + ro), nullptr, nullptr, 8192, 2048, 2048, 2048, 0, 0);
        GO(B16(WS_MIX + 3 * mb), B16(WS_WBA + 16 * MiB), B16(WS_V + ro), nullptr, nullptr, 8192, 2048, 2048, 2048, 0, 0);
        GO(B16(WS_MIX + 1 * mb), B16(WS_WBA + 32 * MiB), B16(WS_L1W + lo_), nullptr, nullptr, 8192, 256, 2048, 256, 2, 0);
        GO(B16(WS_MIX + 4 * mb), B16(WS_WBA + 33 * MiB), B16(WS_L1A + lo_), nullptr, nullptr, 8192, 256, 2048, 256, 0, 32);
        GO(B16(WS_MIX + 5 * mb), B16(WS_WBA + 34 * MiB), B16(WS_L1G + lo_), nullptr, nullptr, 8192, 256, 2048, 256, 3, 64);
    }
    GO(B16(WS_L1W), B16(WS_WBA + 35 * MiB), B16(WS_WDEC), p.in[17], nullptr, MTOK, 2048, 256, 2048, 4, 0);
    GO(B16(WS_L1A), B16(WS_WBA + 36 * MiB), B16(WS_AA), p.in[20], nullptr, MTOK, 2048, 256, 2048, 3, 0);
    GO(B16(WS_L1G), B16(WS_WBA + 37 * MiB), B16(WS_GG), nullptr, nullptr, MTOK, 2048, 256, 2048, 0, 0);
    GO(B16(WS_YG), B16(WS_WBA + 24 * MiB), d_out, nullptr, (const float*)d_out, MTOK, 2048, 2048, 2048, 0, 0);
    GO(B16(WS_H), B16(WS_WMLP1), B16(WS_U), nullptr, nullptr, MTOK, DFF, 2048, DFF, 1, 0);
    GO(B16(WS_U), B16(WS_WMLP1 + 32 * MiB), d_out, nullptr, (const float*)d_out, MTOK, 2048, DFF, 2048, 0, 0);
    int ns = 0;
    auto ST = [&](int kind, int lo, int hi, int clo = 0, int chi = 0, int cq = 0) { p.kind[ns] = kind; p.lo[ns] = lo; p.hi[ns] = hi; p.clo[ns] = clo; p.chi[ns] = chi; p.cq[ns] = cq; ++ns; };
    ST(K_PRE0, 0, 2); ST(K_GEMMB, 0, 1, 2, 4, 0); ST(K_CONVSSD, 0, 0); ST(K_MIX0, 0, 0); ST(K_POST0, 0, 0); ST(K_GEMMF, 1, 2); ST(K_NORM, 0, 0); ST(K_GEMMB, 2, 3); ST(K_GEMMF, 3, 4);
    ST(K_PRE1, 4, 14); ST(K_GEMMB, 4, 10, 14, 16, 1); ST(K_MIXES, 0, 0); ST(K_GEMMB, 10, 16, 14, 16, 1); ST(K_GEMMB, 16, 19); ST(K_RWKV, 0, 0); ST(K_GEMMF, 19, 20); ST(K_NORM, 1, 0); ST(K_GEMMB, 20, 21); ST(K_GEMMF, 21, 22);
    (void)hipMemsetAsync(ws + WS_BAR, 0, 16384 + 1024, stream);
#if MK_MULTI
    for (int s = 0; s < ns; ++s) { p.step_lo = s; p.step_hi = s + 1; hipLaunchKernelGGL(mega, dim3(grid), dim3(512), LDS_BYTES, stream, p); }
#else
    p.step_lo = 0; p.step_hi = ns;
    void* args[] = {(void*)&p};
    const hipError_t e = hipLaunchCooperativeKernel((const void*)mega, dim3(grid), dim3(512), args, LDS_BYTES, stream);
    if (e != hipSuccess) fprintf(stderr, "cooperative launch failed: %s (grid %d)\n", hipGetErrorString(e), grid);
#endif
}
```
